# Optimizing an MI355X kernel written in HIP

```python
import math
import jax, jax.numpy as jnp
from jax import lax
import numpy as np

D_MODEL = 1024
BATCH = 8
SEQ = 4096
DEPTH = 4

CHUNK = 64

MIX_WIDTH = D_MODEL
SSM_WIDTH = MIX_WIDTH // 2
SSM_GROUP_CH = 16
SSM_GROUPS = SSM_WIDTH // SSM_GROUP_CH
SSM_STATE = 64
DT_MIN = 1e-3
DT_MAX = 1e-1
ATTN_WIDTH = MIX_WIDTH - SSM_WIDTH
HEAD_DIM = 64
N_HEADS = ATTN_WIDTH // HEAD_DIM
Q_BLOCK = 128
IN_WIDTH = SSM_WIDTH + 3 * ATTN_WIDTH + N_HEADS

PEER_HEADS = 8
PEER_N_KEYS = 128
PEER_EXPERTS = PEER_N_KEYS * PEER_N_KEYS
PEER_TOPK = 16
PEER_QUERY_DIM = 128
PEER_HALF = PEER_QUERY_DIM // 2
PEER_BLOCK = 128

RMS_EPS = 1e-6

kernel_name = "hybrid_s5_fox_peer_trunk"


def rms_norm(x, g):
    xf = x.astype(jnp.float32)
    y = xf * lax.rsqrt(jnp.mean(xf * xf, axis=-1, keepdims=True) + RMS_EPS)
    return (y * g.astype(jnp.float32)).astype(x.dtype)


def _ssm_combine(e1, e2):
    a1r, a1i, b1r, b1i = e1
    a2r, a2i, b2r, b2i = e2
    return (a2r * a1r - a2i * a1i,
            a2r * a1i + a2i * a1r,
            a2r * b1r - a2i * b1i + b2r,
            a2r * b1i + a2i * b1r + b2i)


def s5_mixer(u, lam_re, lam_im, log_dt, b_re, b_im, c_re, c_im, d_skip, w_glu, b_glu):
    bsz, seq, _ = u.shape
    f32 = jnp.float32
    uf = u.astype(f32).reshape(bsz, seq, SSM_GROUPS, SSM_GROUP_CH)
    dt = jnp.exp(log_dt.astype(f32))[:, None]
    lr = lam_re.astype(f32)
    li = lam_im.astype(f32)
    mag = jnp.exp(lr * dt)
    a_re = mag * jnp.cos(li * dt)
    a_im = mag * jnp.sin(li * dt)
    den = lr * lr + li * li
    nr = a_re - 1.0
    z_re = (nr * lr + a_im * li) / den
    z_im = (a_im * lr - nr * li) / den
    br = b_re.astype(f32)
    bi = b_im.astype(f32)
    bb_re = z_re[..., None] * br - z_im[..., None] * bi
    bb_im = z_re[..., None] * bi + z_im[..., None] * br
    x_re = jnp.einsum('bsgh,gph->bsgp', uf, bb_re)
    x_im = jnp.einsum('bsgh,gph->bsgp', uf, bb_im)
    ar = jnp.broadcast_to(a_re[None, None], (1, seq, SSM_GROUPS, SSM_STATE))
    ai = jnp.broadcast_to(a_im[None, None], (1, seq, SSM_GROUPS, SSM_STATE))
    _, _, s_re, s_im = lax.associative_scan(_ssm_combine, (ar, ai, x_re, x_im), axis=1)
    y = (jnp.einsum('bsgp,ghp->bsgh', s_re, c_re.astype(f32))
         - jnp.einsum('bsgp,ghp->bsgh', s_im, c_im.astype(f32))
         + d_skip.astype(f32) * uf)
    g = jax.nn.gelu(y.reshape(bsz, seq, SSM_WIDTH))
    out = g * jax.nn.sigmoid(g @ w_glu.astype(f32) + b_glu.astype(f32))
    return out.astype(u.dtype)


def fox_attention(q, k, v, f_logit):
    bsz, seq, _ = q.shape
    qh = q.reshape(bsz, seq, N_HEADS, HEAD_DIM).transpose(0, 2, 1, 3)
    kh = k.reshape(bsz, seq, N_HEADS, HEAD_DIM).transpose(0, 2, 1, 3)
    vh = v.reshape(bsz, seq, N_HEADS, HEAD_DIM).transpose(0, 2, 1, 3)
    log_f = jax.nn.log_sigmoid(f_logit.astype(jnp.float32))
    cum = jnp.cumsum(log_f, axis=1).transpose(0, 2, 1)
    scale = HEAD_DIM ** -0.5
    outs = []
    for blk in range(seq // Q_BLOCK):
        q0 = blk * Q_BLOCK
        q1 = q0 + Q_BLOCK
        logits = jnp.einsum('bhqd,bhkd->bhqk', qh[:, :, q0:q1], kh[:, :, :q1]).astype(jnp.float32) * scale
        logits = logits + cum[:, :, q0:q1, None] - cum[:, :, None, :q1]
        causal = jnp.arange(q0, q1)[:, None] >= jnp.arange(q1)[None, :]
        logits = jnp.where(causal, logits, -jnp.inf)
        probs = jax.nn.softmax(logits, axis=-1).astype(vh.dtype)
        outs.append(jnp.einsum('bhqk,bhkd->bhqd', probs, vh[:, :, :q1]))
    out = jnp.concatenate(outs, axis=2)
    return out.transpose(0, 2, 1, 3).reshape(bsz, seq, ATTN_WIDTH)


def peer_ffn(h, w_q, sub_keys, u_tab, v_tab):
    bsz, seq, d = h.shape
    q = (h @ w_q).reshape(bsz, seq, PEER_HEADS, 2, PEER_HALF)
    s1 = jnp.einsum('bshd,hnd->bshn', q[..., 0, :], sub_keys[:, 0]).astype(jnp.float32)
    s2 = jnp.einsum('bshd,hnd->bshn', q[..., 1, :], sub_keys[:, 1]).astype(jnp.float32)
    t1, i1 = lax.top_k(s1, PEER_TOPK)
    t2, i2 = lax.top_k(s2, PEER_TOPK)
    cand = (t1[..., :, None] + t2[..., None, :]).reshape(bsz, seq, PEER_HEADS, PEER_TOPK * PEER_TOPK)
    cand_idx = (i1[..., :, None] * PEER_N_KEYS + i2[..., None, :]).reshape(bsz, seq, PEER_HEADS, PEER_TOPK * PEER_TOPK)
    best, pos = lax.top_k(cand, PEER_TOPK)
    idx = jnp.take_along_axis(cand_idx, pos, axis=-1)
    gate = jax.nn.softmax(best, axis=-1)
    n_tok = bsz * seq
    n_blk = n_tok // PEER_BLOCK
    hf = h.reshape(n_blk, PEER_BLOCK, d)
    idxf = idx.reshape(n_blk, PEER_BLOCK, PEER_HEADS * PEER_TOPK)
    gf = gate.reshape(n_blk, PEER_BLOCK, PEER_HEADS * PEER_TOPK)

    def block(args):
        hb, ib, gb = args
        ub = jnp.take(u_tab, ib, axis=0)
        vb = jnp.take(v_tab, ib, axis=0)
        act = jax.nn.gelu(jnp.einsum('tkd,td->tk', ub, hb).astype(jnp.float32))
        coef = (act * gb).astype(hb.dtype)
        return jnp.einsum('tk,tkd->td', coef, vb)

    out = lax.map(block, (hf, idxf, gf))
    return out.reshape(bsz, seq, d)


def setup_inputs(seed: int = 0) -> dict:
    key = jax.random.key(seed)
    ks = jax.random.split(key, 24)
    f32 = jnp.float32
    L, D, G, P, Hc = DEPTH, D_MODEL, SSM_GROUPS, SSM_STATE, SSM_GROUP_CH
    nrm = lambda k, shape, s: jax.random.normal(k, shape, f32) * s
    x = jax.random.normal(ks[0], (BATCH, SEQ, D), f32)
    norm1_g = 1.0 + nrm(ks[1], (L, D), 0.01)
    w_in = nrm(ks[2], (L, D, IN_WIDTH), D ** -0.5)
    n_idx = jnp.arange(P, dtype=f32)
    ssm_lambda_re = -0.5 + nrm(ks[3], (L, G, P), 0.01)
    ssm_lambda_im = math.pi * n_idx + nrm(ks[4], (L, G, P), 0.01)
    ssm_log_dt = jax.random.uniform(ks[5], (L, G), f32, math.log(DT_MIN), math.log(DT_MAX))
    b_scale = (2.0 * Hc) ** -0.5
    ssm_b_re = nrm(ks[6], (L, G, P, Hc), b_scale)
    ssm_b_im = nrm(ks[7], (L, G, P, Hc), b_scale)
    c_scale = (2.0 * P) ** -0.5
    ssm_c_re = nrm(ks[8], (L, G, Hc, P), c_scale)
    ssm_c_im = nrm(ks[9], (L, G, Hc, P), c_scale)
    ssm_d = nrm(ks[10], (L, G, Hc), 1.0)
    ssm_w_glu = nrm(ks[11], (L, SSM_WIDTH, SSM_WIDTH), SSM_WIDTH ** -0.5)
    ssm_b_glu = nrm(ks[12], (L, SSM_WIDTH), 0.01)
    fox_b_f = jnp.linspace(1.0, 5.0, N_HEADS, dtype=f32)[None, :] + nrm(ks[13], (L, N_HEADS), 0.1)
    g_ssm_out = 1.0 + nrm(ks[14], (L, SSM_WIDTH), 0.01)
    g_attn_out = 1.0 + nrm(ks[15], (L, ATTN_WIDTH), 0.01)
    w_o = nrm(ks[16], (L, MIX_WIDTH, D), MIX_WIDTH ** -0.5)
    norm2_g = 1.0 + nrm(ks[17], (L, D), 0.01)
    peer_w_q = nrm(ks[18], (L, D, PEER_HEADS * PEER_QUERY_DIM), D ** -0.5)
    peer_keys = nrm(ks[19], (L, PEER_HEADS, 2, PEER_N_KEYS, PEER_HALF), PEER_HALF ** -0.5)
    peer_u = nrm(ks[20], (L, PEER_EXPERTS, D), D ** -0.5)
    peer_v = nrm(ks[21], (L, PEER_EXPERTS, D), 0.25)
    norm_f = 1.0 + nrm(ks[22], (D,), 0.01)
    return {"x": x, "norm1_g": norm1_g, "w_in": w_in,
            "ssm_lambda_re": ssm_lambda_re, "ssm_lambda_im": ssm_lambda_im, "ssm_log_dt": ssm_log_dt,
            "ssm_b_re": ssm_b_re, "ssm_b_im": ssm_b_im, "ssm_c_re": ssm_c_re, "ssm_c_im": ssm_c_im,
            "ssm_d": ssm_d, "ssm_w_glu": ssm_w_glu, "ssm_b_glu": ssm_b_glu,
            "fox_b_f": fox_b_f, "g_ssm_out": g_ssm_out, "g_attn_out": g_attn_out, "w_o": w_o,
            "norm2_g": norm2_g, "peer_w_q": peer_w_q, "peer_keys": peer_keys,
            "peer_u": peer_u, "peer_v": peer_v, "norm_f": norm_f}


def reference(x, norm1_g, w_in, ssm_lambda_re, ssm_lambda_im, ssm_log_dt, ssm_b_re, ssm_b_im,
              ssm_c_re, ssm_c_im, ssm_d, ssm_w_glu, ssm_b_glu, fox_b_f, g_ssm_out, g_attn_out, w_o,
              norm2_g, peer_w_q, peer_keys, peer_u, peer_v, norm_f):
    h = x
    o_q = SSM_WIDTH
    o_k = o_q + ATTN_WIDTH
    o_v = o_k + ATTN_WIDTH
    o_f = o_v + ATTN_WIDTH
    for l in range(DEPTH):
        xn = rms_norm(h, norm1_g[l])
        proj = xn @ w_in[l]
        u_ssm = proj[..., :o_q]
        q = proj[..., o_q:o_k]
        k = proj[..., o_k:o_v]
        v = proj[..., o_v:o_f]
        f_logit = proj[..., o_f:] + fox_b_f[l]
        y_ssm = s5_mixer(u_ssm, ssm_lambda_re[l], ssm_lambda_im[l], ssm_log_dt[l], ssm_b_re[l], ssm_b_im[l],
                         ssm_c_re[l], ssm_c_im[l], ssm_d[l], ssm_w_glu[l], ssm_b_glu[l])
        y_att = fox_attention(q, k, v, f_logit)
        mixed = jnp.concatenate([rms_norm(y_ssm, g_ssm_out[l]), rms_norm(y_att, g_attn_out[l])], axis=-1)
        h = h + mixed @ w_o[l]
        h = h + peer_ffn(rms_norm(h, norm2_g[l]), peer_w_q[l], peer_keys[l], peer_u[l], peer_v[l])
    return rms_norm(h, norm_f)
```

```cpp
#include <hip/hip_runtime.h>
#include <cstdint>
#include <cstdio>

namespace nv {
constexpr int D = 1024, BATCH = 8, SEQ = 4096, DEPTH = 4, T = BATCH * SEQ;
constexpr int SSMW = 512, G = 32, HC = 16, P = 64, ATTW = 512, HD = 64, NH = 8, INW = 2056;
constexpr int PH = 8, NK = 128, TOPK = 16, QD = 128, HALF = 64, NEXP = 16384;
constexpr float EPS = 1e-6f;

typedef short bf16x8 __attribute__((ext_vector_type(8)));
typedef float f32x16 __attribute__((ext_vector_type(16)));

__device__ __forceinline__ unsigned short f2bf(float f) { unsigned u = __float_as_uint(f); return (unsigned short)((u + 0x7fffu + ((u >> 16) & 1u)) >> 16); }
__device__ __forceinline__ float gelu_tanh(float x) { const float u = 0.7978845608028654f * (x + 0.044715f * x * x * x); return 0.5f * x * (1.f + tanhf(u)); }
__device__ __forceinline__ float wave_sum(float v) {
#pragma unroll
    for (int o = 1; o < 64; o <<= 1) v += __shfl_xor(v, o);
    return v;
}

__global__ void __launch_bounds__(256) k_rmsnorm(const float* __restrict__ in, int ldi, const float* __restrict__ g, float* __restrict__ out, int ldo, int n, int rows) {
    const int w = (blockIdx.x * blockDim.x + threadIdx.x) >> 6, lane = threadIdx.x & 63;
    if (w >= rows) return;
    const float* r = in + (size_t)w * ldi; float* o = out + (size_t)w * ldo;
    float s = 0.f;
    for (int c = lane; c < n; c += 64) { const float v = r[c]; s += v * v; }
    s = wave_sum(s);
    const float rs = rsqrtf(s / (float)n + EPS);
    for (int c = lane; c < n; c += 64) o[c] = r[c] * rs * g[c];
}

template <class Epi>
__global__ void __launch_bounds__(256) k_gemm(const float* __restrict__ A, int lda, const float* __restrict__ B, int ldb, int M, int N, int K, Epi epi) {
    __shared__ __attribute__((aligned(16))) unsigned short As[128][40];
    __shared__ __attribute__((aligned(16))) unsigned short Bs[128][40];
    const int tid = threadIdx.x, wave = tid >> 6, lane = tid & 63;
    const int m0 = blockIdx.y * 128, n0 = blockIdx.x * 128;
    const int wm = (wave >> 1) * 64, wn = (wave & 1) * 64;
    f32x16 acc[2][2];
#pragma unroll
    for (int i = 0; i < 2; ++i)
#pragma unroll
        for (int j = 0; j < 2; ++j)
#pragma unroll
            for (int r = 0; r < 16; ++r) acc[i][j][r] = 0.f;
    for (int k0 = 0; k0 < K; k0 += 32) {
#pragma unroll
        for (int i = 0; i < 4; ++i) {
            const int idx = tid + i * 256, r = idx >> 3, c = (idx & 7) * 4;
            const float4 v = *(const float4*)(A + (size_t)(m0 + r) * lda + k0 + c);
            As[r][c] = f2bf(v.x); As[r][c + 1] = f2bf(v.y); As[r][c + 2] = f2bf(v.z); As[r][c + 3] = f2bf(v.w);
        }
#pragma unroll
        for (int i = 0; i < 4; ++i) {
            const int idx = tid + i * 256, k = idx >> 5, c = (idx & 31) * 4, n = n0 + c;
            float4 v = make_float4(0.f, 0.f, 0.f, 0.f);
            if (n + 3 < N) v = *(const float4*)(B + (size_t)(k0 + k) * ldb + n);
            Bs[c][k] = f2bf(v.x); Bs[c + 1][k] = f2bf(v.y); Bs[c + 2][k] = f2bf(v.z); Bs[c + 3][k] = f2bf(v.w);
        }
        __syncthreads();
#pragma unroll
        for (int ks = 0; ks < 2; ++ks) {
            bf16x8 a[2], b[2];
#pragma unroll
            for (int i = 0; i < 2; ++i) a[i] = *(const bf16x8*)&As[wm + i * 32 + (lane & 31)][ks * 16 + (lane >> 5) * 8];
#pragma unroll
            for (int j = 0; j < 2; ++j) b[j] = *(const bf16x8*)&Bs[wn + j * 32 + (lane & 31)][ks * 16 + (lane >> 5) * 8];
#pragma unroll
            for (int i = 0; i < 2; ++i)
#pragma unroll
                for (int j = 0; j < 2; ++j) acc[i][j] = __builtin_amdgcn_mfma_f32_32x32x16_bf16(a[i], b[j], acc[i][j], 0, 0, 0);
        }
        __syncthreads();
    }
#pragma unroll
    for (int i = 0; i < 2; ++i)
#pragma unroll
        for (int j = 0; j < 2; ++j)
#pragma unroll
            for (int r = 0; r < 16; ++r) {
                const int row = m0 + wm + i * 32 + (r & 3) + 8 * (r >> 2) + 4 * (lane >> 5), col = n0 + wn + j * 32 + (lane & 31);
                if (col < N) epi(row, col, acc[i][j][r]);
            }
}
struct EpiStore { float* C; int ldc; int pad; __device__ void operator()(int r, int c, float v) const { C[(size_t)r * ldc + c] = v; } };
struct EpiAdd { float* C; int ldc; int pad; __device__ void operator()(int r, int c, float v) const { C[(size_t)r * ldc + c] += v; } };
struct EpiGlu { const float* gel; const float* bias; float* out; __device__ void operator()(int r, int c, float v) const {
    const float gg = gel[(size_t)r * SSMW + c]; out[(size_t)r * SSMW + c] = gg / (1.f + expf(-(v + bias[c]))); } };

__global__ void __launch_bounds__(64) k_ssm(const float* __restrict__ proj, const float* __restrict__ lam_re, const float* __restrict__ lam_im, const float* __restrict__ log_dt,
                                            const float* __restrict__ b_re, const float* __restrict__ b_im, const float* __restrict__ c_re, const float* __restrict__ c_im,
                                            const float* __restrict__ dsk, float* __restrict__ gel) {
    const int b = blockIdx.x / G, g = blockIdx.x % G, p = threadIdx.x;
    const float dt = expf(log_dt[g]);
    const float lr = lam_re[g * P + p], li = lam_im[g * P + p];
    const float mag = expf(lr * dt), are = mag * cosf(li * dt), aim = mag * sinf(li * dt);
    const float den = lr * lr + li * li, nr = are - 1.f;
    const float zre = (nr * lr + aim * li) / den, zim = (aim * lr - nr * li) / den;
    float bbr[HC], bbi[HC], cr[HC], ci[HC];
#pragma unroll
    for (int h = 0; h < HC; ++h) {
        const float br = b_re[(g * P + p) * HC + h], bi = b_im[(g * P + p) * HC + h];
        bbr[h] = zre * br - zim * bi; bbi[h] = zre * bi + zim * br;
        cr[h] = c_re[(g * HC + h) * P + p]; ci[h] = c_im[(g * HC + h) * P + p];
    }
    const float dmine = dsk[g * HC + (p & 15)];
    float sre = 0.f, sim = 0.f;
    for (int t = 0; t < SEQ; ++t) {
        const float* u = proj + (size_t)(b * SEQ + t) * INW + g * HC;
        float xr = 0.f, xi = 0.f, um = 0.f;
#pragma unroll
        for (int h = 0; h < HC; ++h) { const float uv = u[h]; xr += bbr[h] * uv; xi += bbi[h] * uv; if ((p & 15) == h) um = uv; }
        const float nre = are * sre - aim * sim + xr, nim = are * sim + aim * sre + xi;
        sre = nre; sim = nim;
        float ymine = 0.f;
#pragma unroll
        for (int h = 0; h < HC; ++h) { const float v = wave_sum(cr[h] * sre - ci[h] * sim); if ((p & 15) == h) ymine = v; }
        if (p < HC) gel[(size_t)(b * SEQ + t) * SSMW + g * HC + p] = gelu_tanh(ymine + dmine * um);
    }
}

__global__ void k_cum(const float* __restrict__ proj, const float* __restrict__ bf, float* __restrict__ cum) {
    const int i = blockIdx.x * blockDim.x + threadIdx.x; if (i >= BATCH * NH) return;
    const int b = i / NH, h = i % NH; float c = 0.f;
    for (int t = 0; t < SEQ; ++t) {
        const float x = proj[(size_t)(b * SEQ + t) * INW + 2048 + h] + bf[h];
        const float ls = fminf(x, 0.f) - log1pf(expf(-fabsf(x)));
        c += ls; cum[(size_t)i * SEQ + t] = c;
    }
}

__global__ void __launch_bounds__(64) k_attn(const float* __restrict__ proj, const float* __restrict__ cum, float* __restrict__ yatt) {
    const int tb = blockIdx.x % (SEQ / 64), bh = blockIdx.x / (SEQ / 64), b = bh / NH, h = bh % NH;
    const int t = tb * 64 + threadIdx.x;
    const float* base = proj + (size_t)b * SEQ * INW;
    float q[HD], o[HD];
#pragma unroll
    for (int d = 0; d < HD; ++d) { q[d] = base[(size_t)t * INW + 512 + h * HD + d] * 0.125f; o[d] = 0.f; }
    const float* cm = cum + (size_t)bh * SEQ; const float ct = cm[t];
    float m = -INFINITY, l = 0.f;
    const int smax = tb * 64 + 63;
    for (int s = 0; s <= smax; ++s) {
        const float* kr = base + (size_t)s * INW + 1024 + h * HD; const float* vr = base + (size_t)s * INW + 1536 + h * HD;
        float lg = ct - cm[s];
#pragma unroll
        for (int d = 0; d < HD; ++d) lg += q[d] * kr[d];
        if (s <= t) {
            const float mn = fmaxf(m, lg), sc = expf(m - mn), pp = expf(lg - mn);
            l = l * sc + pp; m = mn;
#pragma unroll
            for (int d = 0; d < HD; ++d) o[d] = o[d] * sc + pp * vr[d];
        }
    }
    const float il = 1.f / l;
#pragma unroll
    for (int d = 0; d < HD; ++d) yatt[(size_t)(b * SEQ + t) * ATTW + h * HD + d] = o[d] * il;
}

__global__ void __launch_bounds__(256) k_peer_select(const float* __restrict__ qp, const float* __restrict__ keys, int* __restrict__ idx, float* __restrict__ gate) {
    __shared__ float sc[256]; __shared__ float tv[32]; __shared__ int ti[32]; __shared__ float cand[256];
    const int tok = blockIdx.x / PH, hd = blockIdx.x % PH, tid = threadIdx.x, lane = tid & 63, wave = tid >> 6;
    {
        const int half = tid >> 7, n = tid & 127;
        const float* q = qp + (size_t)tok * D + hd * QD + half * HALF; const float* kk = keys + ((size_t)(hd * 2 + half) * NK + n) * HALF;
        float s = 0.f;
        for (int d = 0; d < HALF; ++d) s += q[d] * kk[d];
        sc[tid] = s;
    }
    __syncthreads();
    if (wave == 0 || wave == 2) {
        const int half = wave >> 1;
        float v0 = sc[half * 128 + lane], v1 = sc[half * 128 + lane + 64];
        for (int k = 0; k < TOPK; ++k) {
            float bv; int bi;
            if (v0 >= v1) { bv = v0; bi = lane; } else { bv = v1; bi = lane + 64; }
#pragma unroll
            for (int o = 1; o < 64; o <<= 1) { const float ov = __shfl_xor(bv, o); const int oi = __shfl_xor(bi, o); if (ov > bv || (ov == bv && oi < bi)) { bv = ov; bi = oi; } }
            if (lane == 0) { tv[half * 16 + k] = bv; ti[half * 16 + k] = bi; }
            if (bi == lane) v0 = -INFINITY; if (bi == lane + 64) v1 = -INFINITY;
        }
    }
    __syncthreads();
    cand[tid] = tv[tid >> 4] + tv[16 + (tid & 15)];
    __syncthreads();
    if (wave == 0) {
        float v[4];
#pragma unroll
        for (int j = 0; j < 4; ++j) v[j] = cand[lane + 64 * j];
        float best = 0.f; int bidx = 0; float mx = 0.f, se = 0.f;
        for (int k = 0; k < TOPK; ++k) {
            float bv = v[0]; int bi = lane;
#pragma unroll
            for (int j = 1; j < 4; ++j) if (v[j] > bv) { bv = v[j]; bi = lane + 64 * j; }
#pragma unroll
            for (int o = 1; o < 64; o <<= 1) { const float ov = __shfl_xor(bv, o); const int oi = __shfl_xor(bi, o); if (ov > bv || (ov == bv && oi < bi)) { bv = ov; bi = oi; } }
            if (k == 0) mx = bv;
            const float e = expf(bv - mx); se += e;
            if (lane == k) { best = e; bidx = ti[bi >> 4] * NK + ti[16 + (bi & 15)]; }
#pragma unroll
            for (int j = 0; j < 4; ++j) if (bi == lane + 64 * j) v[j] = -INFINITY;
        }
        if (lane < TOPK) { idx[(size_t)tok * 128 + hd * TOPK + lane] = bidx; gate[(size_t)tok * 128 + hd * TOPK + lane] = best / se; }
    }
}

__global__ void __launch_bounds__(256) k_peer_eval(const float* __restrict__ hn, const int* __restrict__ idx, const float* __restrict__ gate,
                                                   const float* __restrict__ ut, const float* __restrict__ vt, float* __restrict__ h) {
    __shared__ float red[4][D];
    const int tok = blockIdx.x, tid = threadIdx.x, lane = tid & 63, wave = tid >> 6;
    float4 x[4], acc[4];
#pragma unroll
    for (int j = 0; j < 4; ++j) { x[j] = *(const float4*)(hn + (size_t)tok * D + j * 256 + lane * 4); acc[j] = make_float4(0.f, 0.f, 0.f, 0.f); }
    for (int k = 0; k < 32; ++k) {
        const int pr = wave * 32 + k; const int e = idx[(size_t)tok * 128 + pr]; const float gt = gate[(size_t)tok * 128 + pr];
        const float* ur = ut + (size_t)e * D; const float* vr = vt + (size_t)e * D;
        float s = 0.f;
#pragma unroll
        for (int j = 0; j < 4; ++j) { const float4 uv = *(const float4*)(ur + j * 256 + lane * 4); s += uv.x * x[j].x + uv.y * x[j].y + uv.z * x[j].z + uv.w * x[j].w; }
        s = wave_sum(s);
        const float cf = gelu_tanh(s) * gt;
#pragma unroll
        for (int j = 0; j < 4; ++j) { const float4 vv = *(const float4*)(vr + j * 256 + lane * 4); acc[j].x += cf * vv.x; acc[j].y += cf * vv.y; acc[j].z += cf * vv.z; acc[j].w += cf * vv.w; }
    }
#pragma unroll
    for (int j = 0; j < 4; ++j) *(float4*)&red[wave][j * 256 + lane * 4] = acc[j];
    __syncthreads();
    for (int c = tid; c < D; c += 256) h[(size_t)tok * D + c] += red[0][c] + red[1][c] + red[2][c] + red[3][c];
}
}

extern "C" void kernel_launch(void* const* d_in, const int* in_sizes, int n_in, void* d_out, int out_size, void* d_ws, size_t ws_size, hipStream_t stream) {
    using namespace nv;
    const float* x = (const float*)d_in[0]; const float* norm1_g = (const float*)d_in[1]; const float* w_in = (const float*)d_in[2];
    const float* lam_re = (const float*)d_in[3]; const float* lam_im = (const float*)d_in[4]; const float* log_dt = (const float*)d_in[5];
    const float* b_re = (const float*)d_in[6]; const float* b_im = (const float*)d_in[7]; const float* c_re = (const float*)d_in[8]; const float* c_im = (const float*)d_in[9];
    const float* ssm_d = (const float*)d_in[10]; const float* w_glu = (const float*)d_in[11]; const float* b_glu = (const float*)d_in[12];
    const float* fox_b = (const float*)d_in[13]; const float* g_ssm = (const float*)d_in[14]; const float* g_att = (const float*)d_in[15];
    const float* w_o = (const float*)d_in[16]; const float* norm2_g = (const float*)d_in[17]; const float* w_q = (const float*)d_in[18];
    const float* pkeys = (const float*)d_in[19]; const float* pu = (const float*)d_in[20]; const float* pv = (const float*)d_in[21]; const float* norm_f = (const float*)d_in[22];
    unsigned char* ws = (unsigned char*)d_ws; const size_t MB = 1u << 20;
    float* h = (float*)(ws + 0 * MB); float* xn = (float*)(ws + 128 * MB); float* proj = (float*)(ws + 256 * MB);
    float* mixed = (float*)(ws + 256 * MB); float* qp = (float*)(ws + 384 * MB);
    float* gel = (float*)(ws + 528 * MB); float* yssm = (float*)(ws + 592 * MB); float* yatt = (float*)(ws + 656 * MB);
    int* idx = (int*)(ws + 720 * MB); float* gate = (float*)(ws + 736 * MB); float* cum = (float*)(ws + 752 * MB);
    if (ws_size < 760 * MB) { fprintf(stderr, "workspace too small\n"); return; }
    (void)hipMemcpyAsync(h, x, (size_t)T * D * 4, hipMemcpyDeviceToDevice, stream);
    for (int l = 0; l < DEPTH; ++l) {
        k_rmsnorm<<<T / 4, 256, 0, stream>>>(h, D, norm1_g + l * D, xn, D, D, T);
        k_gemm<EpiStore><<<dim3((INW + 127) / 128, T / 128), 256, 0, stream>>>(xn, D, w_in + (size_t)l * D * INW, INW, T, INW, D, EpiStore{proj, INW, 0});
        k_ssm<<<BATCH * G, 64, 0, stream>>>(proj, lam_re + l * G * P, lam_im + l * G * P, log_dt + l * G, b_re + (size_t)l * G * P * HC, b_im + (size_t)l * G * P * HC,
                                            c_re + (size_t)l * G * HC * P, c_im + (size_t)l * G * HC * P, ssm_d + l * G * HC, gel);
        k_gemm<EpiGlu><<<dim3(SSMW / 128, T / 128), 256, 0, stream>>>(gel, SSMW, w_glu + (size_t)l * SSMW * SSMW, SSMW, T, SSMW, SSMW, EpiGlu{gel, b_glu + l * SSMW, yssm});
        k_cum<<<1, 64, 0, stream>>>(proj, fox_b + l * NH, cum);
        k_attn<<<BATCH * NH * (SEQ / 64), 64, 0, stream>>>(proj, cum, yatt);
        k_rmsnorm<<<T / 4, 256, 0, stream>>>(yssm, SSMW, g_ssm + l * SSMW, mixed, D, SSMW, T);
        k_rmsnorm<<<T / 4, 256, 0, stream>>>(yatt, ATTW, g_att + l * ATTW, mixed + SSMW, D, ATTW, T);
        k_gemm<EpiAdd><<<dim3(D / 128, T / 128), 256, 0, stream>>>(mixed, D, w_o + (size_t)l * D * D, D, T, D, D, EpiAdd{h, D, 0});
        k_rmsnorm<<<T / 4, 256, 0, stream>>>(h, D, norm2_g + l * D, xn, D, D, T);
        k_gemm<EpiStore><<<dim3(D / 128, T / 128), 256, 0, stream>>>(xn, D, w_q + (size_t)l * D * D, D, T, D, D, EpiStore{qp, D, 0});
        k_peer_select<<<T * PH, 256, 0, stream>>>(qp, pkeys + (size_t)l * PH * 2 * NK * HALF, idx, gate);
        k_peer_eval<<<T, 256, 0, stream>>>(xn, idx, gate, pu + (size_t)l * NEXP * D, pv + (size_t)l * NEXP * D, h);
    }
    k_rmsnorm<<<T / 4, 256, 0, stream>>>(h, D, norm_f, (float*)d_out, D, D, T);
}
```

```cpp
#include <hip/hip_runtime.h>
#include <hip/hip_cooperative_groups.h>
#include <cstdint>
#include <cstdio>

namespace nv {
constexpr int D = 1024, BATCH = 8, SEQ = 4096, DEPTH = 4, T = BATCH * SEQ;
constexpr int SSMW = 512, G = 32, HC = 16, P = 64, ATTW = 512, HD = 64, NH = 8, INW = 2056;
constexpr int PH = 8, NK = 128, TOPK = 16, QD = 128, HALF = 64, NEXP = 16384;
constexpr float EPS = 1e-6f;

typedef short bf16x8 __attribute__((ext_vector_type(8)));
typedef float f32x16 __attribute__((ext_vector_type(16)));

__device__ __forceinline__ unsigned short f2bf(float f) { unsigned u = __float_as_uint(f); return (unsigned short)((u + 0x7fffu + ((u >> 16) & 1u)) >> 16); }
__device__ __forceinline__ float gelu_tanh(float x) { const float u = 0.7978845608028654f * (x + 0.044715f * x * x * x); return 0.5f * x * (1.f + tanhf(u)); }
__device__ __forceinline__ float wave_sum(float v) {
#pragma unroll
    for (int o = 1; o < 64; o <<= 1) v += __shfl_xor(v, o);
    return v;
}


__device__ __forceinline__ int otid() { int t = threadIdx.x; asm volatile("" : "+v"(t)); return t; }
__device__ __forceinline__ int obid() { int t = blockIdx.x; asm volatile("" : "+s"(t)); return t; }
__device__ __forceinline__ int ogrid() { int t = gridDim.x; asm volatile("" : "+s"(t)); return t; }
__device__ __forceinline__ void ph_rmsnorm(const float* __restrict__ in, int ldi, const float* __restrict__ g, float* __restrict__ out, int ldo, int n, int rows) {
    const int TIDX = otid(), BIDX = obid(), GDIM = ogrid(); (void)TIDX; (void)BIDX; (void)GDIM;
    const int lane = TIDX & 63, gw = BIDX * 8 + (TIDX >> 6), ngw = GDIM * 8;
    for (int w = gw; w < rows; w += ngw) {
        const float* r = in + (size_t)w * ldi; float* o = out + (size_t)w * ldo;
        float s = 0.f;
        for (int c = lane; c < n; c += 64) { const float v = r[c]; s += v * v; }
        s = wave_sum(s);
        const float rs = rsqrtf(s / (float)n + EPS);
        for (int c = lane; c < n; c += 64) o[c] = r[c] * rs * g[c];
    }
}

template <class Epi>
__device__ __forceinline__ void ph_gemm(unsigned char* sm, const float* __restrict__ A, int lda, const float* __restrict__ B, int ldb, int M, int N, int K, Epi epi) {
    const int TIDX = otid(), BIDX = obid(), GDIM = ogrid(); (void)TIDX; (void)BIDX; (void)GDIM;
    const int team = TIDX >> 8, tid = TIDX & 255, wave = tid >> 6, lane = tid & 63;
    unsigned short (*As)[40] = (unsigned short (*)[40])(sm + team * 20480); unsigned short (*Bs)[40] = (unsigned short (*)[40])(sm + team * 20480 + 10240);
    const int ntn = (N + 127) / 128, ntiles = ntn * (M / 128);
    const int wm = (wave >> 1) * 64, wn = (wave & 1) * 64;
    for (int it = BIDX; it < ntiles / 2; it += GDIM) {
        const int tile = it * 2 + team, m0 = (tile / ntn) * 128, n0 = (tile % ntn) * 128;
        f32x16 acc[2][2];
#pragma unroll
        for (int i = 0; i < 2; ++i)
#pragma unroll
            for (int j = 0; j < 2; ++j)
#pragma unroll
                for (int r = 0; r < 16; ++r) acc[i][j][r] = 0.f;
        for (int k0 = 0; k0 < K; k0 += 32) {
#pragma unroll
            for (int i = 0; i < 4; ++i) {
                const int idx = tid + i * 256, r = idx >> 3, c = (idx & 7) * 4;
                const float4 v = *(const float4*)(A + (size_t)(m0 + r) * lda + k0 + c);
                As[r][c] = f2bf(v.x); As[r][c + 1] = f2bf(v.y); As[r][c + 2] = f2bf(v.z); As[r][c + 3] = f2bf(v.w);
            }
#pragma unroll
            for (int i = 0; i < 4; ++i) {
                const int idx = tid + i * 256, k = idx >> 5, c = (idx & 31) * 4, n = n0 + c;
                float4 v = make_float4(0.f, 0.f, 0.f, 0.f);
                if (n + 3 < N) v = *(const float4*)(B + (size_t)(k0 + k) * ldb + n);
                Bs[c][k] = f2bf(v.x); Bs[c + 1][k] = f2bf(v.y); Bs[c + 2][k] = f2bf(v.z); Bs[c + 3][k] = f2bf(v.w);
            }
            __syncthreads();
#pragma unroll
            for (int ks = 0; ks < 2; ++ks) {
                bf16x8 a[2], b[2];
#pragma unroll
                for (int i = 0; i < 2; ++i) a[i] = *(const bf16x8*)&As[wm + i * 32 + (lane & 31)][ks * 16 + (lane >> 5) * 8];
#pragma unroll
                for (int j = 0; j < 2; ++j) b[j] = *(const bf16x8*)&Bs[wn + j * 32 + (lane & 31)][ks * 16 + (lane >> 5) * 8];
#pragma unroll
                for (int i = 0; i < 2; ++i)
#pragma unroll
                    for (int j = 0; j < 2; ++j) acc[i][j] = __builtin_amdgcn_mfma_f32_32x32x16_bf16(a[i], b[j], acc[i][j], 0, 0, 0);
            }
            __syncthreads();
        }
#pragma unroll
        for (int i = 0; i < 2; ++i)
#pragma unroll
            for (int j = 0; j < 2; ++j)
#pragma unroll
                for (int r = 0; r < 16; ++r) {
                    const int row = m0 + wm + i * 32 + (r & 3) + 8 * (r >> 2) + 4 * (lane >> 5), col = n0 + wn + j * 32 + (lane & 31);
                    if (col < N) epi(row, col, acc[i][j][r]);
                }
    }
}
struct EpiStore { float* C; int ldc; int pad; __device__ void operator()(int r, int c, float v) const { C[(size_t)r * ldc + c] = v; } };
struct EpiAdd { float* C; int ldc; int pad; __device__ void operator()(int r, int c, float v) const { C[(size_t)r * ldc + c] += v; } };
struct EpiGlu { const float* gel; const float* bias; float* out; __device__ void operator()(int r, int c, float v) const {
    const float gg = gel[(size_t)r * SSMW + c]; out[(size_t)r * SSMW + c] = gg / (1.f + expf(-(v + bias[c]))); } };

__device__ __forceinline__ void ph_ssm(const float* __restrict__ proj, const float* __restrict__ lam_re, const float* __restrict__ lam_im, const float* __restrict__ log_dt,
                                       const float* __restrict__ b_re, const float* __restrict__ b_im, const float* __restrict__ c_re, const float* __restrict__ c_im,
                                       const float* __restrict__ dsk, float* __restrict__ gel) {
    const int TIDX = otid(), BIDX = obid(), GDIM = ogrid(); (void)TIDX; (void)BIDX; (void)GDIM;
    const int p = TIDX & 63, wv = TIDX >> 6;
    for (int item = BIDX + GDIM * wv; item < BATCH * G; item += GDIM * 8) {
        const int b = item / G, g = item % G;
        const float dt = expf(log_dt[g]);
        const float lr = lam_re[g * P + p], li = lam_im[g * P + p];
        const float mag = expf(lr * dt), are = mag * cosf(li * dt), aim = mag * sinf(li * dt);
        const float den = lr * lr + li * li, nr = are - 1.f;
        const float zre = (nr * lr + aim * li) / den, zim = (aim * lr - nr * li) / den;
        float bbr[HC], bbi[HC], cr[HC], ci[HC];
#pragma unroll
        for (int h = 0; h < HC; ++h) {
            const float br = b_re[(g * P + p) * HC + h], bi = b_im[(g * P + p) * HC + h];
            bbr[h] = zre * br - zim * bi; bbi[h] = zre * bi + zim * br;
            cr[h] = c_re[(g * HC + h) * P + p]; ci[h] = c_im[(g * HC + h) * P + p];
        }
        const float dmine = dsk[g * HC + (p & 15)];
        float sre = 0.f, sim = 0.f;
        for (int t = 0; t < SEQ; ++t) {
            const float* u = proj + (size_t)(b * SEQ + t) * INW + g * HC;
            float xr = 0.f, xi = 0.f, um = 0.f;
#pragma unroll
            for (int h = 0; h < HC; ++h) { const float uv = u[h]; xr += bbr[h] * uv; xi += bbi[h] * uv; if ((p & 15) == h) um = uv; }
            const float nre = are * sre - aim * sim + xr, nim = are * sim + aim * sre + xi;
            sre = nre; sim = nim;
            float ymine = 0.f;
#pragma unroll
            for (int h = 0; h < HC; ++h) { const float v = wave_sum(cr[h] * sre - ci[h] * sim); if ((p & 15) == h) ymine = v; }
            if (p < HC) gel[(size_t)(b * SEQ + t) * SSMW + g * HC + p] = gelu_tanh(ymine + dmine * um);
        }
    }
}

__device__ __forceinline__ void ph_cum(const float* __restrict__ proj, const float* __restrict__ bf, float* __restrict__ cum) {
    const int TIDX = otid(), BIDX = obid(), GDIM = ogrid(); (void)TIDX; (void)BIDX; (void)GDIM;
    if (BIDX != GDIM - 1 || (TIDX >> 6) != 7) return;
    const int i = TIDX & 63;
    const int b = i / NH, h = i % NH; float c = 0.f;
    for (int t = 0; t < SEQ; ++t) {
        const float x = proj[(size_t)(b * SEQ + t) * INW + 2048 + h] + bf[h];
        const float ls = fminf(x, 0.f) - log1pf(expf(-fabsf(x)));
        c += ls; cum[(size_t)i * SEQ + t] = c;
    }
}

__device__ __forceinline__ void ph_attn(const float* __restrict__ proj, const float* __restrict__ cum, float* __restrict__ yatt) {
    const int TIDX = otid(), BIDX = obid(), GDIM = ogrid(); (void)TIDX; (void)BIDX; (void)GDIM;
    const int gw = BIDX * 8 + (TIDX >> 6), ngw = GDIM * 8, lane = TIDX & 63;
    constexpr int NIT = BATCH * NH * (SEQ / 64);
    for (int it0 = gw; it0 < NIT; it0 += ngw) {
        const int it = NIT - 1 - it0;
        const int tb = it / (BATCH * NH), bh = it % (BATCH * NH), b = bh / NH, h = bh % NH;
        const int t = tb * 64 + lane;
        const float* base = proj + (size_t)b * SEQ * INW;
        float q[HD], o[HD];
#pragma unroll
        for (int d = 0; d < HD; ++d) { q[d] = base[(size_t)t * INW + 512 + h * HD + d] * 0.125f; o[d] = 0.f; }
        const float* cm = cum + (size_t)bh * SEQ; const float ct = cm[t];
        float m = -INFINITY, l = 0.f;
        const int smax = tb * 64 + 63;
        for (int s = 0; s <= smax; ++s) {
            const float* kr = base + (size_t)s * INW + 1024 + h * HD; const float* vr = base + (size_t)s * INW + 1536 + h * HD;
            float lg = ct - cm[s];
#pragma unroll
            for (int d = 0; d < HD; ++d) lg += q[d] * kr[d];
            if (s <= t) {
                const float mn = fmaxf(m, lg), sc = expf(m - mn), pp = expf(lg - mn);
                l = l * sc + pp; m = mn;
#pragma unroll
                for (int d = 0; d < HD; ++d) o[d] = o[d] * sc + pp * vr[d];
            }
        }
        const float il = 1.f / l;
#pragma unroll
        for (int d = 0; d < HD; ++d) yatt[(size_t)(b * SEQ + t) * ATTW + h * HD + d] = o[d] * il;
    }
}

__device__ __forceinline__ void ph_peer_select(unsigned char* sm, const float* __restrict__ qp, const float* __restrict__ keys, int* __restrict__ idx, float* __restrict__ gate) {
    const int TIDX = otid(), BIDX = obid(), GDIM = ogrid(); (void)TIDX; (void)BIDX; (void)GDIM;
    const int team = TIDX >> 8, tid = TIDX & 255, lane = tid & 63, wave = tid >> 6;
    float* sc = (float*)(sm + team * 4096); float* tv = sc + 256; int* ti = (int*)(tv + 32); float* cand = (float*)(ti + 32);
    for (int it = BIDX; it < T * PH / 2; it += GDIM) {
        const int item = it * 2 + team, tok = item / PH, hd = item % PH;
        {
            const int half = tid >> 7, n = tid & 127;
            const float* q = qp + (size_t)tok * D + hd * QD + half * HALF; const float* kk = keys + ((size_t)(hd * 2 + half) * NK + n) * HALF;
            float s = 0.f;
            for (int d = 0; d < HALF; ++d) s += q[d] * kk[d];
            sc[tid] = s;
        }
        __syncthreads();
        if (wave == 0 || wave == 2) {
            const int half = wave >> 1;
            float v0 = sc[half * 128 + lane], v1 = sc[half * 128 + lane + 64];
            for (int k = 0; k < TOPK; ++k) {
                float bv; int bi;
                if (v0 >= v1) { bv = v0; bi = lane; } else { bv = v1; bi = lane + 64; }
#pragma unroll
                for (int o = 1; o < 64; o <<= 1) { const float ov = __shfl_xor(bv, o); const int oi = __shfl_xor(bi, o); if (ov > bv || (ov == bv && oi < bi)) { bv = ov; bi = oi; } }
                if (lane == 0) { tv[half * 16 + k] = bv; ti[half * 16 + k] = bi; }
                if (bi == lane) v0 = -INFINITY; if (bi == lane + 64) v1 = -INFINITY;
            }
        }
        __syncthreads();
        cand[tid] = tv[tid >> 4] + tv[16 + (tid & 15)];
        __syncthreads();
        if (wave == 0) {
            float v[4];
#pragma unroll
            for (int j = 0; j < 4; ++j) v[j] = cand[lane + 64 * j];
            float best = 0.f; int bidx = 0; float mx = 0.f, se = 0.f;
            for (int k = 0; k < TOPK; ++k) {
                float bv = v[0]; int bi = lane;
#pragma unroll
                for (int j = 1; j < 4; ++j) if (v[j] > bv) { bv = v[j]; bi = lane + 64 * j; }
#pragma unroll
                for (int o = 1; o < 64; o <<= 1) { const float ov = __shfl_xor(bv, o); const int oi = __shfl_xor(bi, o); if (ov > bv || (ov == bv && oi < bi)) { bv = ov; bi = oi; } }
                if (k == 0) mx = bv;
                const float e = expf(bv - mx); se += e;
                if (lane == k) { best = e; bidx = ti[bi >> 4] * NK + ti[16 + (bi & 15)]; }
#pragma unroll
                for (int j = 0; j < 4; ++j) if (bi == lane + 64 * j) v[j] = -INFINITY;
            }
            if (lane < TOPK) { idx[(size_t)tok * 128 + hd * TOPK + lane] = bidx; gate[(size_t)tok * 128 + hd * TOPK + lane] = best / se; }
        }
        __syncthreads();
    }
}

__device__ __forceinline__ void ph_peer_eval(unsigned char* sm, const float* __restrict__ hn, const int* __restrict__ idx, const float* __restrict__ gate,
                                             const float* __restrict__ ut, const float* __restrict__ vt, float* __restrict__ h) {
    const int TIDX = otid(), BIDX = obid(), GDIM = ogrid(); (void)TIDX; (void)BIDX; (void)GDIM;
    const int team = TIDX >> 8, tid = TIDX & 255, lane = tid & 63, wave = tid >> 6;
    float (*red)[D] = (float (*)[D])(sm + team * 16384);
    for (int it = BIDX; it < T / 2; it += GDIM) {
        const int tok = it * 2 + team;
        float4 x[4], acc[4];
#pragma unroll
        for (int j = 0; j < 4; ++j) { x[j] = *(const float4*)(hn + (size_t)tok * D + j * 256 + lane * 4); acc[j] = make_float4(0.f, 0.f, 0.f, 0.f); }
        for (int k = 0; k < 32; ++k) {
            const int pr = wave * 32 + k; const int e = idx[(size_t)tok * 128 + pr]; const float gt = gate[(size_t)tok * 128 + pr];
            const float* ur = ut + (size_t)e * D; const float* vr = vt + (size_t)e * D;
            float s = 0.f;
#pragma unroll
            for (int j = 0; j < 4; ++j) { const float4 uv = *(const float4*)(ur + j * 256 + lane * 4); s += uv.x * x[j].x + uv.y * x[j].y + uv.z * x[j].z + uv.w * x[j].w; }
            s = wave_sum(s);
            const float cf = gelu_tanh(s) * gt;
#pragma unroll
            for (int j = 0; j < 4; ++j) { const float4 vv = *(const float4*)(vr + j * 256 + lane * 4); acc[j].x += cf * vv.x; acc[j].y += cf * vv.y; acc[j].z += cf * vv.z; acc[j].w += cf * vv.w; }
        }
#pragma unroll
        for (int j = 0; j < 4; ++j) *(float4*)&red[wave][j * 256 + lane * 4] = acc[j];
        __syncthreads();
        for (int c = tid; c < D; c += 256) h[(size_t)tok * D + c] += red[0][c] + red[1][c] + red[2][c] + red[3][c];
        __syncthreads();
    }
}

struct Params { const float* in[23]; float* out; unsigned char* ws; };

__global__ void __launch_bounds__(512) k_mega(Params p) {
    namespace cg = cooperative_groups;
    cg::grid_group grid = cg::this_grid();
    __shared__ __attribute__((aligned(16))) unsigned char smem[40960];
    const float* x = p.in[0]; const float* norm1_g = p.in[1]; const float* w_in = p.in[2];
    const float* lam_re = p.in[3]; const float* lam_im = p.in[4]; const float* log_dt = p.in[5];
    const float* b_re = p.in[6]; const float* b_im = p.in[7]; const float* c_re = p.in[8]; const float* c_im = p.in[9];
    const float* ssm_d = p.in[10]; const float* w_glu = p.in[11]; const float* b_glu = p.in[12];
    const float* fox_b = p.in[13]; const float* g_ssm = p.in[14]; const float* g_att = p.in[15];
    const float* w_o = p.in[16]; const float* norm2_g = p.in[17]; const float* w_q = p.in[18];
    const float* pkeys = p.in[19]; const float* pu = p.in[20]; const float* pv = p.in[21]; const float* norm_f = p.in[22];
    unsigned char* ws = p.ws; const size_t MB = 1u << 20;
    float* h = (float*)(ws + 0 * MB); float* xn = (float*)(ws + 128 * MB); float* proj = (float*)(ws + 256 * MB);
    float* mixed = (float*)(ws + 256 * MB); float* qp = (float*)(ws + 384 * MB);
    float* gel = (float*)(ws + 528 * MB); float* yssm = (float*)(ws + 592 * MB); float* yatt = (float*)(ws + 656 * MB);
    int* idx = (int*)(ws + 720 * MB); float* gate = (float*)(ws + 736 * MB); float* cum = (float*)(ws + 752 * MB);
    { const float4* s = (const float4*)x; float4* d = (float4*)h; const size_t n = (size_t)T * D / 4;
      for (size_t i = (size_t)blockIdx.x * 512 + threadIdx.x; i < n; i += (size_t)gridDim.x * 512) d[i] = s[i]; }
    grid.sync();
#pragma nounroll
    for (int l_ = 0; l_ < DEPTH; ++l_) {
        int l = l_; asm volatile("" : "+s"(l));
        ph_rmsnorm(h, D, norm1_g + l * D, xn, D, D, T);
        grid.sync();
        ph_gemm<EpiStore>(smem, xn, D, w_in + (size_t)l * D * INW, INW, T, INW, D, EpiStore{proj, INW, 0});
        grid.sync();
        ph_cum(proj, fox_b + l * NH, cum);
        ph_ssm(proj, lam_re + l * G * P, lam_im + l * G * P, log_dt + l * G, b_re + (size_t)l * G * P * HC, b_im + (size_t)l * G * P * HC,
               c_re + (size_t)l * G * HC * P, c_im + (size_t)l * G * HC * P, ssm_d + l * G * HC, gel);
        grid.sync();
        ph_attn(proj, cum, yatt);
        ph_gemm<EpiGlu>(smem, gel, SSMW, w_glu + (size_t)l * SSMW * SSMW, SSMW, T, SSMW, SSMW, EpiGlu{gel, b_glu + l * SSMW, yssm});
        grid.sync();
        ph_rmsnorm(yssm, SSMW, g_ssm + l * SSMW, mixed, D, SSMW, T);
        ph_rmsnorm(yatt, ATTW, g_att + l * ATTW, mixed + SSMW, D, ATTW, T);
        grid.sync();
        ph_gemm<EpiAdd>(smem, mixed, D, w_o + (size_t)l * D * D, D, T, D, D, EpiAdd{h, D, 0});
        grid.sync();
        ph_rmsnorm(h, D, norm2_g + l * D, xn, D, D, T);
        grid.sync();
        ph_gemm<EpiStore>(smem, xn, D, w_q + (size_t)l * D * D, D, T, D, D, EpiStore{qp, D, 0});
        grid.sync();
        ph_peer_select(smem, qp, pkeys + (size_t)l * PH * 2 * NK * HALF, idx, gate);
        grid.sync();
        ph_peer_eval(smem, xn, idx, gate, pu + (size_t)l * NEXP * D, pv + (size_t)l * NEXP * D, h);
        grid.sync();
    }
    ph_rmsnorm(h, D, norm_f, p.out, D, D, T);
}
}

extern "C" void kernel_launch(void* const* d_in, const int* in_sizes, int n_in, void* d_out, int out_size, void* d_ws, size_t ws_size, hipStream_t stream) {
    using namespace nv;
    static int grid_blocks = 0;
    if (!grid_blocks) {
        int dev = 0, cus = 0, per_cu = 0;
        (void)hipGetDevice(&dev);
        (void)hipDeviceGetAttribute(&cus, hipDeviceAttributeMultiprocessorCount, dev);
        (void)hipOccupancyMaxActiveBlocksPerMultiprocessor(&per_cu, (const void*)k_mega, 512, 0);
        if (per_cu < 1) { fprintf(stderr, "occupancy query returned %d\n", per_cu); per_cu = 1; }
        if (per_cu > 1) per_cu = 1;
        grid_blocks = cus * per_cu;
    }
    if (ws_size < (size_t)760 * (1u << 20) || n_in != 23) { fprintf(stderr, "bad workspace / inputs\n"); return; }
    Params p{};
    for (int i = 0; i < 23; ++i) p.in[i] = (const float*)d_in[i];
    p.out = (float*)d_out; p.ws = (unsigned char*)d_ws;
    void* args[] = {&p};
    hipError_t e = hipLaunchCooperativeKernel((const void*)k_mega, dim3(grid_blocks), dim3(512), args, 0, stream);
    if (e != hipSuccess) fprintf(stderr, "cooperative launch failed: %s (grid %d)\n", hipGetErrorString(e), grid_blocks);
}
```

```cpp
#include <hip/hip_runtime.h>
#include <hip/hip_cooperative_groups.h>
#include <hip/hip_bf16.h>
#include <cstdint>
#include <cstdio>

#define LAS __attribute__((address_space(3)))
#define GAS __attribute__((address_space(1)))

namespace nv {
constexpr int D = 1024, BATCH = 8, SEQ = 4096, DEPTH = 4, T = BATCH * SEQ;
constexpr int SSMW = 512, G = 32, HC = 16, P = 64, ATTW = 512, HD = 64, NH = 8, INW = 2056;
constexpr int PH = 8, NK = 128, TOPK = 16, QD = 128, HALF = 64, NEXP = 16384;
constexpr int CHUNK = 64, NCH = T / CHUNK  , UPW = 128 + CHUNK * HC  ;
constexpr float EPS = 1e-6f;

typedef short bf16x8 __attribute__((ext_vector_type(8)));
typedef float f32x16 __attribute__((ext_vector_type(16)));
typedef float f32x4 __attribute__((ext_vector_type(4)));
typedef unsigned u32x4 __attribute__((ext_vector_type(4)));
typedef unsigned short bf16_t;

constexpr size_t MiB = 1u << 20;
constexpr size_t WS_CTL = 0, CTL_BYTES = 4 * MiB;
constexpr size_t WS_BT1 = 4 * MiB;
constexpr size_t WS_BT2 = 20 * MiB;
constexpr size_t WS_BT3 = 22 * MiB;
constexpr size_t WS_BT4 = 30 * MiB;
constexpr size_t WS_WF = 38 * MiB;
constexpr size_t WS_KEYS = 39 * MiB;
constexpr size_t WS_KD = 40 * MiB, WS_WOUT = 49 * MiB, WS_WST = 81 * MiB;
constexpr size_t WS_PU = 90 * MiB, WS_PV8 = 154 * MiB;
constexpr size_t WS_PART = 218 * MiB;
constexpr size_t WS_H = 346 * MiB;
constexpr size_t WS_HB = 474 * MiB;
constexpr size_t WS_UP = 538 * MiB;
constexpr size_t WS_Q = 576 * MiB, WS_K = 608 * MiB, WS_V = 640 * MiB;
constexpr size_t WS_LOGF = 672 * MiB, WS_CUM = 673 * MiB;
constexpr size_t WS_SLOC = 674 * MiB, WS_GEL = 708 * MiB, WS_MIX = 740 * MiB;
constexpr size_t WS_SSP = 916 * MiB;
constexpr size_t WS_QP = 852 * MiB;
constexpr size_t WS_IDX = 804 * MiB, WS_GATE = 820 * MiB, WS_COEF = 836 * MiB;
constexpr size_t WS_XN_F = 90 * MiB, WS_MIXED_F = 218 * MiB, WS_QP_F = 852 * MiB, WS_GEL_F = 90 * MiB  , WS_YSSM_F = 740 * MiB, WS_YATT_F = 674 * MiB;
constexpr size_t WS_END = 980 * MiB;
constexpr int CW_BAR = 4096;
constexpr int CW_SS = 65536;
constexpr int SS_H1 = 0  , SS_H2 = 5  , SS_SSM = 9, SS_ATT = 13;
static_assert((size_t)(CW_SS + 17 * T) * 4 <= CTL_BYTES, "ctl region");

__device__ __forceinline__ unsigned short f2bf(float f) { unsigned u = __float_as_uint(f); return (unsigned short)((u + 0x7fffu + ((u >> 16) & 1u)) >> 16); }
__device__ __forceinline__ float bf2f(unsigned short b) { return __uint_as_float(((unsigned)b) << 16); }
__device__ __forceinline__ unsigned pk2(float lo, float hi) { return (unsigned)f2bf(lo) | ((unsigned)f2bf(hi) << 16); }
__device__ __forceinline__ float gelu_tanh(float x) { const float u = 0.7978845608028654f * (x + 0.044715f * x * x * x); return 0.5f * x * (1.f + tanhf(u)); }
__device__ __forceinline__ float wave_sum(float v) {
#pragma unroll
    for (int o = 1; o < 64; o <<= 1) v += __shfl_xor(v, o);
    return v;
}
__device__ __forceinline__ int otid() { int t = threadIdx.x; asm volatile("" : "+v"(t)); return t; }
__device__ __forceinline__ int obid() { int t = blockIdx.x; asm volatile("" : "+s"(t)); return t; }
__device__ __forceinline__ int ogrid() { int t = gridDim.x; asm volatile("" : "+s"(t)); return t; }
#define PH_IDS const int TIDX = otid(), BIDX = obid(), GDIM = ogrid(); (void)TIDX; (void)BIDX; (void)GDIM;
__device__ __forceinline__ size_t up_index(int row, int c) { const int n = row >> 6, j = row & 63, g = c >> 4, hh = c & 15; return ((size_t)g * NCH + n) * UPW + 128 + j * HC + hh; }
}
namespace ge {
#define GE_LAS __attribute__((address_space(3)))
typedef unsigned short bf16_t;
typedef short bf16x8 __attribute__((ext_vector_type(8)));
typedef float f32x4 __attribute__((ext_vector_type(4)));
typedef unsigned u32x4 __attribute__((ext_vector_type(4)));
typedef unsigned u32x2 __attribute__((ext_vector_type(2)));
constexpr int ROWF_OFF = 131072 + 4096;
constexpr int BM = 256, BK = 64, HALF = 128, HTB = HALF * BK * 2  , STAGE_BYTES = 8 * HTB, NXCD = 8, WGM = 8;

__host__ __device__ __forceinline__ int lds_byte(int r, int c) { const int st = (r >> 4) * 2 + (c >> 5), rr = r & 15, cc = c & 31, ob = rr * 64 + cc * 2; return st * 1024 + (ob ^ (((ob >> 9) & 1) << 5)); }
__host__ __device__ __forceinline__ void stage_rc(int b, int& R, int& C) { const int st = b / 1024, sb = b % 1024, swz = sb ^ (((sb >> 9) & 1) << 5); R = (st >> 1) * 16 + swz / 64; C = (st & 1) * 32 + (swz % 64) / 2; }
__host__ __device__ __forceinline__ int perm32(int rho) { const int n = rho >> 4, i = rho & 15; return 8 * (i >> 2) + 4 * n + (i & 3); }

struct Unit { const char* A0; const char* B0; int nt; int pm, pn, aux; };
__device__ __forceinline__ unsigned cvt_pk_bf16(float lo, float hi) { unsigned r; asm volatile("v_cvt_pk_bf16_f32 %0, %1, %2" : "=v"(r) : "v"(lo), "v"(hi)); return r; }

__device__ __forceinline__ bool static_tile(int i, int G, int c, int nM, int nN, int& pm, int& pn) {
    const int nwg = nM * nN; const long L = (long)i * G + c; if (L >= nwg) return false;
    int wgid = (int)L; { const int q = nwg / NXCD, r = nwg % NXCD, xcd = wgid % NXCD, off = wgid / NXCD; wgid = (xcd < r ? xcd * (q + 1) : r * (q + 1) + (xcd - r) * q) + off; }
    const int nig = WGM * nN, gid = wgid / nig, fm = gid * WGM, gsz = (nM - fm) < WGM ? (nM - fm) : WGM;
    pm = fm + ((wgid % nig) % gsz); pn = (wgid % nig) / gsz; return true;
}

template <class Epi, class Sched>
__device__ __forceinline__ void gemm_phase(GE_LAS unsigned char* lds, const Sched& S, const Epi& E, int tid) {
    const int wid = __builtin_amdgcn_readfirstlane(tid >> 6), lane = tid & 63, wr = wid >> 2, wc = wid & 3, fr = lane & 15, fq = lane >> 4;
    unsigned voffA[2], voffB[2], voffB1[2];
#pragma unroll
    for (int i = 0; i < 2; ++i) { int R, C; stage_rc(tid * 16 + i * 8192, R, C); const int Rb = Epi::PERM ? ((R & ~31) + perm32(R & 31)) : R;
        voffA[i] = S.voffA(R, C); voffB[i] = S.voffB(Rb, C); if constexpr (Sched::DUALB) voffB1[i] = S.voffB1(Rb, C); else voffB1[i] = 0u; }
    const long hA = S.hA, hB = S.hB;
    const unsigned ldsw = (unsigned)wid * 1024u;
    const int aoff = lds_byte(wr * 64 + fr, fq * 8), boff = lds_byte(wc * 32 + fr, fq * 8);
#define GE_SA(b, h) (((b) * 2 + (h)) * HTB)
#define GE_SB(b, h) ((4 + (b) * 2 + (h)) * HTB)
#define GE_STAGE(bufoff, gbase, voff) do { _Pragma("unroll") for (int _i = 0; _i < 2; ++_i) \
        __builtin_amdgcn_global_load_lds((const unsigned*)((const char*)(gbase) + (voff)[_i]), (GE_LAS unsigned*)(lds + (bufoff) + ldsw + _i * 8192), 16, 0, 0); } while (0)
#define GE_STAGE_B(bufoff, gbase, sel, half) do { if constexpr (Sched::DUALB) { const char* _g = (const char*)(gbase) + ((half) ? ((sel) ? S.hB1 : hB) : 0l); _Pragma("unroll") for (int _i = 0; _i < 2; ++_i) { const unsigned _v = (sel) ? voffB1[_i] : voffB[_i]; \
        __builtin_amdgcn_global_load_lds((const unsigned*)(_g + _v), (GE_LAS unsigned*)(lds + (bufoff) + ldsw + _i * 8192), 16, 0, 0); } } else { GE_STAGE(bufoff, (const char*)(gbase) + ((half) ? hB : 0l), voffB); } } while (0)
#define GE_LDA(dst, b, h) do { _Pragma("unroll") for (int m = 0; m < 4; ++m) _Pragma("unroll") for (int k = 0; k < 2; ++k) dst[m][k] = *(const GE_LAS bf16x8*)(lds + GE_SA(b, h) + aoff + m * 2048 + k * 1024); } while (0)
#define GE_LDB(dst, b, h) do { _Pragma("unroll") for (int n = 0; n < 2; ++n) _Pragma("unroll") for (int k = 0; k < 2; ++k) dst[n][k] = *(const GE_LAS bf16x8*)(lds + GE_SB(b, h) + boff + n * 2048 + k * 1024); } while (0)
#define GE_MMA(ai, bj, At, Bt) do { __builtin_amdgcn_s_setprio(1); _Pragma("unroll") for (int m = 0; m < 4; ++m) _Pragma("unroll") for (int n = 0; n < 2; ++n) _Pragma("unroll") for (int k = 0; k < 2; ++k) \
        acc[ai][bj][m][n] = __builtin_amdgcn_mfma_f32_16x16x32_bf16(Bt[n][k], At[m][k], acc[ai][bj][m][n], 0, 0, 0); __builtin_amdgcn_s_setprio(0); } while (0)
#define GE_WAIT_V(n) asm volatile("s_waitcnt vmcnt(" #n ")" ::: "memory")
#define GE_WAIT_L(n) asm volatile("s_waitcnt lgkmcnt(" #n ")" ::: "memory")
#define GE_BAR __builtin_amdgcn_s_barrier()
#define GE_SCHED __builtin_amdgcn_sched_barrier(0)
    Unit cur, nxt; int ui = 0;
    if (!S.next(0, cur)) return;
    f32x4 acc[2][2][4][2];
#pragma unroll
    for (int a = 0; a < 2; ++a)
#pragma unroll
        for (int b = 0; b < 2; ++b)
#pragma unroll
            for (int m = 0; m < 4; ++m)
#pragma unroll
                for (int n = 0; n < 2; ++n) acc[a][b][m][n] = (f32x4){0.f, 0.f, 0.f, 0.f};
    bf16x8 At[4][2], B0[2][2], B1[2][2];
    if constexpr (Epi::UBEGIN) E.unit_begin(cur, tid, lds + ROWF_OFF);
    {
        const char* a0 = S.ta(cur, 0); const char* b0 = S.tb(cur, 0); const char* a1 = S.ta(cur, 1); const char* b1 = S.tb(cur, 1);
        const bool s0 = S.sb(cur, 0), s1 = S.sb(cur, 1);
        GE_STAGE_B(GE_SB(0, 0), b0, s0, 0); GE_STAGE_B(GE_SB(0, 1), b0, s0, 1); GE_STAGE(GE_SA(0, 0), a0, voffA); GE_STAGE(GE_SA(0, 1), a0 + hA, voffA);
        if (wr == 1) GE_BAR;
        GE_WAIT_V(2); GE_BAR;
        GE_STAGE_B(GE_SB(1, 0), b1, s1, 0); GE_STAGE(GE_SA(1, 0), a1, voffA); GE_STAGE_B(GE_SB(1, 1), b1, s1, 1);
        GE_WAIT_V(6); GE_BAR;
    }
    for (;;) {
        const bool has_next = S.next(ui + 1, nxt);
        const int nt = cur.nt;
        for (int t = 0; t < nt; t += 2) {
            const bool last = (t == nt - 2);
            const char* a1 = S.ta(cur, t + 1);
            const char* a2 = last ? (has_next ? S.ta(nxt, 0) : S.ta(cur, 0)) : S.ta(cur, t + 2);
            const char* b2 = last ? (has_next ? S.tb(nxt, 0) : S.tb(cur, 0)) : S.tb(cur, t + 2);
            const char* a3 = last ? (has_next ? S.ta(nxt, 1) : S.ta(cur, 1)) : S.ta(cur, t + 3);
            const char* b3 = last ? (has_next ? S.tb(nxt, 1) : S.tb(cur, 1)) : S.tb(cur, t + 3);
            const bool s2 = last ? (has_next ? S.sb(nxt, 0) : S.sb(cur, 0)) : S.sb(cur, t + 2), s3 = last ? (has_next ? S.sb(nxt, 1) : S.sb(cur, 1)) : S.sb(cur, t + 3);
            GE_LDB(B0, 0, 0); GE_LDB(B1, 0, 1); GE_SCHED; GE_LDA(At, 0, 0); GE_STAGE(GE_SA(1, 1), a1 + hA, voffA);
            GE_WAIT_V(8); GE_WAIT_L(0); GE_BAR; GE_MMA(0, 0, At, B0); GE_MMA(0, 1, At, B1); GE_BAR; GE_SCHED;
            GE_LDA(At, 0, 1); GE_STAGE_B(GE_SB(0, 0), b2, s2, 0); GE_STAGE_B(GE_SB(0, 1), b2, s2, 1); GE_STAGE(GE_SA(0, 0), a2, voffA);
            GE_WAIT_V(8); GE_WAIT_L(0); GE_BAR; GE_MMA(1, 0, At, B0); GE_MMA(1, 1, At, B1); GE_BAR; GE_SCHED;
            GE_LDB(B0, 1, 0); GE_LDB(B1, 1, 1); GE_SCHED; GE_LDA(At, 1, 0); GE_STAGE(GE_SA(0, 1), a2 + hA, voffA);
            GE_WAIT_V(8); GE_WAIT_L(0); GE_BAR; GE_MMA(0, 0, At, B0); GE_MMA(0, 1, At, B1); GE_BAR; GE_SCHED;
            GE_LDA(At, 1, 1); GE_STAGE_B(GE_SB(1, 0), b3, s3, 0); GE_STAGE_B(GE_SB(1, 1), b3, s3, 1); GE_STAGE(GE_SA(1, 0), a3, voffA);
            GE_WAIT_V(8); GE_WAIT_L(0); GE_BAR; GE_MMA(1, 0, At, B0); GE_MMA(1, 1, At, B1); GE_BAR; GE_SCHED;
            if constexpr (Epi::MIDK) { if (t + 2 == (nt >> 1)) E.midk(acc, cur, wr, fr, lds + ROWF_OFF + (ui & 1) * 2048); }
        }
        if (wr == 0) GE_BAR;
        E(acc, cur, wr, wc, fr, fq, lds + ROWF_OFF + (ui & 1) * 2048);
        if (!has_next) break;
        if constexpr (Epi::UBEGIN) E.unit_begin(nxt, tid, lds + ROWF_OFF + ((ui + 1) & 1) * 2048);
#pragma unroll
        for (int a = 0; a < 2; ++a)
#pragma unroll
            for (int b = 0; b < 2; ++b)
#pragma unroll
                for (int m = 0; m < 4; ++m)
#pragma unroll
                    for (int n = 0; n < 2; ++n) acc[a][b][m][n] = (f32x4){0.f, 0.f, 0.f, 0.f};
        cur = nxt; ++ui;
        if (wr == 1) GE_BAR;
    }
    GE_WAIT_V(0);
    GE_BAR;
#undef GE_SA
#undef GE_SB
#undef GE_STAGE
#undef GE_STAGE_B
#undef GE_LDA
#undef GE_LDB
#undef GE_MMA
#undef GE_WAIT_V
#undef GE_WAIT_L
#undef GE_BAR
#undef GE_SCHED
}
}
namespace nv {
__device__ __forceinline__ float sum16(const float* p);
__device__ __forceinline__ void ph_rmsnorm(const float* __restrict__ in, int ldi, const float* __restrict__ g, float* __restrict__ out, int ldo, int n, int rows) {
    PH_IDS
    const int lane = TIDX & 63, gw = BIDX * 8 + (TIDX >> 6), ngw = GDIM * 8;
    for (int w = gw; w < rows; w += ngw) {
        const float* r = in + (size_t)w * ldi; float* o = out + (size_t)w * ldo;
        float s = 0.f;
        for (int c = lane; c < n; c += 64) { const float v = r[c]; s += v * v; }
        s = wave_sum(s);
        const float rs = rsqrtf(s / (float)n + EPS);
        for (int c = lane; c < n; c += 64) o[c] = r[c] * rs * g[c];
    }
}
__device__ __forceinline__ void ph_make_hb(const float* __restrict__ h, bf16_t* __restrict__ hb, float* __restrict__ ss) {
    PH_IDS
    const int lane = TIDX & 63, gw = BIDX * 8 + (TIDX >> 6), ngw = GDIM * 8;
    for (int w = gw; w < T; w += ngw) {
        const f32x4* r = (const f32x4*)(h + (size_t)w * D) + lane; unsigned long long* o = (unsigned long long*)(hb + (size_t)w * D) + lane;
        float s = 0.f;
#pragma unroll
        for (int j = 0; j < 4; ++j) { const f32x4 v = r[64 * j]; s += v.x * v.x + v.y * v.y + v.z * v.z + v.w * v.w; o[64 * j] = (unsigned long long)pk2(v.x, v.y) | ((unsigned long long)pk2(v.z, v.w) << 32); }
        s = wave_sum(s);
        if (lane == 0) ss[w] = s;
    }
}

template <class Epi>
__device__ __forceinline__ void ph_gemm(unsigned char* sm, const float* __restrict__ A, int lda, const float* __restrict__ B, int ldb, int M, int N, int K, Epi epi) {
    PH_IDS
    const int team = TIDX >> 8, tid = TIDX & 255, wave = tid >> 6, lane = tid & 63;
    unsigned short (*As)[40] = (unsigned short (*)[40])(sm + team * 20480); unsigned short (*Bs)[40] = (unsigned short (*)[40])(sm + team * 20480 + 10240);
    const int ntn = (N + 127) / 128, ntiles = ntn * (M / 128);
    const int wm = (wave >> 1) * 64, wn = (wave & 1) * 64;
    for (int it = BIDX; it < ntiles / 2; it += GDIM) {
        const int tile = it * 2 + team, m0 = (tile / ntn) * 128, n0 = (tile % ntn) * 128;
        f32x16 acc[2][2];
#pragma unroll
        for (int i = 0; i < 2; ++i)
#pragma unroll
            for (int j = 0; j < 2; ++j)
#pragma unroll
                for (int r = 0; r < 16; ++r) acc[i][j][r] = 0.f;
        for (int k0 = 0; k0 < K; k0 += 32) {
#pragma unroll
            for (int i = 0; i < 4; ++i) {
                const int idx = tid + i * 256, r = idx >> 3, c = (idx & 7) * 4;
                const float4 v = *(const float4*)(A + (size_t)(m0 + r) * lda + k0 + c);
                As[r][c] = f2bf(v.x); As[r][c + 1] = f2bf(v.y); As[r][c + 2] = f2bf(v.z); As[r][c + 3] = f2bf(v.w);
            }
#pragma unroll
            for (int i = 0; i < 4; ++i) {
                const int idx = tid + i * 256, k = idx >> 5, c = (idx & 31) * 4, n = n0 + c;
                float4 v = make_float4(0.f, 0.f, 0.f, 0.f);
                if (n + 3 < N) v = *(const float4*)(B + (size_t)(k0 + k) * ldb + n);
                Bs[c][k] = f2bf(v.x); Bs[c + 1][k] = f2bf(v.y); Bs[c + 2][k] = f2bf(v.z); Bs[c + 3][k] = f2bf(v.w);
            }
            __syncthreads();
#pragma unroll
            for (int ks = 0; ks < 2; ++ks) {
                bf16x8 a[2], b[2];
#pragma unroll
                for (int i = 0; i < 2; ++i) a[i] = *(const bf16x8*)&As[wm + i * 32 + (lane & 31)][ks * 16 + (lane >> 5) * 8];
#pragma unroll
                for (int j = 0; j < 2; ++j) b[j] = *(const bf16x8*)&Bs[wn + j * 32 + (lane & 31)][ks * 16 + (lane >> 5) * 8];
#pragma unroll
                for (int i = 0; i < 2; ++i)
#pragma unroll
                    for (int j = 0; j < 2; ++j) acc[i][j] = __builtin_amdgcn_mfma_f32_32x32x16_bf16(a[i], b[j], acc[i][j], 0, 0, 0);
            }
            __syncthreads();
        }
#pragma unroll
        for (int i = 0; i < 2; ++i)
#pragma unroll
            for (int j = 0; j < 2; ++j)
#pragma unroll
                for (int r = 0; r < 16; ++r) {
                    const int row = m0 + wm + i * 32 + (r & 3) + 8 * (r >> 2) + 4 * (lane >> 5), col = n0 + wn + j * 32 + (lane & 31);
                    if (col < N) epi(row, col, acc[i][j][r]);
                }
    }
}
struct EpiStore { float* C; int ldc; int pad; __device__ void operator()(int r, int c, float v) const { C[(size_t)r * ldc + c] = v; } };
struct EpiAdd { float* C; int ldc; int pad; __device__ void operator()(int r, int c, float v) const { C[(size_t)r * ldc + c] += v; } };
struct EpiGlu { const float* gel; const float* bias; float* out; __device__ void operator()(int r, int c, float v) const {
    const float gg = gel[(size_t)r * SSMW + c]; out[(size_t)r * SSMW + c] = gg / (1.f + expf(-(v + bias[c]))); } };

__device__ __forceinline__ void ph_ssm(const bf16_t* __restrict__ UP, const float* __restrict__ lam_re, const float* __restrict__ lam_im, const float* __restrict__ log_dt,
                                       const float* __restrict__ b_re, const float* __restrict__ b_im, const float* __restrict__ c_re, const float* __restrict__ c_im,
                                       const float* __restrict__ dsk, bf16_t* __restrict__ gel) {
    PH_IDS
    const int p = TIDX & 63, wv = TIDX >> 6;
    for (int item = BIDX + GDIM * wv; item < BATCH * G; item += GDIM * 8) {
        const int b = item / G, g = item % G;
        const float dt = expf(log_dt[g]);
        const float lr = lam_re[g * P + p], li = lam_im[g * P + p];
        const float mag = expf(lr * dt), are = mag * cosf(li * dt), aim = mag * sinf(li * dt);
        const float den = lr * lr + li * li, nr = are - 1.f;
        const float zre = (nr * lr + aim * li) / den, zim = (aim * lr - nr * li) / den;
        float bbr[HC], bbi[HC], cr[HC], ci[HC];
#pragma unroll
        for (int h = 0; h < HC; ++h) {
            const float br = b_re[(g * P + p) * HC + h], bi = b_im[(g * P + p) * HC + h];
            bbr[h] = zre * br - zim * bi; bbi[h] = zre * bi + zim * br;
            cr[h] = c_re[(g * HC + h) * P + p]; ci[h] = c_im[(g * HC + h) * P + p];
        }
        const float dmine = dsk[g * HC + (p & 15)];
        float sre = 0.f, sim = 0.f;
        for (int t = 0; t < SEQ; ++t) {
            const bf16_t* u = UP + up_index(b * SEQ + t, g * HC);
            float xr = 0.f, xi = 0.f, um = 0.f;
#pragma unroll
            for (int h = 0; h < HC; ++h) { const float uv = bf2f(u[h]); xr += bbr[h] * uv; xi += bbi[h] * uv; if ((p & 15) == h) um = uv; }
            const float nre = are * sre - aim * sim + xr, nim = are * sim + aim * sre + xi;
            sre = nre; sim = nim;
            float ymine = 0.f;
#pragma unroll
            for (int h = 0; h < HC; ++h) { const float v = wave_sum(cr[h] * sre - ci[h] * sim); if ((p & 15) == h) ymine = v; }
            if (p < HC) gel[((size_t)g * T + b * SEQ + t) * HC + p] = f2bf(gelu_tanh(ymine + dmine * um));
        }
    }
}

__device__ __forceinline__ void ph_cum(const float* __restrict__ logf, float* __restrict__ cum) {
    PH_IDS
    if (BIDX != GDIM - 1 || (TIDX >> 6) != 7) return;
    const int i = TIDX & 63;
    const int b = i / NH, h = i % NH; float c = 0.f;
    for (int t = 0; t < SEQ; ++t) { c += logf[(size_t)(b * SEQ + t) * NH + h]; cum[(size_t)i * SEQ + t] = c * 1.4426950408889634f; }
}

__device__ __forceinline__ void ph_attn(const bf16_t* __restrict__ Q, const bf16_t* __restrict__ Kb, const bf16_t* __restrict__ Vb, const float* __restrict__ cum, bf16_t* __restrict__ MIX, float* __restrict__ ssp_att) {
    PH_IDS
    const int gw = BIDX * 8 + (TIDX >> 6), ngw = GDIM * 8, lane = TIDX & 63;
    constexpr int NIT = BATCH * NH * (SEQ / 64);
    for (int it0 = gw; it0 < NIT; it0 += ngw) {
        const int it = NIT - 1 - it0;
        const int tb = it / (BATCH * NH), bh = it % (BATCH * NH), b = bh / NH, h = bh % NH;
        const int t = tb * 64 + lane;
        float q[HD], o[HD];
#pragma unroll
        for (int d = 0; d < HD; ++d) { q[d] = bf2f(Q[(size_t)(b * SEQ + t) * ATTW + h * HD + d]) * 0.125f; o[d] = 0.f; }
        const float* cm = cum + (size_t)bh * SEQ; const float ct = cm[t];
        float m = -INFINITY, l = 0.f;
        const int smax = tb * 64 + 63;
        for (int s = 0; s <= smax; ++s) {
            const bf16_t* kr = Kb + (size_t)(b * SEQ + s) * ATTW + h * HD; const bf16_t* vr = Vb + (size_t)(b * SEQ + s) * ATTW + h * HD;
            float lg = ct - cm[s];
#pragma unroll
            for (int d = 0; d < HD; ++d) lg += q[d] * bf2f(kr[d]);
            if (s <= t) {
                const float mn = fmaxf(m, lg), sc = expf(m - mn), pp = expf(lg - mn);
                l = l * sc + pp; m = mn;
#pragma unroll
                for (int d = 0; d < HD; ++d) o[d] = o[d] * sc + pp * bf2f(vr[d]);
            }
        }
        const float il = 1.f / l; float sq = 0.f;
#pragma unroll
        for (int d = 0; d < HD; ++d) { const float ov = o[d] * il; sq += ov * ov; MIX[(size_t)(b * SEQ + t) * D + SSMW + h * HD + d] = f2bf(ov); }
        ssp_att[(size_t)(b * SEQ + t) * 8 + h] = sq;
    }
}

__device__ __forceinline__ void ph_peer_select(unsigned char* sm, const bf16_t* __restrict__ qp, const float* __restrict__ keys, int* __restrict__ idx, float* __restrict__ gate) {
    PH_IDS
    const int team = TIDX >> 8, tid = TIDX & 255, lane = tid & 63, wave = tid >> 6;
    float* sc = (float*)(sm + team * 4096); float* tv = sc + 256; int* ti = (int*)(tv + 32); float* cand = (float*)(ti + 32);
    for (int it = BIDX; it < T * PH / 2; it += GDIM) {
        const int item = it * 2 + team, tok = item / PH, hd = item % PH;
        {
            const int half = tid >> 7, n = tid & 127;
            const bf16_t* q = qp + (size_t)tok * D + hd * QD + half * HALF; const float* kk = keys + ((size_t)(hd * 2 + half) * NK + n) * HALF;
            float s = 0.f;
            for (int d = 0; d < HALF; ++d) s += bf2f(q[d]) * kk[d];
            sc[tid] = s;
        }
        __syncthreads();
        if (wave == 0 || wave == 2) {
            const int half = wave >> 1;
            float v0 = sc[half * 128 + lane], v1 = sc[half * 128 + lane + 64];
            for (int k = 0; k < TOPK; ++k) {
                float bv; int bi;
                if (v0 >= v1) { bv = v0; bi = lane; } else { bv = v1; bi = lane + 64; }
#pragma unroll
                for (int o = 1; o < 64; o <<= 1) { const float ov = __shfl_xor(bv, o); const int oi = __shfl_xor(bi, o); if (ov > bv || (ov == bv && oi < bi)) { bv = ov; bi = oi; } }
                if (lane == 0) { tv[half * 16 + k] = bv; ti[half * 16 + k] = bi; }
                if (bi == lane) v0 = -INFINITY; if (bi == lane + 64) v1 = -INFINITY;
            }
        }
        __syncthreads();
        cand[tid] = tv[tid >> 4] + tv[16 + (tid & 15)];
        __syncthreads();
        if (wave == 0) {
            float v[4];
#pragma unroll
            for (int j = 0; j < 4; ++j) v[j] = cand[lane + 64 * j];
            float best = 0.f; int bidx = 0; float mx = 0.f, se = 0.f;
            for (int k = 0; k < TOPK; ++k) {
                float bv = v[0]; int bi = lane;
#pragma unroll
                for (int j = 1; j < 4; ++j) if (v[j] > bv) { bv = v[j]; bi = lane + 64 * j; }
#pragma unroll
                for (int o = 1; o < 64; o <<= 1) { const float ov = __shfl_xor(bv, o); const int oi = __shfl_xor(bi, o); if (ov > bv || (ov == bv && oi < bi)) { bv = ov; bi = oi; } }
                if (k == 0) mx = bv;
                const float e = expf(bv - mx); se += e;
                if (lane == k) { best = e; bidx = ti[bi >> 4] * NK + ti[16 + (bi & 15)]; }
#pragma unroll
                for (int j = 0; j < 4; ++j) if (bi == lane + 64 * j) v[j] = -INFINITY;
            }
            if (lane < TOPK) { idx[(size_t)tok * 128 + hd * TOPK + lane] = bidx; gate[(size_t)tok * 128 + hd * TOPK + lane] = best / se; }
        }
        __syncthreads();
    }
}

__device__ __forceinline__ void ph_peer_eval(unsigned char* sm, const float* __restrict__ ss2, const float* __restrict__ g2, const int* __restrict__ idx, const float* __restrict__ gate,
                                             const float* __restrict__ ut, const float* __restrict__ vt, float* __restrict__ h) {
    PH_IDS
    const int team = TIDX >> 8, tid = TIDX & 255, lane = tid & 63, wave = tid >> 6;
    float (*red)[D] = (float (*)[D])(sm + team * 16384);
    for (int it = BIDX; it < T / 2; it += GDIM) {
        const int tok = it * 2 + team;
        float4 x[4], acc[4];
#pragma unroll
        for (int j = 0; j < 4; ++j) { const float rs = rsqrtf(sum16(ss2 + (size_t)tok * 16) * (1.f / D) + EPS); const float4 hv = *(const float4*)(h + (size_t)tok * D + j * 256 + lane * 4); const float4 gv = *(const float4*)(g2 + j * 256 + lane * 4);
            x[j] = make_float4(hv.x * rs * gv.x, hv.y * rs * gv.y, hv.z * rs * gv.z, hv.w * rs * gv.w); acc[j] = make_float4(0.f, 0.f, 0.f, 0.f); }
        for (int k = 0; k < 32; ++k) {
            const int pr = wave * 32 + k; const int e = idx[(size_t)tok * 128 + pr]; const float gt = gate[(size_t)tok * 128 + pr];
            const float* ur = ut + (size_t)e * D; const float* vr = vt + (size_t)e * D;
            float s = 0.f;
#pragma unroll
            for (int j = 0; j < 4; ++j) { const float4 uv = *(const float4*)(ur + j * 256 + lane * 4); s += uv.x * x[j].x + uv.y * x[j].y + uv.z * x[j].z + uv.w * x[j].w; }
            s = wave_sum(s);
            const float cf = gelu_tanh(s) * gt;
#pragma unroll
            for (int j = 0; j < 4; ++j) { const float4 vv = *(const float4*)(vr + j * 256 + lane * 4); acc[j].x += cf * vv.x; acc[j].y += cf * vv.y; acc[j].z += cf * vv.z; acc[j].w += cf * vv.w; }
        }
#pragma unroll
        for (int j = 0; j < 4; ++j) *(float4*)&red[wave][j * 256 + lane * 4] = acc[j];
        __syncthreads();
        for (int c = tid; c < D; c += 256) h[(size_t)tok * D + c] += red[0][c] + red[1][c] + red[2][c] + red[3][c];
        __syncthreads();
    }
}
}
namespace nv {
__device__ __forceinline__ float sum8(const float* p);
__device__ __forceinline__ float sum16(const float* p);
#define XB_TMO      128
#define XB_XCNT(j)  (256  + 64 * (j))
#define XB_XSUB(j)  (1280 + 64 * (j))
#define XB_XGEN(j)  (2304 + 64 * (j))
#define XB_TOP      3328
#define XB_TOPGEN   3392
#define XCD_BAR_WORDS 3456
#define XB_SPIN_CAP (1u << 24)
__device__ __forceinline__ unsigned xb_ld(unsigned* p)              { return __hip_atomic_load(p, __ATOMIC_RELAXED, __HIP_MEMORY_SCOPE_AGENT); }
__device__ __forceinline__ unsigned xb_add(unsigned* p, unsigned v) { return __hip_atomic_fetch_add(p, v, __ATOMIC_RELAXED, __HIP_MEMORY_SCOPE_AGENT); }
__device__ __forceinline__ unsigned xb_xcc_id() { return (unsigned)__builtin_amdgcn_s_getreg((3 << 11) | 20) & 0xFu; }
#define XB_SPIN(cond, bar) do { unsigned _sp = 0; while (cond) { __builtin_amdgcn_s_sleep(1); \
    if ((++_sp & 255u) == 0u) { if (xb_ld(&(bar)[XB_TMO])) break; if (_sp > XB_SPIN_CAP) { atomicAdd(&(bar)[XB_TMO], 1u); break; } } } } while (0)
struct XcdBarrier { unsigned* bar; unsigned x; volatile LAS unsigned* st; };
__device__ __forceinline__ XcdBarrier xcd_barrier_post(unsigned* bar, volatile LAS unsigned* st) {
    XcdBarrier b; b.bar = bar; b.x = xb_xcc_id(); b.st = st;
    if (threadIdx.x == 0) (void)xb_add(&bar[XB_XCNT(b.x)], 1u);
    return b;
}
__device__ __forceinline__ void xcd_barrier_complete(unsigned* bar, unsigned x, unsigned& nloc, unsigned& nx) {
    const unsigned Gsz = gridDim.x * gridDim.y * gridDim.z;
    unsigned sum, cnt, mine, sp = 0u;
    for (;;) {
        sum = 0u; cnt = 0u; mine = 0u;
#pragma unroll
        for (unsigned j = 0; j < 16; ++j) { const unsigned c = xb_ld(&bar[XB_XCNT(j)]); sum += c; cnt += (c > 0u) ? 1u : 0u; mine = (j == x) ? c : mine; }
        if (sum == Gsz) break;
        __builtin_amdgcn_s_sleep(1);
        if ((++sp & 255u) == 0u) { if (xb_ld(&bar[XB_TMO])) break; if (sp > XB_SPIN_CAP) { atomicAdd(&bar[XB_TMO], 1u); break; } }
    }
    nloc = mine > 0u ? mine : 1u; nx = cnt > 0u ? cnt : 1u;
}
__device__ __forceinline__ void xcd_barrier(const XcdBarrier& b) {
    asm volatile("s_waitcnt vmcnt(0)" ::: "memory");
    __syncthreads();
    if (threadIdx.x == 0) {
        unsigned* bar = b.bar;
        __builtin_amdgcn_s_waitcnt(0);
        unsigned nloc = b.st[0], nx = b.st[1];
        if (nloc == 0u) { xcd_barrier_complete(bar, b.x, nloc, nx); b.st[0] = nloc; b.st[1] = nx; }
        const unsigned old = xb_add(&bar[XB_XSUB(b.x)], 1u);
        const unsigned gen = old / nloc;
        if (old + 1u == (gen + 1u) * nloc) {
            __builtin_amdgcn_fence(__ATOMIC_RELEASE, "agent");
            asm volatile("s_waitcnt vmcnt(0)" ::: "memory");
            const unsigned og = xb_add(&bar[XB_TOP], 1u);
            const unsigned tg = og / nx;
            if (og + 1u == (tg + 1u) * nx) xb_add(&bar[XB_TOPGEN], 1u);
            else XB_SPIN(xb_ld(&bar[XB_TOPGEN]) == tg, bar);
            __builtin_amdgcn_fence(__ATOMIC_ACQUIRE, "agent");
            xb_add(&bar[XB_XGEN(b.x)], 1u);
            asm volatile("s_waitcnt vmcnt(0)" ::: "memory");
        } else {
            XB_SPIN(xb_ld(&bar[XB_XGEN(b.x)]) == gen, bar);
            __builtin_amdgcn_fence(__ATOMIC_ACQUIRE, "agent");
            asm volatile("s_waitcnt vmcnt(0)" ::: "memory");
        }
    }
    __syncthreads();
}

#define LDS_WAIT() asm volatile("s_waitcnt lgkmcnt(0)" ::: "memory")
template <class Sc>
__device__ __forceinline__ void p0_transpose_item(const float* __restrict__ W, int ldw, int K, int Ncols, Sc sc, bf16_t* __restrict__ WT, LAS float* scr, int item, int lane) {
    const int nblk = Ncols / 32, kb = item / nblk, nb = item % nblk, k0 = 64 * kb, n0 = 32 * nb;
#pragma unroll 8
    for (int i = 0; i < 32; ++i) { const int kk = 2 * i + (lane >> 5); scr[kk * 33 + (lane & 31)] = W[(size_t)(k0 + kk) * ldw + n0 + (lane & 31)] * sc(k0 + kk); }
    LDS_WAIT(); asm volatile("" ::: "memory");
    const int c = lane & 7;
#pragma unroll
    for (int j = 0; j < 4; ++j) { const int n = (lane >> 3) + 8 * j; const LAS float* s = scr + (8 * c) * 33 + n;
        u32x4 o; o.x = pk2(s[0 * 33], s[1 * 33]); o.y = pk2(s[2 * 33], s[3 * 33]); o.z = pk2(s[4 * 33], s[5 * 33]); o.w = pk2(s[6 * 33], s[7 * 33]);
        *(u32x4*)(WT + (size_t)(n0 + n) * K + k0 + 8 * c) = o; }
    LDS_WAIT(); asm volatile("" ::: "memory");
}
struct ScVec { const float* g; __device__ __forceinline__ float operator()(int k) const { return g[k]; } };
struct ScOne { __device__ __forceinline__ float operator()(int) const { return 1.f; } };
struct ScTwo { const float* g0; const float* g1; __device__ __forceinline__ float operator()(int k) const { return k < 512 ? g0[k] : g1[k - 512]; } };

constexpr int TAB_OFF = 131072 + 1024;
__device__ __forceinline__ void* ldarg(LAS unsigned char* lds, int i) {
    unsigned off = TAB_OFF + 8 * i; asm volatile("" : "+s"(off));
    const unsigned long long v = *(volatile LAS unsigned long long*)(lds + off);
    const unsigned lo = __builtin_amdgcn_readfirstlane((unsigned)v), hi = __builtin_amdgcn_readfirstlane((unsigned)(v >> 32));
    return (void*)(((unsigned long long)hi << 32) | lo);
}

__device__ __forceinline__ void p0_prologue(LAS unsigned char* lds) {
    PH_IDS
    const int lane = TIDX & 63, wave = TIDX >> 6, gw = BIDX * 8 + wave, ngw = GDIM * 8;
    LAS float* scr = (LAS float*)(lds + wave * 16384);
    unsigned char* ws = (unsigned char*)ldarg(lds, 24);
    const float* a0 = (const float*)ldarg(lds, 0); const float* a1 = (const float*)ldarg(lds, 1); const float* a2 = (const float*)ldarg(lds, 2); const float* a11 = (const float*)ldarg(lds, 11);
    const float* a14 = (const float*)ldarg(lds, 14); const float* a15 = (const float*)ldarg(lds, 15); const float* a16 = (const float*)ldarg(lds, 16); const float* a17 = (const float*)ldarg(lds, 17); const float* a18 = (const float*)ldarg(lds, 18);
    constexpr int I1 = (D / 64) * (2048 / 32), I2 = (SSMW / 64) * (SSMW / 32), I3 = (D / 64) * (D / 32), I4 = I3, IL = I1 + I2 + I3 + I4;
    for (int it = gw; it < DEPTH * IL; it += ngw) {
        const int l = it / IL; int r = it % IL;
        if (r < I1) { p0_transpose_item(a2 + (size_t)l * D * INW, INW, D, 2048, ScVec{a1 + l * D}, (bf16_t*)(ws + WS_BT1) + (size_t)l * 2048 * D, scr, r, lane); continue; } r -= I1;
        if (r < I2) { p0_transpose_item(a11 + (size_t)l * SSMW * SSMW, SSMW, SSMW, SSMW, ScOne{}, (bf16_t*)(ws + WS_BT2) + (size_t)l * SSMW * SSMW, scr, r, lane); continue; } r -= I2;
        if (r < I3) { p0_transpose_item(a16 + (size_t)l * D * D, D, D, D, ScTwo{a14 + l * SSMW, a15 + l * ATTW}, (bf16_t*)(ws + WS_BT3) + (size_t)l * D * D, scr, r, lane); continue; } r -= I3;
        p0_transpose_item(a18 + (size_t)l * D * D, D, D, D, ScVec{a17 + l * D}, (bf16_t*)(ws + WS_BT4) + (size_t)l * D * D, scr, r, lane);
    }
    for (int i = BIDX * 512 + TIDX; i < DEPTH * 16 * D; i += GDIM * 512) {
        const int l = i / (16 * D), j = (i / D) % 16, k = i % D;
        const float v = j < 8 ? a2[((size_t)l * D + k) * INW + 2048 + j] * a1[l * D + k] : 0.f;
        ((bf16_t*)(ws + WS_WF))[i] = f2bf(v);
    }
    {
        const float* x = a0; float* h = (float*)(ws + WS_H); bf16_t* hb = (bf16_t*)(ws + WS_HB); float* ssp1 = (float*)(ws + WS_SSP) + (size_t)T * 32;
        for (int w = gw; w < T; w += ngw) {
            const f32x4* r = (const f32x4*)(x + (size_t)w * D) + lane; f32x4* hr = (f32x4*)(h + (size_t)w * D) + lane; unsigned long long* o = (unsigned long long*)(hb + (size_t)w * D) + lane;
            float s = 0.f;
#pragma unroll
            for (int j = 0; j < 4; ++j) { const f32x4 v = r[64 * j]; hr[64 * j] = v; s += v.x * v.x + v.y * v.y + v.z * v.z + v.w * v.w; o[64 * j] = (unsigned long long)pk2(v.x, v.y) | ((unsigned long long)pk2(v.z, v.w) << 32); }
            s = wave_sum(s);
            if (lane < 8) ssp1[(size_t)w * 8 + lane] = lane == 0 ? s : 0.f;
        }
    }
}

struct SchedGen {
    static constexpr bool DUALB = false; long hB1;
    __device__ __forceinline__ bool sb(const ge::Unit&, int) const { return false; }
    __device__ __forceinline__ unsigned voffB1(int, int) const { return 0u; }
    const char* A; const char* B; int a_row_b, a_c16_b, b_row_b, b_c16_b; long a_pm_b, a_kt_b, b_pn_b, b_kt_b; int nM, nN, nt, G, c; long hA, hB;
    __device__ __forceinline__ void init_plain(const void* A_, int lda_bytes, const void* B_, int ldb_bytes, int M, int N, int K, int G_, int c_) {
        A = (const char*)A_; B = (const char*)B_; a_row_b = lda_bytes; a_c16_b = 32; b_row_b = ldb_bytes; b_c16_b = 32; a_pm_b = 256l * lda_bytes; a_kt_b = 128; b_pn_b = 256l * ldb_bytes; b_kt_b = 128;
        nM = M / 256; nN = N / 256; nt = K / 64; G = G_; c = c_; hA = 128l * lda_bytes; hB = 128l * ldb_bytes; }
    __device__ __forceinline__ bool next(int i, ge::Unit& u) const {
        int pm, pn; if (!ge::static_tile(i, G, c, nM, nN, pm, pn)) return false;
        u.A0 = A + (size_t)pm * a_pm_b; u.B0 = B + (size_t)pn * b_pn_b; u.nt = nt; u.pm = pm; u.pn = pn; u.aux = 0; return true; }
    __device__ __forceinline__ const char* ta(const ge::Unit& u, int t) const { return u.A0 + t * a_kt_b; }
    __device__ __forceinline__ const char* tb(const ge::Unit& u, int t) const { return u.B0 + t * b_kt_b; }
    __device__ __forceinline__ unsigned voffA(int R, int C) const { return (unsigned)(R * a_row_b + (C >> 4) * a_c16_b + (C & 15) * 2); }
    __device__ __forceinline__ unsigned voffB(int Rb, int C) const { return (unsigned)(Rb * b_row_b + (C >> 4) * b_c16_b + (C & 15) * 2); }
};
typedef SchedGen SchedPlain;

constexpr float QSCALE = 0.125f * 1.4426950408889634f;
struct EpiInProj {
    static constexpr bool PERM = true, MIDK = false, UBEGIN = true;
    const float* ssp1; bf16_t* UP; bf16_t* QKV;
    __device__ __forceinline__ void unit_begin(const ge::Unit& u, int tid, LAS unsigned char* rowf) const {
        if (tid < 256) { const int row = u.pm * 256 + tid; ((LAS float*)rowf)[tid] = rsqrtf(sum8(ssp1 + (size_t)row * 8) * (1.f / D) + EPS); }
    }
    __device__ __forceinline__ void midk(ge::f32x4 (&)[2][2][4][2], const ge::Unit&, int, int, LAS unsigned char*) const {}
    __device__ __forceinline__ void operator()(const ge::f32x4 (&acc)[2][2][4][2], const ge::Unit& u, int wr, int wc, int fr, int fq, LAS unsigned char* rowf) const {
        const int row0 = u.pm * 256 + wr * 64 + fr, colt = u.pn * 256, region = colt >> 9;
        bf16_t* dstb = QKV + (size_t)(region - 1) * ((WS_K - WS_Q) / 2);
#pragma unroll
        for (int ai = 0; ai < 2; ++ai)
#pragma unroll
            for (int m = 0; m < 4; ++m) {
                const int row = row0 + ai * 128 + m * 16; const float rs = ((const LAS float*)rowf)[ai * 128 + wr * 64 + m * 16 + fr];
#pragma unroll
                for (int bj = 0; bj < 2; ++bj) {
                    const int c = (colt & 511) + bj * 128 + wc * 32 + 8 * fq;
                    const float rq = region == 1 ? rs * QSCALE : rs;
                    const ge::f32x4 v0 = acc[ai][bj][m][0] * rq, v1 = acc[ai][bj][m][1] * rq;
                    u32x4 w; w.x = ge::cvt_pk_bf16(v0[0], v0[1]); w.y = ge::cvt_pk_bf16(v0[2], v0[3]); w.z = ge::cvt_pk_bf16(v1[0], v1[1]); w.w = ge::cvt_pk_bf16(v1[2], v1[3]);
                    bf16_t* dst = region == 0 ? UP + up_index(row, c) : dstb + (size_t)row * 512 + c;
                    *(u32x4*)dst = w;
                }
            }
    }
};

__device__ __forceinline__ float sum8(const float* p) { const ge::f32x4 a = *(const ge::f32x4*)p, b = *(const ge::f32x4*)(p + 4); return ((a[0] + a[1]) + (a[2] + a[3])) + ((b[0] + b[1]) + (b[2] + b[3])); }
__device__ __forceinline__ float sum16(const float* p) { return sum8(p) + sum8(p + 8); }
__device__ __forceinline__ size_t gel_index(int row, int c) { return ((size_t)(c >> 4) * T + row) * HC + (c & 15); }
__device__ __forceinline__ float sigmoidf_(float x) { return 1.f / (1.f + __expf(-x)); }
struct EpiGlu2 {
    static constexpr bool PERM = true, MIDK = false, UBEGIN = false;
    const bf16_t* GEL; const float* bias; bf16_t* MIX; float* ssp;
    __device__ __forceinline__ void unit_begin(const ge::Unit&, int, LAS unsigned char*) const {}
    __device__ __forceinline__ void midk(ge::f32x4 (&)[2][2][4][2], const ge::Unit&, int, int, LAS unsigned char*) const {}
    __device__ __forceinline__ void operator()(const ge::f32x4 (&acc)[2][2][4][2], const ge::Unit& u, int wr, int wc, int fr, int fq, LAS unsigned char*) const {
        const int row0 = u.pm * 256 + wr * 64 + fr, colt = u.pn * 256;
#pragma unroll
        for (int ai = 0; ai < 2; ++ai)
#pragma unroll
            for (int m = 0; m < 4; ++m) {
                const int row = row0 + ai * 128 + m * 16; float sq = 0.f;
#pragma unroll
                for (int bj = 0; bj < 2; ++bj) {
                    const int c = colt + bj * 128 + wc * 32 + 8 * fq;
                    const ge::f32x4 b0 = *(const ge::f32x4*)(bias + c), b1 = *(const ge::f32x4*)(bias + c + 4);
                    const u32x4 gw = *(const u32x4*)(GEL + gel_index(row, c));
                    const ge::f32x4 v0 = acc[ai][bj][m][0] + b0, v1 = acc[ai][bj][m][1] + b1;
                    float o[8];
                    o[0] = __uint_as_float(gw.x << 16) * sigmoidf_(v0[0]); o[1] = __uint_as_float(gw.x & 0xffff0000u) * sigmoidf_(v0[1]);
                    o[2] = __uint_as_float(gw.y << 16) * sigmoidf_(v0[2]); o[3] = __uint_as_float(gw.y & 0xffff0000u) * sigmoidf_(v0[3]);
                    o[4] = __uint_as_float(gw.z << 16) * sigmoidf_(v1[0]); o[5] = __uint_as_float(gw.z & 0xffff0000u) * sigmoidf_(v1[1]);
                    o[6] = __uint_as_float(gw.w << 16) * sigmoidf_(v1[2]); o[7] = __uint_as_float(gw.w & 0xffff0000u) * sigmoidf_(v1[3]);
#pragma unroll
                    for (int e = 0; e < 8; ++e) sq += o[e] * o[e];
                    u32x4 w; w.x = ge::cvt_pk_bf16(o[0], o[1]); w.y = ge::cvt_pk_bf16(o[2], o[3]); w.z = ge::cvt_pk_bf16(o[4], o[5]); w.w = ge::cvt_pk_bf16(o[6], o[7]);
                    *(u32x4*)(MIX + (size_t)row * D + c) = w;
                }
                sq += __shfl_xor(sq, 16); sq += __shfl_xor(sq, 32);
                if (fq == 0) ssp[(size_t)row * 8 + u.pn * 4 + wc] = sq;
            }
    }
};
struct EpiWo {
    static constexpr bool PERM = false, MIDK = true, UBEGIN = true;
    const float* ssp_s; const float* ssp_a; float* h; bf16_t* hb; float* ssp2;
    typedef float f32x2_ __attribute__((ext_vector_type(2)));
    __device__ __forceinline__ void unit_begin(const ge::Unit& u, int tid, LAS unsigned char* rowf) const {
        if (tid < 256) { const int row = u.pm * 256 + tid;
            const float rs_s = rsqrtf(sum8(ssp_s + (size_t)row * 8) * (1.f / SSMW) + EPS), rs_a = rsqrtf(sum8(ssp_a + (size_t)row * 8) * (1.f / ATTW) + EPS);
            ((LAS f32x2_*)rowf)[tid] = (f32x2_){rs_s / rs_a, rs_a}; }
    }
    __device__ __forceinline__ void midk(ge::f32x4 (&acc)[2][2][4][2], const ge::Unit& u, int wr, int fr, LAS unsigned char* rowf) const {
#pragma unroll
        for (int ai = 0; ai < 2; ++ai)
#pragma unroll
            for (int m = 0; m < 4; ++m) {
                const float f = ((const LAS f32x2_*)rowf)[ai * 128 + wr * 64 + m * 16 + fr].x;
#pragma unroll
                for (int bj = 0; bj < 2; ++bj)
#pragma unroll
                    for (int n = 0; n < 2; ++n) acc[ai][bj][m][n] = acc[ai][bj][m][n] * f;
            }
    }
    __device__ __forceinline__ void operator()(const ge::f32x4 (&acc)[2][2][4][2], const ge::Unit& u, int wr, int wc, int fr, int fq, LAS unsigned char* rowf) const {
        const int row0 = u.pm * 256 + wr * 64 + fr, colt = u.pn * 256;
#pragma unroll
        for (int ai = 0; ai < 2; ++ai)
#pragma unroll
            for (int m = 0; m < 4; ++m) {
                const int row = row0 + ai * 128 + m * 16; const float ra = ((const LAS f32x2_*)rowf)[ai * 128 + wr * 64 + m * 16 + fr].y; float sq = 0.f;
#pragma unroll
                for (int bj = 0; bj < 2; ++bj)
#pragma unroll
                    for (int n = 0; n < 2; ++n) {
                        const int c = colt + bj * 128 + wc * 32 + 16 * n + 4 * fq;
                        float* hp = h + (size_t)row * D + c;
                        ge::f32x4 hv = *(const ge::f32x4*)hp; hv = hv + acc[ai][bj][m][n] * ra;
                        *(ge::f32x4*)hp = hv;
                        sq += hv[0] * hv[0] + hv[1] * hv[1] + hv[2] * hv[2] + hv[3] * hv[3];
                        ge::u32x2 w; w.x = ge::cvt_pk_bf16(hv[0], hv[1]); w.y = ge::cvt_pk_bf16(hv[2], hv[3]);
                        *(ge::u32x2*)(hb + (size_t)row * D + c) = w;
                    }
                sq += __shfl_xor(sq, 16); sq += __shfl_xor(sq, 32);
                if (fq == 0) ssp2[(size_t)row * 16 + u.pn * 4 + wc] = sq;
            }
    }
};
struct EpiWq {
    static constexpr bool PERM = true, MIDK = false, UBEGIN = true;
    const float* ssp2; bf16_t* QP;
    __device__ __forceinline__ void unit_begin(const ge::Unit& u, int tid, LAS unsigned char* rowf) const {
        if (tid < 256) { const int row = u.pm * 256 + tid; ((LAS float*)rowf)[tid] = rsqrtf(sum16(ssp2 + (size_t)row * 16) * (1.f / D) + EPS); }
    }
    __device__ __forceinline__ void midk(ge::f32x4 (&)[2][2][4][2], const ge::Unit&, int, int, LAS unsigned char*) const {}
    __device__ __forceinline__ void operator()(const ge::f32x4 (&acc)[2][2][4][2], const ge::Unit& u, int wr, int wc, int fr, int fq, LAS unsigned char* rowf) const {
        const int row0 = u.pm * 256 + wr * 64 + fr, colt = u.pn * 256;
#pragma unroll
        for (int ai = 0; ai < 2; ++ai)
#pragma unroll
            for (int m = 0; m < 4; ++m) {
                const int row = row0 + ai * 128 + m * 16; const float rs = ((const LAS float*)rowf)[ai * 128 + wr * 64 + m * 16 + fr];
#pragma unroll
                for (int bj = 0; bj < 2; ++bj) {
                    const int c = colt + bj * 128 + wc * 32 + 8 * fq;
                    const ge::f32x4 v0 = acc[ai][bj][m][0] * rs, v1 = acc[ai][bj][m][1] * rs;
                    u32x4 w; w.x = ge::cvt_pk_bf16(v0[0], v0[1]); w.y = ge::cvt_pk_bf16(v0[2], v0[3]); w.z = ge::cvt_pk_bf16(v1[0], v1[1]); w.w = ge::cvt_pk_bf16(v1[2], v1[3]);
                    *(u32x4*)(QP + (size_t)row * D + c) = w;
                }
            }
    }
};

__device__ __forceinline__ void ph_flogit(const bf16_t* __restrict__ hb, const bf16_t* __restrict__ wf, const float* __restrict__ ss, const float* __restrict__ bfv, float* __restrict__ logf) {
    PH_IDS
    const int lane = TIDX & 63, gw = BIDX * 8 + (TIDX >> 6), ngw = GDIM * 8, r16 = lane & 15, q4 = lane >> 4;
    for (int item = gw; item < T / 16; item += ngw) {
        const int tok0 = item * 16;
        ge::f32x4 acc = {0.f, 0.f, 0.f, 0.f};
        const bf16_t* ar = hb + (size_t)(tok0 + r16) * D + q4 * 8; const bf16_t* br = wf + (size_t)r16 * D + q4 * 8;
#pragma unroll 8
        for (int ks = 0; ks < D / 32; ++ks) {
            const bf16x8 a = *(const bf16x8*)(ar + ks * 32), b = *(const bf16x8*)(br + ks * 32);
            acc = __builtin_amdgcn_mfma_f32_16x16x32_bf16(a, b, acc, 0, 0, 0);
        }
        if (r16 < NH) {
            const float bj = bfv[r16];
#pragma unroll
            for (int r = 0; r < 4; ++r) {
                const int tok = tok0 + 4 * q4 + r; const float x = acc[r] * rsqrtf(sum8(ss + (size_t)tok * 8) * (1.f / D) + EPS) + bj;
                logf[(size_t)tok * NH + r16] = fminf(x, 0.f) - log1pf(expf(-fabsf(x)));
            }
        }
    }
}
}
namespace nv {
constexpr float USCALE = 256.f, VSCALE = 16.f;
typedef float f32x2 __attribute__((ext_vector_type(2)));
__device__ __forceinline__ float clamp448(float x) { return fminf(fmaxf(x, -448.f), 448.f); }
__device__ __forceinline__ unsigned pack4_fp8(float a, float b, float c, float d) {
    int w = 0; w = __builtin_amdgcn_cvt_pk_fp8_f32(clamp448(a), clamp448(b), w, false); w = __builtin_amdgcn_cvt_pk_fp8_f32(clamp448(c), clamp448(d), w, true); return (unsigned)w; }

__device__ __forceinline__ void p0_peer_tables(const float* __restrict__ pu, const float* __restrict__ pv, const float* __restrict__ g2, unsigned char* __restrict__ PU8, unsigned char* __restrict__ PV8) {
    PH_IDS
    const size_t n16 = (size_t)DEPTH * NEXP * D / 16;
    for (size_t i = (size_t)BIDX * 512 + TIDX; i < 2 * n16; i += (size_t)GDIM * 512) {
        const bool isv = i >= n16; const size_t j = isv ? i - n16 : i; const size_t e0 = j * 16;
        const float* src = (isv ? pv : pu) + e0;
        const int l = (int)(e0 / ((size_t)NEXP * D)), c = (int)(e0 % D);
        f32x4 x[4];
#pragma unroll
        for (int k = 0; k < 4; ++k) x[k] = *(const f32x4*)(src + 4 * k);
        u32x4 o;
        if (isv) {
#pragma unroll
            for (int k = 0; k < 4; ++k) o[k] = pack4_fp8(x[k].x * VSCALE, x[k].y * VSCALE, x[k].z * VSCALE, x[k].w * VSCALE);
        } else {
#pragma unroll
            for (int k = 0; k < 4; ++k) { const f32x4 g = *(const f32x4*)(g2 + l * D + c + 4 * k) * USCALE; o[k] = pack4_fp8(x[k].x * g.x, x[k].y * g.y, x[k].z * g.z, x[k].w * g.w); }
        }
        *(u32x4*)((isv ? PV8 : PU8) + e0) = o;
    }
}

__device__ __forceinline__ void ph_peer_u(const unsigned char* __restrict__ PU8, const bf16_t* __restrict__ hb, const int* __restrict__ idx, float* __restrict__ partial) {
    PH_IDS
    const int lane = TIDX & 63, wave = TIDX >> 6, r = lane & 15, q = lane >> 4;
    const int slice = BIDX & 7, nblk = GDIM >> 3, gw = (BIDX >> 3) * 8 + wave, ngw = nblk * 8;
    for (int t = gw; t < T; t += ngw) {
        long bop[2][2];
#pragma unroll
        for (int s2 = 0; s2 < 2; ++s2)
#pragma unroll
            for (int hf = 0; hf < 2; ++hf) {
                const u32x4 w = *(const u32x4*)(hb + (size_t)t * D + 128 * slice + 64 * s2 + 16 * q + 8 * hf);
                float x[8];
#pragma unroll
                for (int k = 0; k < 4; ++k) { x[2 * k] = __uint_as_float(w[k] << 16); x[2 * k + 1] = __uint_as_float(w[k] & 0xffff0000u); }
                const unsigned h0 = pack4_fp8(x[0], x[1], x[2], x[3]), h1 = pack4_fp8(x[4], x[5], x[6], x[7]);
                const f32x2 a0 = __builtin_amdgcn_cvt_pk_f32_fp8((int)h0, false), a1 = __builtin_amdgcn_cvt_pk_f32_fp8((int)h0, true), a2 = __builtin_amdgcn_cvt_pk_f32_fp8((int)h1, false), a3 = __builtin_amdgcn_cvt_pk_f32_fp8((int)h1, true);
                const unsigned l0 = pack4_fp8(x[0] - a0.x, x[1] - a0.y, x[2] - a1.x, x[3] - a1.y), l1 = pack4_fp8(x[4] - a2.x, x[5] - a2.y, x[6] - a3.x, x[7] - a3.y);
                const unsigned lo32 = r == 0 ? h0 : (r == 1 ? l0 : 0u), hi32 = r == 0 ? h1 : (r == 1 ? l1 : 0u);
                bop[s2][hf] = (long)(((unsigned long long)hi32 << 32) | lo32);
            }
        int e[8];
#pragma unroll
        for (int m = 0; m < 8; ++m) e[m] = idx[(size_t)t * 128 + 16 * m + r];
        u32x4 a[8][2];
#pragma unroll
        for (int m = 0; m < 8; ++m)
#pragma unroll
            for (int s2 = 0; s2 < 2; ++s2) a[m][s2] = *(const u32x4*)(PU8 + (size_t)e[m] * D + 128 * slice + 64 * s2 + 16 * q);
#pragma unroll
        for (int m = 0; m < 8; ++m) {
            ge::f32x4 acc = {0.f, 0.f, 0.f, 0.f};
#pragma unroll
            for (int s2 = 0; s2 < 2; ++s2) {
                const long alo = (long)(((unsigned long long)a[m][s2].y << 32) | a[m][s2].x), ahi = (long)(((unsigned long long)a[m][s2].w << 32) | a[m][s2].z);
                acc = __builtin_amdgcn_mfma_f32_16x16x32_fp8_fp8(alo, bop[s2][0], acc, 0, 0, 0);
                acc = __builtin_amdgcn_mfma_f32_16x16x32_fp8_fp8(ahi, bop[s2][1], acc, 0, 0, 0);
            }
            ge::f32x4 tot;
#pragma unroll
            for (int i = 0; i < 4; ++i) tot[i] = acc[i] + __shfl_xor(acc[i], 1);
            if (r == 0) *(ge::f32x4*)(partial + ((size_t)slice * T + t) * 128 + 16 * m + 4 * q) = tot;
        }
    }
}

__device__ __forceinline__ void ph_peer_coef(const float* __restrict__ partial, const float* __restrict__ ssp2, const float* __restrict__ gate, float* __restrict__ coef) {
    PH_IDS
    for (size_t i = (size_t)BIDX * 512 + TIDX; i < (size_t)T * 128; i += (size_t)GDIM * 512) {
        const int t = (int)(i >> 7);
        float s = 0.f;
#pragma unroll
        for (int k = 0; k < 8; ++k) s += partial[(size_t)k * T * 128 + i];
        const float rs = rsqrtf(sum16(ssp2 + (size_t)t * 16) * (1.f / D) + EPS);
        coef[i] = gelu_tanh(s * rs * (1.f / USCALE)) * gate[i];
    }
}

__device__ __forceinline__ void ph_peer_v(const unsigned char* __restrict__ PV8, const int* __restrict__ idx, const float* __restrict__ coef, float* __restrict__ h, bf16_t* __restrict__ hb, float* __restrict__ ssp1) {
    PH_IDS
    const int lane = TIDX & 63, wave = TIDX >> 6, c8 = lane & 7, rg = lane >> 3;
    const int slice = BIDX & 7, nblk = GDIM >> 3, gw = (BIDX >> 3) * 8 + wave, ngw = nblk * 8;
    for (int t = gw; t < T; t += ngw) {
        float acc[16];
#pragma unroll
        for (int k = 0; k < 16; ++k) acc[k] = 0.f;
        int e[16]; float cf[16];
#pragma unroll
        for (int i = 0; i < 16; ++i) { e[i] = idx[(size_t)t * 128 + 8 * i + rg]; cf[i] = coef[(size_t)t * 128 + 8 * i + rg]; }
        u32x4 v[16];
#pragma unroll
        for (int i = 0; i < 16; ++i) v[i] = *(const u32x4*)(PV8 + (size_t)e[i] * D + 128 * slice + 16 * c8);
#pragma unroll
        for (int i = 0; i < 16; ++i)
#pragma unroll
            for (int k = 0; k < 4; ++k) {
                const f32x2 p0 = __builtin_amdgcn_cvt_pk_f32_fp8((int)v[i][k], false), p1 = __builtin_amdgcn_cvt_pk_f32_fp8((int)v[i][k], true);
                acc[4 * k] += cf[i] * p0.x; acc[4 * k + 1] += cf[i] * p0.y; acc[4 * k + 2] += cf[i] * p1.x; acc[4 * k + 3] += cf[i] * p1.y;
            }
#pragma unroll
        for (int k = 0; k < 16; ++k) { acc[k] += __shfl_xor(acc[k], 8); acc[k] += __shfl_xor(acc[k], 16); acc[k] += __shfl_xor(acc[k], 32); }
        float sq = 0.f;
        if (rg == 0) {
            float* hp = h + (size_t)t * D + 128 * slice + 16 * c8; bf16_t* bp = hb + (size_t)t * D + 128 * slice + 16 * c8;
            u32x4 w[2];
#pragma unroll
            for (int k = 0; k < 4; ++k) {
                f32x4 hv = *(const f32x4*)(hp + 4 * k);
                hv.x += acc[4 * k] * (1.f / VSCALE); hv.y += acc[4 * k + 1] * (1.f / VSCALE); hv.z += acc[4 * k + 2] * (1.f / VSCALE); hv.w += acc[4 * k + 3] * (1.f / VSCALE);
                *(f32x4*)(hp + 4 * k) = hv; sq += hv.x * hv.x + hv.y * hv.y + hv.z * hv.z + hv.w * hv.w;
                w[k >> 1][(k & 1) * 2] = pk2(hv.x, hv.y); w[k >> 1][(k & 1) * 2 + 1] = pk2(hv.z, hv.w);
            }
            *(u32x4*)bp = w[0]; *(u32x4*)(bp + 8) = w[1];
        }
        sq += __shfl_xor(sq, 1); sq += __shfl_xor(sq, 2); sq += __shfl_xor(sq, 4);
        if (lane == 0) ssp1[(size_t)t * 8 + slice] = sq;
    }
}

__device__ __forceinline__ void ph_final(const float* __restrict__ h, const float* __restrict__ ssp1, const float* __restrict__ g, float* __restrict__ out) {
    PH_IDS
    const int lane = TIDX & 63, gw = BIDX * 8 + (TIDX >> 6), ngw = GDIM * 8;
    for (int w = gw; w < T; w += ngw) {
        const float rs = rsqrtf(sum8(ssp1 + (size_t)w * 8) * (1.f / D) + EPS);
        const f32x4* r = (const f32x4*)(h + (size_t)w * D) + lane; const f32x4* gg = (const f32x4*)g + lane; f32x4* o = (f32x4*)(out + (size_t)w * D) + lane;
#pragma unroll
        for (int j = 0; j < 4; ++j) { const f32x4 v = r[64 * j], gv = gg[64 * j]; o[64 * j] = v * rs * gv; }
    }
}
}
namespace attn_body {
using bf16=__hip_bfloat16;
using bf16x8=__attribute__((ext_vector_type(8)))short;
using s16x4=__attribute__((ext_vector_type(4)))short;
using f32x16=__attribute__((ext_vector_type(16)))float;
using u32x4=__attribute__((ext_vector_type(4)))unsigned;
constexpr int BATCH=8,NHEAD=8,SEQ=4096,D=64,DM=NHEAD*D;
constexpr int OPITCH=1024,OCOL=512;
constexpr int NW=8,QBLK=32,QB=QBLK*NW,KVBLK=64,NQB=SEQ/QB;
constexpr int ATTN_PITCH=DM, ATTN_UNIT_ROWS=QB;
__device__ __forceinline__ int crow(int r,int hi){return (r&3)+8*(r>>2)+4*hi;}
#define SBAR() __builtin_amdgcn_sched_barrier(0)
__device__ __forceinline__ void cmask(f32x16&p0,f32x16&p1,int jb,int qrel,int hi){
  const float NEG=-INFINITY; int kb=64*jb+4*hi;
  #pragma unroll
  for(int r=0;r<16;++r){int kv=kb+(r&3)+8*(r>>2); if(kv>qrel)p0[r]=NEG; if(kv+32>qrel)p1[r]=NEG;}
}

constexpr int NSLOT=3, SLOTB=8192;
constexpr int LDS_K=0, LDS_V=NSLOT*SLOTB, LDS_WS=2*NSLOT*SLOTB, LDS_OST=LDS_WS+NW*64*4, LDS_CUM=LDS_OST+NW*4096, LDS_BYTES=LDS_CUM+SEQ*4;
constexpr float C2=0.125f*1.4426950408889634f;
__device__ __forceinline__ void glds16(const void*gsrc,unsigned lds_dst){unsigned keep;
  asm volatile("s_mov_b32 %0, m0\n\ts_mov_b32 m0, %2\n\ts_nop 0\n\tglobal_load_lds_dwordx4 %1, off\n\ts_mov_b32 m0, %0":"=&s"(keep):"v"(gsrc),"s"(lds_dst):"memory");}
__device__ __forceinline__ float max3f(float a,float b,float c){float r;asm("v_max3_f32 %0, %1, %2, %3":"=v"(r):"v"(a),"v"(b),"v"(c));return r;}
__device__ __forceinline__ float max2f(float a,float b){float r;asm("v_max_f32_e32 %0, %1, %2":"=v"(r):"v"(a),"v"(b));return r;}
__device__ __forceinline__ float fadd_s(float a,float b){float r;asm("v_add_f32_e32 %0, %1, %2":"=v"(r):"v"(a),"v"(b));return r;}
__device__ __forceinline__ float fsub_s(float a,float b){float r;asm("v_sub_f32_e32 %0, %1, %2":"=v"(r):"v"(a),"v"(b));return r;}
typedef float f32x4_t __attribute__((ext_vector_type(4)));
typedef float f32x2_t __attribute__((ext_vector_type(2))); typedef __bf16 bf16x2_t __attribute__((ext_vector_type(2)));
__device__ __forceinline__ unsigned cvtpk_s(float lo,float hi){f32x2_t v={lo,hi};bf16x2_t b=__builtin_convertvector(v,bf16x2_t);return __builtin_bit_cast(unsigned,b);}
#define WAIT_BAR(N) asm volatile("s_waitcnt vmcnt(" #N ") lgkmcnt(0)\n\ts_barrier":::"memory")

__device__ __forceinline__ void qkt(f32x16&p0,f32x16&p1,const char*Kslot,const bf16x8*qr,const f32x16&negm,int r32,int hi){
  const char*kb=Kslot+hi*1024+r32*16;
  #pragma unroll
  for(int d0=0;d0<4;++d0){
    const bf16x8 b0=*reinterpret_cast<const bf16x8*>(kb+d0*2048);
    const bf16x8 b1=*reinterpret_cast<const bf16x8*>(kb+d0*2048+512);
    if(d0==0){p0=__builtin_amdgcn_mfma_f32_32x32x16_bf16(b0,qr[0],negm,0,0,0);p1=__builtin_amdgcn_mfma_f32_32x32x16_bf16(b1,qr[0],negm,0,0,0);}
    else{p0=__builtin_amdgcn_mfma_f32_32x32x16_bf16(b0,qr[d0],p0,0,0,0);p1=__builtin_amdgcn_mfma_f32_32x32x16_bf16(b1,qr[d0],p1,0,0,0);}}
}
typedef __attribute__((address_space(3))) const char* lds_cptr;
typedef short v4i16_t __attribute__((ext_vector_type(4)));
__device__ __forceinline__ void kload8(bf16x8*kf,lds_cptr kp){
  kf[0]=*(const __attribute__((address_space(3))) bf16x8*)(kp);      kf[1]=*(const __attribute__((address_space(3))) bf16x8*)(kp+512);
  kf[2]=*(const __attribute__((address_space(3))) bf16x8*)(kp+2048); kf[3]=*(const __attribute__((address_space(3))) bf16x8*)(kp+2560);
  kf[4]=*(const __attribute__((address_space(3))) bf16x8*)(kp+4096); kf[5]=*(const __attribute__((address_space(3))) bf16x8*)(kp+4608);
  kf[6]=*(const __attribute__((address_space(3))) bf16x8*)(kp+6144); kf[7]=*(const __attribute__((address_space(3))) bf16x8*)(kp+6656);
}
__device__ __forceinline__ void kload2(bf16x8*kf,lds_cptr kp,int j){ kf[2*j]=*(const __attribute__((address_space(3))) bf16x8*)(kp+j*2048); kf[2*j+1]=*(const __attribute__((address_space(3))) bf16x8*)(kp+j*2048+512); }
__device__ __forceinline__ s16x4 vtr(lds_cptr p){ return __builtin_bit_cast(s16x4,__builtin_amdgcn_ds_read_tr16_b64_v4i16((__attribute__((address_space(3))) v4i16_t*)p)); }
__device__ __forceinline__ float rowmax(const f32x16&p0,const f32x16&p1){
  float a=max3f(p0[0],p0[1],p1[0]),b=max3f(p0[2],p0[3],p1[1]);a=max3f(a,p1[2],p1[3]);
  #pragma unroll
  for(int r=4;r<16;r+=4){a=max3f(a,p0[r],p0[r+1]);b=max3f(b,p0[r+2],p0[r+3]);a=max3f(a,p1[r],p1[r+1]);b=max3f(b,p1[r+2],p1[r+3]);}
  const float m=max2f(a,b);
  auto rr=__builtin_amdgcn_permlane32_swap(__float_as_uint(m),__float_as_uint(m),false,false);
  return max2f(__uint_as_float(rr[0]),__uint_as_float(rr[1]));
}
__device__ __forceinline__ void pv(f32x16*o,int vb,bf16x8 pa0,bf16x8 pa1,bf16x8 pa2,bf16x8 pa3){
  #pragma unroll
  for(int d0=0;d0<2;++d0){s16x4 lo[4],hi[4];
    #pragma unroll
    for(int ks=0;ks<4;++ks){
      asm volatile("ds_read_b64_tr_b16 %0,%1 offset:%c2":"=&v"(lo[ks]):"v"(vb),"i"(d0*4096+ks*1024):"memory");
      asm volatile("ds_read_b64_tr_b16 %0,%1 offset:%c2":"=&v"(hi[ks]):"v"(vb),"i"(d0*4096+ks*1024+512):"memory");}
    asm volatile("s_waitcnt lgkmcnt(0)":::"memory");SBAR();
    #define PK(k) (bf16x8){lo[k][0],lo[k][1],lo[k][2],lo[k][3],hi[k][0],hi[k][1],hi[k][2],hi[k][3]}
    o[d0]=__builtin_amdgcn_mfma_f32_32x32x16_bf16(pa0,PK(0),o[d0],0,0,0);
    o[d0]=__builtin_amdgcn_mfma_f32_32x32x16_bf16(pa1,PK(1),o[d0],0,0,0);
    o[d0]=__builtin_amdgcn_mfma_f32_32x32x16_bf16(pa2,PK(2),o[d0],0,0,0);
    o[d0]=__builtin_amdgcn_mfma_f32_32x32x16_bf16(pa3,PK(3),o[d0],0,0,0);
    #undef PK
  }
}

#ifndef ATTN_STORE16
#define ATTN_STORE16(p,v) (*(u32x4*)(p)=(v))
#endif
template<int THRL> __device__ __forceinline__ void attn_unit(int b,int h,int qb,const bf16*Q,const bf16*__restrict__ K,const bf16*__restrict__ V,const float*__restrict__ cum2,bf16*O,float*__restrict__ ssp,char*shm,int tid_){
  int tid=tid_; asm volatile("":"+v"(tid)); const int lane=tid&63,r32=lane&31,hi=lane>>5; const int wid=__builtin_amdgcn_readfirstlane(tid>>6);
  const long rowbase=(long)b*SEQ; const int q0=qb*QB;
  const bf16*Qw=Q+(rowbase+q0+wid*QBLK)*DM+h*D;
  const bf16*Kh=K+rowbase*DM+h*D,*Vh=V+rowbase*DM+h*D;
  const unsigned lds0=(unsigned)(uintptr_t)shm;
  float*wsf=(float*)(shm+LDS_WS)+wid*64;
  const bf16*ksrc=Kh+(long)lane*DM+wid*8;
  const bf16*vsrc=Vh+(long)(16*(wid&3)+(lane>>2))*DM+(wid>>2)*32+(lane&3)*8;
  const unsigned kdst=lds0+LDS_K+wid*1024, vdst=lds0+LDS_V+wid*1024;
  #define DMA_K(t,slot) glds16(ksrc+(long)(t)*KVBLK*DM,(unsigned)__builtin_amdgcn_readfirstlane(kdst+(slot)))
  #define DMA_V(t,slot) glds16(vsrc+(long)(t)*KVBLK*DM,(unsigned)__builtin_amdgcn_readfirstlane(vdst+(slot)))
  const int vb0=(int)(lds0+LDS_V)+((lane>>4)&1)*32+(lane&3)*8+(4*hi+((lane&15)>>2))*64;
  const char*Kbase=shm+LDS_K; bf16x8 kf[8];
  const lds_cptr shm3=(lds_cptr)shm; const lds_cptr kp0=shm3+LDS_K+hi*1024+r32*16; const lds_cptr vp0=shm3+LDS_V+((lane>>4)&1)*32+(lane&3)*8+(4*hi+((lane&15)>>2))*64;
  { float*cl=(float*)(shm+LDS_CUM); const float*cg=cum2+(long)(b*NHEAD+h)*SEQ; for(int i=tid;i<q0+QB;i+=NW*64)cl[i]=cg[i]; }
  const float cq2=cum2[(long)(b*NHEAD+h)*SEQ+q0+wid*QBLK+r32];
  const __attribute__((address_space(3))) float* ckl=(const __attribute__((address_space(3))) float*)(shm3+LDS_CUM)+4*hi;
  #define BIAS(P0,P1,t) do{ const __attribute__((address_space(3))) float*ck_=ckl+64*(t); const float mm_=mhat-cq2; _Pragma("unroll") for(int g_=0;g_<4;++g_){ \
      const f32x4_t c0_=*(const __attribute__((address_space(3))) f32x4_t*)(ck_+8*g_)+mm_, c1_=*(const __attribute__((address_space(3))) f32x4_t*)(ck_+32+8*g_)+mm_; \
      _Pragma("unroll") for(int i_=0;i_<4;++i_){P0[4*g_+i_]-=c0_[i_];P1[4*g_+i_]-=c1_[i_];} SBAR(); } }while(0)
  const int NT=(q0+QB)/KVBLK;
  DMA_K(0,0);DMA_V(0,0);DMA_K(1,SLOTB);
  bf16x8 qr[4];
  #pragma unroll
  for(int d0=0;d0<4;++d0)qr[d0]=*reinterpret_cast<const bf16x8*>(&Qw[(long)r32*DM+d0*16+hi*8]);
  float mhat=0.f,l_reg=0.f;f32x16 o[2];o[0]=f32x16{};o[1]=f32x16{};const f32x16 negm=f32x16{};
  const int qrel=wid*QBLK+r32;
  #define CMASK(P0,P1,t) do{int jb_=(t)-(NT-4); if(jb_>=0)cmask(P0,P1,jb_,qrel,hi);}while(0)
  bool resc=false;
  #define START(P0,P1) do{ const float rm=rowmax(P0,P1); resc=false; \
    { const float dl=rm; mhat=fadd_s(mhat,dl); \
      _Pragma("unroll") for(int r=0;r<16;++r){P0[r]=fsub_s(P0[r],dl);P1[r]=fsub_s(P1[r],dl);} \
      } \
    _Pragma("unroll") for(int r=0;r<16;++r)P0[r]=__builtin_amdgcn_exp2f(P0[r]); }while(0)
  #define RESC() do{ if(resc){ asm volatile("s_waitcnt lgkmcnt(0)":::"memory"); \
      _Pragma("unroll") for(int d_=0;d_<2;++d_) _Pragma("unroll") for(int r=0;r<16;++r)o[d_][r]*=wsf[crow(r,hi)]; } }while(0)
  f32x16 pA0,pA1,pB0,pB1;
  int sl_prev=0,sl_cur=0,sl_next=SLOTB;
  #define ROT() do{sl_prev=sl_cur;sl_cur=sl_next;sl_next=(sl_next==(NSLOT-1)*SLOTB)?0:sl_next+SLOTB;}while(0)
  DMA_K(2,2*SLOTB);
  WAIT_BAR(3);
  qkt(pA0,pA1,Kbase,qr,negm,r32,hi);asm volatile("s_nop 15\n\ts_nop 7":"+v"(pA0),"+v"(pA1));BIAS(pA0,pA1,0);CMASK(pA0,pA1,0);
  START(pA0,pA1);
  _Pragma("unroll") for(int r=0;r<16;++r)pA1[r]=__builtin_amdgcn_exp2f(pA1[r]);
  WAIT_BAR(0);
  DMA_K(3,0);DMA_V(1,SLOTB);
  ROT();
  kload8(kf,kp0+sl_cur);
  WAIT_BAR(2);
  s16x4 vlo[8],vhi[8]; u32x4 pw0,pw1,pw2,pw3;
  #define PKW(P,B) cvtpk_s(P[B],P[B+1])
  #define PAF(k) __builtin_bit_cast(bf16x8,pw##k)
  #define VFR(i) (bf16x8){vlo[i][0],vlo[i][1],vlo[i][2],vlo[i][3],vhi[i][0],vhi[i][1],vhi[i][2],vhi[i][3]}
  #define PIN(x) asm volatile("":"+v"(x))
  #define MX3(a,b,c) __builtin_fmaxf(__builtin_fmaxf((a),(b)),(c))
  #define GAPA(MF,A0,A1,A2,A3,W0,W1,PW) do{ MF; sacc+=A0; sacc+=A1; sacc+=A2; sacc+=A3; PIN(sacc); W0; W1; PIN(PW); SBAR(); }while(0)
  #define EX(v) __builtin_amdgcn_exp2f(v)
  #define GAPB(MF,X,B) do{ MF; X[B]=EX(X[B]); X[B+1]=EX(X[B+1]); X[B+2]=EX(X[B+2]); X[B+3]=EX(X[B+3]); PIN(X); SBAR(); }while(0)
  #define VRD(i) do{ vlo[i]=vtr(vp_+(((i)>>2)*4096+((i)&3)*1024)); vhi[i]=vtr(vp_+(((i)>>2)*4096+((i)&3)*1024+512)); }while(0)
  #define KRD(G,j) do{ if(G){ kload2(kf,kp0+sl_next,j); SBAR(); } }while(0)
  #define STEP(C0,C1,P0,P1,t,GK,GV,GL) do{ SBAR(); \
    const lds_cptr vp_=vp0+sl_prev; \
    VRD(0); SBAR(); float sacc=(P0[0]+P0[1]); \
    GAPA(C0=__builtin_amdgcn_mfma_f32_32x32x16_bf16(kf[0],qr[0],negm,0,0,0), P0[2],P0[3],P0[4],P0[5],     pw0[0]=PKW(P0,0), pw0[1]=PKW(P0,2), pw0); \
    VRD(4); SBAR(); GAPA(C1=__builtin_amdgcn_mfma_f32_32x32x16_bf16(kf[1],qr[0],negm,0,0,0), P0[6],P0[7],P0[8],P0[9],     pw0[2]=PKW(P0,4), pw0[3]=PKW(P0,6), pw0); \
    VRD(1); SBAR(); GAPA(C0=__builtin_amdgcn_mfma_f32_32x32x16_bf16(kf[2],qr[1],C0,0,0,0),   P0[10],P0[11],P0[12],P0[13], pw1[0]=PKW(P0,8), pw1[1]=PKW(P0,10), pw1); \
    VRD(5); SBAR(); GAPA(C1=__builtin_amdgcn_mfma_f32_32x32x16_bf16(kf[3],qr[1],C1,0,0,0),   P0[14],P0[15],P1[0],P1[1],   pw1[2]=PKW(P0,12),pw1[3]=PKW(P0,14), pw1); \
    VRD(2); SBAR(); GAPA(C0=__builtin_amdgcn_mfma_f32_32x32x16_bf16(kf[4],qr[2],C0,0,0,0),   P1[2],P1[3],P1[4],P1[5],     pw2[0]=PKW(P1,0), pw2[1]=PKW(P1,2), pw2); \
    VRD(6); SBAR(); GAPA(C1=__builtin_amdgcn_mfma_f32_32x32x16_bf16(kf[5],qr[2],C1,0,0,0),   P1[6],P1[7],P1[8],P1[9],     pw2[2]=PKW(P1,4), pw2[3]=PKW(P1,6), pw2); \
    VRD(3); SBAR(); GAPA(C0=__builtin_amdgcn_mfma_f32_32x32x16_bf16(kf[6],qr[3],C0,0,0,0),   P1[10],P1[11],P1[12],P1[13], pw3[0]=PKW(P1,8), pw3[1]=PKW(P1,10), pw3); \
    VRD(7); SBAR(); GAPA(C1=__builtin_amdgcn_mfma_f32_32x32x16_bf16(kf[7],qr[3],C1,0,0,0),   P1[14],P1[15],0.f,0.f,       pw3[2]=PKW(P1,12),pw3[3]=PKW(P1,14), pw3); \
    l_reg+=sacc; \
    if(GK){DMA_K((t)+3,sl_cur);} if(GV){DMA_V((t)+1,sl_next);} \
    BIAS(C0,C1,t); CMASK(C0,C1,t); \
    { float a=MX3(C0[0],C0[1],C1[0]),b=MX3(C0[2],C0[3],C1[1]); a=MX3(a,C1[2],C1[3]); \
      _Pragma("unroll") for(int r=4;r<16;r+=4){a=MX3(a,C0[r],C0[r+1]);b=MX3(b,C0[r+2],C0[r+3]);a=MX3(a,C1[r],C1[r+1]);b=MX3(b,C1[r+2],C1[r+3]);} \
      float rm=__builtin_fmaxf(a,b); { auto rr=__builtin_amdgcn_permlane32_swap(__float_as_uint(rm),__float_as_uint(rm),false,false); rm=__builtin_fmaxf(__uint_as_float(rr[0]),__uint_as_float(rr[1])); } \
      resc=false; \
      if(__builtin_expect(__any(rm>(float)THRL),0)){ const float dl=__builtin_fmaxf(rm,0.f); mhat+=dl; \
        _Pragma("unroll") for(int r=0;r<16;++r){C0[r]-=dl;C1[r]-=dl;} \
        const float f=__builtin_amdgcn_exp2f(-dl); l_reg*=f; if(hi==0)wsf[r32]=f; resc=true; } } \
    SBAR(); \
    GAPB(o[0]=__builtin_amdgcn_mfma_f32_32x32x16_bf16(PAF(0),VFR(0),o[0],0,0,0), C0,0); \
    GAPB(o[1]=__builtin_amdgcn_mfma_f32_32x32x16_bf16(PAF(0),VFR(4),o[1],0,0,0), C0,4); \
    KRD(GL,0); GAPB(o[0]=__builtin_amdgcn_mfma_f32_32x32x16_bf16(PAF(1),VFR(1),o[0],0,0,0), C0,8); \
    KRD(GL,1); GAPB(o[1]=__builtin_amdgcn_mfma_f32_32x32x16_bf16(PAF(1),VFR(5),o[1],0,0,0), C0,12); \
    KRD(GL,2); GAPB(o[0]=__builtin_amdgcn_mfma_f32_32x32x16_bf16(PAF(2),VFR(2),o[0],0,0,0), C1,0); \
    KRD(GL,3); GAPB(o[1]=__builtin_amdgcn_mfma_f32_32x32x16_bf16(PAF(2),VFR(6),o[1],0,0,0), C1,4); \
    GAPB(o[0]=__builtin_amdgcn_mfma_f32_32x32x16_bf16(PAF(3),VFR(3),o[0],0,0,0), C1,8); \
    GAPB(o[1]=__builtin_amdgcn_mfma_f32_32x32x16_bf16(PAF(3),VFR(7),o[1],0,0,0), C1,12); \
    }while(0)
  int t=1;
  #undef CMASK
  #define CMASK(P0,P1,t) do{}while(0)
  for(;t+5<NT;t+=2){
    STEP(pB0,pB1,pA0,pA1,t,true,true,true);     WAIT_BAR(2); RESC(); ROT();
    STEP(pA0,pA1,pB0,pB1,t+1,true,true,true);   WAIT_BAR(2); RESC(); ROT();
  }
  #undef CMASK
  #define CMASK(P0,P1,t) do{int jb_=(t)-(NT-4); if(jb_>=0)cmask(P0,P1,jb_,qrel,hi);}while(0)
  #define ENDW(tt) do{ if((tt)+3<NT){WAIT_BAR(2);} else if((tt)+2<NT){WAIT_BAR(1);} else {WAIT_BAR(0);} }while(0)
  for(;t+1<NT;t+=2){
    STEP(pB0,pB1,pA0,pA1,t,(t+3<NT),(t+1<NT),(t+1<NT));       ENDW(t);   RESC(); ROT();
    STEP(pA0,pA1,pB0,pB1,t+1,(t+4<NT),(t+2<NT),(t+2<NT));     ENDW(t+1); RESC(); ROT();
  }
  STEP(pB0,pB1,pA0,pA1,NT-1,false,false,false); RESC();
  { float sacc=pB0[0]+pB0[1]; _Pragma("unroll") for(int r=2;r<16;++r)sacc+=pB0[r]; _Pragma("unroll") for(int r=0;r<16;++r)sacc+=pB1[r]; l_reg+=sacc;
    pw0=(u32x4){PKW(pB0,0),PKW(pB0,2),PKW(pB0,4),PKW(pB0,6)};pw1=(u32x4){PKW(pB0,8),PKW(pB0,10),PKW(pB0,12),PKW(pB0,14)};pw2=(u32x4){PKW(pB1,0),PKW(pB1,2),PKW(pB1,4),PKW(pB1,6)};pw3=(u32x4){PKW(pB1,8),PKW(pB1,10),PKW(pB1,12),PKW(pB1,14)};
    SBAR(); pv(o,vb0+sl_cur,PAF(0),PAF(1),PAF(2),PAF(3)); }
  #undef PKW
  #undef PAF
  #undef VFR
  #undef PIN
  #undef MX3
  #undef GAPA
  #undef GAPB
  #undef EX
  #undef VRD
  #undef KRD
  #undef STEP
  #undef ENDW
  {auto rr=__builtin_amdgcn_permlane32_swap(__float_as_uint(l_reg),__float_as_uint(l_reg),false,false);l_reg=__uint_as_float(rr[0])+__uint_as_float(rr[1]);}
  if(hi==0)wsf[32+r32]=l_reg;asm volatile("s_waitcnt lgkmcnt(0)":::"memory");
  float rli[16];
  #pragma unroll
  for(int r=0;r<16;++r)rli[r]=__builtin_amdgcn_rcpf(wsf[32+crow(r,hi)]);
  int lane_e=lane; asm volatile("":"+v"(lane_e));
  bf16*Ow=O+(rowbase+q0+wid*QBLK)*OPITCH+OCOL+h*D; float*sw=ssp+(rowbase+q0+wid*QBLK)*8+h;
  { bf16*stg=(bf16*)(shm+LDS_OST)+wid*2048;
    #pragma unroll
    for(int r=0;r<16;++r){const int orow=crow(r,hi);
      #pragma unroll
      for(int d0=0;d0<2;++d0)stg[orow*64+d0*32+r32]=__float2bfloat16(o[d0][r]*rli[r]);}
    asm volatile("s_waitcnt lgkmcnt(0)":::"memory");
    #pragma unroll
    for(int i=0;i<4;++i){const int row=i*8+(lane_e>>3),ch=lane_e&7; const u32x4 v=*(const u32x4*)(stg+row*64+ch*8); ATTN_STORE16(Ow+(long)row*OPITCH+ch*8,v);
      float sq=0.f;
      #pragma unroll
      for(int k=0;k<4;++k){const float a=__uint_as_float(v[k]<<16),c=__uint_as_float(v[k]&0xffff0000u);sq+=a*a+c*c;}
      sq+=__shfl_xor(sq,1);sq+=__shfl_xor(sq,2);sq+=__shfl_xor(sq,4);
      if(ch==0)sw[(long)row*8]=sq; } }
  asm volatile("s_waitcnt lgkmcnt(0)\n\ts_barrier":::"memory");
  #undef DMA_K
  #undef DMA_V
  #undef CMASK
  #undef START
  #undef RESC
  #undef BIAS
  #undef ROT
}
constexpr int ATTN_LDS_BYTES=LDS_BYTES;
template<int THRL=8> __device__ __forceinline__ void attn_phase(char*lds,const bf16*Q,const bf16*K,const bf16*V,const float*cum2,bf16*O,float*ssp,int tid,int bid,int grid){
  const int vcu=(grid%8==0)?(bid%8)*(grid/8)+bid/8:bid;
  for(int v=vcu;v<BATCH*NHEAD*4;v+=grid){ const int bh=v>>2,s=v&3;
    #pragma unroll 1
    for(int i=0;i<4;++i){ const int qb=(i==0)?s:(i==1)?7-s:(i==2)?8+s:15-s; attn_unit<THRL>(bh/NHEAD,bh%NHEAD,qb,Q,K,V,cum2,O,ssp,lds,tid); } }
}
#undef SBAR
#undef WAIT_BAR
}
namespace nv {
typedef float f32x2v __attribute__((ext_vector_type(2)));
constexpr size_t WS_APOW = 921 * MiB;
constexpr size_t WS_BBAR = 89 * MiB;
constexpr int KDW = 128 * 256;
__device__ __forceinline__ void p0_ssm_a(const float* __restrict__ lam_re, const float* __restrict__ lam_im, const float* __restrict__ log_dt, const float* __restrict__ b_re, const float* __restrict__ b_im,
                                         f32x2v* __restrict__ apow, f32x2v* __restrict__ bbar) {
    PH_IDS
    for (int i = BIDX * 512 + TIDX; i < DEPTH * G * P; i += GDIM * 512) {
        const int lg = i / P, p = i % P;
        const float dtf = expf(log_dt[lg]); const float lr = lam_re[i], li = lam_im[i];
        const double ang = (double)li * (double)dtf, k2 = rint(ang * 0.15915494309189535), red = ang - k2 * 6.283185307179586;
        const float mag = expf(lr * dtf), rr = (float)red; const double are = (double)(mag * cosf(rr)), aim = (double)(mag * sinf(rr));
        double pr = 1.0, pi = 0.0;
        for (int d = 0; d <= 64; ++d) { apow[((size_t)lg * 65 + d) * P + p] = (f32x2v){(float)pr, (float)pi}; const double nr_ = pr * are - pi * aim, ni_ = pr * aim + pi * are; pr = nr_; pi = ni_; }
        const double lrd = lr, lid = li, den = lrd * lrd + lid * lid, nr = are - 1.0, zre = (nr * lrd + aim * lid) / den, zim = (aim * lrd - nr * lid) / den;
        for (int h = 0; h < HC; ++h) { const double br = b_re[(size_t)i * HC + h], bi = b_im[(size_t)i * HC + h]; bbar[(size_t)i * HC + h] = (f32x2v){(float)(zre * br - zim * bi), (float)(zre * bi + zim * br)}; }
    }
}
__device__ __forceinline__ void p0_ssm_b(const f32x2v* __restrict__ apow, const f32x2v* __restrict__ bbar, const float* __restrict__ c_re, const float* __restrict__ c_im, const float* __restrict__ dsk,
                                         bf16_t* __restrict__ KD, bf16_t* __restrict__ WST, bf16_t* __restrict__ WOUT) {
    PH_IDS
    const int gt = BIDX * 512 + TIDX, nth = GDIM * 512;
    for (int i = gt; i < DEPTH * G * KDW; i += nth) {
        const int lg = i / KDW, r = i % KDW, dd = r >> 8, h = (r >> 4) & 15, h2 = r & 15, d = dd - 63;
        float v = 0.f;
        if (d >= 0 && dd < 127) {
            const f32x2v* ap = apow + ((size_t)lg * 65 + d) * P; const f32x2v* bb = bbar + (size_t)lg * P * HC + h2; const float* cr = c_re + ((size_t)lg * HC + h) * P; const float* ci = c_im + ((size_t)lg * HC + h) * P;
            for (int p = 0; p < P; ++p) { const f32x2v a = ap[p], b = bb[(size_t)p * HC]; const float wr = a.x * b.x - a.y * b.y, wi = a.x * b.y + a.y * b.x; v += cr[p] * wr - ci[p] * wi; }
            if (d == 0 && h == h2) v += dsk[lg * HC + h];
        }
        KD[i] = f2bf(v);
    }
    for (int i = gt; i < DEPTH * G * 128 * 256; i += nth) {
        const int lg = i >> 15, r = i & 32767, row = r >> 8, k = r & 255, j = k >> 4, h2 = k & 15, p = row & 63;
        const f32x2v a = apow[((size_t)lg * 65 + (15 - j)) * P + p], b = bbar[((size_t)lg * P + p) * HC + h2];
        WST[i] = f2bf(row < 64 ? a.x * b.x - a.y * b.y : a.x * b.y + a.y * b.x);
    }
    for (int i = gt; i < DEPTH * G * 1024 * 128; i += nth) {
        const int lg = i >> 17, r = i & 131071, row = r >> 7, k = r & 127, ti = row >> 4, h = row & 15, p = k & 63;
        const f32x2v e = apow[((size_t)lg * 65 + ti + 1) * P + p]; const float cr = c_re[((size_t)lg * HC + h) * P + p], ci = c_im[((size_t)lg * HC + h) * P + p];
        WOUT[i] = f2bf(k < 64 ? cr * e.x - ci * e.y : -(cr * e.y + ci * e.x));
    }
}

struct SchedSsmS {
    static constexpr bool DUALB = false; long hA, hB, hB1;
    const char* UP; const char* WST; int G_, c;
    __device__ __forceinline__ void init(const void* up, const void* wst_l, int grid, int bid) { UP = (const char*)up; WST = (const char*)wst_l; G_ = grid; c = bid; hA = 128l * UPW * 2; hB = 0; hB1 = 0; }
    __device__ __forceinline__ bool next(int i, ge::Unit& u) const {
        const int L = i * G_ + c; if (L >= G * 2 * 4) return false;
        const int g = L >> 3, pm = (L >> 2) & 1, ks = L & 3;
        u.A0 = UP + (((size_t)g * NCH + pm * 256) * UPW + 128 + ks * 256) * 2; u.B0 = WST + (size_t)g * 128 * 256 * 2; u.nt = 4; u.pm = pm; u.pn = ks; u.aux = g; return true; }
    __device__ __forceinline__ const char* ta(const ge::Unit& u, int t) const { return u.A0 + t * 128; }
    __device__ __forceinline__ const char* tb(const ge::Unit& u, int t) const { return u.B0 + t * 128; }
    __device__ __forceinline__ bool sb(const ge::Unit&, int) const { return false; }
    __device__ __forceinline__ unsigned voffA(int R, int C) const { return (unsigned)(R * UPW * 2 + C * 2); }
    __device__ __forceinline__ unsigned voffB(int Rb, int C) const { return (unsigned)(Rb * 512 + C * 2); }
    __device__ __forceinline__ unsigned voffB1(int, int) const { return 0u; }
};
struct EpiSsmS {
    static constexpr bool PERM = false, MIDK = false, UBEGIN = false;
    float* SLOC;
    __device__ __forceinline__ void unit_begin(const ge::Unit&, int, LAS unsigned char*) const {}
    __device__ __forceinline__ void midk(ge::f32x4 (&)[2][2][4][2], const ge::Unit&, int, int, LAS unsigned char*) const {}
    __device__ __forceinline__ void operator()(const ge::f32x4 (&acc)[2][2][4][2], const ge::Unit& u, int wr, int wc, int fr, int fq, LAS unsigned char*) const {
        const int g = u.aux, ks = u.pn;
#pragma unroll
        for (int ai = 0; ai < 2; ++ai)
#pragma unroll
            for (int m = 0; m < 4; ++m) {
                const int chunk = u.pm * 256 + ai * 128 + wr * 64 + m * 16 + fr; float* dst = SLOC + ((size_t)g * (NCH * 4) + chunk * 4 + ks) * 128;
#pragma unroll
                for (int n = 0; n < 2; ++n) *(ge::f32x4*)(dst + wc * 32 + 16 * n + 4 * fq) = acc[ai][0][m][n];
            }
    }
};

__device__ __forceinline__ void ph_ssm_prefix(const float* __restrict__ SLOC, const f32x2v* __restrict__ apow_l, bf16_t* __restrict__ UP) {
    PH_IDS
    const int p = TIDX & 63, wv = TIDX >> 6;
    for (int item = BIDX + GDIM * wv; item < BATCH * G; item += GDIM * 8) {
        const int b = item / G, g = item % G;
        const f32x2v a16 = apow_l[((size_t)g * 65 + 16) * P + p];
        const float* src = SLOC + ((size_t)g * (NCH * 4) + (size_t)b * 256) * 128 + p; bf16_t* dst = UP + ((size_t)g * NCH + b * 64) * UPW + p;
        float sr = 0.f, si = 0.f;
        for (int c = 0; c < 64; c += 2) {
            float xr[8], xi[8];
#pragma unroll
            for (int k = 0; k < 8; ++k) { xr[k] = src[(size_t)(c * 4 + k) * 128]; xi[k] = src[(size_t)(c * 4 + k) * 128 + 64]; }
#pragma unroll
            for (int k = 0; k < 8; ++k) {
                if ((k & 3) == 0) { bf16_t* d = dst + (size_t)(c + (k >> 2)) * UPW; d[0] = f2bf(sr); d[64] = f2bf(si); }
                const float nr = a16.x * sr - a16.y * si + xr[k], ni = a16.x * si + a16.y * sr + xi[k]; sr = nr; si = ni;
            }
        }
    }
}
__device__ __forceinline__ void ph_cum2(const float* __restrict__ logf, float* __restrict__ cum) {
    PH_IDS
    const int lane = TIDX & 63, gw = BIDX * 8 + (TIDX >> 6), ngw = GDIM * 8;
    for (int item = gw; item < BATCH * NH; item += ngw) {
        const int b = item / NH, h = item % NH;
        const float* src = logf + ((size_t)b * SEQ + lane * 64) * NH + h; float* dst = cum + (size_t)item * SEQ + lane * 64;
        float tot = 0.f;
        for (int i = 0; i < 64; ++i) tot += src[(size_t)i * NH];
        float ex = tot;
#pragma unroll
        for (int o = 1; o < 64; o <<= 1) { const float y = __shfl_up(ex, o); if (lane >= o) ex += y; }
        float run = ex - tot;
        for (int i = 0; i < 64; ++i) { run += src[(size_t)i * NH]; dst[i] = run * 1.4426950408889634f; }
    }
}

struct SchedSsmC {
    static constexpr bool DUALB = true; long hA, hB, hB1;
    const char* UP; const char* WOUT; const char* KD; int G_, c;
    __device__ __forceinline__ void init(const void* up, const void* wout_l, const void* kd_l, int grid, int bid) { UP = (const char*)up; WOUT = (const char*)wout_l; KD = (const char*)kd_l; G_ = grid; c = bid; hA = 128l * UPW * 2; hB = 128l * 256; hB1 = 8l * 512; }
    __device__ __forceinline__ bool next(int i, ge::Unit& u) const {
        const int L = i * G_ + c; if (L >= G * 2 * 4) return false;
        const int pn = 3 - (L >> 6), g = (L & 63) >> 1, pm = L & 1;
        u.A0 = UP + ((size_t)g * NCH + pm * 256) * UPW * 2; u.B0 = nullptr; u.nt = 2 + 4 * (pn + 1); u.pm = pm; u.pn = pn; u.aux = g; return true; }
    __device__ __forceinline__ const char* ta(const ge::Unit& u, int t) const { return u.A0 + t * 128; }
    __device__ __forceinline__ bool sb(const ge::Unit&, int t) const { return t >= 2; }
    __device__ __forceinline__ const char* tb(const ge::Unit& u, int t) const {
        return t < 2 ? WOUT + ((size_t)u.aux * 1024 + u.pn * 256) * 256 + t * 128 : KD + ((size_t)u.aux * KDW + (size_t)(16 * u.pn - 4 * (t - 2) + 60) * 256) * 2; }
    __device__ __forceinline__ unsigned voffA(int R, int C) const { return (unsigned)(R * UPW * 2 + C * 2); }
    __device__ __forceinline__ unsigned voffB(int Rb, int C) const { return (unsigned)(Rb * 256 + C * 2); }
    __device__ __forceinline__ unsigned voffB1(int Rb, int C) const { return (unsigned)((((Rb >> 4) + 3 - (C >> 4)) * 256 + (Rb & 15) * 16 + (C & 15)) * 2); }
};
__device__ __forceinline__ float gelu_fast(float x) { const float u = 1.5957691216057308f * (x + 0.044715f * x * x * x); return x - x / (1.f + __expf(u)); }
struct EpiSsmC {
    static constexpr bool PERM = true, MIDK = false, UBEGIN = false;
    bf16_t* GEL;
    __device__ __forceinline__ void unit_begin(const ge::Unit&, int, LAS unsigned char*) const {}
    __device__ __forceinline__ void midk(ge::f32x4 (&)[2][2][4][2], const ge::Unit&, int, int, LAS unsigned char*) const {}
    __device__ __forceinline__ void operator()(const ge::f32x4 (&acc)[2][2][4][2], const ge::Unit& u, int wr, int wc, int fr, int fq, LAS unsigned char*) const {
        const int g = u.aux;
#pragma unroll
        for (int ai = 0; ai < 2; ++ai)
#pragma unroll
            for (int m = 0; m < 4; ++m) {
                const int chunk = u.pm * 256 + ai * 128 + wr * 64 + m * 16 + fr;
#pragma unroll
                for (int bj = 0; bj < 2; ++bj) {
                    const int col = u.pn * 256 + bj * 128 + wc * 32 + 8 * fq, ti = col >> 4, h0 = col & 15;
                    const ge::f32x4 v0 = acc[ai][bj][m][0], v1 = acc[ai][bj][m][1];
                    u32x4 w; w.x = ge::cvt_pk_bf16(gelu_fast(v0[0]), gelu_fast(v0[1])); w.y = ge::cvt_pk_bf16(gelu_fast(v0[2]), gelu_fast(v0[3]));
                    w.z = ge::cvt_pk_bf16(gelu_fast(v1[0]), gelu_fast(v1[1])); w.w = ge::cvt_pk_bf16(gelu_fast(v1[2]), gelu_fast(v1[3]));
                    *(u32x4*)(GEL + ((size_t)g * T + chunk * 64 + ti) * HC + h0) = w;
                }
            }
    }
};
}
namespace nv {
#define SEL_CE(x, y) do { const int _h = max((x), (y)), _l = min((x), (y)); (x) = _h; (y) = _l; } while (0)
__device__ __forceinline__ void sel_sort16(int (&v)[16]) {
    SEL_CE(v[0], v[1]);
    SEL_CE(v[2], v[3]);
    SEL_CE(v[0], v[2]);
    SEL_CE(v[1], v[3]);
    SEL_CE(v[1], v[2]);
    SEL_CE(v[4], v[5]);
    SEL_CE(v[6], v[7]);
    SEL_CE(v[4], v[6]);
    SEL_CE(v[5], v[7]);
    SEL_CE(v[5], v[6]);
    SEL_CE(v[0], v[4]);
    SEL_CE(v[2], v[6]);
    SEL_CE(v[2], v[4]);
    SEL_CE(v[1], v[5]);
    SEL_CE(v[3], v[7]);
    SEL_CE(v[3], v[5]);
    SEL_CE(v[1], v[2]);
    SEL_CE(v[3], v[4]);
    SEL_CE(v[5], v[6]);
    SEL_CE(v[8], v[9]);
    SEL_CE(v[10], v[11]);
    SEL_CE(v[8], v[10]);
    SEL_CE(v[9], v[11]);
    SEL_CE(v[9], v[10]);
    SEL_CE(v[12], v[13]);
    SEL_CE(v[14], v[15]);
    SEL_CE(v[12], v[14]);
    SEL_CE(v[13], v[15]);
    SEL_CE(v[13], v[14]);
    SEL_CE(v[8], v[12]);
    SEL_CE(v[10], v[14]);
    SEL_CE(v[10], v[12]);
    SEL_CE(v[9], v[13]);
    SEL_CE(v[11], v[15]);
    SEL_CE(v[11], v[13]);
    SEL_CE(v[9], v[10]);
    SEL_CE(v[11], v[12]);
    SEL_CE(v[13], v[14]);
    SEL_CE(v[0], v[8]);
    SEL_CE(v[4], v[12]);
    SEL_CE(v[4], v[8]);
    SEL_CE(v[2], v[10]);
    SEL_CE(v[6], v[14]);
    SEL_CE(v[6], v[10]);
    SEL_CE(v[2], v[4]);
    SEL_CE(v[6], v[8]);
    SEL_CE(v[10], v[12]);
    SEL_CE(v[1], v[9]);
    SEL_CE(v[5], v[13]);
    SEL_CE(v[5], v[9]);
    SEL_CE(v[3], v[11]);
    SEL_CE(v[7], v[15]);
    SEL_CE(v[7], v[11]);
    SEL_CE(v[3], v[5]);
    SEL_CE(v[7], v[9]);
    SEL_CE(v[11], v[13]);
    SEL_CE(v[1], v[2]);
    SEL_CE(v[3], v[4]);
    SEL_CE(v[5], v[6]);
    SEL_CE(v[7], v[8]);
    SEL_CE(v[9], v[10]);
    SEL_CE(v[11], v[12]);
    SEL_CE(v[13], v[14]);
}
__device__ __forceinline__ void sel_merge16(int (&a)[16], const int (&b)[16]) {
    a[0] = max(a[0], b[15]);
    a[1] = max(a[1], b[14]);
    a[2] = max(a[2], b[13]);
    a[3] = max(a[3], b[12]);
    a[4] = max(a[4], b[11]);
    a[5] = max(a[5], b[10]);
    a[6] = max(a[6], b[9]);
    a[7] = max(a[7], b[8]);
    a[8] = max(a[8], b[7]);
    a[9] = max(a[9], b[6]);
    a[10] = max(a[10], b[5]);
    a[11] = max(a[11], b[4]);
    a[12] = max(a[12], b[3]);
    a[13] = max(a[13], b[2]);
    a[14] = max(a[14], b[1]);
    a[15] = max(a[15], b[0]);
    SEL_CE(a[0], a[8]);
    SEL_CE(a[1], a[9]);
    SEL_CE(a[2], a[10]);
    SEL_CE(a[3], a[11]);
    SEL_CE(a[4], a[12]);
    SEL_CE(a[5], a[13]);
    SEL_CE(a[6], a[14]);
    SEL_CE(a[7], a[15]);
    SEL_CE(a[0], a[4]);
    SEL_CE(a[1], a[5]);
    SEL_CE(a[2], a[6]);
    SEL_CE(a[3], a[7]);
    SEL_CE(a[8], a[12]);
    SEL_CE(a[9], a[13]);
    SEL_CE(a[10], a[14]);
    SEL_CE(a[11], a[15]);
    SEL_CE(a[0], a[2]);
    SEL_CE(a[1], a[3]);
    SEL_CE(a[4], a[6]);
    SEL_CE(a[5], a[7]);
    SEL_CE(a[8], a[10]);
    SEL_CE(a[9], a[11]);
    SEL_CE(a[12], a[14]);
    SEL_CE(a[13], a[15]);
    SEL_CE(a[0], a[1]);
    SEL_CE(a[2], a[3]);
    SEL_CE(a[4], a[5]);
    SEL_CE(a[6], a[7]);
    SEL_CE(a[8], a[9]);
    SEL_CE(a[10], a[11]);
    SEL_CE(a[12], a[13]);
    SEL_CE(a[14], a[15]);
}
constexpr int SEL_NCAND = 50;
#define SEL_CANDS(F) \
    F(0, 0, 0) \
    F(1, 0, 1) \
    F(2, 0, 2) \
    F(3, 0, 3) \
    F(4, 0, 4) \
    F(5, 0, 5) \
    F(6, 0, 6) \
    F(7, 0, 7) \
    F(8, 0, 8) \
    F(9, 0, 9) \
    F(10, 0, 10) \
    F(11, 0, 11) \
    F(12, 0, 12) \
    F(13, 0, 13) \
    F(14, 0, 14) \
    F(15, 0, 15) \
    F(16, 1, 0) \
    F(17, 1, 1) \
    F(18, 1, 2) \
    F(19, 1, 3) \
    F(20, 1, 4) \
    F(21, 1, 5) \
    F(22, 1, 6) \
    F(23, 1, 7) \
    F(24, 2, 0) \
    F(25, 2, 1) \
    F(26, 2, 2) \
    F(27, 2, 3) \
    F(28, 2, 4) \
    F(29, 3, 0) \
    F(30, 3, 1) \
    F(31, 3, 2) \
    F(32, 3, 3) \
    F(33, 4, 0) \
    F(34, 4, 1) \
    F(35, 4, 2) \
    F(36, 5, 0) \
    F(37, 5, 1) \
    F(38, 6, 0) \
    F(39, 6, 1) \
    F(40, 7, 0) \
    F(41, 7, 1) \
    F(42, 8, 0) \
    F(43, 9, 0) \
    F(44, 10, 0) \
    F(45, 11, 0) \
    F(46, 12, 0) \
    F(47, 13, 0) \
    F(48, 14, 0) \
    F(49, 15, 0)
__device__ __forceinline__ int f2key(float f) { const int b = __float_as_int(f); return b ^ ((b >> 31) & 0x7fffffff); }
__device__ __forceinline__ float key2f(int k) { return __int_as_float(k ^ ((k >> 31) & 0x7fffffff)); }
__device__ __forceinline__ void sel_top16(const f32x16 (&acc)[4], int hi, int (&t)[16]) {
    int g1[16], g2[16], g3[16];
#pragma unroll
    for (int r = 0; r < 16; ++r) { const int n = (r & 3) + 8 * (r >> 2) + 4 * hi;
        t[r] = (f2key(acc[0][r]) & ~0x7F) | n; g1[r] = (f2key(acc[1][r]) & ~0x7F) | (32 + n); g2[r] = (f2key(acc[2][r]) & ~0x7F) | (64 + n); g3[r] = (f2key(acc[3][r]) & ~0x7F) | (96 + n); }
    sel_sort16(t); sel_sort16(g1); sel_sort16(g2); sel_sort16(g3);
    sel_merge16(t, g1); sel_merge16(g2, g3); sel_merge16(t, g2);
#pragma unroll
    for (int i = 0; i < 16; ++i) g1[i] = __shfl_xor(t[i], 32);
    sel_merge16(t, g1);
}
__device__ __forceinline__ void ph_select(const bf16_t* __restrict__ QP, const bf16_t* __restrict__ KEYS, int* __restrict__ idx, float* __restrict__ gate, LAS unsigned char* lds) {
    PH_IDS
    const int lane = TIDX & 63, hd = TIDX >> 6, r = lane & 31, hi = lane >> 5;
    LAS unsigned* my = (LAS unsigned*)(lds + hd * 2048) + lane;
    for (int tg = BIDX; tg < T / 32; tg += GDIM) {
        const int tok0 = tg * 32;
        int rk = r; asm volatile("" : "+v"(rk));
        int t1[16], t2[16];
#pragma unroll
        for (int half = 0; half < 2; ++half) {
            f32x16 acc[4];
#pragma unroll
            for (int mt = 0; mt < 4; ++mt)
#pragma unroll
                for (int i = 0; i < 16; ++i) acc[mt][i] = 0.f;
            const bf16_t* qb = QP + (size_t)(tok0 + r) * D + hd * QD + half * HALF + 8 * hi;
            const bf16_t* kb = KEYS + ((size_t)(hd * 2 + half) * NK + rk) * HALF + 8 * hi;
#pragma unroll
            for (int ks = 0; ks < 4; ++ks) {
                const bf16x8 b = *(const bf16x8*)(qb + 16 * ks);
#pragma unroll
                for (int mt = 0; mt < 4; ++mt) { const bf16x8 a = *(const bf16x8*)(kb + (size_t)mt * 32 * HALF + 16 * ks); acc[mt] = __builtin_amdgcn_mfma_f32_32x32x16_bf16(a, b, acc[mt], 0, 0, 0); }
            }
            if (half == 0) sel_top16(acc, hi, t1); else sel_top16(acc, hi, t2);
        }
        float f1[16], f2[16];
#pragma unroll
        for (int i = 0; i < 16; ++i) { f1[i] = key2f(t1[i]); f2[i] = key2f(t2[i]); }
        int c0[16], c1[16], c2[16], c3[16];
#pragma unroll
        for (int i = 0; i < 16; ++i) c3[i] = (int)0x80000000;
#define SEL_F(k, i, j) { const int v_ = (f2key(f1[i] + f2[j]) & ~0xFF) | ((i) << 4 | (j)); if ((k) < 16) c0[(k) & 15] = v_; else if ((k) < 32) c1[(k) & 15] = v_; else if ((k) < 48) c2[(k) & 15] = v_; else c3[(k) & 15] = v_; }
        SEL_CANDS(SEL_F)
#undef SEL_F
        sel_sort16(c0); sel_sort16(c1); sel_sort16(c2); SEL_CE(c3[0], c3[1]);
        sel_merge16(c0, c1); sel_merge16(c2, c3); sel_merge16(c0, c2);
#pragma unroll
        for (int j = 0; j < 4; ++j) {
            my[64 * j] = (unsigned)(t1[4 * j] & 0x7F) | ((unsigned)(t1[4 * j + 1] & 0x7F) << 8) | ((unsigned)(t1[4 * j + 2] & 0x7F) << 16) | ((unsigned)(t1[4 * j + 3] & 0x7F) << 24);
            my[64 * (4 + j)] = (unsigned)(t2[4 * j] & 0x7F) | ((unsigned)(t2[4 * j + 1] & 0x7F) << 8) | ((unsigned)(t2[4 * j + 2] & 0x7F) << 16) | ((unsigned)(t2[4 * j + 3] & 0x7F) << 24);
        }
        const float mx = key2f(c0[0]); float e[16], se = 0.f;
#pragma unroll
        for (int k = 0; k < 16; ++k) { e[k] = __expf(key2f(c0[k]) - mx); se += e[k]; }
        const float inv = 1.f / se;
        asm volatile("s_waitcnt lgkmcnt(0)" ::: "memory");
        const size_t o = (size_t)(tok0 + r) * 128 + hd * TOPK;
        if (hi == 0) {
            int id[16];
#pragma unroll
            for (int k = 0; k < 16; ++k) { const int code = c0[k] & 0xFF, i = code >> 4, j = code & 15;
                const unsigned w1 = my[64 * (i >> 2)], w2 = my[64 * (4 + (j >> 2))];
                id[k] = (int)((w1 >> (8 * (i & 3))) & 0x7F) * NK + (int)((w2 >> (8 * (j & 3))) & 0x7F); }
#pragma unroll
            for (int k = 0; k < 4; ++k) *(int4*)(idx + o + 4 * k) = make_int4(id[4 * k], id[4 * k + 1], id[4 * k + 2], id[4 * k + 3]);
        } else {
#pragma unroll
            for (int k = 0; k < 4; ++k) *(float4*)(gate + o + 4 * k) = make_float4(e[4 * k] * inv, e[4 * k + 1] * inv, e[4 * k + 2] * inv, e[4 * k + 3] * inv);
        }
        asm volatile("s_waitcnt lgkmcnt(0)" ::: "memory");
    }
}
}
namespace nv {
constexpr int LDS_BYTES = 147456, MISC_OFF = 131072 + 320;
struct Params { const float* in[23]; float* out; unsigned char* ws; };

__global__ void __launch_bounds__(512, 2) k_mega(Params prm) {
    extern __shared__ __attribute__((aligned(16))) unsigned char lds_raw[];
    namespace cg = cooperative_groups;
    cg::grid_group grid = cg::this_grid();
    LAS unsigned char* lds = (LAS unsigned char*)lds_raw;
    unsigned char* smem = lds_raw;
    for (int u = threadIdx.x; u < (LDS_BYTES - 131072) / 4; u += 512) ((LAS unsigned*)(lds + 131072))[u] = 0u;
    __syncthreads();
    if (threadIdx.x == 0) {
        LAS unsigned long long* tab = (LAS unsigned long long*)(lds + TAB_OFF);
#pragma unroll
        for (int i = 0; i < 23; ++i) tab[i] = (unsigned long long)prm.in[i];
        tab[23] = (unsigned long long)prm.out; tab[24] = (unsigned long long)prm.ws;
    }
    __syncthreads();
#define ARG(i) ((const float*)ldarg(lds, (i)))
#define WSP() ((unsigned char*)ldarg(lds, 24))
    XcdBarrier bar = xcd_barrier_post((unsigned*)(WSP() + WS_CTL) + CW_BAR, (volatile LAS unsigned*)(lds + MISC_OFF) + 8);
#define GRID_BAR() do { xcd_barrier(bar); asm volatile("" ::: "memory"); } while (0)
    p0_prologue(lds);
    { unsigned char* ws = WSP(); p0_peer_tables(ARG(20), ARG(21), ARG(17), ws + WS_PU, ws + WS_PV8); }
    { unsigned char* ws = WSP(); const float* pk = ARG(19); bf16_t* kb = (bf16_t*)(ws + WS_KEYS); for (int i = obid() * 512 + otid(); i < DEPTH * PH * 2 * NK * HALF; i += ogrid() * 512) kb[i] = f2bf(pk[i]); }
    { unsigned char* ws = WSP(); p0_ssm_a(ARG(3), ARG(4), ARG(5), ARG(6), ARG(7), (f32x2v*)(ws + WS_APOW), (f32x2v*)(ws + WS_BBAR)); }
    GRID_BAR();
    { unsigned char* ws = WSP(); p0_ssm_b((const f32x2v*)(ws + WS_APOW), (const f32x2v*)(ws + WS_BBAR), ARG(8), ARG(9), ARG(10), (bf16_t*)(ws + WS_KD), (bf16_t*)(ws + WS_WST), (bf16_t*)(ws + WS_WOUT)); }
    grid.sync();
#pragma nounroll
    for (int l_ = 0; l_ < DEPTH; ++l_) {
        int l = l_; asm volatile("" : "+s"(l));
        {
            unsigned char* ws = WSP(); bf16_t* hb = (bf16_t*)(ws + WS_HB); float* ss1 = (float*)(ws + WS_SSP) + (size_t)T * 32;
            SchedGen S; S.init_plain(hb, D * 2, (const bf16_t*)(ws + WS_BT1) + (size_t)l * 2048 * D, D * 2, T, 2048, D, ogrid(), obid());
            EpiInProj E{ss1, (bf16_t*)(ws + WS_UP), (bf16_t*)(ws + WS_Q)};
            ge::gemm_phase<EpiInProj, SchedGen>(lds, S, E, otid());
            ph_flogit(hb, (const bf16_t*)(ws + WS_WF) + (size_t)l * 16 * D, ss1, ARG(13) + l * NH, (float*)(ws + WS_LOGF));
        }
        GRID_BAR();
        {
            unsigned char* ws = WSP();
            SchedSsmS S; S.init(ws + WS_UP, (const bf16_t*)(ws + WS_WST) + (size_t)l * G * 128 * 256, ogrid(), obid());
            EpiSsmS E{(float*)(ws + WS_SLOC)};
            ge::gemm_phase<EpiSsmS, SchedSsmS>(lds, S, E, otid());
            ph_cum2((const float*)(ws + WS_LOGF), (float*)(ws + WS_CUM));
        }
        GRID_BAR();
        { unsigned char* ws = WSP(); ph_ssm_prefix((const float*)(ws + WS_SLOC), (const f32x2v*)(ws + WS_APOW) + (size_t)l * G * 65 * P, (bf16_t*)(ws + WS_UP)); }
        GRID_BAR();
        {
            unsigned char* ws = WSP(); float* ssp_s = (float*)(ws + WS_SSP); float* ssp_a = ssp_s + (size_t)T * 8;
            {
                SchedSsmC S; S.init(ws + WS_UP, (const bf16_t*)(ws + WS_WOUT) + (size_t)l * G * 1024 * 128, (const bf16_t*)(ws + WS_KD) + (size_t)l * G * KDW, ogrid(), obid());
                EpiSsmC E{(bf16_t*)(ws + WS_GEL)};
                ge::gemm_phase<EpiSsmC, SchedSsmC>(lds, S, E, otid());
            }
            GRID_BAR();
            attn_body::attn_phase<8>((char*)lds_raw, (const attn_body::bf16*)(ws + WS_Q), (const attn_body::bf16*)(ws + WS_K), (const attn_body::bf16*)(ws + WS_V), (const float*)(ws + WS_CUM), (attn_body::bf16*)(ws + WS_MIX), ssp_a, otid(), obid(), ogrid());
            SchedGen S; S.init_plain(ws + WS_GEL, 32, (const bf16_t*)(ws + WS_BT2) + (size_t)l * SSMW * SSMW, SSMW * 2, T, SSMW, SSMW, ogrid(), obid());
            S.a_c16_b = T * 32; S.a_kt_b = 4l * T * 32;
            EpiGlu2 E{(const bf16_t*)(ws + WS_GEL), ARG(12) + l * SSMW, (bf16_t*)(ws + WS_MIX), ssp_s};
            ge::gemm_phase<EpiGlu2, SchedGen>(lds, S, E, otid());
        }
        GRID_BAR();
        {
            unsigned char* ws = WSP(); float* ssp_s = (float*)(ws + WS_SSP); float* ssp_a = ssp_s + (size_t)T * 8; float* ssp_2 = ssp_a + (size_t)T * 8;
            SchedGen S; S.init_plain(ws + WS_MIX, D * 2, (const bf16_t*)(ws + WS_BT3) + (size_t)l * D * D, D * 2, T, D, D, ogrid(), obid());
            EpiWo E{ssp_s, ssp_a, (float*)(ws + WS_H), (bf16_t*)(ws + WS_HB), ssp_2};
            ge::gemm_phase<EpiWo, SchedGen>(lds, S, E, otid());
        }
        GRID_BAR();
        {
            unsigned char* ws = WSP(); float* ssp_2 = (float*)(ws + WS_SSP) + (size_t)T * 16;
            SchedGen S; S.init_plain(ws + WS_HB, D * 2, (const bf16_t*)(ws + WS_BT4) + (size_t)l * D * D, D * 2, T, D, D, ogrid(), obid());
            EpiWq E{ssp_2, (bf16_t*)(ws + WS_QP)};
            ge::gemm_phase<EpiWq, SchedGen>(lds, S, E, otid());
        }
        GRID_BAR();
        { unsigned char* ws = WSP(); ph_select((const bf16_t*)(ws + WS_QP), (const bf16_t*)(ws + WS_KEYS) + (size_t)l * PH * 2 * NK * HALF, (int*)(ws + WS_IDX), (float*)(ws + WS_GATE), lds); }
        GRID_BAR();
        { unsigned char* ws = WSP(); ph_peer_u(ws + WS_PU + (size_t)l * NEXP * D, (const bf16_t*)(ws + WS_HB), (const int*)(ws + WS_IDX), (float*)(ws + WS_PART)); }
        GRID_BAR();
        { unsigned char* ws = WSP(); ph_peer_coef((const float*)(ws + WS_PART), (const float*)(ws + WS_SSP) + (size_t)T * 16, (const float*)(ws + WS_GATE), (float*)(ws + WS_COEF)); }
        GRID_BAR();
        { unsigned char* ws = WSP(); ph_peer_v(ws + WS_PV8 + (size_t)l * NEXP * D, (const int*)(ws + WS_IDX), (const float*)(ws + WS_COEF), (float*)(ws + WS_H), (bf16_t*)(ws + WS_HB), (float*)(ws + WS_SSP) + (size_t)T * 32); }
        GRID_BAR();
    }
    { unsigned char* ws = WSP(); ph_final((const float*)(ws + WS_H), (const float*)(ws + WS_SSP) + (size_t)T * 32, ARG(22), (float*)ldarg(lds, 23)); }
}
}

extern "C" void kernel_launch(void* const* d_in, const int* in_sizes, int n_in, void* d_out, int out_size, void* d_ws, size_t ws_size, hipStream_t stream) {
    using namespace nv;
    static int grid_blocks = 0;
    if (!grid_blocks) {
        int dev = 0, cus = 0, per_cu = 0;
        (void)hipGetDevice(&dev);
        (void)hipDeviceGetAttribute(&cus, hipDeviceAttributeMultiprocessorCount, dev);
        if (hipFuncSetAttribute((const void*)k_mega, hipFuncAttributeMaxDynamicSharedMemorySize, LDS_BYTES) != hipSuccess) { fprintf(stderr, "hipFuncSetAttribute failed\n"); grid_blocks = -1; return; }
        (void)hipOccupancyMaxActiveBlocksPerMultiprocessor(&per_cu, (const void*)k_mega, 512, LDS_BYTES);
        if (per_cu < 1) { fprintf(stderr, "occupancy query returned %d\n", per_cu); (void)hipGetLastError(); }
        grid_blocks = cus;
    }
    if (grid_blocks < 0) return;
    if (ws_size < WS_END || n_in != 23) { fprintf(stderr, "bad workspace / inputs\n"); return; }
    (void)hipMemsetAsync((char*)d_ws + WS_CTL, 0, CTL_BYTES, stream);
    Params p{};
    for (int i = 0; i < 23; ++i) p.in[i] = (const float*)d_in[i];
    p.out = (float*)d_out; p.ws = (unsigned char*)d_ws;
    void* args[] = {&p};
    hipError_t e = hipLaunchCooperativeKernel((const void*)k_mega, dim3(grid_blocks), dim3(512), args, LDS_BYTES, stream);
    if (e != hipSuccess) fprintf(stderr, "cooperative launch failed: %s (grid %d)\n", hipGetErrorString(e), grid_blocks);
}
```

```cpp
#include <hip/hip_runtime.h>
#include <hip/hip_cooperative_groups.h>
#include <hip/hip_bf16.h>
#include <cstdint>
#include <cstdio>

#define LAS __attribute__((address_space(3)))
#define GAS __attribute__((address_space(1)))

namespace nv {
constexpr int D = 1024, BATCH = 8, SEQ = 4096, DEPTH = 4, T = BATCH * SEQ;
constexpr int SSMW = 512, G = 32, HC = 16, P = 64, ATTW = 512, HD = 64, NH = 8, INW = 2056;
constexpr int PH = 8, NK = 128, TOPK = 16, QD = 128, HALF = 64, NEXP = 16384;
constexpr int CHUNK = 64, NCH = T / CHUNK  , UPW = 128 + CHUNK * HC  ;
constexpr float EPS = 1e-6f;

typedef short bf16x8 __attribute__((ext_vector_type(8)));
typedef float f32x16 __attribute__((ext_vector_type(16)));
typedef float f32x4 __attribute__((ext_vector_type(4)));
typedef unsigned u32x4 __attribute__((ext_vector_type(4)));
typedef unsigned short bf16_t;

constexpr size_t MiB = 1u << 20;
constexpr size_t WS_CTL = 0, CTL_BYTES = 4 * MiB;
constexpr size_t WS_BT1 = 4 * MiB;
constexpr size_t WS_BT2 = 20 * MiB;
constexpr size_t WS_BT3 = 22 * MiB;
constexpr size_t WS_BT4 = 30 * MiB;
constexpr size_t WS_WF = 38 * MiB;
constexpr size_t WS_KEYS = 39 * MiB;
constexpr size_t WS_KD = 40 * MiB, WS_WOUT = 49 * MiB, WS_WST = 81 * MiB;
constexpr size_t WS_PU = 90 * MiB, WS_PV8 = 154 * MiB;
constexpr size_t WS_PART = 218 * MiB;
constexpr size_t WS_H = 346 * MiB;
constexpr size_t WS_HB = 474 * MiB;
constexpr size_t WS_UP = 538 * MiB;
constexpr size_t WS_Q = 576 * MiB, WS_K = 608 * MiB, WS_V = 640 * MiB;
constexpr size_t WS_LOGF = 672 * MiB, WS_CUM = 673 * MiB;
constexpr size_t WS_SLOC = 674 * MiB, WS_GEL = 708 * MiB, WS_MIX = 740 * MiB;
constexpr size_t WS_SSP = 916 * MiB;
constexpr size_t WS_QP = 852 * MiB;
constexpr size_t WS_IDX = 804 * MiB, WS_GATE = 820 * MiB, WS_COEF = 836 * MiB;
constexpr size_t WS_XN_F = 90 * MiB, WS_MIXED_F = 218 * MiB, WS_QP_F = 852 * MiB, WS_GEL_F = 90 * MiB  , WS_YSSM_F = 740 * MiB, WS_YATT_F = 674 * MiB;
constexpr size_t WS_END = 980 * MiB;
constexpr int CW_QUEUE = 1024;
constexpr int CW_RANK = 2048;
constexpr int CW_BAR = 4096;
constexpr int CW_SS = 65536;
constexpr int SS_H1 = 0  , SS_H2 = 5  , SS_SSM = 9, SS_ATT = 13;
static_assert((size_t)(CW_SS + 17 * T) * 4 <= CTL_BYTES, "ctl region");

__device__ __forceinline__ unsigned short f2bf(float f) { unsigned u = __float_as_uint(f); return (unsigned short)((u + 0x7fffu + ((u >> 16) & 1u)) >> 16); }
__device__ __forceinline__ float bf2f(unsigned short b) { return __uint_as_float(((unsigned)b) << 16); }
__device__ __forceinline__ unsigned pk2(float lo, float hi) { return (unsigned)f2bf(lo) | ((unsigned)f2bf(hi) << 16); }
__device__ __forceinline__ float gelu_tanh(float x) { const float u = 0.7978845608028654f * (x + 0.044715f * x * x * x); return 0.5f * x * (1.f + tanhf(u)); }
__device__ __forceinline__ float wave_sum(float v) {
#pragma unroll
    for (int o = 1; o < 64; o <<= 1) v += __shfl_xor(v, o);
    return v;
}
__device__ __forceinline__ int otid() { int t = threadIdx.x; asm volatile("" : "+v"(t)); return t; }
__device__ __forceinline__ int obid() { int t = blockIdx.x; asm volatile("" : "+s"(t)); return t; }
__device__ __forceinline__ int ogrid() { int t = gridDim.x; asm volatile("" : "+s"(t)); return t; }
#define PH_IDS const int TIDX = otid(), BIDX = obid(), GDIM = ogrid(); (void)TIDX; (void)BIDX; (void)GDIM;
__device__ __forceinline__ size_t up_index(int row, int c) { const int n = row >> 6, j = row & 63, g = c >> 4, hh = c & 15; return ((size_t)g * NCH + n) * UPW + 128 + j * HC + hh; }
}
namespace ge {
#define GE_LAS __attribute__((address_space(3)))
typedef unsigned short bf16_t;
typedef short bf16x8 __attribute__((ext_vector_type(8)));
typedef float f32x4 __attribute__((ext_vector_type(4)));
typedef unsigned u32x4 __attribute__((ext_vector_type(4)));
typedef unsigned u32x2 __attribute__((ext_vector_type(2)));
constexpr int ROWF_OFF = 131072 + 4096;
constexpr int BM = 256, BK = 64, HALF = 128, HTB = HALF * BK * 2  , STAGE_BYTES = 8 * HTB, NXCD = 8, WGM = 8;

__host__ __device__ __forceinline__ int lds_byte(int r, int c) { const int st = (r >> 4) * 2 + (c >> 5), rr = r & 15, cc = c & 31, ob = rr * 64 + cc * 2; return st * 1024 + (ob ^ (((ob >> 9) & 1) << 5)); }
__host__ __device__ __forceinline__ void stage_rc(int b, int& R, int& C) { const int st = b / 1024, sb = b % 1024, swz = sb ^ (((sb >> 9) & 1) << 5); R = (st >> 1) * 16 + swz / 64; C = (st & 1) * 32 + (swz % 64) / 2; }
__host__ __device__ __forceinline__ int perm32(int rho) { const int n = rho >> 4, i = rho & 15; return 8 * (i >> 2) + 4 * n + (i & 3); }

struct Unit { const char* A0; const char* B0; int nt; int pm, pn, aux; };
__device__ __forceinline__ unsigned cvt_pk_bf16(float lo, float hi) { unsigned r; asm volatile("v_cvt_pk_bf16_f32 %0, %1, %2" : "=v"(r) : "v"(lo), "v"(hi)); return r; }

__device__ __forceinline__ bool static_tile(int i, int G, int c, int nM, int nN, int& pm, int& pn) {
    const int nwg = nM * nN; const long L = (long)i * G + c; if (L >= nwg) return false;
    int wgid = (int)L; { const int q = nwg / NXCD, r = nwg % NXCD, xcd = wgid % NXCD, off = wgid / NXCD; wgid = (xcd < r ? xcd * (q + 1) : r * (q + 1) + (xcd - r) * q) + off; }
    const int nig = WGM * nN, gid = wgid / nig, fm = gid * WGM, gsz = (nM - fm) < WGM ? (nM - fm) : WGM;
    pm = fm + ((wgid % nig) % gsz); pn = (wgid % nig) / gsz; return true;
}

template <class Epi, class Sched>
__device__ __forceinline__ void gemm_phase(GE_LAS unsigned char* lds, const Sched& S, const Epi& E, int tid) {
    const int wid = __builtin_amdgcn_readfirstlane(tid >> 6), lane = tid & 63, wr = wid >> 2, wc = wid & 3, fr = lane & 15, fq = lane >> 4;
    unsigned voffA[2], voffB[2], voffB1[2];
#pragma unroll
    for (int i = 0; i < 2; ++i) { int R, C; stage_rc(tid * 16 + i * 8192, R, C); const int Rb = Epi::PERM ? ((R & ~31) + perm32(R & 31)) : R;
        voffA[i] = S.voffA(R, C); voffB[i] = S.voffB(Rb, C); if constexpr (Sched::DUALB) voffB1[i] = S.voffB1(Rb, C); else voffB1[i] = 0u; }
    const long hA = S.hA, hB = S.hB;
    const unsigned ldsw = (unsigned)wid * 1024u;
    const int aoff = lds_byte(wr * 64 + fr, fq * 8), boff = lds_byte(wc * 32 + fr, fq * 8);
#define GE_SA(b, h) (((b) * 2 + (h)) * HTB)
#define GE_SB(b, h) ((4 + (b) * 2 + (h)) * HTB)
#define GE_STAGE(bufoff, gbase, voff) do { _Pragma("unroll") for (int _i = 0; _i < 2; ++_i) \
        __builtin_amdgcn_global_load_lds((const unsigned*)((const char*)(gbase) + (voff)[_i]), (GE_LAS unsigned*)(lds + (bufoff) + ldsw + _i * 8192), 16, 0, 0); } while (0)
#define GE_STAGE_B(bufoff, gbase, sel, half) do { if constexpr (Sched::DUALB) { const char* _g = (const char*)(gbase) + ((half) ? ((sel) ? S.hB1 : hB) : 0l); _Pragma("unroll") for (int _i = 0; _i < 2; ++_i) { const unsigned _v = (sel) ? voffB1[_i] : voffB[_i]; \
        __builtin_amdgcn_global_load_lds((const unsigned*)(_g + _v), (GE_LAS unsigned*)(lds + (bufoff) + ldsw + _i * 8192), 16, 0, 0); } } else { GE_STAGE(bufoff, (const char*)(gbase) + ((half) ? hB : 0l), voffB); } } while (0)
#define GE_LDA(dst, b, h) do { _Pragma("unroll") for (int m = 0; m < 4; ++m) _Pragma("unroll") for (int k = 0; k < 2; ++k) dst[m][k] = *(const GE_LAS bf16x8*)(lds + GE_SA(b, h) + aoff + m * 2048 + k * 1024); } while (0)
#define GE_LDB(dst, b, h) do { _Pragma("unroll") for (int n = 0; n < 2; ++n) _Pragma("unroll") for (int k = 0; k < 2; ++k) dst[n][k] = *(const GE_LAS bf16x8*)(lds + GE_SB(b, h) + boff + n * 2048 + k * 1024); } while (0)
#define GE_MMA(ai, bj, At, Bt) do { __builtin_amdgcn_s_setprio(1); _Pragma("unroll") for (int m = 0; m < 4; ++m) _Pragma("unroll") for (int n = 0; n < 2; ++n) _Pragma("unroll") for (int k = 0; k < 2; ++k) \
        acc[ai][bj][m][n] = __builtin_amdgcn_mfma_f32_16x16x32_bf16(Bt[n][k], At[m][k], acc[ai][bj][m][n], 0, 0, 0); __builtin_amdgcn_s_setprio(0); } while (0)
#define GE_WAIT_V(n) asm volatile("s_waitcnt vmcnt(" #n ")" ::: "memory")
#define GE_WAIT_L(n) asm volatile("s_waitcnt lgkmcnt(" #n ")" ::: "memory")
#define GE_BAR __builtin_amdgcn_s_barrier()
#define GE_SCHED __builtin_amdgcn_sched_barrier(0)
    Unit cur, nxt; int ui = 0;
    if (!S.next(0, cur)) return;
    f32x4 acc[2][2][4][2];
#pragma unroll
    for (int a = 0; a < 2; ++a)
#pragma unroll
        for (int b = 0; b < 2; ++b)
#pragma unroll
            for (int m = 0; m < 4; ++m)
#pragma unroll
                for (int n = 0; n < 2; ++n) acc[a][b][m][n] = (f32x4){0.f, 0.f, 0.f, 0.f};
    bf16x8 At[4][2], B0[2][2], B1[2][2];
    if constexpr (Epi::UBEGIN) E.unit_begin(cur, tid, lds + ROWF_OFF);
    {
        const char* a0 = S.ta(cur, 0); const char* b0 = S.tb(cur, 0); const char* a1 = S.ta(cur, 1); const char* b1 = S.tb(cur, 1);
        const bool s0 = S.sb(cur, 0), s1 = S.sb(cur, 1);
        GE_STAGE_B(GE_SB(0, 0), b0, s0, 0); GE_STAGE_B(GE_SB(0, 1), b0, s0, 1); GE_STAGE(GE_SA(0, 0), a0, voffA); GE_STAGE(GE_SA(0, 1), a0 + hA, voffA);
        if (wr == 1) GE_BAR;
        GE_WAIT_V(2); GE_BAR;
        GE_STAGE_B(GE_SB(1, 0), b1, s1, 0); GE_STAGE(GE_SA(1, 0), a1, voffA); GE_STAGE_B(GE_SB(1, 1), b1, s1, 1);
        GE_WAIT_V(6); GE_BAR;
    }
    for (;;) {
        const bool has_next = S.next(ui + 1, nxt);
        const int nt = cur.nt;
        for (int t = 0; t < nt; t += 2) {
            const bool last = (t == nt - 2);
            const char* a1 = S.ta(cur, t + 1);
            const char* a2 = last ? (has_next ? S.ta(nxt, 0) : S.ta(cur, 0)) : S.ta(cur, t + 2);
            const char* b2 = last ? (has_next ? S.tb(nxt, 0) : S.tb(cur, 0)) : S.tb(cur, t + 2);
            const char* a3 = last ? (has_next ? S.ta(nxt, 1) : S.ta(cur, 1)) : S.ta(cur, t + 3);
            const char* b3 = last ? (has_next ? S.tb(nxt, 1) : S.tb(cur, 1)) : S.tb(cur, t + 3);
            const bool s2 = last ? (has_next ? S.sb(nxt, 0) : S.sb(cur, 0)) : S.sb(cur, t + 2), s3 = last ? (has_next ? S.sb(nxt, 1) : S.sb(cur, 1)) : S.sb(cur, t + 3);
            GE_LDB(B0, 0, 0); GE_LDB(B1, 0, 1); GE_SCHED; GE_LDA(At, 0, 0); GE_STAGE(GE_SA(1, 1), a1 + hA, voffA);
            GE_WAIT_V(8); GE_WAIT_L(0); GE_BAR; GE_MMA(0, 0, At, B0); GE_MMA(0, 1, At, B1); GE_BAR; GE_SCHED;
            GE_LDA(At, 0, 1); GE_STAGE_B(GE_SB(0, 0), b2, s2, 0); GE_STAGE_B(GE_SB(0, 1), b2, s2, 1); GE_STAGE(GE_SA(0, 0), a2, voffA);
            GE_WAIT_V(8); GE_WAIT_L(0); GE_BAR; GE_MMA(1, 0, At, B0); GE_MMA(1, 1, At, B1); GE_BAR; GE_SCHED;
            GE_LDB(B0, 1, 0); GE_LDB(B1, 1, 1); GE_SCHED; GE_LDA(At, 1, 0); GE_STAGE(GE_SA(0, 1), a2 + hA, voffA);
            GE_WAIT_V(8); GE_WAIT_L(0); GE_BAR; GE_MMA(0, 0, At, B0); GE_MMA(0, 1, At, B1); GE_BAR; GE_SCHED;
            GE_LDA(At, 1, 1); GE_STAGE_B(GE_SB(1, 0), b3, s3, 0); GE_STAGE_B(GE_SB(1, 1), b3, s3, 1); GE_STAGE(GE_SA(1, 0), a3, voffA);
            GE_WAIT_V(8); GE_WAIT_L(0); GE_BAR; GE_MMA(1, 0, At, B0); GE_MMA(1, 1, At, B1); GE_BAR; GE_SCHED;
            if constexpr (Epi::MIDK) { if (t + 2 == (nt >> 1)) E.midk(acc, cur, wr, fr, lds + ROWF_OFF + (ui & 1) * 2048); }
        }
        if (wr == 0) GE_BAR;
        E(acc, cur, wr, wc, fr, fq, lds + ROWF_OFF + (ui & 1) * 2048);
        if (!has_next) break;
        if constexpr (Epi::UBEGIN) E.unit_begin(nxt, tid, lds + ROWF_OFF + ((ui + 1) & 1) * 2048);
#pragma unroll
        for (int a = 0; a < 2; ++a)
#pragma unroll
            for (int b = 0; b < 2; ++b)
#pragma unroll
                for (int m = 0; m < 4; ++m)
#pragma unroll
                    for (int n = 0; n < 2; ++n) acc[a][b][m][n] = (f32x4){0.f, 0.f, 0.f, 0.f};
        cur = nxt; ++ui;
        if (wr == 1) GE_BAR;
    }
    GE_WAIT_V(0);
    GE_BAR;
#undef GE_SA
#undef GE_SB
#undef GE_STAGE
#undef GE_STAGE_B
#undef GE_LDA
#undef GE_LDB
#undef GE_MMA
#undef GE_WAIT_V
#undef GE_WAIT_L
#undef GE_BAR
#undef GE_SCHED
}
}
namespace nv {
__device__ __forceinline__ float sum16(const float* p);
__device__ __forceinline__ void ph_rmsnorm(const float* __restrict__ in, int ldi, const float* __restrict__ g, float* __restrict__ out, int ldo, int n, int rows) {
    PH_IDS
    const int lane = TIDX & 63, gw = BIDX * 8 + (TIDX >> 6), ngw = GDIM * 8;
    for (int w = gw; w < rows; w += ngw) {
        const float* r = in + (size_t)w * ldi; float* o = out + (size_t)w * ldo;
        float s = 0.f;
        for (int c = lane; c < n; c += 64) { const float v = r[c]; s += v * v; }
        s = wave_sum(s);
        const float rs = rsqrtf(s / (float)n + EPS);
        for (int c = lane; c < n; c += 64) o[c] = r[c] * rs * g[c];
    }
}
__device__ __forceinline__ void ph_make_hb(const float* __restrict__ h, bf16_t* __restrict__ hb, float* __restrict__ ss) {
    PH_IDS
    const int lane = TIDX & 63, gw = BIDX * 8 + (TIDX >> 6), ngw = GDIM * 8;
    for (int w = gw; w < T; w += ngw) {
        const f32x4* r = (const f32x4*)(h + (size_t)w * D) + lane; unsigned long long* o = (unsigned long long*)(hb + (size_t)w * D) + lane;
        float s = 0.f;
#pragma unroll
        for (int j = 0; j < 4; ++j) { const f32x4 v = r[64 * j]; s += v.x * v.x + v.y * v.y + v.z * v.z + v.w * v.w; o[64 * j] = (unsigned long long)pk2(v.x, v.y) | ((unsigned long long)pk2(v.z, v.w) << 32); }
        s = wave_sum(s);
        if (lane == 0) ss[w] = s;
    }
}

template <class Epi>
__device__ __forceinline__ void ph_gemm(unsigned char* sm, const float* __restrict__ A, int lda, const float* __restrict__ B, int ldb, int M, int N, int K, Epi epi) {
    PH_IDS
    const int team = TIDX >> 8, tid = TIDX & 255, wave = tid >> 6, lane = tid & 63;
    unsigned short (*As)[40] = (unsigned short (*)[40])(sm + team * 20480); unsigned short (*Bs)[40] = (unsigned short (*)[40])(sm + team * 20480 + 10240);
    const int ntn = (N + 127) / 128, ntiles = ntn * (M / 128);
    const int wm = (wave >> 1) * 64, wn = (wave & 1) * 64;
    for (int it = BIDX; it < ntiles / 2; it += GDIM) {
        const int tile = it * 2 + team, m0 = (tile / ntn) * 128, n0 = (tile % ntn) * 128;
        f32x16 acc[2][2];
#pragma unroll
        for (int i = 0; i < 2; ++i)
#pragma unroll
            for (int j = 0; j < 2; ++j)
#pragma unroll
                for (int r = 0; r < 16; ++r) acc[i][j][r] = 0.f;
        for (int k0 = 0; k0 < K; k0 += 32) {
#pragma unroll
            for (int i = 0; i < 4; ++i) {
                const int idx = tid + i * 256, r = idx >> 3, c = (idx & 7) * 4;
                const float4 v = *(const float4*)(A + (size_t)(m0 + r) * lda + k0 + c);
                As[r][c] = f2bf(v.x); As[r][c + 1] = f2bf(v.y); As[r][c + 2] = f2bf(v.z); As[r][c + 3] = f2bf(v.w);
            }
#pragma unroll
            for (int i = 0; i < 4; ++i) {
                const int idx = tid + i * 256, k = idx >> 5, c = (idx & 31) * 4, n = n0 + c;
                float4 v = make_float4(0.f, 0.f, 0.f, 0.f);
                if (n + 3 < N) v = *(const float4*)(B + (size_t)(k0 + k) * ldb + n);
                Bs[c][k] = f2bf(v.x); Bs[c + 1][k] = f2bf(v.y); Bs[c + 2][k] = f2bf(v.z); Bs[c + 3][k] = f2bf(v.w);
            }
            __syncthreads();
#pragma unroll
            for (int ks = 0; ks < 2; ++ks) {
                bf16x8 a[2], b[2];
#pragma unroll
                for (int i = 0; i < 2; ++i) a[i] = *(const bf16x8*)&As[wm + i * 32 + (lane & 31)][ks * 16 + (lane >> 5) * 8];
#pragma unroll
                for (int j = 0; j < 2; ++j) b[j] = *(const bf16x8*)&Bs[wn + j * 32 + (lane & 31)][ks * 16 + (lane >> 5) * 8];
#pragma unroll
                for (int i = 0; i < 2; ++i)
#pragma unroll
                    for (int j = 0; j < 2; ++j) acc[i][j] = __builtin_amdgcn_mfma_f32_32x32x16_bf16(a[i], b[j], acc[i][j], 0, 0, 0);
            }
            __syncthreads();
        }
#pragma unroll
        for (int i = 0; i < 2; ++i)
#pragma unroll
            for (int j = 0; j < 2; ++j)
#pragma unroll
                for (int r = 0; r < 16; ++r) {
                    const int row = m0 + wm + i * 32 + (r & 3) + 8 * (r >> 2) + 4 * (lane >> 5), col = n0 + wn + j * 32 + (lane & 31);
                    if (col < N) epi(row, col, acc[i][j][r]);
                }
    }
}
struct EpiStore { float* C; int ldc; int pad; __device__ void operator()(int r, int c, float v) const { C[(size_t)r * ldc + c] = v; } };
struct EpiAdd { float* C; int ldc; int pad; __device__ void operator()(int r, int c, float v) const { C[(size_t)r * ldc + c] += v; } };
struct EpiGlu { const float* gel; const float* bias; float* out; __device__ void operator()(int r, int c, float v) const {
    const float gg = gel[(size_t)r * SSMW + c]; out[(size_t)r * SSMW + c] = gg / (1.f + expf(-(v + bias[c]))); } };

__device__ __forceinline__ void ph_ssm(const bf16_t* __restrict__ UP, const float* __restrict__ lam_re, const float* __restrict__ lam_im, const float* __restrict__ log_dt,
                                       const float* __restrict__ b_re, const float* __restrict__ b_im, const float* __restrict__ c_re, const float* __restrict__ c_im,
                                       const float* __restrict__ dsk, bf16_t* __restrict__ gel) {
    PH_IDS
    const int p = TIDX & 63, wv = TIDX >> 6;
    for (int item = BIDX + GDIM * wv; item < BATCH * G; item += GDIM * 8) {
        const int b = item / G, g = item % G;
        const float dt = expf(log_dt[g]);
        const float lr = lam_re[g * P + p], li = lam_im[g * P + p];
        const float mag = expf(lr * dt), are = mag * cosf(li * dt), aim = mag * sinf(li * dt);
        const float den = lr * lr + li * li, nr = are - 1.f;
        const float zre = (nr * lr + aim * li) / den, zim = (aim * lr - nr * li) / den;
        float bbr[HC], bbi[HC], cr[HC], ci[HC];
#pragma unroll
        for (int h = 0; h < HC; ++h) {
            const float br = b_re[(g * P + p) * HC + h], bi = b_im[(g * P + p) * HC + h];
            bbr[h] = zre * br - zim * bi; bbi[h] = zre * bi + zim * br;
            cr[h] = c_re[(g * HC + h) * P + p]; ci[h] = c_im[(g * HC + h) * P + p];
        }
        const float dmine = dsk[g * HC + (p & 15)];
        float sre = 0.f, sim = 0.f;
        for (int t = 0; t < SEQ; ++t) {
            const bf16_t* u = UP + up_index(b * SEQ + t, g * HC);
            float xr = 0.f, xi = 0.f, um = 0.f;
#pragma unroll
            for (int h = 0; h < HC; ++h) { const float uv = bf2f(u[h]); xr += bbr[h] * uv; xi += bbi[h] * uv; if ((p & 15) == h) um = uv; }
            const float nre = are * sre - aim * sim + xr, nim = are * sim + aim * sre + xi;
            sre = nre; sim = nim;
            float ymine = 0.f;
#pragma unroll
            for (int h = 0; h < HC; ++h) { const float v = wave_sum(cr[h] * sre - ci[h] * sim); if ((p & 15) == h) ymine = v; }
            if (p < HC) gel[((size_t)g * T + b * SEQ + t) * HC + p] = f2bf(gelu_tanh(ymine + dmine * um));
        }
    }
}

__device__ __forceinline__ void ph_cum(const float* __restrict__ logf, float* __restrict__ cum) {
    PH_IDS
    if (BIDX != GDIM - 1 || (TIDX >> 6) != 7) return;
    const int i = TIDX & 63;
    const int b = i / NH, h = i % NH; float c = 0.f;
    for (int t = 0; t < SEQ; ++t) { c += logf[(size_t)(b * SEQ + t) * NH + h]; cum[(size_t)i * SEQ + t] = c * 1.4426950408889634f; }
}

__device__ __forceinline__ void ph_attn(const bf16_t* __restrict__ Q, const bf16_t* __restrict__ Kb, const bf16_t* __restrict__ Vb, const float* __restrict__ cum, bf16_t* __restrict__ MIX, float* __restrict__ ssp_att) {
    PH_IDS
    const int gw = BIDX * 8 + (TIDX >> 6), ngw = GDIM * 8, lane = TIDX & 63;
    constexpr int NIT = BATCH * NH * (SEQ / 64);
    for (int it0 = gw; it0 < NIT; it0 += ngw) {
        const int it = NIT - 1 - it0;
        const int tb = it / (BATCH * NH), bh = it % (BATCH * NH), b = bh / NH, h = bh % NH;
        const int t = tb * 64 + lane;
        float q[HD], o[HD];
#pragma unroll
        for (int d = 0; d < HD; ++d) { q[d] = bf2f(Q[(size_t)(b * SEQ + t) * ATTW + h * HD + d]) * 0.125f; o[d] = 0.f; }
        const float* cm = cum + (size_t)bh * SEQ; const float ct = cm[t];
        float m = -INFINITY, l = 0.f;
        const int smax = tb * 64 + 63;
        for (int s = 0; s <= smax; ++s) {
            const bf16_t* kr = Kb + (size_t)(b * SEQ + s) * ATTW + h * HD; const bf16_t* vr = Vb + (size_t)(b * SEQ + s) * ATTW + h * HD;
            float lg = ct - cm[s];
#pragma unroll
            for (int d = 0; d < HD; ++d) lg += q[d] * bf2f(kr[d]);
            if (s <= t) {
                const float mn = fmaxf(m, lg), sc = expf(m - mn), pp = expf(lg - mn);
                l = l * sc + pp; m = mn;
#pragma unroll
                for (int d = 0; d < HD; ++d) o[d] = o[d] * sc + pp * bf2f(vr[d]);
            }
        }
        const float il = 1.f / l; float sq = 0.f;
#pragma unroll
        for (int d = 0; d < HD; ++d) { const float ov = o[d] * il; sq += ov * ov; MIX[(size_t)(b * SEQ + t) * D + SSMW + h * HD + d] = f2bf(ov); }
        ssp_att[(size_t)(b * SEQ + t) * 8 + h] = sq;
    }
}

__device__ __forceinline__ void ph_peer_select(unsigned char* sm, const bf16_t* __restrict__ qp, const float* __restrict__ keys, int* __restrict__ idx, float* __restrict__ gate) {
    PH_IDS
    const int team = TIDX >> 8, tid = TIDX & 255, lane = tid & 63, wave = tid >> 6;
    float* sc = (float*)(sm + team * 4096); float* tv = sc + 256; int* ti = (int*)(tv + 32); float* cand = (float*)(ti + 32);
    for (int it = BIDX; it < T * PH / 2; it += GDIM) {
        const int item = it * 2 + team, tok = item / PH, hd = item % PH;
        {
            const int half = tid >> 7, n = tid & 127;
            const bf16_t* q = qp + (size_t)tok * D + hd * QD + half * HALF; const float* kk = keys + ((size_t)(hd * 2 + half) * NK + n) * HALF;
            float s = 0.f;
            for (int d = 0; d < HALF; ++d) s += bf2f(q[d]) * kk[d];
            sc[tid] = s;
        }
        __syncthreads();
        if (wave == 0 || wave == 2) {
            const int half = wave >> 1;
            float v0 = sc[half * 128 + lane], v1 = sc[half * 128 + lane + 64];
            for (int k = 0; k < TOPK; ++k) {
                float bv; int bi;
                if (v0 >= v1) { bv = v0; bi = lane; } else { bv = v1; bi = lane + 64; }
#pragma unroll
                for (int o = 1; o < 64; o <<= 1) { const float ov = __shfl_xor(bv, o); const int oi = __shfl_xor(bi, o); if (ov > bv || (ov == bv && oi < bi)) { bv = ov; bi = oi; } }
                if (lane == 0) { tv[half * 16 + k] = bv; ti[half * 16 + k] = bi; }
                if (bi == lane) v0 = -INFINITY; if (bi == lane + 64) v1 = -INFINITY;
            }
        }
        __syncthreads();
        cand[tid] = tv[tid >> 4] + tv[16 + (tid & 15)];
        __syncthreads();
        if (wave == 0) {
            float v[4];
#pragma unroll
            for (int j = 0; j < 4; ++j) v[j] = cand[lane + 64 * j];
            float best = 0.f; int bidx = 0; float mx = 0.f, se = 0.f;
            for (int k = 0; k < TOPK; ++k) {
                float bv = v[0]; int bi = lane;
#pragma unroll
                for (int j = 1; j < 4; ++j) if (v[j] > bv) { bv = v[j]; bi = lane + 64 * j; }
#pragma unroll
                for (int o = 1; o < 64; o <<= 1) { const float ov = __shfl_xor(bv, o); const int oi = __shfl_xor(bi, o); if (ov > bv || (ov == bv && oi < bi)) { bv = ov; bi = oi; } }
                if (k == 0) mx = bv;
                const float e = expf(bv - mx); se += e;
                if (lane == k) { best = e; bidx = ti[bi >> 4] * NK + ti[16 + (bi & 15)]; }
#pragma unroll
                for (int j = 0; j < 4; ++j) if (bi == lane + 64 * j) v[j] = -INFINITY;
            }
            if (lane < TOPK) { idx[(size_t)tok * 128 + hd * TOPK + lane] = bidx; gate[(size_t)tok * 128 + hd * TOPK + lane] = best / se; }
        }
        __syncthreads();
    }
}

__device__ __forceinline__ void ph_peer_eval(unsigned char* sm, const float* __restrict__ ss2, const float* __restrict__ g2, const int* __restrict__ idx, const float* __restrict__ gate,
                                             const float* __restrict__ ut, const float* __restrict__ vt, float* __restrict__ h) {
    PH_IDS
    const int team = TIDX >> 8, tid = TIDX & 255, lane = tid & 63, wave = tid >> 6;
    float (*red)[D] = (float (*)[D])(sm + team * 16384);
    for (int it = BIDX; it < T / 2; it += GDIM) {
        const int tok = it * 2 + team;
        float4 x[4], acc[4];
#pragma unroll
        for (int j = 0; j < 4; ++j) { const float rs = rsqrtf(sum16(ss2 + (size_t)tok * 16) * (1.f / D) + EPS); const float4 hv = *(const float4*)(h + (size_t)tok * D + j * 256 + lane * 4); const float4 gv = *(const float4*)(g2 + j * 256 + lane * 4);
            x[j] = make_float4(hv.x * rs * gv.x, hv.y * rs * gv.y, hv.z * rs * gv.z, hv.w * rs * gv.w); acc[j] = make_float4(0.f, 0.f, 0.f, 0.f); }
        for (int k = 0; k < 32; ++k) {
            const int pr = wave * 32 + k; const int e = idx[(size_t)tok * 128 + pr]; const float gt = gate[(size_t)tok * 128 + pr];
            const float* ur = ut + (size_t)e * D; const float* vr = vt + (size_t)e * D;
            float s = 0.f;
#pragma unroll
            for (int j = 0; j < 4; ++j) { const float4 uv = *(const float4*)(ur + j * 256 + lane * 4); s += uv.x * x[j].x + uv.y * x[j].y + uv.z * x[j].z + uv.w * x[j].w; }
            s = wave_sum(s);
            const float cf = gelu_tanh(s) * gt;
#pragma unroll
            for (int j = 0; j < 4; ++j) { const float4 vv = *(const float4*)(vr + j * 256 + lane * 4); acc[j].x += cf * vv.x; acc[j].y += cf * vv.y; acc[j].z += cf * vv.z; acc[j].w += cf * vv.w; }
        }
#pragma unroll
        for (int j = 0; j < 4; ++j) *(float4*)&red[wave][j * 256 + lane * 4] = acc[j];
        __syncthreads();
        for (int c = tid; c < D; c += 256) h[(size_t)tok * D + c] += red[0][c] + red[1][c] + red[2][c] + red[3][c];
        __syncthreads();
    }
}
}
namespace nv {
__device__ __forceinline__ float sum8(const float* p);
__device__ __forceinline__ float sum16(const float* p);
#define XB_TMO      128
#define XB_XCNT(j)  (256  + 64 * (j))
#define XB_XSUB(j)  (1280 + 64 * (j))
#define XB_XGEN(j)  (2304 + 64 * (j))
#define XB_TOP      3328
#define XB_TOPGEN   3392
#define XCD_BAR_WORDS 3456
#define XB_SPIN_CAP (1u << 24)
__device__ __forceinline__ unsigned xb_ld(unsigned* p)              { return __hip_atomic_load(p, __ATOMIC_RELAXED, __HIP_MEMORY_SCOPE_AGENT); }
__device__ __forceinline__ unsigned xb_add(unsigned* p, unsigned v) { return __hip_atomic_fetch_add(p, v, __ATOMIC_RELAXED, __HIP_MEMORY_SCOPE_AGENT); }
__device__ __forceinline__ unsigned xb_xcc_id() { return (unsigned)__builtin_amdgcn_s_getreg((3 << 11) | 20) & 0xFu; }
#define XB_SPIN(cond, bar) do { unsigned _sp = 0; while (cond) { __builtin_amdgcn_s_sleep(1); \
    if ((++_sp & 255u) == 0u) { if (xb_ld(&(bar)[XB_TMO])) break; if (_sp > XB_SPIN_CAP) { atomicAdd(&(bar)[XB_TMO], 1u); break; } } } } while (0)
struct XcdBarrier { unsigned* bar; unsigned x; volatile LAS unsigned* st; };
__device__ __forceinline__ XcdBarrier xcd_barrier_post(unsigned* bar, volatile LAS unsigned* st) {
    XcdBarrier b; b.bar = bar; b.x = xb_xcc_id(); b.st = st;
    if (threadIdx.x == 0) (void)xb_add(&bar[XB_XCNT(b.x)], 1u);
    return b;
}
__device__ __forceinline__ void xcd_barrier_complete(unsigned* bar, unsigned x, unsigned& nloc, unsigned& nx) {
    const unsigned Gsz = gridDim.x * gridDim.y * gridDim.z;
    unsigned sum, cnt, mine, sp = 0u;
    for (;;) {
        sum = 0u; cnt = 0u; mine = 0u;
#pragma unroll
        for (unsigned j = 0; j < 16; ++j) { const unsigned c = xb_ld(&bar[XB_XCNT(j)]); sum += c; cnt += (c > 0u) ? 1u : 0u; mine = (j == x) ? c : mine; }
        if (sum == Gsz) break;
        __builtin_amdgcn_s_sleep(1);
        if ((++sp & 255u) == 0u) { if (xb_ld(&bar[XB_TMO])) break; if (sp > XB_SPIN_CAP) { atomicAdd(&bar[XB_TMO], 1u); break; } }
    }
    nloc = mine > 0u ? mine : 1u; nx = cnt > 0u ? cnt : 1u;
}
__device__ __forceinline__ void xcd_barrier(const XcdBarrier& b) {
    asm volatile("s_waitcnt vmcnt(0)" ::: "memory");
    __syncthreads();
    if (threadIdx.x == 0) {
        unsigned* bar = b.bar;
        __builtin_amdgcn_s_waitcnt(0);
        unsigned nloc = b.st[0], nx = b.st[1];
        if (nloc == 0u) { xcd_barrier_complete(bar, b.x, nloc, nx); b.st[0] = nloc; b.st[1] = nx; }
        const unsigned old = xb_add(&bar[XB_XSUB(b.x)], 1u);
        const unsigned gen = old / nloc;
        if (old + 1u == (gen + 1u) * nloc) {
            __builtin_amdgcn_fence(__ATOMIC_RELEASE, "agent");
            asm volatile("s_waitcnt vmcnt(0)" ::: "memory");
            const unsigned og = xb_add(&bar[XB_TOP], 1u);
            const unsigned tg = og / nx;
            if (og + 1u == (tg + 1u) * nx) xb_add(&bar[XB_TOPGEN], 1u);
            else XB_SPIN(xb_ld(&bar[XB_TOPGEN]) == tg, bar);
            __builtin_amdgcn_fence(__ATOMIC_ACQUIRE, "agent");
            xb_add(&bar[XB_XGEN(b.x)], 1u);
            asm volatile("s_waitcnt vmcnt(0)" ::: "memory");
        } else {
            XB_SPIN(xb_ld(&bar[XB_XGEN(b.x)]) == gen, bar);
            __builtin_amdgcn_fence(__ATOMIC_ACQUIRE, "agent");
            asm volatile("s_waitcnt vmcnt(0)" ::: "memory");
        }
    }
    __syncthreads();
}

#define LDS_WAIT() asm volatile("s_waitcnt lgkmcnt(0)" ::: "memory")
template <class Sc>
__device__ __forceinline__ void p0_transpose_item(const float* __restrict__ W, int ldw, int K, int Ncols, Sc sc, bf16_t* __restrict__ WT, LAS float* scr, int item, int lane) {
    const int nblk = Ncols / 32, kb = item / nblk, nb = item % nblk, k0 = 64 * kb, n0 = 32 * nb;
#pragma unroll 8
    for (int i = 0; i < 32; ++i) { const int kk = 2 * i + (lane >> 5); scr[kk * 33 + (lane & 31)] = W[(size_t)(k0 + kk) * ldw + n0 + (lane & 31)] * sc(k0 + kk); }
    LDS_WAIT(); asm volatile("" ::: "memory");
    const int c = lane & 7;
#pragma unroll
    for (int j = 0; j < 4; ++j) { const int n = (lane >> 3) + 8 * j; const LAS float* s = scr + (8 * c) * 33 + n;
        u32x4 o; o.x = pk2(s[0 * 33], s[1 * 33]); o.y = pk2(s[2 * 33], s[3 * 33]); o.z = pk2(s[4 * 33], s[5 * 33]); o.w = pk2(s[6 * 33], s[7 * 33]);
        *(u32x4*)(WT + (size_t)(n0 + n) * K + k0 + 8 * c) = o; }
    LDS_WAIT(); asm volatile("" ::: "memory");
}
struct ScVec { const float* g; __device__ __forceinline__ float operator()(int k) const { return g[k]; } };
struct ScOne { __device__ __forceinline__ float operator()(int) const { return 1.f; } };
struct ScTwo { const float* g0; const float* g1; __device__ __forceinline__ float operator()(int k) const { return k < 512 ? g0[k] : g1[k - 512]; } };

constexpr int TAB_OFF = 131072 + 1024;
__device__ __forceinline__ void* ldarg(LAS unsigned char* lds, int i) {
    unsigned off = TAB_OFF + 8 * i; asm volatile("" : "+s"(off));
    const unsigned long long v = *(volatile LAS unsigned long long*)(lds + off);
    const unsigned lo = __builtin_amdgcn_readfirstlane((unsigned)v), hi = __builtin_amdgcn_readfirstlane((unsigned)(v >> 32));
    return (void*)(((unsigned long long)hi << 32) | lo);
}

__device__ __forceinline__ void p0_prologue(LAS unsigned char* lds) {
    PH_IDS
    const int lane = TIDX & 63, wave = TIDX >> 6, gw = BIDX * 8 + wave, ngw = GDIM * 8;
    LAS float* scr = (LAS float*)(lds + wave * 16384);
    unsigned char* ws = (unsigned char*)ldarg(lds, 24);
    const float* a0 = (const float*)ldarg(lds, 0); const float* a1 = (const float*)ldarg(lds, 1); const float* a2 = (const float*)ldarg(lds, 2); const float* a11 = (const float*)ldarg(lds, 11);
    const float* a14 = (const float*)ldarg(lds, 14); const float* a15 = (const float*)ldarg(lds, 15); const float* a16 = (const float*)ldarg(lds, 16); const float* a17 = (const float*)ldarg(lds, 17); const float* a18 = (const float*)ldarg(lds, 18);
    constexpr int I1 = (D / 64) * (2048 / 32), I2 = (SSMW / 64) * (SSMW / 32), I3 = (D / 64) * (D / 32), I4 = I3, IL = I1 + I2 + I3 + I4;
    for (int it = gw; it < DEPTH * IL; it += ngw) {
        const int l = it / IL; int r = it % IL;
        if (r < I1) { p0_transpose_item(a2 + (size_t)l * D * INW, INW, D, 2048, ScVec{a1 + l * D}, (bf16_t*)(ws + WS_BT1) + (size_t)l * 2048 * D, scr, r, lane); continue; } r -= I1;
        if (r < I2) { p0_transpose_item(a11 + (size_t)l * SSMW * SSMW, SSMW, SSMW, SSMW, ScOne{}, (bf16_t*)(ws + WS_BT2) + (size_t)l * SSMW * SSMW, scr, r, lane); continue; } r -= I2;
        if (r < I3) { p0_transpose_item(a16 + (size_t)l * D * D, D, D, D, ScTwo{a14 + l * SSMW, a15 + l * ATTW}, (bf16_t*)(ws + WS_BT3) + (size_t)l * D * D, scr, r, lane); continue; } r -= I3;
        p0_transpose_item(a18 + (size_t)l * D * D, D, D, D, ScVec{a17 + l * D}, (bf16_t*)(ws + WS_BT4) + (size_t)l * D * D, scr, r, lane);
    }
    for (int i = BIDX * 512 + TIDX; i < DEPTH * 16 * D; i += GDIM * 512) {
        const int l = i / (16 * D), j = (i / D) % 16, k = i % D;
        const float v = j < 8 ? a2[((size_t)l * D + k) * INW + 2048 + j] * a1[l * D + k] : 0.f;
        ((bf16_t*)(ws + WS_WF))[i] = f2bf(v);
    }
    {
        const float* x = a0; float* h = (float*)(ws + WS_H); bf16_t* hb = (bf16_t*)(ws + WS_HB); float* ssp1 = (float*)(ws + WS_SSP) + (size_t)T * 32;
        for (int w = gw; w < T; w += ngw) {
            const f32x4* r = (const f32x4*)(x + (size_t)w * D) + lane; f32x4* hr = (f32x4*)(h + (size_t)w * D) + lane; unsigned long long* o = (unsigned long long*)(hb + (size_t)w * D) + lane;
            float s = 0.f;
#pragma unroll
            for (int j = 0; j < 4; ++j) { const f32x4 v = r[64 * j]; hr[64 * j] = v; s += v.x * v.x + v.y * v.y + v.z * v.z + v.w * v.w; o[64 * j] = (unsigned long long)pk2(v.x, v.y) | ((unsigned long long)pk2(v.z, v.w) << 32); }
            s = wave_sum(s);
            if (lane < 8) ssp1[(size_t)w * 8 + lane] = lane == 0 ? s : 0.f;
        }
    }
}

struct SchedGen {
    static constexpr bool DUALB = false; long hB1;
    __device__ __forceinline__ bool sb(const ge::Unit&, int) const { return false; }
    __device__ __forceinline__ unsigned voffB1(int, int) const { return 0u; }
    const char* A; const char* B; int a_row_b, a_c16_b, b_row_b, b_c16_b; long a_pm_b, a_kt_b, b_pn_b, b_kt_b; int nM, nN, nt, G, c; long hA, hB;
    __device__ __forceinline__ void init_plain(const void* A_, int lda_bytes, const void* B_, int ldb_bytes, int M, int N, int K, int G_, int c_) {
        A = (const char*)A_; B = (const char*)B_; a_row_b = lda_bytes; a_c16_b = 32; b_row_b = ldb_bytes; b_c16_b = 32; a_pm_b = 256l * lda_bytes; a_kt_b = 128; b_pn_b = 256l * ldb_bytes; b_kt_b = 128;
        nM = M / 256; nN = N / 256; nt = K / 64; G = G_; c = c_; hA = 128l * lda_bytes; hB = 128l * ldb_bytes; }
    __device__ __forceinline__ bool next(int i, ge::Unit& u) const {
        int pm, pn; if (!ge::static_tile(i, G, c, nM, nN, pm, pn)) return false;
        u.A0 = A + (size_t)pm * a_pm_b; u.B0 = B + (size_t)pn * b_pn_b; u.nt = nt; u.pm = pm; u.pn = pn; u.aux = 0; return true; }
    __device__ __forceinline__ const char* ta(const ge::Unit& u, int t) const { return u.A0 + t * a_kt_b; }
    __device__ __forceinline__ const char* tb(const ge::Unit& u, int t) const { return u.B0 + t * b_kt_b; }
    __device__ __forceinline__ unsigned voffA(int R, int C) const { return (unsigned)(R * a_row_b + (C >> 4) * a_c16_b + (C & 15) * 2); }
    __device__ __forceinline__ unsigned voffB(int Rb, int C) const { return (unsigned)(Rb * b_row_b + (C >> 4) * b_c16_b + (C & 15) * 2); }
};
typedef SchedGen SchedPlain;

constexpr float QSCALE = 0.125f * 1.4426950408889634f;
struct EpiInProj {
    static constexpr bool PERM = true, MIDK = false, UBEGIN = true;
    const float* ssp1; bf16_t* UP; bf16_t* QKV;
    __device__ __forceinline__ void unit_begin(const ge::Unit& u, int tid, LAS unsigned char* rowf) const {
        if (tid < 256) { const int row = u.pm * 256 + tid; ((LAS float*)rowf)[tid] = rsqrtf(sum8(ssp1 + (size_t)row * 8) * (1.f / D) + EPS); }
    }
    __device__ __forceinline__ void midk(ge::f32x4 (&)[2][2][4][2], const ge::Unit&, int, int, LAS unsigned char*) const {}
    __device__ __forceinline__ void operator()(const ge::f32x4 (&acc)[2][2][4][2], const ge::Unit& u, int wr, int wc, int fr, int fq, LAS unsigned char* rowf) const {
        const int row0 = u.pm * 256 + wr * 64 + fr, colt = u.pn * 256, region = colt >> 9;
        bf16_t* dstb = QKV + (size_t)(region - 1) * ((WS_K - WS_Q) / 2);
#pragma unroll
        for (int ai = 0; ai < 2; ++ai)
#pragma unroll
            for (int m = 0; m < 4; ++m) {
                const int row = row0 + ai * 128 + m * 16; const float rs = ((const LAS float*)rowf)[ai * 128 + wr * 64 + m * 16 + fr];
#pragma unroll
                for (int bj = 0; bj < 2; ++bj) {
                    const int c = (colt & 511) + bj * 128 + wc * 32 + 8 * fq;
                    const float rq = region == 1 ? rs * QSCALE : rs;
                    const ge::f32x4 v0 = acc[ai][bj][m][0] * rq, v1 = acc[ai][bj][m][1] * rq;
                    u32x4 w; w.x = ge::cvt_pk_bf16(v0[0], v0[1]); w.y = ge::cvt_pk_bf16(v0[2], v0[3]); w.z = ge::cvt_pk_bf16(v1[0], v1[1]); w.w = ge::cvt_pk_bf16(v1[2], v1[3]);
                    bf16_t* dst = region == 0 ? UP + up_index(row, c) : dstb + (size_t)row * 512 + c;
                    *(u32x4*)dst = w;
                }
            }
    }
};

__device__ __forceinline__ float sum8(const float* p) { const ge::f32x4 a = *(const ge::f32x4*)p, b = *(const ge::f32x4*)(p + 4); return ((a[0] + a[1]) + (a[2] + a[3])) + ((b[0] + b[1]) + (b[2] + b[3])); }
__device__ __forceinline__ float sum16(const float* p) { return sum8(p) + sum8(p + 8); }
__device__ __forceinline__ size_t gel_index(int row, int c) { return ((size_t)(c >> 4) * T + row) * HC + (c & 15); }
__device__ __forceinline__ float sigmoidf_(float x) { return 1.f / (1.f + __expf(-x)); }
struct EpiGlu2 {
    static constexpr bool PERM = true, MIDK = false, UBEGIN = false;
    const bf16_t* GEL; const float* bias; bf16_t* MIX; float* ssp;
    __device__ __forceinline__ void unit_begin(const ge::Unit&, int, LAS unsigned char*) const {}
    __device__ __forceinline__ void midk(ge::f32x4 (&)[2][2][4][2], const ge::Unit&, int, int, LAS unsigned char*) const {}
    __device__ __forceinline__ void operator()(const ge::f32x4 (&acc)[2][2][4][2], const ge::Unit& u, int wr, int wc, int fr, int fq, LAS unsigned char*) const {
        const int row0 = u.pm * 256 + wr * 64 + fr, colt = u.pn * 256;
#pragma unroll
        for (int ai = 0; ai < 2; ++ai)
#pragma unroll
            for (int m = 0; m < 4; ++m) {
                const int row = row0 + ai * 128 + m * 16; float sq = 0.f;
#pragma unroll
                for (int bj = 0; bj < 2; ++bj) {
                    const int c = colt + bj * 128 + wc * 32 + 8 * fq;
                    const ge::f32x4 b0 = *(const ge::f32x4*)(bias + c), b1 = *(const ge::f32x4*)(bias + c + 4);
                    const u32x4 gw = *(const u32x4*)(GEL + gel_index(row, c));
                    const ge::f32x4 v0 = acc[ai][bj][m][0] + b0, v1 = acc[ai][bj][m][1] + b1;
                    float o[8];
                    o[0] = __uint_as_float(gw.x << 16) * sigmoidf_(v0[0]); o[1] = __uint_as_float(gw.x & 0xffff0000u) * sigmoidf_(v0[1]);
                    o[2] = __uint_as_float(gw.y << 16) * sigmoidf_(v0[2]); o[3] = __uint_as_float(gw.y & 0xffff0000u) * sigmoidf_(v0[3]);
                    o[4] = __uint_as_float(gw.z << 16) * sigmoidf_(v1[0]); o[5] = __uint_as_float(gw.z & 0xffff0000u) * sigmoidf_(v1[1]);
                    o[6] = __uint_as_float(gw.w << 16) * sigmoidf_(v1[2]); o[7] = __uint_as_float(gw.w & 0xffff0000u) * sigmoidf_(v1[3]);
#pragma unroll
                    for (int e = 0; e < 8; ++e) sq += o[e] * o[e];
                    u32x4 w; w.x = ge::cvt_pk_bf16(o[0], o[1]); w.y = ge::cvt_pk_bf16(o[2], o[3]); w.z = ge::cvt_pk_bf16(o[4], o[5]); w.w = ge::cvt_pk_bf16(o[6], o[7]);
                    *(u32x4*)(MIX + (size_t)row * D + c) = w;
                }
                sq += __shfl_xor(sq, 16); sq += __shfl_xor(sq, 32);
                if (fq == 0) ssp[(size_t)row * 8 + u.pn * 4 + wc] = sq;
            }
    }
};
struct EpiWo {
    static constexpr bool PERM = true, MIDK = true, UBEGIN = true;
    const float* ssp_s; const float* ssp_a; const float* hin; float* h; bf16_t* hb; float* ssp2;
    typedef float f32x2_ __attribute__((ext_vector_type(2)));
    __device__ __forceinline__ void unit_begin(const ge::Unit& u, int tid, LAS unsigned char* rowf) const {
        if (tid < 256) { const int row = u.pm * 256 + tid;
            const float rs_s = rsqrtf(sum8(ssp_s + (size_t)row * 8) * (1.f / SSMW) + EPS), rs_a = rsqrtf(sum8(ssp_a + (size_t)row * 8) * (1.f / ATTW) + EPS);
            ((LAS f32x2_*)rowf)[tid] = (f32x2_){rs_s / rs_a, rs_a}; }
    }
    __device__ __forceinline__ void midk(ge::f32x4 (&acc)[2][2][4][2], const ge::Unit& u, int wr, int fr, LAS unsigned char* rowf) const {
#pragma unroll
        for (int ai = 0; ai < 2; ++ai)
#pragma unroll
            for (int m = 0; m < 4; ++m) {
                const float f = ((const LAS f32x2_*)rowf)[ai * 128 + wr * 64 + m * 16 + fr].x;
#pragma unroll
                for (int bj = 0; bj < 2; ++bj)
#pragma unroll
                    for (int n = 0; n < 2; ++n) acc[ai][bj][m][n] = acc[ai][bj][m][n] * f;
            }
    }
    __device__ __forceinline__ void operator()(const ge::f32x4 (&acc)[2][2][4][2], const ge::Unit& u, int wr, int wc, int fr, int fq, LAS unsigned char* rowf) const {
        const int row0 = u.pm * 256 + wr * 64 + fr, colt = u.pn * 256;
#pragma unroll
        for (int ai = 0; ai < 2; ++ai)
#pragma unroll
            for (int m = 0; m < 4; ++m) {
                const int row = row0 + ai * 128 + m * 16; const float ra = ((const LAS f32x2_*)rowf)[ai * 128 + wr * 64 + m * 16 + fr].y; float sq = 0.f;
#pragma unroll
                for (int bj = 0; bj < 2; ++bj) {
                    const int c = colt + bj * 128 + wc * 32 + 8 * fq;
                    const size_t o = (size_t)row * D + c;
                    ge::f32x4 h0 = *(const ge::f32x4*)(hin + o), h1 = *(const ge::f32x4*)(hin + o + 4);
                    h0 = h0 + acc[ai][bj][m][0] * ra; h1 = h1 + acc[ai][bj][m][1] * ra;
                    *(ge::f32x4*)(h + o) = h0; *(ge::f32x4*)(h + o + 4) = h1;
                    sq += (h0[0] * h0[0] + h0[1] * h0[1]) + (h0[2] * h0[2] + h0[3] * h0[3]) + (h1[0] * h1[0] + h1[1] * h1[1]) + (h1[2] * h1[2] + h1[3] * h1[3]);
                    u32x4 w; w.x = ge::cvt_pk_bf16(h0[0], h0[1]); w.y = ge::cvt_pk_bf16(h0[2], h0[3]); w.z = ge::cvt_pk_bf16(h1[0], h1[1]); w.w = ge::cvt_pk_bf16(h1[2], h1[3]);
                    *(u32x4*)(hb + o) = w;
                }
                sq += __shfl_xor(sq, 16); sq += __shfl_xor(sq, 32);
                if (fq == 0) ssp2[(size_t)row * 16 + u.pn * 4 + wc] = sq;
            }
    }
};
struct EpiWq {
    static constexpr bool PERM = true, MIDK = false, UBEGIN = true;
    const float* ssp2; bf16_t* QP;
    __device__ __forceinline__ void unit_begin(const ge::Unit& u, int tid, LAS unsigned char* rowf) const {
        if (tid < 256) { const int row = u.pm * 256 + tid; ((LAS float*)rowf)[tid] = rsqrtf(sum16(ssp2 + (size_t)row * 16) * (1.f / D) + EPS); }
    }
    __device__ __forceinline__ void midk(ge::f32x4 (&)[2][2][4][2], const ge::Unit&, int, int, LAS unsigned char*) const {}
    __device__ __forceinline__ void operator()(const ge::f32x4 (&acc)[2][2][4][2], const ge::Unit& u, int wr, int wc, int fr, int fq, LAS unsigned char* rowf) const {
        const int row0 = u.pm * 256 + wr * 64 + fr, colt = u.pn * 256;
#pragma unroll
        for (int ai = 0; ai < 2; ++ai)
#pragma unroll
            for (int m = 0; m < 4; ++m) {
                const int row = row0 + ai * 128 + m * 16; const float rs = ((const LAS float*)rowf)[ai * 128 + wr * 64 + m * 16 + fr];
#pragma unroll
                for (int bj = 0; bj < 2; ++bj) {
                    const int c = colt + bj * 128 + wc * 32 + 8 * fq;
                    const ge::f32x4 v0 = acc[ai][bj][m][0] * rs, v1 = acc[ai][bj][m][1] * rs;
                    u32x4 w; w.x = ge::cvt_pk_bf16(v0[0], v0[1]); w.y = ge::cvt_pk_bf16(v0[2], v0[3]); w.z = ge::cvt_pk_bf16(v1[0], v1[1]); w.w = ge::cvt_pk_bf16(v1[2], v1[3]);
                    *(u32x4*)(QP + (size_t)row * D + c) = w;
                }
            }
    }
};

__device__ __forceinline__ void ph_flogit(const bf16_t* __restrict__ hb, const bf16_t* __restrict__ wf, const float* __restrict__ ss, const float* __restrict__ bfv, float* __restrict__ logf) {
    PH_IDS
    const int lane = TIDX & 63, gw = BIDX * 8 + (TIDX >> 6), ngw = GDIM * 8, r16 = lane & 15, q4 = lane >> 4;
    for (int item = gw; item < T / 16; item += ngw) {
        const int tok0 = item * 16;
        ge::f32x4 acc = {0.f, 0.f, 0.f, 0.f};
        const bf16_t* ar = hb + (size_t)(tok0 + r16) * D + q4 * 8; const bf16_t* br = wf + (size_t)r16 * D + q4 * 8;
#pragma unroll 8
        for (int ks = 0; ks < D / 32; ++ks) {
            const bf16x8 a = *(const bf16x8*)(ar + ks * 32), b = *(const bf16x8*)(br + ks * 32);
            acc = __builtin_amdgcn_mfma_f32_16x16x32_bf16(a, b, acc, 0, 0, 0);
        }
        if (r16 < NH) {
            const float bj = bfv[r16];
#pragma unroll
            for (int r = 0; r < 4; ++r) {
                const int tok = tok0 + 4 * q4 + r; const float x = acc[r] * rsqrtf(sum8(ss + (size_t)tok * 8) * (1.f / D) + EPS) + bj;
                logf[(size_t)tok * NH + r16] = fminf(x, 0.f) - log1pf(expf(-fabsf(x)));
            }
        }
    }
}
}
namespace nv {
__device__ __forceinline__ float gelu_fast(float x);
constexpr float USCALE = 256.f, VSCALE = 16.f;
typedef float f32x2 __attribute__((ext_vector_type(2)));
typedef int i32x2 __attribute__((ext_vector_type(2)));
__device__ __forceinline__ float clamp448(float x) { return fminf(fmaxf(x, -448.f), 448.f); }
__device__ __forceinline__ unsigned pack4_fp8(float a, float b, float c, float d) {
    int w = 0; w = __builtin_amdgcn_cvt_pk_fp8_f32(clamp448(a), clamp448(b), w, false); w = __builtin_amdgcn_cvt_pk_fp8_f32(clamp448(c), clamp448(d), w, true); return (unsigned)w; }

__device__ __forceinline__ void peer_split(LAS unsigned char* lds, int bid, int grid, int wave, int& slice, int& gw, int& ngw) {
    volatile LAS unsigned* M = (volatile LAS unsigned*)(lds + 131072 + 320);
    const unsigned x = __builtin_amdgcn_readfirstlane(M[16]), rk = __builtin_amdgcn_readfirstlane(M[17]), nl = __builtin_amdgcn_readfirstlane(M[18]), ok = __builtin_amdgcn_readfirstlane(M[19]);
    if (ok) { slice = (int)x; gw = (int)rk * 8 + wave; ngw = (int)nl * 8; }
    else { slice = bid & 7; gw = (bid >> 3) * 8 + wave; ngw = (grid >> 3) * 8; }
}
__device__ __forceinline__ void p0_peer_tables(const float* __restrict__ pu, const float* __restrict__ pv, const float* __restrict__ g2, unsigned char* __restrict__ PU8, unsigned char* __restrict__ PV8) {
    PH_IDS
    const size_t n16 = (size_t)DEPTH * NEXP * D / 16;
    for (size_t i = (size_t)BIDX * 512 + TIDX; i < 2 * n16; i += (size_t)GDIM * 512) {
        const bool isv = i >= n16; const size_t j = isv ? i - n16 : i; const size_t e0 = j * 16;
        const float* src = (isv ? pv : pu) + e0;
        const int l = (int)(e0 / ((size_t)NEXP * D)), c = (int)(e0 % D);
        f32x4 x[4];
#pragma unroll
        for (int k = 0; k < 4; ++k) x[k] = *(const f32x4*)(src + 4 * k);
        u32x4 o;
        if (isv) {
#pragma unroll
            for (int k = 0; k < 4; ++k) o[k] = pack4_fp8(x[k].x * VSCALE, x[k].y * VSCALE, x[k].z * VSCALE, x[k].w * VSCALE);
        } else {
#pragma unroll
            for (int k = 0; k < 4; ++k) { const f32x4 g = *(const f32x4*)(g2 + l * D + c + 4 * k) * USCALE; o[k] = pack4_fp8(x[k].x * g.x, x[k].y * g.y, x[k].z * g.z, x[k].w * g.w); }
        }
        const size_t er = (e0 / D) % NEXP;
        *(u32x4*)((isv ? PV8 : PU8) + (((size_t)l * 8 + (c >> 7)) * NEXP + er) * 128 + (c & 127)) = o;
    }
}

constexpr int PB = 16;
__device__ __forceinline__ unsigned pack4_fp8_nc(float a, float b, float c, float d) { int w = 0; w = __builtin_amdgcn_cvt_pk_fp8_f32(a, b, w, false); w = __builtin_amdgcn_cvt_pk_fp8_f32(c, d, w, true); return (unsigned)w; }
__device__ __forceinline__ float dpp_xor1(float x) { return __int_as_float(__builtin_amdgcn_update_dpp(0, __float_as_int(x), 0xB1, 0xF, 0xF, true)); }
template <int MODE = 0>
__device__ __forceinline__ void ph_peer_u(LAS unsigned char* lds, const unsigned char* __restrict__ PU8, const bf16_t* __restrict__ hb, const int* __restrict__ idx, float* __restrict__ partial, int imask = 0x7fffffff) {
    PH_IDS
    const int lane = TIDX & 63, wave = TIDX >> 6, r = lane & 15, q = lane >> 4;
    int slice, gw, ngw; peer_split(lds, BIDX, GDIM, wave, slice, gw, ngw);
    const unsigned char* tab = PU8 + (size_t)slice * NEXP * 128 + 16 * q;
    LAS int* li = (LAS int*)(lds + wave * 12288);
    LAS u32x4* lh = (LAS u32x4*)(lds + wave * 12288 + 8192);
    const int ntok = gw < T ? (T - gw + ngw - 1) / ngw : 0;
    const int p0 = 2 * lane, sd0 = (p0 >> 6) * 64 + (p0 & 15) * 4 + ((p0 & 63) >> 4), sd1 = sd0 + 4;
    for (int tb = 0; tb < ntok; tb += PB) {
        const int nb = min(PB, ntok - tb);
        for (int k = 0; k < nb; ++k) {
            const size_t t = (size_t)gw + (size_t)(tb + k) * ngw;
            i32x2 v = *(const i32x2*)(idx + t * 128 + 2 * lane); v.x &= imask; v.y &= imask; li[k * 128 + sd0] = v.x; li[k * 128 + sd1] = v.y;
            if (lane < 16) lh[k * 16 + lane] = *(const u32x4*)(hb + t * D + 128 * slice + 8 * lane);
        }
        asm volatile("s_waitcnt vmcnt(0) lgkmcnt(0)" ::: "memory");
        const int nstep = 2 * nb;
        u32x4 rb[2][4][2]; long bop[2][2];
#define PU_ISSUE(s, B) do { const ge::u32x4 ii_ = *(const LAS ge::u32x4*)(li + (s) * 64 + r * 4); _Pragma("unroll") for (int m_ = 0; m_ < 4; ++m_) { const unsigned char* rp_ = tab + (size_t)ii_[m_] * 128; \
            rb[B][m_][0] = *(const u32x4*)rp_; rb[B][m_][1] = *(const u32x4*)(rp_ + 64); } } while (0)
#define PU_STEP(s, B, HALF) do { if ((s) < nstep) { if ((s) + 1 < nstep) PU_ISSUE((s) + 1, (B) ^ 1); \
            const int k_ = (s) >> 1; const size_t t_ = (size_t)gw + (size_t)(tb + k_) * ngw; \
            if (HALF == 0) { _Pragma("unroll") for (int s2 = 0; s2 < 2; ++s2) _Pragma("unroll") for (int hf = 0; hf < 2; ++hf) { \
                const u32x4 w = lh[k_ * 16 + 8 * s2 + 2 * q + hf]; float x[8]; \
                _Pragma("unroll") for (int j = 0; j < 4; ++j) { x[2 * j] = __uint_as_float(w[j] << 16); x[2 * j + 1] = __uint_as_float(w[j] & 0xffff0000u); } \
                const unsigned h0 = pack4_fp8_nc(x[0], x[1], x[2], x[3]), h1 = pack4_fp8_nc(x[4], x[5], x[6], x[7]); \
                const f32x2 a0 = __builtin_amdgcn_cvt_pk_f32_fp8((int)h0, false), a1 = __builtin_amdgcn_cvt_pk_f32_fp8((int)h0, true), a2 = __builtin_amdgcn_cvt_pk_f32_fp8((int)h1, false), a3 = __builtin_amdgcn_cvt_pk_f32_fp8((int)h1, true); \
                const unsigned l0 = pack4_fp8_nc(x[0] - a0.x, x[1] - a0.y, x[2] - a1.x, x[3] - a1.y), l1 = pack4_fp8_nc(x[4] - a2.x, x[5] - a2.y, x[6] - a3.x, x[7] - a3.y); \
                const unsigned lo32 = r == 0 ? h0 : (r == 1 ? l0 : 0u), hi32 = r == 0 ? h1 : (r == 1 ? l1 : 0u); \
                bop[s2][hf] = (long)(((unsigned long long)hi32 << 32) | lo32); } } \
            _Pragma("unroll") for (int m = 0; m < 4; ++m) { ge::f32x4 acc = {0.f, 0.f, 0.f, 0.f}; \
                _Pragma("unroll") for (int s2 = 0; s2 < 2; ++s2) { const u32x4 av = rb[B][m][s2]; \
                    const long alo = (long)(((unsigned long long)av.y << 32) | av.x), ahi = (long)(((unsigned long long)av.w << 32) | av.z); \
                    acc = __builtin_amdgcn_mfma_f32_16x16x32_fp8_fp8(alo, bop[s2][0], acc, 0, 0, 0); acc = __builtin_amdgcn_mfma_f32_16x16x32_fp8_fp8(ahi, bop[s2][1], acc, 0, 0, 0); } \
                ge::f32x4 tot; _Pragma("unroll") for (int i = 0; i < 4; ++i) tot[i] = acc[i] + dpp_xor1(acc[i]); \
                if (r == 0) *(ge::f32x4*)(partial + ((size_t)slice * T + t_) * 128 + 64 * HALF + 16 * m + 4 * q) = tot; } } } while (0)
        PU_ISSUE(0, 0);
        for (int s0 = 0; s0 < nstep; s0 += 2) { PU_STEP(s0, 0, 0); PU_STEP(s0 + 1, 1, 1); }
#undef PU_ISSUE
#undef PU_STEP
        asm volatile("s_waitcnt lgkmcnt(0)" ::: "memory");
    }
}

__device__ __forceinline__ void ph_peer_coef(const float* __restrict__ partial, const float* __restrict__ ssp2, const float* __restrict__ gate, float* __restrict__ coef) {
    PH_IDS
    const size_t n4 = (size_t)T * 128 / 4, stride = (size_t)GDIM * 512;
    for (size_t i0 = (size_t)BIDX * 512 + TIDX; i0 < n4; i0 += 2 * stride) {
        f32x4 pv[2][8], gv[2]; float rs[2];
#pragma unroll
        for (int u = 0; u < 2; ++u) { const size_t i = i0 + u * stride;
            if (i < n4) {
#pragma unroll
                for (int k = 0; k < 8; ++k) pv[u][k] = *(const f32x4*)(partial + (size_t)k * T * 128 + 4 * i);
                gv[u] = *(const f32x4*)(gate + 4 * i); rs[u] = sum16(ssp2 + (i >> 5) * 16);
            } }
#pragma unroll
        for (int u = 0; u < 2; ++u) { const size_t i = i0 + u * stride;
            if (i < n4) {
                f32x4 s = ((pv[u][0] + pv[u][1]) + (pv[u][2] + pv[u][3])) + ((pv[u][4] + pv[u][5]) + (pv[u][6] + pv[u][7]));
                const float sc = rsqrtf(rs[u] * (1.f / D) + EPS) * (1.f / USCALE);
                f32x4 o; o.x = gelu_fast(s.x * sc) * gv[u].x; o.y = gelu_fast(s.y * sc) * gv[u].y; o.z = gelu_fast(s.z * sc) * gv[u].z; o.w = gelu_fast(s.w * sc) * gv[u].w;
                *(f32x4*)(coef + 4 * i) = o;
            } }
    }
}

__device__ __forceinline__ float dpp_ror8(float x) { return __int_as_float(__builtin_amdgcn_update_dpp(0, __float_as_int(x), 0x128, 0xF, 0xF, true)); }
template <int MODE = 0>
__device__ __forceinline__ void ph_peer_v(LAS unsigned char* lds, const unsigned char* __restrict__ PV8, const int* __restrict__ idx, const float* __restrict__ coef, const float* hin, float* h, bf16_t* __restrict__ hb, float* __restrict__ ssp1, int imask = 0x7fffffff) {
    PH_IDS
    const int lane = TIDX & 63, wave = TIDX >> 6, c8 = lane & 7, rg = lane >> 3;
    int slice, gw, ngw; peer_split(lds, BIDX, GDIM, wave, slice, gw, ngw);
    const unsigned char* tab = PV8 + (size_t)slice * NEXP * 128 + 16 * c8;
    LAS int* li = (LAS int*)(lds + wave * 16384);
    LAS float* lc = (LAS float*)(lds + wave * 16384 + 8192);
    const int ntok = gw < T ? (T - gw + ngw - 1) / ngw : 0;
    const int p0 = 2 * lane, sd0 = (p0 >> 6) * 64 + (p0 & 7) * 8 + ((p0 & 63) >> 3), sd1 = sd0 + 8;
    const int colo = 128 * slice + 16 * c8 + 2 * rg;
    for (int tb = 0; tb < ntok; tb += PB) {
        const int nb = min(PB, ntok - tb);
        for (int k = 0; k < nb; ++k) {
            const size_t t = (size_t)gw + (size_t)(tb + k) * ngw;
            i32x2 v = *(const i32x2*)(idx + t * 128 + 2 * lane); v.x &= imask; v.y &= imask; const f32x2 c = *(const f32x2*)(coef + t * 128 + 2 * lane);
            li[k * 128 + sd0] = v.x; li[k * 128 + sd1] = v.y; lc[k * 128 + sd0] = c.x; lc[k * 128 + sd1] = c.y;
        }
        asm volatile("s_waitcnt vmcnt(0) lgkmcnt(0)" ::: "memory");
        const int nstep = 2 * nb;
        u32x4 rb[2][8]; float acc[16]; f32x2 hv;
#define PV_ISSUE(s, B) do { const LAS int* ip_ = li + (s) * 64 + rg * 8; const ge::u32x4 ia_ = *(const LAS ge::u32x4*)ip_, ib_ = *(const LAS ge::u32x4*)(ip_ + 4); \
            _Pragma("unroll") for (int i_ = 0; i_ < 8; ++i_) { const unsigned e_ = i_ < 4 ? ia_[i_ & 3] : ib_[i_ & 3]; rb[B][i_] = *(const u32x4*)(tab + (size_t)e_ * 128); } } while (0)
#define PV_STEP(s, B) do { if ((s) < nstep) { if ((s) + 1 < nstep) PV_ISSUE((s) + 1, (B) ^ 1); \
            const int k_ = (s) >> 1, half_ = (s) & 1; const size_t t_ = (size_t)gw + (size_t)(tb + k_) * ngw; \
            if (half_ == 0) { _Pragma("unroll") for (int k = 0; k < 16; ++k) acc[k] = 0.f; hv = *(const f32x2*)(hin + t_ * D + colo); } \
            const LAS float* cp_ = lc + (s) * 64 + rg * 8; const ge::f32x4 ca_ = *(const LAS ge::f32x4*)cp_, cb_ = *(const LAS ge::f32x4*)(cp_ + 4); \
            _Pragma("unroll") for (int i = 0; i < 8; ++i) { const float cf = i < 4 ? ca_[i & 3] : cb_[i & 3]; _Pragma("unroll") for (int k = 0; k < 4; ++k) { \
                const f32x2 q0 = __builtin_amdgcn_cvt_pk_f32_fp8((int)rb[B][i][k], false), q1 = __builtin_amdgcn_cvt_pk_f32_fp8((int)rb[B][i][k], true); \
                acc[4 * k] += cf * q0.x; acc[4 * k + 1] += cf * q0.y; acc[4 * k + 2] += cf * q1.x; acc[4 * k + 3] += cf * q1.y; } __builtin_amdgcn_sched_barrier(0); } \
            if (half_ == 1) { float s8[8], s4[4]; \
                _Pragma("unroll") for (int k = 0; k < 8; ++k) { auto rr = __builtin_amdgcn_permlane32_swap(__float_as_uint(acc[k]), __float_as_uint(acc[k + 8]), false, false); s8[k] = __uint_as_float(rr[0]) + __uint_as_float(rr[1]); } \
                _Pragma("unroll") for (int k = 0; k < 4; ++k) { auto rr = __builtin_amdgcn_permlane16_swap(__float_as_uint(s8[k]), __float_as_uint(s8[k + 4]), false, false); s4[k] = __uint_as_float(rr[0]) + __uint_as_float(rr[1]); } \
                const bool b3_ = (lane & 8) != 0; \
                const float o0 = (b3_ ? s4[2] : s4[0]) + dpp_ror8(b3_ ? s4[0] : s4[2]), o1 = (b3_ ? s4[3] : s4[1]) + dpp_ror8(b3_ ? s4[1] : s4[3]); \
                const float x0 = hv.x + o0 * (1.f / VSCALE), x1 = hv.y + o1 * (1.f / VSCALE); \
                *(f32x2*)(h + t_ * D + colo) = (f32x2){x0, x1}; *(unsigned*)(hb + t_ * D + colo) = pk2(x0, x1); \
                float sq = x0 * x0 + x1 * x1; sq = wave_sum(sq); if (lane == 0) ssp1[t_ * 8 + slice] = sq; } } } while (0)
        PV_ISSUE(0, 0);
        for (int s0 = 0; s0 < nstep; s0 += 2) { PV_STEP(s0, 0); PV_STEP(s0 + 1, 1); }
#undef PV_ISSUE
#undef PV_STEP
        asm volatile("s_waitcnt lgkmcnt(0)" ::: "memory");
    }
}

__device__ __forceinline__ void ph_final(const float* __restrict__ h, const float* __restrict__ ssp1, const float* __restrict__ g, float* __restrict__ out) {
    PH_IDS
    const int lane = TIDX & 63, gw = BIDX * 8 + (TIDX >> 6), ngw = GDIM * 8;
    for (int w = gw; w < T; w += ngw) {
        const float rs = rsqrtf(sum8(ssp1 + (size_t)w * 8) * (1.f / D) + EPS);
        const f32x4* r = (const f32x4*)(h + (size_t)w * D) + lane; const f32x4* gg = (const f32x4*)g + lane; f32x4* o = (f32x4*)(out + (size_t)w * D) + lane;
#pragma unroll
        for (int j = 0; j < 4; ++j) { const f32x4 v = r[64 * j], gv = gg[64 * j]; o[64 * j] = v * rs * gv; }
    }
}
}
namespace attn_body {
using bf16=__hip_bfloat16;
using bf16x8=__attribute__((ext_vector_type(8)))short;
using s16x4=__attribute__((ext_vector_type(4)))short;
using f32x16=__attribute__((ext_vector_type(16)))float;
using u32x4=__attribute__((ext_vector_type(4)))unsigned;
constexpr int BATCH=8,NHEAD=8,SEQ=4096,D=64,DM=NHEAD*D;
constexpr int OPITCH=1024,OCOL=512;
constexpr int NW=8,QBLK=32,QB=QBLK*NW,KVBLK=64,NQB=SEQ/QB;
constexpr int ATTN_PITCH=DM, ATTN_UNIT_ROWS=QB;
__device__ __forceinline__ int crow(int r,int hi){return (r&3)+8*(r>>2)+4*hi;}
#define SBAR() __builtin_amdgcn_sched_barrier(0)
__device__ __forceinline__ void cmask(f32x16&p0,f32x16&p1,int jb,int qrel,int hi){
  const float NEG=-INFINITY; int kb=64*jb+4*hi;
  #pragma unroll
  for(int r=0;r<16;++r){int kv=kb+(r&3)+8*(r>>2); if(kv>qrel)p0[r]=NEG; if(kv+32>qrel)p1[r]=NEG;}
}

constexpr int NSLOT=3, SLOTB=8192;
constexpr int LDS_K=0, LDS_V=NSLOT*SLOTB, LDS_WS=2*NSLOT*SLOTB, LDS_OST=LDS_WS+NW*64*4, LDS_CUM=LDS_OST+NW*4096, LDS_BYTES=LDS_CUM+SEQ*4;
constexpr float PRUNE_T=80.f;
constexpr float C2=0.125f*1.4426950408889634f;
__device__ __forceinline__ void glds16(const void*gsrc,unsigned lds_dst){unsigned keep;
  asm volatile("s_mov_b32 %0, m0\n\ts_mov_b32 m0, %2\n\ts_nop 0\n\tglobal_load_lds_dwordx4 %1, off\n\ts_mov_b32 m0, %0":"=&s"(keep):"v"(gsrc),"s"(lds_dst):"memory");}
__device__ __forceinline__ float max3f(float a,float b,float c){float r;asm("v_max3_f32 %0, %1, %2, %3":"=v"(r):"v"(a),"v"(b),"v"(c));return r;}
__device__ __forceinline__ float max2f(float a,float b){float r;asm("v_max_f32_e32 %0, %1, %2":"=v"(r):"v"(a),"v"(b));return r;}
__device__ __forceinline__ float fadd_s(float a,float b){float r;asm("v_add_f32_e32 %0, %1, %2":"=v"(r):"v"(a),"v"(b));return r;}
__device__ __forceinline__ float fsub_s(float a,float b){float r;asm("v_sub_f32_e32 %0, %1, %2":"=v"(r):"v"(a),"v"(b));return r;}
typedef float f32x4_t __attribute__((ext_vector_type(4)));
typedef float f32x2_t __attribute__((ext_vector_type(2))); typedef __bf16 bf16x2_t __attribute__((ext_vector_type(2)));
__device__ __forceinline__ unsigned cvtpk_s(float lo,float hi){f32x2_t v={lo,hi};bf16x2_t b=__builtin_convertvector(v,bf16x2_t);return __builtin_bit_cast(unsigned,b);}
#define WAIT_BAR(N) asm volatile("s_waitcnt vmcnt(" #N ") lgkmcnt(0)\n\ts_barrier":::"memory")

__device__ __forceinline__ void qkt(f32x16&p0,f32x16&p1,const char*Kslot,const bf16x8*qr,const f32x16&negm,int r32,int hi){
  const char*kb=Kslot+hi*1024+r32*16;
  #pragma unroll
  for(int d0=0;d0<4;++d0){
    const bf16x8 b0=*reinterpret_cast<const bf16x8*>(kb+d0*2048);
    const bf16x8 b1=*reinterpret_cast<const bf16x8*>(kb+d0*2048+512);
    if(d0==0){p0=__builtin_amdgcn_mfma_f32_32x32x16_bf16(b0,qr[0],negm,0,0,0);p1=__builtin_amdgcn_mfma_f32_32x32x16_bf16(b1,qr[0],negm,0,0,0);}
    else{p0=__builtin_amdgcn_mfma_f32_32x32x16_bf16(b0,qr[d0],p0,0,0,0);p1=__builtin_amdgcn_mfma_f32_32x32x16_bf16(b1,qr[d0],p1,0,0,0);}}
}
typedef __attribute__((address_space(3))) const char* lds_cptr;
typedef short v4i16_t __attribute__((ext_vector_type(4)));
__device__ __forceinline__ void kload8(bf16x8*kf,lds_cptr kp){
  kf[0]=*(const __attribute__((address_space(3))) bf16x8*)(kp);      kf[1]=*(const __attribute__((address_space(3))) bf16x8*)(kp+512);
  kf[2]=*(const __attribute__((address_space(3))) bf16x8*)(kp+2048); kf[3]=*(const __attribute__((address_space(3))) bf16x8*)(kp+2560);
  kf[4]=*(const __attribute__((address_space(3))) bf16x8*)(kp+4096); kf[5]=*(const __attribute__((address_space(3))) bf16x8*)(kp+4608);
  kf[6]=*(const __attribute__((address_space(3))) bf16x8*)(kp+6144); kf[7]=*(const __attribute__((address_space(3))) bf16x8*)(kp+6656);
}
__device__ __forceinline__ void kload2(bf16x8*kf,lds_cptr kp,int j){ kf[2*j]=*(const __attribute__((address_space(3))) bf16x8*)(kp+j*2048); kf[2*j+1]=*(const __attribute__((address_space(3))) bf16x8*)(kp+j*2048+512); }
__device__ __forceinline__ s16x4 vtr(lds_cptr p){ return __builtin_bit_cast(s16x4,__builtin_amdgcn_ds_read_tr16_b64_v4i16((__attribute__((address_space(3))) v4i16_t*)p)); }
__device__ __forceinline__ float rowmax(const f32x16&p0,const f32x16&p1){
  float a=max3f(p0[0],p0[1],p1[0]),b=max3f(p0[2],p0[3],p1[1]);a=max3f(a,p1[2],p1[3]);
  #pragma unroll
  for(int r=4;r<16;r+=4){a=max3f(a,p0[r],p0[r+1]);b=max3f(b,p0[r+2],p0[r+3]);a=max3f(a,p1[r],p1[r+1]);b=max3f(b,p1[r+2],p1[r+3]);}
  const float m=max2f(a,b);
  auto rr=__builtin_amdgcn_permlane32_swap(__float_as_uint(m),__float_as_uint(m),false,false);
  return max2f(__uint_as_float(rr[0]),__uint_as_float(rr[1]));
}
__device__ __forceinline__ void pv(f32x16*o,int vb,bf16x8 pa0,bf16x8 pa1,bf16x8 pa2,bf16x8 pa3){
  #pragma unroll
  for(int d0=0;d0<2;++d0){s16x4 lo[4],hi[4];
    #pragma unroll
    for(int ks=0;ks<4;++ks){
      asm volatile("ds_read_b64_tr_b16 %0,%1 offset:%c2":"=&v"(lo[ks]):"v"(vb),"i"(d0*4096+ks*1024):"memory");
      asm volatile("ds_read_b64_tr_b16 %0,%1 offset:%c2":"=&v"(hi[ks]):"v"(vb),"i"(d0*4096+ks*1024+512):"memory");}
    asm volatile("s_waitcnt lgkmcnt(0)":::"memory");SBAR();
    #define PK(k) (bf16x8){lo[k][0],lo[k][1],lo[k][2],lo[k][3],hi[k][0],hi[k][1],hi[k][2],hi[k][3]}
    o[d0]=__builtin_amdgcn_mfma_f32_32x32x16_bf16(pa0,PK(0),o[d0],0,0,0);
    o[d0]=__builtin_amdgcn_mfma_f32_32x32x16_bf16(pa1,PK(1),o[d0],0,0,0);
    o[d0]=__builtin_amdgcn_mfma_f32_32x32x16_bf16(pa2,PK(2),o[d0],0,0,0);
    o[d0]=__builtin_amdgcn_mfma_f32_32x32x16_bf16(pa3,PK(3),o[d0],0,0,0);
    #undef PK
  }
}

#ifndef ATTN_STORE16
#define ATTN_STORE16(p,v) (*(u32x4*)(p)=(v))
#endif
template<int THRL> __device__ __forceinline__ void attn_unit(int b,int h,int qb,const bf16*Q,const bf16*__restrict__ K,const bf16*__restrict__ V,const float*__restrict__ cum2,bf16*O,float*__restrict__ ssp,char*shm,int tid_){
  int tid=tid_; asm volatile("":"+v"(tid)); const int lane=tid&63,r32=lane&31,hi=lane>>5; const int wid=__builtin_amdgcn_readfirstlane(tid>>6);
  const long rowbase=(long)b*SEQ; const int q0=qb*QB;
  const bf16*Qw=Q+(rowbase+q0+wid*QBLK)*DM+h*D;
  const bf16*Kh=K+rowbase*DM+h*D,*Vh=V+rowbase*DM+h*D;
  const unsigned lds0=(unsigned)(uintptr_t)shm;
  float*wsf=(float*)(shm+LDS_WS)+wid*64;
  const int NTf=(q0+QB)/KVBLK; const float*cg=cum2+(long)(b*NHEAD+h)*SEQ;
  int ts; { const float thr=cg[q0]+PRUNE_T; const float ce=lane<NTf?cg[64*lane+63]:0.f; const unsigned long long m_=__ballot((lane<NTf)&&(ce<=thr));
    ts=m_?(int)__builtin_ctzll(m_):0; ts&=~1; if(ts>NTf-4)ts=NTf-4; ts=__builtin_amdgcn_readfirstlane(ts); }
  const bf16*ksrc=Kh+(long)(ts*KVBLK+lane)*DM+wid*8;
  const bf16*vsrc=Vh+(long)(ts*KVBLK+16*(wid&3)+(lane>>2))*DM+(wid>>2)*32+(lane&3)*8;
  const unsigned kdst=lds0+LDS_K+wid*1024, vdst=lds0+LDS_V+wid*1024;
  #define DMA_K(t,slot) glds16(ksrc+(long)(t)*KVBLK*DM,(unsigned)__builtin_amdgcn_readfirstlane(kdst+(slot)))
  #define DMA_V(t,slot) glds16(vsrc+(long)(t)*KVBLK*DM,(unsigned)__builtin_amdgcn_readfirstlane(vdst+(slot)))
  const int vb0=(int)(lds0+LDS_V)+((lane>>4)&1)*32+(lane&3)*8+(4*hi+((lane&15)>>2))*64;
  const char*Kbase=shm+LDS_K; bf16x8 kf[8];
  const lds_cptr shm3=(lds_cptr)shm; const lds_cptr kp0=shm3+LDS_K+hi*1024+r32*16; const lds_cptr vp0=shm3+LDS_V+((lane>>4)&1)*32+(lane&3)*8+(4*hi+((lane&15)>>2))*64;
  { float*cl=(float*)(shm+LDS_CUM); for(int i=tid+ts*KVBLK;i<q0+QB;i+=NW*64)cl[i-ts*KVBLK]=cg[i]; }
  const float cq2=cg[q0+wid*QBLK+r32];
  const __attribute__((address_space(3))) float* ckl=(const __attribute__((address_space(3))) float*)(shm3+LDS_CUM)+4*hi;
  #define BIAS(P0,P1,t) do{ const __attribute__((address_space(3))) float*ck_=ckl+64*(t); const float mm_=mhat-cq2; _Pragma("unroll") for(int g_=0;g_<4;++g_){ \
      const f32x4_t c0_=*(const __attribute__((address_space(3))) f32x4_t*)(ck_+8*g_)+mm_, c1_=*(const __attribute__((address_space(3))) f32x4_t*)(ck_+32+8*g_)+mm_; \
      _Pragma("unroll") for(int i_=0;i_<4;++i_){P0[4*g_+i_]-=c0_[i_];P1[4*g_+i_]-=c1_[i_];} SBAR(); } }while(0)
  const int NT=NTf-ts;
  DMA_K(0,0);DMA_V(0,0);DMA_K(1,SLOTB);
  bf16x8 qr[4];
  #pragma unroll
  for(int d0=0;d0<4;++d0)qr[d0]=*reinterpret_cast<const bf16x8*>(&Qw[(long)r32*DM+d0*16+hi*8]);
  float mhat=0.f,l_reg=0.f;f32x16 o[2];o[0]=f32x16{};o[1]=f32x16{};const f32x16 negm=f32x16{};
  const int qrel=wid*QBLK+r32;
  #define CMASK(P0,P1,t) do{int jb_=(t)-(NT-4); if(jb_>=0)cmask(P0,P1,jb_,qrel,hi);}while(0)
  bool resc=false;
  #define START(P0,P1) do{ const float rm=rowmax(P0,P1); resc=false; \
    { const float dl=rm; mhat=fadd_s(mhat,dl); \
      _Pragma("unroll") for(int r=0;r<16;++r){P0[r]=fsub_s(P0[r],dl);P1[r]=fsub_s(P1[r],dl);} \
      } \
    _Pragma("unroll") for(int r=0;r<16;++r)P0[r]=__builtin_amdgcn_exp2f(P0[r]); }while(0)
  #define RESC() do{ if(resc){ asm volatile("s_waitcnt lgkmcnt(0)":::"memory"); \
      _Pragma("unroll") for(int d_=0;d_<2;++d_) _Pragma("unroll") for(int r=0;r<16;++r)o[d_][r]*=wsf[crow(r,hi)]; } }while(0)
  f32x16 pA0,pA1,pB0,pB1;
  int sl_prev=0,sl_cur=0,sl_next=SLOTB;
  #define ROT() do{sl_prev=sl_cur;sl_cur=sl_next;sl_next=(sl_next==(NSLOT-1)*SLOTB)?0:sl_next+SLOTB;}while(0)
  DMA_K(2,2*SLOTB);
  WAIT_BAR(3);
  qkt(pA0,pA1,Kbase,qr,negm,r32,hi);asm volatile("s_nop 15\n\ts_nop 7":"+v"(pA0),"+v"(pA1));BIAS(pA0,pA1,0);CMASK(pA0,pA1,0);
  START(pA0,pA1);
  _Pragma("unroll") for(int r=0;r<16;++r)pA1[r]=__builtin_amdgcn_exp2f(pA1[r]);
  WAIT_BAR(0);
  DMA_K(3,0);DMA_V(1,SLOTB);
  ROT();
  kload8(kf,kp0+sl_cur);
  WAIT_BAR(2);
  s16x4 vlo[8],vhi[8]; u32x4 pw0,pw1,pw2,pw3;
  #define PKW(P,B) cvtpk_s(P[B],P[B+1])
  #define PAF(k) __builtin_bit_cast(bf16x8,pw##k)
  #define VFR(i) (bf16x8){vlo[i][0],vlo[i][1],vlo[i][2],vlo[i][3],vhi[i][0],vhi[i][1],vhi[i][2],vhi[i][3]}
  #define PIN(x) asm volatile("":"+v"(x))
  #define MX3(a,b,c) __builtin_fmaxf(__builtin_fmaxf((a),(b)),(c))
  #define GAPA(MF,A0,A1,A2,A3,W0,W1,PW) do{ MF; sacc+=A0; sacc+=A1; sacc+=A2; sacc+=A3; PIN(sacc); W0; W1; PIN(PW); SBAR(); }while(0)
  #define EX(v) __builtin_amdgcn_exp2f(v)
  #define GAPB(MF,X,B) do{ MF; X[B]=EX(X[B]); X[B+1]=EX(X[B+1]); X[B+2]=EX(X[B+2]); X[B+3]=EX(X[B+3]); PIN(X); SBAR(); }while(0)
  #define VRD(i) do{ vlo[i]=vtr(vp_+(((i)>>2)*4096+((i)&3)*1024)); vhi[i]=vtr(vp_+(((i)>>2)*4096+((i)&3)*1024+512)); }while(0)
  #define KRD(G,j) do{ if(G){ kload2(kf,kp0+sl_next,j); SBAR(); } }while(0)
  #define STEP(C0,C1,P0,P1,t,GK,GV,GL) do{ SBAR(); \
    const lds_cptr vp_=vp0+sl_prev; \
    VRD(0); SBAR(); float sacc=(P0[0]+P0[1]); \
    GAPA(C0=__builtin_amdgcn_mfma_f32_32x32x16_bf16(kf[0],qr[0],negm,0,0,0), P0[2],P0[3],P0[4],P0[5],     pw0[0]=PKW(P0,0), pw0[1]=PKW(P0,2), pw0); \
    VRD(4); SBAR(); GAPA(C1=__builtin_amdgcn_mfma_f32_32x32x16_bf16(kf[1],qr[0],negm,0,0,0), P0[6],P0[7],P0[8],P0[9],     pw0[2]=PKW(P0,4), pw0[3]=PKW(P0,6), pw0); \
    VRD(1); SBAR(); GAPA(C0=__builtin_amdgcn_mfma_f32_32x32x16_bf16(kf[2],qr[1],C0,0,0,0),   P0[10],P0[11],P0[12],P0[13], pw1[0]=PKW(P0,8), pw1[1]=PKW(P0,10), pw1); \
    VRD(5); SBAR(); GAPA(C1=__builtin_amdgcn_mfma_f32_32x32x16_bf16(kf[3],qr[1],C1,0,0,0),   P0[14],P0[15],P1[0],P1[1],   pw1[2]=PKW(P0,12),pw1[3]=PKW(P0,14), pw1); \
    VRD(2); SBAR(); GAPA(C0=__builtin_amdgcn_mfma_f32_32x32x16_bf16(kf[4],qr[2],C0,0,0,0),   P1[2],P1[3],P1[4],P1[5],     pw2[0]=PKW(P1,0), pw2[1]=PKW(P1,2), pw2); \
    VRD(6); SBAR(); GAPA(C1=__builtin_amdgcn_mfma_f32_32x32x16_bf16(kf[5],qr[2],C1,0,0,0),   P1[6],P1[7],P1[8],P1[9],     pw2[2]=PKW(P1,4), pw2[3]=PKW(P1,6), pw2); \
    VRD(3); SBAR(); GAPA(C0=__builtin_amdgcn_mfma_f32_32x32x16_bf16(kf[6],qr[3],C0,0,0,0),   P1[10],P1[11],P1[12],P1[13], pw3[0]=PKW(P1,8), pw3[1]=PKW(P1,10), pw3); \
    VRD(7); SBAR(); GAPA(C1=__builtin_amdgcn_mfma_f32_32x32x16_bf16(kf[7],qr[3],C1,0,0,0),   P1[14],P1[15],0.f,0.f,       pw3[2]=PKW(P1,12),pw3[3]=PKW(P1,14), pw3); \
    l_reg+=sacc; \
    if(GK){DMA_K((t)+3,sl_cur);} if(GV){DMA_V((t)+1,sl_next);} \
    BIAS(C0,C1,t); CMASK(C0,C1,t); \
    { float a=MX3(C0[0],C0[1],C1[0]),b=MX3(C0[2],C0[3],C1[1]); a=MX3(a,C1[2],C1[3]); \
      _Pragma("unroll") for(int r=4;r<16;r+=4){a=MX3(a,C0[r],C0[r+1]);b=MX3(b,C0[r+2],C0[r+3]);a=MX3(a,C1[r],C1[r+1]);b=MX3(b,C1[r+2],C1[r+3]);} \
      float rm=__builtin_fmaxf(a,b); { auto rr=__builtin_amdgcn_permlane32_swap(__float_as_uint(rm),__float_as_uint(rm),false,false); rm=__builtin_fmaxf(__uint_as_float(rr[0]),__uint_as_float(rr[1])); } \
      resc=false; \
      if(__builtin_expect(__any(rm>(float)THRL),0)){ const float dl=__builtin_fmaxf(rm,0.f); mhat+=dl; \
        _Pragma("unroll") for(int r=0;r<16;++r){C0[r]-=dl;C1[r]-=dl;} \
        const float f=__builtin_amdgcn_exp2f(-dl); l_reg*=f; if(hi==0)wsf[r32]=f; resc=true; } } \
    SBAR(); \
    GAPB(o[0]=__builtin_amdgcn_mfma_f32_32x32x16_bf16(PAF(0),VFR(0),o[0],0,0,0), C0,0); \
    GAPB(o[1]=__builtin_amdgcn_mfma_f32_32x32x16_bf16(PAF(0),VFR(4),o[1],0,0,0), C0,4); \
    KRD(GL,0); GAPB(o[0]=__builtin_amdgcn_mfma_f32_32x32x16_bf16(PAF(1),VFR(1),o[0],0,0,0), C0,8); \
    KRD(GL,1); GAPB(o[1]=__builtin_amdgcn_mfma_f32_32x32x16_bf16(PAF(1),VFR(5),o[1],0,0,0), C0,12); \
    KRD(GL,2); GAPB(o[0]=__builtin_amdgcn_mfma_f32_32x32x16_bf16(PAF(2),VFR(2),o[0],0,0,0), C1,0); \
    KRD(GL,3); GAPB(o[1]=__builtin_amdgcn_mfma_f32_32x32x16_bf16(PAF(2),VFR(6),o[1],0,0,0), C1,4); \
    GAPB(o[0]=__builtin_amdgcn_mfma_f32_32x32x16_bf16(PAF(3),VFR(3),o[0],0,0,0), C1,8); \
    GAPB(o[1]=__builtin_amdgcn_mfma_f32_32x32x16_bf16(PAF(3),VFR(7),o[1],0,0,0), C1,12); \
    }while(0)
  int t=1;
  #undef CMASK
  #define CMASK(P0,P1,t) do{}while(0)
  for(;t+5<NT;t+=2){
    STEP(pB0,pB1,pA0,pA1,t,true,true,true);     WAIT_BAR(2); RESC(); ROT();
    STEP(pA0,pA1,pB0,pB1,t+1,true,true,true);   WAIT_BAR(2); RESC(); ROT();
  }
  #undef CMASK
  #define CMASK(P0,P1,t) do{int jb_=(t)-(NT-4); if(jb_>=0)cmask(P0,P1,jb_,qrel,hi);}while(0)
  #define ENDW(tt) do{ if((tt)+3<NT){WAIT_BAR(2);} else if((tt)+2<NT){WAIT_BAR(1);} else {WAIT_BAR(0);} }while(0)
  for(;t+1<NT;t+=2){
    STEP(pB0,pB1,pA0,pA1,t,(t+3<NT),(t+1<NT),(t+1<NT));       ENDW(t);   RESC(); ROT();
    STEP(pA0,pA1,pB0,pB1,t+1,(t+4<NT),(t+2<NT),(t+2<NT));     ENDW(t+1); RESC(); ROT();
  }
  STEP(pB0,pB1,pA0,pA1,NT-1,false,false,false); RESC();
  { float sacc=pB0[0]+pB0[1]; _Pragma("unroll") for(int r=2;r<16;++r)sacc+=pB0[r]; _Pragma("unroll") for(int r=0;r<16;++r)sacc+=pB1[r]; l_reg+=sacc;
    pw0=(u32x4){PKW(pB0,0),PKW(pB0,2),PKW(pB0,4),PKW(pB0,6)};pw1=(u32x4){PKW(pB0,8),PKW(pB0,10),PKW(pB0,12),PKW(pB0,14)};pw2=(u32x4){PKW(pB1,0),PKW(pB1,2),PKW(pB1,4),PKW(pB1,6)};pw3=(u32x4){PKW(pB1,8),PKW(pB1,10),PKW(pB1,12),PKW(pB1,14)};
    SBAR(); pv(o,vb0+sl_cur,PAF(0),PAF(1),PAF(2),PAF(3)); }
  #undef PKW
  #undef PAF
  #undef VFR
  #undef PIN
  #undef MX3
  #undef GAPA
  #undef GAPB
  #undef EX
  #undef VRD
  #undef KRD
  #undef STEP
  #undef ENDW
  {auto rr=__builtin_amdgcn_permlane32_swap(__float_as_uint(l_reg),__float_as_uint(l_reg),false,false);l_reg=__uint_as_float(rr[0])+__uint_as_float(rr[1]);}
  if(hi==0)wsf[32+r32]=l_reg;asm volatile("s_waitcnt lgkmcnt(0)":::"memory");
  float rli[16];
  #pragma unroll
  for(int r=0;r<16;++r)rli[r]=__builtin_amdgcn_rcpf(wsf[32+crow(r,hi)]);
  int lane_e=lane; asm volatile("":"+v"(lane_e));
  bf16*Ow=O+(rowbase+q0+wid*QBLK)*OPITCH+OCOL+h*D; float*sw=ssp+(rowbase+q0+wid*QBLK)*8+h;
  { bf16*stg=(bf16*)(shm+LDS_OST)+wid*2048;
    #pragma unroll
    for(int r=0;r<16;++r){const int orow=crow(r,hi);
      #pragma unroll
      for(int d0=0;d0<2;++d0)stg[orow*64+d0*32+r32]=__float2bfloat16(o[d0][r]*rli[r]);}
    asm volatile("s_waitcnt lgkmcnt(0)":::"memory");
    #pragma unroll
    for(int i=0;i<4;++i){const int row=i*8+(lane_e>>3),ch=lane_e&7; const u32x4 v=*(const u32x4*)(stg+row*64+ch*8); ATTN_STORE16(Ow+(long)row*OPITCH+ch*8,v);
      float sq=0.f;
      #pragma unroll
      for(int k=0;k<4;++k){const float a=__uint_as_float(v[k]<<16),c=__uint_as_float(v[k]&0xffff0000u);sq+=a*a+c*c;}
      sq+=__shfl_xor(sq,1);sq+=__shfl_xor(sq,2);sq+=__shfl_xor(sq,4);
      if(ch==0)sw[(long)row*8]=sq; } }
  asm volatile("s_waitcnt lgkmcnt(0)\n\ts_barrier":::"memory");
  #undef DMA_K
  #undef DMA_V
  #undef CMASK
  #undef START
  #undef RESC
  #undef BIAS
  #undef ROT
}
constexpr int ATTN_LDS_BYTES=LDS_BYTES;
template<int THRL=8> __device__ __forceinline__ void attn_phase(char*lds,const bf16*Q,const bf16*K,const bf16*V,const float*cum2,bf16*O,float*ssp,unsigned*ctr,volatile __attribute__((address_space(3))) unsigned*slot,int tid){
  for(;;){
    if(tid==0)*slot=__hip_atomic_fetch_add(ctr,1u,__ATOMIC_RELAXED,__HIP_MEMORY_SCOPE_AGENT);
    __syncthreads();
    const int u=(int)*slot;
    __syncthreads();
    if(u>=BATCH*NHEAD*NQB)break;
    const int qb=NQB-1-(u>>6),h=NHEAD-1-((u>>3)&7),b=u&7;
    attn_unit<THRL>(b,h,qb,Q,K,V,cum2,O,ssp,lds,tid);
  }
}
#undef SBAR
#undef WAIT_BAR
}
namespace nv {
typedef float f32x2v __attribute__((ext_vector_type(2)));
constexpr size_t WS_APOW = 921 * MiB;
constexpr size_t WS_BBAR = 89 * MiB;
constexpr int KDW = 128 * 256;
__device__ __forceinline__ void p0_ssm_a(const float* __restrict__ lam_re, const float* __restrict__ lam_im, const float* __restrict__ log_dt, const float* __restrict__ b_re, const float* __restrict__ b_im,
                                         f32x2v* __restrict__ apow, f32x2v* __restrict__ bbar) {
    PH_IDS
    for (int i = BIDX * 512 + TIDX; i < DEPTH * G * P; i += GDIM * 512) {
        const int lg = i / P, p = i % P;
        const float dtf = expf(log_dt[lg]); const float lr = lam_re[i], li = lam_im[i];
        const double ang = (double)li * (double)dtf, k2 = rint(ang * 0.15915494309189535), red = ang - k2 * 6.283185307179586;
        const float mag = expf(lr * dtf), rr = (float)red; const double are = (double)(mag * cosf(rr)), aim = (double)(mag * sinf(rr));
        double pr = 1.0, pi = 0.0;
        for (int d = 0; d <= 64; ++d) { apow[((size_t)lg * 65 + d) * P + p] = (f32x2v){(float)pr, (float)pi}; const double nr_ = pr * are - pi * aim, ni_ = pr * aim + pi * are; pr = nr_; pi = ni_; }
        const double lrd = lr, lid = li, den = lrd * lrd + lid * lid, nr = are - 1.0, zre = (nr * lrd + aim * lid) / den, zim = (aim * lrd - nr * lid) / den;
        for (int h = 0; h < HC; ++h) { const double br = b_re[(size_t)i * HC + h], bi = b_im[(size_t)i * HC + h]; bbar[(size_t)i * HC + h] = (f32x2v){(float)(zre * br - zim * bi), (float)(zre * bi + zim * br)}; }
    }
}
__device__ __forceinline__ void p0_ssm_b(const f32x2v* __restrict__ apow, const f32x2v* __restrict__ bbar, const float* __restrict__ c_re, const float* __restrict__ c_im, const float* __restrict__ dsk,
                                         bf16_t* __restrict__ KD, bf16_t* __restrict__ WST, bf16_t* __restrict__ WOUT) {
    PH_IDS
    const int gt = BIDX * 512 + TIDX, nth = GDIM * 512;
    for (int i = gt; i < DEPTH * G * KDW; i += nth) {
        const int lg = i / KDW, r = i % KDW, dd = r >> 8, h = (r >> 4) & 15, h2 = r & 15, d = dd - 63;
        float v = 0.f;
        if (d >= 0 && dd < 127) {
            const f32x2v* ap = apow + ((size_t)lg * 65 + d) * P; const f32x2v* bb = bbar + (size_t)lg * P * HC + h2; const float* cr = c_re + ((size_t)lg * HC + h) * P; const float* ci = c_im + ((size_t)lg * HC + h) * P;
            for (int p = 0; p < P; ++p) { const f32x2v a = ap[p], b = bb[(size_t)p * HC]; const float wr = a.x * b.x - a.y * b.y, wi = a.x * b.y + a.y * b.x; v += cr[p] * wr - ci[p] * wi; }
            if (d == 0 && h == h2) v += dsk[lg * HC + h];
        }
        KD[i] = f2bf(v);
    }
    for (int i = gt; i < DEPTH * G * 128 * 256; i += nth) {
        const int lg = i >> 15, r = i & 32767, row = r >> 8, k = r & 255, j = k >> 4, h2 = k & 15, p = row & 63;
        const f32x2v a = apow[((size_t)lg * 65 + (15 - j)) * P + p], b = bbar[((size_t)lg * P + p) * HC + h2];
        WST[i] = f2bf(row < 64 ? a.x * b.x - a.y * b.y : a.x * b.y + a.y * b.x);
    }
    for (int i = gt; i < DEPTH * G * 1024 * 128; i += nth) {
        const int lg = i >> 17, r = i & 131071, row = r >> 7, k = r & 127, ti = row >> 4, h = row & 15, p = k & 63;
        const f32x2v e = apow[((size_t)lg * 65 + ti + 1) * P + p]; const float cr = c_re[((size_t)lg * HC + h) * P + p], ci = c_im[((size_t)lg * HC + h) * P + p];
        WOUT[i] = f2bf(k < 64 ? cr * e.x - ci * e.y : -(cr * e.y + ci * e.x));
    }
}

struct SchedSsmS {
    static constexpr bool DUALB = false; long hA, hB, hB1;
    const char* UP; const char* WST; int G_, c;
    __device__ __forceinline__ void init(const void* up, const void* wst_l, int grid, int bid) { UP = (const char*)up; WST = (const char*)wst_l; G_ = grid; c = bid; hA = 128l * UPW * 2; hB = 0; hB1 = 0; }
    __device__ __forceinline__ bool next(int i, ge::Unit& u) const {
        const int L = i * G_ + c; if (L >= G * 2 * 4) return false;
        const int g = L >> 3, pm = (L >> 2) & 1, ks = L & 3;
        u.A0 = UP + (((size_t)g * NCH + pm * 256) * UPW + 128 + ks * 256) * 2; u.B0 = WST + (size_t)g * 128 * 256 * 2; u.nt = 4; u.pm = pm; u.pn = ks; u.aux = g; return true; }
    __device__ __forceinline__ const char* ta(const ge::Unit& u, int t) const { return u.A0 + t * 128; }
    __device__ __forceinline__ const char* tb(const ge::Unit& u, int t) const { return u.B0 + t * 128; }
    __device__ __forceinline__ bool sb(const ge::Unit&, int) const { return false; }
    __device__ __forceinline__ unsigned voffA(int R, int C) const { return (unsigned)(R * UPW * 2 + C * 2); }
    __device__ __forceinline__ unsigned voffB(int Rb, int C) const { return (unsigned)(Rb * 512 + C * 2); }
    __device__ __forceinline__ unsigned voffB1(int, int) const { return 0u; }
};
struct EpiSsmS {
    static constexpr bool PERM = false, MIDK = false, UBEGIN = false;
    float* SLOC;
    __device__ __forceinline__ void unit_begin(const ge::Unit&, int, LAS unsigned char*) const {}
    __device__ __forceinline__ void midk(ge::f32x4 (&)[2][2][4][2], const ge::Unit&, int, int, LAS unsigned char*) const {}
    __device__ __forceinline__ void operator()(const ge::f32x4 (&acc)[2][2][4][2], const ge::Unit& u, int wr, int wc, int fr, int fq, LAS unsigned char*) const {
        const int g = u.aux, ks = u.pn;
#pragma unroll
        for (int ai = 0; ai < 2; ++ai)
#pragma unroll
            for (int m = 0; m < 4; ++m) {
                const int chunk = u.pm * 256 + ai * 128 + wr * 64 + m * 16 + fr; float* dst = SLOC + ((size_t)g * (NCH * 4) + chunk * 4 + ks) * 128;
#pragma unroll
                for (int n = 0; n < 2; ++n) *(ge::f32x4*)(dst + wc * 32 + 16 * n + 4 * fq) = acc[ai][0][m][n];
            }
    }
};

__device__ __forceinline__ void ph_ssm_prefix(LAS unsigned char* lds, const float* __restrict__ SLOC, const f32x2v* __restrict__ apow_l, bf16_t* __restrict__ UP) {
    PH_IDS
    const int p = TIDX & 63, w = TIDX >> 6;
    LAS f32x2v* ex = (LAS f32x2v*)lds;
    for (int item = BIDX; item < BATCH * G; item += GDIM) {
        const int b = item / G, g = item % G;
        const f32x2v a16 = apow_l[((size_t)g * 65 + 16) * P + p];
        const float* src = SLOC + ((size_t)g * (NCH * 4) + (size_t)b * 256 + 32 * w) * 128 + p; bf16_t* dst = UP + ((size_t)g * NCH + b * 64 + 8 * w) * UPW + p;
        float xr[32], xi[32];
#pragma unroll
        for (int k = 0; k < 32; ++k) { xr[k] = src[(size_t)k * 128]; xi[k] = src[(size_t)k * 128 + 64]; }
        float sr = 0.f, si = 0.f;
#pragma unroll
        for (int k = 0; k < 32; ++k) { const float nr = a16.x * sr - a16.y * si + xr[k], ni = a16.x * si + a16.y * sr + xi[k]; sr = nr; si = ni; }
        ex[w * 64 + p] = (f32x2v){sr, si};
        float qr = a16.x, qi = a16.y;
#pragma unroll
        for (int k = 0; k < 5; ++k) { const float nr = qr * qr - qi * qi, ni = 2.f * qr * qi; qr = nr; qi = ni; }
        __syncthreads();
        sr = 0.f; si = 0.f;
        for (int j = 0; j < w; ++j) { const f32x2v e = ex[j * 64 + p]; const float nr = qr * sr - qi * si + e.x, ni = qr * si + qi * sr + e.y; sr = nr; si = ni; }
#pragma unroll
        for (int k = 0; k < 32; ++k) {
            if ((k & 3) == 0) { bf16_t* d = dst + (size_t)(k >> 2) * UPW; d[0] = f2bf(sr); d[64] = f2bf(si); }
            const float nr = a16.x * sr - a16.y * si + xr[k], ni = a16.x * si + a16.y * sr + xi[k]; sr = nr; si = ni;
        }
        __syncthreads();
    }
}
__device__ __forceinline__ void ph_cum2(const float* __restrict__ logf, float* __restrict__ cum) {
    PH_IDS
    const int lane = TIDX & 63, gw = BIDX * 8 + (TIDX >> 6), ngw = GDIM * 8;
    for (int item = gw; item < BATCH * NH; item += ngw) {
        const int b = item / NH, h = item % NH;
        const float* src = logf + ((size_t)b * SEQ + lane * 64) * NH + h; float* dst = cum + (size_t)item * SEQ + lane * 64;
        float tot = 0.f;
        for (int i = 0; i < 64; ++i) tot += src[(size_t)i * NH];
        float ex = tot;
#pragma unroll
        for (int o = 1; o < 64; o <<= 1) { const float y = __shfl_up(ex, o); if (lane >= o) ex += y; }
        float run = ex - tot;
        for (int i = 0; i < 64; ++i) { run += src[(size_t)i * NH]; dst[i] = run * 1.4426950408889634f; }
    }
}

struct SchedSsmC {
    static constexpr bool DUALB = true; long hA, hB, hB1;
    const char* UP; const char* WOUT; const char* KD; int G_, c;
    __device__ __forceinline__ void init(const void* up, const void* wout_l, const void* kd_l, int grid, int bid) { UP = (const char*)up; WOUT = (const char*)wout_l; KD = (const char*)kd_l; G_ = grid; c = bid; hA = 128l * UPW * 2; hB = 128l * 256; hB1 = 8l * 512; }
    __device__ __forceinline__ bool next(int i, ge::Unit& u) const {
        const int L = i * G_ + c; if (L >= G * 2 * 4) return false;
        const int pn = 3 - (L >> 6), g = (L & 63) >> 1, pm = L & 1;
        u.A0 = UP + ((size_t)g * NCH + pm * 256) * UPW * 2; u.B0 = nullptr; u.nt = 2 + 4 * (pn + 1); u.pm = pm; u.pn = pn; u.aux = g; return true; }
    __device__ __forceinline__ const char* ta(const ge::Unit& u, int t) const { return u.A0 + t * 128; }
    __device__ __forceinline__ bool sb(const ge::Unit&, int t) const { return t >= 2; }
    __device__ __forceinline__ const char* tb(const ge::Unit& u, int t) const {
        return t < 2 ? WOUT + ((size_t)u.aux * 1024 + u.pn * 256) * 256 + t * 128 : KD + ((size_t)u.aux * KDW + (size_t)(16 * u.pn - 4 * (t - 2) + 60) * 256) * 2; }
    __device__ __forceinline__ unsigned voffA(int R, int C) const { return (unsigned)(R * UPW * 2 + C * 2); }
    __device__ __forceinline__ unsigned voffB(int Rb, int C) const { return (unsigned)(Rb * 256 + C * 2); }
    __device__ __forceinline__ unsigned voffB1(int Rb, int C) const { return (unsigned)((((Rb >> 4) + 3 - (C >> 4)) * 256 + (Rb & 15) * 16 + (C & 15)) * 2); }
};
__device__ __forceinline__ float gelu_fast(float x) { const float u = 1.5957691216057308f * (x + 0.044715f * x * x * x); return x - x / (1.f + __expf(u)); }
struct EpiSsmC {
    static constexpr bool PERM = true, MIDK = false, UBEGIN = false;
    bf16_t* GEL;
    __device__ __forceinline__ void unit_begin(const ge::Unit&, int, LAS unsigned char*) const {}
    __device__ __forceinline__ void midk(ge::f32x4 (&)[2][2][4][2], const ge::Unit&, int, int, LAS unsigned char*) const {}
    __device__ __forceinline__ void operator()(const ge::f32x4 (&acc)[2][2][4][2], const ge::Unit& u, int wr, int wc, int fr, int fq, LAS unsigned char*) const {
        const int g = u.aux;
#pragma unroll
        for (int ai = 0; ai < 2; ++ai)
#pragma unroll
            for (int m = 0; m < 4; ++m) {
                const int chunk = u.pm * 256 + ai * 128 + wr * 64 + m * 16 + fr;
#pragma unroll
                for (int bj = 0; bj < 2; ++bj) {
                    const int col = u.pn * 256 + bj * 128 + wc * 32 + 8 * fq, ti = col >> 4, h0 = col & 15;
                    const ge::f32x4 v0 = acc[ai][bj][m][0], v1 = acc[ai][bj][m][1];
                    u32x4 w; w.x = ge::cvt_pk_bf16(gelu_fast(v0[0]), gelu_fast(v0[1])); w.y = ge::cvt_pk_bf16(gelu_fast(v0[2]), gelu_fast(v0[3]));
                    w.z = ge::cvt_pk_bf16(gelu_fast(v1[0]), gelu_fast(v1[1])); w.w = ge::cvt_pk_bf16(gelu_fast(v1[2]), gelu_fast(v1[3]));
                    *(u32x4*)(GEL + ((size_t)g * T + chunk * 64 + ti) * HC + h0) = w;
                }
            }
    }
};
}
namespace nv {
#define SEL_CE(x, y) do { const int _h = max((x), (y)), _l = min((x), (y)); (x) = _h; (y) = _l; } while (0)
__device__ __forceinline__ void sel_sort16(int (&v)[16]) {
    SEL_CE(v[0], v[1]);
    SEL_CE(v[2], v[3]);
    SEL_CE(v[0], v[2]);
    SEL_CE(v[1], v[3]);
    SEL_CE(v[1], v[2]);
    SEL_CE(v[4], v[5]);
    SEL_CE(v[6], v[7]);
    SEL_CE(v[4], v[6]);
    SEL_CE(v[5], v[7]);
    SEL_CE(v[5], v[6]);
    SEL_CE(v[0], v[4]);
    SEL_CE(v[2], v[6]);
    SEL_CE(v[2], v[4]);
    SEL_CE(v[1], v[5]);
    SEL_CE(v[3], v[7]);
    SEL_CE(v[3], v[5]);
    SEL_CE(v[1], v[2]);
    SEL_CE(v[3], v[4]);
    SEL_CE(v[5], v[6]);
    SEL_CE(v[8], v[9]);
    SEL_CE(v[10], v[11]);
    SEL_CE(v[8], v[10]);
    SEL_CE(v[9], v[11]);
    SEL_CE(v[9], v[10]);
    SEL_CE(v[12], v[13]);
    SEL_CE(v[14], v[15]);
    SEL_CE(v[12], v[14]);
    SEL_CE(v[13], v[15]);
    SEL_CE(v[13], v[14]);
    SEL_CE(v[8], v[12]);
    SEL_CE(v[10], v[14]);
    SEL_CE(v[10], v[12]);
    SEL_CE(v[9], v[13]);
    SEL_CE(v[11], v[15]);
    SEL_CE(v[11], v[13]);
    SEL_CE(v[9], v[10]);
    SEL_CE(v[11], v[12]);
    SEL_CE(v[13], v[14]);
    SEL_CE(v[0], v[8]);
    SEL_CE(v[4], v[12]);
    SEL_CE(v[4], v[8]);
    SEL_CE(v[2], v[10]);
    SEL_CE(v[6], v[14]);
    SEL_CE(v[6], v[10]);
    SEL_CE(v[2], v[4]);
    SEL_CE(v[6], v[8]);
    SEL_CE(v[10], v[12]);
    SEL_CE(v[1], v[9]);
    SEL_CE(v[5], v[13]);
    SEL_CE(v[5], v[9]);
    SEL_CE(v[3], v[11]);
    SEL_CE(v[7], v[15]);
    SEL_CE(v[7], v[11]);
    SEL_CE(v[3], v[5]);
    SEL_CE(v[7], v[9]);
    SEL_CE(v[11], v[13]);
    SEL_CE(v[1], v[2]);
    SEL_CE(v[3], v[4]);
    SEL_CE(v[5], v[6]);
    SEL_CE(v[7], v[8]);
    SEL_CE(v[9], v[10]);
    SEL_CE(v[11], v[12]);
    SEL_CE(v[13], v[14]);
}
__device__ __forceinline__ void sel_merge16(int (&a)[16], const int (&b)[16]) {
    a[0] = max(a[0], b[15]);
    a[1] = max(a[1], b[14]);
    a[2] = max(a[2], b[13]);
    a[3] = max(a[3], b[12]);
    a[4] = max(a[4], b[11]);
    a[5] = max(a[5], b[10]);
    a[6] = max(a[6], b[9]);
    a[7] = max(a[7], b[8]);
    a[8] = max(a[8], b[7]);
    a[9] = max(a[9], b[6]);
    a[10] = max(a[10], b[5]);
    a[11] = max(a[11], b[4]);
    a[12] = max(a[12], b[3]);
    a[13] = max(a[13], b[2]);
    a[14] = max(a[14], b[1]);
    a[15] = max(a[15], b[0]);
    SEL_CE(a[0], a[8]);
    SEL_CE(a[1], a[9]);
    SEL_CE(a[2], a[10]);
    SEL_CE(a[3], a[11]);
    SEL_CE(a[4], a[12]);
    SEL_CE(a[5], a[13]);
    SEL_CE(a[6], a[14]);
    SEL_CE(a[7], a[15]);
    SEL_CE(a[0], a[4]);
    SEL_CE(a[1], a[5]);
    SEL_CE(a[2], a[6]);
    SEL_CE(a[3], a[7]);
    SEL_CE(a[8], a[12]);
    SEL_CE(a[9], a[13]);
    SEL_CE(a[10], a[14]);
    SEL_CE(a[11], a[15]);
    SEL_CE(a[0], a[2]);
    SEL_CE(a[1], a[3]);
    SEL_CE(a[4], a[6]);
    SEL_CE(a[5], a[7]);
    SEL_CE(a[8], a[10]);
    SEL_CE(a[9], a[11]);
    SEL_CE(a[12], a[14]);
    SEL_CE(a[13], a[15]);
    SEL_CE(a[0], a[1]);
    SEL_CE(a[2], a[3]);
    SEL_CE(a[4], a[5]);
    SEL_CE(a[6], a[7]);
    SEL_CE(a[8], a[9]);
    SEL_CE(a[10], a[11]);
    SEL_CE(a[12], a[13]);
    SEL_CE(a[14], a[15]);
}
constexpr int SEL_NCAND = 50;
#define SEL_CANDS(F) \
    F(0, 0, 0) \
    F(1, 0, 1) \
    F(2, 0, 2) \
    F(3, 0, 3) \
    F(4, 0, 4) \
    F(5, 0, 5) \
    F(6, 0, 6) \
    F(7, 0, 7) \
    F(8, 0, 8) \
    F(9, 0, 9) \
    F(10, 0, 10) \
    F(11, 0, 11) \
    F(12, 0, 12) \
    F(13, 0, 13) \
    F(14, 0, 14) \
    F(15, 0, 15) \
    F(16, 1, 0) \
    F(17, 1, 1) \
    F(18, 1, 2) \
    F(19, 1, 3) \
    F(20, 1, 4) \
    F(21, 1, 5) \
    F(22, 1, 6) \
    F(23, 1, 7) \
    F(24, 2, 0) \
    F(25, 2, 1) \
    F(26, 2, 2) \
    F(27, 2, 3) \
    F(28, 2, 4) \
    F(29, 3, 0) \
    F(30, 3, 1) \
    F(31, 3, 2) \
    F(32, 3, 3) \
    F(33, 4, 0) \
    F(34, 4, 1) \
    F(35, 4, 2) \
    F(36, 5, 0) \
    F(37, 5, 1) \
    F(38, 6, 0) \
    F(39, 6, 1) \
    F(40, 7, 0) \
    F(41, 7, 1) \
    F(42, 8, 0) \
    F(43, 9, 0) \
    F(44, 10, 0) \
    F(45, 11, 0) \
    F(46, 12, 0) \
    F(47, 13, 0) \
    F(48, 14, 0) \
    F(49, 15, 0)
__device__ __forceinline__ int f2key(float f) { const int b = __float_as_int(f); return b ^ ((b >> 31) & 0x7fffffff); }
__device__ __forceinline__ float key2f(int k) { return __int_as_float(k ^ ((k >> 31) & 0x7fffffff)); }
__device__ __forceinline__ void sel_top16(const f32x16 (&acc)[4], int hi, int (&t)[16]) {
    int g1[16], g2[16], g3[16];
#pragma unroll
    for (int r = 0; r < 16; ++r) { const int n = (r & 3) + 8 * (r >> 2) + 4 * hi;
        t[r] = (f2key(acc[0][r]) & ~0x7F) | n; g1[r] = (f2key(acc[1][r]) & ~0x7F) | (32 + n); g2[r] = (f2key(acc[2][r]) & ~0x7F) | (64 + n); g3[r] = (f2key(acc[3][r]) & ~0x7F) | (96 + n); }
    sel_sort16(t); sel_sort16(g1); sel_sort16(g2); sel_sort16(g3);
    sel_merge16(t, g1); sel_merge16(g2, g3); sel_merge16(t, g2);
#pragma unroll
    for (int i = 0; i < 16; ++i) g1[i] = __shfl_xor(t[i], 32);
    sel_merge16(t, g1);
}
__device__ __forceinline__ void ph_select(const bf16_t* __restrict__ QP, const bf16_t* __restrict__ KEYS, int* __restrict__ idx, float* __restrict__ gate, LAS unsigned char* lds) {
    PH_IDS
    const int lane = TIDX & 63, hd = TIDX >> 6, r = lane & 31, hi = lane >> 5;
    LAS unsigned* my = (LAS unsigned*)(lds + hd * 2048) + lane;
    for (int tg = BIDX; tg < T / 32; tg += GDIM) {
        const int tok0 = tg * 32;
        int rk = r; asm volatile("" : "+v"(rk));
        int t1[16], t2[16];
#pragma unroll
        for (int half = 0; half < 2; ++half) {
            f32x16 acc[4];
#pragma unroll
            for (int mt = 0; mt < 4; ++mt)
#pragma unroll
                for (int i = 0; i < 16; ++i) acc[mt][i] = 0.f;
            const bf16_t* qb = QP + (size_t)(tok0 + r) * D + hd * QD + half * HALF + 8 * hi;
            const bf16_t* kb = KEYS + ((size_t)(hd * 2 + half) * NK + rk) * HALF + 8 * hi;
#pragma unroll
            for (int ks = 0; ks < 4; ++ks) {
                const bf16x8 b = *(const bf16x8*)(qb + 16 * ks);
#pragma unroll
                for (int mt = 0; mt < 4; ++mt) { const bf16x8 a = *(const bf16x8*)(kb + (size_t)mt * 32 * HALF + 16 * ks); acc[mt] = __builtin_amdgcn_mfma_f32_32x32x16_bf16(a, b, acc[mt], 0, 0, 0); }
            }
            if (half == 0) sel_top16(acc, hi, t1); else sel_top16(acc, hi, t2);
        }
        float f1[16], f2[16];
#pragma unroll
        for (int i = 0; i < 16; ++i) { f1[i] = key2f(t1[i]); f2[i] = key2f(t2[i]); }
        int c0[16], c1[16], c2[16], c3[16];
#pragma unroll
        for (int i = 0; i < 16; ++i) c3[i] = (int)0x80000000;
#define SEL_F(k, i, j) { const int v_ = (f2key(f1[i] + f2[j]) & ~0xFF) | ((i) << 4 | (j)); if ((k) < 16) c0[(k) & 15] = v_; else if ((k) < 32) c1[(k) & 15] = v_; else if ((k) < 48) c2[(k) & 15] = v_; else c3[(k) & 15] = v_; }
        SEL_CANDS(SEL_F)
#undef SEL_F
        sel_sort16(c0); sel_sort16(c1); sel_sort16(c2); SEL_CE(c3[0], c3[1]);
        sel_merge16(c0, c1); sel_merge16(c2, c3); sel_merge16(c0, c2);
#pragma unroll
        for (int j = 0; j < 4; ++j) {
            my[64 * j] = (unsigned)(t1[4 * j] & 0x7F) | ((unsigned)(t1[4 * j + 1] & 0x7F) << 8) | ((unsigned)(t1[4 * j + 2] & 0x7F) << 16) | ((unsigned)(t1[4 * j + 3] & 0x7F) << 24);
            my[64 * (4 + j)] = (unsigned)(t2[4 * j] & 0x7F) | ((unsigned)(t2[4 * j + 1] & 0x7F) << 8) | ((unsigned)(t2[4 * j + 2] & 0x7F) << 16) | ((unsigned)(t2[4 * j + 3] & 0x7F) << 24);
        }
        const float mx = key2f(c0[0]); float e[16], se = 0.f;
#pragma unroll
        for (int k = 0; k < 16; ++k) { e[k] = __expf(key2f(c0[k]) - mx); se += e[k]; }
        const float inv = 1.f / se;
        asm volatile("s_waitcnt lgkmcnt(0)" ::: "memory");
        const size_t o = (size_t)(tok0 + r) * 128 + hd * TOPK;
        if (hi == 0) {
            int id[16];
#pragma unroll
            for (int k = 0; k < 16; ++k) { const int code = c0[k] & 0xFF, i = code >> 4, j = code & 15;
                const unsigned w1 = my[64 * (i >> 2)], w2 = my[64 * (4 + (j >> 2))];
                id[k] = (int)((w1 >> (8 * (i & 3))) & 0x7F) * NK + (int)((w2 >> (8 * (j & 3))) & 0x7F); }
#pragma unroll
            for (int k = 0; k < 4; ++k) *(int4*)(idx + o + 4 * k) = make_int4(id[4 * k], id[4 * k + 1], id[4 * k + 2], id[4 * k + 3]);
        } else {
#pragma unroll
            for (int k = 0; k < 4; ++k) *(float4*)(gate + o + 4 * k) = make_float4(e[4 * k] * inv, e[4 * k + 1] * inv, e[4 * k + 2] * inv, e[4 * k + 3] * inv);
        }
        asm volatile("s_waitcnt lgkmcnt(0)" ::: "memory");
    }
}
}
#ifndef PROBE_MASK
#define PROBE_MASK 0
#endif
#define REPS(bit) (((PROBE_MASK >> (bit)) & 1) ? 2 : 1)
namespace nv {
constexpr int LDS_BYTES = 147456, MISC_OFF = 131072 + 320;
struct Params { const float* in[23]; float* out; unsigned char* ws; };

__global__ void __launch_bounds__(512, 2) k_mega(Params prm) {
    extern __shared__ __attribute__((aligned(16))) unsigned char lds_raw[];
    namespace cg = cooperative_groups;
    cg::grid_group grid = cg::this_grid();
    LAS unsigned char* lds = (LAS unsigned char*)lds_raw;
    unsigned char* smem = lds_raw;
    for (int u = threadIdx.x; u < (LDS_BYTES - 131072) / 4; u += 512) ((LAS unsigned*)(lds + 131072))[u] = 0u;
    __syncthreads();
    if (threadIdx.x == 0) {
        LAS unsigned long long* tab = (LAS unsigned long long*)(lds + TAB_OFF);
#pragma unroll
        for (int i = 0; i < 23; ++i) tab[i] = (unsigned long long)prm.in[i];
        tab[23] = (unsigned long long)prm.out; tab[24] = (unsigned long long)prm.ws;
    }
    __syncthreads();
#define ARG(i) ((const float*)ldarg(lds, (i)))
#define WSP() ((unsigned char*)ldarg(lds, 24))
    XcdBarrier bar = xcd_barrier_post((unsigned*)(WSP() + WS_CTL) + CW_BAR, (volatile LAS unsigned*)(lds + MISC_OFF) + 8);
#define GRID_BAR() do { xcd_barrier(bar); asm volatile("" ::: "memory"); } while (0)
    if (threadIdx.x == 0) { volatile LAS unsigned* M = (volatile LAS unsigned*)(lds + MISC_OFF); M[16] = bar.x; M[17] = xb_add((unsigned*)(WSP() + WS_CTL) + CW_RANK + 64 * bar.x, 1u); }
    for (int rep = 0; rep < REPS(0); ++rep) {
    p0_prologue(lds);
    { unsigned char* ws = WSP(); p0_peer_tables(ARG(20), ARG(21), ARG(17), ws + WS_PU, ws + WS_PV8); }
    { unsigned char* ws = WSP(); const float* pk = ARG(19); bf16_t* kb = (bf16_t*)(ws + WS_KEYS); for (int i = obid() * 512 + otid(); i < DEPTH * PH * 2 * NK * HALF; i += ogrid() * 512) kb[i] = f2bf(pk[i]); }
    { unsigned char* ws = WSP(); p0_ssm_a(ARG(3), ARG(4), ARG(5), ARG(6), ARG(7), (f32x2v*)(ws + WS_APOW), (f32x2v*)(ws + WS_BBAR)); }
    }
    GRID_BAR();
    if (threadIdx.x == 0) {
        volatile LAS unsigned* M = (volatile LAS unsigned*)(lds + MISC_OFF); unsigned* bw = (unsigned*)(WSP() + WS_CTL) + CW_BAR; unsigned tot = 0u, ok = 1u;
        for (unsigned j = 0; j < 16; ++j) { const unsigned cnt = xb_ld(&bw[XB_XCNT(j)]); tot += cnt; if ((j < 8) != (cnt > 0u)) ok = 0u; }
        M[18] = xb_ld(&bw[XB_XCNT(bar.x)]); M[19] = (ok && tot == gridDim.x) ? 1u : 0u;
    }
    __syncthreads();
    { unsigned char* ws = WSP(); p0_ssm_b((const f32x2v*)(ws + WS_APOW), (const f32x2v*)(ws + WS_BBAR), ARG(8), ARG(9), ARG(10), (bf16_t*)(ws + WS_KD), (bf16_t*)(ws + WS_WST), (bf16_t*)(ws + WS_WOUT)); }
    grid.sync();
#pragma nounroll
    for (int l_ = 0; l_ < DEPTH; ++l_) {
        int l = l_; asm volatile("" : "+s"(l));
        {
            unsigned char* ws = WSP(); bf16_t* hb = (bf16_t*)(ws + WS_HB); float* ss1 = (float*)(ws + WS_SSP) + (size_t)T * 32;
            for (int rep = 0; rep < REPS(1); ++rep) {
            SchedGen S; S.init_plain(hb, D * 2, (const bf16_t*)(ws + WS_BT1) + (size_t)l * 2048 * D, D * 2, T, 2048, D, ogrid(), obid());
            EpiInProj E{ss1, (bf16_t*)(ws + WS_UP), (bf16_t*)(ws + WS_Q)};
            ge::gemm_phase<EpiInProj, SchedGen>(lds, S, E, otid());
            }
            for (int rep = 0; rep < REPS(2); ++rep)
            ph_flogit(hb, (const bf16_t*)(ws + WS_WF) + (size_t)l * 16 * D, ss1, ARG(13) + l * NH, (float*)(ws + WS_LOGF));
        }
        GRID_BAR();
        {
            unsigned char* ws = WSP();
            for (int rep = 0; rep < REPS(3); ++rep) {
            SchedSsmS S; S.init(ws + WS_UP, (const bf16_t*)(ws + WS_WST) + (size_t)l * G * 128 * 256, ogrid(), obid());
            EpiSsmS E{(float*)(ws + WS_SLOC)};
            ge::gemm_phase<EpiSsmS, SchedSsmS>(lds, S, E, otid());
            }
            for (int rep = 0; rep < REPS(4); ++rep)
            ph_cum2((const float*)(ws + WS_LOGF), (float*)(ws + WS_CUM));
        }
        GRID_BAR();
        for (int rep = 0; rep < REPS(5); ++rep)
        { unsigned char* ws = WSP(); ph_ssm_prefix(lds, (const float*)(ws + WS_SLOC), (const f32x2v*)(ws + WS_APOW) + (size_t)l * G * 65 * P, (bf16_t*)(ws + WS_UP)); }
        GRID_BAR();
        {
            unsigned char* ws = WSP(); float* ssp_s = (float*)(ws + WS_SSP); float* ssp_a = ssp_s + (size_t)T * 8;
            for (int rep = 0; rep < REPS(6); ++rep)
            {
                SchedSsmC S; S.init(ws + WS_UP, (const bf16_t*)(ws + WS_WOUT) + (size_t)l * G * 1024 * 128, (const bf16_t*)(ws + WS_KD) + (size_t)l * G * KDW, ogrid(), obid());
                EpiSsmC E{(bf16_t*)(ws + WS_GEL)};
                ge::gemm_phase<EpiSsmC, SchedSsmC>(lds, S, E, otid());
            }
            GRID_BAR();
            for (int rep = 0; rep < REPS(7); ++rep)
            attn_body::attn_phase<8>((char*)lds_raw, (const attn_body::bf16*)(ws + WS_Q), (const attn_body::bf16*)(ws + WS_K), (const attn_body::bf16*)(ws + WS_V), (const float*)(ws + WS_CUM), (attn_body::bf16*)(ws + WS_MIX), ssp_a, (unsigned*)(ws + WS_CTL) + CW_QUEUE + 64 * (l * 2 + rep), (volatile LAS unsigned*)(lds + MISC_OFF) + 24, otid());
            for (int rep = 0; rep < REPS(8); ++rep) {
            SchedGen S; S.init_plain(ws + WS_GEL, 32, (const bf16_t*)(ws + WS_BT2) + (size_t)l * SSMW * SSMW, SSMW * 2, T, SSMW, SSMW, ogrid(), obid());
            S.a_c16_b = T * 32; S.a_kt_b = 4l * T * 32;
            EpiGlu2 E{(const bf16_t*)(ws + WS_GEL), ARG(12) + l * SSMW, (bf16_t*)(ws + WS_MIX), ssp_s};
            ge::gemm_phase<EpiGlu2, SchedGen>(lds, S, E, otid());
            }
        }
        GRID_BAR();
        {
            unsigned char* ws = WSP(); float* ssp_s = (float*)(ws + WS_SSP); float* ssp_a = ssp_s + (size_t)T * 8; float* ssp_2 = ssp_a + (size_t)T * 8;
            for (int rep = 0; rep < REPS(9); ++rep) {
            const bool dummy = rep + 1 < REPS(9);
            SchedGen S; S.init_plain(ws + WS_MIX, D * 2, (const bf16_t*)(ws + WS_BT3) + (size_t)l * D * D, D * 2, T, D, D, ogrid(), obid());
            EpiWo E{ssp_s, ssp_a, (const float*)(ws + WS_H), dummy ? (float*)(ws + WS_PART) : (float*)(ws + WS_H), dummy ? (bf16_t*)(ws + WS_QP) : (bf16_t*)(ws + WS_HB), dummy ? (float*)(ws + WS_SLOC) : ssp_2};
            ge::gemm_phase<EpiWo, SchedGen>(lds, S, E, otid());
            }
        }
        GRID_BAR();
        {
            unsigned char* ws = WSP(); float* ssp_2 = (float*)(ws + WS_SSP) + (size_t)T * 16;
            for (int rep = 0; rep < REPS(10); ++rep) {
            SchedGen S; S.init_plain(ws + WS_HB, D * 2, (const bf16_t*)(ws + WS_BT4) + (size_t)l * D * D, D * 2, T, D, D, ogrid(), obid());
            EpiWq E{ssp_2, (bf16_t*)(ws + WS_QP)};
            ge::gemm_phase<EpiWq, SchedGen>(lds, S, E, otid());
            }
        }
        GRID_BAR();
        for (int rep = 0; rep < REPS(11); ++rep)
        { unsigned char* ws = WSP(); ph_select((const bf16_t*)(ws + WS_QP), (const bf16_t*)(ws + WS_KEYS) + (size_t)l * PH * 2 * NK * HALF, (int*)(ws + WS_IDX), (float*)(ws + WS_GATE), lds); }
        GRID_BAR();
        if (PROBE_MASK & (1 << 16)) { unsigned char* ws = WSP(); ph_peer_u<0>(lds, ws + WS_PU + (size_t)l * NEXP * D, (const bf16_t*)(ws + WS_HB), (const int*)(ws + WS_IDX), (float*)(ws + WS_UP), 1023); }
        for (int rep = 0; rep < REPS(12); ++rep)
        { unsigned char* ws = WSP(); ph_peer_u<0>(lds, ws + WS_PU + (size_t)l * NEXP * D, (const bf16_t*)(ws + WS_HB), (const int*)(ws + WS_IDX), (float*)(ws + WS_PART)); }
        GRID_BAR();
        for (int rep = 0; rep < REPS(13); ++rep)
        { unsigned char* ws = WSP(); ph_peer_coef((const float*)(ws + WS_PART), (const float*)(ws + WS_SSP) + (size_t)T * 16, (const float*)(ws + WS_GATE), (float*)(ws + WS_COEF)); }
        GRID_BAR();
        if (PROBE_MASK & (1 << 17)) { unsigned char* ws = WSP();
          ph_peer_v<0>(lds, ws + WS_PV8 + (size_t)l * NEXP * D, (const int*)(ws + WS_IDX), (const float*)(ws + WS_COEF), (const float*)(ws + WS_H), (float*)(ws + WS_PART), (bf16_t*)(ws + WS_UP), (float*)(ws + WS_SLOC), 1023); }
        for (int rep = 0; rep < REPS(14); ++rep)
        { unsigned char* ws = WSP(); const bool dummy = rep + 1 < REPS(14);
          ph_peer_v<0>(lds, ws + WS_PV8 + (size_t)l * NEXP * D, (const int*)(ws + WS_IDX), (const float*)(ws + WS_COEF), (const float*)(ws + WS_H), dummy ? (float*)(ws + WS_PART) : (float*)(ws + WS_H),
                    dummy ? (bf16_t*)(ws + WS_UP) : (bf16_t*)(ws + WS_HB), dummy ? (float*)(ws + WS_SLOC) : (float*)(ws + WS_SSP) + (size_t)T * 32); }
        if (PROBE_MASK & (1 << 15)) { for (int rep = 0; rep < 8; ++rep) GRID_BAR(); }
        GRID_BAR();
    }
    { unsigned char* ws = WSP(); ph_final((const float*)(ws + WS_H), (const float*)(ws + WS_SSP) + (size_t)T * 32, ARG(22), (float*)ldarg(lds, 23)); }
}
}

extern "C" void kernel_launch(void* const* d_in, const int* in_sizes, int n_in, void* d_out, int out_size, void* d_ws, size_t ws_size, hipStream_t stream) {
    using namespace nv;
    static int grid_blocks = 0;
    if (!grid_blocks) {
        int dev = 0, cus = 0, per_cu = 0;
        (void)hipGetDevice(&dev);
        (void)hipDeviceGetAttribute(&cus, hipDeviceAttributeMultiprocessorCount, dev);
        if (hipFuncSetAttribute((const void*)k_mega, hipFuncAttributeMaxDynamicSharedMemorySize, LDS_BYTES) != hipSuccess) { fprintf(stderr, "hipFuncSetAttribute failed\n"); grid_blocks = -1; return; }
        (void)hipOccupancyMaxActiveBlocksPerMultiprocessor(&per_cu, (const void*)k_mega, 512, LDS_BYTES);
        if (per_cu < 1) { fprintf(stderr, "occupancy query returned %d\n", per_cu); (void)hipGetLastError(); }
        grid_blocks = cus;
    }
    if (grid_blocks < 0) return;
    if (ws_size < WS_END || n_in != 23) { fprintf(stderr, "bad workspace / inputs\n"); return; }
    (void)hipMemsetAsync((char*)d_ws + WS_CTL, 0, CTL_BYTES, stream);
    Params p{};
    for (int i = 0; i < 23; ++i) p.in[i] = (const float*)d_in[i];
    p.out = (float*)d_out; p.ws = (unsigned char*)d_ws;
    void* args[] = {&p};
    hipError_t e = hipLaunchCooperativeKernel((const void*)k_mega, dim3(grid_blocks), dim3(512), args, LDS_BYTES, stream);
    if (e != hipSuccess) fprintf(stderr, "cooperative launch failed: %s (grid %d)\n", hipGetErrorString(e), grid_blocks);
}
```

```cpp
#include <hip/hip_runtime.h>
#include <hip/hip_cooperative_groups.h>
#include <hip/hip_bf16.h>
#include <cstdint>
#include <cstdio>

#define LAS __attribute__((address_space(3)))
#define GAS __attribute__((address_space(1)))

namespace nv {
constexpr int D = 1024, BATCH = 8, SEQ = 4096, DEPTH = 4, T = BATCH * SEQ;
constexpr int SSMW = 512, G = 32, HC = 16, P = 64, ATTW = 512, HD = 64, NH = 8, INW = 2056;
constexpr int PH = 8, NK = 128, TOPK = 16, QD = 128, HALF = 64, NEXP = 16384;
constexpr int CHUNK = 64, NCH = T / CHUNK  , UPW = 128 + CHUNK * HC  ;
constexpr float EPS = 1e-6f;

typedef short bf16x8 __attribute__((ext_vector_type(8)));
typedef float f32x16 __attribute__((ext_vector_type(16)));
typedef float f32x4 __attribute__((ext_vector_type(4)));
typedef unsigned u32x4 __attribute__((ext_vector_type(4)));
typedef unsigned short bf16_t;

constexpr size_t MiB = 1u << 20;
constexpr size_t WS_CTL = 0, CTL_BYTES = 4 * MiB;
constexpr size_t WS_BT1 = 4 * MiB;
constexpr size_t WS_BT2 = 20 * MiB;
constexpr size_t WS_BT3 = 22 * MiB;
constexpr size_t WS_BT4 = 30 * MiB;
constexpr size_t WS_WF = 38 * MiB;
constexpr size_t WS_KEYS = 39 * MiB;
constexpr size_t WS_KD = 40 * MiB, WS_WOUT = 49 * MiB, WS_WST = 81 * MiB;
constexpr size_t WS_PU = 90 * MiB, WS_PV8 = 154 * MiB;
constexpr size_t WS_PART = 218 * MiB;
constexpr size_t WS_H = 346 * MiB;
constexpr size_t WS_HB = 474 * MiB;
constexpr size_t WS_UP = 538 * MiB;
constexpr size_t WS_Q = 576 * MiB, WS_K = 608 * MiB, WS_V = 640 * MiB;
constexpr size_t WS_LOGF = 672 * MiB, WS_CUM = 673 * MiB;
constexpr size_t WS_SLOC = 674 * MiB, WS_GEL = 708 * MiB, WS_MIX = 740 * MiB;
constexpr size_t WS_SSP = 916 * MiB;
constexpr size_t WS_QP = 852 * MiB;
constexpr size_t WS_IDX = 804 * MiB, WS_GATE = 820 * MiB, WS_COEF = 836 * MiB;
constexpr size_t WS_XN_F = 90 * MiB, WS_MIXED_F = 218 * MiB, WS_QP_F = 852 * MiB, WS_GEL_F = 90 * MiB  , WS_YSSM_F = 740 * MiB, WS_YATT_F = 674 * MiB;
constexpr size_t WS_END = 980 * MiB;
constexpr int CW_QUEUE = 1024;
constexpr int CW_RANK = 2048;
constexpr int CW_BAR = 4096;
constexpr int CW_SS = 65536;
constexpr int SS_H1 = 0  , SS_H2 = 5  , SS_SSM = 9, SS_ATT = 13;
static_assert((size_t)(CW_SS + 17 * T) * 4 <= CTL_BYTES, "ctl region");

__device__ __forceinline__ unsigned short f2bf(float f) { unsigned u = __float_as_uint(f); return (unsigned short)((u + 0x7fffu + ((u >> 16) & 1u)) >> 16); }
__device__ __forceinline__ float bf2f(unsigned short b) { return __uint_as_float(((unsigned)b) << 16); }
__device__ __forceinline__ unsigned pk2(float lo, float hi) { return (unsigned)f2bf(lo) | ((unsigned)f2bf(hi) << 16); }
__device__ __forceinline__ float gelu_tanh(float x) { const float u = 0.7978845608028654f * (x + 0.044715f * x * x * x); return 0.5f * x * (1.f + tanhf(u)); }
__device__ __forceinline__ float wave_sum(float v) {
#pragma unroll
    for (int o = 1; o < 64; o <<= 1) v += __shfl_xor(v, o);
    return v;
}
__device__ __forceinline__ int otid() { int t = threadIdx.x; asm volatile("" : "+v"(t)); return t; }
__device__ __forceinline__ int obid() { int t = blockIdx.x; asm volatile("" : "+s"(t)); return t; }
__device__ __forceinline__ int ogrid() { int t = gridDim.x; asm volatile("" : "+s"(t)); return t; }
#define PH_IDS const int TIDX = otid(), BIDX = obid(), GDIM = ogrid(); (void)TIDX; (void)BIDX; (void)GDIM;
__device__ __forceinline__ size_t up_index(int row, int c) { const int n = row >> 6, j = row & 63, g = c >> 4, hh = c & 15; return ((size_t)g * NCH + n) * UPW + 128 + j * HC + hh; }
}
namespace ge {
#define GE_LAS __attribute__((address_space(3)))
typedef unsigned short bf16_t;
typedef short bf16x8 __attribute__((ext_vector_type(8)));
typedef float f32x4 __attribute__((ext_vector_type(4)));
typedef unsigned u32x4 __attribute__((ext_vector_type(4)));
typedef unsigned u32x2 __attribute__((ext_vector_type(2)));
constexpr int ROWF_OFF = 131072 + 4096;
constexpr int BM = 256, BK = 64, HALF = 128, HTB = HALF * BK * 2  , STAGE_BYTES = 8 * HTB, NXCD = 8, WGM = 8;

__host__ __device__ __forceinline__ int lds_byte(int r, int c) { const int st = (r >> 4) * 2 + (c >> 5), rr = r & 15, cc = c & 31, ob = rr * 64 + cc * 2; return st * 1024 + (ob ^ (((ob >> 9) & 1) << 5)); }
__host__ __device__ __forceinline__ void stage_rc(int b, int& R, int& C) { const int st = b / 1024, sb = b % 1024, swz = sb ^ (((sb >> 9) & 1) << 5); R = (st >> 1) * 16 + swz / 64; C = (st & 1) * 32 + (swz % 64) / 2; }
__host__ __device__ __forceinline__ int perm32(int rho) { const int n = rho >> 4, i = rho & 15; return 8 * (i >> 2) + 4 * n + (i & 3); }

struct Unit { const char* A0; const char* B0; int nt; int pm, pn, aux; };
__device__ __forceinline__ unsigned cvt_pk_bf16(float lo, float hi) { unsigned r; asm volatile("v_cvt_pk_bf16_f32 %0, %1, %2" : "=v"(r) : "v"(lo), "v"(hi)); return r; }

__device__ __forceinline__ bool static_tile(int i, int G, int c, int nM, int nN, int& pm, int& pn) {
    const int nwg = nM * nN; const long L = (long)i * G + c; if (L >= nwg) return false;
    int wgid = (int)L; { const int q = nwg / NXCD, r = nwg % NXCD, xcd = wgid % NXCD, off = wgid / NXCD; wgid = (xcd < r ? xcd * (q + 1) : r * (q + 1) + (xcd - r) * q) + off; }
    const int nig = WGM * nN, gid = wgid / nig, fm = gid * WGM, gsz = (nM - fm) < WGM ? (nM - fm) : WGM;
    pm = fm + ((wgid % nig) % gsz); pn = (wgid % nig) / gsz; return true;
}

template <class Epi, class Sched>
__device__ __forceinline__ void gemm_phase(GE_LAS unsigned char* lds, const Sched& S, const Epi& E, int tid) {
    const int wid = __builtin_amdgcn_readfirstlane(tid >> 6), lane = tid & 63, wr = wid >> 2, wc = wid & 3, fr = lane & 15, fq = lane >> 4;
    unsigned voffA[2], voffB[2], voffB1[2];
#pragma unroll
    for (int i = 0; i < 2; ++i) { int R, C; stage_rc(tid * 16 + i * 8192, R, C); const int Rb = Epi::PERM ? ((R & ~31) + perm32(R & 31)) : R;
        voffA[i] = S.voffA(R, C); voffB[i] = S.voffB(Rb, C); if constexpr (Sched::DUALB) voffB1[i] = S.voffB1(Rb, C); else voffB1[i] = 0u; }
    const long hA = S.hA, hB = S.hB;
    const unsigned ldsw = (unsigned)wid * 1024u;
    const int aoff = lds_byte(wr * 64 + fr, fq * 8), boff = lds_byte(wc * 32 + fr, fq * 8);
#define GE_SA(b, h) (((b) * 2 + (h)) * HTB)
#define GE_SB(b, h) ((4 + (b) * 2 + (h)) * HTB)
#define GE_STAGE(bufoff, gbase, voff) do { _Pragma("unroll") for (int _i = 0; _i < 2; ++_i) \
        __builtin_amdgcn_global_load_lds((const unsigned*)((const char*)(gbase) + (voff)[_i]), (GE_LAS unsigned*)(lds + (bufoff) + ldsw + _i * 8192), 16, 0, 0); } while (0)
#define GE_STAGE_B(bufoff, gbase, sel, half) do { if constexpr (Sched::DUALB) { const char* _g = (const char*)(gbase) + ((half) ? ((sel) ? S.hB1 : hB) : 0l); _Pragma("unroll") for (int _i = 0; _i < 2; ++_i) { const unsigned _v = (sel) ? voffB1[_i] : voffB[_i]; \
        __builtin_amdgcn_global_load_lds((const unsigned*)(_g + _v), (GE_LAS unsigned*)(lds + (bufoff) + ldsw + _i * 8192), 16, 0, 0); } } else { GE_STAGE(bufoff, (const char*)(gbase) + ((half) ? hB : 0l), voffB); } } while (0)
#define GE_LDA(dst, b, h) do { _Pragma("unroll") for (int m = 0; m < 4; ++m) _Pragma("unroll") for (int k = 0; k < 2; ++k) dst[m][k] = *(const GE_LAS bf16x8*)(lds + GE_SA(b, h) + aoff + m * 2048 + k * 1024); } while (0)
#define GE_LDB(dst, b, h) do { _Pragma("unroll") for (int n = 0; n < 2; ++n) _Pragma("unroll") for (int k = 0; k < 2; ++k) dst[n][k] = *(const GE_LAS bf16x8*)(lds + GE_SB(b, h) + boff + n * 2048 + k * 1024); } while (0)
#define GE_MMA(ai, bj, At, Bt) do { __builtin_amdgcn_s_setprio(1); _Pragma("unroll") for (int m = 0; m < 4; ++m) _Pragma("unroll") for (int n = 0; n < 2; ++n) _Pragma("unroll") for (int k = 0; k < 2; ++k) \
        acc[ai][bj][m][n] = __builtin_amdgcn_mfma_f32_16x16x32_bf16(Bt[n][k], At[m][k], acc[ai][bj][m][n], 0, 0, 0); __builtin_amdgcn_s_setprio(0); } while (0)
#define GE_WAIT_V(n) asm volatile("s_waitcnt vmcnt(" #n ")" ::: "memory")
#define GE_WAIT_L(n) asm volatile("s_waitcnt lgkmcnt(" #n ")" ::: "memory")
#define GE_BAR __builtin_amdgcn_s_barrier()
#define GE_SCHED __builtin_amdgcn_sched_barrier(0)
    Unit cur, nxt; int ui = 0;
    if (!S.next(0, cur)) return;
    f32x4 acc[2][2][4][2];
#pragma unroll
    for (int a = 0; a < 2; ++a)
#pragma unroll
        for (int b = 0; b < 2; ++b)
#pragma unroll
            for (int m = 0; m < 4; ++m)
#pragma unroll
                for (int n = 0; n < 2; ++n) acc[a][b][m][n] = (f32x4){0.f, 0.f, 0.f, 0.f};
    bf16x8 At[4][2], B0[2][2], B1[2][2];
    if constexpr (Epi::UBEGIN) E.unit_begin(cur, tid, lds + ROWF_OFF);
    {
        const char* a0 = S.ta(cur, 0); const char* b0 = S.tb(cur, 0); const char* a1 = S.ta(cur, 1); const char* b1 = S.tb(cur, 1);
        const bool s0 = S.sb(cur, 0), s1 = S.sb(cur, 1);
        GE_STAGE_B(GE_SB(0, 0), b0, s0, 0); GE_STAGE_B(GE_SB(0, 1), b0, s0, 1); GE_STAGE(GE_SA(0, 0), a0, voffA); GE_STAGE(GE_SA(0, 1), a0 + hA, voffA);
        if (wr == 1) GE_BAR;
        GE_WAIT_V(2); GE_BAR;
        GE_STAGE_B(GE_SB(1, 0), b1, s1, 0); GE_STAGE(GE_SA(1, 0), a1, voffA); GE_STAGE_B(GE_SB(1, 1), b1, s1, 1);
        GE_WAIT_V(6); GE_BAR;
    }
    for (;;) {
        const bool has_next = S.next(ui + 1, nxt);
        const int nt = cur.nt;
        for (int t = 0; t < nt; t += 2) {
            const bool last = (t == nt - 2);
            const char* a1 = S.ta(cur, t + 1);
            const char* a2 = last ? (has_next ? S.ta(nxt, 0) : S.ta(cur, 0)) : S.ta(cur, t + 2);
            const char* b2 = last ? (has_next ? S.tb(nxt, 0) : S.tb(cur, 0)) : S.tb(cur, t + 2);
            const char* a3 = last ? (has_next ? S.ta(nxt, 1) : S.ta(cur, 1)) : S.ta(cur, t + 3);
            const char* b3 = last ? (has_next ? S.tb(nxt, 1) : S.tb(cur, 1)) : S.tb(cur, t + 3);
            const bool s2 = last ? (has_next ? S.sb(nxt, 0) : S.sb(cur, 0)) : S.sb(cur, t + 2), s3 = last ? (has_next ? S.sb(nxt, 1) : S.sb(cur, 1)) : S.sb(cur, t + 3);
            GE_LDB(B0, 0, 0); GE_LDB(B1, 0, 1); GE_SCHED; GE_LDA(At, 0, 0); GE_STAGE(GE_SA(1, 1), a1 + hA, voffA);
            GE_WAIT_V(8); GE_WAIT_L(0); GE_BAR; GE_MMA(0, 0, At, B0); GE_MMA(0, 1, At, B1); GE_BAR; GE_SCHED;
            GE_LDA(At, 0, 1); GE_STAGE_B(GE_SB(0, 0), b2, s2, 0); GE_STAGE_B(GE_SB(0, 1), b2, s2, 1); GE_STAGE(GE_SA(0, 0), a2, voffA);
            GE_WAIT_V(8); GE_WAIT_L(0); GE_BAR; GE_MMA(1, 0, At, B0); GE_MMA(1, 1, At, B1); GE_BAR; GE_SCHED;
            GE_LDB(B0, 1, 0); GE_LDB(B1, 1, 1); GE_SCHED; GE_LDA(At, 1, 0); GE_STAGE(GE_SA(0, 1), a2 + hA, voffA);
            GE_WAIT_V(8); GE_WAIT_L(0); GE_BAR; GE_MMA(0, 0, At, B0); GE_MMA(0, 1, At, B1); GE_BAR; GE_SCHED;
            GE_LDA(At, 1, 1); GE_STAGE_B(GE_SB(1, 0), b3, s3, 0); GE_STAGE_B(GE_SB(1, 1), b3, s3, 1); GE_STAGE(GE_SA(1, 0), a3, voffA);
            GE_WAIT_V(8); GE_WAIT_L(0); GE_BAR; GE_MMA(1, 0, At, B0); GE_MMA(1, 1, At, B1); GE_BAR; GE_SCHED;
            if constexpr (Epi::MIDK) { if (t + 2 == (nt >> 1)) E.midk(acc, cur, wr, fr, lds + ROWF_OFF + (ui & 1) * 2048); }
        }
        if (wr == 0) GE_BAR;
        E(acc, cur, wr, wc, fr, fq, lds + ROWF_OFF + (ui & 1) * 2048);
        if (!has_next) break;
        if constexpr (Epi::UBEGIN) E.unit_begin(nxt, tid, lds + ROWF_OFF + ((ui + 1) & 1) * 2048);
#pragma unroll
        for (int a = 0; a < 2; ++a)
#pragma unroll
            for (int b = 0; b < 2; ++b)
#pragma unroll
                for (int m = 0; m < 4; ++m)
#pragma unroll
                    for (int n = 0; n < 2; ++n) acc[a][b][m][n] = (f32x4){0.f, 0.f, 0.f, 0.f};
        cur = nxt; ++ui;
        if (wr == 1) GE_BAR;
    }
    GE_WAIT_V(0);
    GE_BAR;
#undef GE_SA
#undef GE_SB
#undef GE_STAGE
#undef GE_STAGE_B
#undef GE_LDA
#undef GE_LDB
#undef GE_MMA
#undef GE_WAIT_V
#undef GE_WAIT_L
#undef GE_BAR
#undef GE_SCHED
}
}
namespace nv {
__device__ __forceinline__ float sum16(const float* p);
__device__ __forceinline__ void ph_rmsnorm(const float* __restrict__ in, int ldi, const float* __restrict__ g, float* __restrict__ out, int ldo, int n, int rows) {
    PH_IDS
    const int lane = TIDX & 63, gw = BIDX * 8 + (TIDX >> 6), ngw = GDIM * 8;
    for (int w = gw; w < rows; w += ngw) {
        const float* r = in + (size_t)w * ldi; float* o = out + (size_t)w * ldo;
        float s = 0.f;
        for (int c = lane; c < n; c += 64) { const float v = r[c]; s += v * v; }
        s = wave_sum(s);
        const float rs = rsqrtf(s / (float)n + EPS);
        for (int c = lane; c < n; c += 64) o[c] = r[c] * rs * g[c];
    }
}
__device__ __forceinline__ void ph_make_hb(const float* __restrict__ h, bf16_t* __restrict__ hb, float* __restrict__ ss) {
    PH_IDS
    const int lane = TIDX & 63, gw = BIDX * 8 + (TIDX >> 6), ngw = GDIM * 8;
    for (int w = gw; w < T; w += ngw) {
        const f32x4* r = (const f32x4*)(h + (size_t)w * D) + lane; unsigned long long* o = (unsigned long long*)(hb + (size_t)w * D) + lane;
        float s = 0.f;
#pragma unroll
        for (int j = 0; j < 4; ++j) { const f32x4 v = r[64 * j]; s += v.x * v.x + v.y * v.y + v.z * v.z + v.w * v.w; o[64 * j] = (unsigned long long)pk2(v.x, v.y) | ((unsigned long long)pk2(v.z, v.w) << 32); }
        s = wave_sum(s);
        if (lane == 0) ss[w] = s;
    }
}

template <class Epi>
__device__ __forceinline__ void ph_gemm(unsigned char* sm, const float* __restrict__ A, int lda, const float* __restrict__ B, int ldb, int M, int N, int K, Epi epi) {
    PH_IDS
    const int team = TIDX >> 8, tid = TIDX & 255, wave = tid >> 6, lane = tid & 63;
    unsigned short (*As)[40] = (unsigned short (*)[40])(sm + team * 20480); unsigned short (*Bs)[40] = (unsigned short (*)[40])(sm + team * 20480 + 10240);
    const int ntn = (N + 127) / 128, ntiles = ntn * (M / 128);
    const int wm = (wave >> 1) * 64, wn = (wave & 1) * 64;
    for (int it = BIDX; it < ntiles / 2; it += GDIM) {
        const int tile = it * 2 + team, m0 = (tile / ntn) * 128, n0 = (tile % ntn) * 128;
        f32x16 acc[2][2];
#pragma unroll
        for (int i = 0; i < 2; ++i)
#pragma unroll
            for (int j = 0; j < 2; ++j)
#pragma unroll
                for (int r = 0; r < 16; ++r) acc[i][j][r] = 0.f;
        for (int k0 = 0; k0 < K; k0 += 32) {
#pragma unroll
            for (int i = 0; i < 4; ++i) {
                const int idx = tid + i * 256, r = idx >> 3, c = (idx & 7) * 4;
                const float4 v = *(const float4*)(A + (size_t)(m0 + r) * lda + k0 + c);
                As[r][c] = f2bf(v.x); As[r][c + 1] = f2bf(v.y); As[r][c + 2] = f2bf(v.z); As[r][c + 3] = f2bf(v.w);
            }
#pragma unroll
            for (int i = 0; i < 4; ++i) {
                const int idx = tid + i * 256, k = idx >> 5, c = (idx & 31) * 4, n = n0 + c;
                float4 v = make_float4(0.f, 0.f, 0.f, 0.f);
                if (n + 3 < N) v = *(const float4*)(B + (size_t)(k0 + k) * ldb + n);
                Bs[c][k] = f2bf(v.x); Bs[c + 1][k] = f2bf(v.y); Bs[c + 2][k] = f2bf(v.z); Bs[c + 3][k] = f2bf(v.w);
            }
            __syncthreads();
#pragma unroll
            for (int ks = 0; ks < 2; ++ks) {
                bf16x8 a[2], b[2];
#pragma unroll
                for (int i = 0; i < 2; ++i) a[i] = *(const bf16x8*)&As[wm + i * 32 + (lane & 31)][ks * 16 + (lane >> 5) * 8];
#pragma unroll
                for (int j = 0; j < 2; ++j) b[j] = *(const bf16x8*)&Bs[wn + j * 32 + (lane & 31)][ks * 16 + (lane >> 5) * 8];
#pragma unroll
                for (int i = 0; i < 2; ++i)
#pragma unroll
                    for (int j = 0; j < 2; ++j) acc[i][j] = __builtin_amdgcn_mfma_f32_32x32x16_bf16(a[i], b[j], acc[i][j], 0, 0, 0);
            }
            __syncthreads();
        }
#pragma unroll
        for (int i = 0; i < 2; ++i)
#pragma unroll
            for (int j = 0; j < 2; ++j)
#pragma unroll
                for (int r = 0; r < 16; ++r) {
                    const int row = m0 + wm + i * 32 + (r & 3) + 8 * (r >> 2) + 4 * (lane >> 5), col = n0 + wn + j * 32 + (lane & 31);
                    if (col < N) epi(row, col, acc[i][j][r]);
                }
    }
}
struct EpiStore { float* C; int ldc; int pad; __device__ void operator()(int r, int c, float v) const { C[(size_t)r * ldc + c] = v; } };
struct EpiAdd { float* C; int ldc; int pad; __device__ void operator()(int r, int c, float v) const { C[(size_t)r * ldc + c] += v; } };
struct EpiGlu { const float* gel; const float* bias; float* out; __device__ void operator()(int r, int c, float v) const {
    const float gg = gel[(size_t)r * SSMW + c]; out[(size_t)r * SSMW + c] = gg / (1.f + expf(-(v + bias[c]))); } };

__device__ __forceinline__ void ph_ssm(const bf16_t* __restrict__ UP, const float* __restrict__ lam_re, const float* __restrict__ lam_im, const float* __restrict__ log_dt,
                                       const float* __restrict__ b_re, const float* __restrict__ b_im, const float* __restrict__ c_re, const float* __restrict__ c_im,
                                       const float* __restrict__ dsk, bf16_t* __restrict__ gel) {
    PH_IDS
    const int p = TIDX & 63, wv = TIDX >> 6;
    for (int item = BIDX + GDIM * wv; item < BATCH * G; item += GDIM * 8) {
        const int b = item / G, g = item % G;
        const float dt = expf(log_dt[g]);
        const float lr = lam_re[g * P + p], li = lam_im[g * P + p];
        const float mag = expf(lr * dt), are = mag * cosf(li * dt), aim = mag * sinf(li * dt);
        const float den = lr * lr + li * li, nr = are - 1.f;
        const float zre = (nr * lr + aim * li) / den, zim = (aim * lr - nr * li) / den;
        float bbr[HC], bbi[HC], cr[HC], ci[HC];
#pragma unroll
        for (int h = 0; h < HC; ++h) {
            const float br = b_re[(g * P + p) * HC + h], bi = b_im[(g * P + p) * HC + h];
            bbr[h] = zre * br - zim * bi; bbi[h] = zre * bi + zim * br;
            cr[h] = c_re[(g * HC + h) * P + p]; ci[h] = c_im[(g * HC + h) * P + p];
        }
        const float dmine = dsk[g * HC + (p & 15)];
        float sre = 0.f, sim = 0.f;
        for (int t = 0; t < SEQ; ++t) {
            const bf16_t* u = UP + up_index(b * SEQ + t, g * HC);
            float xr = 0.f, xi = 0.f, um = 0.f;
#pragma unroll
            for (int h = 0; h < HC; ++h) { const float uv = bf2f(u[h]); xr += bbr[h] * uv; xi += bbi[h] * uv; if ((p & 15) == h) um = uv; }
            const float nre = are * sre - aim * sim + xr, nim = are * sim + aim * sre + xi;
            sre = nre; sim = nim;
            float ymine = 0.f;
#pragma unroll
            for (int h = 0; h < HC; ++h) { const float v = wave_sum(cr[h] * sre - ci[h] * sim); if ((p & 15) == h) ymine = v; }
            if (p < HC) gel[((size_t)g * T + b * SEQ + t) * HC + p] = f2bf(gelu_tanh(ymine + dmine * um));
        }
    }
}

__device__ __forceinline__ void ph_cum(const float* __restrict__ logf, float* __restrict__ cum) {
    PH_IDS
    if (BIDX != GDIM - 1 || (TIDX >> 6) != 7) return;
    const int i = TIDX & 63;
    const int b = i / NH, h = i % NH; float c = 0.f;
    for (int t = 0; t < SEQ; ++t) { c += logf[(size_t)(b * SEQ + t) * NH + h]; cum[(size_t)i * SEQ + t] = c * 1.4426950408889634f; }
}

__device__ __forceinline__ void ph_attn(const bf16_t* __restrict__ Q, const bf16_t* __restrict__ Kb, const bf16_t* __restrict__ Vb, const float* __restrict__ cum, bf16_t* __restrict__ MIX, float* __restrict__ ssp_att) {
    PH_IDS
    const int gw = BIDX * 8 + (TIDX >> 6), ngw = GDIM * 8, lane = TIDX & 63;
    constexpr int NIT = BATCH * NH * (SEQ / 64);
    for (int it0 = gw; it0 < NIT; it0 += ngw) {
        const int it = NIT - 1 - it0;
        const int tb = it / (BATCH * NH), bh = it % (BATCH * NH), b = bh / NH, h = bh % NH;
        const int t = tb * 64 + lane;
        float q[HD], o[HD];
#pragma unroll
        for (int d = 0; d < HD; ++d) { q[d] = bf2f(Q[(size_t)(b * SEQ + t) * ATTW + h * HD + d]) * 0.125f; o[d] = 0.f; }
        const float* cm = cum + (size_t)bh * SEQ; const float ct = cm[t];
        float m = -INFINITY, l = 0.f;
        const int smax = tb * 64 + 63;
        for (int s = 0; s <= smax; ++s) {
            const bf16_t* kr = Kb + (size_t)(b * SEQ + s) * ATTW + h * HD; const bf16_t* vr = Vb + (size_t)(b * SEQ + s) * ATTW + h * HD;
            float lg = ct - cm[s];
#pragma unroll
            for (int d = 0; d < HD; ++d) lg += q[d] * bf2f(kr[d]);
            if (s <= t) {
                const float mn = fmaxf(m, lg), sc = expf(m - mn), pp = expf(lg - mn);
                l = l * sc + pp; m = mn;
#pragma unroll
                for (int d = 0; d < HD; ++d) o[d] = o[d] * sc + pp * bf2f(vr[d]);
            }
        }
        const float il = 1.f / l; float sq = 0.f;
#pragma unroll
        for (int d = 0; d < HD; ++d) { const float ov = o[d] * il; sq += ov * ov; MIX[(size_t)(b * SEQ + t) * D + SSMW + h * HD + d] = f2bf(ov); }
        ssp_att[(size_t)(b * SEQ + t) * 8 + h] = sq;
    }
}

__device__ __forceinline__ void ph_peer_select(unsigned char* sm, const bf16_t* __restrict__ qp, const float* __restrict__ keys, int* __restrict__ idx, float* __restrict__ gate) {
    PH_IDS
    const int team = TIDX >> 8, tid = TIDX & 255, lane = tid & 63, wave = tid >> 6;
    float* sc = (float*)(sm + team * 4096); float* tv = sc + 256; int* ti = (int*)(tv + 32); float* cand = (float*)(ti + 32);
    for (int it = BIDX; it < T * PH / 2; it += GDIM) {
        const int item = it * 2 + team, tok = item / PH, hd = item % PH;
        {
            const int half = tid >> 7, n = tid & 127;
            const bf16_t* q = qp + (size_t)tok * D + hd * QD + half * HALF; const float* kk = keys + ((size_t)(hd * 2 + half) * NK + n) * HALF;
            float s = 0.f;
            for (int d = 0; d < HALF; ++d) s += bf2f(q[d]) * kk[d];
            sc[tid] = s;
        }
        __syncthreads();
        if (wave == 0 || wave == 2) {
            const int half = wave >> 1;
            float v0 = sc[half * 128 + lane], v1 = sc[half * 128 + lane + 64];
            for (int k = 0; k < TOPK; ++k) {
                float bv; int bi;
                if (v0 >= v1) { bv = v0; bi = lane; } else { bv = v1; bi = lane + 64; }
#pragma unroll
                for (int o = 1; o < 64; o <<= 1) { const float ov = __shfl_xor(bv, o); const int oi = __shfl_xor(bi, o); if (ov > bv || (ov == bv && oi < bi)) { bv = ov; bi = oi; } }
                if (lane == 0) { tv[half * 16 + k] = bv; ti[half * 16 + k] = bi; }
                if (bi == lane) v0 = -INFINITY; if (bi == lane + 64) v1 = -INFINITY;
            }
        }
        __syncthreads();
        cand[tid] = tv[tid >> 4] + tv[16 + (tid & 15)];
        __syncthreads();
        if (wave == 0) {
            float v[4];
#pragma unroll
            for (int j = 0; j < 4; ++j) v[j] = cand[lane + 64 * j];
            float best = 0.f; int bidx = 0; float mx = 0.f, se = 0.f;
            for (int k = 0; k < TOPK; ++k) {
                float bv = v[0]; int bi = lane;
#pragma unroll
                for (int j = 1; j < 4; ++j) if (v[j] > bv) { bv = v[j]; bi = lane + 64 * j; }
#pragma unroll
                for (int o = 1; o < 64; o <<= 1) { const float ov = __shfl_xor(bv, o); const int oi = __shfl_xor(bi, o); if (ov > bv || (ov == bv && oi < bi)) { bv = ov; bi = oi; } }
                if (k == 0) mx = bv;
                const float e = expf(bv - mx); se += e;
                if (lane == k) { best = e; bidx = ti[bi >> 4] * NK + ti[16 + (bi & 15)]; }
#pragma unroll
                for (int j = 0; j < 4; ++j) if (bi == lane + 64 * j) v[j] = -INFINITY;
            }
            if (lane < TOPK) { idx[(size_t)tok * 128 + hd * TOPK + lane] = bidx; gate[(size_t)tok * 128 + hd * TOPK + lane] = best / se; }
        }
        __syncthreads();
    }
}

__device__ __forceinline__ void ph_peer_eval(unsigned char* sm, const float* __restrict__ ss2, const float* __restrict__ g2, const int* __restrict__ idx, const float* __restrict__ gate,
                                             const float* __restrict__ ut, const float* __restrict__ vt, float* __restrict__ h) {
    PH_IDS
    const int team = TIDX >> 8, tid = TIDX & 255, lane = tid & 63, wave = tid >> 6;
    float (*red)[D] = (float (*)[D])(sm + team * 16384);
    for (int it = BIDX; it < T / 2; it += GDIM) {
        const int tok = it * 2 + team;
        float4 x[4], acc[4];
#pragma unroll
        for (int j = 0; j < 4; ++j) { const float rs = rsqrtf(sum16(ss2 + (size_t)tok * 16) * (1.f / D) + EPS); const float4 hv = *(const float4*)(h + (size_t)tok * D + j * 256 + lane * 4); const float4 gv = *(const float4*)(g2 + j * 256 + lane * 4);
            x[j] = make_float4(hv.x * rs * gv.x, hv.y * rs * gv.y, hv.z * rs * gv.z, hv.w * rs * gv.w); acc[j] = make_float4(0.f, 0.f, 0.f, 0.f); }
        for (int k = 0; k < 32; ++k) {
            const int pr = wave * 32 + k; const int e = idx[(size_t)tok * 128 + pr]; const float gt = gate[(size_t)tok * 128 + pr];
            const float* ur = ut + (size_t)e * D; const float* vr = vt + (size_t)e * D;
            float s = 0.f;
#pragma unroll
            for (int j = 0; j < 4; ++j) { const float4 uv = *(const float4*)(ur + j * 256 + lane * 4); s += uv.x * x[j].x + uv.y * x[j].y + uv.z * x[j].z + uv.w * x[j].w; }
            s = wave_sum(s);
            const float cf = gelu_tanh(s) * gt;
#pragma unroll
            for (int j = 0; j < 4; ++j) { const float4 vv = *(const float4*)(vr + j * 256 + lane * 4); acc[j].x += cf * vv.x; acc[j].y += cf * vv.y; acc[j].z += cf * vv.z; acc[j].w += cf * vv.w; }
        }
#pragma unroll
        for (int j = 0; j < 4; ++j) *(float4*)&red[wave][j * 256 + lane * 4] = acc[j];
        __syncthreads();
        for (int c = tid; c < D; c += 256) h[(size_t)tok * D + c] += red[0][c] + red[1][c] + red[2][c] + red[3][c];
        __syncthreads();
    }
}
}
namespace nv {
__device__ __forceinline__ float sum8(const float* p);
__device__ __forceinline__ float sum16(const float* p);
#define XB_TMO      128
#define XB_XCNT(j)  (256  + 64 * (j))
#define XB_XSUB(j)  (1280 + 64 * (j))
#define XB_XGEN(j)  (2304 + 64 * (j))
#define XB_TOP      3328
#define XB_TOPGEN   3392
#define XCD_BAR_WORDS 3456
#define XB_SPIN_CAP (1u << 24)
__device__ __forceinline__ unsigned xb_ld(unsigned* p)              { return __hip_atomic_load(p, __ATOMIC_RELAXED, __HIP_MEMORY_SCOPE_AGENT); }
__device__ __forceinline__ unsigned xb_add(unsigned* p, unsigned v) { return __hip_atomic_fetch_add(p, v, __ATOMIC_RELAXED, __HIP_MEMORY_SCOPE_AGENT); }
__device__ __forceinline__ unsigned xb_xcc_id() { return (unsigned)__builtin_amdgcn_s_getreg((3 << 11) | 20) & 0xFu; }
#define XB_SPIN(cond, bar) do { unsigned _sp = 0; while (cond) { __builtin_amdgcn_s_sleep(1); \
    if ((++_sp & 255u) == 0u) { if (xb_ld(&(bar)[XB_TMO])) break; if (_sp > XB_SPIN_CAP) { atomicAdd(&(bar)[XB_TMO], 1u); break; } } } } while (0)
struct XcdBarrier { unsigned* bar; unsigned x; volatile LAS unsigned* st; };
__device__ __forceinline__ XcdBarrier xcd_barrier_post(unsigned* bar, volatile LAS unsigned* st) {
    XcdBarrier b; b.bar = bar; b.x = xb_xcc_id(); b.st = st;
    if (threadIdx.x == 0) (void)xb_add(&bar[XB_XCNT(b.x)], 1u);
    return b;
}
__device__ __forceinline__ void xcd_barrier_complete(unsigned* bar, unsigned x, unsigned& nloc, unsigned& nx) {
    const unsigned Gsz = gridDim.x * gridDim.y * gridDim.z;
    unsigned sum, cnt, mine, sp = 0u;
    for (;;) {
        sum = 0u; cnt = 0u; mine = 0u;
#pragma unroll
        for (unsigned j = 0; j < 16; ++j) { const unsigned c = xb_ld(&bar[XB_XCNT(j)]); sum += c; cnt += (c > 0u) ? 1u : 0u; mine = (j == x) ? c : mine; }
        if (sum == Gsz) break;
        __builtin_amdgcn_s_sleep(1);
        if ((++sp & 255u) == 0u) { if (xb_ld(&bar[XB_TMO])) break; if (sp > XB_SPIN_CAP) { atomicAdd(&bar[XB_TMO], 1u); break; } }
    }
    nloc = mine > 0u ? mine : 1u; nx = cnt > 0u ? cnt : 1u;
}
__device__ __forceinline__ void xcd_barrier(const XcdBarrier& b) {
    asm volatile("s_waitcnt vmcnt(0)" ::: "memory");
    __syncthreads();
    if (threadIdx.x == 0) {
        unsigned* bar = b.bar;
        __builtin_amdgcn_s_waitcnt(0);
        unsigned nloc = b.st[0], nx = b.st[1];
        if (nloc == 0u) { xcd_barrier_complete(bar, b.x, nloc, nx); b.st[0] = nloc; b.st[1] = nx; }
        const unsigned old = xb_add(&bar[XB_XSUB(b.x)], 1u);
        const unsigned gen = old / nloc;
        if (old + 1u == (gen + 1u) * nloc) {
            __builtin_amdgcn_fence(__ATOMIC_RELEASE, "agent");
            asm volatile("s_waitcnt vmcnt(0)" ::: "memory");
            const unsigned og = xb_add(&bar[XB_TOP], 1u);
            const unsigned tg = og / nx;
            if (og + 1u == (tg + 1u) * nx) xb_add(&bar[XB_TOPGEN], 1u);
            else XB_SPIN(xb_ld(&bar[XB_TOPGEN]) == tg, bar);
            __builtin_amdgcn_fence(__ATOMIC_ACQUIRE, "agent");
            xb_add(&bar[XB_XGEN(b.x)], 1u);
            asm volatile("s_waitcnt vmcnt(0)" ::: "memory");
        } else {
            XB_SPIN(xb_ld(&bar[XB_XGEN(b.x)]) == gen, bar);
            __builtin_amdgcn_fence(__ATOMIC_ACQUIRE, "agent");
            asm volatile("s_waitcnt vmcnt(0)" ::: "memory");
        }
    }
    __syncthreads();
}

#define LDS_WAIT() asm volatile("s_waitcnt lgkmcnt(0)" ::: "memory")
template <class Sc>
__device__ __forceinline__ void p0_transpose_item(const float* __restrict__ W, int ldw, int K, int Ncols, Sc sc, bf16_t* __restrict__ WT, LAS float* scr, int item, int lane) {
    const int nblk = Ncols / 32, kb = item / nblk, nb = item % nblk, k0 = 64 * kb, n0 = 32 * nb;
#pragma unroll 8
    for (int i = 0; i < 32; ++i) { const int kk = 2 * i + (lane >> 5); scr[kk * 33 + (lane & 31)] = W[(size_t)(k0 + kk) * ldw + n0 + (lane & 31)] * sc(k0 + kk); }
    LDS_WAIT(); asm volatile("" ::: "memory");
    const int c = lane & 7;
#pragma unroll
    for (int j = 0; j < 4; ++j) { const int n = (lane >> 3) + 8 * j; const LAS float* s = scr + (8 * c) * 33 + n;
        u32x4 o; o.x = pk2(s[0 * 33], s[1 * 33]); o.y = pk2(s[2 * 33], s[3 * 33]); o.z = pk2(s[4 * 33], s[5 * 33]); o.w = pk2(s[6 * 33], s[7 * 33]);
        *(u32x4*)(WT + (size_t)(n0 + n) * K + k0 + 8 * c) = o; }
    LDS_WAIT(); asm volatile("" ::: "memory");
}
struct ScVec { const float* g; __device__ __forceinline__ float operator()(int k) const { return g[k]; } };
struct ScOne { __device__ __forceinline__ float operator()(int) const { return 1.f; } };
struct ScTwo { const float* g0; const float* g1; __device__ __forceinline__ float operator()(int k) const { return k < 512 ? g0[k] : g1[k - 512]; } };

constexpr int TAB_OFF = 131072 + 1024;
__device__ __forceinline__ void* ldarg(LAS unsigned char* lds, int i) {
    unsigned off = TAB_OFF + 8 * i; asm volatile("" : "+s"(off));
    const unsigned long long v = *(volatile LAS unsigned long long*)(lds + off);
    const unsigned lo = __builtin_amdgcn_readfirstlane((unsigned)v), hi = __builtin_amdgcn_readfirstlane((unsigned)(v >> 32));
    return (void*)(((unsigned long long)hi << 32) | lo);
}

__device__ __forceinline__ void p0_prologue(LAS unsigned char* lds) {
    PH_IDS
    const int lane = TIDX & 63, wave = TIDX >> 6, gw = BIDX * 8 + wave, ngw = GDIM * 8;
    LAS float* scr = (LAS float*)(lds + wave * 16384);
    unsigned char* ws = (unsigned char*)ldarg(lds, 24);
    const float* a0 = (const float*)ldarg(lds, 0); const float* a1 = (const float*)ldarg(lds, 1); const float* a2 = (const float*)ldarg(lds, 2); const float* a11 = (const float*)ldarg(lds, 11);
    const float* a14 = (const float*)ldarg(lds, 14); const float* a15 = (const float*)ldarg(lds, 15); const float* a16 = (const float*)ldarg(lds, 16); const float* a17 = (const float*)ldarg(lds, 17); const float* a18 = (const float*)ldarg(lds, 18);
    constexpr int I1 = (D / 64) * (2048 / 32), I2 = (SSMW / 64) * (SSMW / 32), I3 = (D / 64) * (D / 32), I4 = I3, IL = I1 + I2 + I3 + I4;
    for (int it = gw; it < DEPTH * IL; it += ngw) {
        const int l = it / IL; int r = it % IL;
        if (r < I1) { p0_transpose_item(a2 + (size_t)l * D * INW, INW, D, 2048, ScVec{a1 + l * D}, (bf16_t*)(ws + WS_BT1) + (size_t)l * 2048 * D, scr, r, lane); continue; } r -= I1;
        if (r < I2) { p0_transpose_item(a11 + (size_t)l * SSMW * SSMW, SSMW, SSMW, SSMW, ScOne{}, (bf16_t*)(ws + WS_BT2) + (size_t)l * SSMW * SSMW, scr, r, lane); continue; } r -= I2;
        if (r < I3) { p0_transpose_item(a16 + (size_t)l * D * D, D, D, D, ScTwo{a14 + l * SSMW, a15 + l * ATTW}, (bf16_t*)(ws + WS_BT3) + (size_t)l * D * D, scr, r, lane); continue; } r -= I3;
        p0_transpose_item(a18 + (size_t)l * D * D, D, D, D, ScVec{a17 + l * D}, (bf16_t*)(ws + WS_BT4) + (size_t)l * D * D, scr, r, lane);
    }
    for (int i = BIDX * 512 + TIDX; i < DEPTH * 16 * D; i += GDIM * 512) {
        const int l = i / (16 * D), j = (i / D) % 16, k = i % D;
        const float v = j < 8 ? a2[((size_t)l * D + k) * INW + 2048 + j] * a1[l * D + k] : 0.f;
        ((bf16_t*)(ws + WS_WF))[i] = f2bf(v);
    }
    {
        const float* x = a0; bf16_t* hb = (bf16_t*)(ws + WS_HB); float* ssp1 = (float*)(ws + WS_SSP) + (size_t)T * 32;
        for (int w = gw; w < T; w += ngw) {
            const f32x4* r = (const f32x4*)(x + (size_t)w * D) + lane; unsigned long long* o = (unsigned long long*)(hb + (size_t)w * D) + lane;
            float s = 0.f;
#pragma unroll
            for (int j = 0; j < 4; ++j) { const f32x4 v = r[64 * j]; const unsigned w0 = pk2(v.x, v.y), w1 = pk2(v.z, v.w); o[64 * j] = (unsigned long long)w0 | ((unsigned long long)w1 << 32);
                const float a = __uint_as_float(w0 << 16), b = __uint_as_float(w0 & 0xffff0000u), c = __uint_as_float(w1 << 16), d = __uint_as_float(w1 & 0xffff0000u); s += (a * a + b * b) + (c * c + d * d); }
            s = wave_sum(s);
            if (lane < 8) ssp1[(size_t)w * 8 + lane] = lane == 0 ? s : 0.f;
        }
    }
}

struct SchedGen {
    static constexpr bool DUALB = false; long hB1;
    __device__ __forceinline__ bool sb(const ge::Unit&, int) const { return false; }
    __device__ __forceinline__ unsigned voffB1(int, int) const { return 0u; }
    const char* A; const char* B; int a_row_b, a_c16_b, b_row_b, b_c16_b; long a_pm_b, a_kt_b, b_pn_b, b_kt_b; int nM, nN, nt, G, c; long hA, hB;
    __device__ __forceinline__ void init_plain(const void* A_, int lda_bytes, const void* B_, int ldb_bytes, int M, int N, int K, int G_, int c_) {
        A = (const char*)A_; B = (const char*)B_; a_row_b = lda_bytes; a_c16_b = 32; b_row_b = ldb_bytes; b_c16_b = 32; a_pm_b = 256l * lda_bytes; a_kt_b = 128; b_pn_b = 256l * ldb_bytes; b_kt_b = 128;
        nM = M / 256; nN = N / 256; nt = K / 64; G = G_; c = c_; hA = 128l * lda_bytes; hB = 128l * ldb_bytes; }
    __device__ __forceinline__ bool next(int i, ge::Unit& u) const {
        int pm, pn; if (!ge::static_tile(i, G, c, nM, nN, pm, pn)) return false;
        u.A0 = A + (size_t)pm * a_pm_b; u.B0 = B + (size_t)pn * b_pn_b; u.nt = nt; u.pm = pm; u.pn = pn; u.aux = 0; return true; }
    __device__ __forceinline__ const char* ta(const ge::Unit& u, int t) const { return u.A0 + t * a_kt_b; }
    __device__ __forceinline__ const char* tb(const ge::Unit& u, int t) const { return u.B0 + t * b_kt_b; }
    __device__ __forceinline__ unsigned voffA(int R, int C) const { return (unsigned)(R * a_row_b + (C >> 4) * a_c16_b + (C & 15) * 2); }
    __device__ __forceinline__ unsigned voffB(int Rb, int C) const { return (unsigned)(Rb * b_row_b + (C >> 4) * b_c16_b + (C & 15) * 2); }
};
typedef SchedGen SchedPlain;

constexpr float QSCALE = 0.125f * 1.4426950408889634f;
struct EpiInProj {
    static constexpr bool PERM = true, MIDK = false, UBEGIN = true;
    const float* ssp1; bf16_t* UP; bf16_t* QKV;
    __device__ __forceinline__ void unit_begin(const ge::Unit& u, int tid, LAS unsigned char* rowf) const {
        if (tid < 256) { const int row = u.pm * 256 + tid; ((LAS float*)rowf)[tid] = rsqrtf(sum8(ssp1 + (size_t)row * 8) * (1.f / D) + EPS); }
    }
    __device__ __forceinline__ void midk(ge::f32x4 (&)[2][2][4][2], const ge::Unit&, int, int, LAS unsigned char*) const {}
    __device__ __forceinline__ void operator()(const ge::f32x4 (&acc)[2][2][4][2], const ge::Unit& u, int wr, int wc, int fr, int fq, LAS unsigned char* rowf) const {
        const int row0 = u.pm * 256 + wr * 64 + fr, colt = u.pn * 256, region = colt >> 9;
        bf16_t* dstb = QKV + (size_t)(region - 1) * ((WS_K - WS_Q) / 2);
#pragma unroll
        for (int ai = 0; ai < 2; ++ai)
#pragma unroll
            for (int m = 0; m < 4; ++m) {
                const int row = row0 + ai * 128 + m * 16; const float rs = ((const LAS float*)rowf)[ai * 128 + wr * 64 + m * 16 + fr];
#pragma unroll
                for (int bj = 0; bj < 2; ++bj) {
                    const int c = (colt & 511) + bj * 128 + wc * 32 + 8 * fq;
                    const float rq = region == 1 ? rs * QSCALE : rs;
                    const ge::f32x4 v0 = acc[ai][bj][m][0] * rq, v1 = acc[ai][bj][m][1] * rq;
                    u32x4 w; w.x = ge::cvt_pk_bf16(v0[0], v0[1]); w.y = ge::cvt_pk_bf16(v0[2], v0[3]); w.z = ge::cvt_pk_bf16(v1[0], v1[1]); w.w = ge::cvt_pk_bf16(v1[2], v1[3]);
                    bf16_t* dst = region == 0 ? UP + up_index(row, c) : dstb + (size_t)row * 512 + c;
                    *(u32x4*)dst = w;
                }
            }
    }
};

__device__ __forceinline__ float sum8(const float* p) { const ge::f32x4 a = *(const ge::f32x4*)p, b = *(const ge::f32x4*)(p + 4); return ((a[0] + a[1]) + (a[2] + a[3])) + ((b[0] + b[1]) + (b[2] + b[3])); }
__device__ __forceinline__ float sum16(const float* p) { return sum8(p) + sum8(p + 8); }
__device__ __forceinline__ size_t gel_index(int row, int c) { return ((size_t)(c >> 4) * T + row) * HC + (c & 15); }
__device__ __forceinline__ float sigmoidf_(float x) { return 1.f / (1.f + __expf(-x)); }
struct EpiGlu2 {
    static constexpr bool PERM = true, MIDK = false, UBEGIN = false;
    const bf16_t* GEL; const float* bias; bf16_t* MIX; float* ssp;
    __device__ __forceinline__ void unit_begin(const ge::Unit&, int, LAS unsigned char*) const {}
    __device__ __forceinline__ void midk(ge::f32x4 (&)[2][2][4][2], const ge::Unit&, int, int, LAS unsigned char*) const {}
    __device__ __forceinline__ void operator()(const ge::f32x4 (&acc)[2][2][4][2], const ge::Unit& u, int wr, int wc, int fr, int fq, LAS unsigned char*) const {
        const int row0 = u.pm * 256 + wr * 64 + fr, colt = u.pn * 256;
#pragma unroll
        for (int ai = 0; ai < 2; ++ai)
#pragma unroll
            for (int m = 0; m < 4; ++m) {
                const int row = row0 + ai * 128 + m * 16; float sq = 0.f;
#pragma unroll
                for (int bj = 0; bj < 2; ++bj) {
                    const int c = colt + bj * 128 + wc * 32 + 8 * fq;
                    const ge::f32x4 b0 = *(const ge::f32x4*)(bias + c), b1 = *(const ge::f32x4*)(bias + c + 4);
                    const u32x4 gw = *(const u32x4*)(GEL + gel_index(row, c));
                    const ge::f32x4 v0 = acc[ai][bj][m][0] + b0, v1 = acc[ai][bj][m][1] + b1;
                    float o[8];
                    o[0] = __uint_as_float(gw.x << 16) * sigmoidf_(v0[0]); o[1] = __uint_as_float(gw.x & 0xffff0000u) * sigmoidf_(v0[1]);
                    o[2] = __uint_as_float(gw.y << 16) * sigmoidf_(v0[2]); o[3] = __uint_as_float(gw.y & 0xffff0000u) * sigmoidf_(v0[3]);
                    o[4] = __uint_as_float(gw.z << 16) * sigmoidf_(v1[0]); o[5] = __uint_as_float(gw.z & 0xffff0000u) * sigmoidf_(v1[1]);
                    o[6] = __uint_as_float(gw.w << 16) * sigmoidf_(v1[2]); o[7] = __uint_as_float(gw.w & 0xffff0000u) * sigmoidf_(v1[3]);
#pragma unroll
                    for (int e = 0; e < 8; ++e) sq += o[e] * o[e];
                    u32x4 w; w.x = ge::cvt_pk_bf16(o[0], o[1]); w.y = ge::cvt_pk_bf16(o[2], o[3]); w.z = ge::cvt_pk_bf16(o[4], o[5]); w.w = ge::cvt_pk_bf16(o[6], o[7]);
                    *(u32x4*)(MIX + (size_t)row * D + c) = w;
                }
                sq += __shfl_xor(sq, 16); sq += __shfl_xor(sq, 32);
                if (fq == 0) ssp[(size_t)row * 8 + u.pn * 4 + wc] = sq;
            }
    }
};
struct EpiWo {
    static constexpr bool PERM = true, MIDK = true, UBEGIN = true;
    const float* ssp_s; const float* ssp_a; const bf16_t* hin; bf16_t* hb; float* ssp2;
    typedef float f32x2_ __attribute__((ext_vector_type(2)));
    __device__ __forceinline__ void unit_begin(const ge::Unit& u, int tid, LAS unsigned char* rowf) const {
        if (tid < 256) { const int row = u.pm * 256 + tid;
            const float rs_s = rsqrtf(sum8(ssp_s + (size_t)row * 8) * (1.f / SSMW) + EPS), rs_a = rsqrtf(sum8(ssp_a + (size_t)row * 8) * (1.f / ATTW) + EPS);
            ((LAS f32x2_*)rowf)[tid] = (f32x2_){rs_s / rs_a, rs_a}; }
    }
    __device__ __forceinline__ void midk(ge::f32x4 (&acc)[2][2][4][2], const ge::Unit& u, int wr, int fr, LAS unsigned char* rowf) const {
#pragma unroll
        for (int ai = 0; ai < 2; ++ai)
#pragma unroll
            for (int m = 0; m < 4; ++m) {
                const float f = ((const LAS f32x2_*)rowf)[ai * 128 + wr * 64 + m * 16 + fr].x;
#pragma unroll
                for (int bj = 0; bj < 2; ++bj)
#pragma unroll
                    for (int n = 0; n < 2; ++n) acc[ai][bj][m][n] = acc[ai][bj][m][n] * f;
            }
    }
    __device__ __forceinline__ void operator()(const ge::f32x4 (&acc)[2][2][4][2], const ge::Unit& u, int wr, int wc, int fr, int fq, LAS unsigned char* rowf) const {
        const int row0 = u.pm * 256 + wr * 64 + fr, colt = u.pn * 256;
#pragma unroll
        for (int ai = 0; ai < 2; ++ai)
#pragma unroll
            for (int m = 0; m < 4; ++m) {
                const int row = row0 + ai * 128 + m * 16; const float ra = ((const LAS f32x2_*)rowf)[ai * 128 + wr * 64 + m * 16 + fr].y; float sq = 0.f;
#pragma unroll
                for (int bj = 0; bj < 2; ++bj) {
                    const int c = colt + bj * 128 + wc * 32 + 8 * fq;
                    const size_t o = (size_t)row * D + c;
                    const u32x4 hw = *(const u32x4*)(hin + o);
                    const ge::f32x4 a0 = acc[ai][bj][m][0] * ra, a1 = acc[ai][bj][m][1] * ra;
                    u32x4 w; w.x = ge::cvt_pk_bf16(__uint_as_float(hw.x << 16) + a0[0], __uint_as_float(hw.x & 0xffff0000u) + a0[1]); w.y = ge::cvt_pk_bf16(__uint_as_float(hw.y << 16) + a0[2], __uint_as_float(hw.y & 0xffff0000u) + a0[3]);
                    w.z = ge::cvt_pk_bf16(__uint_as_float(hw.z << 16) + a1[0], __uint_as_float(hw.z & 0xffff0000u) + a1[1]); w.w = ge::cvt_pk_bf16(__uint_as_float(hw.w << 16) + a1[2], __uint_as_float(hw.w & 0xffff0000u) + a1[3]);
                    *(u32x4*)(hb + o) = w;
#pragma unroll
                    for (int e = 0; e < 4; ++e) { const float lo = __uint_as_float(w[e] << 16), hi = __uint_as_float(w[e] & 0xffff0000u); sq += lo * lo + hi * hi; }
                }
                sq += __shfl_xor(sq, 16); sq += __shfl_xor(sq, 32);
                if (fq == 0) ssp2[(size_t)row * 16 + u.pn * 4 + wc] = sq;
            }
    }
};
struct EpiWq {
    static constexpr bool PERM = true, MIDK = false, UBEGIN = true;
    const float* ssp2; bf16_t* QP;
    __device__ __forceinline__ void unit_begin(const ge::Unit& u, int tid, LAS unsigned char* rowf) const {
        if (tid < 256) { const int row = u.pm * 256 + tid; ((LAS float*)rowf)[tid] = rsqrtf(sum16(ssp2 + (size_t)row * 16) * (1.f / D) + EPS); }
    }
    __device__ __forceinline__ void midk(ge::f32x4 (&)[2][2][4][2], const ge::Unit&, int, int, LAS unsigned char*) const {}
    __device__ __forceinline__ void operator()(const ge::f32x4 (&acc)[2][2][4][2], const ge::Unit& u, int wr, int wc, int fr, int fq, LAS unsigned char* rowf) const {
        const int row0 = u.pm * 256 + wr * 64 + fr, colt = u.pn * 256;
#pragma unroll
        for (int ai = 0; ai < 2; ++ai)
#pragma unroll
            for (int m = 0; m < 4; ++m) {
                const int row = row0 + ai * 128 + m * 16; const float rs = ((const LAS float*)rowf)[ai * 128 + wr * 64 + m * 16 + fr];
#pragma unroll
                for (int bj = 0; bj < 2; ++bj) {
                    const int c = colt + bj * 128 + wc * 32 + 8 * fq;
                    const ge::f32x4 v0 = acc[ai][bj][m][0] * rs, v1 = acc[ai][bj][m][1] * rs;
                    u32x4 w; w.x = ge::cvt_pk_bf16(v0[0], v0[1]); w.y = ge::cvt_pk_bf16(v0[2], v0[3]); w.z = ge::cvt_pk_bf16(v1[0], v1[1]); w.w = ge::cvt_pk_bf16(v1[2], v1[3]);
                    *(u32x4*)(QP + (size_t)row * D + c) = w;
                }
            }
    }
};

__device__ __forceinline__ void ph_flogit(const bf16_t* __restrict__ hb, const bf16_t* __restrict__ wf, const float* __restrict__ ss, const float* __restrict__ bfv, float* __restrict__ logf) {
    PH_IDS
    const int lane = TIDX & 63, gw = BIDX * 8 + (TIDX >> 6), ngw = GDIM * 8, r16 = lane & 15, q4 = lane >> 4;
    for (int item = gw; item < T / 16; item += ngw) {
        const int tok0 = item * 16;
        ge::f32x4 acc = {0.f, 0.f, 0.f, 0.f};
        const bf16_t* ar = hb + (size_t)(tok0 + r16) * D + q4 * 8; const bf16_t* br = wf + (size_t)r16 * D + q4 * 8;
#pragma unroll 8
        for (int ks = 0; ks < D / 32; ++ks) {
            const bf16x8 a = *(const bf16x8*)(ar + ks * 32), b = *(const bf16x8*)(br + ks * 32);
            acc = __builtin_amdgcn_mfma_f32_16x16x32_bf16(a, b, acc, 0, 0, 0);
        }
        if (r16 < NH) {
            const float bj = bfv[r16];
#pragma unroll
            for (int r = 0; r < 4; ++r) {
                const int tok = tok0 + 4 * q4 + r; const float x = acc[r] * rsqrtf(sum8(ss + (size_t)tok * 8) * (1.f / D) + EPS) + bj;
                logf[(size_t)tok * NH + r16] = fminf(x, 0.f) - log1pf(expf(-fabsf(x)));
            }
        }
    }
}
}
namespace nv {
__device__ __forceinline__ float gelu_fast(float x);
constexpr float USCALE = 256.f, VSCALE = 16.f;
typedef float f32x2 __attribute__((ext_vector_type(2)));
typedef int i32x2 __attribute__((ext_vector_type(2)));
__device__ __forceinline__ float clamp448(float x) { return fminf(fmaxf(x, -448.f), 448.f); }
__device__ __forceinline__ unsigned pack4_fp8(float a, float b, float c, float d) {
    int w = 0; w = __builtin_amdgcn_cvt_pk_fp8_f32(clamp448(a), clamp448(b), w, false); w = __builtin_amdgcn_cvt_pk_fp8_f32(clamp448(c), clamp448(d), w, true); return (unsigned)w; }

__device__ __forceinline__ void peer_split(LAS unsigned char* lds, int bid, int grid, int wave, int& slice, int& gw, int& ngw) {
    volatile LAS unsigned* M = (volatile LAS unsigned*)(lds + 131072 + 320);
    const unsigned x = __builtin_amdgcn_readfirstlane(M[16]), rk = __builtin_amdgcn_readfirstlane(M[17]), nl = __builtin_amdgcn_readfirstlane(M[18]), ok = __builtin_amdgcn_readfirstlane(M[19]);
    if (ok) { slice = (int)x; gw = (int)rk * 8 + wave; ngw = (int)nl * 8; }
    else { slice = bid & 7; gw = (bid >> 3) * 8 + wave; ngw = (grid >> 3) * 8; }
}
__device__ __forceinline__ void p0_peer_tables(const float* __restrict__ pu, const float* __restrict__ pv, const float* __restrict__ g2, unsigned char* __restrict__ PU8, unsigned char* __restrict__ PV8) {
    PH_IDS
    const size_t n16 = (size_t)DEPTH * NEXP * D / 16;
    for (size_t i = (size_t)BIDX * 512 + TIDX; i < 2 * n16; i += (size_t)GDIM * 512) {
        const bool isv = i >= n16; const size_t j = isv ? i - n16 : i; const size_t e0 = j * 16;
        const float* src = (isv ? pv : pu) + e0;
        const int l = (int)(e0 / ((size_t)NEXP * D)), c = (int)(e0 % D);
        f32x4 x[4];
#pragma unroll
        for (int k = 0; k < 4; ++k) x[k] = *(const f32x4*)(src + 4 * k);
        u32x4 o;
        if (isv) {
#pragma unroll
            for (int k = 0; k < 4; ++k) o[k] = pack4_fp8(x[k].x * VSCALE, x[k].y * VSCALE, x[k].z * VSCALE, x[k].w * VSCALE);
        } else {
#pragma unroll
            for (int k = 0; k < 4; ++k) { const f32x4 g = *(const f32x4*)(g2 + l * D + c + 4 * k) * USCALE; o[k] = pack4_fp8(x[k].x * g.x, x[k].y * g.y, x[k].z * g.z, x[k].w * g.w); }
        }
        const size_t er = (e0 / D) % NEXP;
        *(u32x4*)((isv ? PV8 : PU8) + (((size_t)l * 8 + (c >> 7)) * NEXP + er) * 128 + (c & 127)) = o;
    }
}

constexpr int PB = 16;
#define DPPF(x, CTRL) __int_as_float(__builtin_amdgcn_update_dpp(0, __float_as_int(x), (CTRL), 0xF, 0xF, true))
template <int MODE = 0>
__device__ __forceinline__ void ph_peer_u(LAS unsigned char* lds, const unsigned char* __restrict__ PU8, const bf16_t* __restrict__ hb, const int* __restrict__ idx, float* __restrict__ partial, int imask = 0x7fffffff) {
    PH_IDS
    const int lane = TIDX & 63, wave = TIDX >> 6, c8 = lane & 7, rg = lane >> 3;
    int slice, gw, ngw; peer_split(lds, BIDX, GDIM, wave, slice, gw, ngw);
    const unsigned char* tab = PU8 + (size_t)slice * NEXP * 128; const unsigned lo16 = 16u * c8;
    LAS int* li = (LAS int*)(lds + wave * 12288);
    LAS u32x4* lh = (LAS u32x4*)(lds + wave * 12288 + 8192);
    const int ntok = gw < T ? (T - gw + ngw - 1) / ngw : 0;
    const int p0 = 2 * lane, sd0 = (p0 >> 6) * 64 + (p0 & 7) * 8 + ((p0 & 63) >> 3), sd1 = sd0 + 8;
    const bool b2 = (c8 & 4) != 0, b1 = (c8 & 2) != 0, b0 = (c8 & 1) != 0;
    const int i0 = 8 * (int)b2 + 4 * (int)b0 + 2 * (int)b1;
    for (int tb = 0; tb < ntok; tb += PB) {
        const int nb = min(PB, ntok - tb);
        for (int k = 0; k < nb; ++k) {
            const size_t t = (size_t)gw + (size_t)(tb + k) * ngw;
            i32x2 v = *(const i32x2*)(idx + t * 128 + 2 * lane); v.x &= imask; v.y &= imask; li[k * 128 + sd0] = v.x; li[k * 128 + sd1] = v.y;
            if (lane < 16) lh[k * 16 + lane] = *(const u32x4*)(hb + t * D + 128 * slice + 8 * lane);
        }
        asm volatile("s_waitcnt vmcnt(0) lgkmcnt(0)" ::: "memory");
        const int nstep = 4 * nb;
        u32x4 rb[4][4]; float pv[16], hx[16];
#define PU_ISSUE(s, B) do { const ge::u32x4 ia_ = *(const LAS ge::u32x4*)(li + ((s) >> 1) * 64 + rg * 8 + 4 * ((s) & 1)); \
            _Pragma("unroll") for (int i_ = 0; i_ < 4; ++i_) rb[B][i_] = *(const u32x4*)(tab + (ia_[i_] * 128u + lo16)); } while (0)
#define PU_STEP(s, B, QT) do { if ((s) < nstep) { if ((s) + 3 < nstep) PU_ISSUE((s) + 3, ((B) + 3) & 3); \
            const int k_ = (s) >> 2; const size_t t_ = (size_t)gw + (size_t)(tb + k_) * ngw; \
            if (QT == 0) { const u32x4 w0 = lh[k_ * 16 + 2 * c8], w1 = lh[k_ * 16 + 2 * c8 + 1];          \
                _Pragma("unroll") for (int j = 0; j < 4; ++j) { hx[2 * j] = __uint_as_float(w0[j] << 16); hx[2 * j + 1] = __uint_as_float(w0[j] & 0xffff0000u); hx[8 + 2 * j] = __uint_as_float(w1[j] << 16); hx[9 + 2 * j] = __uint_as_float(w1[j] & 0xffff0000u); } } \
            _Pragma("unroll") for (int i = 0; i < 4; ++i) { float d0 = 0.f, d1 = 0.f; _Pragma("unroll") for (int k = 0; k < 4; ++k) { \
                const f32x2 q0 = __builtin_amdgcn_cvt_pk_f32_fp8((int)rb[B][i][k], false), q1 = __builtin_amdgcn_cvt_pk_f32_fp8((int)rb[B][i][k], true); \
                d0 += q0.x * hx[4 * k] + q1.x * hx[4 * k + 2]; d1 += q0.y * hx[4 * k + 1] + q1.y * hx[4 * k + 3]; } pv[4 * QT + i] = d0 + d1; } \
            if (QT == 3) { float y[8], z[4]; \
                _Pragma("unroll") for (int j = 0; j < 8; ++j) { const float keep = b2 ? pv[8 + j] : pv[j], send = b2 ? pv[j] : pv[8 + j]; y[j] = keep + DPPF(send, 0x141); }       \
                _Pragma("unroll") for (int j = 0; j < 4; ++j) { const float keep = b0 ? y[4 + j] : y[j], send = b0 ? y[j] : y[4 + j]; z[j] = keep + DPPF(send, 0xB1); }          \
                const float o0 = (b1 ? z[2] : z[0]) + DPPF(b1 ? z[0] : z[2], 0x4E), o1 = (b1 ? z[3] : z[1]) + DPPF(b1 ? z[1] : z[3], 0x4E);                                    \
                float* dst = partial + ((size_t)slice * T + t_) * 128 + 8 * i0 + rg; dst[0] = o0; dst[8] = o1; } } } while (0)
        PU_ISSUE(0, 0); PU_ISSUE(1, 1); PU_ISSUE(2, 2);
        for (int s0 = 0; s0 < nstep; s0 += 4) { PU_STEP(s0, 0, 0); PU_STEP(s0 + 1, 1, 1); PU_STEP(s0 + 2, 2, 2); PU_STEP(s0 + 3, 3, 3); }
#undef PU_ISSUE
#undef PU_STEP
        asm volatile("s_waitcnt lgkmcnt(0)" ::: "memory");
    }
}

__device__ __forceinline__ void ph_peer_coef(const float* __restrict__ partial, const float* __restrict__ ssp2, const float* __restrict__ gate, float* __restrict__ coef) {
    PH_IDS
    const size_t n4 = (size_t)T * 128 / 4, stride = (size_t)GDIM * 512;
    for (size_t i0 = (size_t)BIDX * 512 + TIDX; i0 < n4; i0 += 2 * stride) {
        f32x4 pv[2][8], gv[2]; float rs[2];
#pragma unroll
        for (int u = 0; u < 2; ++u) { const size_t i = i0 + u * stride;
            if (i < n4) {
#pragma unroll
                for (int k = 0; k < 8; ++k) pv[u][k] = *(const f32x4*)(partial + (size_t)k * T * 128 + 4 * i);
                gv[u] = *(const f32x4*)(gate + 4 * i); rs[u] = sum16(ssp2 + (i >> 5) * 16);
            } }
#pragma unroll
        for (int u = 0; u < 2; ++u) { const size_t i = i0 + u * stride;
            if (i < n4) {
                f32x4 s = ((pv[u][0] + pv[u][1]) + (pv[u][2] + pv[u][3])) + ((pv[u][4] + pv[u][5]) + (pv[u][6] + pv[u][7]));
                const float sc = rsqrtf(rs[u] * (1.f / D) + EPS) * (1.f / USCALE);
                f32x4 o; o.x = gelu_fast(s.x * sc) * gv[u].x; o.y = gelu_fast(s.y * sc) * gv[u].y; o.z = gelu_fast(s.z * sc) * gv[u].z; o.w = gelu_fast(s.w * sc) * gv[u].w;
                *(f32x4*)(coef + 4 * i) = o;
            } }
    }
}

__device__ __forceinline__ float dpp_ror8(float x) { return __int_as_float(__builtin_amdgcn_update_dpp(0, __float_as_int(x), 0x128, 0xF, 0xF, true)); }
template <int MODE = 0>
__device__ __forceinline__ void ph_peer_v(LAS unsigned char* lds, const unsigned char* __restrict__ PV8, const int* __restrict__ idx, const float* __restrict__ coef, const bf16_t* hin, bf16_t* hb, float* __restrict__ ssp1, int imask = 0x7fffffff) {
    PH_IDS
    const int lane = TIDX & 63, wave = TIDX >> 6, c8 = lane & 7, rg = lane >> 3;
    int slice, gw, ngw; peer_split(lds, BIDX, GDIM, wave, slice, gw, ngw);
    const unsigned char* tab = PV8 + (size_t)slice * NEXP * 128; const unsigned lo16 = 16u * c8;
    LAS int* li = (LAS int*)(lds + wave * 16384);
    LAS float* lc = (LAS float*)(lds + wave * 16384 + 8192);
    const int ntok = gw < T ? (T - gw + ngw - 1) / ngw : 0;
    const int p0 = 2 * lane, sd0 = (p0 >> 6) * 64 + (p0 & 7) * 8 + ((p0 & 63) >> 3), sd1 = sd0 + 8;
    const int colo = 128 * slice + 16 * c8 + 2 * rg;
    for (int tb = 0; tb < ntok; tb += PB) {
        const int nb = min(PB, ntok - tb);
        for (int k = 0; k < nb; ++k) {
            const size_t t = (size_t)gw + (size_t)(tb + k) * ngw;
            i32x2 v = *(const i32x2*)(idx + t * 128 + 2 * lane); v.x &= imask; v.y &= imask; const f32x2 c = *(const f32x2*)(coef + t * 128 + 2 * lane);
            li[k * 128 + sd0] = v.x; li[k * 128 + sd1] = v.y; lc[k * 128 + sd0] = c.x; lc[k * 128 + sd1] = c.y;
        }
        asm volatile("s_waitcnt vmcnt(0) lgkmcnt(0)" ::: "memory");
        const int nstep = 4 * nb;
        u32x4 rb[8][4]; float acc[16]; unsigned hv;
#define PV_ISSUE(s, B) do { const ge::u32x4 ia_ = *(const LAS ge::u32x4*)(li + ((s) >> 1) * 64 + rg * 8 + 4 * ((s) & 1)); \
            _Pragma("unroll") for (int i_ = 0; i_ < 4; ++i_) rb[B][i_] = *(const u32x4*)(tab + (ia_[i_] * 128u + lo16)); } while (0)
#define PV_STEP(s, B, QT) do { if ((s) < nstep) { if ((s) + 7 < nstep) PV_ISSUE((s) + 7, ((B) + 7) & 7); \
            const int k_ = (s) >> 2; const size_t t_ = (size_t)gw + (size_t)(tb + k_) * ngw; \
            if (QT == 0) { _Pragma("unroll") for (int k = 0; k < 16; ++k) acc[k] = 0.f; hv = *(const unsigned*)(hin + t_ * D + colo); } \
            const ge::f32x4 ca_ = *(const LAS ge::f32x4*)(lc + ((s) >> 1) * 64 + rg * 8 + 4 * ((s) & 1)); \
            _Pragma("unroll") for (int i = 0; i < 4; ++i) { const float cf = ca_[i]; _Pragma("unroll") for (int k = 0; k < 4; ++k) { \
                const f32x2 q0 = __builtin_amdgcn_cvt_pk_f32_fp8((int)rb[B][i][k], false), q1 = __builtin_amdgcn_cvt_pk_f32_fp8((int)rb[B][i][k], true); \
                acc[4 * k] += cf * q0.x; acc[4 * k + 1] += cf * q0.y; acc[4 * k + 2] += cf * q1.x; acc[4 * k + 3] += cf * q1.y; } } \
            if (QT == 3) { float s8[8], s4[4]; \
                _Pragma("unroll") for (int k = 0; k < 8; ++k) { auto rr = __builtin_amdgcn_permlane32_swap(__float_as_uint(acc[k]), __float_as_uint(acc[k + 8]), false, false); s8[k] = __uint_as_float(rr[0]) + __uint_as_float(rr[1]); } \
                _Pragma("unroll") for (int k = 0; k < 4; ++k) { auto rr = __builtin_amdgcn_permlane16_swap(__float_as_uint(s8[k]), __float_as_uint(s8[k + 4]), false, false); s4[k] = __uint_as_float(rr[0]) + __uint_as_float(rr[1]); } \
                const bool b3_ = (lane & 8) != 0; \
                const float o0 = (b3_ ? s4[2] : s4[0]) + dpp_ror8(b3_ ? s4[0] : s4[2]), o1 = (b3_ ? s4[3] : s4[1]) + dpp_ror8(b3_ ? s4[1] : s4[3]); \
                const unsigned w_ = pk2(__uint_as_float(hv << 16) + o0 * (1.f / VSCALE), __uint_as_float(hv & 0xffff0000u) + o1 * (1.f / VSCALE)); \
                *(unsigned*)(hb + t_ * D + colo) = w_; const float x0 = __uint_as_float(w_ << 16), x1 = __uint_as_float(w_ & 0xffff0000u); \
                float sq = x0 * x0 + x1 * x1; sq = wave_sum(sq); if (lane == 0) ssp1[t_ * 8 + slice] = sq; } } } while (0)
        PV_ISSUE(0, 0); PV_ISSUE(1, 1); PV_ISSUE(2, 2); PV_ISSUE(3, 3); if (4 < nstep) { PV_ISSUE(4, 4); PV_ISSUE(5, 5); PV_ISSUE(6, 6); }
        for (int s0 = 0; s0 < nstep; s0 += 8) { PV_STEP(s0, 0, 0); PV_STEP(s0 + 1, 1, 1); PV_STEP(s0 + 2, 2, 2); PV_STEP(s0 + 3, 3, 3); PV_STEP(s0 + 4, 4, 0); PV_STEP(s0 + 5, 5, 1); PV_STEP(s0 + 6, 6, 2); PV_STEP(s0 + 7, 7, 3); }
#undef PV_ISSUE
#undef PV_STEP
        asm volatile("s_waitcnt lgkmcnt(0)" ::: "memory");
    }
}

__device__ __forceinline__ void ph_final(const bf16_t* __restrict__ hb, const float* __restrict__ ssp1, const float* __restrict__ g, float* __restrict__ out) {
    PH_IDS
    const int lane = TIDX & 63, gw = BIDX * 8 + (TIDX >> 6), ngw = GDIM * 8;
    for (int w = gw; w < T; w += ngw) {
        const float rs = rsqrtf(sum8(ssp1 + (size_t)w * 8) * (1.f / D) + EPS);
        const u32x4* r = (const u32x4*)(hb + (size_t)w * D) + lane; const f32x4* gg = (const f32x4*)g; f32x4* o = (f32x4*)(out + (size_t)w * D);
#pragma unroll
        for (int j = 0; j < 2; ++j) { const u32x4 v = r[64 * j]; const int c4 = (64 * j + lane) * 2; const f32x4 g0 = gg[c4], g1 = gg[c4 + 1];
            o[c4] = (f32x4){__uint_as_float(v.x << 16) * rs * g0.x, __uint_as_float(v.x & 0xffff0000u) * rs * g0.y, __uint_as_float(v.y << 16) * rs * g0.z, __uint_as_float(v.y & 0xffff0000u) * rs * g0.w};
            o[c4 + 1] = (f32x4){__uint_as_float(v.z << 16) * rs * g1.x, __uint_as_float(v.z & 0xffff0000u) * rs * g1.y, __uint_as_float(v.w << 16) * rs * g1.z, __uint_as_float(v.w & 0xffff0000u) * rs * g1.w}; }
    }
}
}
namespace attn_body {
using bf16=__hip_bfloat16;
using bf16x8=__attribute__((ext_vector_type(8)))short;
using s16x4=__attribute__((ext_vector_type(4)))short;
using f32x16=__attribute__((ext_vector_type(16)))float;
using u32x4=__attribute__((ext_vector_type(4)))unsigned;
constexpr int BATCH=8,NHEAD=8,SEQ=4096,D=64,DM=NHEAD*D;
constexpr int OPITCH=1024,OCOL=512;
constexpr int NW=8,QBLK=32,QB=QBLK*NW,KVBLK=64,NQB=SEQ/QB;
constexpr int ATTN_PITCH=DM, ATTN_UNIT_ROWS=QB;
__device__ __forceinline__ int crow(int r,int hi){return (r&3)+8*(r>>2)+4*hi;}
#define SBAR() __builtin_amdgcn_sched_barrier(0)
__device__ __forceinline__ void cmask(f32x16&p0,f32x16&p1,int jb,int qrel,int hi){
  const float NEG=-INFINITY; int kb=64*jb+4*hi;
  #pragma unroll
  for(int r=0;r<16;++r){int kv=kb+(r&3)+8*(r>>2); if(kv>qrel)p0[r]=NEG; if(kv+32>qrel)p1[r]=NEG;}
}

constexpr int NSLOT=3, SLOTB=8192;
constexpr int LDS_K=0, LDS_V=NSLOT*SLOTB, LDS_WS=2*NSLOT*SLOTB, LDS_OST=LDS_WS+NW*64*4, LDS_CUM=LDS_OST+NW*4096, LDS_BYTES=LDS_CUM+SEQ*4;
constexpr float PRUNE_T=64.f;
constexpr float C2=0.125f*1.4426950408889634f;
__device__ __forceinline__ void glds16(const void*gsrc,unsigned lds_dst){unsigned keep;
  asm volatile("s_mov_b32 %0, m0\n\ts_mov_b32 m0, %2\n\ts_nop 0\n\tglobal_load_lds_dwordx4 %1, off\n\ts_mov_b32 m0, %0":"=&s"(keep):"v"(gsrc),"s"(lds_dst):"memory");}
__device__ __forceinline__ float max3f(float a,float b,float c){float r;asm("v_max3_f32 %0, %1, %2, %3":"=v"(r):"v"(a),"v"(b),"v"(c));return r;}
__device__ __forceinline__ float max2f(float a,float b){float r;asm("v_max_f32_e32 %0, %1, %2":"=v"(r):"v"(a),"v"(b));return r;}
__device__ __forceinline__ float fadd_s(float a,float b){float r;asm("v_add_f32_e32 %0, %1, %2":"=v"(r):"v"(a),"v"(b));return r;}
__device__ __forceinline__ float fsub_s(float a,float b){float r;asm("v_sub_f32_e32 %0, %1, %2":"=v"(r):"v"(a),"v"(b));return r;}
typedef float f32x4_t __attribute__((ext_vector_type(4)));
typedef float f32x2_t __attribute__((ext_vector_type(2))); typedef __bf16 bf16x2_t __attribute__((ext_vector_type(2)));
__device__ __forceinline__ unsigned cvtpk_s(float lo,float hi){f32x2_t v={lo,hi};bf16x2_t b=__builtin_convertvector(v,bf16x2_t);return __builtin_bit_cast(unsigned,b);}
#define WAIT_BAR(N) asm volatile("s_waitcnt vmcnt(" #N ") lgkmcnt(0)\n\ts_barrier":::"memory")

__device__ __forceinline__ void qkt(f32x16&p0,f32x16&p1,const char*Kslot,const bf16x8*qr,const f32x16&negm,int r32,int hi){
  const char*kb=Kslot+hi*1024+r32*16;
  #pragma unroll
  for(int d0=0;d0<4;++d0){
    const bf16x8 b0=*reinterpret_cast<const bf16x8*>(kb+d0*2048);
    const bf16x8 b1=*reinterpret_cast<const bf16x8*>(kb+d0*2048+512);
    if(d0==0){p0=__builtin_amdgcn_mfma_f32_32x32x16_bf16(b0,qr[0],negm,0,0,0);p1=__builtin_amdgcn_mfma_f32_32x32x16_bf16(b1,qr[0],negm,0,0,0);}
    else{p0=__builtin_amdgcn_mfma_f32_32x32x16_bf16(b0,qr[d0],p0,0,0,0);p1=__builtin_amdgcn_mfma_f32_32x32x16_bf16(b1,qr[d0],p1,0,0,0);}}
}
typedef __attribute__((address_space(3))) const char* lds_cptr;
typedef short v4i16_t __attribute__((ext_vector_type(4)));
__device__ __forceinline__ void kload8(bf16x8*kf,lds_cptr kp){
  kf[0]=*(const __attribute__((address_space(3))) bf16x8*)(kp);      kf[1]=*(const __attribute__((address_space(3))) bf16x8*)(kp+512);
  kf[2]=*(const __attribute__((address_space(3))) bf16x8*)(kp+2048); kf[3]=*(const __attribute__((address_space(3))) bf16x8*)(kp+2560);
  kf[4]=*(const __attribute__((address_space(3))) bf16x8*)(kp+4096); kf[5]=*(const __attribute__((address_space(3))) bf16x8*)(kp+4608);
  kf[6]=*(const __attribute__((address_space(3))) bf16x8*)(kp+6144); kf[7]=*(const __attribute__((address_space(3))) bf16x8*)(kp+6656);
}
__device__ __forceinline__ void kload2(bf16x8*kf,lds_cptr kp,int j){ kf[2*j]=*(const __attribute__((address_space(3))) bf16x8*)(kp+j*2048); kf[2*j+1]=*(const __attribute__((address_space(3))) bf16x8*)(kp+j*2048+512); }
__device__ __forceinline__ s16x4 vtr(lds_cptr p){ return __builtin_bit_cast(s16x4,__builtin_amdgcn_ds_read_tr16_b64_v4i16((__attribute__((address_space(3))) v4i16_t*)p)); }
__device__ __forceinline__ float rowmax(const f32x16&p0,const f32x16&p1){
  float a=max3f(p0[0],p0[1],p1[0]),b=max3f(p0[2],p0[3],p1[1]);a=max3f(a,p1[2],p1[3]);
  #pragma unroll
  for(int r=4;r<16;r+=4){a=max3f(a,p0[r],p0[r+1]);b=max3f(b,p0[r+2],p0[r+3]);a=max3f(a,p1[r],p1[r+1]);b=max3f(b,p1[r+2],p1[r+3]);}
  const float m=max2f(a,b);
  auto rr=__builtin_amdgcn_permlane32_swap(__float_as_uint(m),__float_as_uint(m),false,false);
  return max2f(__uint_as_float(rr[0]),__uint_as_float(rr[1]));
}
__device__ __forceinline__ void pv(f32x16*o,int vb,bf16x8 pa0,bf16x8 pa1,bf16x8 pa2,bf16x8 pa3){
  #pragma unroll
  for(int d0=0;d0<2;++d0){s16x4 lo[4],hi[4];
    #pragma unroll
    for(int ks=0;ks<4;++ks){
      asm volatile("ds_read_b64_tr_b16 %0,%1 offset:%c2":"=&v"(lo[ks]):"v"(vb),"i"(d0*4096+ks*1024):"memory");
      asm volatile("ds_read_b64_tr_b16 %0,%1 offset:%c2":"=&v"(hi[ks]):"v"(vb),"i"(d0*4096+ks*1024+512):"memory");}
    asm volatile("s_waitcnt lgkmcnt(0)":::"memory");SBAR();
    #define PK(k) (bf16x8){lo[k][0],lo[k][1],lo[k][2],lo[k][3],hi[k][0],hi[k][1],hi[k][2],hi[k][3]}
    o[d0]=__builtin_amdgcn_mfma_f32_32x32x16_bf16(pa0,PK(0),o[d0],0,0,0);
    o[d0]=__builtin_amdgcn_mfma_f32_32x32x16_bf16(pa1,PK(1),o[d0],0,0,0);
    o[d0]=__builtin_amdgcn_mfma_f32_32x32x16_bf16(pa2,PK(2),o[d0],0,0,0);
    o[d0]=__builtin_amdgcn_mfma_f32_32x32x16_bf16(pa3,PK(3),o[d0],0,0,0);
    #undef PK
  }
}

#ifndef ATTN_STORE16
#define ATTN_STORE16(p,v) (*(u32x4*)(p)=(v))
#endif
template<int THRL> __device__ __forceinline__ void attn_unit(int b,int h,int qb,const bf16*Q,const bf16*__restrict__ K,const bf16*__restrict__ V,const float*__restrict__ cum2,bf16*O,float*__restrict__ ssp,char*shm,int tid_){
  int tid=tid_; asm volatile("":"+v"(tid)); const int lane=tid&63,r32=lane&31,hi=lane>>5; const int wid=__builtin_amdgcn_readfirstlane(tid>>6);
  const long rowbase=(long)b*SEQ; const int q0=qb*QB;
  const bf16*Qw=Q+(rowbase+q0+wid*QBLK)*DM+h*D;
  const bf16*Kh=K+rowbase*DM+h*D,*Vh=V+rowbase*DM+h*D;
  const unsigned lds0=(unsigned)(uintptr_t)shm;
  float*wsf=(float*)(shm+LDS_WS)+wid*64;
  const int NTf=(q0+QB)/KVBLK; const float*cg=cum2+(long)(b*NHEAD+h)*SEQ;
  int ts; { const float thr=cg[q0]+PRUNE_T; const float ce=lane<NTf?cg[64*lane+63]:0.f; const unsigned long long m_=__ballot((lane<NTf)&&(ce<=thr));
    ts=m_?(int)__builtin_ctzll(m_):0; ts&=~1; if(ts>NTf-4)ts=NTf-4; ts=__builtin_amdgcn_readfirstlane(ts); }
  const bf16*ksrc=Kh+(long)(ts*KVBLK+lane)*DM+wid*8;
  const bf16*vsrc=Vh+(long)(ts*KVBLK+16*(wid&3)+(lane>>2))*DM+(wid>>2)*32+(lane&3)*8;
  const unsigned kdst=lds0+LDS_K+wid*1024, vdst=lds0+LDS_V+wid*1024;
  #define DMA_K(t,slot) glds16(ksrc+(long)(t)*KVBLK*DM,(unsigned)__builtin_amdgcn_readfirstlane(kdst+(slot)))
  #define DMA_V(t,slot) glds16(vsrc+(long)(t)*KVBLK*DM,(unsigned)__builtin_amdgcn_readfirstlane(vdst+(slot)))
  const int vb0=(int)(lds0+LDS_V)+((lane>>4)&1)*32+(lane&3)*8+(4*hi+((lane&15)>>2))*64;
  const char*Kbase=shm+LDS_K; bf16x8 kf[8];
  const lds_cptr shm3=(lds_cptr)shm; const lds_cptr kp0=shm3+LDS_K+hi*1024+r32*16; const lds_cptr vp0=shm3+LDS_V+((lane>>4)&1)*32+(lane&3)*8+(4*hi+((lane&15)>>2))*64;
  { float*cl=(float*)(shm+LDS_CUM); for(int i=tid+ts*KVBLK;i<q0+QB;i+=NW*64)cl[i-ts*KVBLK]=cg[i]; }
  const float cq2=cg[q0+wid*QBLK+r32];
  const __attribute__((address_space(3))) float* ckl=(const __attribute__((address_space(3))) float*)(shm3+LDS_CUM)+4*hi;
  #define BIAS(P0,P1,t) do{ const __attribute__((address_space(3))) float*ck_=ckl+64*(t); const float mm_=mhat-cq2; _Pragma("unroll") for(int g_=0;g_<4;++g_){ \
      const f32x4_t c0_=*(const __attribute__((address_space(3))) f32x4_t*)(ck_+8*g_)+mm_, c1_=*(const __attribute__((address_space(3))) f32x4_t*)(ck_+32+8*g_)+mm_; \
      _Pragma("unroll") for(int i_=0;i_<4;++i_){P0[4*g_+i_]-=c0_[i_];P1[4*g_+i_]-=c1_[i_];} SBAR(); } }while(0)
  const int NT=NTf-ts;
  DMA_K(0,0);DMA_V(0,0);DMA_K(1,SLOTB);
  bf16x8 qr[4];
  #pragma unroll
  for(int d0=0;d0<4;++d0)qr[d0]=*reinterpret_cast<const bf16x8*>(&Qw[(long)r32*DM+d0*16+hi*8]);
  float mhat=0.f,l_reg=0.f;f32x16 o[2];o[0]=f32x16{};o[1]=f32x16{};const f32x16 negm=f32x16{};
  const int qrel=wid*QBLK+r32;
  #define CMASK(P0,P1,t) do{int jb_=(t)-(NT-4); if(jb_>=0)cmask(P0,P1,jb_,qrel,hi);}while(0)
  bool resc=false;
  #define START(P0,P1) do{ const float rm=rowmax(P0,P1); resc=false; \
    { const float dl=rm; mhat=fadd_s(mhat,dl); \
      _Pragma("unroll") for(int r=0;r<16;++r){P0[r]=fsub_s(P0[r],dl);P1[r]=fsub_s(P1[r],dl);} \
      } \
    _Pragma("unroll") for(int r=0;r<16;++r)P0[r]=__builtin_amdgcn_exp2f(P0[r]); }while(0)
  #define RESC() do{ if(resc){ asm volatile("s_waitcnt lgkmcnt(0)":::"memory"); \
      _Pragma("unroll") for(int d_=0;d_<2;++d_) _Pragma("unroll") for(int r=0;r<16;++r)o[d_][r]*=wsf[crow(r,hi)]; } }while(0)
  f32x16 pA0,pA1,pB0,pB1;
  int sl_prev=0,sl_cur=0,sl_next=SLOTB;
  #define ROT() do{sl_prev=sl_cur;sl_cur=sl_next;sl_next=(sl_next==(NSLOT-1)*SLOTB)?0:sl_next+SLOTB;}while(0)
  DMA_K(2,2*SLOTB);
  WAIT_BAR(3);
  qkt(pA0,pA1,Kbase,qr,negm,r32,hi);asm volatile("s_nop 15\n\ts_nop 7":"+v"(pA0),"+v"(pA1));BIAS(pA0,pA1,0);CMASK(pA0,pA1,0);
  START(pA0,pA1);
  _Pragma("unroll") for(int r=0;r<16;++r)pA1[r]=__builtin_amdgcn_exp2f(pA1[r]);
  WAIT_BAR(0);
  DMA_K(3,0);DMA_V(1,SLOTB);
  ROT();
  kload8(kf,kp0+sl_cur);
  WAIT_BAR(2);
  s16x4 vlo[8],vhi[8]; u32x4 pw0,pw1,pw2,pw3;
  #define PKW(P,B) cvtpk_s(P[B],P[B+1])
  #define PAF(k) __builtin_bit_cast(bf16x8,pw##k)
  #define VFR(i) (bf16x8){vlo[i][0],vlo[i][1],vlo[i][2],vlo[i][3],vhi[i][0],vhi[i][1],vhi[i][2],vhi[i][3]}
  #define PIN(x) asm volatile("":"+v"(x))
  #define MX3(a,b,c) __builtin_fmaxf(__builtin_fmaxf((a),(b)),(c))
  #define GAPA(MF,A0,A1,A2,A3,W0,W1,PW) do{ MF; sacc+=A0; sacc+=A1; sacc+=A2; sacc+=A3; PIN(sacc); W0; W1; PIN(PW); SBAR(); }while(0)
  #define EX(v) __builtin_amdgcn_exp2f(v)
  #define GAPB(MF,X,B) do{ MF; X[B]=EX(X[B]); X[B+1]=EX(X[B+1]); X[B+2]=EX(X[B+2]); X[B+3]=EX(X[B+3]); PIN(X); SBAR(); }while(0)
  #define VRD(i) do{ vlo[i]=vtr(vp_+(((i)>>2)*4096+((i)&3)*1024)); vhi[i]=vtr(vp_+(((i)>>2)*4096+((i)&3)*1024+512)); }while(0)
  #define KRD(G,j) do{ if(G){ kload2(kf,kp0+sl_next,j); SBAR(); } }while(0)
  #define STEP(C0,C1,P0,P1,t,GK,GV,GL) do{ SBAR(); \
    const lds_cptr vp_=vp0+sl_prev; \
    VRD(0); SBAR(); float sacc=(P0[0]+P0[1]); \
    GAPA(C0=__builtin_amdgcn_mfma_f32_32x32x16_bf16(kf[0],qr[0],negm,0,0,0), P0[2],P0[3],P0[4],P0[5],     pw0[0]=PKW(P0,0), pw0[1]=PKW(P0,2), pw0); \
    VRD(4); SBAR(); GAPA(C1=__builtin_amdgcn_mfma_f32_32x32x16_bf16(kf[1],qr[0],negm,0,0,0), P0[6],P0[7],P0[8],P0[9],     pw0[2]=PKW(P0,4), pw0[3]=PKW(P0,6), pw0); \
    VRD(1); SBAR(); GAPA(C0=__builtin_amdgcn_mfma_f32_32x32x16_bf16(kf[2],qr[1],C0,0,0,0),   P0[10],P0[11],P0[12],P0[13], pw1[0]=PKW(P0,8), pw1[1]=PKW(P0,10), pw1); \
    VRD(5); SBAR(); GAPA(C1=__builtin_amdgcn_mfma_f32_32x32x16_bf16(kf[3],qr[1],C1,0,0,0),   P0[14],P0[15],P1[0],P1[1],   pw1[2]=PKW(P0,12),pw1[3]=PKW(P0,14), pw1); \
    VRD(2); SBAR(); GAPA(C0=__builtin_amdgcn_mfma_f32_32x32x16_bf16(kf[4],qr[2],C0,0,0,0),   P1[2],P1[3],P1[4],P1[5],     pw2[0]=PKW(P1,0), pw2[1]=PKW(P1,2), pw2); \
    VRD(6); SBAR(); GAPA(C1=__builtin_amdgcn_mfma_f32_32x32x16_bf16(kf[5],qr[2],C1,0,0,0),   P1[6],P1[7],P1[8],P1[9],     pw2[2]=PKW(P1,4), pw2[3]=PKW(P1,6), pw2); \
    VRD(3); SBAR(); GAPA(C0=__builtin_amdgcn_mfma_f32_32x32x16_bf16(kf[6],qr[3],C0,0,0,0),   P1[10],P1[11],P1[12],P1[13], pw3[0]=PKW(P1,8), pw3[1]=PKW(P1,10), pw3); \
    VRD(7); SBAR(); GAPA(C1=__builtin_amdgcn_mfma_f32_32x32x16_bf16(kf[7],qr[3],C1,0,0,0),   P1[14],P1[15],0.f,0.f,       pw3[2]=PKW(P1,12),pw3[3]=PKW(P1,14), pw3); \
    l_reg+=sacc; \
    if(GK){DMA_K((t)+3,sl_cur);} if(GV){DMA_V((t)+1,sl_next);} \
    BIAS(C0,C1,t); CMASK(C0,C1,t); \
    { float a=MX3(C0[0],C0[1],C1[0]),b=MX3(C0[2],C0[3],C1[1]); a=MX3(a,C1[2],C1[3]); \
      _Pragma("unroll") for(int r=4;r<16;r+=4){a=MX3(a,C0[r],C0[r+1]);b=MX3(b,C0[r+2],C0[r+3]);a=MX3(a,C1[r],C1[r+1]);b=MX3(b,C1[r+2],C1[r+3]);} \
      float rm=__builtin_fmaxf(a,b); { auto rr=__builtin_amdgcn_permlane32_swap(__float_as_uint(rm),__float_as_uint(rm),false,false); rm=__builtin_fmaxf(__uint_as_float(rr[0]),__uint_as_float(rr[1])); } \
      resc=false; \
      if(__builtin_expect(__any(rm>(float)THRL),0)){ const float dl=__builtin_fmaxf(rm,0.f); mhat+=dl; \
        _Pragma("unroll") for(int r=0;r<16;++r){C0[r]-=dl;C1[r]-=dl;} \
        const float f=__builtin_amdgcn_exp2f(-dl); l_reg*=f; if(hi==0)wsf[r32]=f; resc=true; } } \
    SBAR(); \
    GAPB(o[0]=__builtin_amdgcn_mfma_f32_32x32x16_bf16(PAF(0),VFR(0),o[0],0,0,0), C0,0); \
    GAPB(o[1]=__builtin_amdgcn_mfma_f32_32x32x16_bf16(PAF(0),VFR(4),o[1],0,0,0), C0,4); \
    KRD(GL,0); GAPB(o[0]=__builtin_amdgcn_mfma_f32_32x32x16_bf16(PAF(1),VFR(1),o[0],0,0,0), C0,8); \
    KRD(GL,1); GAPB(o[1]=__builtin_amdgcn_mfma_f32_32x32x16_bf16(PAF(1),VFR(5),o[1],0,0,0), C0,12); \
    KRD(GL,2); GAPB(o[0]=__builtin_amdgcn_mfma_f32_32x32x16_bf16(PAF(2),VFR(2),o[0],0,0,0), C1,0); \
    KRD(GL,3); GAPB(o[1]=__builtin_amdgcn_mfma_f32_32x32x16_bf16(PAF(2),VFR(6),o[1],0,0,0), C1,4); \
    GAPB(o[0]=__builtin_amdgcn_mfma_f32_32x32x16_bf16(PAF(3),VFR(3),o[0],0,0,0), C1,8); \
    GAPB(o[1]=__builtin_amdgcn_mfma_f32_32x32x16_bf16(PAF(3),VFR(7),o[1],0,0,0), C1,12); \
    }while(0)
  int t=1;
  #undef CMASK
  #define CMASK(P0,P1,t) do{}while(0)
  for(;t+5<NT;t+=2){
    STEP(pB0,pB1,pA0,pA1,t,true,true,true);     WAIT_BAR(2); RESC(); ROT();
    STEP(pA0,pA1,pB0,pB1,t+1,true,true,true);   WAIT_BAR(2); RESC(); ROT();
  }
  #undef CMASK
  #define CMASK(P0,P1,t) do{int jb_=(t)-(NT-4); if(jb_>=0)cmask(P0,P1,jb_,qrel,hi);}while(0)
  #define ENDW(tt) do{ if((tt)+3<NT){WAIT_BAR(2);} else if((tt)+2<NT){WAIT_BAR(1);} else {WAIT_BAR(0);} }while(0)
  for(;t+1<NT;t+=2){
    STEP(pB0,pB1,pA0,pA1,t,(t+3<NT),(t+1<NT),(t+1<NT));       ENDW(t);   RESC(); ROT();
    STEP(pA0,pA1,pB0,pB1,t+1,(t+4<NT),(t+2<NT),(t+2<NT));     ENDW(t+1); RESC(); ROT();
  }
  STEP(pB0,pB1,pA0,pA1,NT-1,false,false,false); RESC();
  { float sacc=pB0[0]+pB0[1]; _Pragma("unroll") for(int r=2;r<16;++r)sacc+=pB0[r]; _Pragma("unroll") for(int r=0;r<16;++r)sacc+=pB1[r]; l_reg+=sacc;
    pw0=(u32x4){PKW(pB0,0),PKW(pB0,2),PKW(pB0,4),PKW(pB0,6)};pw1=(u32x4){PKW(pB0,8),PKW(pB0,10),PKW(pB0,12),PKW(pB0,14)};pw2=(u32x4){PKW(pB1,0),PKW(pB1,2),PKW(pB1,4),PKW(pB1,6)};pw3=(u32x4){PKW(pB1,8),PKW(pB1,10),PKW(pB1,12),PKW(pB1,14)};
    SBAR(); pv(o,vb0+sl_cur,PAF(0),PAF(1),PAF(2),PAF(3)); }
  #undef PKW
  #undef PAF
  #undef VFR
  #undef PIN
  #undef MX3
  #undef GAPA
  #undef GAPB
  #undef EX
  #undef VRD
  #undef KRD
  #undef STEP
  #undef ENDW
  {auto rr=__builtin_amdgcn_permlane32_swap(__float_as_uint(l_reg),__float_as_uint(l_reg),false,false);l_reg=__uint_as_float(rr[0])+__uint_as_float(rr[1]);}
  if(hi==0)wsf[32+r32]=l_reg;asm volatile("s_waitcnt lgkmcnt(0)":::"memory");
  float rli[16];
  #pragma unroll
  for(int r=0;r<16;++r)rli[r]=__builtin_amdgcn_rcpf(wsf[32+crow(r,hi)]);
  int lane_e=lane; asm volatile("":"+v"(lane_e));
  bf16*Ow=O+(rowbase+q0+wid*QBLK)*OPITCH+OCOL+h*D; float*sw=ssp+(rowbase+q0+wid*QBLK)*8+h;
  { bf16*stg=(bf16*)(shm+LDS_OST)+wid*2048;
    #pragma unroll
    for(int r=0;r<16;++r){const int orow=crow(r,hi);
      #pragma unroll
      for(int d0=0;d0<2;++d0)stg[orow*64+d0*32+r32]=__float2bfloat16(o[d0][r]*rli[r]);}
    asm volatile("s_waitcnt lgkmcnt(0)":::"memory");
    #pragma unroll
    for(int i=0;i<4;++i){const int row=i*8+(lane_e>>3),ch=lane_e&7; const u32x4 v=*(const u32x4*)(stg+row*64+ch*8); ATTN_STORE16(Ow+(long)row*OPITCH+ch*8,v);
      float sq=0.f;
      #pragma unroll
      for(int k=0;k<4;++k){const float a=__uint_as_float(v[k]<<16),c=__uint_as_float(v[k]&0xffff0000u);sq+=a*a+c*c;}
      sq+=__shfl_xor(sq,1);sq+=__shfl_xor(sq,2);sq+=__shfl_xor(sq,4);
      if(ch==0)sw[(long)row*8]=sq; } }
  asm volatile("s_waitcnt lgkmcnt(0)\n\ts_barrier":::"memory");
  #undef DMA_K
  #undef DMA_V
  #undef CMASK
  #undef START
  #undef RESC
  #undef BIAS
  #undef ROT
}
constexpr int ATTN_LDS_BYTES=LDS_BYTES;
template<int THRL=8> __device__ __forceinline__ void attn_phase(char*lds,const bf16*Q,const bf16*K,const bf16*V,const float*cum2,bf16*O,float*ssp,unsigned*ctr,volatile __attribute__((address_space(3))) unsigned*slot,int tid){
  for(;;){
    if(tid==0)*slot=__hip_atomic_fetch_add(ctr,1u,__ATOMIC_RELAXED,__HIP_MEMORY_SCOPE_AGENT);
    __syncthreads();
    const int u=(int)*slot;
    __syncthreads();
    if(u>=BATCH*NHEAD*NQB)break;
    const int qb=NQB-1-(u>>6),h=NHEAD-1-((u>>3)&7),b=u&7;
    attn_unit<THRL>(b,h,qb,Q,K,V,cum2,O,ssp,lds,tid);
  }
}
#undef SBAR
#undef WAIT_BAR
}
namespace nv {
typedef float f32x2v __attribute__((ext_vector_type(2)));
constexpr size_t WS_APOW = 921 * MiB;
constexpr size_t WS_BBAR = 89 * MiB;
constexpr int KDW = 128 * 256;
__device__ __forceinline__ void p0_ssm_a(const float* __restrict__ lam_re, const float* __restrict__ lam_im, const float* __restrict__ log_dt, const float* __restrict__ b_re, const float* __restrict__ b_im,
                                         f32x2v* __restrict__ apow, f32x2v* __restrict__ bbar) {
    PH_IDS
    for (int i = BIDX * 512 + TIDX; i < DEPTH * G * P; i += GDIM * 512) {
        const int lg = i / P, p = i % P;
        const float dtf = expf(log_dt[lg]); const float lr = lam_re[i], li = lam_im[i];
        const double ang = (double)li * (double)dtf, k2 = rint(ang * 0.15915494309189535), red = ang - k2 * 6.283185307179586;
        const float mag = expf(lr * dtf), rr = (float)red; const double are = (double)(mag * cosf(rr)), aim = (double)(mag * sinf(rr));
        double pr = 1.0, pi = 0.0;
        for (int d = 0; d <= 64; ++d) { apow[((size_t)lg * 65 + d) * P + p] = (f32x2v){(float)pr, (float)pi}; const double nr_ = pr * are - pi * aim, ni_ = pr * aim + pi * are; pr = nr_; pi = ni_; }
        const double lrd = lr, lid = li, den = lrd * lrd + lid * lid, nr = are - 1.0, zre = (nr * lrd + aim * lid) / den, zim = (aim * lrd - nr * lid) / den;
        for (int h = 0; h < HC; ++h) { const double br = b_re[(size_t)i * HC + h], bi = b_im[(size_t)i * HC + h]; bbar[(size_t)i * HC + h] = (f32x2v){(float)(zre * br - zim * bi), (float)(zre * bi + zim * br)}; }
    }
}
__device__ __forceinline__ void p0_ssm_b(const f32x2v* __restrict__ apow, const f32x2v* __restrict__ bbar, const float* __restrict__ c_re, const float* __restrict__ c_im, const float* __restrict__ dsk,
                                         bf16_t* __restrict__ KD, bf16_t* __restrict__ WST, bf16_t* __restrict__ WOUT) {
    PH_IDS
    const int gt = BIDX * 512 + TIDX, nth = GDIM * 512;
    for (int i = gt; i < DEPTH * G * KDW; i += nth) {
        const int lg = i / KDW, r = i % KDW, dd = r >> 8, h = (r >> 4) & 15, h2 = r & 15, d = dd - 63;
        float v = 0.f;
        if (d >= 0 && dd < 127) {
            const f32x2v* ap = apow + ((size_t)lg * 65 + d) * P; const f32x2v* bb = bbar + (size_t)lg * P * HC + h2; const float* cr = c_re + ((size_t)lg * HC + h) * P; const float* ci = c_im + ((size_t)lg * HC + h) * P;
            for (int p = 0; p < P; ++p) { const f32x2v a = ap[p], b = bb[(size_t)p * HC]; const float wr = a.x * b.x - a.y * b.y, wi = a.x * b.y + a.y * b.x; v += cr[p] * wr - ci[p] * wi; }
            if (d == 0 && h == h2) v += dsk[lg * HC + h];
        }
        KD[i] = f2bf(v);
    }
    for (int i = gt; i < DEPTH * G * 128 * 256; i += nth) {
        const int lg = i >> 15, r = i & 32767, row = r >> 8, k = r & 255, j = k >> 4, h2 = k & 15, p = row & 63;
        const f32x2v a = apow[((size_t)lg * 65 + (15 - j)) * P + p], b = bbar[((size_t)lg * P + p) * HC + h2];
        WST[i] = f2bf(row < 64 ? a.x * b.x - a.y * b.y : a.x * b.y + a.y * b.x);
    }
    for (int i = gt; i < DEPTH * G * 1024 * 128; i += nth) {
        const int lg = i >> 17, r = i & 131071, row = r >> 7, k = r & 127, ti = row >> 4, h = row & 15, p = k & 63;
        const f32x2v e = apow[((size_t)lg * 65 + ti + 1) * P + p]; const float cr = c_re[((size_t)lg * HC + h) * P + p], ci = c_im[((size_t)lg * HC + h) * P + p];
        WOUT[i] = f2bf(k < 64 ? cr * e.x - ci * e.y : -(cr * e.y + ci * e.x));
    }
}

struct SchedSsmS {
    static constexpr bool DUALB = false; long hA, hB, hB1;
    const char* UP; const char* WST; int G_, c;
    __device__ __forceinline__ void init(const void* up, const void* wst_l, int grid, int bid) { UP = (const char*)up; WST = (const char*)wst_l; G_ = grid; c = bid; hA = 128l * UPW * 2; hB = 0; hB1 = 0; }
    __device__ __forceinline__ bool next(int i, ge::Unit& u) const {
        const int L = i * G_ + c; if (L >= G * 2 * 4) return false;
        const int g = L >> 3, pm = (L >> 2) & 1, ks = L & 3;
        u.A0 = UP + (((size_t)g * NCH + pm * 256) * UPW + 128 + ks * 256) * 2; u.B0 = WST + (size_t)g * 128 * 256 * 2; u.nt = 4; u.pm = pm; u.pn = ks; u.aux = g; return true; }
    __device__ __forceinline__ const char* ta(const ge::Unit& u, int t) const { return u.A0 + t * 128; }
    __device__ __forceinline__ const char* tb(const ge::Unit& u, int t) const { return u.B0 + t * 128; }
    __device__ __forceinline__ bool sb(const ge::Unit&, int) const { return false; }
    __device__ __forceinline__ unsigned voffA(int R, int C) const { return (unsigned)(R * UPW * 2 + C * 2); }
    __device__ __forceinline__ unsigned voffB(int Rb, int C) const { return (unsigned)(Rb * 512 + C * 2); }
    __device__ __forceinline__ unsigned voffB1(int, int) const { return 0u; }
};
struct EpiSsmS {
    static constexpr bool PERM = false, MIDK = false, UBEGIN = false;
    float* SLOC;
    __device__ __forceinline__ void unit_begin(const ge::Unit&, int, LAS unsigned char*) const {}
    __device__ __forceinline__ void midk(ge::f32x4 (&)[2][2][4][2], const ge::Unit&, int, int, LAS unsigned char*) const {}
    __device__ __forceinline__ void operator()(const ge::f32x4 (&acc)[2][2][4][2], const ge::Unit& u, int wr, int wc, int fr, int fq, LAS unsigned char*) const {
        const int g = u.aux, ks = u.pn;
#pragma unroll
        for (int ai = 0; ai < 2; ++ai)
#pragma unroll
            for (int m = 0; m < 4; ++m) {
                const int chunk = u.pm * 256 + ai * 128 + wr * 64 + m * 16 + fr; float* dst = SLOC + ((size_t)g * (NCH * 4) + chunk * 4 + ks) * 128;
#pragma unroll
                for (int n = 0; n < 2; ++n) *(ge::f32x4*)(dst + wc * 32 + 16 * n + 4 * fq) = acc[ai][0][m][n];
            }
    }
};

__device__ __forceinline__ void ph_ssm_prefix(LAS unsigned char* lds, const float* __restrict__ SLOC, const f32x2v* __restrict__ apow_l, bf16_t* __restrict__ UP) {
    PH_IDS
    const int p = TIDX & 63, w = TIDX >> 6;
    LAS f32x2v* ex = (LAS f32x2v*)lds;
    for (int item = BIDX; item < BATCH * G; item += GDIM) {
        const int b = item / G, g = item % G;
        const f32x2v a16 = apow_l[((size_t)g * 65 + 16) * P + p];
        const float* src = SLOC + ((size_t)g * (NCH * 4) + (size_t)b * 256 + 32 * w) * 128 + p; bf16_t* dst = UP + ((size_t)g * NCH + b * 64 + 8 * w) * UPW + p;
        float xr[32], xi[32];
#pragma unroll
        for (int k = 0; k < 32; ++k) { xr[k] = src[(size_t)k * 128]; xi[k] = src[(size_t)k * 128 + 64]; }
        float sr = 0.f, si = 0.f;
#pragma unroll
        for (int k = 0; k < 32; ++k) { const float nr = a16.x * sr - a16.y * si + xr[k], ni = a16.x * si + a16.y * sr + xi[k]; sr = nr; si = ni; }
        ex[w * 64 + p] = (f32x2v){sr, si};
        float qr = a16.x, qi = a16.y;
#pragma unroll
        for (int k = 0; k < 5; ++k) { const float nr = qr * qr - qi * qi, ni = 2.f * qr * qi; qr = nr; qi = ni; }
        __syncthreads();
        sr = 0.f; si = 0.f;
        for (int j = 0; j < w; ++j) { const f32x2v e = ex[j * 64 + p]; const float nr = qr * sr - qi * si + e.x, ni = qr * si + qi * sr + e.y; sr = nr; si = ni; }
#pragma unroll
        for (int k = 0; k < 32; ++k) {
            if ((k & 3) == 0) { bf16_t* d = dst + (size_t)(k >> 2) * UPW; d[0] = f2bf(sr); d[64] = f2bf(si); }
            const float nr = a16.x * sr - a16.y * si + xr[k], ni = a16.x * si + a16.y * sr + xi[k]; sr = nr; si = ni;
        }
        __syncthreads();
    }
}
__device__ __forceinline__ void ph_cum2(const float* __restrict__ logf, float* __restrict__ cum) {
    PH_IDS
    const int lane = TIDX & 63, gw = BIDX * 8 + (TIDX >> 6), ngw = GDIM * 8;
    for (int item = gw; item < BATCH * NH; item += ngw) {
        const int b = item / NH, h = item % NH;
        const float* src = logf + ((size_t)b * SEQ + lane * 64) * NH + h; float* dst = cum + (size_t)item * SEQ + lane * 64;
        float tot = 0.f;
        for (int i = 0; i < 64; ++i) tot += src[(size_t)i * NH];
        float ex = tot;
#pragma unroll
        for (int o = 1; o < 64; o <<= 1) { const float y = __shfl_up(ex, o); if (lane >= o) ex += y; }
        float run = ex - tot;
        for (int i = 0; i < 64; ++i) { run += src[(size_t)i * NH]; dst[i] = run * 1.4426950408889634f; }
    }
}

struct SchedSsmC {
    static constexpr bool DUALB = true; long hA, hB, hB1;
    const char* UP; const char* WOUT; const char* KD; int G_, c;
    __device__ __forceinline__ void init(const void* up, const void* wout_l, const void* kd_l, int grid, int bid) { UP = (const char*)up; WOUT = (const char*)wout_l; KD = (const char*)kd_l; G_ = grid; c = bid; hA = 128l * UPW * 2; hB = 128l * 256; hB1 = 8l * 512; }
    __device__ __forceinline__ bool next(int i, ge::Unit& u) const {
        const int L = i * G_ + c; if (L >= G * 2 * 4) return false;
        const int pn = 3 - (L >> 6), g = (L & 63) >> 1, pm = L & 1;
        u.A0 = UP + ((size_t)g * NCH + pm * 256) * UPW * 2; u.B0 = nullptr; u.nt = 2 + 4 * (pn + 1); u.pm = pm; u.pn = pn; u.aux = g; return true; }
    __device__ __forceinline__ const char* ta(const ge::Unit& u, int t) const { return u.A0 + t * 128; }
    __device__ __forceinline__ bool sb(const ge::Unit&, int t) const { return t >= 2; }
    __device__ __forceinline__ const char* tb(const ge::Unit& u, int t) const {
        return t < 2 ? WOUT + ((size_t)u.aux * 1024 + u.pn * 256) * 256 + t * 128 : KD + ((size_t)u.aux * KDW + (size_t)(16 * u.pn - 4 * (t - 2) + 60) * 256) * 2; }
    __device__ __forceinline__ unsigned voffA(int R, int C) const { return (unsigned)(R * UPW * 2 + C * 2); }
    __device__ __forceinline__ unsigned voffB(int Rb, int C) const { return (unsigned)(Rb * 256 + C * 2); }
    __device__ __forceinline__ unsigned voffB1(int Rb, int C) const { return (unsigned)((((Rb >> 4) + 3 - (C >> 4)) * 256 + (Rb & 15) * 16 + (C & 15)) * 2); }
};
__device__ __forceinline__ float gelu_fast(float x) { const float u = 1.5957691216057308f * (x + 0.044715f * x * x * x); return x - x / (1.f + __expf(u)); }
struct EpiSsmC {
    static constexpr bool PERM = true, MIDK = false, UBEGIN = false;
    bf16_t* GEL;
    __device__ __forceinline__ void unit_begin(const ge::Unit&, int, LAS unsigned char*) const {}
    __device__ __forceinline__ void midk(ge::f32x4 (&)[2][2][4][2], const ge::Unit&, int, int, LAS unsigned char*) const {}
    __device__ __forceinline__ void operator()(const ge::f32x4 (&acc)[2][2][4][2], const ge::Unit& u, int wr, int wc, int fr, int fq, LAS unsigned char*) const {
        const int g = u.aux;
#pragma unroll
        for (int ai = 0; ai < 2; ++ai)
#pragma unroll
            for (int m = 0; m < 4; ++m) {
                const int chunk = u.pm * 256 + ai * 128 + wr * 64 + m * 16 + fr;
#pragma unroll
                for (int bj = 0; bj < 2; ++bj) {
                    const int col = u.pn * 256 + bj * 128 + wc * 32 + 8 * fq, ti = col >> 4, h0 = col & 15;
                    const ge::f32x4 v0 = acc[ai][bj][m][0], v1 = acc[ai][bj][m][1];
                    u32x4 w; w.x = ge::cvt_pk_bf16(gelu_fast(v0[0]), gelu_fast(v0[1])); w.y = ge::cvt_pk_bf16(gelu_fast(v0[2]), gelu_fast(v0[3]));
                    w.z = ge::cvt_pk_bf16(gelu_fast(v1[0]), gelu_fast(v1[1])); w.w = ge::cvt_pk_bf16(gelu_fast(v1[2]), gelu_fast(v1[3]));
                    *(u32x4*)(GEL + ((size_t)g * T + chunk * 64 + ti) * HC + h0) = w;
                }
            }
    }
};
}
namespace nv {
#define SEL_CE(x, y) do { const int _h = max((x), (y)), _l = min((x), (y)); (x) = _h; (y) = _l; } while (0)
__device__ __forceinline__ void sel_sort16(int (&v)[16]) {
    SEL_CE(v[0], v[1]);
    SEL_CE(v[2], v[3]);
    SEL_CE(v[0], v[2]);
    SEL_CE(v[1], v[3]);
    SEL_CE(v[1], v[2]);
    SEL_CE(v[4], v[5]);
    SEL_CE(v[6], v[7]);
    SEL_CE(v[4], v[6]);
    SEL_CE(v[5], v[7]);
    SEL_CE(v[5], v[6]);
    SEL_CE(v[0], v[4]);
    SEL_CE(v[2], v[6]);
    SEL_CE(v[2], v[4]);
    SEL_CE(v[1], v[5]);
    SEL_CE(v[3], v[7]);
    SEL_CE(v[3], v[5]);
    SEL_CE(v[1], v[2]);
    SEL_CE(v[3], v[4]);
    SEL_CE(v[5], v[6]);
    SEL_CE(v[8], v[9]);
    SEL_CE(v[10], v[11]);
    SEL_CE(v[8], v[10]);
    SEL_CE(v[9], v[11]);
    SEL_CE(v[9], v[10]);
    SEL_CE(v[12], v[13]);
    SEL_CE(v[14], v[15]);
    SEL_CE(v[12], v[14]);
    SEL_CE(v[13], v[15]);
    SEL_CE(v[13], v[14]);
    SEL_CE(v[8], v[12]);
    SEL_CE(v[10], v[14]);
    SEL_CE(v[10], v[12]);
    SEL_CE(v[9], v[13]);
    SEL_CE(v[11], v[15]);
    SEL_CE(v[11], v[13]);
    SEL_CE(v[9], v[10]);
    SEL_CE(v[11], v[12]);
    SEL_CE(v[13], v[14]);
    SEL_CE(v[0], v[8]);
    SEL_CE(v[4], v[12]);
    SEL_CE(v[4], v[8]);
    SEL_CE(v[2], v[10]);
    SEL_CE(v[6], v[14]);
    SEL_CE(v[6], v[10]);
    SEL_CE(v[2], v[4]);
    SEL_CE(v[6], v[8]);
    SEL_CE(v[10], v[12]);
    SEL_CE(v[1], v[9]);
    SEL_CE(v[5], v[13]);
    SEL_CE(v[5], v[9]);
    SEL_CE(v[3], v[11]);
    SEL_CE(v[7], v[15]);
    SEL_CE(v[7], v[11]);
    SEL_CE(v[3], v[5]);
    SEL_CE(v[7], v[9]);
    SEL_CE(v[11], v[13]);
    SEL_CE(v[1], v[2]);
    SEL_CE(v[3], v[4]);
    SEL_CE(v[5], v[6]);
    SEL_CE(v[7], v[8]);
    SEL_CE(v[9], v[10]);
    SEL_CE(v[11], v[12]);
    SEL_CE(v[13], v[14]);
}
__device__ __forceinline__ void sel_merge16(int (&a)[16], const int (&b)[16]) {
    a[0] = max(a[0], b[15]);
    a[1] = max(a[1], b[14]);
    a[2] = max(a[2], b[13]);
    a[3] = max(a[3], b[12]);
    a[4] = max(a[4], b[11]);
    a[5] = max(a[5], b[10]);
    a[6] = max(a[6], b[9]);
    a[7] = max(a[7], b[8]);
    a[8] = max(a[8], b[7]);
    a[9] = max(a[9], b[6]);
    a[10] = max(a[10], b[5]);
    a[11] = max(a[11], b[4]);
    a[12] = max(a[12], b[3]);
    a[13] = max(a[13], b[2]);
    a[14] = max(a[14], b[1]);
    a[15] = max(a[15], b[0]);
    SEL_CE(a[0], a[8]);
    SEL_CE(a[1], a[9]);
    SEL_CE(a[2], a[10]);
    SEL_CE(a[3], a[11]);
    SEL_CE(a[4], a[12]);
    SEL_CE(a[5], a[13]);
    SEL_CE(a[6], a[14]);
    SEL_CE(a[7], a[15]);
    SEL_CE(a[0], a[4]);
    SEL_CE(a[1], a[5]);
    SEL_CE(a[2], a[6]);
    SEL_CE(a[3], a[7]);
    SEL_CE(a[8], a[12]);
    SEL_CE(a[9], a[13]);
    SEL_CE(a[10], a[14]);
    SEL_CE(a[11], a[15]);
    SEL_CE(a[0], a[2]);
    SEL_CE(a[1], a[3]);
    SEL_CE(a[4], a[6]);
    SEL_CE(a[5], a[7]);
    SEL_CE(a[8], a[10]);
    SEL_CE(a[9], a[11]);
    SEL_CE(a[12], a[14]);
    SEL_CE(a[13], a[15]);
    SEL_CE(a[0], a[1]);
    SEL_CE(a[2], a[3]);
    SEL_CE(a[4], a[5]);
    SEL_CE(a[6], a[7]);
    SEL_CE(a[8], a[9]);
    SEL_CE(a[10], a[11]);
    SEL_CE(a[12], a[13]);
    SEL_CE(a[14], a[15]);
}
constexpr int SEL_NCAND = 50;
#define SEL_CANDS(F) \
    F(0, 0, 0) \
    F(1, 0, 1) \
    F(2, 0, 2) \
    F(3, 0, 3) \
    F(4, 0, 4) \
    F(5, 0, 5) \
    F(6, 0, 6) \
    F(7, 0, 7) \
    F(8, 0, 8) \
    F(9, 0, 9) \
    F(10, 0, 10) \
    F(11, 0, 11) \
    F(12, 0, 12) \
    F(13, 0, 13) \
    F(14, 0, 14) \
    F(15, 0, 15) \
    F(16, 1, 0) \
    F(17, 1, 1) \
    F(18, 1, 2) \
    F(19, 1, 3) \
    F(20, 1, 4) \
    F(21, 1, 5) \
    F(22, 1, 6) \
    F(23, 1, 7) \
    F(24, 2, 0) \
    F(25, 2, 1) \
    F(26, 2, 2) \
    F(27, 2, 3) \
    F(28, 2, 4) \
    F(29, 3, 0) \
    F(30, 3, 1) \
    F(31, 3, 2) \
    F(32, 3, 3) \
    F(33, 4, 0) \
    F(34, 4, 1) \
    F(35, 4, 2) \
    F(36, 5, 0) \
    F(37, 5, 1) \
    F(38, 6, 0) \
    F(39, 6, 1) \
    F(40, 7, 0) \
    F(41, 7, 1) \
    F(42, 8, 0) \
    F(43, 9, 0) \
    F(44, 10, 0) \
    F(45, 11, 0) \
    F(46, 12, 0) \
    F(47, 13, 0) \
    F(48, 14, 0) \
    F(49, 15, 0)
__device__ __forceinline__ int f2key(float f) { const int b = __float_as_int(f); return b ^ ((b >> 31) & 0x7fffffff); }
__device__ __forceinline__ float key2f(int k) { return __int_as_float(k ^ ((k >> 31) & 0x7fffffff)); }
__device__ __forceinline__ void sel_top16(const f32x16 (&acc)[4], int hi, int (&t)[16]) {
    int g1[16], g2[16], g3[16];
#pragma unroll
    for (int r = 0; r < 16; ++r) { const int n = (r & 3) + 8 * (r >> 2) + 4 * hi;
        t[r] = (f2key(acc[0][r]) & ~0x7F) | n; g1[r] = (f2key(acc[1][r]) & ~0x7F) | (32 + n); g2[r] = (f2key(acc[2][r]) & ~0x7F) | (64 + n); g3[r] = (f2key(acc[3][r]) & ~0x7F) | (96 + n); }
    sel_sort16(t); sel_sort16(g1); sel_sort16(g2); sel_sort16(g3);
    sel_merge16(t, g1); sel_merge16(g2, g3); sel_merge16(t, g2);
#pragma unroll
    for (int i = 0; i < 16; ++i) { auto rr = __builtin_amdgcn_permlane32_swap((unsigned)t[i], (unsigned)t[i], false, false); g1[i] = (int)(hi ? rr[0] : rr[1]); }
    sel_merge16(t, g1);
}
__device__ __forceinline__ void ph_select(const bf16_t* __restrict__ QP, const bf16_t* __restrict__ KEYS, int* __restrict__ idx, float* __restrict__ gate, LAS unsigned char* lds) {
    PH_IDS
    const int lane = TIDX & 63, hd = TIDX >> 6, r = lane & 31, hi = lane >> 5;
    LAS unsigned* my = (LAS unsigned*)(lds + hd * 2048) + lane;
    for (int tg = BIDX; tg < T / 32; tg += GDIM) {
        const int tok0 = tg * 32;
        int rk = r; asm volatile("" : "+v"(rk));
        int t1[16], t2[16];
#pragma unroll
        for (int half = 0; half < 2; ++half) {
            f32x16 acc[4];
#pragma unroll
            for (int mt = 0; mt < 4; ++mt)
#pragma unroll
                for (int i = 0; i < 16; ++i) acc[mt][i] = 0.f;
            const bf16_t* qb = QP + (size_t)(tok0 + r) * D + hd * QD + half * HALF + 8 * hi;
            const bf16_t* kb = KEYS + ((size_t)(hd * 2 + half) * NK + rk) * HALF + 8 * hi;
#pragma unroll
            for (int ks = 0; ks < 4; ++ks) {
                const bf16x8 b = *(const bf16x8*)(qb + 16 * ks);
#pragma unroll
                for (int mt = 0; mt < 4; ++mt) { const bf16x8 a = *(const bf16x8*)(kb + (size_t)mt * 32 * HALF + 16 * ks); acc[mt] = __builtin_amdgcn_mfma_f32_32x32x16_bf16(a, b, acc[mt], 0, 0, 0); }
            }
            if (half == 0) sel_top16(acc, hi, t1); else sel_top16(acc, hi, t2);
        }
        float f1[16], f2[16];
#pragma unroll
        for (int i = 0; i < 16; ++i) { f1[i] = key2f(t1[i]); f2[i] = key2f(t2[i]); }
        int c0[16], c1[16], c2[16], c3[16];
#pragma unroll
        for (int i = 0; i < 16; ++i) c3[i] = (int)0x80000000;
#define SEL_F(k, i, j) { const int v_ = (f2key(f1[i] + f2[j]) & ~0xFF) | ((i) << 4 | (j)); if ((k) < 16) c0[(k) & 15] = v_; else if ((k) < 32) c1[(k) & 15] = v_; else if ((k) < 48) c2[(k) & 15] = v_; else c3[(k) & 15] = v_; }
        SEL_CANDS(SEL_F)
#undef SEL_F
        sel_sort16(c0); sel_sort16(c1); sel_sort16(c2); SEL_CE(c3[0], c3[1]);
        sel_merge16(c0, c1); sel_merge16(c2, c3); sel_merge16(c0, c2);
#pragma unroll
        for (int j = 0; j < 4; ++j) {
            my[64 * j] = (unsigned)(t1[4 * j] & 0x7F) | ((unsigned)(t1[4 * j + 1] & 0x7F) << 8) | ((unsigned)(t1[4 * j + 2] & 0x7F) << 16) | ((unsigned)(t1[4 * j + 3] & 0x7F) << 24);
            my[64 * (4 + j)] = (unsigned)(t2[4 * j] & 0x7F) | ((unsigned)(t2[4 * j + 1] & 0x7F) << 8) | ((unsigned)(t2[4 * j + 2] & 0x7F) << 16) | ((unsigned)(t2[4 * j + 3] & 0x7F) << 24);
        }
        const float mx = key2f(c0[0]); float e[16], se = 0.f;
#pragma unroll
        for (int k = 0; k < 16; ++k) { e[k] = __expf(key2f(c0[k]) - mx); se += e[k]; }
        const float inv = 1.f / se;
        asm volatile("s_waitcnt lgkmcnt(0)" ::: "memory");
        const size_t o = (size_t)(tok0 + r) * 128 + hd * TOPK;
        if (hi == 0) {
            int id[16];
#pragma unroll
            for (int k = 0; k < 16; ++k) { const int code = c0[k] & 0xFF, i = code >> 4, j = code & 15;
                const unsigned w1 = my[64 * (i >> 2)], w2 = my[64 * (4 + (j >> 2))];
                id[k] = (int)((w1 >> (8 * (i & 3))) & 0x7F) * NK + (int)((w2 >> (8 * (j & 3))) & 0x7F); }
#pragma unroll
            for (int k = 0; k < 4; ++k) *(int4*)(idx + o + 4 * k) = make_int4(id[4 * k], id[4 * k + 1], id[4 * k + 2], id[4 * k + 3]);
        } else {
#pragma unroll
            for (int k = 0; k < 4; ++k) *(float4*)(gate + o + 4 * k) = make_float4(e[4 * k] * inv, e[4 * k + 1] * inv, e[4 * k + 2] * inv, e[4 * k + 3] * inv);
        }
        asm volatile("s_waitcnt lgkmcnt(0)" ::: "memory");
    }
}
}
#ifndef PROBE_MASK
#define PROBE_MASK 0
#endif
#define REPS(bit) (((PROBE_MASK >> (bit)) & 1) ? 2 : 1)
namespace nv {
constexpr int LDS_BYTES = 147456, MISC_OFF = 131072 + 320;
struct Params { const float* in[23]; float* out; unsigned char* ws; };

__global__ void __launch_bounds__(512, 2) k_mega(Params prm) {
    extern __shared__ __attribute__((aligned(16))) unsigned char lds_raw[];
    namespace cg = cooperative_groups;
    cg::grid_group grid = cg::this_grid();
    LAS unsigned char* lds = (LAS unsigned char*)lds_raw;
    unsigned char* smem = lds_raw;
    for (int u = threadIdx.x; u < (LDS_BYTES - 131072) / 4; u += 512) ((LAS unsigned*)(lds + 131072))[u] = 0u;
    __syncthreads();
    if (threadIdx.x == 0) {
        LAS unsigned long long* tab = (LAS unsigned long long*)(lds + TAB_OFF);
#pragma unroll
        for (int i = 0; i < 23; ++i) tab[i] = (unsigned long long)prm.in[i];
        tab[23] = (unsigned long long)prm.out; tab[24] = (unsigned long long)prm.ws;
    }
    __syncthreads();
#define ARG(i) ((const float*)ldarg(lds, (i)))
#define WSP() ((unsigned char*)ldarg(lds, 24))
    XcdBarrier bar = xcd_barrier_post((unsigned*)(WSP() + WS_CTL) + CW_BAR, (volatile LAS unsigned*)(lds + MISC_OFF) + 8);
#define GRID_BAR() do { xcd_barrier(bar); asm volatile("" ::: "memory"); } while (0)
    if (threadIdx.x == 0) { volatile LAS unsigned* M = (volatile LAS unsigned*)(lds + MISC_OFF); M[16] = bar.x; M[17] = xb_add((unsigned*)(WSP() + WS_CTL) + CW_RANK + 64 * bar.x, 1u); }
    for (int rep = 0; rep < REPS(0); ++rep) {
    p0_prologue(lds);
    { unsigned char* ws = WSP(); p0_peer_tables(ARG(20), ARG(21), ARG(17), ws + WS_PU, ws + WS_PV8); }
    { unsigned char* ws = WSP(); const float* pk = ARG(19); bf16_t* kb = (bf16_t*)(ws + WS_KEYS); for (int i = obid() * 512 + otid(); i < DEPTH * PH * 2 * NK * HALF; i += ogrid() * 512) kb[i] = f2bf(pk[i]); }
    { unsigned char* ws = WSP(); p0_ssm_a(ARG(3), ARG(4), ARG(5), ARG(6), ARG(7), (f32x2v*)(ws + WS_APOW), (f32x2v*)(ws + WS_BBAR)); }
    }
    GRID_BAR();
    if (threadIdx.x == 0) {
        volatile LAS unsigned* M = (volatile LAS unsigned*)(lds + MISC_OFF); unsigned* bw = (unsigned*)(WSP() + WS_CTL) + CW_BAR; unsigned tot = 0u, ok = 1u;
        for (unsigned j = 0; j < 16; ++j) { const unsigned cnt = xb_ld(&bw[XB_XCNT(j)]); tot += cnt; if ((j < 8) != (cnt > 0u)) ok = 0u; }
        M[18] = xb_ld(&bw[XB_XCNT(bar.x)]); M[19] = (ok && tot == gridDim.x) ? 1u : 0u;
    }
    __syncthreads();
    { unsigned char* ws = WSP(); p0_ssm_b((const f32x2v*)(ws + WS_APOW), (const f32x2v*)(ws + WS_BBAR), ARG(8), ARG(9), ARG(10), (bf16_t*)(ws + WS_KD), (bf16_t*)(ws + WS_WST), (bf16_t*)(ws + WS_WOUT)); }
    grid.sync();
#pragma nounroll
    for (int l_ = 0; l_ < DEPTH; ++l_) {
        int l = l_; asm volatile("" : "+s"(l));
        {
            unsigned char* ws = WSP(); bf16_t* hb = (bf16_t*)(ws + WS_HB); float* ss1 = (float*)(ws + WS_SSP) + (size_t)T * 32;
            for (int rep = 0; rep < REPS(1); ++rep) {
            SchedGen S; S.init_plain(hb, D * 2, (const bf16_t*)(ws + WS_BT1) + (size_t)l * 2048 * D, D * 2, T, 2048, D, ogrid(), obid());
            EpiInProj E{ss1, (bf16_t*)(ws + WS_UP), (bf16_t*)(ws + WS_Q)};
            ge::gemm_phase<EpiInProj, SchedGen>(lds, S, E, otid());
            }
            for (int rep = 0; rep < REPS(2); ++rep)
            ph_flogit(hb, (const bf16_t*)(ws + WS_WF) + (size_t)l * 16 * D, ss1, ARG(13) + l * NH, (float*)(ws + WS_LOGF));
        }
        GRID_BAR();
        {
            unsigned char* ws = WSP();
            for (int rep = 0; rep < REPS(3); ++rep) {
            SchedSsmS S; S.init(ws + WS_UP, (const bf16_t*)(ws + WS_WST) + (size_t)l * G * 128 * 256, ogrid(), obid());
            EpiSsmS E{(float*)(ws + WS_SLOC)};
            ge::gemm_phase<EpiSsmS, SchedSsmS>(lds, S, E, otid());
            }
            for (int rep = 0; rep < REPS(4); ++rep)
            ph_cum2((const float*)(ws + WS_LOGF), (float*)(ws + WS_CUM));
        }
        GRID_BAR();
        for (int rep = 0; rep < REPS(5); ++rep)
        { unsigned char* ws = WSP(); ph_ssm_prefix(lds, (const float*)(ws + WS_SLOC), (const f32x2v*)(ws + WS_APOW) + (size_t)l * G * 65 * P, (bf16_t*)(ws + WS_UP)); }
        GRID_BAR();
        {
            unsigned char* ws = WSP(); float* ssp_s = (float*)(ws + WS_SSP); float* ssp_a = ssp_s + (size_t)T * 8;
            for (int rep = 0; rep < REPS(6); ++rep)
            {
                SchedSsmC S; S.init(ws + WS_UP, (const bf16_t*)(ws + WS_WOUT) + (size_t)l * G * 1024 * 128, (const bf16_t*)(ws + WS_KD) + (size_t)l * G * KDW, ogrid(), obid());
                EpiSsmC E{(bf16_t*)(ws + WS_GEL)};
                ge::gemm_phase<EpiSsmC, SchedSsmC>(lds, S, E, otid());
            }
            GRID_BAR();
            for (int rep = 0; rep < REPS(7); ++rep)
            attn_body::attn_phase<8>((char*)lds_raw, (const attn_body::bf16*)(ws + WS_Q), (const attn_body::bf16*)(ws + WS_K), (const attn_body::bf16*)(ws + WS_V), (const float*)(ws + WS_CUM), (attn_body::bf16*)(ws + WS_MIX), ssp_a, (unsigned*)(ws + WS_CTL) + CW_QUEUE + 64 * (l * 2 + rep), (volatile LAS unsigned*)(lds + MISC_OFF) + 24, otid());
            for (int rep = 0; rep < REPS(8); ++rep) {
            SchedGen S; S.init_plain(ws + WS_GEL, 32, (const bf16_t*)(ws + WS_BT2) + (size_t)l * SSMW * SSMW, SSMW * 2, T, SSMW, SSMW, ogrid(), obid());
            S.a_c16_b = T * 32; S.a_kt_b = 4l * T * 32;
            EpiGlu2 E{(const bf16_t*)(ws + WS_GEL), ARG(12) + l * SSMW, (bf16_t*)(ws + WS_MIX), ssp_s};
            ge::gemm_phase<EpiGlu2, SchedGen>(lds, S, E, otid());
            }
        }
        GRID_BAR();
        {
            unsigned char* ws = WSP(); float* ssp_s = (float*)(ws + WS_SSP); float* ssp_a = ssp_s + (size_t)T * 8; float* ssp_2 = ssp_a + (size_t)T * 8;
            for (int rep = 0; rep < REPS(9); ++rep) {
            const bool dummy = rep + 1 < REPS(9);
            SchedGen S; S.init_plain(ws + WS_MIX, D * 2, (const bf16_t*)(ws + WS_BT3) + (size_t)l * D * D, D * 2, T, D, D, ogrid(), obid());
            EpiWo E{ssp_s, ssp_a, (const bf16_t*)(ws + WS_HB), dummy ? (bf16_t*)(ws + WS_QP) : (bf16_t*)(ws + WS_HB), dummy ? (float*)(ws + WS_SLOC) : ssp_2};
            ge::gemm_phase<EpiWo, SchedGen>(lds, S, E, otid());
            }
        }
        GRID_BAR();
        {
            unsigned char* ws = WSP(); float* ssp_2 = (float*)(ws + WS_SSP) + (size_t)T * 16;
            for (int rep = 0; rep < REPS(10); ++rep) {
            SchedGen S; S.init_plain(ws + WS_HB, D * 2, (const bf16_t*)(ws + WS_BT4) + (size_t)l * D * D, D * 2, T, D, D, ogrid(), obid());
            EpiWq E{ssp_2, (bf16_t*)(ws + WS_QP)};
            ge::gemm_phase<EpiWq, SchedGen>(lds, S, E, otid());
            }
        }
        GRID_BAR();
        for (int rep = 0; rep < REPS(11); ++rep)
        { unsigned char* ws = WSP(); ph_select((const bf16_t*)(ws + WS_QP), (const bf16_t*)(ws + WS_KEYS) + (size_t)l * PH * 2 * NK * HALF, (int*)(ws + WS_IDX), (float*)(ws + WS_GATE), lds); }
        GRID_BAR();
        if (PROBE_MASK & (1 << 16)) { unsigned char* ws = WSP(); ph_peer_u<0>(lds, ws + WS_PU + (size_t)l * NEXP * D, (const bf16_t*)(ws + WS_HB), (const int*)(ws + WS_IDX), (float*)(ws + WS_UP), 1023); }
        for (int rep = 0; rep < REPS(12); ++rep)
        { unsigned char* ws = WSP(); ph_peer_u<0>(lds, ws + WS_PU + (size_t)l * NEXP * D, (const bf16_t*)(ws + WS_HB), (const int*)(ws + WS_IDX), (float*)(ws + WS_PART)); }
        GRID_BAR();
        for (int rep = 0; rep < REPS(13); ++rep)
        { unsigned char* ws = WSP(); ph_peer_coef((const float*)(ws + WS_PART), (const float*)(ws + WS_SSP) + (size_t)T * 16, (const float*)(ws + WS_GATE), (float*)(ws + WS_COEF)); }
        GRID_BAR();
        if (PROBE_MASK & (1 << 17)) { unsigned char* ws = WSP();
          ph_peer_v<0>(lds, ws + WS_PV8 + (size_t)l * NEXP * D, (const int*)(ws + WS_IDX), (const float*)(ws + WS_COEF), (const bf16_t*)(ws + WS_HB), (bf16_t*)(ws + WS_UP), (float*)(ws + WS_SLOC), 1023); }
        for (int rep = 0; rep < REPS(14); ++rep)
        { unsigned char* ws = WSP(); const bool dummy = rep + 1 < REPS(14);
          ph_peer_v<0>(lds, ws + WS_PV8 + (size_t)l * NEXP * D, (const int*)(ws + WS_IDX), (const float*)(ws + WS_COEF), (const bf16_t*)(ws + WS_HB),
                    dummy ? (bf16_t*)(ws + WS_UP) : (bf16_t*)(ws + WS_HB), dummy ? (float*)(ws + WS_SLOC) : (float*)(ws + WS_SSP) + (size_t)T * 32); }
        if (PROBE_MASK & (1 << 15)) { for (int rep = 0; rep < 8; ++rep) GRID_BAR(); }
        GRID_BAR();
    }
    { unsigned char* ws = WSP(); ph_final((const bf16_t*)(ws + WS_HB), (const float*)(ws + WS_SSP) + (size_t)T * 32, ARG(22), (float*)ldarg(lds, 23)); }
}
}

extern "C" void kernel_launch(void* const* d_in, const int* in_sizes, int n_in, void* d_out, int out_size, void* d_ws, size_t ws_size, hipStream_t stream) {
    using namespace nv;
    static int grid_blocks = 0;
    if (!grid_blocks) {
        int dev = 0, cus = 0, per_cu = 0;
        (void)hipGetDevice(&dev);
        (void)hipDeviceGetAttribute(&cus, hipDeviceAttributeMultiprocessorCount, dev);
        if (hipFuncSetAttribute((const void*)k_mega, hipFuncAttributeMaxDynamicSharedMemorySize, LDS_BYTES) != hipSuccess) { fprintf(stderr, "hipFuncSetAttribute failed\n"); grid_blocks = -1; return; }
        (void)hipOccupancyMaxActiveBlocksPerMultiprocessor(&per_cu, (const void*)k_mega, 512, LDS_BYTES);
        if (per_cu < 1) { fprintf(stderr, "occupancy query returned %d\n", per_cu); (void)hipGetLastError(); }
        grid_blocks = cus;
    }
    if (grid_blocks < 0) return;
    if (ws_size < WS_END || n_in != 23) { fprintf(stderr, "bad workspace / inputs\n"); return; }
    (void)hipMemsetAsync((char*)d_ws + WS_CTL, 0, CTL_BYTES, stream);
    Params p{};
    for (int i = 0; i < 23; ++i) p.in[i] = (const float*)d_in[i];
    p.out = (float*)d_out; p.ws = (unsigned char*)d_ws;
    void* args[] = {&p};
    hipError_t e = hipLaunchCooperativeKernel((const void*)k_mega, dim3(grid_blocks), dim3(512), args, LDS_BYTES, stream);
    if (e != hipSuccess) fprintf(stderr, "cooperative launch failed: %s (grid %d)\n", hipGetErrorString(e), grid_blocks);
}
```

```cpp
#include <hip/hip_runtime.h>
#include <hip/hip_cooperative_groups.h>
#include <hip/hip_bf16.h>
#include <cstdint>
#include <cstdio>

#define LAS __attribute__((address_space(3)))
#define GAS __attribute__((address_space(1)))

namespace nv {
constexpr int D = 1024, BATCH = 8, SEQ = 4096, DEPTH = 4, T = BATCH * SEQ;
constexpr int SSMW = 512, G = 32, HC = 16, P = 64, ATTW = 512, HD = 64, NH = 8, INW = 2056;
constexpr int PH = 8, NK = 128, TOPK = 16, QD = 128, HALF = 64, NEXP = 16384;
constexpr int CHUNK = 64, NCH = T / CHUNK  , UPW = 128 + CHUNK * HC  ;
constexpr float EPS = 1e-6f;

typedef short bf16x8 __attribute__((ext_vector_type(8)));
typedef float f32x16 __attribute__((ext_vector_type(16)));
typedef float f32x4 __attribute__((ext_vector_type(4)));
typedef unsigned u32x4 __attribute__((ext_vector_type(4)));
typedef unsigned short bf16_t;

constexpr size_t MiB = 1u << 20;
constexpr size_t WS_CTL = 0, CTL_BYTES = 4 * MiB;
constexpr size_t WS_BT1 = 4 * MiB;
constexpr size_t WS_BT2 = 20 * MiB;
constexpr size_t WS_BT3 = 22 * MiB;
constexpr size_t WS_BT4 = 30 * MiB;
constexpr size_t WS_WF = 38 * MiB;
constexpr size_t WS_KEYS = 39 * MiB;
constexpr size_t WS_KD = 40 * MiB, WS_WOUT = 49 * MiB, WS_WST = 81 * MiB;
constexpr size_t WS_PU = 90 * MiB, WS_PV8 = 154 * MiB;
constexpr size_t WS_PART = 218 * MiB;
constexpr size_t WS_H = 346 * MiB;
constexpr size_t WS_HB = 474 * MiB;
constexpr size_t WS_UP = 538 * MiB;
constexpr size_t WS_Q = 576 * MiB, WS_K = 608 * MiB, WS_V = 640 * MiB;
constexpr size_t WS_LOGF = 672 * MiB, WS_CUM = 673 * MiB;
constexpr size_t WS_SLOC = 674 * MiB, WS_GEL = 708 * MiB, WS_MIX = 740 * MiB;
constexpr size_t WS_SSP = 916 * MiB;
constexpr size_t WS_QP = 852 * MiB;
constexpr size_t WS_IDX = 804 * MiB, WS_GATE = 820 * MiB, WS_COEF = 836 * MiB;
constexpr size_t WS_XN_F = 90 * MiB, WS_MIXED_F = 218 * MiB, WS_QP_F = 852 * MiB, WS_GEL_F = 90 * MiB  , WS_YSSM_F = 740 * MiB, WS_YATT_F = 674 * MiB;
constexpr size_t WS_END = 980 * MiB;
constexpr int CW_QUEUE = 1024;
constexpr int CW_RANK = 2048;
constexpr int CW_BAR = 4096;
constexpr int CW_SS = 65536;
constexpr int SS_H1 = 0  , SS_H2 = 5  , SS_SSM = 9, SS_ATT = 13;
static_assert((size_t)(CW_SS + 17 * T) * 4 <= CTL_BYTES, "ctl region");

__device__ __forceinline__ unsigned short f2bf(float f) { unsigned u = __float_as_uint(f); return (unsigned short)((u + 0x7fffu + ((u >> 16) & 1u)) >> 16); }
__device__ __forceinline__ float bf2f(unsigned short b) { return __uint_as_float(((unsigned)b) << 16); }
__device__ __forceinline__ unsigned pk2(float lo, float hi) { return (unsigned)f2bf(lo) | ((unsigned)f2bf(hi) << 16); }
__device__ __forceinline__ float gelu_tanh(float x) { const float u = 0.7978845608028654f * (x + 0.044715f * x * x * x); return 0.5f * x * (1.f + tanhf(u)); }
__device__ __forceinline__ float wave_sum(float v) {
#pragma unroll
    for (int o = 1; o < 64; o <<= 1) v += __shfl_xor(v, o);
    return v;
}
__device__ __forceinline__ int otid() { int t = threadIdx.x; asm volatile("" : "+v"(t)); return t; }
__device__ __forceinline__ int obid() { int t = blockIdx.x; asm volatile("" : "+s"(t)); return t; }
__device__ __forceinline__ int ogrid() { int t = gridDim.x; asm volatile("" : "+s"(t)); return t; }
#define PH_IDS const int TIDX = otid(), BIDX = obid(), GDIM = ogrid(); (void)TIDX; (void)BIDX; (void)GDIM;
__device__ __forceinline__ size_t up_index(int row, int c) { const int n = row >> 6, j = row & 63, g = c >> 4, hh = c & 15; return ((size_t)g * NCH + n) * UPW + 128 + j * HC + hh; }
}
namespace ge {
#define GE_LAS __attribute__((address_space(3)))
typedef unsigned short bf16_t;
typedef short bf16x8 __attribute__((ext_vector_type(8)));
typedef float f32x4 __attribute__((ext_vector_type(4)));
typedef unsigned u32x4 __attribute__((ext_vector_type(4)));
typedef unsigned u32x2 __attribute__((ext_vector_type(2)));
constexpr int ROWF_OFF = 131072 + 4096;
constexpr int BM = 256, BK = 64, HALF = 128, HTB = HALF * BK * 2  , STAGE_BYTES = 8 * HTB, NXCD = 8, WGM = 8;

__host__ __device__ __forceinline__ int lds_byte(int r, int c) { const int st = (r >> 4) * 2 + (c >> 5), rr = r & 15, cc = c & 31, ob = rr * 64 + cc * 2; return st * 1024 + (ob ^ (((ob >> 9) & 1) << 5)); }
__host__ __device__ __forceinline__ void stage_rc(int b, int& R, int& C) { const int st = b / 1024, sb = b % 1024, swz = sb ^ (((sb >> 9) & 1) << 5); R = (st >> 1) * 16 + swz / 64; C = (st & 1) * 32 + (swz % 64) / 2; }
__host__ __device__ __forceinline__ int perm32(int rho) { const int n = rho >> 4, i = rho & 15; return 8 * (i >> 2) + 4 * n + (i & 3); }

struct Unit { const char* A0; const char* B0; int nt; int pm, pn, aux; };
__device__ __forceinline__ unsigned cvt_pk_bf16(float lo, float hi) { unsigned r; asm volatile("v_cvt_pk_bf16_f32 %0, %1, %2" : "=v"(r) : "v"(lo), "v"(hi)); return r; }

__device__ __forceinline__ bool static_tile(int i, int G, int c, int nM, int nN, int& pm, int& pn) {
    const int nwg = nM * nN; const long L = (long)i * G + c; if (L >= nwg) return false;
    int wgid = (int)L; { const int q = nwg / NXCD, r = nwg % NXCD, xcd = wgid % NXCD, off = wgid / NXCD; wgid = (xcd < r ? xcd * (q + 1) : r * (q + 1) + (xcd - r) * q) + off; }
    const int nig = WGM * nN, gid = wgid / nig, fm = gid * WGM, gsz = (nM - fm) < WGM ? (nM - fm) : WGM;
    pm = fm + ((wgid % nig) % gsz); pn = (wgid % nig) / gsz; return true;
}

template <class Epi, class Sched>
__device__ __forceinline__ void gemm_phase(GE_LAS unsigned char* lds, const Sched& S, const Epi& E, int tid) {
    const int wid = __builtin_amdgcn_readfirstlane(tid >> 6), lane = tid & 63, wr = wid >> 2, wc = wid & 3, fr = lane & 15, fq = lane >> 4;
    unsigned voffA[2], voffB[2], voffB1[2];
#pragma unroll
    for (int i = 0; i < 2; ++i) { int R, C; stage_rc(tid * 16 + i * 8192, R, C); const int Rb = Epi::PERM ? ((R & ~31) + perm32(R & 31)) : R;
        voffA[i] = S.voffA(R, C); voffB[i] = S.voffB(Rb, C); if constexpr (Sched::DUALB) voffB1[i] = S.voffB1(Rb, C); else voffB1[i] = 0u; }
    const long hA = S.hA, hB = S.hB;
    const unsigned ldsw = (unsigned)wid * 1024u;
    const int aoff = lds_byte(wr * 64 + fr, fq * 8), boff = lds_byte(wc * 32 + fr, fq * 8);
#define GE_SA(b, h) (((b) * 2 + (h)) * HTB)
#define GE_SB(b, h) ((4 + (b) * 2 + (h)) * HTB)
#define GE_STAGE(bufoff, gbase, voff) do { _Pragma("unroll") for (int _i = 0; _i < 2; ++_i) \
        __builtin_amdgcn_global_load_lds((const unsigned*)((const char*)(gbase) + (voff)[_i]), (GE_LAS unsigned*)(lds + (bufoff) + ldsw + _i * 8192), 16, 0, 0); } while (0)
#define GE_STAGE_B(bufoff, gbase, sel, half) do { if constexpr (Sched::DUALB) { const char* _g = (const char*)(gbase) + ((half) ? ((sel) ? S.hB1 : hB) : 0l); _Pragma("unroll") for (int _i = 0; _i < 2; ++_i) { const unsigned _v = (sel) ? voffB1[_i] : voffB[_i]; \
        __builtin_amdgcn_global_load_lds((const unsigned*)(_g + _v), (GE_LAS unsigned*)(lds + (bufoff) + ldsw + _i * 8192), 16, 0, 0); } } else { GE_STAGE(bufoff, (const char*)(gbase) + ((half) ? hB : 0l), voffB); } } while (0)
#define GE_LDA(dst, b, h) do { _Pragma("unroll") for (int m = 0; m < 4; ++m) _Pragma("unroll") for (int k = 0; k < 2; ++k) dst[m][k] = *(const GE_LAS bf16x8*)(lds + GE_SA(b, h) + aoff + m * 2048 + k * 1024); } while (0)
#define GE_LDB(dst, b, h) do { _Pragma("unroll") for (int n = 0; n < 2; ++n) _Pragma("unroll") for (int k = 0; k < 2; ++k) dst[n][k] = *(const GE_LAS bf16x8*)(lds + GE_SB(b, h) + boff + n * 2048 + k * 1024); } while (0)
#define GE_MMA(ai, bj, At, Bt) do { __builtin_amdgcn_s_setprio(1); _Pragma("unroll") for (int m = 0; m < 4; ++m) _Pragma("unroll") for (int n = 0; n < 2; ++n) _Pragma("unroll") for (int k = 0; k < 2; ++k) \
        acc[ai][bj][m][n] = __builtin_amdgcn_mfma_f32_16x16x32_bf16(Bt[n][k], At[m][k], acc[ai][bj][m][n], 0, 0, 0); __builtin_amdgcn_s_setprio(0); } while (0)
#define GE_WAIT_V(n) asm volatile("s_waitcnt vmcnt(" #n ")" ::: "memory")
#define GE_WAIT_L(n) asm volatile("s_waitcnt lgkmcnt(" #n ")" ::: "memory")
#define GE_BAR __builtin_amdgcn_s_barrier()
#define GE_SCHED __builtin_amdgcn_sched_barrier(0)
    Unit cur, nxt; int ui = 0;
    if (!S.next(0, cur)) return;
    f32x4 acc[2][2][4][2];
#pragma unroll
    for (int a = 0; a < 2; ++a)
#pragma unroll
        for (int b = 0; b < 2; ++b)
#pragma unroll
            for (int m = 0; m < 4; ++m)
#pragma unroll
                for (int n = 0; n < 2; ++n) acc[a][b][m][n] = (f32x4){0.f, 0.f, 0.f, 0.f};
    bf16x8 At[4][2], B0[2][2], B1[2][2];
    if constexpr (Epi::UBEGIN) E.unit_begin(cur, tid, lds + ROWF_OFF);
    {
        const char* a0 = S.ta(cur, 0); const char* b0 = S.tb(cur, 0); const char* a1 = S.ta(cur, 1); const char* b1 = S.tb(cur, 1);
        const bool s0 = S.sb(cur, 0), s1 = S.sb(cur, 1);
        GE_STAGE_B(GE_SB(0, 0), b0, s0, 0); GE_STAGE_B(GE_SB(0, 1), b0, s0, 1); GE_STAGE(GE_SA(0, 0), a0, voffA); GE_STAGE(GE_SA(0, 1), a0 + hA, voffA);
        if (wr == 1) GE_BAR;
        GE_WAIT_V(2); GE_BAR;
        GE_STAGE_B(GE_SB(1, 0), b1, s1, 0); GE_STAGE(GE_SA(1, 0), a1, voffA); GE_STAGE_B(GE_SB(1, 1), b1, s1, 1);
        GE_WAIT_V(6); GE_BAR;
    }
    for (;;) {
        const bool has_next = S.next(ui + 1, nxt);
        const int nt = cur.nt;
        for (int t = 0; t < nt; t += 2) {
            const bool last = (t == nt - 2);
            const char* a1 = S.ta(cur, t + 1);
            const char* a2 = last ? (has_next ? S.ta(nxt, 0) : S.ta(cur, 0)) : S.ta(cur, t + 2);
            const char* b2 = last ? (has_next ? S.tb(nxt, 0) : S.tb(cur, 0)) : S.tb(cur, t + 2);
            const char* a3 = last ? (has_next ? S.ta(nxt, 1) : S.ta(cur, 1)) : S.ta(cur, t + 3);
            const char* b3 = last ? (has_next ? S.tb(nxt, 1) : S.tb(cur, 1)) : S.tb(cur, t + 3);
            const bool s2 = last ? (has_next ? S.sb(nxt, 0) : S.sb(cur, 0)) : S.sb(cur, t + 2), s3 = last ? (has_next ? S.sb(nxt, 1) : S.sb(cur, 1)) : S.sb(cur, t + 3);
            GE_LDB(B0, 0, 0); GE_LDB(B1, 0, 1); GE_SCHED; GE_LDA(At, 0, 0); GE_STAGE(GE_SA(1, 1), a1 + hA, voffA);
            GE_WAIT_V(8); GE_WAIT_L(0); GE_BAR; GE_MMA(0, 0, At, B0); GE_MMA(0, 1, At, B1); GE_BAR; GE_SCHED;
            GE_LDA(At, 0, 1); GE_STAGE_B(GE_SB(0, 0), b2, s2, 0); GE_STAGE_B(GE_SB(0, 1), b2, s2, 1); GE_STAGE(GE_SA(0, 0), a2, voffA);
            GE_WAIT_V(8); GE_WAIT_L(0); GE_BAR; GE_MMA(1, 0, At, B0); GE_MMA(1, 1, At, B1); GE_BAR; GE_SCHED;
            GE_LDB(B0, 1, 0); GE_LDB(B1, 1, 1); GE_SCHED; GE_LDA(At, 1, 0); GE_STAGE(GE_SA(0, 1), a2 + hA, voffA);
            GE_WAIT_V(8); GE_WAIT_L(0); GE_BAR; GE_MMA(0, 0, At, B0); GE_MMA(0, 1, At, B1); GE_BAR; GE_SCHED;
            GE_LDA(At, 1, 1); GE_STAGE_B(GE_SB(1, 0), b3, s3, 0); GE_STAGE_B(GE_SB(1, 1), b3, s3, 1); GE_STAGE(GE_SA(1, 0), a3, voffA);
            GE_WAIT_V(8); GE_WAIT_L(0); GE_BAR; GE_MMA(1, 0, At, B0); GE_MMA(1, 1, At, B1); GE_BAR; GE_SCHED;
            if constexpr (Epi::MIDK) { if (t + 2 == (nt >> 1)) E.midk(acc, cur, wr, fr, lds + ROWF_OFF + (ui & 1) * 2048); }
        }
        if (wr == 0) GE_BAR;
        E(acc, cur, wr, wc, fr, fq, lds + ROWF_OFF + (ui & 1) * 2048);
        if (!has_next) break;
        if constexpr (Epi::UBEGIN) E.unit_begin(nxt, tid, lds + ROWF_OFF + ((ui + 1) & 1) * 2048);
#pragma unroll
        for (int a = 0; a < 2; ++a)
#pragma unroll
            for (int b = 0; b < 2; ++b)
#pragma unroll
                for (int m = 0; m < 4; ++m)
#pragma unroll
                    for (int n = 0; n < 2; ++n) acc[a][b][m][n] = (f32x4){0.f, 0.f, 0.f, 0.f};
        cur = nxt; ++ui;
        if (wr == 1) GE_BAR;
    }
    GE_WAIT_V(0);
    GE_BAR;
#undef GE_SA
#undef GE_SB
#undef GE_STAGE
#undef GE_STAGE_B
#undef GE_LDA
#undef GE_LDB
#undef GE_MMA
#undef GE_WAIT_V
#undef GE_WAIT_L
#undef GE_BAR
#undef GE_SCHED
}
}
namespace nv {
__device__ __forceinline__ float sum16(const float* p);
__device__ __forceinline__ void ph_rmsnorm(const float* __restrict__ in, int ldi, const float* __restrict__ g, float* __restrict__ out, int ldo, int n, int rows) {
    PH_IDS
    const int lane = TIDX & 63, gw = BIDX * 8 + __builtin_amdgcn_readfirstlane(TIDX >> 6), ngw = GDIM * 8;
    for (int w = gw; w < rows; w += ngw) {
        const float* r = in + (size_t)w * ldi; float* o = out + (size_t)w * ldo;
        float s = 0.f;
        for (int c = lane; c < n; c += 64) { const float v = r[c]; s += v * v; }
        s = wave_sum(s);
        const float rs = rsqrtf(s / (float)n + EPS);
        for (int c = lane; c < n; c += 64) o[c] = r[c] * rs * g[c];
    }
}
__device__ __forceinline__ void ph_make_hb(const float* __restrict__ h, bf16_t* __restrict__ hb, float* __restrict__ ss) {
    PH_IDS
    const int lane = TIDX & 63, gw = BIDX * 8 + __builtin_amdgcn_readfirstlane(TIDX >> 6), ngw = GDIM * 8;
    for (int w = gw; w < T; w += ngw) {
        const f32x4* r = (const f32x4*)(h + (size_t)w * D) + lane; unsigned long long* o = (unsigned long long*)(hb + (size_t)w * D) + lane;
        float s = 0.f;
#pragma unroll
        for (int j = 0; j < 4; ++j) { const f32x4 v = r[64 * j]; s += v.x * v.x + v.y * v.y + v.z * v.z + v.w * v.w; o[64 * j] = (unsigned long long)pk2(v.x, v.y) | ((unsigned long long)pk2(v.z, v.w) << 32); }
        s = wave_sum(s);
        if (lane == 0) ss[w] = s;
    }
}

template <class Epi>
__device__ __forceinline__ void ph_gemm(unsigned char* sm, const float* __restrict__ A, int lda, const float* __restrict__ B, int ldb, int M, int N, int K, Epi epi) {
    PH_IDS
    const int team = TIDX >> 8, tid = TIDX & 255, wave = tid >> 6, lane = tid & 63;
    unsigned short (*As)[40] = (unsigned short (*)[40])(sm + team * 20480); unsigned short (*Bs)[40] = (unsigned short (*)[40])(sm + team * 20480 + 10240);
    const int ntn = (N + 127) / 128, ntiles = ntn * (M / 128);
    const int wm = (wave >> 1) * 64, wn = (wave & 1) * 64;
    for (int it = BIDX; it < ntiles / 2; it += GDIM) {
        const int tile = it * 2 + team, m0 = (tile / ntn) * 128, n0 = (tile % ntn) * 128;
        f32x16 acc[2][2];
#pragma unroll
        for (int i = 0; i < 2; ++i)
#pragma unroll
            for (int j = 0; j < 2; ++j)
#pragma unroll
                for (int r = 0; r < 16; ++r) acc[i][j][r] = 0.f;
        for (int k0 = 0; k0 < K; k0 += 32) {
#pragma unroll
            for (int i = 0; i < 4; ++i) {
                const int idx = tid + i * 256, r = idx >> 3, c = (idx & 7) * 4;
                const float4 v = *(const float4*)(A + (size_t)(m0 + r) * lda + k0 + c);
                As[r][c] = f2bf(v.x); As[r][c + 1] = f2bf(v.y); As[r][c + 2] = f2bf(v.z); As[r][c + 3] = f2bf(v.w);
            }
#pragma unroll
            for (int i = 0; i < 4; ++i) {
                const int idx = tid + i * 256, k = idx >> 5, c = (idx & 31) * 4, n = n0 + c;
                float4 v = make_float4(0.f, 0.f, 0.f, 0.f);
                if (n + 3 < N) v = *(const float4*)(B + (size_t)(k0 + k) * ldb + n);
                Bs[c][k] = f2bf(v.x); Bs[c + 1][k] = f2bf(v.y); Bs[c + 2][k] = f2bf(v.z); Bs[c + 3][k] = f2bf(v.w);
            }
            __syncthreads();
#pragma unroll
            for (int ks = 0; ks < 2; ++ks) {
                bf16x8 a[2], b[2];
#pragma unroll
                for (int i = 0; i < 2; ++i) a[i] = *(const bf16x8*)&As[wm + i * 32 + (lane & 31)][ks * 16 + (lane >> 5) * 8];
#pragma unroll
                for (int j = 0; j < 2; ++j) b[j] = *(const bf16x8*)&Bs[wn + j * 32 + (lane & 31)][ks * 16 + (lane >> 5) * 8];
#pragma unroll
                for (int i = 0; i < 2; ++i)
#pragma unroll
                    for (int j = 0; j < 2; ++j) acc[i][j] = __builtin_amdgcn_mfma_f32_32x32x16_bf16(a[i], b[j], acc[i][j], 0, 0, 0);
            }
            __syncthreads();
        }
#pragma unroll
        for (int i = 0; i < 2; ++i)
#pragma unroll
            for (int j = 0; j < 2; ++j)
#pragma unroll
                for (int r = 0; r < 16; ++r) {
                    const int row = m0 + wm + i * 32 + (r & 3) + 8 * (r >> 2) + 4 * (lane >> 5), col = n0 + wn + j * 32 + (lane & 31);
                    if (col < N) epi(row, col, acc[i][j][r]);
                }
    }
}
struct EpiStore { float* C; int ldc; int pad; __device__ void operator()(int r, int c, float v) const { C[(size_t)r * ldc + c] = v; } };
struct EpiAdd { float* C; int ldc; int pad; __device__ void operator()(int r, int c, float v) const { C[(size_t)r * ldc + c] += v; } };
struct EpiGlu { const float* gel; const float* bias; float* out; __device__ void operator()(int r, int c, float v) const {
    const float gg = gel[(size_t)r * SSMW + c]; out[(size_t)r * SSMW + c] = gg / (1.f + expf(-(v + bias[c]))); } };

__device__ __forceinline__ void ph_ssm(const bf16_t* __restrict__ UP, const float* __restrict__ lam_re, const float* __restrict__ lam_im, const float* __restrict__ log_dt,
                                       const float* __restrict__ b_re, const float* __restrict__ b_im, const float* __restrict__ c_re, const float* __restrict__ c_im,
                                       const float* __restrict__ dsk, bf16_t* __restrict__ gel) {
    PH_IDS
    const int p = TIDX & 63, wv = __builtin_amdgcn_readfirstlane(TIDX >> 6);
    for (int item = BIDX + GDIM * wv; item < BATCH * G; item += GDIM * 8) {
        const int b = item / G, g = item % G;
        const float dt = expf(log_dt[g]);
        const float lr = lam_re[g * P + p], li = lam_im[g * P + p];
        const float mag = expf(lr * dt), are = mag * cosf(li * dt), aim = mag * sinf(li * dt);
        const float den = lr * lr + li * li, nr = are - 1.f;
        const float zre = (nr * lr + aim * li) / den, zim = (aim * lr - nr * li) / den;
        float bbr[HC], bbi[HC], cr[HC], ci[HC];
#pragma unroll
        for (int h = 0; h < HC; ++h) {
            const float br = b_re[(g * P + p) * HC + h], bi = b_im[(g * P + p) * HC + h];
            bbr[h] = zre * br - zim * bi; bbi[h] = zre * bi + zim * br;
            cr[h] = c_re[(g * HC + h) * P + p]; ci[h] = c_im[(g * HC + h) * P + p];
        }
        const float dmine = dsk[g * HC + (p & 15)];
        float sre = 0.f, sim = 0.f;
        for (int t = 0; t < SEQ; ++t) {
            const bf16_t* u = UP + up_index(b * SEQ + t, g * HC);
            float xr = 0.f, xi = 0.f, um = 0.f;
#pragma unroll
            for (int h = 0; h < HC; ++h) { const float uv = bf2f(u[h]); xr += bbr[h] * uv; xi += bbi[h] * uv; if ((p & 15) == h) um = uv; }
            const float nre = are * sre - aim * sim + xr, nim = are * sim + aim * sre + xi;
            sre = nre; sim = nim;
            float ymine = 0.f;
#pragma unroll
            for (int h = 0; h < HC; ++h) { const float v = wave_sum(cr[h] * sre - ci[h] * sim); if ((p & 15) == h) ymine = v; }
            if (p < HC) gel[((size_t)g * T + b * SEQ + t) * HC + p] = f2bf(gelu_tanh(ymine + dmine * um));
        }
    }
}

__device__ __forceinline__ void ph_cum(const float* __restrict__ logf, float* __restrict__ cum) {
    PH_IDS
    if (BIDX != GDIM - 1 || __builtin_amdgcn_readfirstlane(TIDX >> 6) != 7) return;
    const int i = TIDX & 63;
    const int b = i / NH, h = i % NH; float c = 0.f;
    for (int t = 0; t < SEQ; ++t) { c += logf[(size_t)(b * SEQ + t) * NH + h]; cum[(size_t)i * SEQ + t] = c * 1.4426950408889634f; }
}

__device__ __forceinline__ void ph_attn(const bf16_t* __restrict__ Q, const bf16_t* __restrict__ Kb, const bf16_t* __restrict__ Vb, const float* __restrict__ cum, bf16_t* __restrict__ MIX, float* __restrict__ ssp_att) {
    PH_IDS
    const int gw = BIDX * 8 + __builtin_amdgcn_readfirstlane(TIDX >> 6), ngw = GDIM * 8, lane = TIDX & 63;
    constexpr int NIT = BATCH * NH * (SEQ / 64);
    for (int it0 = gw; it0 < NIT; it0 += ngw) {
        const int it = NIT - 1 - it0;
        const int tb = it / (BATCH * NH), bh = it % (BATCH * NH), b = bh / NH, h = bh % NH;
        const int t = tb * 64 + lane;
        float q[HD], o[HD];
#pragma unroll
        for (int d = 0; d < HD; ++d) { q[d] = bf2f(Q[(size_t)(b * SEQ + t) * ATTW + h * HD + d]) * 0.125f; o[d] = 0.f; }
        const float* cm = cum + (size_t)bh * SEQ; const float ct = cm[t];
        float m = -INFINITY, l = 0.f;
        const int smax = tb * 64 + 63;
        for (int s = 0; s <= smax; ++s) {
            const bf16_t* kr = Kb + (size_t)(b * SEQ + s) * ATTW + h * HD; const bf16_t* vr = Vb + (size_t)(b * SEQ + s) * ATTW + h * HD;
            float lg = ct - cm[s];
#pragma unroll
            for (int d = 0; d < HD; ++d) lg += q[d] * bf2f(kr[d]);
            if (s <= t) {
                const float mn = fmaxf(m, lg), sc = expf(m - mn), pp = expf(lg - mn);
                l = l * sc + pp; m = mn;
#pragma unroll
                for (int d = 0; d < HD; ++d) o[d] = o[d] * sc + pp * bf2f(vr[d]);
            }
        }
        const float il = 1.f / l; float sq = 0.f;
#pragma unroll
        for (int d = 0; d < HD; ++d) { const float ov = o[d] * il; sq += ov * ov; MIX[(size_t)(b * SEQ + t) * D + SSMW + h * HD + d] = f2bf(ov); }
        ssp_att[(size_t)(b * SEQ + t) * 8 + h] = sq;
    }
}

__device__ __forceinline__ void ph_peer_select(unsigned char* sm, const bf16_t* __restrict__ qp, const float* __restrict__ keys, int* __restrict__ idx, float* __restrict__ gate) {
    PH_IDS
    const int team = TIDX >> 8, tid = TIDX & 255, lane = tid & 63, wave = tid >> 6;
    float* sc = (float*)(sm + team * 4096); float* tv = sc + 256; int* ti = (int*)(tv + 32); float* cand = (float*)(ti + 32);
    for (int it = BIDX; it < T * PH / 2; it += GDIM) {
        const int item = it * 2 + team, tok = item / PH, hd = item % PH;
        {
            const int half = tid >> 7, n = tid & 127;
            const bf16_t* q = qp + (size_t)tok * D + hd * QD + half * HALF; const float* kk = keys + ((size_t)(hd * 2 + half) * NK + n) * HALF;
            float s = 0.f;
            for (int d = 0; d < HALF; ++d) s += bf2f(q[d]) * kk[d];
            sc[tid] = s;
        }
        __syncthreads();
        if (wave == 0 || wave == 2) {
            const int half = wave >> 1;
            float v0 = sc[half * 128 + lane], v1 = sc[half * 128 + lane + 64];
            for (int k = 0; k < TOPK; ++k) {
                float bv; int bi;
                if (v0 >= v1) { bv = v0; bi = lane; } else { bv = v1; bi = lane + 64; }
#pragma unroll
                for (int o = 1; o < 64; o <<= 1) { const float ov = __shfl_xor(bv, o); const int oi = __shfl_xor(bi, o); if (ov > bv || (ov == bv && oi < bi)) { bv = ov; bi = oi; } }
                if (lane == 0) { tv[half * 16 + k] = bv; ti[half * 16 + k] = bi; }
                if (bi == lane) v0 = -INFINITY; if (bi == lane + 64) v1 = -INFINITY;
            }
        }
        __syncthreads();
        cand[tid] = tv[tid >> 4] + tv[16 + (tid & 15)];
        __syncthreads();
        if (wave == 0) {
            float v[4];
#pragma unroll
            for (int j = 0; j < 4; ++j) v[j] = cand[lane + 64 * j];
            float best = 0.f; int bidx = 0; float mx = 0.f, se = 0.f;
            for (int k = 0; k < TOPK; ++k) {
                float bv = v[0]; int bi = lane;
#pragma unroll
                for (int j = 1; j < 4; ++j) if (v[j] > bv) { bv = v[j]; bi = lane + 64 * j; }
#pragma unroll
                for (int o = 1; o < 64; o <<= 1) { const float ov = __shfl_xor(bv, o); const int oi = __shfl_xor(bi, o); if (ov > bv || (ov == bv && oi < bi)) { bv = ov; bi = oi; } }
                if (k == 0) mx = bv;
                const float e = expf(bv - mx); se += e;
                if (lane == k) { best = e; bidx = ti[bi >> 4] * NK + ti[16 + (bi & 15)]; }
#pragma unroll
                for (int j = 0; j < 4; ++j) if (bi == lane + 64 * j) v[j] = -INFINITY;
            }
            if (lane < TOPK) { idx[(size_t)tok * 128 + hd * TOPK + lane] = bidx; gate[(size_t)tok * 128 + hd * TOPK + lane] = best / se; }
        }
        __syncthreads();
    }
}

__device__ __forceinline__ void ph_peer_eval(unsigned char* sm, const float* __restrict__ ss2, const float* __restrict__ g2, const int* __restrict__ idx, const float* __restrict__ gate,
                                             const float* __restrict__ ut, const float* __restrict__ vt, float* __restrict__ h) {
    PH_IDS
    const int team = TIDX >> 8, tid = TIDX & 255, lane = tid & 63, wave = tid >> 6;
    float (*red)[D] = (float (*)[D])(sm + team * 16384);
    for (int it = BIDX; it < T / 2; it += GDIM) {
        const int tok = it * 2 + team;
        float4 x[4], acc[4];
#pragma unroll
        for (int j = 0; j < 4; ++j) { const float rs = rsqrtf(sum16(ss2 + (size_t)tok * 16) * (1.f / D) + EPS); const float4 hv = *(const float4*)(h + (size_t)tok * D + j * 256 + lane * 4); const float4 gv = *(const float4*)(g2 + j * 256 + lane * 4);
            x[j] = make_float4(hv.x * rs * gv.x, hv.y * rs * gv.y, hv.z * rs * gv.z, hv.w * rs * gv.w); acc[j] = make_float4(0.f, 0.f, 0.f, 0.f); }
        for (int k = 0; k < 32; ++k) {
            const int pr = wave * 32 + k; const int e = idx[(size_t)tok * 128 + pr]; const float gt = gate[(size_t)tok * 128 + pr];
            const float* ur = ut + (size_t)e * D; const float* vr = vt + (size_t)e * D;
            float s = 0.f;
#pragma unroll
            for (int j = 0; j < 4; ++j) { const float4 uv = *(const float4*)(ur + j * 256 + lane * 4); s += uv.x * x[j].x + uv.y * x[j].y + uv.z * x[j].z + uv.w * x[j].w; }
            s = wave_sum(s);
            const float cf = gelu_tanh(s) * gt;
#pragma unroll
            for (int j = 0; j < 4; ++j) { const float4 vv = *(const float4*)(vr + j * 256 + lane * 4); acc[j].x += cf * vv.x; acc[j].y += cf * vv.y; acc[j].z += cf * vv.z; acc[j].w += cf * vv.w; }
        }
#pragma unroll
        for (int j = 0; j < 4; ++j) *(float4*)&red[wave][j * 256 + lane * 4] = acc[j];
        __syncthreads();
        for (int c = tid; c < D; c += 256) h[(size_t)tok * D + c] += red[0][c] + red[1][c] + red[2][c] + red[3][c];
        __syncthreads();
    }
}
}
namespace nv {
__device__ __forceinline__ float sum8(const float* p);
__device__ __forceinline__ float sum16(const float* p);
#define XB_TMO      128
#define XB_XCNT(j)  (256  + 64 * (j))
#define XB_XSUB(j)  (1280 + 64 * (j))
#define XB_XGEN(j)  (2304 + 64 * (j))
#define XB_TOP      3328
#define XB_TOPGEN   3392
#define XCD_BAR_WORDS 3456
#define XB_SPIN_CAP (1u << 24)
__device__ __forceinline__ unsigned xb_ld(unsigned* p)              { return __hip_atomic_load(p, __ATOMIC_RELAXED, __HIP_MEMORY_SCOPE_AGENT); }
__device__ __forceinline__ unsigned xb_add(unsigned* p, unsigned v) { return __hip_atomic_fetch_add(p, v, __ATOMIC_RELAXED, __HIP_MEMORY_SCOPE_AGENT); }
__device__ __forceinline__ unsigned xb_xcc_id() { return (unsigned)__builtin_amdgcn_s_getreg((3 << 11) | 20) & 0xFu; }
#define XB_SPIN(cond, bar) do { unsigned _sp = 0; while (cond) { __builtin_amdgcn_s_sleep(1); \
    if ((++_sp & 255u) == 0u) { if (xb_ld(&(bar)[XB_TMO])) break; if (_sp > XB_SPIN_CAP) { atomicAdd(&(bar)[XB_TMO], 1u); break; } } } } while (0)
struct XcdBarrier { unsigned* bar; unsigned x; volatile LAS unsigned* st; };
__device__ __forceinline__ XcdBarrier xcd_barrier_post(unsigned* bar, volatile LAS unsigned* st) {
    XcdBarrier b; b.bar = bar; b.x = xb_xcc_id(); b.st = st;
    if (threadIdx.x == 0) (void)xb_add(&bar[XB_XCNT(b.x)], 1u);
    return b;
}
__device__ __forceinline__ void xcd_barrier_complete(unsigned* bar, unsigned x, unsigned& nloc, unsigned& nx) {
    const unsigned Gsz = gridDim.x * gridDim.y * gridDim.z;
    unsigned sum, cnt, mine, sp = 0u;
    for (;;) {
        sum = 0u; cnt = 0u; mine = 0u;
#pragma unroll
        for (unsigned j = 0; j < 16; ++j) { const unsigned c = xb_ld(&bar[XB_XCNT(j)]); sum += c; cnt += (c > 0u) ? 1u : 0u; mine = (j == x) ? c : mine; }
        if (sum == Gsz) break;
        __builtin_amdgcn_s_sleep(1);
        if ((++sp & 255u) == 0u) { if (xb_ld(&bar[XB_TMO])) break; if (sp > XB_SPIN_CAP) { atomicAdd(&bar[XB_TMO], 1u); break; } }
    }
    nloc = mine > 0u ? mine : 1u; nx = cnt > 0u ? cnt : 1u;
}
__device__ __forceinline__ void xcd_barrier(const XcdBarrier& b) {
    asm volatile("s_waitcnt vmcnt(0)" ::: "memory");
    __syncthreads();
    if (threadIdx.x == 0) {
        unsigned* bar = b.bar;
        __builtin_amdgcn_s_waitcnt(0);
        unsigned nloc = b.st[0], nx = b.st[1];
        if (nloc == 0u) { xcd_barrier_complete(bar, b.x, nloc, nx); b.st[0] = nloc; b.st[1] = nx; }
        const unsigned old = xb_add(&bar[XB_XSUB(b.x)], 1u);
        const unsigned gen = old / nloc;
        if (old + 1u == (gen + 1u) * nloc) {
            __builtin_amdgcn_fence(__ATOMIC_RELEASE, "agent");
            asm volatile("s_waitcnt vmcnt(0)" ::: "memory");
            const unsigned og = xb_add(&bar[XB_TOP], 1u);
            const unsigned tg = og / nx;
            if (og + 1u == (tg + 1u) * nx) xb_add(&bar[XB_TOPGEN], 1u);
            else XB_SPIN(xb_ld(&bar[XB_TOPGEN]) == tg, bar);
            __builtin_amdgcn_fence(__ATOMIC_ACQUIRE, "agent");
            xb_add(&bar[XB_XGEN(b.x)], 1u);
            asm volatile("s_waitcnt vmcnt(0)" ::: "memory");
        } else {
            XB_SPIN(xb_ld(&bar[XB_XGEN(b.x)]) == gen, bar);
            __builtin_amdgcn_fence(__ATOMIC_ACQUIRE, "agent");
            asm volatile("s_waitcnt vmcnt(0)" ::: "memory");
        }
    }
    __syncthreads();
}

#define LDS_WAIT() asm volatile("s_waitcnt lgkmcnt(0)" ::: "memory")
template <class Sc>
__device__ __forceinline__ void p0_transpose_item(const float* __restrict__ W, int ldw, int K, int Ncols, Sc sc, bf16_t* __restrict__ WT, LAS float* scr, int item, int lane) {
    const int nblk = Ncols / 32, kb = item / nblk, nb = item % nblk, k0 = 64 * kb, n0 = 32 * nb;
#pragma unroll 8
    for (int i = 0; i < 32; ++i) { const int kk = 2 * i + (lane >> 5); scr[kk * 33 + (lane & 31)] = W[(size_t)(k0 + kk) * ldw + n0 + (lane & 31)] * sc(k0 + kk); }
    LDS_WAIT(); asm volatile("" ::: "memory");
    const int c = lane & 7;
#pragma unroll
    for (int j = 0; j < 4; ++j) { const int n = (lane >> 3) + 8 * j; const LAS float* s = scr + (8 * c) * 33 + n;
        u32x4 o; o.x = pk2(s[0 * 33], s[1 * 33]); o.y = pk2(s[2 * 33], s[3 * 33]); o.z = pk2(s[4 * 33], s[5 * 33]); o.w = pk2(s[6 * 33], s[7 * 33]);
        *(u32x4*)(WT + (size_t)(n0 + n) * K + k0 + 8 * c) = o; }
    LDS_WAIT(); asm volatile("" ::: "memory");
}
struct ScVec { const float* g; __device__ __forceinline__ float operator()(int k) const { return g[k]; } };
struct ScOne { __device__ __forceinline__ float operator()(int) const { return 1.f; } };
struct ScTwo { const float* g0; const float* g1; __device__ __forceinline__ float operator()(int k) const { return k < 512 ? g0[k] : g1[k - 512]; } };

constexpr int TAB_OFF = 131072 + 1024;
__device__ __forceinline__ void* ldarg(LAS unsigned char* lds, int i) {
    unsigned off = TAB_OFF + 8 * i; asm volatile("" : "+s"(off));
    const unsigned long long v = *(volatile LAS unsigned long long*)(lds + off);
    const unsigned lo = __builtin_amdgcn_readfirstlane((unsigned)v), hi = __builtin_amdgcn_readfirstlane((unsigned)(v >> 32));
    return (void*)(GAS void*)(((unsigned long long)hi << 32) | lo);
}

__device__ __forceinline__ void p0_prologue(LAS unsigned char* lds) {
    PH_IDS
    const int lane = TIDX & 63, wave = __builtin_amdgcn_readfirstlane(TIDX >> 6), gw = BIDX * 8 + wave, ngw = GDIM * 8;
    LAS float* scr = (LAS float*)(lds + wave * 16384);
    unsigned char* ws = (unsigned char*)ldarg(lds, 24);
    const float* a0 = (const float*)ldarg(lds, 0); const float* a1 = (const float*)ldarg(lds, 1); const float* a2 = (const float*)ldarg(lds, 2); const float* a11 = (const float*)ldarg(lds, 11);
    const float* a14 = (const float*)ldarg(lds, 14); const float* a15 = (const float*)ldarg(lds, 15); const float* a16 = (const float*)ldarg(lds, 16); const float* a17 = (const float*)ldarg(lds, 17); const float* a18 = (const float*)ldarg(lds, 18);
    constexpr int I1 = (D / 64) * (2048 / 32), I2 = (SSMW / 64) * (SSMW / 32), I3 = (D / 64) * (D / 32), I4 = I3, IL = I1 + I2 + I3 + I4;
    for (int it = gw; it < DEPTH * IL; it += ngw) {
        const int l = it / IL; int r = it % IL;
        if (r < I1) { p0_transpose_item(a2 + (size_t)l * D * INW, INW, D, 2048, ScVec{a1 + l * D}, (bf16_t*)(ws + WS_BT1) + (size_t)l * 2048 * D, scr, r, lane); continue; } r -= I1;
        if (r < I2) { p0_transpose_item(a11 + (size_t)l * SSMW * SSMW, SSMW, SSMW, SSMW, ScOne{}, (bf16_t*)(ws + WS_BT2) + (size_t)l * SSMW * SSMW, scr, r, lane); continue; } r -= I2;
        if (r < I3) { p0_transpose_item(a16 + (size_t)l * D * D, D, D, D, ScTwo{a14 + l * SSMW, a15 + l * ATTW}, (bf16_t*)(ws + WS_BT3) + (size_t)l * D * D, scr, r, lane); continue; } r -= I3;
        p0_transpose_item(a18 + (size_t)l * D * D, D, D, D, ScVec{a17 + l * D}, (bf16_t*)(ws + WS_BT4) + (size_t)l * D * D, scr, r, lane);
    }
    for (int i = BIDX * 512 + TIDX; i < DEPTH * 16 * D; i += GDIM * 512) {
        const int l = i / (16 * D), j = (i / D) % 16, k = i % D;
        const float v = j < 8 ? a2[((size_t)l * D + k) * INW + 2048 + j] * a1[l * D + k] : 0.f;
        ((bf16_t*)(ws + WS_WF))[i] = f2bf(v);
    }
    {
        const float* x = a0; bf16_t* hb = (bf16_t*)(ws + WS_HB); float* ssp1 = (float*)(ws + WS_SSP) + (size_t)T * 32;
        for (int w = gw; w < T; w += ngw) {
            const f32x4* r = (const f32x4*)(x + (size_t)w * D) + lane; unsigned long long* o = (unsigned long long*)(hb + (size_t)w * D) + lane;
            float s = 0.f;
#pragma unroll
            for (int j = 0; j < 4; ++j) { const f32x4 v = r[64 * j]; const unsigned w0 = pk2(v.x, v.y), w1 = pk2(v.z, v.w); o[64 * j] = (unsigned long long)w0 | ((unsigned long long)w1 << 32);
                const float a = __uint_as_float(w0 << 16), b = __uint_as_float(w0 & 0xffff0000u), c = __uint_as_float(w1 << 16), d = __uint_as_float(w1 & 0xffff0000u); s += (a * a + b * b) + (c * c + d * d); }
            s = wave_sum(s);
            if (lane < 8) ssp1[(size_t)w * 8 + lane] = lane == 0 ? s : 0.f;
        }
    }
}

struct SchedGen {
    static constexpr bool DUALB = false; long hB1;
    __device__ __forceinline__ bool sb(const ge::Unit&, int) const { return false; }
    __device__ __forceinline__ unsigned voffB1(int, int) const { return 0u; }
    const char* A; const char* B; int a_row_b, a_c16_b, b_row_b, b_c16_b; long a_pm_b, a_kt_b, b_pn_b, b_kt_b; int nM, nN, nt, G, c; long hA, hB;
    __device__ __forceinline__ void init_plain(const void* A_, int lda_bytes, const void* B_, int ldb_bytes, int M, int N, int K, int G_, int c_) {
        A = (const char*)A_; B = (const char*)B_; a_row_b = lda_bytes; a_c16_b = 32; b_row_b = ldb_bytes; b_c16_b = 32; a_pm_b = 256l * lda_bytes; a_kt_b = 128; b_pn_b = 256l * ldb_bytes; b_kt_b = 128;
        nM = M / 256; nN = N / 256; nt = K / 64; G = G_; c = c_; hA = 128l * lda_bytes; hB = 128l * ldb_bytes; }
    __device__ __forceinline__ bool next(int i, ge::Unit& u) const {
        int pm, pn; if (!ge::static_tile(i, G, c, nM, nN, pm, pn)) return false;
        u.A0 = A + (size_t)pm * a_pm_b; u.B0 = B + (size_t)pn * b_pn_b; u.nt = nt; u.pm = pm; u.pn = pn; u.aux = 0; return true; }
    __device__ __forceinline__ const char* ta(const ge::Unit& u, int t) const { return u.A0 + t * a_kt_b; }
    __device__ __forceinline__ const char* tb(const ge::Unit& u, int t) const { return u.B0 + t * b_kt_b; }
    __device__ __forceinline__ unsigned voffA(int R, int C) const { return (unsigned)(R * a_row_b + (C >> 4) * a_c16_b + (C & 15) * 2); }
    __device__ __forceinline__ unsigned voffB(int Rb, int C) const { return (unsigned)(Rb * b_row_b + (C >> 4) * b_c16_b + (C & 15) * 2); }
};
typedef SchedGen SchedPlain;

constexpr float QSCALE = 0.125f * 1.4426950408889634f;
struct EpiInProj {
    static constexpr bool PERM = true, MIDK = false, UBEGIN = true;
    const float* ssp1; bf16_t* UP; bf16_t* QKV;
    __device__ __forceinline__ void unit_begin(const ge::Unit& u, int tid, LAS unsigned char* rowf) const {
        if (tid < 256) { const int row = u.pm * 256 + tid; ((LAS float*)rowf)[tid] = rsqrtf(sum8(ssp1 + (size_t)row * 8) * (1.f / D) + EPS); }
    }
    __device__ __forceinline__ void midk(ge::f32x4 (&)[2][2][4][2], const ge::Unit&, int, int, LAS unsigned char*) const {}
    __device__ __forceinline__ void operator()(const ge::f32x4 (&acc)[2][2][4][2], const ge::Unit& u, int wr, int wc, int fr, int fq, LAS unsigned char* rowf) const {
        const int row0 = u.pm * 256 + wr * 64 + fr, colt = u.pn * 256, region = colt >> 9;
        bf16_t* dstb = QKV + (size_t)(region - 1) * ((WS_K - WS_Q) / 2);
#pragma unroll
        for (int ai = 0; ai < 2; ++ai)
#pragma unroll
            for (int m = 0; m < 4; ++m) {
                const int row = row0 + ai * 128 + m * 16; const float rs = ((const LAS float*)rowf)[ai * 128 + wr * 64 + m * 16 + fr];
#pragma unroll
                for (int bj = 0; bj < 2; ++bj) {
                    const int c = (colt & 511) + bj * 128 + wc * 32 + 8 * fq;
                    const float rq = region == 1 ? rs * QSCALE : rs;
                    const ge::f32x4 v0 = acc[ai][bj][m][0] * rq, v1 = acc[ai][bj][m][1] * rq;
                    u32x4 w; w.x = ge::cvt_pk_bf16(v0[0], v0[1]); w.y = ge::cvt_pk_bf16(v0[2], v0[3]); w.z = ge::cvt_pk_bf16(v1[0], v1[1]); w.w = ge::cvt_pk_bf16(v1[2], v1[3]);
                    bf16_t* dst = region == 0 ? UP + up_index(row, c) : dstb + (size_t)row * 512 + c;
                    *(u32x4*)dst = w;
                }
            }
    }
};

__device__ __forceinline__ float sum8(const float* p) { const ge::f32x4 a = *(const ge::f32x4*)p, b = *(const ge::f32x4*)(p + 4); return ((a[0] + a[1]) + (a[2] + a[3])) + ((b[0] + b[1]) + (b[2] + b[3])); }
__device__ __forceinline__ float sum16(const float* p) { return sum8(p) + sum8(p + 8); }
__device__ __forceinline__ size_t gel_index(int row, int c) { return ((size_t)(c >> 4) * T + row) * HC + (c & 15); }
__device__ __forceinline__ float sigmoidf_(float x) { return 1.f / (1.f + __expf(-x)); }
struct EpiGlu2 {
    static constexpr bool PERM = true, MIDK = false, UBEGIN = false;
    const bf16_t* GEL; const float* bias; bf16_t* MIX; float* ssp;
    __device__ __forceinline__ void unit_begin(const ge::Unit&, int, LAS unsigned char*) const {}
    __device__ __forceinline__ void midk(ge::f32x4 (&)[2][2][4][2], const ge::Unit&, int, int, LAS unsigned char*) const {}
    __device__ __forceinline__ void operator()(const ge::f32x4 (&acc)[2][2][4][2], const ge::Unit& u, int wr, int wc, int fr, int fq, LAS unsigned char*) const {
        const int row0 = u.pm * 256 + wr * 64 + fr, colt = u.pn * 256;
#pragma unroll
        for (int ai = 0; ai < 2; ++ai)
#pragma unroll
            for (int m = 0; m < 4; ++m) {
                const int row = row0 + ai * 128 + m * 16; float sq = 0.f;
#pragma unroll
                for (int bj = 0; bj < 2; ++bj) {
                    const int c = colt + bj * 128 + wc * 32 + 8 * fq;
                    const ge::f32x4 b0 = *(const ge::f32x4*)(bias + c), b1 = *(const ge::f32x4*)(bias + c + 4);
                    const u32x4 gw = *(const u32x4*)(GEL + gel_index(row, c));
                    const ge::f32x4 v0 = acc[ai][bj][m][0] + b0, v1 = acc[ai][bj][m][1] + b1;
                    float o[8];
                    o[0] = __uint_as_float(gw.x << 16) * sigmoidf_(v0[0]); o[1] = __uint_as_float(gw.x & 0xffff0000u) * sigmoidf_(v0[1]);
                    o[2] = __uint_as_float(gw.y << 16) * sigmoidf_(v0[2]); o[3] = __uint_as_float(gw.y & 0xffff0000u) * sigmoidf_(v0[3]);
                    o[4] = __uint_as_float(gw.z << 16) * sigmoidf_(v1[0]); o[5] = __uint_as_float(gw.z & 0xffff0000u) * sigmoidf_(v1[1]);
                    o[6] = __uint_as_float(gw.w << 16) * sigmoidf_(v1[2]); o[7] = __uint_as_float(gw.w & 0xffff0000u) * sigmoidf_(v1[3]);
#pragma unroll
                    for (int e = 0; e < 8; ++e) sq += o[e] * o[e];
                    u32x4 w; w.x = ge::cvt_pk_bf16(o[0], o[1]); w.y = ge::cvt_pk_bf16(o[2], o[3]); w.z = ge::cvt_pk_bf16(o[4], o[5]); w.w = ge::cvt_pk_bf16(o[6], o[7]);
                    *(u32x4*)(MIX + (size_t)row * D + c) = w;
                }
                sq += __shfl_xor(sq, 16); sq += __shfl_xor(sq, 32);
                if (fq == 0) ssp[(size_t)row * 8 + u.pn * 4 + wc] = sq;
            }
    }
};
struct EpiWo {
    static constexpr bool PERM = true, MIDK = true, UBEGIN = true;
    const float* ssp_s; const float* ssp_a; const bf16_t* hin; bf16_t* hb; float* ssp2;
    typedef float f32x2_ __attribute__((ext_vector_type(2)));
    __device__ __forceinline__ void unit_begin(const ge::Unit& u, int tid, LAS unsigned char* rowf) const {
        if (tid < 256) { const int row = u.pm * 256 + tid;
            const float rs_s = rsqrtf(sum8(ssp_s + (size_t)row * 8) * (1.f / SSMW) + EPS), rs_a = rsqrtf(sum8(ssp_a + (size_t)row * 8) * (1.f / ATTW) + EPS);
            ((LAS f32x2_*)rowf)[tid] = (f32x2_){rs_s / rs_a, rs_a}; }
    }
    __device__ __forceinline__ void midk(ge::f32x4 (&acc)[2][2][4][2], const ge::Unit& u, int wr, int fr, LAS unsigned char* rowf) const {
#pragma unroll
        for (int ai = 0; ai < 2; ++ai)
#pragma unroll
            for (int m = 0; m < 4; ++m) {
                const float f = ((const LAS f32x2_*)rowf)[ai * 128 + wr * 64 + m * 16 + fr].x;
#pragma unroll
                for (int bj = 0; bj < 2; ++bj)
#pragma unroll
                    for (int n = 0; n < 2; ++n) acc[ai][bj][m][n] = acc[ai][bj][m][n] * f;
            }
    }
    __device__ __forceinline__ void operator()(const ge::f32x4 (&acc)[2][2][4][2], const ge::Unit& u, int wr, int wc, int fr, int fq, LAS unsigned char* rowf) const {
        const int row0 = u.pm * 256 + wr * 64 + fr, colt = u.pn * 256;
#pragma unroll
        for (int ai = 0; ai < 2; ++ai)
#pragma unroll
            for (int m = 0; m < 4; ++m) {
                const int row = row0 + ai * 128 + m * 16; const float ra = ((const LAS f32x2_*)rowf)[ai * 128 + wr * 64 + m * 16 + fr].y; float sq = 0.f;
#pragma unroll
                for (int bj = 0; bj < 2; ++bj) {
                    const int c = colt + bj * 128 + wc * 32 + 8 * fq;
                    const size_t o = (size_t)row * D + c;
                    const u32x4 hw = *(const u32x4*)(hin + o);
                    const ge::f32x4 a0 = acc[ai][bj][m][0] * ra, a1 = acc[ai][bj][m][1] * ra;
                    u32x4 w; w.x = ge::cvt_pk_bf16(__uint_as_float(hw.x << 16) + a0[0], __uint_as_float(hw.x & 0xffff0000u) + a0[1]); w.y = ge::cvt_pk_bf16(__uint_as_float(hw.y << 16) + a0[2], __uint_as_float(hw.y & 0xffff0000u) + a0[3]);
                    w.z = ge::cvt_pk_bf16(__uint_as_float(hw.z << 16) + a1[0], __uint_as_float(hw.z & 0xffff0000u) + a1[1]); w.w = ge::cvt_pk_bf16(__uint_as_float(hw.w << 16) + a1[2], __uint_as_float(hw.w & 0xffff0000u) + a1[3]);
                    *(u32x4*)(hb + o) = w;
#pragma unroll
                    for (int e = 0; e < 4; ++e) { const float lo = __uint_as_float(w[e] << 16), hi = __uint_as_float(w[e] & 0xffff0000u); sq += lo * lo + hi * hi; }
                }
                sq += __shfl_xor(sq, 16); sq += __shfl_xor(sq, 32);
                if (fq == 0) ssp2[(size_t)row * 16 + u.pn * 4 + wc] = sq;
            }
    }
};
struct EpiWq {
    static constexpr bool PERM = true, MIDK = false, UBEGIN = true;
    const float* ssp2; bf16_t* QP;
    __device__ __forceinline__ void unit_begin(const ge::Unit& u, int tid, LAS unsigned char* rowf) const {
        if (tid < 256) { const int row = u.pm * 256 + tid; ((LAS float*)rowf)[tid] = rsqrtf(sum16(ssp2 + (size_t)row * 16) * (1.f / D) + EPS); }
    }
    __device__ __forceinline__ void midk(ge::f32x4 (&)[2][2][4][2], const ge::Unit&, int, int, LAS unsigned char*) const {}
    __device__ __forceinline__ void operator()(const ge::f32x4 (&acc)[2][2][4][2], const ge::Unit& u, int wr, int wc, int fr, int fq, LAS unsigned char* rowf) const {
        const int row0 = u.pm * 256 + wr * 64 + fr, colt = u.pn * 256;
#pragma unroll
        for (int ai = 0; ai < 2; ++ai)
#pragma unroll
            for (int m = 0; m < 4; ++m) {
                const int row = row0 + ai * 128 + m * 16; const float rs = ((const LAS float*)rowf)[ai * 128 + wr * 64 + m * 16 + fr];
#pragma unroll
                for (int bj = 0; bj < 2; ++bj) {
                    const int c = colt + bj * 128 + wc * 32 + 8 * fq;
                    const ge::f32x4 v0 = acc[ai][bj][m][0] * rs, v1 = acc[ai][bj][m][1] * rs;
                    u32x4 w; w.x = ge::cvt_pk_bf16(v0[0], v0[1]); w.y = ge::cvt_pk_bf16(v0[2], v0[3]); w.z = ge::cvt_pk_bf16(v1[0], v1[1]); w.w = ge::cvt_pk_bf16(v1[2], v1[3]);
                    *(u32x4*)(QP + (size_t)row * D + c) = w;
                }
            }
    }
};

__device__ __forceinline__ void ph_flogit(const bf16_t* __restrict__ hb, const bf16_t* __restrict__ wf, const float* __restrict__ ss, const float* __restrict__ bfv, float* __restrict__ logf) {
    PH_IDS
    const int lane = TIDX & 63, gw = BIDX * 8 + __builtin_amdgcn_readfirstlane(TIDX >> 6), ngw = GDIM * 8, r16 = lane & 15, q4 = lane >> 4;
    for (int item = gw; item < T / 16; item += ngw) {
        const int tok0 = item * 16;
        ge::f32x4 acc = {0.f, 0.f, 0.f, 0.f};
        const bf16_t* ar = hb + (size_t)(tok0 + r16) * D + q4 * 8; const bf16_t* br = wf + (size_t)r16 * D + q4 * 8;
#pragma unroll 8
        for (int ks = 0; ks < D / 32; ++ks) {
            const bf16x8 a = *(const bf16x8*)(ar + ks * 32), b = *(const bf16x8*)(br + ks * 32);
            acc = __builtin_amdgcn_mfma_f32_16x16x32_bf16(a, b, acc, 0, 0, 0);
        }
        if (r16 < NH) {
            const float bj = bfv[r16];
#pragma unroll
            for (int r = 0; r < 4; ++r) {
                const int tok = tok0 + 4 * q4 + r; const float x = acc[r] * rsqrtf(sum8(ss + (size_t)tok * 8) * (1.f / D) + EPS) + bj;
                logf[(size_t)tok * NH + r16] = fminf(x, 0.f) - log1pf(expf(-fabsf(x)));
            }
        }
    }
}
}
namespace nv {
__device__ __forceinline__ float gelu_fast(float x);
constexpr float USCALE = 256.f, VSCALE = 16.f;
typedef float f32x2 __attribute__((ext_vector_type(2)));
typedef int i32x2 __attribute__((ext_vector_type(2)));
__device__ __forceinline__ float clamp448(float x) { return fminf(fmaxf(x, -448.f), 448.f); }
__device__ __forceinline__ unsigned pack4_fp8(float a, float b, float c, float d) {
    int w = 0; w = __builtin_amdgcn_cvt_pk_fp8_f32(clamp448(a), clamp448(b), w, false); w = __builtin_amdgcn_cvt_pk_fp8_f32(clamp448(c), clamp448(d), w, true); return (unsigned)w; }

__device__ __forceinline__ void peer_split(LAS unsigned char* lds, int bid, int grid, int wave, int& slice, int& gw, int& ngw) {
    volatile LAS unsigned* M = (volatile LAS unsigned*)(lds + 131072 + 320);
    const unsigned x = __builtin_amdgcn_readfirstlane(M[16]), rk = __builtin_amdgcn_readfirstlane(M[17]), nl = __builtin_amdgcn_readfirstlane(M[18]), ok = __builtin_amdgcn_readfirstlane(M[19]);
    if (ok) { slice = (int)x; gw = (int)rk * 8 + wave; ngw = (int)nl * 8; }
    else { slice = bid & 7; gw = (bid >> 3) * 8 + wave; ngw = (grid >> 3) * 8; }
}
__device__ __forceinline__ void p0_peer_tables(const float* __restrict__ pu, const float* __restrict__ pv, const float* __restrict__ g2, unsigned char* __restrict__ PU8, unsigned char* __restrict__ PV8) {
    PH_IDS
    const size_t n16 = (size_t)DEPTH * NEXP * D / 16;
    for (size_t i = (size_t)BIDX * 512 + TIDX; i < 2 * n16; i += (size_t)GDIM * 512) {
        const bool isv = i >= n16; const size_t j = isv ? i - n16 : i; const size_t e0 = j * 16;
        const float* src = (isv ? pv : pu) + e0;
        const int l = (int)(e0 / ((size_t)NEXP * D)), c = (int)(e0 % D);
        f32x4 x[4];
#pragma unroll
        for (int k = 0; k < 4; ++k) x[k] = *(const f32x4*)(src + 4 * k);
        u32x4 o;
        if (isv) {
#pragma unroll
            for (int k = 0; k < 4; ++k) o[k] = pack4_fp8(x[k].x * VSCALE, x[k].y * VSCALE, x[k].z * VSCALE, x[k].w * VSCALE);
        } else {
#pragma unroll
            for (int k = 0; k < 4; ++k) { const f32x4 g = *(const f32x4*)(g2 + l * D + c + 4 * k) * USCALE; o[k] = pack4_fp8(x[k].x * g.x, x[k].y * g.y, x[k].z * g.z, x[k].w * g.w); }
        }
        const size_t er = (e0 / D) % NEXP;
        *(u32x4*)((isv ? PV8 : PU8) + (((size_t)l * 8 + (c >> 7)) * NEXP + er) * 128 + (c & 127)) = o;
    }
}

constexpr int PB = 16;
#define DPPF(x, CTRL) __int_as_float(__builtin_amdgcn_update_dpp(0, __float_as_int(x), (CTRL), 0xF, 0xF, true))
template <int MODE = 0>
__device__ __forceinline__ void ph_peer_u(LAS unsigned char* lds, const unsigned char* __restrict__ PU8, const bf16_t* __restrict__ hb, const int* __restrict__ idx, float* __restrict__ partial, int imask = 0x7fffffff) {
    PH_IDS
    const int lane = TIDX & 63, wave = __builtin_amdgcn_readfirstlane(TIDX >> 6), c8 = lane & 7, rg = lane >> 3;
    int slice, gw, ngw; peer_split(lds, BIDX, GDIM, wave, slice, gw, ngw);
    const unsigned char* tab = PU8 + (size_t)slice * NEXP * 128; const unsigned lo16 = 16u * c8;
    LAS int* li = (LAS int*)(lds + wave * 12288);
    LAS u32x4* lh = (LAS u32x4*)(lds + wave * 12288 + 8192);
    LAS float* tr = (LAS float*)(lds + 8 * 12288 + wave * 512);
    const int ntok = gw < T ? (T - gw + ngw - 1) / ngw : 0;
    const int p0 = 2 * lane, sd0 = (p0 >> 6) * 64 + (p0 & 7) * 8 + ((p0 & 63) >> 3), sd1 = sd0 + 8;
    const bool b2 = (c8 & 4) != 0, b1 = (c8 & 2) != 0, b0 = (c8 & 1) != 0;
    const int i0 = 8 * (int)b2 + 4 * (int)b0 + 2 * (int)b1;
    for (int tb = 0; tb < ntok; tb += PB) {
        const int nb = min(PB, ntok - tb);
        for (int k = 0; k < nb; ++k) {
            const size_t t = (size_t)gw + (size_t)(tb + k) * ngw;
            i32x2 v = *(const i32x2*)(idx + t * 128 + 2 * lane); v.x &= imask; v.y &= imask; li[k * 128 + sd0] = v.x; li[k * 128 + sd1] = v.y;
            if (lane < 16) lh[k * 16 + lane] = *(const u32x4*)(hb + t * D + 128 * slice + 8 * lane);
        }
        asm volatile("s_waitcnt vmcnt(0) lgkmcnt(0)" ::: "memory");
        const int nstep = 4 * nb;
        u32x4 rb[8][4]; float pv[16], hx[16];
#define PU_ISSUE(s, B) do { const ge::u32x4 ia_ = *(const LAS ge::u32x4*)(li + ((s) >> 1) * 64 + rg * 8 + 4 * ((s) & 1)); \
            _Pragma("unroll") for (int i_ = 0; i_ < 4; ++i_) rb[B][i_] = *(const u32x4*)(tab + (ia_[i_] * 128u + lo16)); } while (0)
#define PU_STEP(s, B, QT) do { if ((s) < nstep) { if ((s) + 7 < nstep) PU_ISSUE((s) + 7, ((B) + 7) & 7); \
            const int k_ = (s) >> 2; const size_t t_ = (size_t)gw + (size_t)(tb + k_) * ngw; \
            if (QT == 0) { const u32x4 w0 = lh[k_ * 16 + 2 * c8], w1 = lh[k_ * 16 + 2 * c8 + 1];          \
                _Pragma("unroll") for (int j = 0; j < 4; ++j) { hx[2 * j] = __uint_as_float(w0[j] << 16); hx[2 * j + 1] = __uint_as_float(w0[j] & 0xffff0000u); hx[8 + 2 * j] = __uint_as_float(w1[j] << 16); hx[9 + 2 * j] = __uint_as_float(w1[j] & 0xffff0000u); } } \
            _Pragma("unroll") for (int i = 0; i < 4; ++i) { float d0 = 0.f, d1 = 0.f; _Pragma("unroll") for (int k = 0; k < 4; ++k) { \
                const f32x2 q0 = __builtin_amdgcn_cvt_pk_f32_fp8((int)rb[B][i][k], false), q1 = __builtin_amdgcn_cvt_pk_f32_fp8((int)rb[B][i][k], true); \
                d0 += q0.x * hx[4 * k] + q1.x * hx[4 * k + 2]; d1 += q0.y * hx[4 * k + 1] + q1.y * hx[4 * k + 3]; } pv[4 * QT + i] = d0 + d1; } \
            if (QT == 3) { float y[8], z[4]; \
                _Pragma("unroll") for (int j = 0; j < 8; ++j) { const float keep = b2 ? pv[8 + j] : pv[j], send = b2 ? pv[j] : pv[8 + j]; y[j] = keep + DPPF(send, 0x141); }       \
                _Pragma("unroll") for (int j = 0; j < 4; ++j) { const float keep = b0 ? y[4 + j] : y[j], send = b0 ? y[j] : y[4 + j]; z[j] = keep + DPPF(send, 0xB1); }          \
                const float o0 = (b1 ? z[2] : z[0]) + DPPF(b1 ? z[0] : z[2], 0x4E), o1 = (b1 ? z[3] : z[1]) + DPPF(b1 ? z[1] : z[3], 0x4E);                                    \
                  \
                tr[8 * i0 + rg] = o0; tr[8 * i0 + 8 + rg] = o1; const f32x2 ov_ = *(const LAS f32x2*)(tr + 2 * lane); \
                *(f32x2*)(partial + ((size_t)slice * T + t_) * 128 + 2 * lane) = ov_; } } } while (0)
        PU_ISSUE(0, 0); PU_ISSUE(1, 1); PU_ISSUE(2, 2); PU_ISSUE(3, 3); if (4 < nstep) { PU_ISSUE(4, 4); PU_ISSUE(5, 5); PU_ISSUE(6, 6); }
        for (int s0 = 0; s0 < nstep; s0 += 8) { PU_STEP(s0, 0, 0); PU_STEP(s0 + 1, 1, 1); PU_STEP(s0 + 2, 2, 2); PU_STEP(s0 + 3, 3, 3); PU_STEP(s0 + 4, 4, 0); PU_STEP(s0 + 5, 5, 1); PU_STEP(s0 + 6, 6, 2); PU_STEP(s0 + 7, 7, 3); }
#undef PU_ISSUE
#undef PU_STEP
        asm volatile("s_waitcnt lgkmcnt(0)" ::: "memory");
    }
}

__device__ __forceinline__ void ph_peer_coef(const float* __restrict__ partial, const float* __restrict__ ssp2, const float* __restrict__ gate, float* __restrict__ coef) {
    PH_IDS
    const size_t n4 = (size_t)T * 128 / 4, stride = (size_t)GDIM * 512;
    for (size_t i0 = (size_t)BIDX * 512 + TIDX; i0 < n4; i0 += 2 * stride) {
        f32x4 pv[2][8], gv[2]; float rs[2];
#pragma unroll
        for (int u = 0; u < 2; ++u) { const size_t i = i0 + u * stride;
            if (i < n4) {
#pragma unroll
                for (int k = 0; k < 8; ++k) pv[u][k] = *(const f32x4*)(partial + (size_t)k * T * 128 + 4 * i);
                gv[u] = *(const f32x4*)(gate + 4 * i); rs[u] = sum16(ssp2 + (i >> 5) * 16);
            } }
#pragma unroll
        for (int u = 0; u < 2; ++u) { const size_t i = i0 + u * stride;
            if (i < n4) {
                f32x4 s = ((pv[u][0] + pv[u][1]) + (pv[u][2] + pv[u][3])) + ((pv[u][4] + pv[u][5]) + (pv[u][6] + pv[u][7]));
                const float sc = rsqrtf(rs[u] * (1.f / D) + EPS) * (1.f / USCALE);
                f32x4 o; o.x = gelu_fast(s.x * sc) * gv[u].x; o.y = gelu_fast(s.y * sc) * gv[u].y; o.z = gelu_fast(s.z * sc) * gv[u].z; o.w = gelu_fast(s.w * sc) * gv[u].w;
                *(f32x4*)(coef + 4 * i) = o;
            } }
    }
}

__device__ __forceinline__ float dpp_ror8(float x) { return __int_as_float(__builtin_amdgcn_update_dpp(0, __float_as_int(x), 0x128, 0xF, 0xF, true)); }
template <int MODE = 0>
__device__ __forceinline__ void ph_peer_v(LAS unsigned char* lds, const unsigned char* __restrict__ PV8, const int* __restrict__ idx, const float* __restrict__ coef, const bf16_t* hin, bf16_t* hb, float* __restrict__ ssp1, int imask = 0x7fffffff) {
    PH_IDS
    const int lane = TIDX & 63, wave = __builtin_amdgcn_readfirstlane(TIDX >> 6), c8 = lane & 7, rg = lane >> 3;
    int slice, gw, ngw; peer_split(lds, BIDX, GDIM, wave, slice, gw, ngw);
    const unsigned char* tab = PV8 + (size_t)slice * NEXP * 128; const unsigned lo16 = 16u * c8;
    LAS int* li = (LAS int*)(lds + wave * 16384);
    LAS float* lc = (LAS float*)(lds + wave * 16384 + 8192);
    const int ntok = gw < T ? (T - gw + ngw - 1) / ngw : 0;
    const int p0 = 2 * lane, sd0 = (p0 >> 6) * 64 + (p0 & 7) * 8 + ((p0 & 63) >> 3), sd1 = sd0 + 8;
    const int wown = 8 * c8 + rg;
    for (int tb = 0; tb < ntok; tb += PB) {
        const int nb = min(PB, ntok - tb);
        for (int k = 0; k < nb; ++k) {
            const size_t t = (size_t)gw + (size_t)(tb + k) * ngw;
            i32x2 v = *(const i32x2*)(idx + t * 128 + 2 * lane); v.x &= imask; v.y &= imask; const f32x2 c = *(const f32x2*)(coef + t * 128 + 2 * lane);
            li[k * 128 + sd0] = v.x; li[k * 128 + sd1] = v.y; lc[k * 128 + sd0] = c.x; lc[k * 128 + sd1] = c.y;
        }
        asm volatile("s_waitcnt vmcnt(0) lgkmcnt(0)" ::: "memory");
        const int nstep = 4 * nb;
        u32x4 rb[8][4]; float acc[16]; unsigned hv;
#define PV_ISSUE(s, B) do { const ge::u32x4 ia_ = *(const LAS ge::u32x4*)(li + ((s) >> 1) * 64 + rg * 8 + 4 * ((s) & 1)); \
            _Pragma("unroll") for (int i_ = 0; i_ < 4; ++i_) rb[B][i_] = *(const u32x4*)(tab + (ia_[i_] * 128u + lo16)); } while (0)
#define PV_STEP(s, B, QT) do { if ((s) < nstep) { if ((s) + 7 < nstep) PV_ISSUE((s) + 7, ((B) + 7) & 7); \
            const int k_ = (s) >> 2; const size_t t_ = (size_t)gw + (size_t)(tb + k_) * ngw; \
            if (QT == 0) { _Pragma("unroll") for (int k = 0; k < 16; ++k) acc[k] = 0.f; hv = (unsigned)__builtin_amdgcn_ds_bpermute(4 * wown, (int)*(const unsigned*)(hin + t_ * D + 128 * slice + 2 * lane)); }     \
            const ge::f32x4 ca_ = *(const LAS ge::f32x4*)(lc + ((s) >> 1) * 64 + rg * 8 + 4 * ((s) & 1)); \
            _Pragma("unroll") for (int i = 0; i < 4; ++i) { const float cf = ca_[i]; _Pragma("unroll") for (int k = 0; k < 4; ++k) { \
                const f32x2 q0 = __builtin_amdgcn_cvt_pk_f32_fp8((int)rb[B][i][k], false), q1 = __builtin_amdgcn_cvt_pk_f32_fp8((int)rb[B][i][k], true); \
                acc[4 * k] += cf * q0.x; acc[4 * k + 1] += cf * q0.y; acc[4 * k + 2] += cf * q1.x; acc[4 * k + 3] += cf * q1.y; } } \
            if (QT == 3) { float s8[8], s4[4]; \
                _Pragma("unroll") for (int k = 0; k < 8; ++k) { auto rr = __builtin_amdgcn_permlane32_swap(__float_as_uint(acc[k]), __float_as_uint(acc[k + 8]), false, false); s8[k] = __uint_as_float(rr[0]) + __uint_as_float(rr[1]); } \
                _Pragma("unroll") for (int k = 0; k < 4; ++k) { auto rr = __builtin_amdgcn_permlane16_swap(__float_as_uint(s8[k]), __float_as_uint(s8[k + 4]), false, false); s4[k] = __uint_as_float(rr[0]) + __uint_as_float(rr[1]); } \
                const bool b3_ = (lane & 8) != 0; \
                const float o0 = (b3_ ? s4[2] : s4[0]) + dpp_ror8(b3_ ? s4[0] : s4[2]), o1 = (b3_ ? s4[3] : s4[1]) + dpp_ror8(b3_ ? s4[1] : s4[3]); \
                const unsigned w_ = pk2(__uint_as_float(hv << 16) + o0 * (1.f / VSCALE), __uint_as_float(hv & 0xffff0000u) + o1 * (1.f / VSCALE)); \
                *(unsigned*)(hb + t_ * D + 128 * slice + 2 * lane) = (unsigned)__builtin_amdgcn_ds_permute(4 * wown, (int)w_);     \
                const float x0 = __uint_as_float(w_ << 16), x1 = __uint_as_float(w_ & 0xffff0000u); \
                float sq = x0 * x0 + x1 * x1; sq = wave_sum(sq); if (lane == 0) ssp1[t_ * 8 + slice] = sq; } } } while (0)
        PV_ISSUE(0, 0); PV_ISSUE(1, 1); PV_ISSUE(2, 2); PV_ISSUE(3, 3); if (4 < nstep) { PV_ISSUE(4, 4); PV_ISSUE(5, 5); PV_ISSUE(6, 6); }
        for (int s0 = 0; s0 < nstep; s0 += 8) { PV_STEP(s0, 0, 0); PV_STEP(s0 + 1, 1, 1); PV_STEP(s0 + 2, 2, 2); PV_STEP(s0 + 3, 3, 3); PV_STEP(s0 + 4, 4, 0); PV_STEP(s0 + 5, 5, 1); PV_STEP(s0 + 6, 6, 2); PV_STEP(s0 + 7, 7, 3); }
#undef PV_ISSUE
#undef PV_STEP
        asm volatile("s_waitcnt lgkmcnt(0)" ::: "memory");
    }
}

__device__ __forceinline__ void ph_final(const bf16_t* __restrict__ hb, const float* __restrict__ ssp1, const float* __restrict__ g, float* __restrict__ out) {
    PH_IDS
    const int lane = TIDX & 63, gw = BIDX * 8 + __builtin_amdgcn_readfirstlane(TIDX >> 6), ngw = GDIM * 8;
    for (int w = gw; w < T; w += ngw) {
        const float rs = rsqrtf(sum8(ssp1 + (size_t)w * 8) * (1.f / D) + EPS);
        const u32x4* r = (const u32x4*)(hb + (size_t)w * D) + lane; const f32x4* gg = (const f32x4*)g; f32x4* o = (f32x4*)(out + (size_t)w * D);
#pragma unroll
        for (int j = 0; j < 2; ++j) { const u32x4 v = r[64 * j]; const int c4 = (64 * j + lane) * 2; const f32x4 g0 = gg[c4], g1 = gg[c4 + 1];
            o[c4] = (f32x4){__uint_as_float(v.x << 16) * rs * g0.x, __uint_as_float(v.x & 0xffff0000u) * rs * g0.y, __uint_as_float(v.y << 16) * rs * g0.z, __uint_as_float(v.y & 0xffff0000u) * rs * g0.w};
            o[c4 + 1] = (f32x4){__uint_as_float(v.z << 16) * rs * g1.x, __uint_as_float(v.z & 0xffff0000u) * rs * g1.y, __uint_as_float(v.w << 16) * rs * g1.z, __uint_as_float(v.w & 0xffff0000u) * rs * g1.w}; }
    }
}
}
namespace attn_body {
using bf16=__hip_bfloat16;
using bf16x8=__attribute__((ext_vector_type(8)))short;
using s16x4=__attribute__((ext_vector_type(4)))short;
using f32x16=__attribute__((ext_vector_type(16)))float;
using u32x4=__attribute__((ext_vector_type(4)))unsigned;
constexpr int BATCH=8,NHEAD=8,SEQ=4096,D=64,DM=NHEAD*D;
constexpr int OPITCH=1024,OCOL=512;
constexpr int NW=8,QBLK=32,QB=QBLK*NW,KVBLK=64,NQB=SEQ/QB;
constexpr int ATTN_PITCH=DM, ATTN_UNIT_ROWS=QB;
__device__ __forceinline__ int crow(int r,int hi){return (r&3)+8*(r>>2)+4*hi;}
#define SBAR() __builtin_amdgcn_sched_barrier(0)
__device__ __forceinline__ void cmask(f32x16&p0,f32x16&p1,int jb,int qrel,int hi){
  const float NEG=-INFINITY; int kb=64*jb+4*hi;
  #pragma unroll
  for(int r=0;r<16;++r){int kv=kb+(r&3)+8*(r>>2); if(kv>qrel)p0[r]=NEG; if(kv+32>qrel)p1[r]=NEG;}
}

constexpr int NSLOT=3, SLOTB=8192;
constexpr int LDS_K=0, LDS_V=NSLOT*SLOTB, LDS_WS=2*NSLOT*SLOTB, LDS_OST=LDS_WS+NW*64*4, LDS_CUM=LDS_OST+NW*4096, LDS_BYTES=LDS_CUM+SEQ*4;
constexpr float PRUNE_T=64.f;
constexpr float C2=0.125f*1.4426950408889634f;
__device__ __forceinline__ void glds16(const void*gsrc,unsigned lds_dst){unsigned keep;
  asm volatile("s_mov_b32 %0, m0\n\ts_mov_b32 m0, %2\n\ts_nop 0\n\tglobal_load_lds_dwordx4 %1, off\n\ts_mov_b32 m0, %0":"=&s"(keep):"v"(gsrc),"s"(lds_dst):"memory");}
__device__ __forceinline__ float max3f(float a,float b,float c){float r;asm("v_max3_f32 %0, %1, %2, %3":"=v"(r):"v"(a),"v"(b),"v"(c));return r;}
__device__ __forceinline__ float max2f(float a,float b){float r;asm("v_max_f32_e32 %0, %1, %2":"=v"(r):"v"(a),"v"(b));return r;}
__device__ __forceinline__ float fadd_s(float a,float b){float r;asm("v_add_f32_e32 %0, %1, %2":"=v"(r):"v"(a),"v"(b));return r;}
__device__ __forceinline__ float fsub_s(float a,float b){float r;asm("v_sub_f32_e32 %0, %1, %2":"=v"(r):"v"(a),"v"(b));return r;}
typedef float f32x4_t __attribute__((ext_vector_type(4)));
typedef float f32x2_t __attribute__((ext_vector_type(2))); typedef __bf16 bf16x2_t __attribute__((ext_vector_type(2)));
__device__ __forceinline__ unsigned cvtpk_s(float lo,float hi){f32x2_t v={lo,hi};bf16x2_t b=__builtin_convertvector(v,bf16x2_t);return __builtin_bit_cast(unsigned,b);}
#define WAIT_BAR(N) asm volatile("s_waitcnt vmcnt(" #N ") lgkmcnt(0)\n\ts_barrier":::"memory")

__device__ __forceinline__ void qkt(f32x16&p0,f32x16&p1,const char*Kslot,const bf16x8*qr,const f32x16&negm,int r32,int hi){
  const char*kb=Kslot+hi*1024+r32*16;
  #pragma unroll
  for(int d0=0;d0<4;++d0){
    const bf16x8 b0=*reinterpret_cast<const bf16x8*>(kb+d0*2048);
    const bf16x8 b1=*reinterpret_cast<const bf16x8*>(kb+d0*2048+512);
    if(d0==0){p0=__builtin_amdgcn_mfma_f32_32x32x16_bf16(b0,qr[0],negm,0,0,0);p1=__builtin_amdgcn_mfma_f32_32x32x16_bf16(b1,qr[0],negm,0,0,0);}
    else{p0=__builtin_amdgcn_mfma_f32_32x32x16_bf16(b0,qr[d0],p0,0,0,0);p1=__builtin_amdgcn_mfma_f32_32x32x16_bf16(b1,qr[d0],p1,0,0,0);}}
}
typedef __attribute__((address_space(3))) const char* lds_cptr;
typedef short v4i16_t __attribute__((ext_vector_type(4)));
__device__ __forceinline__ void kload8(bf16x8*kf,lds_cptr kp){
  kf[0]=*(const __attribute__((address_space(3))) bf16x8*)(kp);      kf[1]=*(const __attribute__((address_space(3))) bf16x8*)(kp+512);
  kf[2]=*(const __attribute__((address_space(3))) bf16x8*)(kp+2048); kf[3]=*(const __attribute__((address_space(3))) bf16x8*)(kp+2560);
  kf[4]=*(const __attribute__((address_space(3))) bf16x8*)(kp+4096); kf[5]=*(const __attribute__((address_space(3))) bf16x8*)(kp+4608);
  kf[6]=*(const __attribute__((address_space(3))) bf16x8*)(kp+6144); kf[7]=*(const __attribute__((address_space(3))) bf16x8*)(kp+6656);
}
__device__ __forceinline__ void kload2(bf16x8*kf,lds_cptr kp,int j){ kf[2*j]=*(const __attribute__((address_space(3))) bf16x8*)(kp+j*2048); kf[2*j+1]=*(const __attribute__((address_space(3))) bf16x8*)(kp+j*2048+512); }
__device__ __forceinline__ s16x4 vtr(lds_cptr p){ return __builtin_bit_cast(s16x4,__builtin_amdgcn_ds_read_tr16_b64_v4i16((__attribute__((address_space(3))) v4i16_t*)p)); }
__device__ __forceinline__ float rowmax(const f32x16&p0,const f32x16&p1){
  float a=max3f(p0[0],p0[1],p1[0]),b=max3f(p0[2],p0[3],p1[1]);a=max3f(a,p1[2],p1[3]);
  #pragma unroll
  for(int r=4;r<16;r+=4){a=max3f(a,p0[r],p0[r+1]);b=max3f(b,p0[r+2],p0[r+3]);a=max3f(a,p1[r],p1[r+1]);b=max3f(b,p1[r+2],p1[r+3]);}
  const float m=max2f(a,b);
  auto rr=__builtin_amdgcn_permlane32_swap(__float_as_uint(m),__float_as_uint(m),false,false);
  return max2f(__uint_as_float(rr[0]),__uint_as_float(rr[1]));
}
__device__ __forceinline__ void pv(f32x16*o,int vb,bf16x8 pa0,bf16x8 pa1,bf16x8 pa2,bf16x8 pa3){
  #pragma unroll
  for(int d0=0;d0<2;++d0){s16x4 lo[4],hi[4];
    #pragma unroll
    for(int ks=0;ks<4;++ks){
      asm volatile("ds_read_b64_tr_b16 %0,%1 offset:%c2":"=&v"(lo[ks]):"v"(vb),"i"(d0*4096+ks*1024):"memory");
      asm volatile("ds_read_b64_tr_b16 %0,%1 offset:%c2":"=&v"(hi[ks]):"v"(vb),"i"(d0*4096+ks*1024+512):"memory");}
    asm volatile("s_waitcnt lgkmcnt(0)":::"memory");SBAR();
    #define PK(k) (bf16x8){lo[k][0],lo[k][1],lo[k][2],lo[k][3],hi[k][0],hi[k][1],hi[k][2],hi[k][3]}
    o[d0]=__builtin_amdgcn_mfma_f32_32x32x16_bf16(pa0,PK(0),o[d0],0,0,0);
    o[d0]=__builtin_amdgcn_mfma_f32_32x32x16_bf16(pa1,PK(1),o[d0],0,0,0);
    o[d0]=__builtin_amdgcn_mfma_f32_32x32x16_bf16(pa2,PK(2),o[d0],0,0,0);
    o[d0]=__builtin_amdgcn_mfma_f32_32x32x16_bf16(pa3,PK(3),o[d0],0,0,0);
    #undef PK
  }
}

#ifndef ATTN_STORE16
#define ATTN_STORE16(p,v) (*(u32x4*)(p)=(v))
#endif
template<int THRL> __device__ __forceinline__ void attn_unit(int b,int h,int qb,const bf16*Q,const bf16*__restrict__ K,const bf16*__restrict__ V,const float*__restrict__ cum2,bf16*O,float*__restrict__ ssp,char*shm,int tid_){
  int tid=tid_; asm volatile("":"+v"(tid)); const int lane=tid&63,r32=lane&31,hi=lane>>5; const int wid=__builtin_amdgcn_readfirstlane(tid>>6);
  const long rowbase=(long)b*SEQ; const int q0=qb*QB;
  const bf16*Qw=Q+(rowbase+q0+wid*QBLK)*DM+h*D;
  const bf16*Kh=K+rowbase*DM+h*D,*Vh=V+rowbase*DM+h*D;
  const unsigned lds0=(unsigned)(uintptr_t)shm;
  float*wsf=(float*)(shm+LDS_WS)+wid*64;
  const int NTf=(q0+QB)/KVBLK; const float*cg=cum2+(long)(b*NHEAD+h)*SEQ;
  int ts; { const float thr=cg[q0]+PRUNE_T; const float ce=lane<NTf?cg[64*lane+63]:0.f; const unsigned long long m_=__ballot((lane<NTf)&&(ce<=thr));
    ts=m_?(int)__builtin_ctzll(m_):0; ts&=~1; if(ts>NTf-4)ts=NTf-4; ts=__builtin_amdgcn_readfirstlane(ts); }
  const bf16*ksrc=Kh+(long)(ts*KVBLK+lane)*DM+wid*8;
  const bf16*vsrc=Vh+(long)(ts*KVBLK+16*(wid&3)+(lane>>2))*DM+(wid>>2)*32+(lane&3)*8;
  const unsigned kdst=lds0+LDS_K+wid*1024, vdst=lds0+LDS_V+wid*1024;
  #define DMA_K(t,slot) glds16(ksrc+(long)(t)*KVBLK*DM,(unsigned)__builtin_amdgcn_readfirstlane(kdst+(slot)))
  #define DMA_V(t,slot) glds16(vsrc+(long)(t)*KVBLK*DM,(unsigned)__builtin_amdgcn_readfirstlane(vdst+(slot)))
  const int vb0=(int)(lds0+LDS_V)+((lane>>4)&1)*32+(lane&3)*8+(4*hi+((lane&15)>>2))*64;
  const char*Kbase=shm+LDS_K; bf16x8 kf[8];
  const lds_cptr shm3=(lds_cptr)shm; const lds_cptr kp0=shm3+LDS_K+hi*1024+r32*16; const lds_cptr vp0=shm3+LDS_V+((lane>>4)&1)*32+(lane&3)*8+(4*hi+((lane&15)>>2))*64;
  { float*cl=(float*)(shm+LDS_CUM); for(int i=tid+ts*KVBLK;i<q0+QB;i+=NW*64)cl[i-ts*KVBLK]=cg[i]; }
  const float cq2=cg[q0+wid*QBLK+r32];
  const __attribute__((address_space(3))) float* ckl=(const __attribute__((address_space(3))) float*)(shm3+LDS_CUM)+4*hi;
  #define BIAS(P0,P1,t) do{ const __attribute__((address_space(3))) float*ck_=ckl+64*(t); const float mm_=mhat-cq2; _Pragma("unroll") for(int g_=0;g_<4;++g_){ \
      const f32x4_t c0_=*(const __attribute__((address_space(3))) f32x4_t*)(ck_+8*g_)+mm_, c1_=*(const __attribute__((address_space(3))) f32x4_t*)(ck_+32+8*g_)+mm_; \
      _Pragma("unroll") for(int i_=0;i_<4;++i_){P0[4*g_+i_]-=c0_[i_];P1[4*g_+i_]-=c1_[i_];} SBAR(); } }while(0)
  const int NT=NTf-ts;
  DMA_K(0,0);DMA_V(0,0);DMA_K(1,SLOTB);
  bf16x8 qr[4];
  #pragma unroll
  for(int d0=0;d0<4;++d0)qr[d0]=*reinterpret_cast<const bf16x8*>(&Qw[(long)r32*DM+d0*16+hi*8]);
  float mhat=0.f,l_reg=0.f;f32x16 o[2];o[0]=f32x16{};o[1]=f32x16{};const f32x16 negm=f32x16{};
  const int qrel=wid*QBLK+r32;
  #define CMASK(P0,P1,t) do{int jb_=(t)-(NT-4); if(jb_>=0)cmask(P0,P1,jb_,qrel,hi);}while(0)
  bool resc=false;
  #define START(P0,P1) do{ const float rm=rowmax(P0,P1); resc=false; \
    { const float dl=rm; mhat=fadd_s(mhat,dl); \
      _Pragma("unroll") for(int r=0;r<16;++r){P0[r]=fsub_s(P0[r],dl);P1[r]=fsub_s(P1[r],dl);} \
      } \
    _Pragma("unroll") for(int r=0;r<16;++r)P0[r]=__builtin_amdgcn_exp2f(P0[r]); }while(0)
  #define RESC() do{ if(resc){ asm volatile("s_waitcnt lgkmcnt(0)":::"memory"); \
      _Pragma("unroll") for(int d_=0;d_<2;++d_) _Pragma("unroll") for(int r=0;r<16;++r)o[d_][r]*=wsf[crow(r,hi)]; } }while(0)
  f32x16 pA0,pA1,pB0,pB1;
  int sl_prev=0,sl_cur=0,sl_next=SLOTB;
  #define ROT() do{sl_prev=sl_cur;sl_cur=sl_next;sl_next=(sl_next==(NSLOT-1)*SLOTB)?0:sl_next+SLOTB;}while(0)
  DMA_K(2,2*SLOTB);
  WAIT_BAR(3);
  qkt(pA0,pA1,Kbase,qr,negm,r32,hi);asm volatile("s_nop 15\n\ts_nop 7":"+v"(pA0),"+v"(pA1));BIAS(pA0,pA1,0);CMASK(pA0,pA1,0);
  START(pA0,pA1);
  _Pragma("unroll") for(int r=0;r<16;++r)pA1[r]=__builtin_amdgcn_exp2f(pA1[r]);
  WAIT_BAR(0);
  DMA_K(3,0);DMA_V(1,SLOTB);
  ROT();
  kload8(kf,kp0+sl_cur);
  WAIT_BAR(2);
  s16x4 vlo[8],vhi[8]; u32x4 pw0,pw1,pw2,pw3;
  #define PKW(P,B) cvtpk_s(P[B],P[B+1])
  #define PAF(k) __builtin_bit_cast(bf16x8,pw##k)
  #define VFR(i) (bf16x8){vlo[i][0],vlo[i][1],vlo[i][2],vlo[i][3],vhi[i][0],vhi[i][1],vhi[i][2],vhi[i][3]}
  #define PIN(x) asm volatile("":"+v"(x))
  #define MX3(a,b,c) __builtin_fmaxf(__builtin_fmaxf((a),(b)),(c))
  #define GAPA(MF,A0,A1,A2,A3,W0,W1,PW) do{ MF; sacc+=A0; sacc+=A1; sacc+=A2; sacc+=A3; PIN(sacc); W0; W1; PIN(PW); SBAR(); }while(0)
  #define EX(v) __builtin_amdgcn_exp2f(v)
  #define GAPB(MF,X,B) do{ MF; X[B]=EX(X[B]); X[B+1]=EX(X[B+1]); X[B+2]=EX(X[B+2]); X[B+3]=EX(X[B+3]); PIN(X); SBAR(); }while(0)
  #define VRD(i) do{ vlo[i]=vtr(vp_+(((i)>>2)*4096+((i)&3)*1024)); vhi[i]=vtr(vp_+(((i)>>2)*4096+((i)&3)*1024+512)); }while(0)
  #define KRD(G,j) do{ if(G){ kload2(kf,kp0+sl_next,j); SBAR(); } }while(0)
  #define STEP(C0,C1,P0,P1,t,GK,GV,GL) do{ SBAR(); \
    const lds_cptr vp_=vp0+sl_prev; \
    VRD(0); SBAR(); float sacc=(P0[0]+P0[1]); \
    GAPA(C0=__builtin_amdgcn_mfma_f32_32x32x16_bf16(kf[0],qr[0],negm,0,0,0), P0[2],P0[3],P0[4],P0[5],     pw0[0]=PKW(P0,0), pw0[1]=PKW(P0,2), pw0); \
    VRD(4); SBAR(); GAPA(C1=__builtin_amdgcn_mfma_f32_32x32x16_bf16(kf[1],qr[0],negm,0,0,0), P0[6],P0[7],P0[8],P0[9],     pw0[2]=PKW(P0,4), pw0[3]=PKW(P0,6), pw0); \
    VRD(1); SBAR(); GAPA(C0=__builtin_amdgcn_mfma_f32_32x32x16_bf16(kf[2],qr[1],C0,0,0,0),   P0[10],P0[11],P0[12],P0[13], pw1[0]=PKW(P0,8), pw1[1]=PKW(P0,10), pw1); \
    VRD(5); SBAR(); GAPA(C1=__builtin_amdgcn_mfma_f32_32x32x16_bf16(kf[3],qr[1],C1,0,0,0),   P0[14],P0[15],P1[0],P1[1],   pw1[2]=PKW(P0,12),pw1[3]=PKW(P0,14), pw1); \
    VRD(2); SBAR(); GAPA(C0=__builtin_amdgcn_mfma_f32_32x32x16_bf16(kf[4],qr[2],C0,0,0,0),   P1[2],P1[3],P1[4],P1[5],     pw2[0]=PKW(P1,0), pw2[1]=PKW(P1,2), pw2); \
    VRD(6); SBAR(); GAPA(C1=__builtin_amdgcn_mfma_f32_32x32x16_bf16(kf[5],qr[2],C1,0,0,0),   P1[6],P1[7],P1[8],P1[9],     pw2[2]=PKW(P1,4), pw2[3]=PKW(P1,6), pw2); \
    VRD(3); SBAR(); GAPA(C0=__builtin_amdgcn_mfma_f32_32x32x16_bf16(kf[6],qr[3],C0,0,0,0),   P1[10],P1[11],P1[12],P1[13], pw3[0]=PKW(P1,8), pw3[1]=PKW(P1,10), pw3); \
    VRD(7); SBAR(); GAPA(C1=__builtin_amdgcn_mfma_f32_32x32x16_bf16(kf[7],qr[3],C1,0,0,0),   P1[14],P1[15],0.f,0.f,       pw3[2]=PKW(P1,12),pw3[3]=PKW(P1,14), pw3); \
    l_reg+=sacc; \
    if(GK){DMA_K((t)+3,sl_cur);} if(GV){DMA_V((t)+1,sl_next);} \
    BIAS(C0,C1,t); CMASK(C0,C1,t); \
    { float a=MX3(C0[0],C0[1],C1[0]),b=MX3(C0[2],C0[3],C1[1]); a=MX3(a,C1[2],C1[3]); \
      _Pragma("unroll") for(int r=4;r<16;r+=4){a=MX3(a,C0[r],C0[r+1]);b=MX3(b,C0[r+2],C0[r+3]);a=MX3(a,C1[r],C1[r+1]);b=MX3(b,C1[r+2],C1[r+3]);} \
      float rm=__builtin_fmaxf(a,b); { auto rr=__builtin_amdgcn_permlane32_swap(__float_as_uint(rm),__float_as_uint(rm),false,false); rm=__builtin_fmaxf(__uint_as_float(rr[0]),__uint_as_float(rr[1])); } \
      resc=false; \
      if(__builtin_expect(__any(rm>(float)THRL),0)){ const float dl=__builtin_fmaxf(rm,0.f); mhat+=dl; \
        _Pragma("unroll") for(int r=0;r<16;++r){C0[r]-=dl;C1[r]-=dl;} \
        const float f=__builtin_amdgcn_exp2f(-dl); l_reg*=f; if(hi==0)wsf[r32]=f; resc=true; } } \
    SBAR(); \
    GAPB(o[0]=__builtin_amdgcn_mfma_f32_32x32x16_bf16(PAF(0),VFR(0),o[0],0,0,0), C0,0); \
    GAPB(o[1]=__builtin_amdgcn_mfma_f32_32x32x16_bf16(PAF(0),VFR(4),o[1],0,0,0), C0,4); \
    KRD(GL,0); GAPB(o[0]=__builtin_amdgcn_mfma_f32_32x32x16_bf16(PAF(1),VFR(1),o[0],0,0,0), C0,8); \
    KRD(GL,1); GAPB(o[1]=__builtin_amdgcn_mfma_f32_32x32x16_bf16(PAF(1),VFR(5),o[1],0,0,0), C0,12); \
    KRD(GL,2); GAPB(o[0]=__builtin_amdgcn_mfma_f32_32x32x16_bf16(PAF(2),VFR(2),o[0],0,0,0), C1,0); \
    KRD(GL,3); GAPB(o[1]=__builtin_amdgcn_mfma_f32_32x32x16_bf16(PAF(2),VFR(6),o[1],0,0,0), C1,4); \
    GAPB(o[0]=__builtin_amdgcn_mfma_f32_32x32x16_bf16(PAF(3),VFR(3),o[0],0,0,0), C1,8); \
    GAPB(o[1]=__builtin_amdgcn_mfma_f32_32x32x16_bf16(PAF(3),VFR(7),o[1],0,0,0), C1,12); \
    }while(0)
  int t=1;
  #undef CMASK
  #define CMASK(P0,P1,t) do{}while(0)
  for(;t+5<NT;t+=2){
    STEP(pB0,pB1,pA0,pA1,t,true,true,true);     WAIT_BAR(2); RESC(); ROT();
    STEP(pA0,pA1,pB0,pB1,t+1,true,true,true);   WAIT_BAR(2); RESC(); ROT();
  }
  #undef CMASK
  #define CMASK(P0,P1,t) do{int jb_=(t)-(NT-4); if(jb_>=0)cmask(P0,P1,jb_,qrel,hi);}while(0)
  #define ENDW(tt) do{ if((tt)+3<NT){WAIT_BAR(2);} else if((tt)+2<NT){WAIT_BAR(1);} else {WAIT_BAR(0);} }while(0)
  for(;t+1<NT;t+=2){
    STEP(pB0,pB1,pA0,pA1,t,(t+3<NT),(t+1<NT),(t+1<NT));       ENDW(t);   RESC(); ROT();
    STEP(pA0,pA1,pB0,pB1,t+1,(t+4<NT),(t+2<NT),(t+2<NT));     ENDW(t+1); RESC(); ROT();
  }
  STEP(pB0,pB1,pA0,pA1,NT-1,false,false,false); RESC();
  { float sacc=pB0[0]+pB0[1]; _Pragma("unroll") for(int r=2;r<16;++r)sacc+=pB0[r]; _Pragma("unroll") for(int r=0;r<16;++r)sacc+=pB1[r]; l_reg+=sacc;
    pw0=(u32x4){PKW(pB0,0),PKW(pB0,2),PKW(pB0,4),PKW(pB0,6)};pw1=(u32x4){PKW(pB0,8),PKW(pB0,10),PKW(pB0,12),PKW(pB0,14)};pw2=(u32x4){PKW(pB1,0),PKW(pB1,2),PKW(pB1,4),PKW(pB1,6)};pw3=(u32x4){PKW(pB1,8),PKW(pB1,10),PKW(pB1,12),PKW(pB1,14)};
    SBAR(); pv(o,vb0+sl_cur,PAF(0),PAF(1),PAF(2),PAF(3)); }
  #undef PKW
  #undef PAF
  #undef VFR
  #undef PIN
  #undef MX3
  #undef GAPA
  #undef GAPB
  #undef EX
  #undef VRD
  #undef KRD
  #undef STEP
  #undef ENDW
  {auto rr=__builtin_amdgcn_permlane32_swap(__float_as_uint(l_reg),__float_as_uint(l_reg),false,false);l_reg=__uint_as_float(rr[0])+__uint_as_float(rr[1]);}
  if(hi==0)wsf[32+r32]=l_reg;asm volatile("s_waitcnt lgkmcnt(0)":::"memory");
  float rli[16];
  #pragma unroll
  for(int r=0;r<16;++r)rli[r]=__builtin_amdgcn_rcpf(wsf[32+crow(r,hi)]);
  int lane_e=lane; asm volatile("":"+v"(lane_e));
  bf16*Ow=O+(rowbase+q0+wid*QBLK)*OPITCH+OCOL+h*D; float*sw=ssp+(rowbase+q0+wid*QBLK)*8+h;
  { bf16*stg=(bf16*)(shm+LDS_OST)+wid*2048;
    #pragma unroll
    for(int r=0;r<16;++r){const int orow=crow(r,hi);
      #pragma unroll
      for(int d0=0;d0<2;++d0)stg[orow*64+d0*32+r32]=__float2bfloat16(o[d0][r]*rli[r]);}
    asm volatile("s_waitcnt lgkmcnt(0)":::"memory");
    #pragma unroll
    for(int i=0;i<4;++i){const int row=i*8+(lane_e>>3),ch=lane_e&7; const u32x4 v=*(const u32x4*)(stg+row*64+ch*8); ATTN_STORE16(Ow+(long)row*OPITCH+ch*8,v);
      float sq=0.f;
      #pragma unroll
      for(int k=0;k<4;++k){const float a=__uint_as_float(v[k]<<16),c=__uint_as_float(v[k]&0xffff0000u);sq+=a*a+c*c;}
      sq+=__shfl_xor(sq,1);sq+=__shfl_xor(sq,2);sq+=__shfl_xor(sq,4);
      if(ch==0)sw[(long)row*8]=sq; } }
  asm volatile("s_waitcnt lgkmcnt(0)\n\ts_barrier":::"memory");
  #undef DMA_K
  #undef DMA_V
  #undef CMASK
  #undef START
  #undef RESC
  #undef BIAS
  #undef ROT
}
constexpr int ATTN_LDS_BYTES=LDS_BYTES;
template<int THRL=8> __device__ __forceinline__ void attn_phase(char*lds,const bf16*Q,const bf16*K,const bf16*V,const float*cum2,bf16*O,float*ssp,unsigned*ctr,volatile __attribute__((address_space(3))) unsigned*slot,int tid){
  for(;;){
    if(tid==0)*slot=__hip_atomic_fetch_add(ctr,1u,__ATOMIC_RELAXED,__HIP_MEMORY_SCOPE_AGENT);
    __syncthreads();
    const int u=(int)*slot;
    __syncthreads();
    if(u>=BATCH*NHEAD*NQB)break;
    const int qb=NQB-1-(u>>6),h=NHEAD-1-((u>>3)&7),b=u&7;
    attn_unit<THRL>(b,h,qb,Q,K,V,cum2,O,ssp,lds,tid);
  }
}
#undef SBAR
#undef WAIT_BAR
}
namespace nv {
typedef float f32x2v __attribute__((ext_vector_type(2)));
constexpr size_t WS_APOW = 921 * MiB;
constexpr size_t WS_BBAR = 89 * MiB;
constexpr int KDW = 128 * 256;
__device__ __forceinline__ void p0_ssm_a(const float* __restrict__ lam_re, const float* __restrict__ lam_im, const float* __restrict__ log_dt, const float* __restrict__ b_re, const float* __restrict__ b_im,
                                         f32x2v* __restrict__ apow, f32x2v* __restrict__ bbar) {
    PH_IDS
    for (int i = BIDX * 512 + TIDX; i < DEPTH * G * P; i += GDIM * 512) {
        const int lg = i / P, p = i % P;
        const float dtf = expf(log_dt[lg]); const float lr = lam_re[i], li = lam_im[i];
        const double ang = (double)li * (double)dtf, k2 = rint(ang * 0.15915494309189535), red = ang - k2 * 6.283185307179586;
        const float mag = expf(lr * dtf), rr = (float)red; const double are = (double)(mag * cosf(rr)), aim = (double)(mag * sinf(rr));
        double pr = 1.0, pi = 0.0;
        for (int d = 0; d <= 64; ++d) { apow[((size_t)lg * 65 + d) * P + p] = (f32x2v){(float)pr, (float)pi}; const double nr_ = pr * are - pi * aim, ni_ = pr * aim + pi * are; pr = nr_; pi = ni_; }
        const double lrd = lr, lid = li, den = lrd * lrd + lid * lid, nr = are - 1.0, zre = (nr * lrd + aim * lid) / den, zim = (aim * lrd - nr * lid) / den;
        for (int h = 0; h < HC; ++h) { const double br = b_re[(size_t)i * HC + h], bi = b_im[(size_t)i * HC + h]; bbar[(size_t)i * HC + h] = (f32x2v){(float)(zre * br - zim * bi), (float)(zre * bi + zim * br)}; }
    }
}
__device__ __forceinline__ void p0_ssm_b(const f32x2v* __restrict__ apow, const f32x2v* __restrict__ bbar, const float* __restrict__ c_re, const float* __restrict__ c_im, const float* __restrict__ dsk,
                                         bf16_t* __restrict__ KD, bf16_t* __restrict__ WST, bf16_t* __restrict__ WOUT) {
    PH_IDS
    const int gt = BIDX * 512 + TIDX, nth = GDIM * 512;
    for (int i = gt; i < DEPTH * G * KDW; i += nth) {
        const int lg = i / KDW, r = i % KDW, dd = r >> 8, h = (r >> 4) & 15, h2 = r & 15, d = dd - 63;
        float v = 0.f;
        if (d >= 0 && dd < 127) {
            const f32x2v* ap = apow + ((size_t)lg * 65 + d) * P; const f32x2v* bb = bbar + (size_t)lg * P * HC + h2; const float* cr = c_re + ((size_t)lg * HC + h) * P; const float* ci = c_im + ((size_t)lg * HC + h) * P;
            for (int p = 0; p < P; ++p) { const f32x2v a = ap[p], b = bb[(size_t)p * HC]; const float wr = a.x * b.x - a.y * b.y, wi = a.x * b.y + a.y * b.x; v += cr[p] * wr - ci[p] * wi; }
            if (d == 0 && h == h2) v += dsk[lg * HC + h];
        }
        KD[i] = f2bf(v);
    }
    for (int i = gt; i < DEPTH * G * 128 * 256; i += nth) {
        const int lg = i >> 15, r = i & 32767, row = r >> 8, k = r & 255, j = k >> 4, h2 = k & 15, p = row & 63;
        const f32x2v a = apow[((size_t)lg * 65 + (15 - j)) * P + p], b = bbar[((size_t)lg * P + p) * HC + h2];
        WST[i] = f2bf(row < 64 ? a.x * b.x - a.y * b.y : a.x * b.y + a.y * b.x);
    }
    for (int i = gt; i < DEPTH * G * 1024 * 128; i += nth) {
        const int lg = i >> 17, r = i & 131071, row = r >> 7, k = r & 127, ti = row >> 4, h = row & 15, p = k & 63;
        const f32x2v e = apow[((size_t)lg * 65 + ti + 1) * P + p]; const float cr = c_re[((size_t)lg * HC + h) * P + p], ci = c_im[((size_t)lg * HC + h) * P + p];
        WOUT[i] = f2bf(k < 64 ? cr * e.x - ci * e.y : -(cr * e.y + ci * e.x));
    }
}

struct SchedSsmS {
    static constexpr bool DUALB = false; long hA, hB, hB1;
    const char* UP; const char* WST; int G_, c;
    __device__ __forceinline__ void init(const void* up, const void* wst_l, int grid, int bid) { UP = (const char*)up; WST = (const char*)wst_l; G_ = grid; c = bid; hA = 128l * UPW * 2; hB = 0; hB1 = 0; }
    __device__ __forceinline__ bool next(int i, ge::Unit& u) const {
        const int L = i * G_ + c; if (L >= G * 2 * 4) return false;
        const int g = L >> 3, pm = (L >> 2) & 1, ks = L & 3;
        u.A0 = UP + (((size_t)g * NCH + pm * 256) * UPW + 128 + ks * 256) * 2; u.B0 = WST + (size_t)g * 128 * 256 * 2; u.nt = 4; u.pm = pm; u.pn = ks; u.aux = g; return true; }
    __device__ __forceinline__ const char* ta(const ge::Unit& u, int t) const { return u.A0 + t * 128; }
    __device__ __forceinline__ const char* tb(const ge::Unit& u, int t) const { return u.B0 + t * 128; }
    __device__ __forceinline__ bool sb(const ge::Unit&, int) const { return false; }
    __device__ __forceinline__ unsigned voffA(int R, int C) const { return (unsigned)(R * UPW * 2 + C * 2); }
    __device__ __forceinline__ unsigned voffB(int Rb, int C) const { return (unsigned)(Rb * 512 + C * 2); }
    __device__ __forceinline__ unsigned voffB1(int, int) const { return 0u; }
};
struct EpiSsmS {
    static constexpr bool PERM = false, MIDK = false, UBEGIN = false;
    float* SLOC;
    __device__ __forceinline__ void unit_begin(const ge::Unit&, int, LAS unsigned char*) const {}
    __device__ __forceinline__ void midk(ge::f32x4 (&)[2][2][4][2], const ge::Unit&, int, int, LAS unsigned char*) const {}
    __device__ __forceinline__ void operator()(const ge::f32x4 (&acc)[2][2][4][2], const ge::Unit& u, int wr, int wc, int fr, int fq, LAS unsigned char*) const {
        const int g = u.aux, ks = u.pn;
#pragma unroll
        for (int ai = 0; ai < 2; ++ai)
#pragma unroll
            for (int m = 0; m < 4; ++m) {
                const int chunk = u.pm * 256 + ai * 128 + wr * 64 + m * 16 + fr; float* dst = SLOC + ((size_t)g * (NCH * 4) + chunk * 4 + ks) * 128;
#pragma unroll
                for (int n = 0; n < 2; ++n) *(ge::f32x4*)(dst + wc * 32 + 16 * n + 4 * fq) = acc[ai][0][m][n];
            }
    }
};

__device__ __forceinline__ void ph_ssm_prefix(LAS unsigned char* lds, const float* __restrict__ SLOC, const f32x2v* __restrict__ apow_l, bf16_t* __restrict__ UP) {
    PH_IDS
    const int p = TIDX & 63, w = __builtin_amdgcn_readfirstlane(TIDX >> 6);
    LAS f32x2v* ex = (LAS f32x2v*)lds;
    for (int item = BIDX; item < BATCH * G; item += GDIM) {
        const int b = item / G, g = item % G;
        const f32x2v a16 = apow_l[((size_t)g * 65 + 16) * P + p];
        const float* src = SLOC + ((size_t)g * (NCH * 4) + (size_t)b * 256 + 32 * w) * 128 + p; bf16_t* dst = UP + ((size_t)g * NCH + b * 64 + 8 * w) * UPW + p;
        float xr[32], xi[32];
#pragma unroll
        for (int k = 0; k < 32; ++k) { xr[k] = src[(size_t)k * 128]; xi[k] = src[(size_t)k * 128 + 64]; }
        float sr = 0.f, si = 0.f;
#pragma unroll
        for (int k = 0; k < 32; ++k) { const float nr = a16.x * sr - a16.y * si + xr[k], ni = a16.x * si + a16.y * sr + xi[k]; sr = nr; si = ni; }
        ex[w * 64 + p] = (f32x2v){sr, si};
        float qr = a16.x, qi = a16.y;
#pragma unroll
        for (int k = 0; k < 5; ++k) { const float nr = qr * qr - qi * qi, ni = 2.f * qr * qi; qr = nr; qi = ni; }
        __syncthreads();
        sr = 0.f; si = 0.f;
        for (int j = 0; j < w; ++j) { const f32x2v e = ex[j * 64 + p]; const float nr = qr * sr - qi * si + e.x, ni = qr * si + qi * sr + e.y; sr = nr; si = ni; }
#pragma unroll
        for (int k = 0; k < 32; ++k) {
            if ((k & 3) == 0) { bf16_t* d = dst + (size_t)(k >> 2) * UPW; d[0] = f2bf(sr); d[64] = f2bf(si); }
            const float nr = a16.x * sr - a16.y * si + xr[k], ni = a16.x * si + a16.y * sr + xi[k]; sr = nr; si = ni;
        }
        __syncthreads();
    }
}
__device__ __forceinline__ void ph_cum2(const float* __restrict__ logf, float* __restrict__ cum) {
    PH_IDS
    const int lane = TIDX & 63, gw = BIDX * 8 + __builtin_amdgcn_readfirstlane(TIDX >> 6), ngw = GDIM * 8;
    for (int item = gw; item < BATCH * NH; item += ngw) {
        const int b = item / NH, h = item % NH;
        const float* src = logf + ((size_t)b * SEQ + lane * 64) * NH + h; float* dst = cum + (size_t)item * SEQ + lane * 64;
        float tot = 0.f;
        for (int i = 0; i < 64; ++i) tot += src[(size_t)i * NH];
        float ex = tot;
#pragma unroll
        for (int o = 1; o < 64; o <<= 1) { const float y = __shfl_up(ex, o); if (lane >= o) ex += y; }
        float run = ex - tot;
        for (int i = 0; i < 64; ++i) { run += src[(size_t)i * NH]; dst[i] = run * 1.4426950408889634f; }
    }
}

struct SchedSsmC {
    static constexpr bool DUALB = true; long hA, hB, hB1;
    const char* UP; const char* WOUT; const char* KD; int G_, c;
    __device__ __forceinline__ void init(const void* up, const void* wout_l, const void* kd_l, int grid, int bid) { UP = (const char*)up; WOUT = (const char*)wout_l; KD = (const char*)kd_l; G_ = grid; c = bid; hA = 128l * UPW * 2; hB = 128l * 256; hB1 = 8l * 512; }
    __device__ __forceinline__ bool next(int i, ge::Unit& u) const {
        const int L = i * G_ + c; if (L >= G * 2 * 4) return false;
        const int pn = 3 - (L >> 6), g = (L & 63) >> 1, pm = L & 1;
        u.A0 = UP + ((size_t)g * NCH + pm * 256) * UPW * 2; u.B0 = nullptr; u.nt = 2 + 4 * (pn + 1); u.pm = pm; u.pn = pn; u.aux = g; return true; }
    __device__ __forceinline__ const char* ta(const ge::Unit& u, int t) const { return u.A0 + t * 128; }
    __device__ __forceinline__ bool sb(const ge::Unit&, int t) const { return t >= 2; }
    __device__ __forceinline__ const char* tb(const ge::Unit& u, int t) const {
        return t < 2 ? WOUT + ((size_t)u.aux * 1024 + u.pn * 256) * 256 + t * 128 : KD + ((size_t)u.aux * KDW + (size_t)(16 * u.pn - 4 * (t - 2) + 60) * 256) * 2; }
    __device__ __forceinline__ unsigned voffA(int R, int C) const { return (unsigned)(R * UPW * 2 + C * 2); }
    __device__ __forceinline__ unsigned voffB(int Rb, int C) const { return (unsigned)(Rb * 256 + C * 2); }
    __device__ __forceinline__ unsigned voffB1(int Rb, int C) const { return (unsigned)((((Rb >> 4) + 3 - (C >> 4)) * 256 + (Rb & 15) * 16 + (C & 15)) * 2); }
};
__device__ __forceinline__ float gelu_fast(float x) { const float u = 1.5957691216057308f * (x + 0.044715f * x * x * x); return x - x / (1.f + __expf(u)); }
struct EpiSsmC {
    static constexpr bool PERM = true, MIDK = false, UBEGIN = false;
    bf16_t* GEL;
    __device__ __forceinline__ void unit_begin(const ge::Unit&, int, LAS unsigned char*) const {}
    __device__ __forceinline__ void midk(ge::f32x4 (&)[2][2][4][2], const ge::Unit&, int, int, LAS unsigned char*) const {}
    __device__ __forceinline__ void operator()(const ge::f32x4 (&acc)[2][2][4][2], const ge::Unit& u, int wr, int wc, int fr, int fq, LAS unsigned char*) const {
        const int g = u.aux;
#pragma unroll
        for (int ai = 0; ai < 2; ++ai)
#pragma unroll
            for (int m = 0; m < 4; ++m) {
                const int chunk = u.pm * 256 + ai * 128 + wr * 64 + m * 16 + fr;
#pragma unroll
                for (int bj = 0; bj < 2; ++bj) {
                    const int col = u.pn * 256 + bj * 128 + wc * 32 + 8 * fq, ti = col >> 4, h0 = col & 15;
                    const ge::f32x4 v0 = acc[ai][bj][m][0], v1 = acc[ai][bj][m][1];
                    u32x4 w; w.x = ge::cvt_pk_bf16(gelu_fast(v0[0]), gelu_fast(v0[1])); w.y = ge::cvt_pk_bf16(gelu_fast(v0[2]), gelu_fast(v0[3]));
                    w.z = ge::cvt_pk_bf16(gelu_fast(v1[0]), gelu_fast(v1[1])); w.w = ge::cvt_pk_bf16(gelu_fast(v1[2]), gelu_fast(v1[3]));
                    *(u32x4*)(GEL + ((size_t)g * T + chunk * 64 + ti) * HC + h0) = w;
                }
            }
    }
};
}
namespace nv {
#define SEL_CE(x, y) do { const int _h = max((x), (y)), _l = min((x), (y)); (x) = _h; (y) = _l; } while (0)
__device__ __forceinline__ void sel_sort16(int (&v)[16]) {
    SEL_CE(v[0], v[1]);
    SEL_CE(v[2], v[3]);
    SEL_CE(v[0], v[2]);
    SEL_CE(v[1], v[3]);
    SEL_CE(v[1], v[2]);
    SEL_CE(v[4], v[5]);
    SEL_CE(v[6], v[7]);
    SEL_CE(v[4], v[6]);
    SEL_CE(v[5], v[7]);
    SEL_CE(v[5], v[6]);
    SEL_CE(v[0], v[4]);
    SEL_CE(v[2], v[6]);
    SEL_CE(v[2], v[4]);
    SEL_CE(v[1], v[5]);
    SEL_CE(v[3], v[7]);
    SEL_CE(v[3], v[5]);
    SEL_CE(v[1], v[2]);
    SEL_CE(v[3], v[4]);
    SEL_CE(v[5], v[6]);
    SEL_CE(v[8], v[9]);
    SEL_CE(v[10], v[11]);
    SEL_CE(v[8], v[10]);
    SEL_CE(v[9], v[11]);
    SEL_CE(v[9], v[10]);
    SEL_CE(v[12], v[13]);
    SEL_CE(v[14], v[15]);
    SEL_CE(v[12], v[14]);
    SEL_CE(v[13], v[15]);
    SEL_CE(v[13], v[14]);
    SEL_CE(v[8], v[12]);
    SEL_CE(v[10], v[14]);
    SEL_CE(v[10], v[12]);
    SEL_CE(v[9], v[13]);
    SEL_CE(v[11], v[15]);
    SEL_CE(v[11], v[13]);
    SEL_CE(v[9], v[10]);
    SEL_CE(v[11], v[12]);
    SEL_CE(v[13], v[14]);
    SEL_CE(v[0], v[8]);
    SEL_CE(v[4], v[12]);
    SEL_CE(v[4], v[8]);
    SEL_CE(v[2], v[10]);
    SEL_CE(v[6], v[14]);
    SEL_CE(v[6], v[10]);
    SEL_CE(v[2], v[4]);
    SEL_CE(v[6], v[8]);
    SEL_CE(v[10], v[12]);
    SEL_CE(v[1], v[9]);
    SEL_CE(v[5], v[13]);
    SEL_CE(v[5], v[9]);
    SEL_CE(v[3], v[11]);
    SEL_CE(v[7], v[15]);
    SEL_CE(v[7], v[11]);
    SEL_CE(v[3], v[5]);
    SEL_CE(v[7], v[9]);
    SEL_CE(v[11], v[13]);
    SEL_CE(v[1], v[2]);
    SEL_CE(v[3], v[4]);
    SEL_CE(v[5], v[6]);
    SEL_CE(v[7], v[8]);
    SEL_CE(v[9], v[10]);
    SEL_CE(v[11], v[12]);
    SEL_CE(v[13], v[14]);
}
__device__ __forceinline__ void sel_merge16(int (&a)[16], const int (&b)[16]) {
    a[0] = max(a[0], b[15]);
    a[1] = max(a[1], b[14]);
    a[2] = max(a[2], b[13]);
    a[3] = max(a[3], b[12]);
    a[4] = max(a[4], b[11]);
    a[5] = max(a[5], b[10]);
    a[6] = max(a[6], b[9]);
    a[7] = max(a[7], b[8]);
    a[8] = max(a[8], b[7]);
    a[9] = max(a[9], b[6]);
    a[10] = max(a[10], b[5]);
    a[11] = max(a[11], b[4]);
    a[12] = max(a[12], b[3]);
    a[13] = max(a[13], b[2]);
    a[14] = max(a[14], b[1]);
    a[15] = max(a[15], b[0]);
    SEL_CE(a[0], a[8]);
    SEL_CE(a[1], a[9]);
    SEL_CE(a[2], a[10]);
    SEL_CE(a[3], a[11]);
    SEL_CE(a[4], a[12]);
    SEL_CE(a[5], a[13]);
    SEL_CE(a[6], a[14]);
    SEL_CE(a[7], a[15]);
    SEL_CE(a[0], a[4]);
    SEL_CE(a[1], a[5]);
    SEL_CE(a[2], a[6]);
    SEL_CE(a[3], a[7]);
    SEL_CE(a[8], a[12]);
    SEL_CE(a[9], a[13]);
    SEL_CE(a[10], a[14]);
    SEL_CE(a[11], a[15]);
    SEL_CE(a[0], a[2]);
    SEL_CE(a[1], a[3]);
    SEL_CE(a[4], a[6]);
    SEL_CE(a[5], a[7]);
    SEL_CE(a[8], a[10]);
    SEL_CE(a[9], a[11]);
    SEL_CE(a[12], a[14]);
    SEL_CE(a[13], a[15]);
    SEL_CE(a[0], a[1]);
    SEL_CE(a[2], a[3]);
    SEL_CE(a[4], a[5]);
    SEL_CE(a[6], a[7]);
    SEL_CE(a[8], a[9]);
    SEL_CE(a[10], a[11]);
    SEL_CE(a[12], a[13]);
    SEL_CE(a[14], a[15]);
}
constexpr int SEL_NCAND = 50;
#define SEL_CANDS(F) \
    F(0, 0, 0) \
    F(1, 0, 1) \
    F(2, 0, 2) \
    F(3, 0, 3) \
    F(4, 0, 4) \
    F(5, 0, 5) \
    F(6, 0, 6) \
    F(7, 0, 7) \
    F(8, 0, 8) \
    F(9, 0, 9) \
    F(10, 0, 10) \
    F(11, 0, 11) \
    F(12, 0, 12) \
    F(13, 0, 13) \
    F(14, 0, 14) \
    F(15, 0, 15) \
    F(16, 1, 0) \
    F(17, 1, 1) \
    F(18, 1, 2) \
    F(19, 1, 3) \
    F(20, 1, 4) \
    F(21, 1, 5) \
    F(22, 1, 6) \
    F(23, 1, 7) \
    F(24, 2, 0) \
    F(25, 2, 1) \
    F(26, 2, 2) \
    F(27, 2, 3) \
    F(28, 2, 4) \
    F(29, 3, 0) \
    F(30, 3, 1) \
    F(31, 3, 2) \
    F(32, 3, 3) \
    F(33, 4, 0) \
    F(34, 4, 1) \
    F(35, 4, 2) \
    F(36, 5, 0) \
    F(37, 5, 1) \
    F(38, 6, 0) \
    F(39, 6, 1) \
    F(40, 7, 0) \
    F(41, 7, 1) \
    F(42, 8, 0) \
    F(43, 9, 0) \
    F(44, 10, 0) \
    F(45, 11, 0) \
    F(46, 12, 0) \
    F(47, 13, 0) \
    F(48, 14, 0) \
    F(49, 15, 0)
__device__ __forceinline__ int f2key(float f) { const int b = __float_as_int(f); return b ^ ((b >> 31) & 0x7fffffff); }
__device__ __forceinline__ float key2f(int k) { return __int_as_float(k ^ ((k >> 31) & 0x7fffffff)); }
__device__ __forceinline__ void sel_top16(const f32x16 (&acc)[4], int hi, int (&t)[16]) {
    int g1[16], g2[16], g3[16];
#pragma unroll
    for (int r = 0; r < 16; ++r) { const int n = (r & 3) + 8 * (r >> 2) + 4 * hi;
        t[r] = (f2key(acc[0][r]) & ~0x7F) | n; g1[r] = (f2key(acc[1][r]) & ~0x7F) | (32 + n); g2[r] = (f2key(acc[2][r]) & ~0x7F) | (64 + n); g3[r] = (f2key(acc[3][r]) & ~0x7F) | (96 + n); }
    sel_sort16(t); sel_sort16(g1); sel_sort16(g2); sel_sort16(g3);
    sel_merge16(t, g1); sel_merge16(g2, g3); sel_merge16(t, g2);
#pragma unroll
    for (int i = 0; i < 16; ++i) { auto rr = __builtin_amdgcn_permlane32_swap((unsigned)t[i], (unsigned)t[i], false, false); g1[i] = (int)(hi ? rr[0] : rr[1]); }
    sel_merge16(t, g1);
}
__device__ __forceinline__ void ph_select(const bf16_t* __restrict__ QP, const bf16_t* __restrict__ KEYS, int* __restrict__ idx, float* __restrict__ gate, LAS unsigned char* lds) {
    PH_IDS
    const int lane = TIDX & 63, hd = __builtin_amdgcn_readfirstlane(TIDX >> 6), r = lane & 31, hi = lane >> 5;
    LAS unsigned* my = (LAS unsigned*)(lds + hd * 2048) + lane;
    for (int tg = BIDX; tg < T / 32; tg += GDIM) {
        const int tok0 = tg * 32;
        int rk = r; asm volatile("" : "+v"(rk));
        int t1[16], t2[16];
#pragma unroll
        for (int half = 0; half < 2; ++half) {
            f32x16 acc[4];
#pragma unroll
            for (int mt = 0; mt < 4; ++mt)
#pragma unroll
                for (int i = 0; i < 16; ++i) acc[mt][i] = 0.f;
            const bf16_t* qb = QP + (size_t)(tok0 + r) * D + hd * QD + half * HALF + 8 * hi;
            const bf16_t* kb = KEYS + ((size_t)(hd * 2 + half) * NK + rk) * HALF + 8 * hi;
#pragma unroll
            for (int ks = 0; ks < 4; ++ks) {
                const bf16x8 b = *(const bf16x8*)(qb + 16 * ks);
#pragma unroll
                for (int mt = 0; mt < 4; ++mt) { const bf16x8 a = *(const bf16x8*)(kb + (size_t)mt * 32 * HALF + 16 * ks); acc[mt] = __builtin_amdgcn_mfma_f32_32x32x16_bf16(a, b, acc[mt], 0, 0, 0); }
            }
            if (half == 0) sel_top16(acc, hi, t1); else sel_top16(acc, hi, t2);
        }
        float f1[16], f2[16];
#pragma unroll
        for (int i = 0; i < 16; ++i) { f1[i] = key2f(t1[i]); f2[i] = key2f(t2[i]); }
        int c0[16], c1[16], c2[16], c3[16];
#pragma unroll
        for (int i = 0; i < 16; ++i) c3[i] = (int)0x80000000;
#define SEL_F(k, i, j) { const int v_ = (f2key(f1[i] + f2[j]) & ~0xFF) | ((i) << 4 | (j)); if ((k) < 16) c0[(k) & 15] = v_; else if ((k) < 32) c1[(k) & 15] = v_; else if ((k) < 48) c2[(k) & 15] = v_; else c3[(k) & 15] = v_; }
        SEL_CANDS(SEL_F)
#undef SEL_F
        sel_sort16(c0); sel_sort16(c1); sel_sort16(c2); SEL_CE(c3[0], c3[1]);
        sel_merge16(c0, c1); sel_merge16(c2, c3); sel_merge16(c0, c2);
#pragma unroll
        for (int j = 0; j < 4; ++j) {
            my[64 * j] = (unsigned)(t1[4 * j] & 0x7F) | ((unsigned)(t1[4 * j + 1] & 0x7F) << 8) | ((unsigned)(t1[4 * j + 2] & 0x7F) << 16) | ((unsigned)(t1[4 * j + 3] & 0x7F) << 24);
            my[64 * (4 + j)] = (unsigned)(t2[4 * j] & 0x7F) | ((unsigned)(t2[4 * j + 1] & 0x7F) << 8) | ((unsigned)(t2[4 * j + 2] & 0x7F) << 16) | ((unsigned)(t2[4 * j + 3] & 0x7F) << 24);
        }
        const float mx = key2f(c0[0]); float e[16], se = 0.f;
#pragma unroll
        for (int k = 0; k < 16; ++k) { e[k] = __expf(key2f(c0[k]) - mx); se += e[k]; }
        const float inv = 1.f / se;
        asm volatile("s_waitcnt lgkmcnt(0)" ::: "memory");
        const size_t o = (size_t)(tok0 + r) * 128 + hd * TOPK;
        if (hi == 0) {
            int id[16];
#pragma unroll
            for (int k = 0; k < 16; ++k) { const int code = c0[k] & 0xFF, i = code >> 4, j = code & 15;
                const unsigned w1 = my[64 * (i >> 2)], w2 = my[64 * (4 + (j >> 2))];
                id[k] = (int)((w1 >> (8 * (i & 3))) & 0x7F) * NK + (int)((w2 >> (8 * (j & 3))) & 0x7F); }
#pragma unroll
            for (int k = 0; k < 4; ++k) *(int4*)(idx + o + 4 * k) = make_int4(id[4 * k], id[4 * k + 1], id[4 * k + 2], id[4 * k + 3]);
        } else {
#pragma unroll
            for (int k = 0; k < 4; ++k) *(float4*)(gate + o + 4 * k) = make_float4(e[4 * k] * inv, e[4 * k + 1] * inv, e[4 * k + 2] * inv, e[4 * k + 3] * inv);
        }
        asm volatile("s_waitcnt lgkmcnt(0)" ::: "memory");
    }
}
}
#ifndef PROBE_MASK
#define PROBE_MASK 0
#endif
#define REPS(bit) (((PROBE_MASK >> (bit)) & 1) ? 2 : 1)
namespace nv {
constexpr int LDS_BYTES = 147456, MISC_OFF = 131072 + 320;
struct Params { const float* in[23]; float* out; unsigned char* ws; };

__global__ void __launch_bounds__(512, 2) k_mega(Params prm) {
    extern __shared__ __attribute__((aligned(16))) unsigned char lds_raw[];
    namespace cg = cooperative_groups;
    cg::grid_group grid = cg::this_grid();
    LAS unsigned char* lds = (LAS unsigned char*)lds_raw;
    unsigned char* smem = lds_raw;
    for (int u = threadIdx.x; u < (LDS_BYTES - 131072) / 4; u += 512) ((LAS unsigned*)(lds + 131072))[u] = 0u;
    __syncthreads();
    if (threadIdx.x == 0) {
        LAS unsigned long long* tab = (LAS unsigned long long*)(lds + TAB_OFF);
#pragma unroll
        for (int i = 0; i < 23; ++i) tab[i] = (unsigned long long)prm.in[i];
        tab[23] = (unsigned long long)prm.out; tab[24] = (unsigned long long)prm.ws;
    }
    __syncthreads();
#define ARG(i) ((const float*)ldarg(lds, (i)))
#define WSP() ((unsigned char*)ldarg(lds, 24))
    XcdBarrier bar = xcd_barrier_post((unsigned*)(WSP() + WS_CTL) + CW_BAR, (volatile LAS unsigned*)(lds + MISC_OFF) + 8);
#define GRID_BAR() do { xcd_barrier(bar); asm volatile("" ::: "memory"); } while (0)
    if (threadIdx.x == 0) { volatile LAS unsigned* M = (volatile LAS unsigned*)(lds + MISC_OFF); M[16] = bar.x; M[17] = xb_add((unsigned*)(WSP() + WS_CTL) + CW_RANK + 64 * bar.x, 1u); }
    for (int rep = 0; rep < REPS(0); ++rep) {
    p0_prologue(lds);
    { unsigned char* ws = WSP(); p0_peer_tables(ARG(20), ARG(21), ARG(17), ws + WS_PU, ws + WS_PV8); }
    { unsigned char* ws = WSP(); const float* pk = ARG(19); bf16_t* kb = (bf16_t*)(ws + WS_KEYS); for (int i = obid() * 512 + otid(); i < DEPTH * PH * 2 * NK * HALF; i += ogrid() * 512) kb[i] = f2bf(pk[i]); }
    { unsigned char* ws = WSP(); p0_ssm_a(ARG(3), ARG(4), ARG(5), ARG(6), ARG(7), (f32x2v*)(ws + WS_APOW), (f32x2v*)(ws + WS_BBAR)); }
    }
    GRID_BAR();
    if (threadIdx.x == 0) {
        volatile LAS unsigned* M = (volatile LAS unsigned*)(lds + MISC_OFF); unsigned* bw = (unsigned*)(WSP() + WS_CTL) + CW_BAR; unsigned tot = 0u, ok = 1u;
        for (unsigned j = 0; j < 16; ++j) { const unsigned cnt = xb_ld(&bw[XB_XCNT(j)]); tot += cnt; if ((j < 8) != (cnt > 0u)) ok = 0u; }
        M[18] = xb_ld(&bw[XB_XCNT(bar.x)]); M[19] = (ok && tot == gridDim.x) ? 1u : 0u;
    }
    __syncthreads();
    { unsigned char* ws = WSP(); p0_ssm_b((const f32x2v*)(ws + WS_APOW), (const f32x2v*)(ws + WS_BBAR), ARG(8), ARG(9), ARG(10), (bf16_t*)(ws + WS_KD), (bf16_t*)(ws + WS_WST), (bf16_t*)(ws + WS_WOUT)); }
    grid.sync();
#pragma nounroll
    for (int l_ = 0; l_ < DEPTH; ++l_) {
        int l = l_; asm volatile("" : "+s"(l));
        {
            unsigned char* ws = WSP(); bf16_t* hb = (bf16_t*)(ws + WS_HB); float* ss1 = (float*)(ws + WS_SSP) + (size_t)T * 32;
            for (int rep = 0; rep < REPS(1); ++rep) {
            SchedGen S; S.init_plain(hb, D * 2, (const bf16_t*)(ws + WS_BT1) + (size_t)l * 2048 * D, D * 2, T, 2048, D, ogrid(), obid());
            EpiInProj E{ss1, (bf16_t*)(ws + WS_UP), (bf16_t*)(ws + WS_Q)};
            ge::gemm_phase<EpiInProj, SchedGen>(lds, S, E, otid());
            }
            for (int rep = 0; rep < REPS(2); ++rep)
            ph_flogit(hb, (const bf16_t*)(ws + WS_WF) + (size_t)l * 16 * D, ss1, ARG(13) + l * NH, (float*)(ws + WS_LOGF));
        }
        GRID_BAR();
        {
            unsigned char* ws = WSP();
            for (int rep = 0; rep < REPS(3); ++rep) {
            SchedSsmS S; S.init(ws + WS_UP, (const bf16_t*)(ws + WS_WST) + (size_t)l * G * 128 * 256, ogrid(), obid());
            EpiSsmS E{(float*)(ws + WS_SLOC)};
            ge::gemm_phase<EpiSsmS, SchedSsmS>(lds, S, E, otid());
            }
            for (int rep = 0; rep < REPS(4); ++rep)
            ph_cum2((const float*)(ws + WS_LOGF), (float*)(ws + WS_CUM));
        }
        GRID_BAR();
        for (int rep = 0; rep < REPS(5); ++rep)
        { unsigned char* ws = WSP(); ph_ssm_prefix(lds, (const float*)(ws + WS_SLOC), (const f32x2v*)(ws + WS_APOW) + (size_t)l * G * 65 * P, (bf16_t*)(ws + WS_UP)); }
        GRID_BAR();
        {
            unsigned char* ws = WSP(); float* ssp_s = (float*)(ws + WS_SSP); float* ssp_a = ssp_s + (size_t)T * 8;
            for (int rep = 0; rep < REPS(6); ++rep)
            {
                SchedSsmC S; S.init(ws + WS_UP, (const bf16_t*)(ws + WS_WOUT) + (size_t)l * G * 1024 * 128, (const bf16_t*)(ws + WS_KD) + (size_t)l * G * KDW, ogrid(), obid());
                EpiSsmC E{(bf16_t*)(ws + WS_GEL)};
                ge::gemm_phase<EpiSsmC, SchedSsmC>(lds, S, E, otid());
            }
            for (int rep = 0; rep < REPS(7); ++rep)
            attn_body::attn_phase<8>((char*)lds_raw, (const attn_body::bf16*)(ws + WS_Q), (const attn_body::bf16*)(ws + WS_K), (const attn_body::bf16*)(ws + WS_V), (const float*)(ws + WS_CUM), (attn_body::bf16*)(ws + WS_MIX), ssp_a, (unsigned*)(ws + WS_CTL) + CW_QUEUE + 64 * (l * 2 + rep), (volatile LAS unsigned*)(lds + MISC_OFF) + 24, otid());
            GRID_BAR();
            for (int rep = 0; rep < REPS(8); ++rep) {
            SchedGen S; S.init_plain(ws + WS_GEL, 32, (const bf16_t*)(ws + WS_BT2) + (size_t)l * SSMW * SSMW, SSMW * 2, T, SSMW, SSMW, ogrid(), obid());
            S.a_c16_b = T * 32; S.a_kt_b = 4l * T * 32;
            EpiGlu2 E{(const bf16_t*)(ws + WS_GEL), ARG(12) + l * SSMW, (bf16_t*)(ws + WS_MIX), ssp_s};
            ge::gemm_phase<EpiGlu2, SchedGen>(lds, S, E, otid());
            }
        }
        GRID_BAR();
        {
            unsigned char* ws = WSP(); float* ssp_s = (float*)(ws + WS_SSP); float* ssp_a = ssp_s + (size_t)T * 8; float* ssp_2 = ssp_a + (size_t)T * 8;
            for (int rep = 0; rep < REPS(9); ++rep) {
            const bool dummy = rep + 1 < REPS(9);
            SchedGen S; S.init_plain(ws + WS_MIX, D * 2, (const bf16_t*)(ws + WS_BT3) + (size_t)l * D * D, D * 2, T, D, D, ogrid(), obid());
            EpiWo E{ssp_s, ssp_a, (const bf16_t*)(ws + WS_HB), dummy ? (bf16_t*)(ws + WS_QP) : (bf16_t*)(ws + WS_HB), dummy ? (float*)(ws + WS_SLOC) : ssp_2};
            ge::gemm_phase<EpiWo, SchedGen>(lds, S, E, otid());
            }
        }
        GRID_BAR();
        {
            unsigned char* ws = WSP(); float* ssp_2 = (float*)(ws + WS_SSP) + (size_t)T * 16;
            for (int rep = 0; rep < REPS(10); ++rep) {
            SchedGen S; S.init_plain(ws + WS_HB, D * 2, (const bf16_t*)(ws + WS_BT4) + (size_t)l * D * D, D * 2, T, D, D, ogrid(), obid());
            EpiWq E{ssp_2, (bf16_t*)(ws + WS_QP)};
            ge::gemm_phase<EpiWq, SchedGen>(lds, S, E, otid());
            }
        }
        GRID_BAR();
        for (int rep = 0; rep < REPS(11); ++rep)
        { unsigned char* ws = WSP(); ph_select((const bf16_t*)(ws + WS_QP), (const bf16_t*)(ws + WS_KEYS) + (size_t)l * PH * 2 * NK * HALF, (int*)(ws + WS_IDX), (float*)(ws + WS_GATE), lds); }
        GRID_BAR();
        if (PROBE_MASK & (1 << 16)) { unsigned char* ws = WSP(); ph_peer_u<0>(lds, ws + WS_PU + (size_t)l * NEXP * D, (const bf16_t*)(ws + WS_HB), (const int*)(ws + WS_IDX), (float*)(ws + WS_UP), 1023); }
        for (int rep = 0; rep < REPS(12); ++rep)
        { unsigned char* ws = WSP(); ph_peer_u<0>(lds, ws + WS_PU + (size_t)l * NEXP * D, (const bf16_t*)(ws + WS_HB), (const int*)(ws + WS_IDX), (float*)(ws + WS_PART)); }
        GRID_BAR();
        for (int rep = 0; rep < REPS(13); ++rep)
        { unsigned char* ws = WSP(); ph_peer_coef((const float*)(ws + WS_PART), (const float*)(ws + WS_SSP) + (size_t)T * 16, (const float*)(ws + WS_GATE), (float*)(ws + WS_COEF)); }
        GRID_BAR();
        if (PROBE_MASK & (1 << 17)) { unsigned char* ws = WSP();
          ph_peer_v<0>(lds, ws + WS_PV8 + (size_t)l * NEXP * D, (const int*)(ws + WS_IDX), (const float*)(ws + WS_COEF), (const bf16_t*)(ws + WS_HB), (bf16_t*)(ws + WS_UP), (float*)(ws + WS_SLOC), 1023); }
        for (int rep = 0; rep < REPS(14); ++rep)
        { unsigned char* ws = WSP(); const bool dummy = rep + 1 < REPS(14);
          ph_peer_v<0>(lds, ws + WS_PV8 + (size_t)l * NEXP * D, (const int*)(ws + WS_IDX), (const float*)(ws + WS_COEF), (const bf16_t*)(ws + WS_HB),
                    dummy ? (bf16_t*)(ws + WS_UP) : (bf16_t*)(ws + WS_HB), dummy ? (float*)(ws + WS_SLOC) : (float*)(ws + WS_SSP) + (size_t)T * 32); }
        if (PROBE_MASK & (1 << 15)) { for (int rep = 0; rep < 8; ++rep) GRID_BAR(); }
        GRID_BAR();
    }
    { unsigned char* ws = WSP(); ph_final((const bf16_t*)(ws + WS_HB), (const float*)(ws + WS_SSP) + (size_t)T * 32, ARG(22), (float*)ldarg(lds, 23)); }
}
}

extern "C" void kernel_launch(void* const* d_in, const int* in_sizes, int n_in, void* d_out, int out_size, void* d_ws, size_t ws_size, hipStream_t stream) {
    using namespace nv;
    static int grid_blocks = 0;
    if (!grid_blocks) {
        int dev = 0, cus = 0, per_cu = 0;
        (void)hipGetDevice(&dev);
        (void)hipDeviceGetAttribute(&cus, hipDeviceAttributeMultiprocessorCount, dev);
        if (hipFuncSetAttribute((const void*)k_mega, hipFuncAttributeMaxDynamicSharedMemorySize, LDS_BYTES) != hipSuccess) { fprintf(stderr, "hipFuncSetAttribute failed\n"); grid_blocks = -1; return; }
        (void)hipOccupancyMaxActiveBlocksPerMultiprocessor(&per_cu, (const void*)k_mega, 512, LDS_BYTES);
        if (per_cu < 1) { fprintf(stderr, "occupancy query returned %d\n", per_cu); (void)hipGetLastError(); }
        grid_blocks = cus;
    }
    if (grid_blocks < 0) return;
    if (ws_size < WS_END || n_in != 23) { fprintf(stderr, "bad workspace / inputs\n"); return; }
    (void)hipMemsetAsync((char*)d_ws + WS_CTL, 0, CTL_BYTES, stream);
    Params p{};
    for (int i = 0; i < 23; ++i) p.in[i] = (const float*)d_in[i];
    p.out = (float*)d_out; p.ws = (unsigned char*)d_ws;
    void* args[] = {&p};
    hipError_t e = hipLaunchCooperativeKernel((const void*)k_mega, dim3(grid_blocks), dim3(512), args, LDS_BYTES, stream);
    if (e != hipSuccess) fprintf(stderr, "cooperative launch failed: %s (grid %d)\n", hipGetErrorString(e), grid_blocks);
}
```

```cpp
#include <hip/hip_runtime.h>
#include <hip/hip_cooperative_groups.h>
#include <hip/hip_bf16.h>
#include <cstdint>
#include <cstdio>

#define LAS __attribute__((address_space(3)))
#define GAS __attribute__((address_space(1)))

namespace nv {
constexpr int D = 1024, BATCH = 8, SEQ = 4096, DEPTH = 4, T = BATCH * SEQ;
constexpr int SSMW = 512, G = 32, HC = 16, P = 64, ATTW = 512, HD = 64, NH = 8, INW = 2056;
constexpr int PH = 8, NK = 128, TOPK = 16, QD = 128, HALF = 64, NEXP = 16384;
constexpr int CHUNK = 64, NCH = T / CHUNK  , UPW = 128 + CHUNK * HC  ;
constexpr float EPS = 1e-6f;

typedef short bf16x8 __attribute__((ext_vector_type(8)));
typedef float f32x16 __attribute__((ext_vector_type(16)));
typedef float f32x4 __attribute__((ext_vector_type(4)));
typedef unsigned u32x4 __attribute__((ext_vector_type(4)));
typedef unsigned short bf16_t;

constexpr size_t MiB = 1u << 20;
constexpr size_t WS_CTL = 0, CTL_BYTES = 4 * MiB;
constexpr size_t WS_BT1 = 4 * MiB;
constexpr size_t WS_BT2 = 20 * MiB;
constexpr size_t WS_BT3 = 22 * MiB;
constexpr size_t WS_BT4 = 30 * MiB;
constexpr size_t WS_WF = 38 * MiB;
constexpr size_t WS_KEYS = 39 * MiB;
constexpr size_t WS_KD = 40 * MiB, WS_WOUT = 49 * MiB, WS_WST = 81 * MiB;
constexpr size_t WS_PU = 90 * MiB, WS_PV8 = 154 * MiB;
constexpr size_t WS_PART = 218 * MiB;
constexpr size_t WS_H = 346 * MiB;
constexpr size_t WS_HB = 474 * MiB;
constexpr size_t WS_UP = 538 * MiB;
constexpr size_t WS_Q = 576 * MiB, WS_K = 608 * MiB, WS_V = 640 * MiB;
constexpr size_t WS_LOGF = 672 * MiB, WS_CUM = 673 * MiB;
constexpr size_t WS_SLOC = 674 * MiB, WS_GEL = 708 * MiB, WS_MIX = 740 * MiB;
constexpr size_t WS_SSP = 916 * MiB;
constexpr size_t WS_QP = 852 * MiB;
constexpr size_t WS_IDX = 804 * MiB, WS_GATE = 820 * MiB, WS_COEF = 836 * MiB;
constexpr size_t WS_XN_F = 90 * MiB, WS_MIXED_F = 218 * MiB, WS_QP_F = 852 * MiB, WS_GEL_F = 90 * MiB  , WS_YSSM_F = 740 * MiB, WS_YATT_F = 674 * MiB;
constexpr size_t WS_END = 980 * MiB;
constexpr int CW_QUEUE = 1024;
constexpr int CW_RANK = 2048;
constexpr int CW_BAR = 4096;
constexpr int CW_SS = 65536;
constexpr int SS_H1 = 0  , SS_H2 = 5  , SS_SSM = 9, SS_ATT = 13;
static_assert((size_t)(CW_SS + 17 * T) * 4 <= CTL_BYTES, "ctl region");

__device__ __forceinline__ unsigned short f2bf(float f) { unsigned u = __float_as_uint(f); return (unsigned short)((u + 0x7fffu + ((u >> 16) & 1u)) >> 16); }
__device__ __forceinline__ float bf2f(unsigned short b) { return __uint_as_float(((unsigned)b) << 16); }
__device__ __forceinline__ unsigned pk2(float lo, float hi) { return (unsigned)f2bf(lo) | ((unsigned)f2bf(hi) << 16); }
__device__ __forceinline__ float gelu_tanh(float x) { const float u = 0.7978845608028654f * (x + 0.044715f * x * x * x); return 0.5f * x * (1.f + tanhf(u)); }
__device__ __forceinline__ float wave_sum(float v) {
#pragma unroll
    for (int o = 1; o < 64; o <<= 1) v += __shfl_xor(v, o);
    return v;
}
__device__ __forceinline__ int otid() { int t = threadIdx.x; asm volatile("" : "+v"(t)); return t; }
__device__ __forceinline__ int obid() { int t = blockIdx.x; asm volatile("" : "+s"(t)); return t; }
__device__ __forceinline__ int ogrid() { int t = gridDim.x; asm volatile("" : "+s"(t)); return t; }
#define PH_IDS const int TIDX = otid(), BIDX = obid(), GDIM = ogrid(); (void)TIDX; (void)BIDX; (void)GDIM;
__device__ __forceinline__ size_t up_index(int row, int c) { const int n = row >> 6, j = row & 63, g = c >> 4, hh = c & 15; return ((size_t)g * NCH + n) * UPW + 128 + j * HC + hh; }
}
namespace ge {
#define GE_LAS __attribute__((address_space(3)))
typedef unsigned short bf16_t;
typedef short bf16x8 __attribute__((ext_vector_type(8)));
typedef float f32x4 __attribute__((ext_vector_type(4)));
typedef unsigned u32x4 __attribute__((ext_vector_type(4)));
typedef unsigned u32x2 __attribute__((ext_vector_type(2)));
constexpr int ROWF_OFF = 131072 + 4096;
constexpr int BM = 256, BK = 64, HALF = 128, HTB = HALF * BK * 2  , STAGE_BYTES = 8 * HTB, NXCD = 8, WGM = 8;

__host__ __device__ __forceinline__ int lds_byte(int r, int c) { const int st = (r >> 4) * 2 + (c >> 5), rr = r & 15, cc = c & 31, ob = rr * 64 + cc * 2; return st * 1024 + (ob ^ (((ob >> 9) & 1) << 5)); }
__host__ __device__ __forceinline__ void stage_rc(int b, int& R, int& C) { const int st = b / 1024, sb = b % 1024, swz = sb ^ (((sb >> 9) & 1) << 5); R = (st >> 1) * 16 + swz / 64; C = (st & 1) * 32 + (swz % 64) / 2; }
__host__ __device__ __forceinline__ int perm32(int rho) { const int n = rho >> 4, i = rho & 15; return 8 * (i >> 2) + 4 * n + (i & 3); }

struct Unit { const char* A0; const char* B0; int nt; int pm, pn, aux; };
__device__ __forceinline__ unsigned cvt_pk_bf16(float lo, float hi) { unsigned r; asm volatile("v_cvt_pk_bf16_f32 %0, %1, %2" : "=v"(r) : "v"(lo), "v"(hi)); return r; }

__device__ __forceinline__ bool static_tile(int i, int G, int c, int nM, int nN, int& pm, int& pn) {
    const int nwg = nM * nN; const long L = (long)i * G + c; if (L >= nwg) return false;
    int wgid = (int)L; { const int q = nwg / NXCD, r = nwg % NXCD, xcd = wgid % NXCD, off = wgid / NXCD; wgid = (xcd < r ? xcd * (q + 1) : r * (q + 1) + (xcd - r) * q) + off; }
    const int nig = WGM * nN, gid = wgid / nig, fm = gid * WGM, gsz = (nM - fm) < WGM ? (nM - fm) : WGM;
    pm = fm + ((wgid % nig) % gsz); pn = (wgid % nig) / gsz; return true;
}

template <class Epi, class Sched>
__device__ __forceinline__ void gemm_phase(GE_LAS unsigned char* lds, const Sched& S, const Epi& E, int tid) {
    const int wid = __builtin_amdgcn_readfirstlane(tid >> 6), lane = tid & 63, wr = wid >> 2, wc = wid & 3, fr = lane & 15, fq = lane >> 4;
    unsigned voffA[2], voffB[2], voffB1[2];
#pragma unroll
    for (int i = 0; i < 2; ++i) { int R, C; stage_rc(tid * 16 + i * 8192, R, C); const int Rb = Epi::PERM ? ((R & ~31) + perm32(R & 31)) : R;
        voffA[i] = S.voffA(R, C); voffB[i] = S.voffB(Rb, C); if constexpr (Sched::DUALB) voffB1[i] = S.voffB1(Rb, C); else voffB1[i] = 0u; }
    const long hA = S.hA, hB = S.hB;
    const unsigned ldsw = (unsigned)wid * 1024u;
    const int aoff = lds_byte(wr * 64 + fr, fq * 8), boff = lds_byte(wc * 32 + fr, fq * 8);
#define GE_SA(b, h) (((b) * 2 + (h)) * HTB)
#define GE_SB(b, h) ((4 + (b) * 2 + (h)) * HTB)
#define GE_STAGE(bufoff, gbase, voff) do { _Pragma("unroll") for (int _i = 0; _i < 2; ++_i) \
        __builtin_amdgcn_global_load_lds((const unsigned*)((const char*)(gbase) + (voff)[_i]), (GE_LAS unsigned*)(lds + (bufoff) + ldsw + _i * 8192), 16, 0, 0); } while (0)
#define GE_STAGE_B(bufoff, gbase, sel, half) do { if constexpr (Sched::DUALB) { const char* _g = (const char*)(gbase) + ((half) ? ((sel) ? S.hB1 : hB) : 0l); _Pragma("unroll") for (int _i = 0; _i < 2; ++_i) { const unsigned _v = (sel) ? voffB1[_i] : voffB[_i]; \
        __builtin_amdgcn_global_load_lds((const unsigned*)(_g + _v), (GE_LAS unsigned*)(lds + (bufoff) + ldsw + _i * 8192), 16, 0, 0); } } else { GE_STAGE(bufoff, (const char*)(gbase) + ((half) ? hB : 0l), voffB); } } while (0)
#define GE_LDA(dst, b, h) do { _Pragma("unroll") for (int m = 0; m < 4; ++m) _Pragma("unroll") for (int k = 0; k < 2; ++k) dst[m][k] = *(const GE_LAS bf16x8*)(lds + GE_SA(b, h) + aoff + m * 2048 + k * 1024); } while (0)
#define GE_LDB(dst, b, h) do { _Pragma("unroll") for (int n = 0; n < 2; ++n) _Pragma("unroll") for (int k = 0; k < 2; ++k) dst[n][k] = *(const GE_LAS bf16x8*)(lds + GE_SB(b, h) + boff + n * 2048 + k * 1024); } while (0)
#define GE_MMA(ai, bj, At, Bt) do { __builtin_amdgcn_s_setprio(1); _Pragma("unroll") for (int m = 0; m < 4; ++m) _Pragma("unroll") for (int n = 0; n < 2; ++n) _Pragma("unroll") for (int k = 0; k < 2; ++k) \
        acc[ai][bj][m][n] = __builtin_amdgcn_mfma_f32_16x16x32_bf16(Bt[n][k], At[m][k], acc[ai][bj][m][n], 0, 0, 0); __builtin_amdgcn_s_setprio(0); } while (0)
#define GE_WAIT_V(n) asm volatile("s_waitcnt vmcnt(" #n ")" ::: "memory")
#define GE_WAIT_L(n) asm volatile("s_waitcnt lgkmcnt(" #n ")" ::: "memory")
#define GE_BAR __builtin_amdgcn_s_barrier()
#define GE_SCHED __builtin_amdgcn_sched_barrier(0)
    Unit cur, nxt; int ui = 0;
    if (!S.next(0, cur)) return;
    f32x4 acc[2][2][4][2];
#pragma unroll
    for (int a = 0; a < 2; ++a)
#pragma unroll
        for (int b = 0; b < 2; ++b)
#pragma unroll
            for (int m = 0; m < 4; ++m)
#pragma unroll
                for (int n = 0; n < 2; ++n) acc[a][b][m][n] = (f32x4){0.f, 0.f, 0.f, 0.f};
    bf16x8 At[4][2], B0[2][2], B1[2][2];
    if constexpr (Epi::UBEGIN) E.unit_begin(cur, tid, lds + ROWF_OFF);
    {
        const char* a0 = S.ta(cur, 0); const char* b0 = S.tb(cur, 0); const char* a1 = S.ta(cur, 1); const char* b1 = S.tb(cur, 1);
        const bool s0 = S.sb(cur, 0), s1 = S.sb(cur, 1);
        GE_STAGE_B(GE_SB(0, 0), b0, s0, 0); GE_STAGE_B(GE_SB(0, 1), b0, s0, 1); GE_STAGE(GE_SA(0, 0), a0, voffA); GE_STAGE(GE_SA(0, 1), a0 + hA, voffA);
        if (wr == 1) GE_BAR;
        GE_WAIT_V(2); GE_BAR;
        GE_STAGE_B(GE_SB(1, 0), b1, s1, 0); GE_STAGE(GE_SA(1, 0), a1, voffA); GE_STAGE_B(GE_SB(1, 1), b1, s1, 1);
        GE_WAIT_V(6); GE_BAR;
    }
    for (;;) {
        const bool has_next = S.next(ui + 1, nxt);
        const int nt = cur.nt;
        for (int t = 0; t < nt; t += 2) {
            const bool last = (t == nt - 2);
            const char* a1 = S.ta(cur, t + 1);
            const char* a2 = last ? (has_next ? S.ta(nxt, 0) : S.ta(cur, 0)) : S.ta(cur, t + 2);
            const char* b2 = last ? (has_next ? S.tb(nxt, 0) : S.tb(cur, 0)) : S.tb(cur, t + 2);
            const char* a3 = last ? (has_next ? S.ta(nxt, 1) : S.ta(cur, 1)) : S.ta(cur, t + 3);
            const char* b3 = last ? (has_next ? S.tb(nxt, 1) : S.tb(cur, 1)) : S.tb(cur, t + 3);
            const bool s2 = last ? (has_next ? S.sb(nxt, 0) : S.sb(cur, 0)) : S.sb(cur, t + 2), s3 = last ? (has_next ? S.sb(nxt, 1) : S.sb(cur, 1)) : S.sb(cur, t + 3);
            GE_LDB(B0, 0, 0); GE_LDB(B1, 0, 1); GE_SCHED; GE_LDA(At, 0, 0); GE_STAGE(GE_SA(1, 1), a1 + hA, voffA);
            GE_WAIT_V(8); GE_WAIT_L(0); GE_BAR; GE_MMA(0, 0, At, B0); GE_MMA(0, 1, At, B1); GE_BAR; GE_SCHED;
            GE_LDA(At, 0, 1); GE_STAGE_B(GE_SB(0, 0), b2, s2, 0); GE_STAGE_B(GE_SB(0, 1), b2, s2, 1); GE_STAGE(GE_SA(0, 0), a2, voffA);
            GE_WAIT_V(8); GE_WAIT_L(0); GE_BAR; GE_MMA(1, 0, At, B0); GE_MMA(1, 1, At, B1); GE_BAR; GE_SCHED;
            GE_LDB(B0, 1, 0); GE_LDB(B1, 1, 1); GE_SCHED; GE_LDA(At, 1, 0); GE_STAGE(GE_SA(0, 1), a2 + hA, voffA);
            GE_WAIT_V(8); GE_WAIT_L(0); GE_BAR; GE_MMA(0, 0, At, B0); GE_MMA(0, 1, At, B1); GE_BAR; GE_SCHED;
            GE_LDA(At, 1, 1); GE_STAGE_B(GE_SB(1, 0), b3, s3, 0); GE_STAGE_B(GE_SB(1, 1), b3, s3, 1); GE_STAGE(GE_SA(1, 0), a3, voffA);
            GE_WAIT_V(8); GE_WAIT_L(0); GE_BAR; GE_MMA(1, 0, At, B0); GE_MMA(1, 1, At, B1); GE_BAR; GE_SCHED;
            if constexpr (Epi::MIDK) { if (t + 2 == (nt >> 1)) E.midk(acc, cur, wr, fr, lds + ROWF_OFF + (ui & 1) * 2048); }
        }
        if (wr == 0) GE_BAR;
        E(acc, cur, wr, wc, fr, fq, lds + ROWF_OFF + (ui & 1) * 2048);
        if (!has_next) break;
        if constexpr (Epi::UBEGIN) E.unit_begin(nxt, tid, lds + ROWF_OFF + ((ui + 1) & 1) * 2048);
#pragma unroll
        for (int a = 0; a < 2; ++a)
#pragma unroll
            for (int b = 0; b < 2; ++b)
#pragma unroll
                for (int m = 0; m < 4; ++m)
#pragma unroll
                    for (int n = 0; n < 2; ++n) acc[a][b][m][n] = (f32x4){0.f, 0.f, 0.f, 0.f};
        cur = nxt; ++ui;
        if (wr == 1) GE_BAR;
    }
    GE_WAIT_V(0);
    GE_BAR;
#undef GE_SA
#undef GE_SB
#undef GE_STAGE
#undef GE_STAGE_B
#undef GE_LDA
#undef GE_LDB
#undef GE_MMA
#undef GE_WAIT_V
#undef GE_WAIT_L
#undef GE_BAR
#undef GE_SCHED
}
}
namespace nv {
__device__ __forceinline__ float sum16(const float* p);
__device__ __forceinline__ void ph_rmsnorm(const float* __restrict__ in, int ldi, const float* __restrict__ g, float* __restrict__ out, int ldo, int n, int rows) {
    PH_IDS
    const int lane = TIDX & 63, gw = BIDX * 8 + __builtin_amdgcn_readfirstlane(TIDX >> 6), ngw = GDIM * 8;
    for (int w = gw; w < rows; w += ngw) {
        const float* r = in + (size_t)w * ldi; float* o = out + (size_t)w * ldo;
        float s = 0.f;
        for (int c = lane; c < n; c += 64) { const float v = r[c]; s += v * v; }
        s = wave_sum(s);
        const float rs = rsqrtf(s / (float)n + EPS);
        for (int c = lane; c < n; c += 64) o[c] = r[c] * rs * g[c];
    }
}
__device__ __forceinline__ void ph_make_hb(const float* __restrict__ h, bf16_t* __restrict__ hb, float* __restrict__ ss) {
    PH_IDS
    const int lane = TIDX & 63, gw = BIDX * 8 + __builtin_amdgcn_readfirstlane(TIDX >> 6), ngw = GDIM * 8;
    for (int w = gw; w < T; w += ngw) {
        const f32x4* r = (const f32x4*)(h + (size_t)w * D) + lane; unsigned long long* o = (unsigned long long*)(hb + (size_t)w * D) + lane;
        float s = 0.f;
#pragma unroll
        for (int j = 0; j < 4; ++j) { const f32x4 v = r[64 * j]; s += v.x * v.x + v.y * v.y + v.z * v.z + v.w * v.w; o[64 * j] = (unsigned long long)pk2(v.x, v.y) | ((unsigned long long)pk2(v.z, v.w) << 32); }
        s = wave_sum(s);
        if (lane == 0) ss[w] = s;
    }
}

template <class Epi>
__device__ __forceinline__ void ph_gemm(unsigned char* sm, const float* __restrict__ A, int lda, const float* __restrict__ B, int ldb, int M, int N, int K, Epi epi) {
    PH_IDS
    const int team = TIDX >> 8, tid = TIDX & 255, wave = tid >> 6, lane = tid & 63;
    unsigned short (*As)[40] = (unsigned short (*)[40])(sm + team * 20480); unsigned short (*Bs)[40] = (unsigned short (*)[40])(sm + team * 20480 + 10240);
    const int ntn = (N + 127) / 128, ntiles = ntn * (M / 128);
    const int wm = (wave >> 1) * 64, wn = (wave & 1) * 64;
    for (int it = BIDX; it < ntiles / 2; it += GDIM) {
        const int tile = it * 2 + team, m0 = (tile / ntn) * 128, n0 = (tile % ntn) * 128;
        f32x16 acc[2][2];
#pragma unroll
        for (int i = 0; i < 2; ++i)
#pragma unroll
            for (int j = 0; j < 2; ++j)
#pragma unroll
                for (int r = 0; r < 16; ++r) acc[i][j][r] = 0.f;
        for (int k0 = 0; k0 < K; k0 += 32) {
#pragma unroll
            for (int i = 0; i < 4; ++i) {
                const int idx = tid + i * 256, r = idx >> 3, c = (idx & 7) * 4;
                const float4 v = *(const float4*)(A + (size_t)(m0 + r) * lda + k0 + c);
                As[r][c] = f2bf(v.x); As[r][c + 1] = f2bf(v.y); As[r][c + 2] = f2bf(v.z); As[r][c + 3] = f2bf(v.w);
            }
#pragma unroll
            for (int i = 0; i < 4; ++i) {
                const int idx = tid + i * 256, k = idx >> 5, c = (idx & 31) * 4, n = n0 + c;
                float4 v = make_float4(0.f, 0.f, 0.f, 0.f);
                if (n + 3 < N) v = *(const float4*)(B + (size_t)(k0 + k) * ldb + n);
                Bs[c][k] = f2bf(v.x); Bs[c + 1][k] = f2bf(v.y); Bs[c + 2][k] = f2bf(v.z); Bs[c + 3][k] = f2bf(v.w);
            }
            __syncthreads();
#pragma unroll
            for (int ks = 0; ks < 2; ++ks) {
                bf16x8 a[2], b[2];
#pragma unroll
                for (int i = 0; i < 2; ++i) a[i] = *(const bf16x8*)&As[wm + i * 32 + (lane & 31)][ks * 16 + (lane >> 5) * 8];
#pragma unroll
                for (int j = 0; j < 2; ++j) b[j] = *(const bf16x8*)&Bs[wn + j * 32 + (lane & 31)][ks * 16 + (lane >> 5) * 8];
#pragma unroll
                for (int i = 0; i < 2; ++i)
#pragma unroll
                    for (int j = 0; j < 2; ++j) acc[i][j] = __builtin_amdgcn_mfma_f32_32x32x16_bf16(a[i], b[j], acc[i][j], 0, 0, 0);
            }
            __syncthreads();
        }
#pragma unroll
        for (int i = 0; i < 2; ++i)
#pragma unroll
            for (int j = 0; j < 2; ++j)
#pragma unroll
                for (int r = 0; r < 16; ++r) {
                    const int row = m0 + wm + i * 32 + (r & 3) + 8 * (r >> 2) + 4 * (lane >> 5), col = n0 + wn + j * 32 + (lane & 31);
                    if (col < N) epi(row, col, acc[i][j][r]);
                }
    }
}
struct EpiStore { float* C; int ldc; int pad; __device__ void operator()(int r, int c, float v) const { C[(size_t)r * ldc + c] = v; } };
struct EpiAdd { float* C; int ldc; int pad; __device__ void operator()(int r, int c, float v) const { C[(size_t)r * ldc + c] += v; } };
struct EpiGlu { const float* gel; const float* bias; float* out; __device__ void operator()(int r, int c, float v) const {
    const float gg = gel[(size_t)r * SSMW + c]; out[(size_t)r * SSMW + c] = gg / (1.f + expf(-(v + bias[c]))); } };

__device__ __forceinline__ void ph_ssm(const bf16_t* __restrict__ UP, const float* __restrict__ lam_re, const float* __restrict__ lam_im, const float* __restrict__ log_dt,
                                       const float* __restrict__ b_re, const float* __restrict__ b_im, const float* __restrict__ c_re, const float* __restrict__ c_im,
                                       const float* __restrict__ dsk, bf16_t* __restrict__ gel) {
    PH_IDS
    const int p = TIDX & 63, wv = __builtin_amdgcn_readfirstlane(TIDX >> 6);
    for (int item = BIDX + GDIM * wv; item < BATCH * G; item += GDIM * 8) {
        const int b = item / G, g = item % G;
        const float dt = expf(log_dt[g]);
        const float lr = lam_re[g * P + p], li = lam_im[g * P + p];
        const float mag = expf(lr * dt), are = mag * cosf(li * dt), aim = mag * sinf(li * dt);
        const float den = lr * lr + li * li, nr = are - 1.f;
        const float zre = (nr * lr + aim * li) / den, zim = (aim * lr - nr * li) / den;
        float bbr[HC], bbi[HC], cr[HC], ci[HC];
#pragma unroll
        for (int h = 0; h < HC; ++h) {
            const float br = b_re[(g * P + p) * HC + h], bi = b_im[(g * P + p) * HC + h];
            bbr[h] = zre * br - zim * bi; bbi[h] = zre * bi + zim * br;
            cr[h] = c_re[(g * HC + h) * P + p]; ci[h] = c_im[(g * HC + h) * P + p];
        }
        const float dmine = dsk[g * HC + (p & 15)];
        float sre = 0.f, sim = 0.f;
        for (int t = 0; t < SEQ; ++t) {
            const bf16_t* u = UP + up_index(b * SEQ + t, g * HC);
            float xr = 0.f, xi = 0.f, um = 0.f;
#pragma unroll
            for (int h = 0; h < HC; ++h) { const float uv = bf2f(u[h]); xr += bbr[h] * uv; xi += bbi[h] * uv; if ((p & 15) == h) um = uv; }
            const float nre = are * sre - aim * sim + xr, nim = are * sim + aim * sre + xi;
            sre = nre; sim = nim;
            float ymine = 0.f;
#pragma unroll
            for (int h = 0; h < HC; ++h) { const float v = wave_sum(cr[h] * sre - ci[h] * sim); if ((p & 15) == h) ymine = v; }
            if (p < HC) gel[((size_t)g * T + b * SEQ + t) * HC + p] = f2bf(gelu_tanh(ymine + dmine * um));
        }
    }
}

__device__ __forceinline__ void ph_cum(const float* __restrict__ logf, float* __restrict__ cum) {
    PH_IDS
    if (BIDX != GDIM - 1 || __builtin_amdgcn_readfirstlane(TIDX >> 6) != 7) return;
    const int i = TIDX & 63;
    const int b = i / NH, h = i % NH; float c = 0.f;
    for (int t = 0; t < SEQ; ++t) { c += logf[(size_t)(b * SEQ + t) * NH + h]; cum[(size_t)i * SEQ + t] = c * 1.4426950408889634f; }
}

__device__ __forceinline__ void ph_attn(const bf16_t* __restrict__ Q, const bf16_t* __restrict__ Kb, const bf16_t* __restrict__ Vb, const float* __restrict__ cum, bf16_t* __restrict__ MIX, float* __restrict__ ssp_att) {
    PH_IDS
    const int gw = BIDX * 8 + __builtin_amdgcn_readfirstlane(TIDX >> 6), ngw = GDIM * 8, lane = TIDX & 63;
    constexpr int NIT = BATCH * NH * (SEQ / 64);
    for (int it0 = gw; it0 < NIT; it0 += ngw) {
        const int it = NIT - 1 - it0;
        const int tb = it / (BATCH * NH), bh = it % (BATCH * NH), b = bh / NH, h = bh % NH;
        const int t = tb * 64 + lane;
        float q[HD], o[HD];
#pragma unroll
        for (int d = 0; d < HD; ++d) { q[d] = bf2f(Q[(size_t)(b * SEQ + t) * ATTW + h * HD + d]) * 0.125f; o[d] = 0.f; }
        const float* cm = cum + (size_t)bh * SEQ; const float ct = cm[t];
        float m = -INFINITY, l = 0.f;
        const int smax = tb * 64 + 63;
        for (int s = 0; s <= smax; ++s) {
            const bf16_t* kr = Kb + (size_t)(b * SEQ + s) * ATTW + h * HD; const bf16_t* vr = Vb + (size_t)(b * SEQ + s) * ATTW + h * HD;
            float lg = ct - cm[s];
#pragma unroll
            for (int d = 0; d < HD; ++d) lg += q[d] * bf2f(kr[d]);
            if (s <= t) {
                const float mn = fmaxf(m, lg), sc = expf(m - mn), pp = expf(lg - mn);
                l = l * sc + pp; m = mn;
#pragma unroll
                for (int d = 0; d < HD; ++d) o[d] = o[d] * sc + pp * bf2f(vr[d]);
            }
        }
        const float il = 1.f / l; float sq = 0.f;
#pragma unroll
        for (int d = 0; d < HD; ++d) { const float ov = o[d] * il; sq += ov * ov; MIX[(size_t)(b * SEQ + t) * D + SSMW + h * HD + d] = f2bf(ov); }
        ssp_att[(size_t)(b * SEQ + t) * 8 + h] = sq;
    }
}

__device__ __forceinline__ void ph_peer_select(unsigned char* sm, const bf16_t* __restrict__ qp, const float* __restrict__ keys, int* __restrict__ idx, float* __restrict__ gate) {
    PH_IDS
    const int team = TIDX >> 8, tid = TIDX & 255, lane = tid & 63, wave = tid >> 6;
    float* sc = (float*)(sm + team * 4096); float* tv = sc + 256; int* ti = (int*)(tv + 32); float* cand = (float*)(ti + 32);
    for (int it = BIDX; it < T * PH / 2; it += GDIM) {
        const int item = it * 2 + team, tok = item / PH, hd = item % PH;
        {
            const int half = tid >> 7, n = tid & 127;
            const bf16_t* q = qp + (size_t)tok * D + hd * QD + half * HALF; const float* kk = keys + ((size_t)(hd * 2 + half) * NK + n) * HALF;
            float s = 0.f;
            for (int d = 0; d < HALF; ++d) s += bf2f(q[d]) * kk[d];
            sc[tid] = s;
        }
        __syncthreads();
        if (wave == 0 || wave == 2) {
            const int half = wave >> 1;
            float v0 = sc[half * 128 + lane], v1 = sc[half * 128 + lane + 64];
            for (int k = 0; k < TOPK; ++k) {
                float bv; int bi;
                if (v0 >= v1) { bv = v0; bi = lane; } else { bv = v1; bi = lane + 64; }
#pragma unroll
                for (int o = 1; o < 64; o <<= 1) { const float ov = __shfl_xor(bv, o); const int oi = __shfl_xor(bi, o); if (ov > bv || (ov == bv && oi < bi)) { bv = ov; bi = oi; } }
                if (lane == 0) { tv[half * 16 + k] = bv; ti[half * 16 + k] = bi; }
                if (bi == lane) v0 = -INFINITY; if (bi == lane + 64) v1 = -INFINITY;
            }
        }
        __syncthreads();
        cand[tid] = tv[tid >> 4] + tv[16 + (tid & 15)];
        __syncthreads();
        if (wave == 0) {
            float v[4];
#pragma unroll
            for (int j = 0; j < 4; ++j) v[j] = cand[lane + 64 * j];
            float best = 0.f; int bidx = 0; float mx = 0.f, se = 0.f;
            for (int k = 0; k < TOPK; ++k) {
                float bv = v[0]; int bi = lane;
#pragma unroll
                for (int j = 1; j < 4; ++j) if (v[j] > bv) { bv = v[j]; bi = lane + 64 * j; }
#pragma unroll
                for (int o = 1; o < 64; o <<= 1) { const float ov = __shfl_xor(bv, o); const int oi = __shfl_xor(bi, o); if (ov > bv || (ov == bv && oi < bi)) { bv = ov; bi = oi; } }
                if (k == 0) mx = bv;
                const float e = expf(bv - mx); se += e;
                if (lane == k) { best = e; bidx = ti[bi >> 4] * NK + ti[16 + (bi & 15)]; }
#pragma unroll
                for (int j = 0; j < 4; ++j) if (bi == lane + 64 * j) v[j] = -INFINITY;
            }
            if (lane < TOPK) { idx[(size_t)tok * 128 + hd * TOPK + lane] = bidx; gate[(size_t)tok * 128 + hd * TOPK + lane] = best / se; }
        }
        __syncthreads();
    }
}

__device__ __forceinline__ void ph_peer_eval(unsigned char* sm, const float* __restrict__ ss2, const float* __restrict__ g2, const int* __restrict__ idx, const float* __restrict__ gate,
                                             const float* __restrict__ ut, const float* __restrict__ vt, float* __restrict__ h) {
    PH_IDS
    const int team = TIDX >> 8, tid = TIDX & 255, lane = tid & 63, wave = tid >> 6;
    float (*red)[D] = (float (*)[D])(sm + team * 16384);
    for (int it = BIDX; it < T / 2; it += GDIM) {
        const int tok = it * 2 + team;
        float4 x[4], acc[4];
#pragma unroll
        for (int j = 0; j < 4; ++j) { const float rs = rsqrtf(sum16(ss2 + (size_t)tok * 16) * (1.f / D) + EPS); const float4 hv = *(const float4*)(h + (size_t)tok * D + j * 256 + lane * 4); const float4 gv = *(const float4*)(g2 + j * 256 + lane * 4);
            x[j] = make_float4(hv.x * rs * gv.x, hv.y * rs * gv.y, hv.z * rs * gv.z, hv.w * rs * gv.w); acc[j] = make_float4(0.f, 0.f, 0.f, 0.f); }
        for (int k = 0; k < 32; ++k) {
            const int pr = wave * 32 + k; const int e = idx[(size_t)tok * 128 + pr]; const float gt = gate[(size_t)tok * 128 + pr];
            const float* ur = ut + (size_t)e * D; const float* vr = vt + (size_t)e * D;
            float s = 0.f;
#pragma unroll
            for (int j = 0; j < 4; ++j) { const float4 uv = *(const float4*)(ur + j * 256 + lane * 4); s += uv.x * x[j].x + uv.y * x[j].y + uv.z * x[j].z + uv.w * x[j].w; }
            s = wave_sum(s);
            const float cf = gelu_tanh(s) * gt;
#pragma unroll
            for (int j = 0; j < 4; ++j) { const float4 vv = *(const float4*)(vr + j * 256 + lane * 4); acc[j].x += cf * vv.x; acc[j].y += cf * vv.y; acc[j].z += cf * vv.z; acc[j].w += cf * vv.w; }
        }
#pragma unroll
        for (int j = 0; j < 4; ++j) *(float4*)&red[wave][j * 256 + lane * 4] = acc[j];
        __syncthreads();
        for (int c = tid; c < D; c += 256) h[(size_t)tok * D + c] += red[0][c] + red[1][c] + red[2][c] + red[3][c];
        __syncthreads();
    }
}
}
namespace nv {
__device__ __forceinline__ float sum8(const float* p);
__device__ __forceinline__ float sum16(const float* p);
#define XB_TMO      128
#define XB_XCNT(j)  (256  + 64 * (j))
#define XB_XSUB(j)  (1280 + 64 * (j))
#define XB_XGEN(j)  (2304 + 64 * (j))
#define XB_TOP      3328
#define XB_TOPGEN   3392
#define XCD_BAR_WORDS 3456
#define XB_SPIN_CAP (1u << 24)
__device__ __forceinline__ unsigned xb_ld(unsigned* p)              { return __hip_atomic_load(p, __ATOMIC_RELAXED, __HIP_MEMORY_SCOPE_AGENT); }
__device__ __forceinline__ unsigned xb_add(unsigned* p, unsigned v) { return __hip_atomic_fetch_add(p, v, __ATOMIC_RELAXED, __HIP_MEMORY_SCOPE_AGENT); }
__device__ __forceinline__ unsigned xb_xcc_id() { return (unsigned)__builtin_amdgcn_s_getreg((3 << 11) | 20) & 0xFu; }
#define XB_SPIN(cond, bar) do { unsigned _sp = 0; while (cond) { __builtin_amdgcn_s_sleep(1); \
    if ((++_sp & 255u) == 0u) { if (xb_ld(&(bar)[XB_TMO])) break; if (_sp > XB_SPIN_CAP) { atomicAdd(&(bar)[XB_TMO], 1u); break; } } } } while (0)
struct XcdBarrier { unsigned* bar; unsigned x; volatile LAS unsigned* st; };
__device__ __forceinline__ XcdBarrier xcd_barrier_post(unsigned* bar, volatile LAS unsigned* st) {
    XcdBarrier b; b.bar = bar; b.x = xb_xcc_id(); b.st = st;
    if (threadIdx.x == 0) (void)xb_add(&bar[XB_XCNT(b.x)], 1u);
    return b;
}
__device__ __forceinline__ void xcd_barrier_complete(unsigned* bar, unsigned x, unsigned& nloc, unsigned& nx) {
    const unsigned Gsz = gridDim.x * gridDim.y * gridDim.z;
    unsigned sum, cnt, mine, sp = 0u;
    for (;;) {
        sum = 0u; cnt = 0u; mine = 0u;
#pragma unroll
        for (unsigned j = 0; j < 16; ++j) { const unsigned c = xb_ld(&bar[XB_XCNT(j)]); sum += c; cnt += (c > 0u) ? 1u : 0u; mine = (j == x) ? c : mine; }
        if (sum == Gsz) break;
        __builtin_amdgcn_s_sleep(1);
        if ((++sp & 255u) == 0u) { if (xb_ld(&bar[XB_TMO])) break; if (sp > XB_SPIN_CAP) { atomicAdd(&bar[XB_TMO], 1u); break; } }
    }
    nloc = mine > 0u ? mine : 1u; nx = cnt > 0u ? cnt : 1u;
}
__device__ __forceinline__ void xcd_barrier(const XcdBarrier& b) {
    asm volatile("s_waitcnt vmcnt(0)" ::: "memory");
    __syncthreads();
    if (threadIdx.x == 0) {
        unsigned* bar = b.bar;
        __builtin_amdgcn_s_waitcnt(0);
        unsigned nloc = b.st[0], nx = b.st[1];
        if (nloc == 0u) { xcd_barrier_complete(bar, b.x, nloc, nx); b.st[0] = nloc; b.st[1] = nx; }
        const unsigned old = xb_add(&bar[XB_XSUB(b.x)], 1u);
        const unsigned gen = old / nloc;
        if (old + 1u == (gen + 1u) * nloc) {
            __builtin_amdgcn_fence(__ATOMIC_RELEASE, "agent");
            asm volatile("s_waitcnt vmcnt(0)" ::: "memory");
            const unsigned og = xb_add(&bar[XB_TOP], 1u);
            const unsigned tg = og / nx;
            if (og + 1u == (tg + 1u) * nx) xb_add(&bar[XB_TOPGEN], 1u);
            else XB_SPIN(xb_ld(&bar[XB_TOPGEN]) == tg, bar);
            __builtin_amdgcn_fence(__ATOMIC_ACQUIRE, "agent");
            xb_add(&bar[XB_XGEN(b.x)], 1u);
            asm volatile("s_waitcnt vmcnt(0)" ::: "memory");
        } else {
            XB_SPIN(xb_ld(&bar[XB_XGEN(b.x)]) == gen, bar);
            __builtin_amdgcn_fence(__ATOMIC_ACQUIRE, "agent");
            asm volatile("s_waitcnt vmcnt(0)" ::: "memory");
        }
    }
    __syncthreads();
}

#define LDS_WAIT() asm volatile("s_waitcnt lgkmcnt(0)" ::: "memory")
template <class Sc>
__device__ __forceinline__ void p0_transpose_item(const float* __restrict__ W, int ldw, int K, int Ncols, Sc sc, bf16_t* __restrict__ WT, LAS float* scr, int item, int lane) {
    const int nblk = Ncols / 32, kb = item / nblk, nb = item % nblk, k0 = 64 * kb, n0 = 32 * nb;
#pragma unroll 8
    for (int i = 0; i < 32; ++i) { const int kk = 2 * i + (lane >> 5); scr[kk * 33 + (lane & 31)] = W[(size_t)(k0 + kk) * ldw + n0 + (lane & 31)] * sc(k0 + kk); }
    LDS_WAIT(); asm volatile("" ::: "memory");
    const int c = lane & 7;
#pragma unroll
    for (int j = 0; j < 4; ++j) { const int n = (lane >> 3) + 8 * j; const LAS float* s = scr + (8 * c) * 33 + n;
        u32x4 o; o.x = pk2(s[0 * 33], s[1 * 33]); o.y = pk2(s[2 * 33], s[3 * 33]); o.z = pk2(s[4 * 33], s[5 * 33]); o.w = pk2(s[6 * 33], s[7 * 33]);
        *(u32x4*)(WT + (size_t)(n0 + n) * K + k0 + 8 * c) = o; }
    LDS_WAIT(); asm volatile("" ::: "memory");
}
struct ScVec { const float* g; __device__ __forceinline__ float operator()(int k) const { return g[k]; } };
struct ScOne { __device__ __forceinline__ float operator()(int) const { return 1.f; } };
struct ScTwo { const float* g0; const float* g1; __device__ __forceinline__ float operator()(int k) const { return k < 512 ? g0[k] : g1[k - 512]; } };

constexpr int TAB_OFF = 131072 + 1024;
__device__ __forceinline__ void* ldarg(LAS unsigned char* lds, int i) {
    unsigned off = TAB_OFF + 8 * i; asm volatile("" : "+s"(off));
    const unsigned long long v = *(volatile LAS unsigned long long*)(lds + off);
    const unsigned lo = __builtin_amdgcn_readfirstlane((unsigned)v), hi = __builtin_amdgcn_readfirstlane((unsigned)(v >> 32));
    return (void*)(GAS void*)(((unsigned long long)hi << 32) | lo);
}

__device__ __forceinline__ void p0_prologue(LAS unsigned char* lds) {
    PH_IDS
    const int lane = TIDX & 63, wave = __builtin_amdgcn_readfirstlane(TIDX >> 6), gw = BIDX * 8 + wave, ngw = GDIM * 8;
    LAS float* scr = (LAS float*)(lds + wave * 16384);
    unsigned char* ws = (unsigned char*)ldarg(lds, 24);
    const float* a0 = (const float*)ldarg(lds, 0); const float* a1 = (const float*)ldarg(lds, 1); const float* a2 = (const float*)ldarg(lds, 2); const float* a11 = (const float*)ldarg(lds, 11);
    const float* a14 = (const float*)ldarg(lds, 14); const float* a15 = (const float*)ldarg(lds, 15); const float* a16 = (const float*)ldarg(lds, 16); const float* a17 = (const float*)ldarg(lds, 17); const float* a18 = (const float*)ldarg(lds, 18);
    constexpr int I1 = (D / 64) * (2048 / 32), I2 = (SSMW / 64) * (SSMW / 32), I3 = (D / 64) * (D / 32), I4 = I3, IL = I1 + I2 + I3 + I4;
    for (int it = gw; it < DEPTH * IL; it += ngw) {
        const int l = it / IL; int r = it % IL;
        if (r < I1) { p0_transpose_item(a2 + (size_t)l * D * INW, INW, D, 2048, ScVec{a1 + l * D}, (bf16_t*)(ws + WS_BT1) + (size_t)l * 2048 * D, scr, r, lane); continue; } r -= I1;
        if (r < I2) { p0_transpose_item(a11 + (size_t)l * SSMW * SSMW, SSMW, SSMW, SSMW, ScOne{}, (bf16_t*)(ws + WS_BT2) + (size_t)l * SSMW * SSMW, scr, r, lane); continue; } r -= I2;
        if (r < I3) { p0_transpose_item(a16 + (size_t)l * D * D, D, D, D, ScTwo{a14 + l * SSMW, a15 + l * ATTW}, (bf16_t*)(ws + WS_BT3) + (size_t)l * D * D, scr, r, lane); continue; } r -= I3;
        p0_transpose_item(a18 + (size_t)l * D * D, D, D, D, ScVec{a17 + l * D}, (bf16_t*)(ws + WS_BT4) + (size_t)l * D * D, scr, r, lane);
    }
    for (int i = BIDX * 512 + TIDX; i < DEPTH * 16 * D; i += GDIM * 512) {
        const int l = i / (16 * D), j = (i / D) % 16, k = i % D;
        const float v = j < 8 ? a2[((size_t)l * D + k) * INW + 2048 + j] * a1[l * D + k] : 0.f;
        ((bf16_t*)(ws + WS_WF))[i] = f2bf(v);
    }
    {
        const float* x = a0; bf16_t* hb = (bf16_t*)(ws + WS_HB); float* ssp1 = (float*)(ws + WS_SSP) + (size_t)T * 32;
        for (int w = gw; w < T; w += ngw) {
            const f32x4* r = (const f32x4*)(x + (size_t)w * D) + lane; unsigned long long* o = (unsigned long long*)(hb + (size_t)w * D) + lane;
            float s = 0.f;
#pragma unroll
            for (int j = 0; j < 4; ++j) { const f32x4 v = r[64 * j]; const unsigned w0 = pk2(v.x, v.y), w1 = pk2(v.z, v.w); o[64 * j] = (unsigned long long)w0 | ((unsigned long long)w1 << 32);
                const float a = __uint_as_float(w0 << 16), b = __uint_as_float(w0 & 0xffff0000u), c = __uint_as_float(w1 << 16), d = __uint_as_float(w1 & 0xffff0000u); s += (a * a + b * b) + (c * c + d * d); }
            s = wave_sum(s);
            if (lane < 8) ssp1[(size_t)w * 8 + lane] = lane == 0 ? s : 0.f;
        }
    }
}

struct SchedGen {
    static constexpr bool DUALB = false; long hB1;
    __device__ __forceinline__ bool sb(const ge::Unit&, int) const { return false; }
    __device__ __forceinline__ unsigned voffB1(int, int) const { return 0u; }
    const char* A; const char* B; int a_row_b, a_c16_b, b_row_b, b_c16_b; long a_pm_b, a_kt_b, b_pn_b, b_kt_b; int nM, nN, nt, G, c; long hA, hB;
    __device__ __forceinline__ void init_plain(const void* A_, int lda_bytes, const void* B_, int ldb_bytes, int M, int N, int K, int G_, int c_) {
        A = (const char*)A_; B = (const char*)B_; a_row_b = lda_bytes; a_c16_b = 32; b_row_b = ldb_bytes; b_c16_b = 32; a_pm_b = 256l * lda_bytes; a_kt_b = 128; b_pn_b = 256l * ldb_bytes; b_kt_b = 128;
        nM = M / 256; nN = N / 256; nt = K / 64; G = G_; c = c_; hA = 128l * lda_bytes; hB = 128l * ldb_bytes; }
    __device__ __forceinline__ bool next(int i, ge::Unit& u) const {
        int pm, pn; if (!ge::static_tile(i, G, c, nM, nN, pm, pn)) return false;
        u.A0 = A + (size_t)pm * a_pm_b; u.B0 = B + (size_t)pn * b_pn_b; u.nt = nt; u.pm = pm; u.pn = pn; u.aux = 0; return true; }
    __device__ __forceinline__ const char* ta(const ge::Unit& u, int t) const { return u.A0 + t * a_kt_b; }
    __device__ __forceinline__ const char* tb(const ge::Unit& u, int t) const { return u.B0 + t * b_kt_b; }
    __device__ __forceinline__ unsigned voffA(int R, int C) const { return (unsigned)(R * a_row_b + (C >> 4) * a_c16_b + (C & 15) * 2); }
    __device__ __forceinline__ unsigned voffB(int Rb, int C) const { return (unsigned)(Rb * b_row_b + (C >> 4) * b_c16_b + (C & 15) * 2); }
};
typedef SchedGen SchedPlain;

constexpr float QSCALE = 0.125f * 1.4426950408889634f;
struct EpiInProj {
    static constexpr bool PERM = true, MIDK = false, UBEGIN = true;
    const float* ssp1; bf16_t* UP; bf16_t* QKV;
    __device__ __forceinline__ void unit_begin(const ge::Unit& u, int tid, LAS unsigned char* rowf) const {
        if (tid < 256) { const int row = u.pm * 256 + tid; ((LAS float*)rowf)[tid] = rsqrtf(sum8(ssp1 + (size_t)row * 8) * (1.f / D) + EPS); }
    }
    __device__ __forceinline__ void midk(ge::f32x4 (&)[2][2][4][2], const ge::Unit&, int, int, LAS unsigned char*) const {}
    __device__ __forceinline__ void operator()(const ge::f32x4 (&acc)[2][2][4][2], const ge::Unit& u, int wr, int wc, int fr, int fq, LAS unsigned char* rowf) const {
        const int row0 = u.pm * 256 + wr * 64 + fr, colt = u.pn * 256, region = colt >> 9;
        bf16_t* dstb = QKV + (size_t)(region - 1) * ((WS_K - WS_Q) / 2);
#pragma unroll
        for (int ai = 0; ai < 2; ++ai)
#pragma unroll
            for (int m = 0; m < 4; ++m) {
                const int row = row0 + ai * 128 + m * 16; const float rs = ((const LAS float*)rowf)[ai * 128 + wr * 64 + m * 16 + fr];
#pragma unroll
                for (int bj = 0; bj < 2; ++bj) {
                    const int c = (colt & 511) + bj * 128 + wc * 32 + 8 * fq;
                    const float rq = region == 1 ? rs * QSCALE : rs;
                    const ge::f32x4 v0 = acc[ai][bj][m][0] * rq, v1 = acc[ai][bj][m][1] * rq;
                    u32x4 w; w.x = ge::cvt_pk_bf16(v0[0], v0[1]); w.y = ge::cvt_pk_bf16(v0[2], v0[3]); w.z = ge::cvt_pk_bf16(v1[0], v1[1]); w.w = ge::cvt_pk_bf16(v1[2], v1[3]);
                    bf16_t* dst = region == 0 ? UP + up_index(row, c) : dstb + (size_t)row * 512 + c;
                    *(u32x4*)dst = w;
                }
            }
    }
};

__device__ __forceinline__ float sum8(const float* p) { const ge::f32x4 a = *(const ge::f32x4*)p, b = *(const ge::f32x4*)(p + 4); return ((a[0] + a[1]) + (a[2] + a[3])) + ((b[0] + b[1]) + (b[2] + b[3])); }
__device__ __forceinline__ float sum16(const float* p) { return sum8(p) + sum8(p + 8); }
__device__ __forceinline__ size_t gel_index(int row, int c) { return ((size_t)(c >> 4) * T + row) * HC + (c & 15); }
__device__ __forceinline__ float sigmoidf_(float x) { return 1.f / (1.f + __expf(-x)); }
struct EpiGlu2 {
    static constexpr bool PERM = true, MIDK = false, UBEGIN = false;
    const bf16_t* GEL; const float* bias; bf16_t* MIX; float* ssp;
    __device__ __forceinline__ void unit_begin(const ge::Unit&, int, LAS unsigned char*) const {}
    __device__ __forceinline__ void midk(ge::f32x4 (&)[2][2][4][2], const ge::Unit&, int, int, LAS unsigned char*) const {}
    __device__ __forceinline__ void operator()(const ge::f32x4 (&acc)[2][2][4][2], const ge::Unit& u, int wr, int wc, int fr, int fq, LAS unsigned char*) const {
        const int row0 = u.pm * 256 + wr * 64 + fr, colt = u.pn * 256;
#pragma unroll
        for (int ai = 0; ai < 2; ++ai)
#pragma unroll
            for (int m = 0; m < 4; ++m) {
                const int row = row0 + ai * 128 + m * 16; float sq = 0.f;
#pragma unroll
                for (int bj = 0; bj < 2; ++bj) {
                    const int c = colt + bj * 128 + wc * 32 + 8 * fq;
                    const ge::f32x4 b0 = *(const ge::f32x4*)(bias + c), b1 = *(const ge::f32x4*)(bias + c + 4);
                    const u32x4 gw = *(const u32x4*)(GEL + gel_index(row, c));
                    const ge::f32x4 v0 = acc[ai][bj][m][0] + b0, v1 = acc[ai][bj][m][1] + b1;
                    float o[8];
                    o[0] = __uint_as_float(gw.x << 16) * sigmoidf_(v0[0]); o[1] = __uint_as_float(gw.x & 0xffff0000u) * sigmoidf_(v0[1]);
                    o[2] = __uint_as_float(gw.y << 16) * sigmoidf_(v0[2]); o[3] = __uint_as_float(gw.y & 0xffff0000u) * sigmoidf_(v0[3]);
                    o[4] = __uint_as_float(gw.z << 16) * sigmoidf_(v1[0]); o[5] = __uint_as_float(gw.z & 0xffff0000u) * sigmoidf_(v1[1]);
                    o[6] = __uint_as_float(gw.w << 16) * sigmoidf_(v1[2]); o[7] = __uint_as_float(gw.w & 0xffff0000u) * sigmoidf_(v1[3]);
#pragma unroll
                    for (int e = 0; e < 8; ++e) sq += o[e] * o[e];
                    u32x4 w; w.x = ge::cvt_pk_bf16(o[0], o[1]); w.y = ge::cvt_pk_bf16(o[2], o[3]); w.z = ge::cvt_pk_bf16(o[4], o[5]); w.w = ge::cvt_pk_bf16(o[6], o[7]);
                    *(u32x4*)(MIX + (size_t)row * D + c) = w;
                }
                sq += __shfl_xor(sq, 16); sq += __shfl_xor(sq, 32);
                if (fq == 0) ssp[(size_t)row * 8 + u.pn * 4 + wc] = sq;
            }
    }
};
struct EpiWo {
    static constexpr bool PERM = true, MIDK = true, UBEGIN = true;
    const float* ssp_s; const float* ssp_a; const bf16_t* hin; bf16_t* hb; float* ssp2;
    typedef float f32x2_ __attribute__((ext_vector_type(2)));
    __device__ __forceinline__ void unit_begin(const ge::Unit& u, int tid, LAS unsigned char* rowf) const {
        if (tid < 256) { const int row = u.pm * 256 + tid;
            const float rs_s = rsqrtf(sum8(ssp_s + (size_t)row * 8) * (1.f / SSMW) + EPS), rs_a = rsqrtf(sum8(ssp_a + (size_t)row * 8) * (1.f / ATTW) + EPS);
            ((LAS f32x2_*)rowf)[tid] = (f32x2_){rs_s / rs_a, rs_a}; }
    }
    __device__ __forceinline__ void midk(ge::f32x4 (&acc)[2][2][4][2], const ge::Unit& u, int wr, int fr, LAS unsigned char* rowf) const {
#pragma unroll
        for (int ai = 0; ai < 2; ++ai)
#pragma unroll
            for (int m = 0; m < 4; ++m) {
                const float f = ((const LAS f32x2_*)rowf)[ai * 128 + wr * 64 + m * 16 + fr].x;
#pragma unroll
                for (int bj = 0; bj < 2; ++bj)
#pragma unroll
                    for (int n = 0; n < 2; ++n) acc[ai][bj][m][n] = acc[ai][bj][m][n] * f;
            }
    }
    __device__ __forceinline__ void operator()(const ge::f32x4 (&acc)[2][2][4][2], const ge::Unit& u, int wr, int wc, int fr, int fq, LAS unsigned char* rowf) const {
        const int row0 = u.pm * 256 + wr * 64 + fr, colt = u.pn * 256;
#pragma unroll
        for (int ai = 0; ai < 2; ++ai)
#pragma unroll
            for (int m = 0; m < 4; ++m) {
                const int row = row0 + ai * 128 + m * 16; const float ra = ((const LAS f32x2_*)rowf)[ai * 128 + wr * 64 + m * 16 + fr].y; float sq = 0.f;
#pragma unroll
                for (int bj = 0; bj < 2; ++bj) {
                    const int c = colt + bj * 128 + wc * 32 + 8 * fq;
                    const size_t o = (size_t)row * D + c;
                    const u32x4 hw = *(const u32x4*)(hin + o);
                    const ge::f32x4 a0 = acc[ai][bj][m][0] * ra, a1 = acc[ai][bj][m][1] * ra;
                    u32x4 w; w.x = ge::cvt_pk_bf16(__uint_as_float(hw.x << 16) + a0[0], __uint_as_float(hw.x & 0xffff0000u) + a0[1]); w.y = ge::cvt_pk_bf16(__uint_as_float(hw.y << 16) + a0[2], __uint_as_float(hw.y & 0xffff0000u) + a0[3]);
                    w.z = ge::cvt_pk_bf16(__uint_as_float(hw.z << 16) + a1[0], __uint_as_float(hw.z & 0xffff0000u) + a1[1]); w.w = ge::cvt_pk_bf16(__uint_as_float(hw.w << 16) + a1[2], __uint_as_float(hw.w & 0xffff0000u) + a1[3]);
                    *(u32x4*)(hb + o) = w;
#pragma unroll
                    for (int e = 0; e < 4; ++e) { const float lo = __uint_as_float(w[e] << 16), hi = __uint_as_float(w[e] & 0xffff0000u); sq += lo * lo + hi * hi; }
                }
                sq += __shfl_xor(sq, 16); sq += __shfl_xor(sq, 32);
                if (fq == 0) ssp2[(size_t)row * 16 + u.pn * 4 + wc] = sq;
            }
    }
};
struct EpiWq {
    static constexpr bool PERM = true, MIDK = false, UBEGIN = true;
    const float* ssp2; bf16_t* QP;
    __device__ __forceinline__ void unit_begin(const ge::Unit& u, int tid, LAS unsigned char* rowf) const {
        if (tid < 256) { const int row = u.pm * 256 + tid; ((LAS float*)rowf)[tid] = rsqrtf(sum16(ssp2 + (size_t)row * 16) * (1.f / D) + EPS); }
    }
    __device__ __forceinline__ void midk(ge::f32x4 (&)[2][2][4][2], const ge::Unit&, int, int, LAS unsigned char*) const {}
    __device__ __forceinline__ void operator()(const ge::f32x4 (&acc)[2][2][4][2], const ge::Unit& u, int wr, int wc, int fr, int fq, LAS unsigned char* rowf) const {
        const int row0 = u.pm * 256 + wr * 64 + fr, colt = u.pn * 256;
#pragma unroll
        for (int ai = 0; ai < 2; ++ai)
#pragma unroll
            for (int m = 0; m < 4; ++m) {
                const int row = row0 + ai * 128 + m * 16; const float rs = ((const LAS float*)rowf)[ai * 128 + wr * 64 + m * 16 + fr];
#pragma unroll
                for (int bj = 0; bj < 2; ++bj) {
                    const int c = colt + bj * 128 + wc * 32 + 8 * fq;
                    const ge::f32x4 v0 = acc[ai][bj][m][0] * rs, v1 = acc[ai][bj][m][1] * rs;
                    u32x4 w; w.x = ge::cvt_pk_bf16(v0[0], v0[1]); w.y = ge::cvt_pk_bf16(v0[2], v0[3]); w.z = ge::cvt_pk_bf16(v1[0], v1[1]); w.w = ge::cvt_pk_bf16(v1[2], v1[3]);
                    *(u32x4*)(QP + (size_t)row * D + c) = w;
                }
            }
    }
};

__device__ __forceinline__ void ph_flogit(const bf16_t* __restrict__ hb, const bf16_t* __restrict__ wf, const float* __restrict__ ss, const float* __restrict__ bfv, float* __restrict__ logf) {
    PH_IDS
    const int lane = TIDX & 63, gw = BIDX * 8 + __builtin_amdgcn_readfirstlane(TIDX >> 6), ngw = GDIM * 8, r16 = lane & 15, q4 = lane >> 4;
    for (int item = gw; item < T / 16; item += ngw) {
        const int tok0 = item * 16;
        ge::f32x4 acc = {0.f, 0.f, 0.f, 0.f};
        const bf16_t* ar = hb + (size_t)(tok0 + r16) * D + q4 * 8; const bf16_t* br = wf + (size_t)r16 * D + q4 * 8;
#pragma unroll 8
        for (int ks = 0; ks < D / 32; ++ks) {
            const bf16x8 a = *(const bf16x8*)(ar + ks * 32), b = *(const bf16x8*)(br + ks * 32);
            acc = __builtin_amdgcn_mfma_f32_16x16x32_bf16(a, b, acc, 0, 0, 0);
        }
        if (r16 < NH) {
            const float bj = bfv[r16];
#pragma unroll
            for (int r = 0; r < 4; ++r) {
                const int tok = tok0 + 4 * q4 + r; const float x = acc[r] * rsqrtf(sum8(ss + (size_t)tok * 8) * (1.f / D) + EPS) + bj;
                logf[(size_t)tok * NH + r16] = fminf(x, 0.f) - log1pf(expf(-fabsf(x)));
            }
        }
    }
}
}
namespace nv {
__device__ __forceinline__ float gelu_fast(float x);
constexpr float USCALE = 256.f, VSCALE = 16.f;
typedef float f32x2 __attribute__((ext_vector_type(2)));
typedef int i32x2 __attribute__((ext_vector_type(2)));
__device__ __forceinline__ float clamp448(float x) { return fminf(fmaxf(x, -448.f), 448.f); }
__device__ __forceinline__ unsigned pack4_fp8(float a, float b, float c, float d) {
    int w = 0; w = __builtin_amdgcn_cvt_pk_fp8_f32(clamp448(a), clamp448(b), w, false); w = __builtin_amdgcn_cvt_pk_fp8_f32(clamp448(c), clamp448(d), w, true); return (unsigned)w; }

__device__ __forceinline__ void peer_split(LAS unsigned char* lds, int bid, int grid, int wave, int& slice, int& gw, int& ngw) {
    volatile LAS unsigned* M = (volatile LAS unsigned*)(lds + 131072 + 320);
    const unsigned x = __builtin_amdgcn_readfirstlane(M[16]), rk = __builtin_amdgcn_readfirstlane(M[17]), nl = __builtin_amdgcn_readfirstlane(M[18]), ok = __builtin_amdgcn_readfirstlane(M[19]);
    if (ok) { slice = (int)x; gw = (int)rk * 8 + wave; ngw = (int)nl * 8; }
    else { slice = bid & 7; gw = (bid >> 3) * 8 + wave; ngw = (grid >> 3) * 8; }
}
__device__ __forceinline__ void p0_peer_tables(const float* __restrict__ pu, const float* __restrict__ pv, const float* __restrict__ g2, unsigned char* __restrict__ PU8, unsigned char* __restrict__ PV8) {
    PH_IDS
    const size_t n16 = (size_t)DEPTH * NEXP * D / 16;
    for (size_t i = (size_t)BIDX * 512 + TIDX; i < 2 * n16; i += (size_t)GDIM * 512) {
        const bool isv = i >= n16; const size_t j = isv ? i - n16 : i; const size_t e0 = j * 16;
        const float* src = (isv ? pv : pu) + e0;
        const int l = (int)(e0 / ((size_t)NEXP * D)), c = (int)(e0 % D);
        f32x4 x[4];
#pragma unroll
        for (int k = 0; k < 4; ++k) x[k] = *(const f32x4*)(src + 4 * k);
        u32x4 o;
        if (isv) {
#pragma unroll
            for (int k = 0; k < 4; ++k) o[k] = pack4_fp8(x[k].x * VSCALE, x[k].y * VSCALE, x[k].z * VSCALE, x[k].w * VSCALE);
        } else {
#pragma unroll
            for (int k = 0; k < 4; ++k) { const f32x4 g = *(const f32x4*)(g2 + l * D + c + 4 * k) * USCALE; o[k] = pack4_fp8(x[k].x * g.x, x[k].y * g.y, x[k].z * g.z, x[k].w * g.w); }
        }
        const size_t er = (e0 / D) % NEXP;
        *(u32x4*)((isv ? PV8 : PU8) + (((size_t)l * 8 + (c >> 7)) * NEXP + er) * 128 + (c & 127)) = o;
    }
}

constexpr int PB = 16;
#define DPPF(x, CTRL) __int_as_float(__builtin_amdgcn_update_dpp(0, __float_as_int(x), (CTRL), 0xF, 0xF, true))
template <int MODE = 0>
__device__ __forceinline__ void ph_peer_u(LAS unsigned char* lds, const unsigned char* __restrict__ PU8, const bf16_t* __restrict__ hb, const int* __restrict__ idx, float* __restrict__ partial, int imask = 0x7fffffff) {
    PH_IDS
    const int lane = TIDX & 63, wave = __builtin_amdgcn_readfirstlane(TIDX >> 6), c8 = lane & 7, rg = lane >> 3;
    int slice, gw, ngw; peer_split(lds, BIDX, GDIM, wave, slice, gw, ngw);
    const unsigned char* tab = PU8 + (size_t)slice * NEXP * 128; const unsigned lo16 = 16u * c8;
    LAS int* li = (LAS int*)(lds + wave * 12288);
    LAS u32x4* lh = (LAS u32x4*)(lds + wave * 12288 + 8192);
    LAS float* tr = (LAS float*)(lds + 8 * 12288 + wave * 512);
    const int ntok = gw < T ? (T - gw + ngw - 1) / ngw : 0;
    const int p0 = 2 * lane, sd0 = (p0 >> 6) * 64 + (p0 & 7) * 8 + ((p0 & 63) >> 3), sd1 = sd0 + 8;
    const bool b2 = (c8 & 4) != 0, b1 = (c8 & 2) != 0, b0 = (c8 & 1) != 0;
    const int i0 = 8 * (int)b2 + 4 * (int)b0 + 2 * (int)b1;
    for (int tb = 0; tb < ntok; tb += PB) {
        const int nb = min(PB, ntok - tb);
        for (int k = 0; k < nb; ++k) {
            const size_t t = (size_t)gw + (size_t)(tb + k) * ngw;
            i32x2 v = *(const i32x2*)(idx + t * 128 + 2 * lane); v.x &= imask; v.y &= imask; li[k * 128 + sd0] = v.x; li[k * 128 + sd1] = v.y;
            if (lane < 16) lh[k * 16 + lane] = *(const u32x4*)(hb + t * D + 128 * slice + 8 * lane);
        }
        asm volatile("s_waitcnt vmcnt(0) lgkmcnt(0)" ::: "memory");
        const int nstep = 4 * nb;
        u32x4 rb[8][4]; float pv[16]; f32x2 hx[8];
#define PU_ISSUE(s, B) do { const ge::u32x4 ia_ = *(const LAS ge::u32x4*)(li + ((s) >> 1) * 64 + rg * 8 + 4 * ((s) & 1)); \
            _Pragma("unroll") for (int i_ = 0; i_ < 4; ++i_) rb[B][i_] = *(const u32x4*)(tab + (ia_[i_] * 128u + lo16)); } while (0)
#define PU_STEP(s, B, QT) do { if ((s) < nstep) { if ((s) + 7 < nstep) PU_ISSUE((s) + 7, ((B) + 7) & 7); \
            const int k_ = (s) >> 2; const size_t t_ = (size_t)gw + (size_t)(tb + k_) * ngw; \
            if (QT == 0) { const u32x4 w0 = lh[k_ * 16 + 2 * c8], w1 = lh[k_ * 16 + 2 * c8 + 1];          \
                _Pragma("unroll") for (int j = 0; j < 4; ++j) { hx[j] = (f32x2){__uint_as_float(w0[j] << 16), __uint_as_float(w0[j] & 0xffff0000u)}; hx[4 + j] = (f32x2){__uint_as_float(w1[j] << 16), __uint_as_float(w1[j] & 0xffff0000u)}; } } \
            _Pragma("unroll") for (int i = 0; i < 4; ++i) { f32x2 dd = {0.f, 0.f}; _Pragma("unroll") for (int k = 0; k < 4; ++k) {        \
                const f32x2 q0 = __builtin_amdgcn_cvt_pk_f32_fp8((int)rb[B][i][k], false), q1 = __builtin_amdgcn_cvt_pk_f32_fp8((int)rb[B][i][k], true); \
                dd = __builtin_elementwise_fma(q0, hx[2 * k], dd); dd = __builtin_elementwise_fma(q1, hx[2 * k + 1], dd); } pv[4 * QT + i] = dd.x + dd.y; } \
            if (QT == 3) { float y[8], z[4]; \
                _Pragma("unroll") for (int j = 0; j < 8; ++j) { const float keep = b2 ? pv[8 + j] : pv[j], send = b2 ? pv[j] : pv[8 + j]; y[j] = keep + DPPF(send, 0x141); }       \
                _Pragma("unroll") for (int j = 0; j < 4; ++j) { const float keep = b0 ? y[4 + j] : y[j], send = b0 ? y[j] : y[4 + j]; z[j] = keep + DPPF(send, 0xB1); }          \
                const float o0 = (b1 ? z[2] : z[0]) + DPPF(b1 ? z[0] : z[2], 0x4E), o1 = (b1 ? z[3] : z[1]) + DPPF(b1 ? z[1] : z[3], 0x4E);                                    \
                  \
                tr[8 * i0 + rg] = o0; tr[8 * i0 + 8 + rg] = o1; const f32x2 ov_ = *(const LAS f32x2*)(tr + 2 * lane); \
                *(f32x2*)(partial + ((size_t)slice * T + t_) * 128 + 2 * lane) = ov_; } } } while (0)
        PU_ISSUE(0, 0); PU_ISSUE(1, 1); PU_ISSUE(2, 2); PU_ISSUE(3, 3); if (4 < nstep) { PU_ISSUE(4, 4); PU_ISSUE(5, 5); PU_ISSUE(6, 6); }
        for (int s0 = 0; s0 < nstep; s0 += 8) { PU_STEP(s0, 0, 0); PU_STEP(s0 + 1, 1, 1); PU_STEP(s0 + 2, 2, 2); PU_STEP(s0 + 3, 3, 3); PU_STEP(s0 + 4, 4, 0); PU_STEP(s0 + 5, 5, 1); PU_STEP(s0 + 6, 6, 2); PU_STEP(s0 + 7, 7, 3); }
#undef PU_ISSUE
#undef PU_STEP
        asm volatile("s_waitcnt lgkmcnt(0)" ::: "memory");
    }
}

constexpr float CSCALE = 64.f;
__device__ __forceinline__ void ph_peer_coef(const float* __restrict__ partial, const float* __restrict__ ssp2, const float* __restrict__ gate, unsigned short* __restrict__ coef8) {
    PH_IDS
    const size_t n4 = (size_t)T * 128 / 4, stride = (size_t)GDIM * 512;
    for (size_t i0 = (size_t)BIDX * 512 + TIDX; i0 < n4; i0 += 2 * stride) {
        f32x4 pv[2][8], gv[2]; float rs[2];
#pragma unroll
        for (int u = 0; u < 2; ++u) { const size_t i = i0 + u * stride;
            if (i < n4) {
#pragma unroll
                for (int k = 0; k < 8; ++k) pv[u][k] = *(const f32x4*)(partial + (size_t)k * T * 128 + 4 * i);
                gv[u] = *(const f32x4*)(gate + 4 * i); rs[u] = sum16(ssp2 + (i >> 5) * 16);
            } }
#pragma unroll
        for (int u = 0; u < 2; ++u) { const size_t i = i0 + u * stride;
            if (i < n4) {
                f32x4 s = ((pv[u][0] + pv[u][1]) + (pv[u][2] + pv[u][3])) + ((pv[u][4] + pv[u][5]) + (pv[u][6] + pv[u][7]));
                const float sc = rsqrtf(rs[u] * (1.f / D) + EPS) * (1.f / USCALE);
                f32x4 o; o.x = gelu_fast(s.x * sc) * gv[u].x * CSCALE; o.y = gelu_fast(s.y * sc) * gv[u].y * CSCALE; o.z = gelu_fast(s.z * sc) * gv[u].z * CSCALE; o.w = gelu_fast(s.w * sc) * gv[u].w * CSCALE;
                const unsigned hi = pack4_fp8(o.x, o.y, o.z, o.w);
                const f32x2 h01 = __builtin_amdgcn_cvt_pk_f32_fp8((int)hi, false), h23 = __builtin_amdgcn_cvt_pk_f32_fp8((int)hi, true);
                const unsigned lo = pack4_fp8(o.x - h01.x, o.y - h01.y, o.z - h23.x, o.w - h23.y);
                const unsigned w0 = (hi & 0xffu) | ((lo & 0xffu) << 8) | ((hi & 0xff00u) << 8) | ((lo & 0xff00u) << 16);
                const unsigned w1 = ((hi >> 16) & 0xffu) | (((lo >> 16) & 0xffu) << 8) | ((hi >> 8) & 0xff0000u) | (lo & 0xff000000u);
                *(ge::u32x2*)(coef8 + 4 * i) = (ge::u32x2){w0, w1};
            } }
    }
}

template <int MODE = 0>
__device__ __forceinline__ void ph_peer_v(LAS unsigned char* lds, const unsigned char* __restrict__ PV8, const int* __restrict__ idx, const unsigned short* __restrict__ coef8, const bf16_t* hin, bf16_t* hb, float* __restrict__ ssp1, int imask = 0x7fffffff) {
    PH_IDS
    const int lane = TIDX & 63, wave = __builtin_amdgcn_readfirstlane(TIDX >> 6), c8 = lane & 7, rg = lane >> 3;
    int slice, gw, ngw; peer_split(lds, BIDX, GDIM, wave, slice, gw, ngw);
    const unsigned char* tab = PV8 + (size_t)slice * NEXP * 128; const unsigned lo16 = 16u * c8;
    LAS int* li = (LAS int*)(lds + wave * 16384);
    LAS unsigned short* lc = (LAS unsigned short*)(lds + wave * 16384 + 8192);
    LAS float* tr = (LAS float*)(lds + wave * 16384 + 12288);
    const int ntok = gw < T ? (T - gw + ngw - 1) / ngw : 0;
    const int p0 = 2 * lane, sd0 = (p0 >> 6) * 64 + (p0 & 7) * 8 + ((p0 & 63) >> 3), sd1 = sd0 + 8;
    const unsigned bsh = 8u * (c8 & 3), mlo = c8 < 4 ? 0xffffffffu : 0u, mhi = ~mlo;
    const int nn = lane & 15, qq = lane >> 4; const bool dvalid = (nn >> 3) == (qq >> 1);
    const int dcol = 64 * (qq & 1) + (nn & 7);
    for (int tb = 0; tb < ntok; tb += PB) {
        const int nb = min(PB, ntok - tb);
        for (int k = 0; k < nb; ++k) {
            const size_t t = (size_t)gw + (size_t)(tb + k) * ngw;
            i32x2 v = *(const i32x2*)(idx + t * 128 + 2 * lane); v.x &= imask; v.y &= imask; const unsigned c = *(const unsigned*)(coef8 + t * 128 + 2 * lane);
            li[k * 128 + sd0] = v.x; li[k * 128 + sd1] = v.y; lc[k * 128 + sd0] = (unsigned short)(c & 0xffffu); lc[k * 128 + sd1] = (unsigned short)(c >> 16);
        }
        asm volatile("s_waitcnt vmcnt(0) lgkmcnt(0)" ::: "memory");
        const int nstep = 4 * nb;
        u32x4 rb[8][4]; ge::f32x4 acc0, acc1; unsigned hv;
#define PV_ISSUE(s, B) do { const ge::u32x4 ia_ = *(const LAS ge::u32x4*)(li + ((s) >> 1) * 64 + rg * 8 + 4 * ((s) & 1)); \
            _Pragma("unroll") for (int i_ = 0; i_ < 4; ++i_) rb[B][i_] = *(const u32x4*)(tab + (ia_[i_] * 128u + lo16)); } while (0)
#define PV_STEP(s, B, QT) do { if ((s) < nstep) { if ((s) + 7 < nstep) PV_ISSUE((s) + 7, ((B) + 7) & 7); \
            const int k_ = (s) >> 2; const size_t t_ = (size_t)gw + (size_t)(tb + k_) * ngw; \
            if (QT == 0) { acc0 = (ge::f32x4){0.f, 0.f, 0.f, 0.f}; acc1 = acc0; hv = *(const unsigned*)(hin + t_ * D + 128 * slice + 2 * lane); }     \
            const ge::u32x2 cw_ = *(const LAS ge::u32x2*)(lc + ((s) >> 1) * 64 + rg * 8 + 4 * ((s) & 1));                       \
            _Pragma("unroll") for (int i = 0; i < 4; ++i) { const unsigned w_ = (i < 2 ? cw_.x : cw_.y) >> (16 * (i & 1)); \
                const unsigned th_ = (w_ & 0xffu) << bsh, tl_ = ((w_ >> 8) & 0xffu) << bsh; \
                const long bh_ = (long)(((unsigned long long)(th_ & mhi) << 32) | (th_ & mlo)), bl_ = (long)(((unsigned long long)(tl_ & mhi) << 32) | (tl_ & mlo)); \
                const u32x4 av = rb[B][i]; const long a0_ = (long)(((unsigned long long)av.y << 32) | av.x), a1_ = (long)(((unsigned long long)av.w << 32) | av.z); \
                acc0 = __builtin_amdgcn_mfma_f32_16x16x32_fp8_fp8(a0_, bh_, acc0, 0, 0, 0); acc1 = __builtin_amdgcn_mfma_f32_16x16x32_fp8_fp8(a1_, bh_, acc1, 0, 0, 0); \
                acc0 = __builtin_amdgcn_mfma_f32_16x16x32_fp8_fp8(a0_, bl_, acc0, 0, 0, 0); acc1 = __builtin_amdgcn_mfma_f32_16x16x32_fp8_fp8(a1_, bl_, acc1, 0, 0, 0); } \
            if (QT == 3) { \
                if (dvalid) { LAS float* tp_ = tr + 128 * (qq >> 1) + dcol; _Pragma("unroll") for (int i = 0; i < 4; ++i) { tp_[16 * i] = acc0[i]; tp_[16 * i + 8] = acc1[i]; } } \
                const f32x2 e0_ = *(const LAS f32x2*)(tr + 2 * lane), e1_ = *(const LAS f32x2*)(tr + 128 + 2 * lane);                 \
                const unsigned w2_ = pk2(__uint_as_float(hv << 16) + (e0_.x + e1_.x) * (1.f / (VSCALE * CSCALE)), __uint_as_float(hv & 0xffff0000u) + (e0_.y + e1_.y) * (1.f / (VSCALE * CSCALE))); \
                *(unsigned*)(hb + t_ * D + 128 * slice + 2 * lane) = w2_; const float x0 = __uint_as_float(w2_ << 16), x1 = __uint_as_float(w2_ & 0xffff0000u); \
                float sq = x0 * x0 + x1 * x1; sq = wave_sum(sq); if (lane == 0) ssp1[t_ * 8 + slice] = sq; } } } while (0)
        PV_ISSUE(0, 0); PV_ISSUE(1, 1); PV_ISSUE(2, 2); PV_ISSUE(3, 3); if (4 < nstep) { PV_ISSUE(4, 4); PV_ISSUE(5, 5); PV_ISSUE(6, 6); }
        for (int s0 = 0; s0 < nstep; s0 += 8) { PV_STEP(s0, 0, 0); PV_STEP(s0 + 1, 1, 1); PV_STEP(s0 + 2, 2, 2); PV_STEP(s0 + 3, 3, 3); PV_STEP(s0 + 4, 4, 0); PV_STEP(s0 + 5, 5, 1); PV_STEP(s0 + 6, 6, 2); PV_STEP(s0 + 7, 7, 3); }
#undef PV_ISSUE
#undef PV_STEP
        asm volatile("s_waitcnt lgkmcnt(0)" ::: "memory");
    }
}

__device__ __forceinline__ void ph_final(const bf16_t* __restrict__ hb, const float* __restrict__ ssp1, const float* __restrict__ g, float* __restrict__ out) {
    PH_IDS
    const int lane = TIDX & 63, gw = BIDX * 8 + __builtin_amdgcn_readfirstlane(TIDX >> 6), ngw = GDIM * 8;
    for (int w = gw; w < T; w += ngw) {
        const float rs = rsqrtf(sum8(ssp1 + (size_t)w * 8) * (1.f / D) + EPS);
        const u32x4* r = (const u32x4*)(hb + (size_t)w * D) + lane; const f32x4* gg = (const f32x4*)g; f32x4* o = (f32x4*)(out + (size_t)w * D);
#pragma unroll
        for (int j = 0; j < 2; ++j) { const u32x4 v = r[64 * j]; const int c4 = (64 * j + lane) * 2; const f32x4 g0 = gg[c4], g1 = gg[c4 + 1];
            o[c4] = (f32x4){__uint_as_float(v.x << 16) * rs * g0.x, __uint_as_float(v.x & 0xffff0000u) * rs * g0.y, __uint_as_float(v.y << 16) * rs * g0.z, __uint_as_float(v.y & 0xffff0000u) * rs * g0.w};
            o[c4 + 1] = (f32x4){__uint_as_float(v.z << 16) * rs * g1.x, __uint_as_float(v.z & 0xffff0000u) * rs * g1.y, __uint_as_float(v.w << 16) * rs * g1.z, __uint_as_float(v.w & 0xffff0000u) * rs * g1.w}; }
    }
}
}
namespace attn_body {
using bf16=__hip_bfloat16;
using bf16x8=__attribute__((ext_vector_type(8)))short;
using s16x4=__attribute__((ext_vector_type(4)))short;
using f32x16=__attribute__((ext_vector_type(16)))float;
using u32x4=__attribute__((ext_vector_type(4)))unsigned;
constexpr int BATCH=8,NHEAD=8,SEQ=4096,D=64,DM=NHEAD*D;
constexpr int OPITCH=1024,OCOL=512;
constexpr int NW=8,QBLK=32,QB=QBLK*NW,KVBLK=64,NQB=SEQ/QB;
constexpr int ATTN_PITCH=DM, ATTN_UNIT_ROWS=QB;
__device__ __forceinline__ int crow(int r,int hi){return (r&3)+8*(r>>2)+4*hi;}
#define SBAR() __builtin_amdgcn_sched_barrier(0)
__device__ __forceinline__ void cmask(f32x16&p0,f32x16&p1,int jb,int qrel,int hi){
  const float NEG=-INFINITY; int kb=64*jb+4*hi;
  #pragma unroll
  for(int r=0;r<16;++r){int kv=kb+(r&3)+8*(r>>2); if(kv>qrel)p0[r]=NEG; if(kv+32>qrel)p1[r]=NEG;}
}

constexpr int NSLOT=3, SLOTB=8192;
constexpr int LDS_K=0, LDS_V=NSLOT*SLOTB, LDS_WS=2*NSLOT*SLOTB, LDS_OST=LDS_WS+NW*64*4, LDS_CUM=LDS_OST+NW*4096, LDS_BYTES=LDS_CUM+SEQ*4;
constexpr float PRUNE_T=64.f;
constexpr float C2=0.125f*1.4426950408889634f;
__device__ __forceinline__ void glds16(const void*gsrc,unsigned lds_dst){unsigned keep;
  asm volatile("s_mov_b32 %0, m0\n\ts_mov_b32 m0, %2\n\ts_nop 0\n\tglobal_load_lds_dwordx4 %1, off\n\ts_mov_b32 m0, %0":"=&s"(keep):"v"(gsrc),"s"(lds_dst):"memory");}
__device__ __forceinline__ float max3f(float a,float b,float c){float r;asm("v_max3_f32 %0, %1, %2, %3":"=v"(r):"v"(a),"v"(b),"v"(c));return r;}
__device__ __forceinline__ float max2f(float a,float b){float r;asm("v_max_f32_e32 %0, %1, %2":"=v"(r):"v"(a),"v"(b));return r;}
__device__ __forceinline__ float fadd_s(float a,float b){float r;asm("v_add_f32_e32 %0, %1, %2":"=v"(r):"v"(a),"v"(b));return r;}
__device__ __forceinline__ float fsub_s(float a,float b){float r;asm("v_sub_f32_e32 %0, %1, %2":"=v"(r):"v"(a),"v"(b));return r;}
typedef float f32x4_t __attribute__((ext_vector_type(4)));
typedef float f32x2_t __attribute__((ext_vector_type(2))); typedef __bf16 bf16x2_t __attribute__((ext_vector_type(2)));
__device__ __forceinline__ unsigned cvtpk_s(float lo,float hi){f32x2_t v={lo,hi};bf16x2_t b=__builtin_convertvector(v,bf16x2_t);return __builtin_bit_cast(unsigned,b);}
#define WAIT_BAR(N) asm volatile("s_waitcnt vmcnt(" #N ") lgkmcnt(0)\n\ts_barrier":::"memory")

__device__ __forceinline__ void qkt(f32x16&p0,f32x16&p1,const char*Kslot,const bf16x8*qr,const f32x16&negm,int r32,int hi){
  const char*kb=Kslot+hi*1024+r32*16;
  #pragma unroll
  for(int d0=0;d0<4;++d0){
    const bf16x8 b0=*reinterpret_cast<const bf16x8*>(kb+d0*2048);
    const bf16x8 b1=*reinterpret_cast<const bf16x8*>(kb+d0*2048+512);
    if(d0==0){p0=__builtin_amdgcn_mfma_f32_32x32x16_bf16(b0,qr[0],negm,0,0,0);p1=__builtin_amdgcn_mfma_f32_32x32x16_bf16(b1,qr[0],negm,0,0,0);}
    else{p0=__builtin_amdgcn_mfma_f32_32x32x16_bf16(b0,qr[d0],p0,0,0,0);p1=__builtin_amdgcn_mfma_f32_32x32x16_bf16(b1,qr[d0],p1,0,0,0);}}
}
typedef __attribute__((address_space(3))) const char* lds_cptr;
typedef short v4i16_t __attribute__((ext_vector_type(4)));
__device__ __forceinline__ void kload8(bf16x8*kf,lds_cptr kp){
  kf[0]=*(const __attribute__((address_space(3))) bf16x8*)(kp);      kf[1]=*(const __attribute__((address_space(3))) bf16x8*)(kp+512);
  kf[2]=*(const __attribute__((address_space(3))) bf16x8*)(kp+2048); kf[3]=*(const __attribute__((address_space(3))) bf16x8*)(kp+2560);
  kf[4]=*(const __attribute__((address_space(3))) bf16x8*)(kp+4096); kf[5]=*(const __attribute__((address_space(3))) bf16x8*)(kp+4608);
  kf[6]=*(const __attribute__((address_space(3))) bf16x8*)(kp+6144); kf[7]=*(const __attribute__((address_space(3))) bf16x8*)(kp+6656);
}
__device__ __forceinline__ void kload2(bf16x8*kf,lds_cptr kp,int j){ kf[2*j]=*(const __attribute__((address_space(3))) bf16x8*)(kp+j*2048); kf[2*j+1]=*(const __attribute__((address_space(3))) bf16x8*)(kp+j*2048+512); }
__device__ __forceinline__ s16x4 vtr(lds_cptr p){ return __builtin_bit_cast(s16x4,__builtin_amdgcn_ds_read_tr16_b64_v4i16((__attribute__((address_space(3))) v4i16_t*)p)); }
__device__ __forceinline__ float rowmax(const f32x16&p0,const f32x16&p1){
  float a=max3f(p0[0],p0[1],p1[0]),b=max3f(p0[2],p0[3],p1[1]);a=max3f(a,p1[2],p1[3]);
  #pragma unroll
  for(int r=4;r<16;r+=4){a=max3f(a,p0[r],p0[r+1]);b=max3f(b,p0[r+2],p0[r+3]);a=max3f(a,p1[r],p1[r+1]);b=max3f(b,p1[r+2],p1[r+3]);}
  const float m=max2f(a,b);
  auto rr=__builtin_amdgcn_permlane32_swap(__float_as_uint(m),__float_as_uint(m),false,false);
  return max2f(__uint_as_float(rr[0]),__uint_as_float(rr[1]));
}
__device__ __forceinline__ void pv(f32x16*o,int vb,bf16x8 pa0,bf16x8 pa1,bf16x8 pa2,bf16x8 pa3){
  #pragma unroll
  for(int d0=0;d0<2;++d0){s16x4 lo[4],hi[4];
    #pragma unroll
    for(int ks=0;ks<4;++ks){
      asm volatile("ds_read_b64_tr_b16 %0,%1 offset:%c2":"=&v"(lo[ks]):"v"(vb),"i"(d0*4096+ks*1024):"memory");
      asm volatile("ds_read_b64_tr_b16 %0,%1 offset:%c2":"=&v"(hi[ks]):"v"(vb),"i"(d0*4096+ks*1024+512):"memory");}
    asm volatile("s_waitcnt lgkmcnt(0)":::"memory");SBAR();
    #define PK(k) (bf16x8){lo[k][0],lo[k][1],lo[k][2],lo[k][3],hi[k][0],hi[k][1],hi[k][2],hi[k][3]}
    o[d0]=__builtin_amdgcn_mfma_f32_32x32x16_bf16(pa0,PK(0),o[d0],0,0,0);
    o[d0]=__builtin_amdgcn_mfma_f32_32x32x16_bf16(pa1,PK(1),o[d0],0,0,0);
    o[d0]=__builtin_amdgcn_mfma_f32_32x32x16_bf16(pa2,PK(2),o[d0],0,0,0);
    o[d0]=__builtin_amdgcn_mfma_f32_32x32x16_bf16(pa3,PK(3),o[d0],0,0,0);
    #undef PK
  }
}

#ifndef ATTN_STORE16
#define ATTN_STORE16(p,v) (*(u32x4*)(p)=(v))
#endif
template<int THRL> __device__ __forceinline__ void attn_unit(int b,int h,int qb,const bf16*Q,const bf16*__restrict__ K,const bf16*__restrict__ V,const float*__restrict__ cum2,bf16*O,float*__restrict__ ssp,char*shm,int tid_){
  int tid=tid_; asm volatile("":"+v"(tid)); const int lane=tid&63,r32=lane&31,hi=lane>>5; const int wid=__builtin_amdgcn_readfirstlane(tid>>6);
  const long rowbase=(long)b*SEQ; const int q0=qb*QB;
  const bf16*Qw=Q+(rowbase+q0+wid*QBLK)*DM+h*D;
  const bf16*Kh=K+rowbase*DM+h*D,*Vh=V+rowbase*DM+h*D;
  const unsigned lds0=(unsigned)(uintptr_t)shm;
  float*wsf=(float*)(shm+LDS_WS)+wid*64;
  const int NTf=(q0+QB)/KVBLK; const float*cg=cum2+(long)(b*NHEAD+h)*SEQ;
  int ts; { const float thr=cg[q0]+PRUNE_T; const float ce=lane<NTf?cg[64*lane+63]:0.f; const unsigned long long m_=__ballot((lane<NTf)&&(ce<=thr));
    ts=m_?(int)__builtin_ctzll(m_):0; ts&=~1; if(ts>NTf-4)ts=NTf-4; ts=__builtin_amdgcn_readfirstlane(ts); }
  const bf16*ksrc=Kh+(long)(ts*KVBLK+lane)*DM+wid*8;
  const bf16*vsrc=Vh+(long)(ts*KVBLK+16*(wid&3)+(lane>>2))*DM+(wid>>2)*32+(lane&3)*8;
  const unsigned kdst=lds0+LDS_K+wid*1024, vdst=lds0+LDS_V+wid*1024;
  #define DMA_K(t,slot) glds16(ksrc+(long)(t)*KVBLK*DM,(unsigned)__builtin_amdgcn_readfirstlane(kdst+(slot)))
  #define DMA_V(t,slot) glds16(vsrc+(long)(t)*KVBLK*DM,(unsigned)__builtin_amdgcn_readfirstlane(vdst+(slot)))
  const int vb0=(int)(lds0+LDS_V)+((lane>>4)&1)*32+(lane&3)*8+(4*hi+((lane&15)>>2))*64;
  const char*Kbase=shm+LDS_K; bf16x8 kf[8];
  const lds_cptr shm3=(lds_cptr)shm; const lds_cptr kp0=shm3+LDS_K+hi*1024+r32*16; const lds_cptr vp0=shm3+LDS_V+((lane>>4)&1)*32+(lane&3)*8+(4*hi+((lane&15)>>2))*64;
  { float*cl=(float*)(shm+LDS_CUM); for(int i=tid+ts*KVBLK;i<q0+QB;i+=NW*64)cl[i-ts*KVBLK]=cg[i]; }
  const float cq2=cg[q0+wid*QBLK+r32];
  const __attribute__((address_space(3))) float* ckl=(const __attribute__((address_space(3))) float*)(shm3+LDS_CUM)+4*hi;
  #define BIAS(P0,P1,t) do{ const __attribute__((address_space(3))) float*ck_=ckl+64*(t); const float mm_=mhat-cq2; _Pragma("unroll") for(int g_=0;g_<4;++g_){ \
      const f32x4_t c0_=*(const __attribute__((address_space(3))) f32x4_t*)(ck_+8*g_)+mm_, c1_=*(const __attribute__((address_space(3))) f32x4_t*)(ck_+32+8*g_)+mm_; \
      _Pragma("unroll") for(int i_=0;i_<4;++i_){P0[4*g_+i_]-=c0_[i_];P1[4*g_+i_]-=c1_[i_];} SBAR(); } }while(0)
  const int NT=NTf-ts;
  DMA_K(0,0);DMA_V(0,0);DMA_K(1,SLOTB);
  bf16x8 qr[4];
  #pragma unroll
  for(int d0=0;d0<4;++d0)qr[d0]=*reinterpret_cast<const bf16x8*>(&Qw[(long)r32*DM+d0*16+hi*8]);
  float mhat=0.f,l_reg=0.f;f32x16 o[2];o[0]=f32x16{};o[1]=f32x16{};const f32x16 negm=f32x16{};
  const int qrel=wid*QBLK+r32;
  #define CMASK(P0,P1,t) do{int jb_=(t)-(NT-4); if(jb_>=0)cmask(P0,P1,jb_,qrel,hi);}while(0)
  bool resc=false;
  #define START(P0,P1) do{ const float rm=rowmax(P0,P1); resc=false; \
    { const float dl=rm; mhat=fadd_s(mhat,dl); \
      _Pragma("unroll") for(int r=0;r<16;++r){P0[r]=fsub_s(P0[r],dl);P1[r]=fsub_s(P1[r],dl);} \
      } \
    _Pragma("unroll") for(int r=0;r<16;++r)P0[r]=__builtin_amdgcn_exp2f(P0[r]); }while(0)
  #define RESC() do{ if(resc){ asm volatile("s_waitcnt lgkmcnt(0)":::"memory"); \
      _Pragma("unroll") for(int d_=0;d_<2;++d_) _Pragma("unroll") for(int r=0;r<16;++r)o[d_][r]*=wsf[crow(r,hi)]; } }while(0)
  f32x16 pA0,pA1,pB0,pB1;
  int sl_prev=0,sl_cur=0,sl_next=SLOTB;
  #define ROT() do{sl_prev=sl_cur;sl_cur=sl_next;sl_next=(sl_next==(NSLOT-1)*SLOTB)?0:sl_next+SLOTB;}while(0)
  DMA_K(2,2*SLOTB);
  WAIT_BAR(3);
  qkt(pA0,pA1,Kbase,qr,negm,r32,hi);asm volatile("s_nop 15\n\ts_nop 7":"+v"(pA0),"+v"(pA1));BIAS(pA0,pA1,0);CMASK(pA0,pA1,0);
  START(pA0,pA1);
  _Pragma("unroll") for(int r=0;r<16;++r)pA1[r]=__builtin_amdgcn_exp2f(pA1[r]);
  WAIT_BAR(0);
  DMA_K(3,0);DMA_V(1,SLOTB);
  ROT();
  kload8(kf,kp0+sl_cur);
  WAIT_BAR(2);
  s16x4 vlo[8],vhi[8]; u32x4 pw0,pw1,pw2,pw3;
  #define PKW(P,B) cvtpk_s(P[B],P[B+1])
  #define PAF(k) __builtin_bit_cast(bf16x8,pw##k)
  #define VFR(i) (bf16x8){vlo[i][0],vlo[i][1],vlo[i][2],vlo[i][3],vhi[i][0],vhi[i][1],vhi[i][2],vhi[i][3]}
  #define PIN(x) asm volatile("":"+v"(x))
  #define MX3(a,b,c) __builtin_fmaxf(__builtin_fmaxf((a),(b)),(c))
  #define GAPA(MF,A0,A1,A2,A3,W0,W1,PW) do{ MF; sacc+=A0; sacc+=A1; sacc+=A2; sacc+=A3; PIN(sacc); W0; W1; PIN(PW); SBAR(); }while(0)
  #define EX(v) __builtin_amdgcn_exp2f(v)
  #define GAPB(MF,X,B) do{ MF; X[B]=EX(X[B]); X[B+1]=EX(X[B+1]); X[B+2]=EX(X[B+2]); X[B+3]=EX(X[B+3]); PIN(X); SBAR(); }while(0)
  #define VRD(i) do{ vlo[i]=vtr(vp_+(((i)>>2)*4096+((i)&3)*1024)); vhi[i]=vtr(vp_+(((i)>>2)*4096+((i)&3)*1024+512)); }while(0)
  #define KRD(G,j) do{ if(G){ kload2(kf,kp0+sl_next,j); SBAR(); } }while(0)
  #define STEP(C0,C1,P0,P1,t,GK,GV,GL) do{ SBAR(); \
    const lds_cptr vp_=vp0+sl_prev; \
    VRD(0); SBAR(); float sacc=(P0[0]+P0[1]); \
    GAPA(C0=__builtin_amdgcn_mfma_f32_32x32x16_bf16(kf[0],qr[0],negm,0,0,0), P0[2],P0[3],P0[4],P0[5],     pw0[0]=PKW(P0,0), pw0[1]=PKW(P0,2), pw0); \
    VRD(4); SBAR(); GAPA(C1=__builtin_amdgcn_mfma_f32_32x32x16_bf16(kf[1],qr[0],negm,0,0,0), P0[6],P0[7],P0[8],P0[9],     pw0[2]=PKW(P0,4), pw0[3]=PKW(P0,6), pw0); \
    VRD(1); SBAR(); GAPA(C0=__builtin_amdgcn_mfma_f32_32x32x16_bf16(kf[2],qr[1],C0,0,0,0),   P0[10],P0[11],P0[12],P0[13], pw1[0]=PKW(P0,8), pw1[1]=PKW(P0,10), pw1); \
    VRD(5); SBAR(); GAPA(C1=__builtin_amdgcn_mfma_f32_32x32x16_bf16(kf[3],qr[1],C1,0,0,0),   P0[14],P0[15],P1[0],P1[1],   pw1[2]=PKW(P0,12),pw1[3]=PKW(P0,14), pw1); \
    VRD(2); SBAR(); GAPA(C0=__builtin_amdgcn_mfma_f32_32x32x16_bf16(kf[4],qr[2],C0,0,0,0),   P1[2],P1[3],P1[4],P1[5],     pw2[0]=PKW(P1,0), pw2[1]=PKW(P1,2), pw2); \
    VRD(6); SBAR(); GAPA(C1=__builtin_amdgcn_mfma_f32_32x32x16_bf16(kf[5],qr[2],C1,0,0,0),   P1[6],P1[7],P1[8],P1[9],     pw2[2]=PKW(P1,4), pw2[3]=PKW(P1,6), pw2); \
    VRD(3); SBAR(); GAPA(C0=__builtin_amdgcn_mfma_f32_32x32x16_bf16(kf[6],qr[3],C0,0,0,0),   P1[10],P1[11],P1[12],P1[13], pw3[0]=PKW(P1,8), pw3[1]=PKW(P1,10), pw3); \
    VRD(7); SBAR(); GAPA(C1=__builtin_amdgcn_mfma_f32_32x32x16_bf16(kf[7],qr[3],C1,0,0,0),   P1[14],P1[15],0.f,0.f,       pw3[2]=PKW(P1,12),pw3[3]=PKW(P1,14), pw3); \
    l_reg+=sacc; \
    if(GK){DMA_K((t)+3,sl_cur);} if(GV){DMA_V((t)+1,sl_next);} \
    BIAS(C0,C1,t); CMASK(C0,C1,t); \
    { float a=MX3(C0[0],C0[1],C1[0]),b=MX3(C0[2],C0[3],C1[1]); a=MX3(a,C1[2],C1[3]); \
      _Pragma("unroll") for(int r=4;r<16;r+=4){a=MX3(a,C0[r],C0[r+1]);b=MX3(b,C0[r+2],C0[r+3]);a=MX3(a,C1[r],C1[r+1]);b=MX3(b,C1[r+2],C1[r+3]);} \
      float rm=__builtin_fmaxf(a,b); { auto rr=__builtin_amdgcn_permlane32_swap(__float_as_uint(rm),__float_as_uint(rm),false,false); rm=__builtin_fmaxf(__uint_as_float(rr[0]),__uint_as_float(rr[1])); } \
      resc=false; \
      if(__builtin_expect(__any(rm>(float)THRL),0)){ const float dl=__builtin_fmaxf(rm,0.f); mhat+=dl; \
        _Pragma("unroll") for(int r=0;r<16;++r){C0[r]-=dl;C1[r]-=dl;} \
        const float f=__builtin_amdgcn_exp2f(-dl); l_reg*=f; if(hi==0)wsf[r32]=f; resc=true; } } \
    SBAR(); \
    GAPB(o[0]=__builtin_amdgcn_mfma_f32_32x32x16_bf16(PAF(0),VFR(0),o[0],0,0,0), C0,0); \
    GAPB(o[1]=__builtin_amdgcn_mfma_f32_32x32x16_bf16(PAF(0),VFR(4),o[1],0,0,0), C0,4); \
    KRD(GL,0); GAPB(o[0]=__builtin_amdgcn_mfma_f32_32x32x16_bf16(PAF(1),VFR(1),o[0],0,0,0), C0,8); \
    KRD(GL,1); GAPB(o[1]=__builtin_amdgcn_mfma_f32_32x32x16_bf16(PAF(1),VFR(5),o[1],0,0,0), C0,12); \
    KRD(GL,2); GAPB(o[0]=__builtin_amdgcn_mfma_f32_32x32x16_bf16(PAF(2),VFR(2),o[0],0,0,0), C1,0); \
    KRD(GL,3); GAPB(o[1]=__builtin_amdgcn_mfma_f32_32x32x16_bf16(PAF(2),VFR(6),o[1],0,0,0), C1,4); \
    GAPB(o[0]=__builtin_amdgcn_mfma_f32_32x32x16_bf16(PAF(3),VFR(3),o[0],0,0,0), C1,8); \
    GAPB(o[1]=__builtin_amdgcn_mfma_f32_32x32x16_bf16(PAF(3),VFR(7),o[1],0,0,0), C1,12); \
    }while(0)
  int t=1;
  #undef CMASK
  #define CMASK(P0,P1,t) do{}while(0)
  for(;t+5<NT;t+=2){
    STEP(pB0,pB1,pA0,pA1,t,true,true,true);     WAIT_BAR(2); RESC(); ROT();
    STEP(pA0,pA1,pB0,pB1,t+1,true,true,true);   WAIT_BAR(2); RESC(); ROT();
  }
  #undef CMASK
  #define CMASK(P0,P1,t) do{int jb_=(t)-(NT-4); if(jb_>=0)cmask(P0,P1,jb_,qrel,hi);}while(0)
  #define ENDW(tt) do{ if((tt)+3<NT){WAIT_BAR(2);} else if((tt)+2<NT){WAIT_BAR(1);} else {WAIT_BAR(0);} }while(0)
  for(;t+1<NT;t+=2){
    STEP(pB0,pB1,pA0,pA1,t,(t+3<NT),(t+1<NT),(t+1<NT));       ENDW(t);   RESC(); ROT();
    STEP(pA0,pA1,pB0,pB1,t+1,(t+4<NT),(t+2<NT),(t+2<NT));     ENDW(t+1); RESC(); ROT();
  }
  STEP(pB0,pB1,pA0,pA1,NT-1,false,false,false); RESC();
  { float sacc=pB0[0]+pB0[1]; _Pragma("unroll") for(int r=2;r<16;++r)sacc+=pB0[r]; _Pragma("unroll") for(int r=0;r<16;++r)sacc+=pB1[r]; l_reg+=sacc;
    pw0=(u32x4){PKW(pB0,0),PKW(pB0,2),PKW(pB0,4),PKW(pB0,6)};pw1=(u32x4){PKW(pB0,8),PKW(pB0,10),PKW(pB0,12),PKW(pB0,14)};pw2=(u32x4){PKW(pB1,0),PKW(pB1,2),PKW(pB1,4),PKW(pB1,6)};pw3=(u32x4){PKW(pB1,8),PKW(pB1,10),PKW(pB1,12),PKW(pB1,14)};
    SBAR(); pv(o,vb0+sl_cur,PAF(0),PAF(1),PAF(2),PAF(3)); }
  #undef PKW
  #undef PAF
  #undef VFR
  #undef PIN
  #undef MX3
  #undef GAPA
  #undef GAPB
  #undef EX
  #undef VRD
  #undef KRD
  #undef STEP
  #undef ENDW
  {auto rr=__builtin_amdgcn_permlane32_swap(__float_as_uint(l_reg),__float_as_uint(l_reg),false,false);l_reg=__uint_as_float(rr[0])+__uint_as_float(rr[1]);}
  if(hi==0)wsf[32+r32]=l_reg;asm volatile("s_waitcnt lgkmcnt(0)":::"memory");
  float rli[16];
  #pragma unroll
  for(int r=0;r<16;++r)rli[r]=__builtin_amdgcn_rcpf(wsf[32+crow(r,hi)]);
  int lane_e=lane; asm volatile("":"+v"(lane_e));
  bf16*Ow=O+(rowbase+q0+wid*QBLK)*OPITCH+OCOL+h*D; float*sw=ssp+(rowbase+q0+wid*QBLK)*8+h;
  { bf16*stg=(bf16*)(shm+LDS_OST)+wid*2048;
    #pragma unroll
    for(int r=0;r<16;++r){const int orow=crow(r,hi);
      #pragma unroll
      for(int d0=0;d0<2;++d0)stg[orow*64+d0*32+r32]=__float2bfloat16(o[d0][r]*rli[r]);}
    asm volatile("s_waitcnt lgkmcnt(0)":::"memory");
    #pragma unroll
    for(int i=0;i<4;++i){const int row=i*8+(lane_e>>3),ch=lane_e&7; const u32x4 v=*(const u32x4*)(stg+row*64+ch*8); ATTN_STORE16(Ow+(long)row*OPITCH+ch*8,v);
      float sq=0.f;
      #pragma unroll
      for(int k=0;k<4;++k){const float a=__uint_as_float(v[k]<<16),c=__uint_as_float(v[k]&0xffff0000u);sq+=a*a+c*c;}
      sq+=__shfl_xor(sq,1);sq+=__shfl_xor(sq,2);sq+=__shfl_xor(sq,4);
      if(ch==0)sw[(long)row*8]=sq; } }
  asm volatile("s_waitcnt lgkmcnt(0)\n\ts_barrier":::"memory");
  #undef DMA_K
  #undef DMA_V
  #undef CMASK
  #undef START
  #undef RESC
  #undef BIAS
  #undef ROT
}
constexpr int ATTN_LDS_BYTES=LDS_BYTES;
template<int THRL=8> __device__ __forceinline__ void attn_phase(char*lds,const bf16*Q,const bf16*K,const bf16*V,const float*cum2,bf16*O,float*ssp,unsigned*ctr,volatile __attribute__((address_space(3))) unsigned*slot,int tid){
  for(;;){
    if(tid==0)*slot=__hip_atomic_fetch_add(ctr,1u,__ATOMIC_RELAXED,__HIP_MEMORY_SCOPE_AGENT);
    __syncthreads();
    const int u=(int)*slot;
    __syncthreads();
    if(u>=BATCH*NHEAD*NQB)break;
    const int qb=NQB-1-(u>>6),h=NHEAD-1-((u>>3)&7),b=u&7;
    attn_unit<THRL>(b,h,qb,Q,K,V,cum2,O,ssp,lds,tid);
  }
}
#undef SBAR
#undef WAIT_BAR
}
namespace nv {
typedef float f32x2v __attribute__((ext_vector_type(2)));
constexpr size_t WS_APOW = 921 * MiB;
constexpr size_t WS_BBAR = 89 * MiB;
constexpr int KDW = 128 * 256;
__device__ __forceinline__ void p0_ssm_a(const float* __restrict__ lam_re, const float* __restrict__ lam_im, const float* __restrict__ log_dt, const float* __restrict__ b_re, const float* __restrict__ b_im,
                                         f32x2v* __restrict__ apow, f32x2v* __restrict__ bbar) {
    PH_IDS
    for (int i = BIDX * 512 + TIDX; i < DEPTH * G * P; i += GDIM * 512) {
        const int lg = i / P, p = i % P;
        const float dtf = expf(log_dt[lg]); const float lr = lam_re[i], li = lam_im[i];
        const double ang = (double)li * (double)dtf, k2 = rint(ang * 0.15915494309189535), red = ang - k2 * 6.283185307179586;
        const float mag = expf(lr * dtf), rr = (float)red; const double are = (double)(mag * cosf(rr)), aim = (double)(mag * sinf(rr));
        double pr = 1.0, pi = 0.0;
        for (int d = 0; d <= 64; ++d) { apow[((size_t)lg * 65 + d) * P + p] = (f32x2v){(float)pr, (float)pi}; const double nr_ = pr * are - pi * aim, ni_ = pr * aim + pi * are; pr = nr_; pi = ni_; }
        const double lrd = lr, lid = li, den = lrd * lrd + lid * lid, nr = are - 1.0, zre = (nr * lrd + aim * lid) / den, zim = (aim * lrd - nr * lid) / den;
        for (int h = 0; h < HC; ++h) { const double br = b_re[(size_t)i * HC + h], bi = b_im[(size_t)i * HC + h]; bbar[(size_t)i * HC + h] = (f32x2v){(float)(zre * br - zim * bi), (float)(zre * bi + zim * br)}; }
    }
}
__device__ __forceinline__ void p0_ssm_b(const f32x2v* __restrict__ apow, const f32x2v* __restrict__ bbar, const float* __restrict__ c_re, const float* __restrict__ c_im, const float* __restrict__ dsk,
                                         bf16_t* __restrict__ KD, bf16_t* __restrict__ WST, bf16_t* __restrict__ WOUT) {
    PH_IDS
    const int gt = BIDX * 512 + TIDX, nth = GDIM * 512;
    for (int i = gt; i < DEPTH * G * KDW; i += nth) {
        const int lg = i / KDW, r = i % KDW, dd = r >> 8, h = (r >> 4) & 15, h2 = r & 15, d = dd - 63;
        float v = 0.f;
        if (d >= 0 && dd < 127) {
            const f32x2v* ap = apow + ((size_t)lg * 65 + d) * P; const f32x2v* bb = bbar + (size_t)lg * P * HC + h2; const float* cr = c_re + ((size_t)lg * HC + h) * P; const float* ci = c_im + ((size_t)lg * HC + h) * P;
            for (int p = 0; p < P; ++p) { const f32x2v a = ap[p], b = bb[(size_t)p * HC]; const float wr = a.x * b.x - a.y * b.y, wi = a.x * b.y + a.y * b.x; v += cr[p] * wr - ci[p] * wi; }
            if (d == 0 && h == h2) v += dsk[lg * HC + h];
        }
        KD[i] = f2bf(v);
    }
    for (int i = gt; i < DEPTH * G * 128 * 256; i += nth) {
        const int lg = i >> 15, r = i & 32767, row = r >> 8, k = r & 255, j = k >> 4, h2 = k & 15, p = row & 63;
        const f32x2v a = apow[((size_t)lg * 65 + (15 - j)) * P + p], b = bbar[((size_t)lg * P + p) * HC + h2];
        WST[i] = f2bf(row < 64 ? a.x * b.x - a.y * b.y : a.x * b.y + a.y * b.x);
    }
    for (int i = gt; i < DEPTH * G * 1024 * 128; i += nth) {
        const int lg = i >> 17, r = i & 131071, row = r >> 7, k = r & 127, ti = row >> 4, h = row & 15, p = k & 63;
        const f32x2v e = apow[((size_t)lg * 65 + ti + 1) * P + p]; const float cr = c_re[((size_t)lg * HC + h) * P + p], ci = c_im[((size_t)lg * HC + h) * P + p];
        WOUT[i] = f2bf(k < 64 ? cr * e.x - ci * e.y : -(cr * e.y + ci * e.x));
    }
}

struct SchedSsmS {
    static constexpr bool DUALB = false; long hA, hB, hB1;
    const char* UP; const char* WST; int G_, c;
    __device__ __forceinline__ void init(const void* up, const void* wst_l, int grid, int bid) { UP = (const char*)up; WST = (const char*)wst_l; G_ = grid; c = bid; hA = 128l * UPW * 2; hB = 0; hB1 = 0; }
    __device__ __forceinline__ bool next(int i, ge::Unit& u) const {
        const int L = i * G_ + c; if (L >= G * 2 * 4) return false;
        const int g = L >> 3, pm = (L >> 2) & 1, ks = L & 3;
        u.A0 = UP + (((size_t)g * NCH + pm * 256) * UPW + 128 + ks * 256) * 2; u.B0 = WST + (size_t)g * 128 * 256 * 2; u.nt = 4; u.pm = pm; u.pn = ks; u.aux = g; return true; }
    __device__ __forceinline__ const char* ta(const ge::Unit& u, int t) const { return u.A0 + t * 128; }
    __device__ __forceinline__ const char* tb(const ge::Unit& u, int t) const { return u.B0 + t * 128; }
    __device__ __forceinline__ bool sb(const ge::Unit&, int) const { return false; }
    __device__ __forceinline__ unsigned voffA(int R, int C) const { return (unsigned)(R * UPW * 2 + C * 2); }
    __device__ __forceinline__ unsigned voffB(int Rb, int C) const { return (unsigned)(Rb * 512 + C * 2); }
    __device__ __forceinline__ unsigned voffB1(int, int) const { return 0u; }
};
struct EpiSsmS {
    static constexpr bool PERM = false, MIDK = false, UBEGIN = false;
    float* SLOC;
    __device__ __forceinline__ void unit_begin(const ge::Unit&, int, LAS unsigned char*) const {}
    __device__ __forceinline__ void midk(ge::f32x4 (&)[2][2][4][2], const ge::Unit&, int, int, LAS unsigned char*) const {}
    __device__ __forceinline__ void operator()(const ge::f32x4 (&acc)[2][2][4][2], const ge::Unit& u, int wr, int wc, int fr, int fq, LAS unsigned char*) const {
        const int g = u.aux, ks = u.pn;
#pragma unroll
        for (int ai = 0; ai < 2; ++ai)
#pragma unroll
            for (int m = 0; m < 4; ++m) {
                const int chunk = u.pm * 256 + ai * 128 + wr * 64 + m * 16 + fr; float* dst = SLOC + ((size_t)g * (NCH * 4) + chunk * 4 + ks) * 128;
#pragma unroll
                for (int n = 0; n < 2; ++n) *(ge::f32x4*)(dst + wc * 32 + 16 * n + 4 * fq) = acc[ai][0][m][n];
            }
    }
};

__device__ __forceinline__ void ph_ssm_prefix(LAS unsigned char* lds, const float* __restrict__ SLOC, const f32x2v* __restrict__ apow_l, bf16_t* __restrict__ UP) {
    PH_IDS
    const int p = TIDX & 63, w = __builtin_amdgcn_readfirstlane(TIDX >> 6);
    LAS f32x2v* ex = (LAS f32x2v*)lds;
    for (int item = BIDX; item < BATCH * G; item += GDIM) {
        const int b = item / G, g = item % G;
        const f32x2v a16 = apow_l[((size_t)g * 65 + 16) * P + p];
        const float* src = SLOC + ((size_t)g * (NCH * 4) + (size_t)b * 256 + 32 * w) * 128 + p; bf16_t* dst = UP + ((size_t)g * NCH + b * 64 + 8 * w) * UPW + p;
        float xr[32], xi[32];
#pragma unroll
        for (int k = 0; k < 32; ++k) { xr[k] = src[(size_t)k * 128]; xi[k] = src[(size_t)k * 128 + 64]; }
        float sr = 0.f, si = 0.f;
#pragma unroll
        for (int k = 0; k < 32; ++k) { const float nr = a16.x * sr - a16.y * si + xr[k], ni = a16.x * si + a16.y * sr + xi[k]; sr = nr; si = ni; }
        ex[w * 64 + p] = (f32x2v){sr, si};
        float qr = a16.x, qi = a16.y;
#pragma unroll
        for (int k = 0; k < 5; ++k) { const float nr = qr * qr - qi * qi, ni = 2.f * qr * qi; qr = nr; qi = ni; }
        __syncthreads();
        sr = 0.f; si = 0.f;
        for (int j = 0; j < w; ++j) { const f32x2v e = ex[j * 64 + p]; const float nr = qr * sr - qi * si + e.x, ni = qr * si + qi * sr + e.y; sr = nr; si = ni; }
#pragma unroll
        for (int k = 0; k < 32; ++k) {
            if ((k & 3) == 0) { bf16_t* d = dst + (size_t)(k >> 2) * UPW; d[0] = f2bf(sr); d[64] = f2bf(si); }
            const float nr = a16.x * sr - a16.y * si + xr[k], ni = a16.x * si + a16.y * sr + xi[k]; sr = nr; si = ni;
        }
        __syncthreads();
    }
}
__device__ __forceinline__ void ph_cum2(const float* __restrict__ logf, float* __restrict__ cum) {
    PH_IDS
    const int lane = TIDX & 63, gw = BIDX * 8 + __builtin_amdgcn_readfirstlane(TIDX >> 6), ngw = GDIM * 8;
    for (int item = gw; item < BATCH * NH; item += ngw) {
        const int b = item / NH, h = item % NH;
        const float* src = logf + ((size_t)b * SEQ + lane * 64) * NH + h; float* dst = cum + (size_t)item * SEQ + lane * 64;
        float tot = 0.f;
        for (int i = 0; i < 64; ++i) tot += src[(size_t)i * NH];
        float ex = tot;
#pragma unroll
        for (int o = 1; o < 64; o <<= 1) { const float y = __shfl_up(ex, o); if (lane >= o) ex += y; }
        float run = ex - tot;
        for (int i = 0; i < 64; ++i) { run += src[(size_t)i * NH]; dst[i] = run * 1.4426950408889634f; }
    }
}

struct SchedSsmC {
    static constexpr bool DUALB = true; long hA, hB, hB1;
    const char* UP; const char* WOUT; const char* KD; int G_, c;
    __device__ __forceinline__ void init(const void* up, const void* wout_l, const void* kd_l, int grid, int bid) { UP = (const char*)up; WOUT = (const char*)wout_l; KD = (const char*)kd_l; G_ = grid; c = bid; hA = 128l * UPW * 2; hB = 128l * 256; hB1 = 8l * 512; }
    __device__ __forceinline__ bool next(int i, ge::Unit& u) const {
        const int L = i * G_ + c; if (L >= G * 2 * 4) return false;
        const int pn = 3 - (L >> 6), g = (L & 63) >> 1, pm = L & 1;
        u.A0 = UP + ((size_t)g * NCH + pm * 256) * UPW * 2; u.B0 = nullptr; u.nt = 2 + 4 * (pn + 1); u.pm = pm; u.pn = pn; u.aux = g; return true; }
    __device__ __forceinline__ const char* ta(const ge::Unit& u, int t) const { return u.A0 + t * 128; }
    __device__ __forceinline__ bool sb(const ge::Unit&, int t) const { return t >= 2; }
    __device__ __forceinline__ const char* tb(const ge::Unit& u, int t) const {
        return t < 2 ? WOUT + ((size_t)u.aux * 1024 + u.pn * 256) * 256 + t * 128 : KD + ((size_t)u.aux * KDW + (size_t)(16 * u.pn - 4 * (t - 2) + 60) * 256) * 2; }
    __device__ __forceinline__ unsigned voffA(int R, int C) const { return (unsigned)(R * UPW * 2 + C * 2); }
    __device__ __forceinline__ unsigned voffB(int Rb, int C) const { return (unsigned)(Rb * 256 + C * 2); }
    __device__ __forceinline__ unsigned voffB1(int Rb, int C) const { return (unsigned)((((Rb >> 4) + 3 - (C >> 4)) * 256 + (Rb & 15) * 16 + (C & 15)) * 2); }
};
__device__ __forceinline__ float gelu_fast(float x) { const float u = 1.5957691216057308f * (x + 0.044715f * x * x * x); return x - x / (1.f + __expf(u)); }
struct EpiSsmC {
    static constexpr bool PERM = true, MIDK = false, UBEGIN = false;
    bf16_t* GEL;
    __device__ __forceinline__ void unit_begin(const ge::Unit&, int, LAS unsigned char*) const {}
    __device__ __forceinline__ void midk(ge::f32x4 (&)[2][2][4][2], const ge::Unit&, int, int, LAS unsigned char*) const {}
    __device__ __forceinline__ void operator()(const ge::f32x4 (&acc)[2][2][4][2], const ge::Unit& u, int wr, int wc, int fr, int fq, LAS unsigned char*) const {
        const int g = u.aux;
#pragma unroll
        for (int ai = 0; ai < 2; ++ai)
#pragma unroll
            for (int m = 0; m < 4; ++m) {
                const int chunk = u.pm * 256 + ai * 128 + wr * 64 + m * 16 + fr;
#pragma unroll
                for (int bj = 0; bj < 2; ++bj) {
                    const int col = u.pn * 256 + bj * 128 + wc * 32 + 8 * fq, ti = col >> 4, h0 = col & 15;
                    const ge::f32x4 v0 = acc[ai][bj][m][0], v1 = acc[ai][bj][m][1];
                    u32x4 w; w.x = ge::cvt_pk_bf16(gelu_fast(v0[0]), gelu_fast(v0[1])); w.y = ge::cvt_pk_bf16(gelu_fast(v0[2]), gelu_fast(v0[3]));
                    w.z = ge::cvt_pk_bf16(gelu_fast(v1[0]), gelu_fast(v1[1])); w.w = ge::cvt_pk_bf16(gelu_fast(v1[2]), gelu_fast(v1[3]));
                    *(u32x4*)(GEL + ((size_t)g * T + chunk * 64 + ti) * HC + h0) = w;
                }
            }
    }
};
}
namespace nv {
#define SEL_CE(x, y) do { const int _h = max((x), (y)), _l = min((x), (y)); (x) = _h; (y) = _l; } while (0)
__device__ __forceinline__ void sel_sort16(int (&v)[16]) {
    SEL_CE(v[0], v[1]);
    SEL_CE(v[2], v[3]);
    SEL_CE(v[0], v[2]);
    SEL_CE(v[1], v[3]);
    SEL_CE(v[1], v[2]);
    SEL_CE(v[4], v[5]);
    SEL_CE(v[6], v[7]);
    SEL_CE(v[4], v[6]);
    SEL_CE(v[5], v[7]);
    SEL_CE(v[5], v[6]);
    SEL_CE(v[0], v[4]);
    SEL_CE(v[2], v[6]);
    SEL_CE(v[2], v[4]);
    SEL_CE(v[1], v[5]);
    SEL_CE(v[3], v[7]);
    SEL_CE(v[3], v[5]);
    SEL_CE(v[1], v[2]);
    SEL_CE(v[3], v[4]);
    SEL_CE(v[5], v[6]);
    SEL_CE(v[8], v[9]);
    SEL_CE(v[10], v[11]);
    SEL_CE(v[8], v[10]);
    SEL_CE(v[9], v[11]);
    SEL_CE(v[9], v[10]);
    SEL_CE(v[12], v[13]);
    SEL_CE(v[14], v[15]);
    SEL_CE(v[12], v[14]);
    SEL_CE(v[13], v[15]);
    SEL_CE(v[13], v[14]);
    SEL_CE(v[8], v[12]);
    SEL_CE(v[10], v[14]);
    SEL_CE(v[10], v[12]);
    SEL_CE(v[9], v[13]);
    SEL_CE(v[11], v[15]);
    SEL_CE(v[11], v[13]);
    SEL_CE(v[9], v[10]);
    SEL_CE(v[11], v[12]);
    SEL_CE(v[13], v[14]);
    SEL_CE(v[0], v[8]);
    SEL_CE(v[4], v[12]);
    SEL_CE(v[4], v[8]);
    SEL_CE(v[2], v[10]);
    SEL_CE(v[6], v[14]);
    SEL_CE(v[6], v[10]);
    SEL_CE(v[2], v[4]);
    SEL_CE(v[6], v[8]);
    SEL_CE(v[10], v[12]);
    SEL_CE(v[1], v[9]);
    SEL_CE(v[5], v[13]);
    SEL_CE(v[5], v[9]);
    SEL_CE(v[3], v[11]);
    SEL_CE(v[7], v[15]);
    SEL_CE(v[7], v[11]);
    SEL_CE(v[3], v[5]);
    SEL_CE(v[7], v[9]);
    SEL_CE(v[11], v[13]);
    SEL_CE(v[1], v[2]);
    SEL_CE(v[3], v[4]);
    SEL_CE(v[5], v[6]);
    SEL_CE(v[7], v[8]);
    SEL_CE(v[9], v[10]);
    SEL_CE(v[11], v[12]);
    SEL_CE(v[13], v[14]);
}
__device__ __forceinline__ void sel_merge16(int (&a)[16], const int (&b)[16]) {
    a[0] = max(a[0], b[15]);
    a[1] = max(a[1], b[14]);
    a[2] = max(a[2], b[13]);
    a[3] = max(a[3], b[12]);
    a[4] = max(a[4], b[11]);
    a[5] = max(a[5], b[10]);
    a[6] = max(a[6], b[9]);
    a[7] = max(a[7], b[8]);
    a[8] = max(a[8], b[7]);
    a[9] = max(a[9], b[6]);
    a[10] = max(a[10], b[5]);
    a[11] = max(a[11], b[4]);
    a[12] = max(a[12], b[3]);
    a[13] = max(a[13], b[2]);
    a[14] = max(a[14], b[1]);
    a[15] = max(a[15], b[0]);
    SEL_CE(a[0], a[8]);
    SEL_CE(a[1], a[9]);
    SEL_CE(a[2], a[10]);
    SEL_CE(a[3], a[11]);
    SEL_CE(a[4], a[12]);
    SEL_CE(a[5], a[13]);
    SEL_CE(a[6], a[14]);
    SEL_CE(a[7], a[15]);
    SEL_CE(a[0], a[4]);
    SEL_CE(a[1], a[5]);
    SEL_CE(a[2], a[6]);
    SEL_CE(a[3], a[7]);
    SEL_CE(a[8], a[12]);
    SEL_CE(a[9], a[13]);
    SEL_CE(a[10], a[14]);
    SEL_CE(a[11], a[15]);
    SEL_CE(a[0], a[2]);
    SEL_CE(a[1], a[3]);
    SEL_CE(a[4], a[6]);
    SEL_CE(a[5], a[7]);
    SEL_CE(a[8], a[10]);
    SEL_CE(a[9], a[11]);
    SEL_CE(a[12], a[14]);
    SEL_CE(a[13], a[15]);
    SEL_CE(a[0], a[1]);
    SEL_CE(a[2], a[3]);
    SEL_CE(a[4], a[5]);
    SEL_CE(a[6], a[7]);
    SEL_CE(a[8], a[9]);
    SEL_CE(a[10], a[11]);
    SEL_CE(a[12], a[13]);
    SEL_CE(a[14], a[15]);
}
constexpr int SEL_NCAND = 50;
#define SEL_CANDS(F) \
    F(0, 0, 0) \
    F(1, 0, 1) \
    F(2, 0, 2) \
    F(3, 0, 3) \
    F(4, 0, 4) \
    F(5, 0, 5) \
    F(6, 0, 6) \
    F(7, 0, 7) \
    F(8, 0, 8) \
    F(9, 0, 9) \
    F(10, 0, 10) \
    F(11, 0, 11) \
    F(12, 0, 12) \
    F(13, 0, 13) \
    F(14, 0, 14) \
    F(15, 0, 15) \
    F(16, 1, 0) \
    F(17, 1, 1) \
    F(18, 1, 2) \
    F(19, 1, 3) \
    F(20, 1, 4) \
    F(21, 1, 5) \
    F(22, 1, 6) \
    F(23, 1, 7) \
    F(24, 2, 0) \
    F(25, 2, 1) \
    F(26, 2, 2) \
    F(27, 2, 3) \
    F(28, 2, 4) \
    F(29, 3, 0) \
    F(30, 3, 1) \
    F(31, 3, 2) \
    F(32, 3, 3) \
    F(33, 4, 0) \
    F(34, 4, 1) \
    F(35, 4, 2) \
    F(36, 5, 0) \
    F(37, 5, 1) \
    F(38, 6, 0) \
    F(39, 6, 1) \
    F(40, 7, 0) \
    F(41, 7, 1) \
    F(42, 8, 0) \
    F(43, 9, 0) \
    F(44, 10, 0) \
    F(45, 11, 0) \
    F(46, 12, 0) \
    F(47, 13, 0) \
    F(48, 14, 0) \
    F(49, 15, 0)
__device__ __forceinline__ int f2key(float f) { const int b = __float_as_int(f); return b ^ ((b >> 31) & 0x7fffffff); }
__device__ __forceinline__ float key2f(int k) { return __int_as_float(k ^ ((k >> 31) & 0x7fffffff)); }
__device__ __forceinline__ void sel_top16(const f32x16 (&acc)[4], int hi, int (&t)[16]) {
    int g1[16], g2[16], g3[16];
#pragma unroll
    for (int r = 0; r < 16; ++r) { const int n = (r & 3) + 8 * (r >> 2) + 4 * hi;
        t[r] = (f2key(acc[0][r]) & ~0x7F) | n; g1[r] = (f2key(acc[1][r]) & ~0x7F) | (32 + n); g2[r] = (f2key(acc[2][r]) & ~0x7F) | (64 + n); g3[r] = (f2key(acc[3][r]) & ~0x7F) | (96 + n); }
    sel_sort16(t); sel_sort16(g1); sel_sort16(g2); sel_sort16(g3);
    sel_merge16(t, g1); sel_merge16(g2, g3); sel_merge16(t, g2);
#pragma unroll
    for (int i = 0; i < 16; ++i) { auto rr = __builtin_amdgcn_permlane32_swap((unsigned)t[i], (unsigned)t[i], false, false); g1[i] = (int)(hi ? rr[0] : rr[1]); }
    sel_merge16(t, g1);
}
__device__ __forceinline__ void ph_select(const bf16_t* __restrict__ QP, const bf16_t* __restrict__ KEYS, int* __restrict__ idx, float* __restrict__ gate, LAS unsigned char* lds) {
    PH_IDS
    const int lane = TIDX & 63, hd = __builtin_amdgcn_readfirstlane(TIDX >> 6), r = lane & 31, hi = lane >> 5;
    LAS unsigned* my = (LAS unsigned*)(lds + hd * 2048) + lane;
    for (int tg = BIDX; tg < T / 32; tg += GDIM) {
        const int tok0 = tg * 32;
        int rk = r; asm volatile("" : "+v"(rk));
        int t1[16], t2[16];
#pragma unroll
        for (int half = 0; half < 2; ++half) {
            f32x16 acc[4];
#pragma unroll
            for (int mt = 0; mt < 4; ++mt)
#pragma unroll
                for (int i = 0; i < 16; ++i) acc[mt][i] = 0.f;
            const bf16_t* qb = QP + (size_t)(tok0 + r) * D + hd * QD + half * HALF + 8 * hi;
            const bf16_t* kb = KEYS + ((size_t)(hd * 2 + half) * NK + rk) * HALF + 8 * hi;
#pragma unroll
            for (int ks = 0; ks < 4; ++ks) {
                const bf16x8 b = *(const bf16x8*)(qb + 16 * ks);
#pragma unroll
                for (int mt = 0; mt < 4; ++mt) { const bf16x8 a = *(const bf16x8*)(kb + (size_t)mt * 32 * HALF + 16 * ks); acc[mt] = __builtin_amdgcn_mfma_f32_32x32x16_bf16(a, b, acc[mt], 0, 0, 0); }
            }
            if (half == 0) sel_top16(acc, hi, t1); else sel_top16(acc, hi, t2);
        }
        float f1[16], f2[16];
#pragma unroll
        for (int i = 0; i < 16; ++i) { f1[i] = key2f(t1[i]); f2[i] = key2f(t2[i]); }
        int c0[16], c1[16], c2[16], c3[16];
#pragma unroll
        for (int i = 0; i < 16; ++i) c3[i] = (int)0x80000000;
#define SEL_F(k, i, j) { const int v_ = (f2key(f1[i] + f2[j]) & ~0xFF) | ((i) << 4 | (j)); if ((k) < 16) c0[(k) & 15] = v_; else if ((k) < 32) c1[(k) & 15] = v_; else if ((k) < 48) c2[(k) & 15] = v_; else c3[(k) & 15] = v_; }
        SEL_CANDS(SEL_F)
#undef SEL_F
        sel_sort16(c0); sel_sort16(c1); sel_sort16(c2); SEL_CE(c3[0], c3[1]);
        sel_merge16(c0, c1); sel_merge16(c2, c3); sel_merge16(c0, c2);
#pragma unroll
        for (int j = 0; j < 4; ++j) {
            my[64 * j] = (unsigned)(t1[4 * j] & 0x7F) | ((unsigned)(t1[4 * j + 1] & 0x7F) << 8) | ((unsigned)(t1[4 * j + 2] & 0x7F) << 16) | ((unsigned)(t1[4 * j + 3] & 0x7F) << 24);
            my[64 * (4 + j)] = (unsigned)(t2[4 * j] & 0x7F) | ((unsigned)(t2[4 * j + 1] & 0x7F) << 8) | ((unsigned)(t2[4 * j + 2] & 0x7F) << 16) | ((unsigned)(t2[4 * j + 3] & 0x7F) << 24);
        }
        const float mx = key2f(c0[0]); float e[16], se = 0.f;
#pragma unroll
        for (int k = 0; k < 16; ++k) { e[k] = __expf(key2f(c0[k]) - mx); se += e[k]; }
        const float inv = 1.f / se;
        asm volatile("s_waitcnt lgkmcnt(0)" ::: "memory");
        const size_t o = (size_t)(tok0 + r) * 128 + hd * TOPK;
        if (hi == 0) {
            int id[16];
#pragma unroll
            for (int k = 0; k < 16; ++k) { const int code = c0[k] & 0xFF, i = code >> 4, j = code & 15;
                const unsigned w1 = my[64 * (i >> 2)], w2 = my[64 * (4 + (j >> 2))];
                id[k] = (int)((w1 >> (8 * (i & 3))) & 0x7F) * NK + (int)((w2 >> (8 * (j & 3))) & 0x7F); }
#pragma unroll
            for (int k = 0; k < 4; ++k) *(int4*)(idx + o + 4 * k) = make_int4(id[4 * k], id[4 * k + 1], id[4 * k + 2], id[4 * k + 3]);
        } else {
#pragma unroll
            for (int k = 0; k < 4; ++k) *(float4*)(gate + o + 4 * k) = make_float4(e[4 * k] * inv, e[4 * k + 1] * inv, e[4 * k + 2] * inv, e[4 * k + 3] * inv);
        }
        asm volatile("s_waitcnt lgkmcnt(0)" ::: "memory");
    }
}
}
#ifndef PROBE_MASK
#define PROBE_MASK 0
#endif
#define REPS(bit) (((PROBE_MASK >> (bit)) & 1) ? 2 : 1)
namespace nv {
constexpr int LDS_BYTES = 147456, MISC_OFF = 131072 + 320;
struct Params { const float* in[23]; float* out; unsigned char* ws; };

__global__ void __launch_bounds__(512, 2) k_mega(Params prm) {
    extern __shared__ __attribute__((aligned(16))) unsigned char lds_raw[];
    namespace cg = cooperative_groups;
    cg::grid_group grid = cg::this_grid();
    LAS unsigned char* lds = (LAS unsigned char*)lds_raw;
    unsigned char* smem = lds_raw;
    for (int u = threadIdx.x; u < (LDS_BYTES - 131072) / 4; u += 512) ((LAS unsigned*)(lds + 131072))[u] = 0u;
    __syncthreads();
    if (threadIdx.x == 0) {
        LAS unsigned long long* tab = (LAS unsigned long long*)(lds + TAB_OFF);
#pragma unroll
        for (int i = 0; i < 23; ++i) tab[i] = (unsigned long long)prm.in[i];
        tab[23] = (unsigned long long)prm.out; tab[24] = (unsigned long long)prm.ws;
    }
    __syncthreads();
#define ARG(i) ((const float*)ldarg(lds, (i)))
#define WSP() ((unsigned char*)ldarg(lds, 24))
    XcdBarrier bar = xcd_barrier_post((unsigned*)(WSP() + WS_CTL) + CW_BAR, (volatile LAS unsigned*)(lds + MISC_OFF) + 8);
#define GRID_BAR() do { xcd_barrier(bar); asm volatile("" ::: "memory"); } while (0)
    if (threadIdx.x == 0) { volatile LAS unsigned* M = (volatile LAS unsigned*)(lds + MISC_OFF); M[16] = bar.x; M[17] = xb_add((unsigned*)(WSP() + WS_CTL) + CW_RANK + 64 * bar.x, 1u); }
    for (int rep = 0; rep < REPS(0); ++rep) {
    p0_prologue(lds);
    { unsigned char* ws = WSP(); p0_peer_tables(ARG(20), ARG(21), ARG(17), ws + WS_PU, ws + WS_PV8); }
    { unsigned char* ws = WSP(); const float* pk = ARG(19); bf16_t* kb = (bf16_t*)(ws + WS_KEYS); for (int i = obid() * 512 + otid(); i < DEPTH * PH * 2 * NK * HALF; i += ogrid() * 512) kb[i] = f2bf(pk[i]); }
    { unsigned char* ws = WSP(); p0_ssm_a(ARG(3), ARG(4), ARG(5), ARG(6), ARG(7), (f32x2v*)(ws + WS_APOW), (f32x2v*)(ws + WS_BBAR)); }
    }
    GRID_BAR();
    if (threadIdx.x == 0) {
        volatile LAS unsigned* M = (volatile LAS unsigned*)(lds + MISC_OFF); unsigned* bw = (unsigned*)(WSP() + WS_CTL) + CW_BAR; unsigned tot = 0u, ok = 1u;
        for (unsigned j = 0; j < 16; ++j) { const unsigned cnt = xb_ld(&bw[XB_XCNT(j)]); tot += cnt; if ((j < 8) != (cnt > 0u)) ok = 0u; }
        M[18] = xb_ld(&bw[XB_XCNT(bar.x)]); M[19] = (ok && tot == gridDim.x) ? 1u : 0u;
    }
    __syncthreads();
    { unsigned char* ws = WSP(); p0_ssm_b((const f32x2v*)(ws + WS_APOW), (const f32x2v*)(ws + WS_BBAR), ARG(8), ARG(9), ARG(10), (bf16_t*)(ws + WS_KD), (bf16_t*)(ws + WS_WST), (bf16_t*)(ws + WS_WOUT)); }
    grid.sync();
#pragma nounroll
    for (int l_ = 0; l_ < DEPTH; ++l_) {
        int l = l_; asm volatile("" : "+s"(l));
        {
            unsigned char* ws = WSP(); bf16_t* hb = (bf16_t*)(ws + WS_HB); float* ss1 = (float*)(ws + WS_SSP) + (size_t)T * 32;
            for (int rep = 0; rep < REPS(1); ++rep) {
            SchedGen S; S.init_plain(hb, D * 2, (const bf16_t*)(ws + WS_BT1) + (size_t)l * 2048 * D, D * 2, T, 2048, D, ogrid(), obid());
            EpiInProj E{ss1, (bf16_t*)(ws + WS_UP), (bf16_t*)(ws + WS_Q)};
            ge::gemm_phase<EpiInProj, SchedGen>(lds, S, E, otid());
            }
            for (int rep = 0; rep < REPS(2); ++rep)
            ph_flogit(hb, (const bf16_t*)(ws + WS_WF) + (size_t)l * 16 * D, ss1, ARG(13) + l * NH, (float*)(ws + WS_LOGF));
        }
        GRID_BAR();
        {
            unsigned char* ws = WSP();
            for (int rep = 0; rep < REPS(3); ++rep) {
            SchedSsmS S; S.init(ws + WS_UP, (const bf16_t*)(ws + WS_WST) + (size_t)l * G * 128 * 256, ogrid(), obid());
            EpiSsmS E{(float*)(ws + WS_SLOC)};
            ge::gemm_phase<EpiSsmS, SchedSsmS>(lds, S, E, otid());
            }
            for (int rep = 0; rep < REPS(4); ++rep)
            ph_cum2((const float*)(ws + WS_LOGF), (float*)(ws + WS_CUM));
        }
        GRID_BAR();
        for (int rep = 0; rep < REPS(5); ++rep)
        { unsigned char* ws = WSP(); ph_ssm_prefix(lds, (const float*)(ws + WS_SLOC), (const f32x2v*)(ws + WS_APOW) + (size_t)l * G * 65 * P, (bf16_t*)(ws + WS_UP)); }
        GRID_BAR();
        {
            unsigned char* ws = WSP(); float* ssp_s = (float*)(ws + WS_SSP); float* ssp_a = ssp_s + (size_t)T * 8;
            for (int rep = 0; rep < REPS(6); ++rep)
            {
                SchedSsmC S; S.init(ws + WS_UP, (const bf16_t*)(ws + WS_WOUT) + (size_t)l * G * 1024 * 128, (const bf16_t*)(ws + WS_KD) + (size_t)l * G * KDW, ogrid(), obid());
                EpiSsmC E{(bf16_t*)(ws + WS_GEL)};
                ge::gemm_phase<EpiSsmC, SchedSsmC>(lds, S, E, otid());
            }
            for (int rep = 0; rep < REPS(7); ++rep)
            attn_body::attn_phase<8>((char*)lds_raw, (const attn_body::bf16*)(ws + WS_Q), (const attn_body::bf16*)(ws + WS_K), (const attn_body::bf16*)(ws + WS_V), (const float*)(ws + WS_CUM), (attn_body::bf16*)(ws + WS_MIX), ssp_a, (unsigned*)(ws + WS_CTL) + CW_QUEUE + 64 * (l * 2 + rep), (volatile LAS unsigned*)(lds + MISC_OFF) + 24, otid());
            GRID_BAR();
            for (int rep = 0; rep < REPS(8); ++rep) {
            SchedGen S; S.init_plain(ws + WS_GEL, 32, (const bf16_t*)(ws + WS_BT2) + (size_t)l * SSMW * SSMW, SSMW * 2, T, SSMW, SSMW, ogrid(), obid());
            S.a_c16_b = T * 32; S.a_kt_b = 4l * T * 32;
            EpiGlu2 E{(const bf16_t*)(ws + WS_GEL), ARG(12) + l * SSMW, (bf16_t*)(ws + WS_MIX), ssp_s};
            ge::gemm_phase<EpiGlu2, SchedGen>(lds, S, E, otid());
            }
        }
        GRID_BAR();
        {
            unsigned char* ws = WSP(); float* ssp_s = (float*)(ws + WS_SSP); float* ssp_a = ssp_s + (size_t)T * 8; float* ssp_2 = ssp_a + (size_t)T * 8;
            for (int rep = 0; rep < REPS(9); ++rep) {
            const bool dummy = rep + 1 < REPS(9);
            SchedGen S; S.init_plain(ws + WS_MIX, D * 2, (const bf16_t*)(ws + WS_BT3) + (size_t)l * D * D, D * 2, T, D, D, ogrid(), obid());
            EpiWo E{ssp_s, ssp_a, (const bf16_t*)(ws + WS_HB), dummy ? (bf16_t*)(ws + WS_QP) : (bf16_t*)(ws + WS_HB), dummy ? (float*)(ws + WS_SLOC) : ssp_2};
            ge::gemm_phase<EpiWo, SchedGen>(lds, S, E, otid());
            }
        }
        GRID_BAR();
        {
            unsigned char* ws = WSP(); float* ssp_2 = (float*)(ws + WS_SSP) + (size_t)T * 16;
            for (int rep = 0; rep < REPS(10); ++rep) {
            SchedGen S; S.init_plain(ws + WS_HB, D * 2, (const bf16_t*)(ws + WS_BT4) + (size_t)l * D * D, D * 2, T, D, D, ogrid(), obid());
            EpiWq E{ssp_2, (bf16_t*)(ws + WS_QP)};
            ge::gemm_phase<EpiWq, SchedGen>(lds, S, E, otid());
            }
        }
        GRID_BAR();
        for (int rep = 0; rep < REPS(11); ++rep)
        { unsigned char* ws = WSP(); ph_select((const bf16_t*)(ws + WS_QP), (const bf16_t*)(ws + WS_KEYS) + (size_t)l * PH * 2 * NK * HALF, (int*)(ws + WS_IDX), (float*)(ws + WS_GATE), lds); }
        GRID_BAR();
        if (PROBE_MASK & (1 << 16)) { unsigned char* ws = WSP(); ph_peer_u<0>(lds, ws + WS_PU + (size_t)l * NEXP * D, (const bf16_t*)(ws + WS_HB), (const int*)(ws + WS_IDX), (float*)(ws + WS_UP), 1023); }
        for (int rep = 0; rep < REPS(12); ++rep)
        { unsigned char* ws = WSP(); ph_peer_u<0>(lds, ws + WS_PU + (size_t)l * NEXP * D, (const bf16_t*)(ws + WS_HB), (const int*)(ws + WS_IDX), (float*)(ws + WS_PART)); }
        GRID_BAR();
        for (int rep = 0; rep < REPS(13); ++rep)
        { unsigned char* ws = WSP(); ph_peer_coef((const float*)(ws + WS_PART), (const float*)(ws + WS_SSP) + (size_t)T * 16, (const float*)(ws + WS_GATE), (unsigned short*)(ws + WS_COEF)); }
        GRID_BAR();
        if (PROBE_MASK & (1 << 17)) { unsigned char* ws = WSP();
          ph_peer_v<0>(lds, ws + WS_PV8 + (size_t)l * NEXP * D, (const int*)(ws + WS_IDX), (const unsigned short*)(ws + WS_COEF), (const bf16_t*)(ws + WS_HB), (bf16_t*)(ws + WS_UP), (float*)(ws + WS_SLOC), 1023); }
        for (int rep = 0; rep < REPS(14); ++rep)
        { unsigned char* ws = WSP(); const bool dummy = rep + 1 < REPS(14);
          ph_peer_v<0>(lds, ws + WS_PV8 + (size_t)l * NEXP * D, (const int*)(ws + WS_IDX), (const unsigned short*)(ws + WS_COEF), (const bf16_t*)(ws + WS_HB),
                    dummy ? (bf16_t*)(ws + WS_UP) : (bf16_t*)(ws + WS_HB), dummy ? (float*)(ws + WS_SLOC) : (float*)(ws + WS_SSP) + (size_t)T * 32); }
        if (PROBE_MASK & (1 << 15)) { for (int rep = 0; rep < 8; ++rep) GRID_BAR(); }
        GRID_BAR();
    }
    { unsigned char* ws = WSP(); ph_final((const bf16_t*)(ws + WS_HB), (const float*)(ws + WS_SSP) + (size_t)T * 32, ARG(22), (float*)ldarg(lds, 23)); }
}
}

extern "C" void kernel_launch(void* const* d_in, const int* in_sizes, int n_in, void* d_out, int out_size, void* d_ws, size_t ws_size, hipStream_t stream) {
    using namespace nv;
    static int grid_blocks = 0;
    if (!grid_blocks) {
        int dev = 0, cus = 0, per_cu = 0;
        (void)hipGetDevice(&dev);
        (void)hipDeviceGetAttribute(&cus, hipDeviceAttributeMultiprocessorCount, dev);
        if (hipFuncSetAttribute((const void*)k_mega, hipFuncAttributeMaxDynamicSharedMemorySize, LDS_BYTES) != hipSuccess) { fprintf(stderr, "hipFuncSetAttribute failed\n"); grid_blocks = -1; return; }
        (void)hipOccupancyMaxActiveBlocksPerMultiprocessor(&per_cu, (const void*)k_mega, 512, LDS_BYTES);
        if (per_cu < 1) { fprintf(stderr, "occupancy query returned %d\n", per_cu); (void)hipGetLastError(); }
        grid_blocks = cus;
    }
    if (grid_blocks < 0) return;
    if (ws_size < WS_END || n_in != 23) { fprintf(stderr, "bad workspace / inputs\n"); return; }
    (void)hipMemsetAsync((char*)d_ws + WS_CTL, 0, CTL_BYTES, stream);
    Params p{};
    for (int i = 0; i < 23; ++i) p.in[i] = (const float*)d_in[i];
    p.out = (float*)d_out; p.ws = (unsigned char*)d_ws;
    void* args[] = {&p};
    hipError_t e = hipLaunchCooperativeKernel((const void*)k_mega, dim3(grid_blocks), dim3(512), args, LDS_BYTES, stream);
    if (e != hipSuccess) fprintf(stderr, "cooperative launch failed: %s (grid %d)\n", hipGetErrorString(e), grid_blocks);
}
```

```cpp
#include <hip/hip_runtime.h>
#include <hip/hip_cooperative_groups.h>
#include <hip/hip_bf16.h>
#include <cstdint>
#include <cstdio>

#define LAS __attribute__((address_space(3)))
#define GAS __attribute__((address_space(1)))

namespace nv {
constexpr int D = 1024, BATCH = 8, SEQ = 4096, DEPTH = 4, T = BATCH * SEQ;
constexpr int SSMW = 512, G = 32, HC = 16, P = 64, ATTW = 512, HD = 64, NH = 8, INW = 2056;
constexpr int PH = 8, NK = 128, TOPK = 16, QD = 128, HALF = 64, NEXP = 16384;
constexpr int CHUNK = 64, NCH = T / CHUNK  , UPW = 128 + CHUNK * HC  ;
constexpr float EPS = 1e-6f;

typedef short bf16x8 __attribute__((ext_vector_type(8)));
typedef float f32x16 __attribute__((ext_vector_type(16)));
typedef float f32x4 __attribute__((ext_vector_type(4)));
typedef unsigned u32x4 __attribute__((ext_vector_type(4)));
typedef unsigned short bf16_t;

constexpr size_t MiB = 1u << 20;
constexpr size_t WS_CTL = 0, CTL_BYTES = 4 * MiB;
constexpr size_t WS_BT1 = 4 * MiB;
constexpr size_t WS_BT2 = 20 * MiB;
constexpr size_t WS_BT3 = 22 * MiB;
constexpr size_t WS_BT4 = 30 * MiB;
constexpr size_t WS_WF = 38 * MiB;
constexpr size_t WS_KEYS = 39 * MiB;
constexpr size_t WS_KD = 40 * MiB, WS_WOUT = 49 * MiB, WS_WST = 81 * MiB;
constexpr size_t WS_PU = 90 * MiB, WS_PV8 = 154 * MiB;
constexpr size_t WS_PART = 218 * MiB;
constexpr size_t WS_H = 346 * MiB;
constexpr size_t WS_HB = 474 * MiB;
constexpr size_t WS_UP = 538 * MiB;
constexpr size_t WS_Q = 576 * MiB, WS_K = 608 * MiB, WS_V = 640 * MiB;
constexpr size_t WS_LOGF = 672 * MiB, WS_CUM = 673 * MiB;
constexpr size_t WS_SLOC = 674 * MiB, WS_GEL = 708 * MiB, WS_MIX = 740 * MiB;
constexpr size_t WS_SSP = 916 * MiB;
constexpr size_t WS_QP = 852 * MiB;
constexpr size_t WS_IDX = 804 * MiB, WS_GATE = 820 * MiB, WS_COEF = 836 * MiB;
constexpr size_t WS_XN_F = 90 * MiB, WS_MIXED_F = 218 * MiB, WS_QP_F = 852 * MiB, WS_GEL_F = 90 * MiB  , WS_YSSM_F = 740 * MiB, WS_YATT_F = 674 * MiB;
constexpr size_t WS_END = 980 * MiB;
constexpr int CW_QUEUE = 1024;
constexpr int CW_RANK = 2048;
constexpr int CW_BAR = 4096;
constexpr int CW_SS = 65536;
constexpr int SS_H1 = 0  , SS_H2 = 5  , SS_SSM = 9, SS_ATT = 13;
static_assert((size_t)(CW_SS + 17 * T) * 4 <= CTL_BYTES, "ctl region");

__device__ __forceinline__ unsigned short f2bf(float f) { unsigned u = __float_as_uint(f); return (unsigned short)((u + 0x7fffu + ((u >> 16) & 1u)) >> 16); }
__device__ __forceinline__ float bf2f(unsigned short b) { return __uint_as_float(((unsigned)b) << 16); }
__device__ __forceinline__ unsigned pk2(float lo, float hi) { return (unsigned)f2bf(lo) | ((unsigned)f2bf(hi) << 16); }
__device__ __forceinline__ float gelu_tanh(float x) { const float u = 0.7978845608028654f * (x + 0.044715f * x * x * x); return 0.5f * x * (1.f + tanhf(u)); }
__device__ __forceinline__ float wave_sum(float v) {
#pragma unroll
    for (int o = 1; o < 64; o <<= 1) v += __shfl_xor(v, o);
    return v;
}
__device__ __forceinline__ int otid() { int t = threadIdx.x; asm volatile("" : "+v"(t)); return t; }
__device__ __forceinline__ int obid() { int t = blockIdx.x; asm volatile("" : "+s"(t)); return t; }
__device__ __forceinline__ int ogrid() { int t = gridDim.x; asm volatile("" : "+s"(t)); return t; }
#define PH_IDS const int TIDX = otid(), BIDX = obid(), GDIM = ogrid(); (void)TIDX; (void)BIDX; (void)GDIM;
__device__ __forceinline__ size_t up_index(int row, int c) { const int n = row >> 6, j = row & 63, g = c >> 4, hh = c & 15; return ((size_t)g * NCH + n) * UPW + 128 + j * HC + hh; }
}
namespace ge {
#define GE_LAS __attribute__((address_space(3)))
typedef unsigned short bf16_t;
typedef short bf16x8 __attribute__((ext_vector_type(8)));
typedef float f32x4 __attribute__((ext_vector_type(4)));
typedef unsigned u32x4 __attribute__((ext_vector_type(4)));
typedef unsigned u32x2 __attribute__((ext_vector_type(2)));
constexpr int ROWF_OFF = 131072 + 4096;
constexpr int BM = 256, BK = 64, HALF = 128, HTB = HALF * BK * 2  , STAGE_BYTES = 8 * HTB, NXCD = 8, WGM = 8;

__host__ __device__ __forceinline__ int lds_byte(int r, int c) { const int st = (r >> 4) * 2 + (c >> 5), rr = r & 15, cc = c & 31, ob = rr * 64 + cc * 2; return st * 1024 + (ob ^ (((ob >> 9) & 1) << 5)); }
__host__ __device__ __forceinline__ void stage_rc(int b, int& R, int& C) { const int st = b / 1024, sb = b % 1024, swz = sb ^ (((sb >> 9) & 1) << 5); R = (st >> 1) * 16 + swz / 64; C = (st & 1) * 32 + (swz % 64) / 2; }
__host__ __device__ __forceinline__ int perm32(int rho) { const int n = rho >> 4, i = rho & 15; return 8 * (i >> 2) + 4 * n + (i & 3); }

struct Unit { const char* A0; const char* B0; int nt; int pm, pn, aux; };
__device__ __forceinline__ unsigned cvt_pk_bf16(float lo, float hi) { unsigned r; asm volatile("v_cvt_pk_bf16_f32 %0, %1, %2" : "=v"(r) : "v"(lo), "v"(hi)); return r; }

__device__ __forceinline__ bool static_tile(int i, int G, int c, int nM, int nN, int& pm, int& pn) {
    const int nwg = nM * nN; const long L = (long)i * G + c; if (L >= nwg) return false;
    int wgid = (int)L; { const int q = nwg / NXCD, r = nwg % NXCD, xcd = wgid % NXCD, off = wgid / NXCD; wgid = (xcd < r ? xcd * (q + 1) : r * (q + 1) + (xcd - r) * q) + off; }
    const int nig = WGM * nN, gid = wgid / nig, fm = gid * WGM, gsz = (nM - fm) < WGM ? (nM - fm) : WGM;
    pm = fm + ((wgid % nig) % gsz); pn = (wgid % nig) / gsz; return true;
}

template <class Epi, class Sched>
__device__ __forceinline__ void gemm_phase(GE_LAS unsigned char* lds, const Sched& S, const Epi& E, int tid) {
    const int wid = __builtin_amdgcn_readfirstlane(tid >> 6), lane = tid & 63, wr = wid >> 2, wc = wid & 3, fr = lane & 15, fq = lane >> 4;
    unsigned voffA[2], voffB[2], voffB1[2];
#pragma unroll
    for (int i = 0; i < 2; ++i) { int R, C; stage_rc(tid * 16 + i * 8192, R, C); const int Rb = Epi::PERM ? ((R & ~31) + perm32(R & 31)) : R;
        voffA[i] = S.voffA(R, C); voffB[i] = S.voffB(Rb, C); if constexpr (Sched::DUALB) voffB1[i] = S.voffB1(Rb, C); else voffB1[i] = 0u; }
    const long hA = S.hA, hB = S.hB;
    const unsigned ldsw = (unsigned)wid * 1024u;
    const int aoff = lds_byte(wr * 64 + fr, fq * 8), boff = lds_byte(wc * 32 + fr, fq * 8);
#define GE_SA(b, h) (((b) * 2 + (h)) * HTB)
#define GE_SB(b, h) ((4 + (b) * 2 + (h)) * HTB)
#define GE_STAGE(bufoff, gbase, voff) do { _Pragma("unroll") for (int _i = 0; _i < 2; ++_i) \
        __builtin_amdgcn_global_load_lds((const unsigned*)((const char*)(gbase) + (voff)[_i]), (GE_LAS unsigned*)(lds + (bufoff) + ldsw + _i * 8192), 16, 0, 0); } while (0)
#define GE_STAGE_B(bufoff, gbase, sel, half) do { if constexpr (Sched::DUALB) { const char* _g = (const char*)(gbase) + ((half) ? ((sel) ? S.hB1 : hB) : 0l); _Pragma("unroll") for (int _i = 0; _i < 2; ++_i) { const unsigned _v = (sel) ? voffB1[_i] : voffB[_i]; \
        __builtin_amdgcn_global_load_lds((const unsigned*)(_g + _v), (GE_LAS unsigned*)(lds + (bufoff) + ldsw + _i * 8192), 16, 0, 0); } } else { GE_STAGE(bufoff, (const char*)(gbase) + ((half) ? hB : 0l), voffB); } } while (0)
#define GE_LDA(dst, b, h) do { _Pragma("unroll") for (int m = 0; m < 4; ++m) _Pragma("unroll") for (int k = 0; k < 2; ++k) dst[m][k] = *(const GE_LAS bf16x8*)(lds + GE_SA(b, h) + aoff + m * 2048 + k * 1024); } while (0)
#define GE_LDB(dst, b, h) do { _Pragma("unroll") for (int n = 0; n < 2; ++n) _Pragma("unroll") for (int k = 0; k < 2; ++k) dst[n][k] = *(const GE_LAS bf16x8*)(lds + GE_SB(b, h) + boff + n * 2048 + k * 1024); } while (0)
#define GE_MMA(ai, bj, At, Bt) do { __builtin_amdgcn_s_setprio(1); _Pragma("unroll") for (int m = 0; m < 4; ++m) _Pragma("unroll") for (int n = 0; n < 2; ++n) _Pragma("unroll") for (int k = 0; k < 2; ++k) \
        acc[ai][bj][m][n] = __builtin_amdgcn_mfma_f32_16x16x32_bf16(Bt[n][k], At[m][k], acc[ai][bj][m][n], 0, 0, 0); __builtin_amdgcn_s_setprio(0); } while (0)
#define GE_WAIT_V(n) asm volatile("s_waitcnt vmcnt(" #n ")" ::: "memory")
#define GE_WAIT_L(n) asm volatile("s_waitcnt lgkmcnt(" #n ")" ::: "memory")
#define GE_BAR __builtin_amdgcn_s_barrier()
#define GE_SCHED __builtin_amdgcn_sched_barrier(0)
    Unit cur, nxt; int ui = 0;
    if (!S.next(0, cur)) return;
    f32x4 acc[2][2][4][2];
#pragma unroll
    for (int a = 0; a < 2; ++a)
#pragma unroll
        for (int b = 0; b < 2; ++b)
#pragma unroll
            for (int m = 0; m < 4; ++m)
#pragma unroll
                for (int n = 0; n < 2; ++n) acc[a][b][m][n] = (f32x4){0.f, 0.f, 0.f, 0.f};
    bf16x8 At[4][2], B0[2][2], B1[2][2];
    if constexpr (Epi::UBEGIN) E.unit_begin(cur, tid, lds + ROWF_OFF);
    {
        const char* a0 = S.ta(cur, 0); const char* b0 = S.tb(cur, 0); const char* a1 = S.ta(cur, 1); const char* b1 = S.tb(cur, 1);
        const bool s0 = S.sb(cur, 0), s1 = S.sb(cur, 1);
        GE_STAGE_B(GE_SB(0, 0), b0, s0, 0); GE_STAGE_B(GE_SB(0, 1), b0, s0, 1); GE_STAGE(GE_SA(0, 0), a0, voffA); GE_STAGE(GE_SA(0, 1), a0 + hA, voffA);
        if (wr == 1) GE_BAR;
        GE_WAIT_V(2); GE_BAR;
        GE_STAGE_B(GE_SB(1, 0), b1, s1, 0); GE_STAGE(GE_SA(1, 0), a1, voffA); GE_STAGE_B(GE_SB(1, 1), b1, s1, 1);
        GE_WAIT_V(6); GE_BAR;
    }
    for (;;) {
        const bool has_next = S.next(ui + 1, nxt);
        const int nt = cur.nt;
        for (int t = 0; t < nt; t += 2) {
            const bool last = (t == nt - 2);
            const char* a1 = S.ta(cur, t + 1);
            const char* a2 = last ? (has_next ? S.ta(nxt, 0) : S.ta(cur, 0)) : S.ta(cur, t + 2);
            const char* b2 = last ? (has_next ? S.tb(nxt, 0) : S.tb(cur, 0)) : S.tb(cur, t + 2);
            const char* a3 = last ? (has_next ? S.ta(nxt, 1) : S.ta(cur, 1)) : S.ta(cur, t + 3);
            const char* b3 = last ? (has_next ? S.tb(nxt, 1) : S.tb(cur, 1)) : S.tb(cur, t + 3);
            const bool s2 = last ? (has_next ? S.sb(nxt, 0) : S.sb(cur, 0)) : S.sb(cur, t + 2), s3 = last ? (has_next ? S.sb(nxt, 1) : S.sb(cur, 1)) : S.sb(cur, t + 3);
            GE_LDB(B0, 0, 0); GE_LDB(B1, 0, 1); GE_SCHED; GE_LDA(At, 0, 0); GE_STAGE(GE_SA(1, 1), a1 + hA, voffA);
            GE_WAIT_V(8); GE_WAIT_L(0); GE_BAR; GE_MMA(0, 0, At, B0); GE_MMA(0, 1, At, B1); GE_BAR; GE_SCHED;
            GE_LDA(At, 0, 1); GE_STAGE_B(GE_SB(0, 0), b2, s2, 0); GE_STAGE_B(GE_SB(0, 1), b2, s2, 1); GE_STAGE(GE_SA(0, 0), a2, voffA);
            GE_WAIT_V(8); GE_WAIT_L(0); GE_BAR; GE_MMA(1, 0, At, B0); GE_MMA(1, 1, At, B1); GE_BAR; GE_SCHED;
            GE_LDB(B0, 1, 0); GE_LDB(B1, 1, 1); GE_SCHED; GE_LDA(At, 1, 0); GE_STAGE(GE_SA(0, 1), a2 + hA, voffA);
            GE_WAIT_V(8); GE_WAIT_L(0); GE_BAR; GE_MMA(0, 0, At, B0); GE_MMA(0, 1, At, B1); GE_BAR; GE_SCHED;
            GE_LDA(At, 1, 1); GE_STAGE_B(GE_SB(1, 0), b3, s3, 0); GE_STAGE_B(GE_SB(1, 1), b3, s3, 1); GE_STAGE(GE_SA(1, 0), a3, voffA);
            GE_WAIT_V(8); GE_WAIT_L(0); GE_BAR; GE_MMA(1, 0, At, B0); GE_MMA(1, 1, At, B1); GE_BAR; GE_SCHED;
            if constexpr (Epi::MIDK) { if (t + 2 == (nt >> 1)) E.midk(acc, cur, wr, fr, lds + ROWF_OFF + (ui & 1) * 2048); }
        }
        if (wr == 0) GE_BAR;
        E(acc, cur, wr, wc, fr, fq, lds + ROWF_OFF + (ui & 1) * 2048);
        if (!has_next) break;
        if constexpr (Epi::UBEGIN) E.unit_begin(nxt, tid, lds + ROWF_OFF + ((ui + 1) & 1) * 2048);
#pragma unroll
        for (int a = 0; a < 2; ++a)
#pragma unroll
            for (int b = 0; b < 2; ++b)
#pragma unroll
                for (int m = 0; m < 4; ++m)
#pragma unroll
                    for (int n = 0; n < 2; ++n) acc[a][b][m][n] = (f32x4){0.f, 0.f, 0.f, 0.f};
        cur = nxt; ++ui;
        if (wr == 1) GE_BAR;
    }
    GE_WAIT_V(0);
    GE_BAR;
#undef GE_SA
#undef GE_SB
#undef GE_STAGE
#undef GE_STAGE_B
#undef GE_LDA
#undef GE_LDB
#undef GE_MMA
#undef GE_WAIT_V
#undef GE_WAIT_L
#undef GE_BAR
#undef GE_SCHED
}
}
namespace nv {
__device__ __forceinline__ float sum8(const float* p);
__device__ __forceinline__ float sum16(const float* p);
#define XB_TMO      128
#define XB_XCNT(j)  (256  + 64 * (j))
#define XB_XSUB(j)  (1280 + 64 * (j))
#define XB_XGEN(j)  (2304 + 64 * (j))
#define XB_TOP      3328
#define XB_TOPGEN   3392
#define XCD_BAR_WORDS 3456
#define XB_SPIN_CAP (1u << 24)
__device__ __forceinline__ unsigned xb_ld(unsigned* p)              { return __hip_atomic_load(p, __ATOMIC_RELAXED, __HIP_MEMORY_SCOPE_AGENT); }
__device__ __forceinline__ unsigned xb_add(unsigned* p, unsigned v) { return __hip_atomic_fetch_add(p, v, __ATOMIC_RELAXED, __HIP_MEMORY_SCOPE_AGENT); }
__device__ __forceinline__ unsigned xb_xcc_id() { return (unsigned)__builtin_amdgcn_s_getreg((3 << 11) | 20) & 0xFu; }
#define XB_SPIN(cond, bar) do { unsigned _sp = 0; while (cond) { __builtin_amdgcn_s_sleep(1); \
    if ((++_sp & 255u) == 0u) { if (xb_ld(&(bar)[XB_TMO])) break; if (_sp > XB_SPIN_CAP) { atomicAdd(&(bar)[XB_TMO], 1u); break; } } } } while (0)
struct XcdBarrier { unsigned* bar; unsigned x; volatile LAS unsigned* st; };
__device__ __forceinline__ XcdBarrier xcd_barrier_post(unsigned* bar, volatile LAS unsigned* st) {
    XcdBarrier b; b.bar = bar; b.x = xb_xcc_id(); b.st = st;
    if (threadIdx.x == 0) (void)xb_add(&bar[XB_XCNT(b.x)], 1u);
    return b;
}
__device__ __forceinline__ void xcd_barrier_complete(unsigned* bar, unsigned x, unsigned& nloc, unsigned& nx) {
    const unsigned Gsz = gridDim.x * gridDim.y * gridDim.z;
    unsigned sum, cnt, mine, sp = 0u;
    for (;;) {
        sum = 0u; cnt = 0u; mine = 0u;
#pragma unroll
        for (unsigned j = 0; j < 16; ++j) { const unsigned c = xb_ld(&bar[XB_XCNT(j)]); sum += c; cnt += (c > 0u) ? 1u : 0u; mine = (j == x) ? c : mine; }
        if (sum == Gsz) break;
        __builtin_amdgcn_s_sleep(1);
        if ((++sp & 255u) == 0u) { if (xb_ld(&bar[XB_TMO])) break; if (sp > XB_SPIN_CAP) { atomicAdd(&bar[XB_TMO], 1u); break; } }
    }
    nloc = mine > 0u ? mine : 1u; nx = cnt > 0u ? cnt : 1u;
}
__device__ __forceinline__ void xcd_barrier(const XcdBarrier& b) {
    asm volatile("s_waitcnt vmcnt(0)" ::: "memory");
    __syncthreads();
    if (threadIdx.x == 0) {
        unsigned* bar = b.bar;
        __builtin_amdgcn_s_waitcnt(0);
        unsigned nloc = b.st[0], nx = b.st[1];
        if (nloc == 0u) { xcd_barrier_complete(bar, b.x, nloc, nx); b.st[0] = nloc; b.st[1] = nx; }
        const unsigned old = xb_add(&bar[XB_XSUB(b.x)], 1u);
        const unsigned gen = old / nloc;
        if (old + 1u == (gen + 1u) * nloc) {
            __builtin_amdgcn_fence(__ATOMIC_RELEASE, "agent");
            asm volatile("s_waitcnt vmcnt(0)" ::: "memory");
            const unsigned og = xb_add(&bar[XB_TOP], 1u);
            const unsigned tg = og / nx;
            if (og + 1u == (tg + 1u) * nx) xb_add(&bar[XB_TOPGEN], 1u);
            else XB_SPIN(xb_ld(&bar[XB_TOPGEN]) == tg, bar);
            __builtin_amdgcn_fence(__ATOMIC_ACQUIRE, "agent");
            xb_add(&bar[XB_XGEN(b.x)], 1u);
            asm volatile("s_waitcnt vmcnt(0)" ::: "memory");
        } else {
            XB_SPIN(xb_ld(&bar[XB_XGEN(b.x)]) == gen, bar);
            __builtin_amdgcn_fence(__ATOMIC_ACQUIRE, "agent");
            asm volatile("s_waitcnt vmcnt(0)" ::: "memory");
        }
    }
    __syncthreads();
}

#define LDS_WAIT() asm volatile("s_waitcnt lgkmcnt(0)" ::: "memory")
template <class Sc>
__device__ __forceinline__ void p0_transpose_item(const float* __restrict__ W, int ldw, int K, int Ncols, Sc sc, bf16_t* __restrict__ WT, LAS float* scr, int item, int lane) {
    const int nblk = Ncols / 32, kb = item / nblk, nb = item % nblk, k0 = 64 * kb, n0 = 32 * nb;
#pragma unroll 8
    for (int i = 0; i < 32; ++i) { const int kk = 2 * i + (lane >> 5); scr[kk * 33 + (lane & 31)] = W[(size_t)(k0 + kk) * ldw + n0 + (lane & 31)] * sc(k0 + kk); }
    LDS_WAIT(); asm volatile("" ::: "memory");
    const int c = lane & 7;
#pragma unroll
    for (int j = 0; j < 4; ++j) { const int n = (lane >> 3) + 8 * j; const LAS float* s = scr + (8 * c) * 33 + n;
        u32x4 o; o.x = pk2(s[0 * 33], s[1 * 33]); o.y = pk2(s[2 * 33], s[3 * 33]); o.z = pk2(s[4 * 33], s[5 * 33]); o.w = pk2(s[6 * 33], s[7 * 33]);
        *(u32x4*)(WT + (size_t)(n0 + n) * K + k0 + 8 * c) = o; }
    LDS_WAIT(); asm volatile("" ::: "memory");
}
struct ScVec { const float* g; __device__ __forceinline__ float operator()(int k) const { return g[k]; } };
struct ScOne { __device__ __forceinline__ float operator()(int) const { return 1.f; } };
struct ScTwo { const float* g0; const float* g1; __device__ __forceinline__ float operator()(int k) const { return k < 512 ? g0[k] : g1[k - 512]; } };

constexpr int TAB_OFF = 131072 + 1024;
__device__ __forceinline__ void* ldarg(LAS unsigned char* lds, int i) {
    unsigned off = TAB_OFF + 8 * i; asm volatile("" : "+s"(off));
    const unsigned long long v = *(volatile LAS unsigned long long*)(lds + off);
    const unsigned lo = __builtin_amdgcn_readfirstlane((unsigned)v), hi = __builtin_amdgcn_readfirstlane((unsigned)(v >> 32));
    return (void*)(GAS void*)(((unsigned long long)hi << 32) | lo);
}

__device__ __forceinline__ void p0_prologue(LAS unsigned char* lds) {
    PH_IDS
    const int lane = TIDX & 63, wave = __builtin_amdgcn_readfirstlane(TIDX >> 6), gw = BIDX * 8 + wave, ngw = GDIM * 8;
    LAS float* scr = (LAS float*)(lds + wave * 16384);
    unsigned char* ws = (unsigned char*)ldarg(lds, 24);
    const float* a0 = (const float*)ldarg(lds, 0); const float* a1 = (const float*)ldarg(lds, 1); const float* a2 = (const float*)ldarg(lds, 2); const float* a11 = (const float*)ldarg(lds, 11);
    const float* a14 = (const float*)ldarg(lds, 14); const float* a15 = (const float*)ldarg(lds, 15); const float* a16 = (const float*)ldarg(lds, 16); const float* a17 = (const float*)ldarg(lds, 17); const float* a18 = (const float*)ldarg(lds, 18);
    constexpr int I1 = (D / 64) * (2048 / 32), I2 = (SSMW / 64) * (SSMW / 32), I3 = (D / 64) * (D / 32), I4 = I3, IL = I1 + I2 + I3 + I4;
    for (int it = gw; it < DEPTH * IL; it += ngw) {
        const int l = it / IL; int r = it % IL;
        if (r < I1) { p0_transpose_item(a2 + (size_t)l * D * INW, INW, D, 2048, ScVec{a1 + l * D}, (bf16_t*)(ws + WS_BT1) + (size_t)l * 2048 * D, scr, r, lane); continue; } r -= I1;
        if (r < I2) { p0_transpose_item(a11 + (size_t)l * SSMW * SSMW, SSMW, SSMW, SSMW, ScOne{}, (bf16_t*)(ws + WS_BT2) + (size_t)l * SSMW * SSMW, scr, r, lane); continue; } r -= I2;
        if (r < I3) { p0_transpose_item(a16 + (size_t)l * D * D, D, D, D, ScTwo{a14 + l * SSMW, a15 + l * ATTW}, (bf16_t*)(ws + WS_BT3) + (size_t)l * D * D, scr, r, lane); continue; } r -= I3;
        p0_transpose_item(a18 + (size_t)l * D * D, D, D, D, ScVec{a17 + l * D}, (bf16_t*)(ws + WS_BT4) + (size_t)l * D * D, scr, r, lane);
    }
    for (int i = BIDX * 512 + TIDX; i < DEPTH * 16 * D; i += GDIM * 512) {
        const int l = i / (16 * D), j = (i / D) % 16, k = i % D;
        const float v = j < 8 ? a2[((size_t)l * D + k) * INW + 2048 + j] * a1[l * D + k] : 0.f;
        ((bf16_t*)(ws + WS_WF))[i] = f2bf(v);
    }
    {
        const float* x = a0; bf16_t* hb = (bf16_t*)(ws + WS_HB); float* ssp1 = (float*)(ws + WS_SSP) + (size_t)T * 32;
        for (int w = gw; w < T; w += ngw) {
            const f32x4* r = (const f32x4*)(x + (size_t)w * D) + lane; unsigned long long* o = (unsigned long long*)(hb + (size_t)w * D) + lane;
            float s = 0.f;
#pragma unroll
            for (int j = 0; j < 4; ++j) { const f32x4 v = r[64 * j]; const unsigned w0 = pk2(v.x, v.y), w1 = pk2(v.z, v.w); o[64 * j] = (unsigned long long)w0 | ((unsigned long long)w1 << 32);
                const float a = __uint_as_float(w0 << 16), b = __uint_as_float(w0 & 0xffff0000u), c = __uint_as_float(w1 << 16), d = __uint_as_float(w1 & 0xffff0000u); s += (a * a + b * b) + (c * c + d * d); }
            s = wave_sum(s);
            if (lane < 8) ssp1[(size_t)w * 8 + lane] = lane == 0 ? s : 0.f;
        }
    }
}

struct SchedGen {
    static constexpr bool DUALB = false; long hB1;
    __device__ __forceinline__ bool sb(const ge::Unit&, int) const { return false; }
    __device__ __forceinline__ unsigned voffB1(int, int) const { return 0u; }
    const char* A; const char* B; int a_row_b, a_c16_b, b_row_b, b_c16_b; long a_pm_b, a_kt_b, b_pn_b, b_kt_b; int nM, nN, nt, G, c; long hA, hB;
    __device__ __forceinline__ void init_plain(const void* A_, int lda_bytes, const void* B_, int ldb_bytes, int M, int N, int K, int G_, int c_) {
        A = (const char*)A_; B = (const char*)B_; a_row_b = lda_bytes; a_c16_b = 32; b_row_b = ldb_bytes; b_c16_b = 32; a_pm_b = 256l * lda_bytes; a_kt_b = 128; b_pn_b = 256l * ldb_bytes; b_kt_b = 128;
        nM = M / 256; nN = N / 256; nt = K / 64; G = G_; c = c_; hA = 128l * lda_bytes; hB = 128l * ldb_bytes; }
    __device__ __forceinline__ bool next(int i, ge::Unit& u) const {
        int pm, pn; if (!ge::static_tile(i, G, c, nM, nN, pm, pn)) return false;
        u.A0 = A + (size_t)pm * a_pm_b; u.B0 = B + (size_t)pn * b_pn_b; u.nt = nt; u.pm = pm; u.pn = pn; u.aux = 0; return true; }
    __device__ __forceinline__ const char* ta(const ge::Unit& u, int t) const { return u.A0 + t * a_kt_b; }
    __device__ __forceinline__ const char* tb(const ge::Unit& u, int t) const { return u.B0 + t * b_kt_b; }
    __device__ __forceinline__ unsigned voffA(int R, int C) const { return (unsigned)(R * a_row_b + (C >> 4) * a_c16_b + (C & 15) * 2); }
    __device__ __forceinline__ unsigned voffB(int Rb, int C) const { return (unsigned)(Rb * b_row_b + (C >> 4) * b_c16_b + (C & 15) * 2); }
};
typedef SchedGen SchedPlain;

constexpr float QSCALE = 0.125f * 1.4426950408889634f;
struct EpiInProj {
    static constexpr bool PERM = true, MIDK = false, UBEGIN = true;
    const float* ssp1; bf16_t* UP; bf16_t* QKV;
    __device__ __forceinline__ void unit_begin(const ge::Unit& u, int tid, LAS unsigned char* rowf) const {
        if (tid < 256) { const int row = u.pm * 256 + tid; ((LAS float*)rowf)[tid] = rsqrtf(sum8(ssp1 + (size_t)row * 8) * (1.f / D) + EPS); }
    }
    __device__ __forceinline__ void midk(ge::f32x4 (&)[2][2][4][2], const ge::Unit&, int, int, LAS unsigned char*) const {}
    __device__ __forceinline__ void operator()(const ge::f32x4 (&acc)[2][2][4][2], const ge::Unit& u, int wr, int wc, int fr, int fq, LAS unsigned char* rowf) const {
        const int row0 = u.pm * 256 + wr * 64 + fr, colt = u.pn * 256, region = colt >> 9;
        bf16_t* dstb = QKV + (size_t)(region - 1) * ((WS_K - WS_Q) / 2);
#pragma unroll
        for (int ai = 0; ai < 2; ++ai)
#pragma unroll
            for (int m = 0; m < 4; ++m) {
                const int row = row0 + ai * 128 + m * 16; const float rs = ((const LAS float*)rowf)[ai * 128 + wr * 64 + m * 16 + fr];
#pragma unroll
                for (int bj = 0; bj < 2; ++bj) {
                    const int c = (colt & 511) + bj * 128 + wc * 32 + 8 * fq;
                    const float rq = region == 1 ? rs * QSCALE : rs;
                    const ge::f32x4 v0 = acc[ai][bj][m][0] * rq, v1 = acc[ai][bj][m][1] * rq;
                    u32x4 w; w.x = ge::cvt_pk_bf16(v0[0], v0[1]); w.y = ge::cvt_pk_bf16(v0[2], v0[3]); w.z = ge::cvt_pk_bf16(v1[0], v1[1]); w.w = ge::cvt_pk_bf16(v1[2], v1[3]);
                    bf16_t* dst = region == 0 ? UP + up_index(row, c) : dstb + (size_t)row * 512 + c;
                    *(u32x4*)dst = w;
                }
            }
    }
};

__device__ __forceinline__ float sum8(const float* p) { const ge::f32x4 a = *(const ge::f32x4*)p, b = *(const ge::f32x4*)(p + 4); return ((a[0] + a[1]) + (a[2] + a[3])) + ((b[0] + b[1]) + (b[2] + b[3])); }
__device__ __forceinline__ float sum16(const float* p) { return sum8(p) + sum8(p + 8); }
__device__ __forceinline__ size_t gel_index(int row, int c) { return ((size_t)(c >> 4) * T + row) * HC + (c & 15); }
__device__ __forceinline__ float sigmoidf_(float x) { return 1.f / (1.f + __expf(-x)); }
struct EpiGlu2 {
    static constexpr bool PERM = true, MIDK = false, UBEGIN = false;
    const bf16_t* GEL; const float* bias; bf16_t* MIX; float* ssp;
    __device__ __forceinline__ void unit_begin(const ge::Unit&, int, LAS unsigned char*) const {}
    __device__ __forceinline__ void midk(ge::f32x4 (&)[2][2][4][2], const ge::Unit&, int, int, LAS unsigned char*) const {}
    __device__ __forceinline__ void operator()(const ge::f32x4 (&acc)[2][2][4][2], const ge::Unit& u, int wr, int wc, int fr, int fq, LAS unsigned char*) const {
        const int row0 = u.pm * 256 + wr * 64 + fr, colt = u.pn * 256;
#pragma unroll
        for (int ai = 0; ai < 2; ++ai)
#pragma unroll
            for (int m = 0; m < 4; ++m) {
                const int row = row0 + ai * 128 + m * 16; float sq = 0.f;
#pragma unroll
                for (int bj = 0; bj < 2; ++bj) {
                    const int c = colt + bj * 128 + wc * 32 + 8 * fq;
                    const ge::f32x4 b0 = *(const ge::f32x4*)(bias + c), b1 = *(const ge::f32x4*)(bias + c + 4);
                    const u32x4 gw = *(const u32x4*)(GEL + gel_index(row, c));
                    const ge::f32x4 v0 = acc[ai][bj][m][0] + b0, v1 = acc[ai][bj][m][1] + b1;
                    float o[8];
                    o[0] = __uint_as_float(gw.x << 16) * sigmoidf_(v0[0]); o[1] = __uint_as_float(gw.x & 0xffff0000u) * sigmoidf_(v0[1]);
                    o[2] = __uint_as_float(gw.y << 16) * sigmoidf_(v0[2]); o[3] = __uint_as_float(gw.y & 0xffff0000u) * sigmoidf_(v0[3]);
                    o[4] = __uint_as_float(gw.z << 16) * sigmoidf_(v1[0]); o[5] = __uint_as_float(gw.z & 0xffff0000u) * sigmoidf_(v1[1]);
                    o[6] = __uint_as_float(gw.w << 16) * sigmoidf_(v1[2]); o[7] = __uint_as_float(gw.w & 0xffff0000u) * sigmoidf_(v1[3]);
#pragma unroll
                    for (int e = 0; e < 8; ++e) sq += o[e] * o[e];
                    u32x4 w; w.x = ge::cvt_pk_bf16(o[0], o[1]); w.y = ge::cvt_pk_bf16(o[2], o[3]); w.z = ge::cvt_pk_bf16(o[4], o[5]); w.w = ge::cvt_pk_bf16(o[6], o[7]);
                    *(u32x4*)(MIX + (size_t)row * D + c) = w;
                }
                sq += __shfl_xor(sq, 16); sq += __shfl_xor(sq, 32);
                if (fq == 0) ssp[(size_t)row * 8 + u.pn * 4 + wc] = sq;
            }
    }
};
struct EpiWo {
    static constexpr bool PERM = true, MIDK = true, UBEGIN = true;
    const float* ssp_s; const float* ssp_a; const bf16_t* hin; bf16_t* hb; float* ssp2;
    typedef float f32x2_ __attribute__((ext_vector_type(2)));
    __device__ __forceinline__ void unit_begin(const ge::Unit& u, int tid, LAS unsigned char* rowf) const {
        if (tid < 256) { const int row = u.pm * 256 + tid;
            const float rs_s = rsqrtf(sum8(ssp_s + (size_t)row * 8) * (1.f / SSMW) + EPS), rs_a = rsqrtf(sum8(ssp_a + (size_t)row * 8) * (1.f / ATTW) + EPS);
            ((LAS f32x2_*)rowf)[tid] = (f32x2_){rs_s / rs_a, rs_a}; }
    }
    __device__ __forceinline__ void midk(ge::f32x4 (&acc)[2][2][4][2], const ge::Unit& u, int wr, int fr, LAS unsigned char* rowf) const {
#pragma unroll
        for (int ai = 0; ai < 2; ++ai)
#pragma unroll
            for (int m = 0; m < 4; ++m) {
                const float f = ((const LAS f32x2_*)rowf)[ai * 128 + wr * 64 + m * 16 + fr].x;
#pragma unroll
                for (int bj = 0; bj < 2; ++bj)
#pragma unroll
                    for (int n = 0; n < 2; ++n) acc[ai][bj][m][n] = acc[ai][bj][m][n] * f;
            }
    }
    __device__ __forceinline__ void operator()(const ge::f32x4 (&acc)[2][2][4][2], const ge::Unit& u, int wr, int wc, int fr, int fq, LAS unsigned char* rowf) const {
        const int row0 = u.pm * 256 + wr * 64 + fr, colt = u.pn * 256;
#pragma unroll
        for (int ai = 0; ai < 2; ++ai)
#pragma unroll
            for (int m = 0; m < 4; ++m) {
                const int row = row0 + ai * 128 + m * 16; const float ra = ((const LAS f32x2_*)rowf)[ai * 128 + wr * 64 + m * 16 + fr].y; float sq = 0.f;
#pragma unroll
                for (int bj = 0; bj < 2; ++bj) {
                    const int c = colt + bj * 128 + wc * 32 + 8 * fq;
                    const size_t o = (size_t)row * D + c;
                    const u32x4 hw = *(const u32x4*)(hin + o);
                    const ge::f32x4 a0 = acc[ai][bj][m][0] * ra, a1 = acc[ai][bj][m][1] * ra;
                    u32x4 w; w.x = ge::cvt_pk_bf16(__uint_as_float(hw.x << 16) + a0[0], __uint_as_float(hw.x & 0xffff0000u) + a0[1]); w.y = ge::cvt_pk_bf16(__uint_as_float(hw.y << 16) + a0[2], __uint_as_float(hw.y & 0xffff0000u) + a0[3]);
                    w.z = ge::cvt_pk_bf16(__uint_as_float(hw.z << 16) + a1[0], __uint_as_float(hw.z & 0xffff0000u) + a1[1]); w.w = ge::cvt_pk_bf16(__uint_as_float(hw.w << 16) + a1[2], __uint_as_float(hw.w & 0xffff0000u) + a1[3]);
                    *(u32x4*)(hb + o) = w;
#pragma unroll
                    for (int e = 0; e < 4; ++e) { const float lo = __uint_as_float(w[e] << 16), hi = __uint_as_float(w[e] & 0xffff0000u); sq += lo * lo + hi * hi; }
                }
                sq += __shfl_xor(sq, 16); sq += __shfl_xor(sq, 32);
                if (fq == 0) ssp2[(size_t)row * 16 + u.pn * 4 + wc] = sq;
            }
    }
};
struct EpiWq {
    static constexpr bool PERM = true, MIDK = false, UBEGIN = true;
    const float* ssp2; bf16_t* QP;
    __device__ __forceinline__ void unit_begin(const ge::Unit& u, int tid, LAS unsigned char* rowf) const {
        if (tid < 256) { const int row = u.pm * 256 + tid; ((LAS float*)rowf)[tid] = rsqrtf(sum16(ssp2 + (size_t)row * 16) * (1.f / D) + EPS); }
    }
    __device__ __forceinline__ void midk(ge::f32x4 (&)[2][2][4][2], const ge::Unit&, int, int, LAS unsigned char*) const {}
    __device__ __forceinline__ void operator()(const ge::f32x4 (&acc)[2][2][4][2], const ge::Unit& u, int wr, int wc, int fr, int fq, LAS unsigned char* rowf) const {
        const int row0 = u.pm * 256 + wr * 64 + fr, colt = u.pn * 256;
#pragma unroll
        for (int ai = 0; ai < 2; ++ai)
#pragma unroll
            for (int m = 0; m < 4; ++m) {
                const int row = row0 + ai * 128 + m * 16; const float rs = ((const LAS float*)rowf)[ai * 128 + wr * 64 + m * 16 + fr];
#pragma unroll
                for (int bj = 0; bj < 2; ++bj) {
                    const int c = colt + bj * 128 + wc * 32 + 8 * fq;
                    const ge::f32x4 v0 = acc[ai][bj][m][0] * rs, v1 = acc[ai][bj][m][1] * rs;
                    u32x4 w; w.x = ge::cvt_pk_bf16(v0[0], v0[1]); w.y = ge::cvt_pk_bf16(v0[2], v0[3]); w.z = ge::cvt_pk_bf16(v1[0], v1[1]); w.w = ge::cvt_pk_bf16(v1[2], v1[3]);
                    *(u32x4*)(QP + (size_t)row * D + c) = w;
                }
            }
    }
};

__device__ __forceinline__ void ph_flogit(const bf16_t* __restrict__ hb, const bf16_t* __restrict__ wf, const float* __restrict__ ss, const float* __restrict__ bfv, float* __restrict__ logf) {
    PH_IDS
    const int lane = TIDX & 63, gw = BIDX * 8 + __builtin_amdgcn_readfirstlane(TIDX >> 6), ngw = GDIM * 8, r16 = lane & 15, q4 = lane >> 4;
    for (int item = gw; item < T / 16; item += ngw) {
        const int tok0 = item * 16;
        ge::f32x4 acc = {0.f, 0.f, 0.f, 0.f};
        const bf16_t* ar = hb + (size_t)(tok0 + r16) * D + q4 * 8; const bf16_t* br = wf + (size_t)r16 * D + q4 * 8;
#pragma unroll 8
        for (int ks = 0; ks < D / 32; ++ks) {
            const bf16x8 a = *(const bf16x8*)(ar + ks * 32), b = *(const bf16x8*)(br + ks * 32);
            acc = __builtin_amdgcn_mfma_f32_16x16x32_bf16(a, b, acc, 0, 0, 0);
        }
        if (r16 < NH) {
            const float bj = bfv[r16];
#pragma unroll
            for (int r = 0; r < 4; ++r) {
                const int tok = tok0 + 4 * q4 + r; const float x = acc[r] * rsqrtf(sum8(ss + (size_t)tok * 8) * (1.f / D) + EPS) + bj;
                logf[(size_t)tok * NH + r16] = fminf(x, 0.f) - log1pf(expf(-fabsf(x)));
            }
        }
    }
}
}
namespace nv {
__device__ __forceinline__ float gelu_fast(float x);
constexpr float USCALE = 256.f, VSCALE = 16.f;
typedef float f32x2 __attribute__((ext_vector_type(2)));
typedef int i32x2 __attribute__((ext_vector_type(2)));
__device__ __forceinline__ float clamp448(float x) { return fminf(fmaxf(x, -448.f), 448.f); }
__device__ __forceinline__ unsigned pack4_fp8(float a, float b, float c, float d) {
    int w = 0; w = __builtin_amdgcn_cvt_pk_fp8_f32(clamp448(a), clamp448(b), w, false); w = __builtin_amdgcn_cvt_pk_fp8_f32(clamp448(c), clamp448(d), w, true); return (unsigned)w; }

__device__ __forceinline__ void peer_split(LAS unsigned char* lds, int bid, int grid, int wave, int& slice, int& gw, int& ngw) {
    volatile LAS unsigned* M = (volatile LAS unsigned*)(lds + 131072 + 320);
    const unsigned x = __builtin_amdgcn_readfirstlane(M[16]), rk = __builtin_amdgcn_readfirstlane(M[17]), nl = __builtin_amdgcn_readfirstlane(M[18]), ok = __builtin_amdgcn_readfirstlane(M[19]);
    if (ok) { slice = (int)x; gw = (int)rk * 8 + wave; ngw = (int)nl * 8; }
    else { slice = bid & 7; gw = (bid >> 3) * 8 + wave; ngw = (grid >> 3) * 8; }
}
__device__ __forceinline__ void p0_peer_tables(const float* __restrict__ pu, const float* __restrict__ pv, const float* __restrict__ g2, unsigned char* __restrict__ PU8, unsigned char* __restrict__ PV8) {
    PH_IDS
    const size_t n16 = (size_t)DEPTH * NEXP * D / 16;
    for (size_t i = (size_t)BIDX * 512 + TIDX; i < 2 * n16; i += (size_t)GDIM * 512) {
        const bool isv = i >= n16; const size_t j = isv ? i - n16 : i; const size_t e0 = j * 16;
        const float* src = (isv ? pv : pu) + e0;
        const int l = (int)(e0 / ((size_t)NEXP * D)), c = (int)(e0 % D);
        f32x4 x[4];
#pragma unroll
        for (int k = 0; k < 4; ++k) x[k] = *(const f32x4*)(src + 4 * k);
        u32x4 o;
        if (isv) {
#pragma unroll
            for (int k = 0; k < 4; ++k) o[k] = pack4_fp8(x[k].x * VSCALE, x[k].y * VSCALE, x[k].z * VSCALE, x[k].w * VSCALE);
        } else {
#pragma unroll
            for (int k = 0; k < 4; ++k) { const f32x4 g = *(const f32x4*)(g2 + l * D + c + 4 * k) * USCALE; o[k] = pack4_fp8(x[k].x * g.x, x[k].y * g.y, x[k].z * g.z, x[k].w * g.w); }
        }
        const size_t er = (e0 / D) % NEXP;
        *(u32x4*)((isv ? PV8 : PU8) + (((size_t)l * 8 + (c >> 7)) * NEXP + er) * 128 + (c & 127)) = o;
    }
}

constexpr int PB = 16;
#define DPPF(x, CTRL) __int_as_float(__builtin_amdgcn_update_dpp(0, __float_as_int(x), (CTRL), 0xF, 0xF, true))
template <int MODE = 0>
__device__ __forceinline__ void ph_peer_u(LAS unsigned char* lds, const unsigned char* __restrict__ PU8, const bf16_t* __restrict__ hb, const unsigned short* __restrict__ idx, bf16_t* __restrict__ partial, int imask = 0x7fffffff) {
    PH_IDS
    const int lane = TIDX & 63, wave = __builtin_amdgcn_readfirstlane(TIDX >> 6), c8 = lane & 7, rg = lane >> 3;
    int slice, gw, ngw; peer_split(lds, BIDX, GDIM, wave, slice, gw, ngw);
    const unsigned char* tab = PU8 + (size_t)slice * NEXP * 128; const unsigned lo16 = 16u * c8;
    LAS int* li = (LAS int*)(lds + wave * 12288);
    LAS u32x4* lh = (LAS u32x4*)(lds + wave * 12288 + 8192);
    LAS float* tr = (LAS float*)(lds + 8 * 12288 + wave * 512);
    const int ntok = gw < T ? (T - gw + ngw - 1) / ngw : 0;
    const int p0 = 2 * lane, sd0 = (p0 >> 6) * 64 + (p0 & 7) * 8 + ((p0 & 63) >> 3), sd1 = sd0 + 8;
    const bool b2 = (c8 & 4) != 0, b1 = (c8 & 2) != 0, b0 = (c8 & 1) != 0;
    const int i0 = 8 * (int)b2 + 4 * (int)b0 + 2 * (int)b1;
    for (int tb = 0; tb < ntok; tb += PB) {
        const int nb = min(PB, ntok - tb);
        for (int k = 0; k < nb; ++k) {
            const size_t t = (size_t)gw + (size_t)(tb + k) * ngw;
            const unsigned iw = *(const unsigned*)(idx + t * 128 + 2 * lane); i32x2 v = {(int)(iw & 0xffffu) & imask, (int)(iw >> 16) & imask}; li[k * 128 + sd0] = v.x; li[k * 128 + sd1] = v.y;
            if (lane < 16) lh[k * 16 + lane] = *(const u32x4*)(hb + t * D + 128 * slice + 8 * lane);
        }
        asm volatile("s_waitcnt vmcnt(0) lgkmcnt(0)" ::: "memory");
        const int nstep = 4 * nb;
        u32x4 rb[8][4]; float pv[16]; f32x2 hx[8];
#define PU_ISSUE(s, B) do { const ge::u32x4 ia_ = *(const LAS ge::u32x4*)(li + ((s) >> 1) * 64 + rg * 8 + 4 * ((s) & 1)); \
            _Pragma("unroll") for (int i_ = 0; i_ < 4; ++i_) rb[B][i_] = *(const u32x4*)(tab + (ia_[i_] * 128u + lo16)); } while (0)
#define PU_STEP(s, B, QT) do { if ((s) < nstep) { if ((s) + 7 < nstep) PU_ISSUE((s) + 7, ((B) + 7) & 7); \
            const int k_ = (s) >> 2; const size_t t_ = (size_t)gw + (size_t)(tb + k_) * ngw; \
            if (QT == 0) { const u32x4 w0 = lh[k_ * 16 + 2 * c8], w1 = lh[k_ * 16 + 2 * c8 + 1];          \
                _Pragma("unroll") for (int j = 0; j < 4; ++j) { hx[j] = (f32x2){__uint_as_float(w0[j] << 16), __uint_as_float(w0[j] & 0xffff0000u)}; hx[4 + j] = (f32x2){__uint_as_float(w1[j] << 16), __uint_as_float(w1[j] & 0xffff0000u)}; } } \
            _Pragma("unroll") for (int i = 0; i < 4; ++i) { f32x2 dd = {0.f, 0.f}; _Pragma("unroll") for (int k = 0; k < 4; ++k) {        \
                const f32x2 q0 = __builtin_amdgcn_cvt_pk_f32_fp8((int)rb[B][i][k], false), q1 = __builtin_amdgcn_cvt_pk_f32_fp8((int)rb[B][i][k], true); \
                dd = __builtin_elementwise_fma(q0, hx[2 * k], dd); dd = __builtin_elementwise_fma(q1, hx[2 * k + 1], dd); } pv[4 * QT + i] = dd.x + dd.y; } \
            if (QT == 3) { float y[8], z[4]; \
                _Pragma("unroll") for (int j = 0; j < 8; ++j) { const float keep = b2 ? pv[8 + j] : pv[j], send = b2 ? pv[j] : pv[8 + j]; y[j] = keep + DPPF(send, 0x141); }       \
                _Pragma("unroll") for (int j = 0; j < 4; ++j) { const float keep = b0 ? y[4 + j] : y[j], send = b0 ? y[j] : y[4 + j]; z[j] = keep + DPPF(send, 0xB1); }          \
                const float o0 = (b1 ? z[2] : z[0]) + DPPF(b1 ? z[0] : z[2], 0x4E), o1 = (b1 ? z[3] : z[1]) + DPPF(b1 ? z[1] : z[3], 0x4E);                                    \
                  \
                tr[8 * i0 + rg] = o0; tr[8 * i0 + 8 + rg] = o1; const f32x2 ov_ = *(const LAS f32x2*)(tr + 2 * lane); \
                *(unsigned*)(partial + ((size_t)slice * T + t_) * 128 + 2 * lane) = pk2(ov_.x, ov_.y); } } } while (0)
        PU_ISSUE(0, 0); PU_ISSUE(1, 1); PU_ISSUE(2, 2); PU_ISSUE(3, 3); if (4 < nstep) { PU_ISSUE(4, 4); PU_ISSUE(5, 5); PU_ISSUE(6, 6); }
        for (int s0 = 0; s0 < nstep; s0 += 8) { PU_STEP(s0, 0, 0); PU_STEP(s0 + 1, 1, 1); PU_STEP(s0 + 2, 2, 2); PU_STEP(s0 + 3, 3, 3); PU_STEP(s0 + 4, 4, 0); PU_STEP(s0 + 5, 5, 1); PU_STEP(s0 + 6, 6, 2); PU_STEP(s0 + 7, 7, 3); }
#undef PU_ISSUE
#undef PU_STEP
        asm volatile("s_waitcnt lgkmcnt(0)" ::: "memory");
    }
}

constexpr float CSCALE = 32.f;
__device__ __forceinline__ void ph_peer_coef(const bf16_t* __restrict__ partial, const float* __restrict__ ssp2, const float* __restrict__ gate, unsigned short* __restrict__ coef8) {
    PH_IDS
    const size_t n4 = (size_t)T * 128 / 4, stride = (size_t)GDIM * 512;
    for (size_t i0 = (size_t)BIDX * 512 + TIDX; i0 < n4; i0 += 2 * stride) {
        ge::u32x2 pv[2][8]; f32x4 gv[2]; float rs[2];
#pragma unroll
        for (int u = 0; u < 2; ++u) { const size_t i = i0 + u * stride;
            if (i < n4) {
#pragma unroll
                for (int k = 0; k < 8; ++k) pv[u][k] = *(const ge::u32x2*)(partial + (size_t)k * T * 128 + 4 * i);
                gv[u] = *(const f32x4*)(gate + 4 * i); rs[u] = sum16(ssp2 + (i >> 5) * 16);
            } }
#pragma unroll
        for (int u = 0; u < 2; ++u) { const size_t i = i0 + u * stride;
            if (i < n4) {
                f32x4 s = {0.f, 0.f, 0.f, 0.f};
#pragma unroll
                for (int k = 0; k < 8; ++k) { s.x += __uint_as_float(pv[u][k].x << 16); s.y += __uint_as_float(pv[u][k].x & 0xffff0000u); s.z += __uint_as_float(pv[u][k].y << 16); s.w += __uint_as_float(pv[u][k].y & 0xffff0000u); }
                const float sc = rsqrtf(rs[u] * (1.f / D) + EPS) * (1.f / USCALE);
                f32x4 o; o.x = gelu_fast(s.x * sc) * gv[u].x * CSCALE; o.y = gelu_fast(s.y * sc) * gv[u].y * CSCALE; o.z = gelu_fast(s.z * sc) * gv[u].z * CSCALE; o.w = gelu_fast(s.w * sc) * gv[u].w * CSCALE;
                const unsigned hi = pack4_fp8(o.x, o.y, o.z, o.w);
                const f32x2 h01 = __builtin_amdgcn_cvt_pk_f32_fp8((int)hi, false), h23 = __builtin_amdgcn_cvt_pk_f32_fp8((int)hi, true);
                const unsigned lo = pack4_fp8(o.x - h01.x, o.y - h01.y, o.z - h23.x, o.w - h23.y);
                const unsigned w0 = (hi & 0xffu) | ((lo & 0xffu) << 8) | ((hi & 0xff00u) << 8) | ((lo & 0xff00u) << 16);
                const unsigned w1 = ((hi >> 16) & 0xffu) | (((lo >> 16) & 0xffu) << 8) | ((hi >> 8) & 0xff0000u) | (lo & 0xff000000u);
                *(ge::u32x2*)(coef8 + 4 * i) = (ge::u32x2){w0, w1};
            } }
    }
}

template <int MODE = 0>
__device__ __forceinline__ void ph_peer_v(LAS unsigned char* lds, const unsigned char* __restrict__ PV8, const unsigned short* __restrict__ idx, const unsigned short* __restrict__ coef8, const bf16_t* hin, bf16_t* hb, float* __restrict__ ssp1, int imask = 0x7fffffff) {
    PH_IDS
    const int lane = TIDX & 63, wave = __builtin_amdgcn_readfirstlane(TIDX >> 6), c8 = lane & 7, rg = lane >> 3;
    int slice, gw, ngw; peer_split(lds, BIDX, GDIM, wave, slice, gw, ngw);
    const unsigned char* tab = PV8 + (size_t)slice * NEXP * 128; const unsigned lo16 = 16u * c8;
    LAS int* li = (LAS int*)(lds + wave * 16384);
    LAS unsigned short* lc = (LAS unsigned short*)(lds + wave * 16384 + 8192);
    LAS float* tr = (LAS float*)(lds + wave * 16384 + 12288);
    const int ntok = gw < T ? (T - gw + ngw - 1) / ngw : 0;
    const int p0 = 2 * lane, sd0 = (p0 >> 6) * 64 + (p0 & 7) * 8 + ((p0 & 63) >> 3), sd1 = sd0 + 8;
    const unsigned bsh = 8u * (c8 & 3), mlo = c8 < 4 ? 0xffffffffu : 0u, mhi = ~mlo;
    const int nn = lane & 15, qq = lane >> 4; const bool dvalid = (nn >> 3) == (qq >> 1);
    const int dcol = 64 * (qq & 1) + (nn & 7);
    for (int tb = 0; tb < ntok; tb += PB) {
        const int nb = min(PB, ntok - tb);
        for (int k = 0; k < nb; ++k) {
            const size_t t = (size_t)gw + (size_t)(tb + k) * ngw;
            const unsigned iw = *(const unsigned*)(idx + t * 128 + 2 * lane); i32x2 v = {(int)(iw & 0xffffu) & imask, (int)(iw >> 16) & imask}; const unsigned c = *(const unsigned*)(coef8 + t * 128 + 2 * lane);
            li[k * 128 + sd0] = v.x; li[k * 128 + sd1] = v.y; lc[k * 128 + sd0] = (unsigned short)(c & 0xffffu); lc[k * 128 + sd1] = (unsigned short)(c >> 16);
        }
        asm volatile("s_waitcnt vmcnt(0) lgkmcnt(0)" ::: "memory");
        const int nstep = 4 * nb;
        u32x4 rb[8][4]; ge::f32x4 acc0, acc1; unsigned hv;
#define PV_ISSUE(s, B) do { const ge::u32x4 ia_ = *(const LAS ge::u32x4*)(li + ((s) >> 1) * 64 + rg * 8 + 4 * ((s) & 1)); \
            _Pragma("unroll") for (int i_ = 0; i_ < 4; ++i_) rb[B][i_] = *(const u32x4*)(tab + (ia_[i_] * 128u + lo16)); } while (0)
#define PV_STEP(s, B, QT) do { if ((s) < nstep) { if ((s) + 7 < nstep) PV_ISSUE((s) + 7, ((B) + 7) & 7); \
            const int k_ = (s) >> 2; const size_t t_ = (size_t)gw + (size_t)(tb + k_) * ngw; \
            if (QT == 0) { acc0 = (ge::f32x4){0.f, 0.f, 0.f, 0.f}; acc1 = acc0; hv = *(const unsigned*)(hin + t_ * D + 128 * slice + 2 * lane); }     \
            const ge::u32x2 cw_ = *(const LAS ge::u32x2*)(lc + ((s) >> 1) * 64 + rg * 8 + 4 * ((s) & 1));                       \
            _Pragma("unroll") for (int i = 0; i < 4; ++i) { const unsigned w_ = (i < 2 ? cw_.x : cw_.y) >> (16 * (i & 1)); \
                const unsigned th_ = (w_ & 0xffu) << bsh, tl_ = ((w_ >> 8) & 0xffu) << bsh; \
                const long bh_ = (long)(((unsigned long long)(th_ & mhi) << 32) | (th_ & mlo)), bl_ = (long)(((unsigned long long)(tl_ & mhi) << 32) | (tl_ & mlo)); \
                const u32x4 av = rb[B][i]; const long a0_ = (long)(((unsigned long long)av.y << 32) | av.x), a1_ = (long)(((unsigned long long)av.w << 32) | av.z); \
                acc0 = __builtin_amdgcn_mfma_f32_16x16x32_fp8_fp8(a0_, bh_, acc0, 0, 0, 0); acc1 = __builtin_amdgcn_mfma_f32_16x16x32_fp8_fp8(a1_, bh_, acc1, 0, 0, 0); \
                acc0 = __builtin_amdgcn_mfma_f32_16x16x32_fp8_fp8(a0_, bl_, acc0, 0, 0, 0); acc1 = __builtin_amdgcn_mfma_f32_16x16x32_fp8_fp8(a1_, bl_, acc1, 0, 0, 0); } \
            if (QT == 3) { \
                if (dvalid) { LAS float* tp_ = tr + 128 * (qq >> 1) + dcol; _Pragma("unroll") for (int i = 0; i < 4; ++i) { tp_[16 * i] = acc0[i]; tp_[16 * i + 8] = acc1[i]; } } \
                const f32x2 e0_ = *(const LAS f32x2*)(tr + 2 * lane), e1_ = *(const LAS f32x2*)(tr + 128 + 2 * lane);                 \
                const unsigned w2_ = pk2(__uint_as_float(hv << 16) + (e0_.x + e1_.x) * (1.f / (VSCALE * CSCALE)), __uint_as_float(hv & 0xffff0000u) + (e0_.y + e1_.y) * (1.f / (VSCALE * CSCALE))); \
                *(unsigned*)(hb + t_ * D + 128 * slice + 2 * lane) = w2_; const float x0 = __uint_as_float(w2_ << 16), x1 = __uint_as_float(w2_ & 0xffff0000u); \
                float sq = x0 * x0 + x1 * x1; sq = wave_sum(sq); if (lane == 0) ssp1[t_ * 8 + slice] = sq; } } } while (0)
        PV_ISSUE(0, 0); PV_ISSUE(1, 1); PV_ISSUE(2, 2); PV_ISSUE(3, 3); if (4 < nstep) { PV_ISSUE(4, 4); PV_ISSUE(5, 5); PV_ISSUE(6, 6); }
        for (int s0 = 0; s0 < nstep; s0 += 8) { PV_STEP(s0, 0, 0); PV_STEP(s0 + 1, 1, 1); PV_STEP(s0 + 2, 2, 2); PV_STEP(s0 + 3, 3, 3); PV_STEP(s0 + 4, 4, 0); PV_STEP(s0 + 5, 5, 1); PV_STEP(s0 + 6, 6, 2); PV_STEP(s0 + 7, 7, 3); }
#undef PV_ISSUE
#undef PV_STEP
        asm volatile("s_waitcnt lgkmcnt(0)" ::: "memory");
    }
}

__device__ __forceinline__ void ph_final(const bf16_t* __restrict__ hb, const float* __restrict__ ssp1, const float* __restrict__ g, float* __restrict__ out) {
    PH_IDS
    const int lane = TIDX & 63, gw = BIDX * 8 + __builtin_amdgcn_readfirstlane(TIDX >> 6), ngw = GDIM * 8;
    for (int w = gw; w < T; w += ngw) {
        const float rs = rsqrtf(sum8(ssp1 + (size_t)w * 8) * (1.f / D) + EPS);
        const u32x4* r = (const u32x4*)(hb + (size_t)w * D) + lane; const f32x4* gg = (const f32x4*)g; f32x4* o = (f32x4*)(out + (size_t)w * D);
#pragma unroll
        for (int j = 0; j < 2; ++j) { const u32x4 v = r[64 * j]; const int c4 = (64 * j + lane) * 2; const f32x4 g0 = gg[c4], g1 = gg[c4 + 1];
            o[c4] = (f32x4){__uint_as_float(v.x << 16) * rs * g0.x, __uint_as_float(v.x & 0xffff0000u) * rs * g0.y, __uint_as_float(v.y << 16) * rs * g0.z, __uint_as_float(v.y & 0xffff0000u) * rs * g0.w};
            o[c4 + 1] = (f32x4){__uint_as_float(v.z << 16) * rs * g1.x, __uint_as_float(v.z & 0xffff0000u) * rs * g1.y, __uint_as_float(v.w << 16) * rs * g1.z, __uint_as_float(v.w & 0xffff0000u) * rs * g1.w}; }
    }
}
}
namespace attn_body {
using bf16=__hip_bfloat16;
using bf16x8=__attribute__((ext_vector_type(8)))short;
using s16x4=__attribute__((ext_vector_type(4)))short;
using f32x16=__attribute__((ext_vector_type(16)))float;
using u32x4=__attribute__((ext_vector_type(4)))unsigned;
constexpr int BATCH=8,NHEAD=8,SEQ=4096,D=64,DM=NHEAD*D;
constexpr int OPITCH=1024,OCOL=512;
constexpr int NW=8,QBLK=32,QB=QBLK*NW,KVBLK=64,NQB=SEQ/QB;
constexpr int ATTN_PITCH=DM, ATTN_UNIT_ROWS=QB;
__device__ __forceinline__ int crow(int r,int hi){return (r&3)+8*(r>>2)+4*hi;}
#define SBAR() __builtin_amdgcn_sched_barrier(0)
__device__ __forceinline__ void cmask(f32x16&p0,f32x16&p1,int jb,int qrel,int hi){
  const float NEG=-INFINITY; int kb=64*jb+4*hi;
  #pragma unroll
  for(int r=0;r<16;++r){int kv=kb+(r&3)+8*(r>>2); if(kv>qrel)p0[r]=NEG; if(kv+32>qrel)p1[r]=NEG;}
}

constexpr int NSLOT=3, SLOTB=8192;
constexpr int LDS_K=0, LDS_V=NSLOT*SLOTB, LDS_WS=2*NSLOT*SLOTB, LDS_OST=LDS_WS+NW*64*4, LDS_CUM=LDS_OST+NW*4096, LDS_BYTES=LDS_CUM+SEQ*4;
constexpr float PRUNE_T=64.f;
constexpr float C2=0.125f*1.4426950408889634f;
__device__ __forceinline__ void glds16(const void*gsrc,unsigned lds_dst){unsigned keep;
  asm volatile("s_mov_b32 %0, m0\n\ts_mov_b32 m0, %2\n\ts_nop 0\n\tglobal_load_lds_dwordx4 %1, off\n\ts_mov_b32 m0, %0":"=&s"(keep):"v"(gsrc),"s"(lds_dst):"memory");}
__device__ __forceinline__ float max3f(float a,float b,float c){float r;asm("v_max3_f32 %0, %1, %2, %3":"=v"(r):"v"(a),"v"(b),"v"(c));return r;}
__device__ __forceinline__ float max2f(float a,float b){float r;asm("v_max_f32_e32 %0, %1, %2":"=v"(r):"v"(a),"v"(b));return r;}
__device__ __forceinline__ float fadd_s(float a,float b){float r;asm("v_add_f32_e32 %0, %1, %2":"=v"(r):"v"(a),"v"(b));return r;}
__device__ __forceinline__ float fsub_s(float a,float b){float r;asm("v_sub_f32_e32 %0, %1, %2":"=v"(r):"v"(a),"v"(b));return r;}
typedef float f32x4_t __attribute__((ext_vector_type(4)));
typedef float f32x2_t __attribute__((ext_vector_type(2))); typedef __bf16 bf16x2_t __attribute__((ext_vector_type(2)));
__device__ __forceinline__ unsigned cvtpk_s(float lo,float hi){f32x2_t v={lo,hi};bf16x2_t b=__builtin_convertvector(v,bf16x2_t);return __builtin_bit_cast(unsigned,b);}
#define WAIT_BAR(N) asm volatile("s_waitcnt vmcnt(" #N ") lgkmcnt(0)\n\ts_barrier":::"memory")

__device__ __forceinline__ void qkt(f32x16&p0,f32x16&p1,const char*Kslot,const bf16x8*qr,const f32x16&negm,int r32,int hi){
  const char*kb=Kslot+hi*1024+r32*16;
  #pragma unroll
  for(int d0=0;d0<4;++d0){
    const bf16x8 b0=*reinterpret_cast<const bf16x8*>(kb+d0*2048);
    const bf16x8 b1=*reinterpret_cast<const bf16x8*>(kb+d0*2048+512);
    if(d0==0){p0=__builtin_amdgcn_mfma_f32_32x32x16_bf16(b0,qr[0],negm,0,0,0);p1=__builtin_amdgcn_mfma_f32_32x32x16_bf16(b1,qr[0],negm,0,0,0);}
    else{p0=__builtin_amdgcn_mfma_f32_32x32x16_bf16(b0,qr[d0],p0,0,0,0);p1=__builtin_amdgcn_mfma_f32_32x32x16_bf16(b1,qr[d0],p1,0,0,0);}}
}
typedef __attribute__((address_space(3))) const char* lds_cptr;
typedef short v4i16_t __attribute__((ext_vector_type(4)));
__device__ __forceinline__ void kload8(bf16x8*kf,lds_cptr kp){
  kf[0]=*(const __attribute__((address_space(3))) bf16x8*)(kp);      kf[1]=*(const __attribute__((address_space(3))) bf16x8*)(kp+512);
  kf[2]=*(const __attribute__((address_space(3))) bf16x8*)(kp+2048); kf[3]=*(const __attribute__((address_space(3))) bf16x8*)(kp+2560);
  kf[4]=*(const __attribute__((address_space(3))) bf16x8*)(kp+4096); kf[5]=*(const __attribute__((address_space(3))) bf16x8*)(kp+4608);
  kf[6]=*(const __attribute__((address_space(3))) bf16x8*)(kp+6144); kf[7]=*(const __attribute__((address_space(3))) bf16x8*)(kp+6656);
}
__device__ __forceinline__ void kload2(bf16x8*kf,lds_cptr kp,int j){ kf[2*j]=*(const __attribute__((address_space(3))) bf16x8*)(kp+j*2048); kf[2*j+1]=*(const __attribute__((address_space(3))) bf16x8*)(kp+j*2048+512); }
__device__ __forceinline__ s16x4 vtr(lds_cptr p){ return __builtin_bit_cast(s16x4,__builtin_amdgcn_ds_read_tr16_b64_v4i16((__attribute__((address_space(3))) v4i16_t*)p)); }
__device__ __forceinline__ float rowmax(const f32x16&p0,const f32x16&p1){
  float a=max3f(p0[0],p0[1],p1[0]),b=max3f(p0[2],p0[3],p1[1]);a=max3f(a,p1[2],p1[3]);
  #pragma unroll
  for(int r=4;r<16;r+=4){a=max3f(a,p0[r],p0[r+1]);b=max3f(b,p0[r+2],p0[r+3]);a=max3f(a,p1[r],p1[r+1]);b=max3f(b,p1[r+2],p1[r+3]);}
  const float m=max2f(a,b);
  auto rr=__builtin_amdgcn_permlane32_swap(__float_as_uint(m),__float_as_uint(m),false,false);
  return max2f(__uint_as_float(rr[0]),__uint_as_float(rr[1]));
}
__device__ __forceinline__ void pv(f32x16*o,int vb,bf16x8 pa0,bf16x8 pa1,bf16x8 pa2,bf16x8 pa3){
  #pragma unroll
  for(int d0=0;d0<2;++d0){s16x4 lo[4],hi[4];
    #pragma unroll
    for(int ks=0;ks<4;++ks){
      asm volatile("ds_read_b64_tr_b16 %0,%1 offset:%c2":"=&v"(lo[ks]):"v"(vb),"i"(d0*4096+ks*1024):"memory");
      asm volatile("ds_read_b64_tr_b16 %0,%1 offset:%c2":"=&v"(hi[ks]):"v"(vb),"i"(d0*4096+ks*1024+512):"memory");}
    asm volatile("s_waitcnt lgkmcnt(0)":::"memory");SBAR();
    #define PK(k) (bf16x8){lo[k][0],lo[k][1],lo[k][2],lo[k][3],hi[k][0],hi[k][1],hi[k][2],hi[k][3]}
    o[d0]=__builtin_amdgcn_mfma_f32_32x32x16_bf16(pa0,PK(0),o[d0],0,0,0);
    o[d0]=__builtin_amdgcn_mfma_f32_32x32x16_bf16(pa1,PK(1),o[d0],0,0,0);
    o[d0]=__builtin_amdgcn_mfma_f32_32x32x16_bf16(pa2,PK(2),o[d0],0,0,0);
    o[d0]=__builtin_amdgcn_mfma_f32_32x32x16_bf16(pa3,PK(3),o[d0],0,0,0);
    #undef PK
  }
}

#ifndef ATTN_STORE16
#define ATTN_STORE16(p,v) (*(u32x4*)(p)=(v))
#endif
template<int THRL> __device__ __forceinline__ void attn_unit(int b,int h,int qb,const bf16*Q,const bf16*__restrict__ K,const bf16*__restrict__ V,const float*__restrict__ cum2,bf16*O,float*__restrict__ ssp,char*shm,int tid_){
  int tid=tid_; asm volatile("":"+v"(tid)); const int lane=tid&63,r32=lane&31,hi=lane>>5; const int wid=__builtin_amdgcn_readfirstlane(tid>>6);
  const long rowbase=(long)b*SEQ; const int q0=qb*QB;
  const bf16*Qw=Q+(rowbase+q0+wid*QBLK)*DM+h*D;
  const bf16*Kh=K+rowbase*DM+h*D,*Vh=V+rowbase*DM+h*D;
  const unsigned lds0=(unsigned)(uintptr_t)shm;
  float*wsf=(float*)(shm+LDS_WS)+wid*64;
  const int NTf=(q0+QB)/KVBLK; const float*cg=cum2+(long)(b*NHEAD+h)*SEQ;
  int ts; { const float thr=cg[q0]+PRUNE_T; const float ce=lane<NTf?cg[64*lane+63]:0.f; const unsigned long long m_=__ballot((lane<NTf)&&(ce<=thr));
    ts=m_?(int)__builtin_ctzll(m_):0; ts&=~1; if(ts>NTf-4)ts=NTf-4; ts=__builtin_amdgcn_readfirstlane(ts); }
  const bf16*ksrc=Kh+(long)(ts*KVBLK+lane)*DM+wid*8;
  const bf16*vsrc=Vh+(long)(ts*KVBLK+16*(wid&3)+(lane>>2))*DM+(wid>>2)*32+(lane&3)*8;
  const unsigned kdst=lds0+LDS_K+wid*1024, vdst=lds0+LDS_V+wid*1024;
  #define DMA_K(t,slot) glds16(ksrc+(long)(t)*KVBLK*DM,(unsigned)__builtin_amdgcn_readfirstlane(kdst+(slot)))
  #define DMA_V(t,slot) glds16(vsrc+(long)(t)*KVBLK*DM,(unsigned)__builtin_amdgcn_readfirstlane(vdst+(slot)))
  const int vb0=(int)(lds0+LDS_V)+((lane>>4)&1)*32+(lane&3)*8+(4*hi+((lane&15)>>2))*64;
  const char*Kbase=shm+LDS_K; bf16x8 kf[8];
  const lds_cptr shm3=(lds_cptr)shm; const lds_cptr kp0=shm3+LDS_K+hi*1024+r32*16; const lds_cptr vp0=shm3+LDS_V+((lane>>4)&1)*32+(lane&3)*8+(4*hi+((lane&15)>>2))*64;
  { float*cl=(float*)(shm+LDS_CUM); for(int i=tid+ts*KVBLK;i<q0+QB;i+=NW*64)cl[i-ts*KVBLK]=cg[i]; }
  const float cq2=cg[q0+wid*QBLK+r32];
  const __attribute__((address_space(3))) float* ckl=(const __attribute__((address_space(3))) float*)(shm3+LDS_CUM)+4*hi;
  #define BIAS(P0,P1,t) do{ const __attribute__((address_space(3))) float*ck_=ckl+64*(t); const float mm_=mhat-cq2; _Pragma("unroll") for(int g_=0;g_<4;++g_){ \
      const f32x4_t c0_=*(const __attribute__((address_space(3))) f32x4_t*)(ck_+8*g_)+mm_, c1_=*(const __attribute__((address_space(3))) f32x4_t*)(ck_+32+8*g_)+mm_; \
      _Pragma("unroll") for(int i_=0;i_<4;++i_){P0[4*g_+i_]-=c0_[i_];P1[4*g_+i_]-=c1_[i_];} SBAR(); } }while(0)
  const int NT=NTf-ts;
  DMA_K(0,0);DMA_V(0,0);DMA_K(1,SLOTB);
  bf16x8 qr[4];
  #pragma unroll
  for(int d0=0;d0<4;++d0)qr[d0]=*reinterpret_cast<const bf16x8*>(&Qw[(long)r32*DM+d0*16+hi*8]);
  float mhat=0.f,l_reg=0.f;f32x16 o[2];o[0]=f32x16{};o[1]=f32x16{};const f32x16 negm=f32x16{};
  const int qrel=wid*QBLK+r32;
  #define CMASK(P0,P1,t) do{int jb_=(t)-(NT-4); if(jb_>=0)cmask(P0,P1,jb_,qrel,hi);}while(0)
  bool resc=false;
  #define START(P0,P1) do{ const float rm=rowmax(P0,P1); resc=false; \
    { const float dl=rm; mhat=fadd_s(mhat,dl); \
      _Pragma("unroll") for(int r=0;r<16;++r){P0[r]=fsub_s(P0[r],dl);P1[r]=fsub_s(P1[r],dl);} \
      } \
    _Pragma("unroll") for(int r=0;r<16;++r)P0[r]=__builtin_amdgcn_exp2f(P0[r]); }while(0)
  #define RESC() do{ if(resc){ asm volatile("s_waitcnt lgkmcnt(0)":::"memory"); \
      _Pragma("unroll") for(int d_=0;d_<2;++d_) _Pragma("unroll") for(int r=0;r<16;++r)o[d_][r]*=wsf[crow(r,hi)]; } }while(0)
  f32x16 pA0,pA1,pB0,pB1;
  int sl_prev=0,sl_cur=0,sl_next=SLOTB;
  #define ROT() do{sl_prev=sl_cur;sl_cur=sl_next;sl_next=(sl_next==(NSLOT-1)*SLOTB)?0:sl_next+SLOTB;}while(0)
  DMA_K(2,2*SLOTB);
  WAIT_BAR(3);
  qkt(pA0,pA1,Kbase,qr,negm,r32,hi);asm volatile("s_nop 15\n\ts_nop 7":"+v"(pA0),"+v"(pA1));BIAS(pA0,pA1,0);CMASK(pA0,pA1,0);
  START(pA0,pA1);
  _Pragma("unroll") for(int r=0;r<16;++r)pA1[r]=__builtin_amdgcn_exp2f(pA1[r]);
  WAIT_BAR(0);
  DMA_K(3,0);DMA_V(1,SLOTB);
  ROT();
  kload8(kf,kp0+sl_cur);
  WAIT_BAR(2);
  s16x4 vlo[8],vhi[8]; u32x4 pw0,pw1,pw2,pw3;
  #define PKW(P,B) cvtpk_s(P[B],P[B+1])
  #define PAF(k) __builtin_bit_cast(bf16x8,pw##k)
  #define VFR(i) (bf16x8){vlo[i][0],vlo[i][1],vlo[i][2],vlo[i][3],vhi[i][0],vhi[i][1],vhi[i][2],vhi[i][3]}
  #define PIN(x) asm volatile("":"+v"(x))
  #define MX3(a,b,c) __builtin_fmaxf(__builtin_fmaxf((a),(b)),(c))
  #define GAPA(MF,A0,A1,A2,A3,W0,W1,PW) do{ MF; sacc+=A0; sacc+=A1; sacc+=A2; sacc+=A3; PIN(sacc); W0; W1; PIN(PW); SBAR(); }while(0)
  #define EX(v) __builtin_amdgcn_exp2f(v)
  #define GAPB(MF,X,B) do{ MF; X[B]=EX(X[B]); X[B+1]=EX(X[B+1]); X[B+2]=EX(X[B+2]); X[B+3]=EX(X[B+3]); PIN(X); SBAR(); }while(0)
  #define VRD(i) do{ vlo[i]=vtr(vp_+(((i)>>2)*4096+((i)&3)*1024)); vhi[i]=vtr(vp_+(((i)>>2)*4096+((i)&3)*1024+512)); }while(0)
  #define KRD(G,j) do{ if(G){ kload2(kf,kp0+sl_next,j); SBAR(); } }while(0)
  #define STEP(C0,C1,P0,P1,t,GK,GV,GL) do{ SBAR(); \
    const lds_cptr vp_=vp0+sl_prev; \
    VRD(0); SBAR(); float sacc=(P0[0]+P0[1]); \
    GAPA(C0=__builtin_amdgcn_mfma_f32_32x32x16_bf16(kf[0],qr[0],negm,0,0,0), P0[2],P0[3],P0[4],P0[5],     pw0[0]=PKW(P0,0), pw0[1]=PKW(P0,2), pw0); \
    VRD(4); SBAR(); GAPA(C1=__builtin_amdgcn_mfma_f32_32x32x16_bf16(kf[1],qr[0],negm,0,0,0), P0[6],P0[7],P0[8],P0[9],     pw0[2]=PKW(P0,4), pw0[3]=PKW(P0,6), pw0); \
    VRD(1); SBAR(); GAPA(C0=__builtin_amdgcn_mfma_f32_32x32x16_bf16(kf[2],qr[1],C0,0,0,0),   P0[10],P0[11],P0[12],P0[13], pw1[0]=PKW(P0,8), pw1[1]=PKW(P0,10), pw1); \
    VRD(5); SBAR(); GAPA(C1=__builtin_amdgcn_mfma_f32_32x32x16_bf16(kf[3],qr[1],C1,0,0,0),   P0[14],P0[15],P1[0],P1[1],   pw1[2]=PKW(P0,12),pw1[3]=PKW(P0,14), pw1); \
    VRD(2); SBAR(); GAPA(C0=__builtin_amdgcn_mfma_f32_32x32x16_bf16(kf[4],qr[2],C0,0,0,0),   P1[2],P1[3],P1[4],P1[5],     pw2[0]=PKW(P1,0), pw2[1]=PKW(P1,2), pw2); \
    VRD(6); SBAR(); GAPA(C1=__builtin_amdgcn_mfma_f32_32x32x16_bf16(kf[5],qr[2],C1,0,0,0),   P1[6],P1[7],P1[8],P1[9],     pw2[2]=PKW(P1,4), pw2[3]=PKW(P1,6), pw2); \
    VRD(3); SBAR(); GAPA(C0=__builtin_amdgcn_mfma_f32_32x32x16_bf16(kf[6],qr[3],C0,0,0,0),   P1[10],P1[11],P1[12],P1[13], pw3[0]=PKW(P1,8), pw3[1]=PKW(P1,10), pw3); \
    VRD(7); SBAR(); GAPA(C1=__builtin_amdgcn_mfma_f32_32x32x16_bf16(kf[7],qr[3],C1,0,0,0),   P1[14],P1[15],0.f,0.f,       pw3[2]=PKW(P1,12),pw3[3]=PKW(P1,14), pw3); \
    l_reg+=sacc; \
    if(GK){DMA_K((t)+3,sl_cur);} if(GV){DMA_V((t)+1,sl_next);} \
    BIAS(C0,C1,t); CMASK(C0,C1,t); \
    { float a=MX3(C0[0],C0[1],C1[0]),b=MX3(C0[2],C0[3],C1[1]); a=MX3(a,C1[2],C1[3]); \
      _Pragma("unroll") for(int r=4;r<16;r+=4){a=MX3(a,C0[r],C0[r+1]);b=MX3(b,C0[r+2],C0[r+3]);a=MX3(a,C1[r],C1[r+1]);b=MX3(b,C1[r+2],C1[r+3]);} \
      float rm=__builtin_fmaxf(a,b); { auto rr=__builtin_amdgcn_permlane32_swap(__float_as_uint(rm),__float_as_uint(rm),false,false); rm=__builtin_fmaxf(__uint_as_float(rr[0]),__uint_as_float(rr[1])); } \
      resc=false; \
      if(__builtin_expect(__any(rm>(float)THRL),0)){ const float dl=__builtin_fmaxf(rm,0.f); mhat+=dl; \
        _Pragma("unroll") for(int r=0;r<16;++r){C0[r]-=dl;C1[r]-=dl;} \
        const float f=__builtin_amdgcn_exp2f(-dl); l_reg*=f; if(hi==0)wsf[r32]=f; resc=true; } } \
    SBAR(); \
    GAPB(o[0]=__builtin_amdgcn_mfma_f32_32x32x16_bf16(PAF(0),VFR(0),o[0],0,0,0), C0,0); \
    GAPB(o[1]=__builtin_amdgcn_mfma_f32_32x32x16_bf16(PAF(0),VFR(4),o[1],0,0,0), C0,4); \
    KRD(GL,0); GAPB(o[0]=__builtin_amdgcn_mfma_f32_32x32x16_bf16(PAF(1),VFR(1),o[0],0,0,0), C0,8); \
    KRD(GL,1); GAPB(o[1]=__builtin_amdgcn_mfma_f32_32x32x16_bf16(PAF(1),VFR(5),o[1],0,0,0), C0,12); \
    KRD(GL,2); GAPB(o[0]=__builtin_amdgcn_mfma_f32_32x32x16_bf16(PAF(2),VFR(2),o[0],0,0,0), C1,0); \
    KRD(GL,3); GAPB(o[1]=__builtin_amdgcn_mfma_f32_32x32x16_bf16(PAF(2),VFR(6),o[1],0,0,0), C1,4); \
    GAPB(o[0]=__builtin_amdgcn_mfma_f32_32x32x16_bf16(PAF(3),VFR(3),o[0],0,0,0), C1,8); \
    GAPB(o[1]=__builtin_amdgcn_mfma_f32_32x32x16_bf16(PAF(3),VFR(7),o[1],0,0,0), C1,12); \
    }while(0)
  int t=1;
  #undef CMASK
  #define CMASK(P0,P1,t) do{}while(0)
  for(;t+5<NT;t+=2){
    STEP(pB0,pB1,pA0,pA1,t,true,true,true);     WAIT_BAR(2); RESC(); ROT();
    STEP(pA0,pA1,pB0,pB1,t+1,true,true,true);   WAIT_BAR(2); RESC(); ROT();
  }
  #undef CMASK
  #define CMASK(P0,P1,t) do{int jb_=(t)-(NT-4); if(jb_>=0)cmask(P0,P1,jb_,qrel,hi);}while(0)
  #define ENDW(tt) do{ if((tt)+3<NT){WAIT_BAR(2);} else if((tt)+2<NT){WAIT_BAR(1);} else {WAIT_BAR(0);} }while(0)
  for(;t+1<NT;t+=2){
    STEP(pB0,pB1,pA0,pA1,t,(t+3<NT),(t+1<NT),(t+1<NT));       ENDW(t);   RESC(); ROT();
    STEP(pA0,pA1,pB0,pB1,t+1,(t+4<NT),(t+2<NT),(t+2<NT));     ENDW(t+1); RESC(); ROT();
  }
  STEP(pB0,pB1,pA0,pA1,NT-1,false,false,false); RESC();
  { float sacc=pB0[0]+pB0[1]; _Pragma("unroll") for(int r=2;r<16;++r)sacc+=pB0[r]; _Pragma("unroll") for(int r=0;r<16;++r)sacc+=pB1[r]; l_reg+=sacc;
    pw0=(u32x4){PKW(pB0,0),PKW(pB0,2),PKW(pB0,4),PKW(pB0,6)};pw1=(u32x4){PKW(pB0,8),PKW(pB0,10),PKW(pB0,12),PKW(pB0,14)};pw2=(u32x4){PKW(pB1,0),PKW(pB1,2),PKW(pB1,4),PKW(pB1,6)};pw3=(u32x4){PKW(pB1,8),PKW(pB1,10),PKW(pB1,12),PKW(pB1,14)};
    SBAR(); pv(o,vb0+sl_cur,PAF(0),PAF(1),PAF(2),PAF(3)); }
  #undef PKW
  #undef PAF
  #undef VFR
  #undef PIN
  #undef MX3
  #undef GAPA
  #undef GAPB
  #undef EX
  #undef VRD
  #undef KRD
  #undef STEP
  #undef ENDW
  {auto rr=__builtin_amdgcn_permlane32_swap(__float_as_uint(l_reg),__float_as_uint(l_reg),false,false);l_reg=__uint_as_float(rr[0])+__uint_as_float(rr[1]);}
  if(hi==0)wsf[32+r32]=l_reg;asm volatile("s_waitcnt lgkmcnt(0)":::"memory");
  float rli[16];
  #pragma unroll
  for(int r=0;r<16;++r)rli[r]=__builtin_amdgcn_rcpf(wsf[32+crow(r,hi)]);
  int lane_e=lane; asm volatile("":"+v"(lane_e));
  bf16*Ow=O+(rowbase+q0+wid*QBLK)*OPITCH+OCOL+h*D; float*sw=ssp+(rowbase+q0+wid*QBLK)*8+h;
  { bf16*stg=(bf16*)(shm+LDS_OST)+wid*2048;
    #pragma unroll
    for(int r=0;r<16;++r){const int orow=crow(r,hi);
      #pragma unroll
      for(int d0=0;d0<2;++d0)stg[orow*64+d0*32+r32]=__float2bfloat16(o[d0][r]*rli[r]);}
    asm volatile("s_waitcnt lgkmcnt(0)":::"memory");
    #pragma unroll
    for(int i=0;i<4;++i){const int row=i*8+(lane_e>>3),ch=lane_e&7; const u32x4 v=*(const u32x4*)(stg+row*64+ch*8); ATTN_STORE16(Ow+(long)row*OPITCH+ch*8,v);
      float sq=0.f;
      #pragma unroll
      for(int k=0;k<4;++k){const float a=__uint_as_float(v[k]<<16),c=__uint_as_float(v[k]&0xffff0000u);sq+=a*a+c*c;}
      sq+=__shfl_xor(sq,1);sq+=__shfl_xor(sq,2);sq+=__shfl_xor(sq,4);
      if(ch==0)sw[(long)row*8]=sq; } }
  asm volatile("s_waitcnt lgkmcnt(0)\n\ts_barrier":::"memory");
  #undef DMA_K
  #undef DMA_V
  #undef CMASK
  #undef START
  #undef RESC
  #undef BIAS
  #undef ROT
}
constexpr int ATTN_LDS_BYTES=LDS_BYTES;
template<int THRL=8> __device__ __forceinline__ void attn_phase(char*lds,const bf16*Q,const bf16*K,const bf16*V,const float*cum2,bf16*O,float*ssp,unsigned*ctr,volatile __attribute__((address_space(3))) unsigned*slot,int tid){
  for(;;){
    if(tid==0)*slot=__hip_atomic_fetch_add(ctr,1u,__ATOMIC_RELAXED,__HIP_MEMORY_SCOPE_AGENT);
    __syncthreads();
    const int u=(int)*slot;
    __syncthreads();
    if(u>=BATCH*NHEAD*NQB)break;
    const int qb=NQB-1-(u>>6),h=NHEAD-1-((u>>3)&7),b=u&7;
    attn_unit<THRL>(b,h,qb,Q,K,V,cum2,O,ssp,lds,tid);
  }
}
#undef SBAR
#undef WAIT_BAR
}
namespace nv {
typedef float f32x2v __attribute__((ext_vector_type(2)));
constexpr size_t WS_APOW = 921 * MiB;
constexpr size_t WS_BBAR = 89 * MiB;
constexpr int KDW = 128 * 256;
__device__ __forceinline__ void p0_ssm_a(const float* __restrict__ lam_re, const float* __restrict__ lam_im, const float* __restrict__ log_dt, const float* __restrict__ b_re, const float* __restrict__ b_im,
                                         f32x2v* __restrict__ apow, f32x2v* __restrict__ bbar) {
    PH_IDS
    for (int i = BIDX * 512 + TIDX; i < DEPTH * G * P; i += GDIM * 512) {
        const int lg = i / P, p = i % P;
        const float dtf = expf(log_dt[lg]); const float lr = lam_re[i], li = lam_im[i];
        const double ang = (double)li * (double)dtf, k2 = rint(ang * 0.15915494309189535), red = ang - k2 * 6.283185307179586;
        const float mag = expf(lr * dtf), rr = (float)red; const double are = (double)(mag * cosf(rr)), aim = (double)(mag * sinf(rr));
        double pr = 1.0, pi = 0.0;
        for (int d = 0; d <= 64; ++d) { apow[((size_t)lg * 65 + d) * P + p] = (f32x2v){(float)pr, (float)pi}; const double nr_ = pr * are - pi * aim, ni_ = pr * aim + pi * are; pr = nr_; pi = ni_; }
        const double lrd = lr, lid = li, den = lrd * lrd + lid * lid, nr = are - 1.0, zre = (nr * lrd + aim * lid) / den, zim = (aim * lrd - nr * lid) / den;
        for (int h = 0; h < HC; ++h) { const double br = b_re[(size_t)i * HC + h], bi = b_im[(size_t)i * HC + h]; bbar[(size_t)i * HC + h] = (f32x2v){(float)(zre * br - zim * bi), (float)(zre * bi + zim * br)}; }
    }
}
__device__ __forceinline__ void p0_ssm_b(const f32x2v* __restrict__ apow, const f32x2v* __restrict__ bbar, const float* __restrict__ c_re, const float* __restrict__ c_im, const float* __restrict__ dsk,
                                         bf16_t* __restrict__ KD, bf16_t* __restrict__ WST, bf16_t* __restrict__ WOUT) {
    PH_IDS
    const int gt = BIDX * 512 + TIDX, nth = GDIM * 512;
    for (int i = gt; i < DEPTH * G * KDW; i += nth) {
        const int lg = i / KDW, r = i % KDW, dd = r >> 8, h = (r >> 4) & 15, h2 = r & 15, d = dd - 63;
        float v = 0.f;
        if (d >= 0 && dd < 127) {
            const f32x2v* ap = apow + ((size_t)lg * 65 + d) * P; const f32x2v* bb = bbar + (size_t)lg * P * HC + h2; const float* cr = c_re + ((size_t)lg * HC + h) * P; const float* ci = c_im + ((size_t)lg * HC + h) * P;
            for (int p = 0; p < P; ++p) { const f32x2v a = ap[p], b = bb[(size_t)p * HC]; const float wr = a.x * b.x - a.y * b.y, wi = a.x * b.y + a.y * b.x; v += cr[p] * wr - ci[p] * wi; }
            if (d == 0 && h == h2) v += dsk[lg * HC + h];
        }
        KD[i] = f2bf(v);
    }
    for (int i = gt; i < DEPTH * G * 128 * 256; i += nth) {
        const int lg = i >> 15, r = i & 32767, row = r >> 8, k = r & 255, j = k >> 4, h2 = k & 15, p = row & 63;
        const f32x2v a = apow[((size_t)lg * 65 + (15 - j)) * P + p], b = bbar[((size_t)lg * P + p) * HC + h2];
        WST[i] = f2bf(row < 64 ? a.x * b.x - a.y * b.y : a.x * b.y + a.y * b.x);
    }
    for (int i = gt; i < DEPTH * G * 1024 * 128; i += nth) {
        const int lg = i >> 17, r = i & 131071, row = r >> 7, k = r & 127, ti = row >> 4, h = row & 15, p = k & 63;
        const f32x2v e = apow[((size_t)lg * 65 + ti + 1) * P + p]; const float cr = c_re[((size_t)lg * HC + h) * P + p], ci = c_im[((size_t)lg * HC + h) * P + p];
        WOUT[i] = f2bf(k < 64 ? cr * e.x - ci * e.y : -(cr * e.y + ci * e.x));
    }
}

struct SchedSsmS {
    static constexpr bool DUALB = false; long hA, hB, hB1;
    const char* UP; const char* WST; int G_, c;
    __device__ __forceinline__ void init(const void* up, const void* wst_l, int grid, int bid) { UP = (const char*)up; WST = (const char*)wst_l; G_ = grid; c = bid; hA = 128l * UPW * 2; hB = 0; hB1 = 0; }
    __device__ __forceinline__ bool next(int i, ge::Unit& u) const {
        const int L = i * G_ + c; if (L >= G * 2 * 4) return false;
        const int g = L >> 3, pm = (L >> 2) & 1, ks = L & 3;
        u.A0 = UP + (((size_t)g * NCH + pm * 256) * UPW + 128 + ks * 256) * 2; u.B0 = WST + (size_t)g * 128 * 256 * 2; u.nt = 4; u.pm = pm; u.pn = ks; u.aux = g; return true; }
    __device__ __forceinline__ const char* ta(const ge::Unit& u, int t) const { return u.A0 + t * 128; }
    __device__ __forceinline__ const char* tb(const ge::Unit& u, int t) const { return u.B0 + t * 128; }
    __device__ __forceinline__ bool sb(const ge::Unit&, int) const { return false; }
    __device__ __forceinline__ unsigned voffA(int R, int C) const { return (unsigned)(R * UPW * 2 + C * 2); }
    __device__ __forceinline__ unsigned voffB(int Rb, int C) const { return (unsigned)(Rb * 512 + C * 2); }
    __device__ __forceinline__ unsigned voffB1(int, int) const { return 0u; }
};
struct EpiSsmS {
    static constexpr bool PERM = false, MIDK = false, UBEGIN = false;
    float* SLOC;
    __device__ __forceinline__ void unit_begin(const ge::Unit&, int, LAS unsigned char*) const {}
    __device__ __forceinline__ void midk(ge::f32x4 (&)[2][2][4][2], const ge::Unit&, int, int, LAS unsigned char*) const {}
    __device__ __forceinline__ void operator()(const ge::f32x4 (&acc)[2][2][4][2], const ge::Unit& u, int wr, int wc, int fr, int fq, LAS unsigned char*) const {
        const int g = u.aux, ks = u.pn;
#pragma unroll
        for (int ai = 0; ai < 2; ++ai)
#pragma unroll
            for (int m = 0; m < 4; ++m) {
                const int chunk = u.pm * 256 + ai * 128 + wr * 64 + m * 16 + fr; float* dst = SLOC + ((size_t)g * (NCH * 4) + chunk * 4 + ks) * 128;
#pragma unroll
                for (int n = 0; n < 2; ++n) *(ge::f32x4*)(dst + wc * 32 + 16 * n + 4 * fq) = acc[ai][0][m][n];
            }
    }
};

__device__ __forceinline__ void ph_ssm_prefix(LAS unsigned char* lds, const float* __restrict__ SLOC, const f32x2v* __restrict__ apow_l, bf16_t* __restrict__ UP) {
    PH_IDS
    const int p = TIDX & 63, w = __builtin_amdgcn_readfirstlane(TIDX >> 6);
    LAS f32x2v* ex = (LAS f32x2v*)lds;
    for (int item = BIDX; item < BATCH * G; item += GDIM) {
        const int b = item / G, g = item % G;
        const f32x2v a16 = apow_l[((size_t)g * 65 + 16) * P + p];
        const float* src = SLOC + ((size_t)g * (NCH * 4) + (size_t)b * 256 + 32 * w) * 128 + p; bf16_t* dst = UP + ((size_t)g * NCH + b * 64 + 8 * w) * UPW + p;
        float xr[32], xi[32];
#pragma unroll
        for (int k = 0; k < 32; ++k) { xr[k] = src[(size_t)k * 128]; xi[k] = src[(size_t)k * 128 + 64]; }
        float sr = 0.f, si = 0.f;
#pragma unroll
        for (int k = 0; k < 32; ++k) { const float nr = a16.x * sr - a16.y * si + xr[k], ni = a16.x * si + a16.y * sr + xi[k]; sr = nr; si = ni; }
        ex[w * 64 + p] = (f32x2v){sr, si};
        float qr = a16.x, qi = a16.y;
#pragma unroll
        for (int k = 0; k < 5; ++k) { const float nr = qr * qr - qi * qi, ni = 2.f * qr * qi; qr = nr; qi = ni; }
        __syncthreads();
        sr = 0.f; si = 0.f;
        for (int j = 0; j < w; ++j) { const f32x2v e = ex[j * 64 + p]; const float nr = qr * sr - qi * si + e.x, ni = qr * si + qi * sr + e.y; sr = nr; si = ni; }
#pragma unroll
        for (int k = 0; k < 32; ++k) {
            if ((k & 3) == 0) { bf16_t* d = dst + (size_t)(k >> 2) * UPW; d[0] = f2bf(sr); d[64] = f2bf(si); }
            const float nr = a16.x * sr - a16.y * si + xr[k], ni = a16.x * si + a16.y * sr + xi[k]; sr = nr; si = ni;
        }
        __syncthreads();
    }
}
__device__ __forceinline__ void ph_cum2(const float* __restrict__ logf, float* __restrict__ cum) {
    PH_IDS
    const int lane = TIDX & 63, gw = BIDX * 8 + __builtin_amdgcn_readfirstlane(TIDX >> 6), ngw = GDIM * 8;
    for (int item = gw; item < BATCH * NH; item += ngw) {
        const int b = item / NH, h = item % NH;
        const float* src = logf + ((size_t)b * SEQ + lane * 64) * NH + h; float* dst = cum + (size_t)item * SEQ + lane * 64;
        float tot = 0.f;
        for (int i = 0; i < 64; ++i) tot += src[(size_t)i * NH];
        float ex = tot;
#pragma unroll
        for (int o = 1; o < 64; o <<= 1) { const float y = __shfl_up(ex, o); if (lane >= o) ex += y; }
        float run = ex - tot;
        for (int i = 0; i < 64; ++i) { run += src[(size_t)i * NH]; dst[i] = run * 1.4426950408889634f; }
    }
}

struct SchedSsmC {
    static constexpr bool DUALB = true; long hA, hB, hB1;
    const char* UP; const char* WOUT; const char* KD; int G_, c;
    __device__ __forceinline__ void init(const void* up, const void* wout_l, const void* kd_l, int grid, int bid) { UP = (const char*)up; WOUT = (const char*)wout_l; KD = (const char*)kd_l; G_ = grid; c = bid; hA = 128l * UPW * 2; hB = 128l * 256; hB1 = 8l * 512; }
    __device__ __forceinline__ bool next(int i, ge::Unit& u) const {
        const int L = i * G_ + c; if (L >= G * 2 * 4) return false;
        const int pn = 3 - (L >> 6), g = (L & 63) >> 1, pm = L & 1;
        u.A0 = UP + ((size_t)g * NCH + pm * 256) * UPW * 2; u.B0 = nullptr; u.nt = 2 + 4 * (pn + 1); u.pm = pm; u.pn = pn; u.aux = g; return true; }
    __device__ __forceinline__ const char* ta(const ge::Unit& u, int t) const { return u.A0 + t * 128; }
    __device__ __forceinline__ bool sb(const ge::Unit&, int t) const { return t >= 2; }
    __device__ __forceinline__ const char* tb(const ge::Unit& u, int t) const {
        return t < 2 ? WOUT + ((size_t)u.aux * 1024 + u.pn * 256) * 256 + t * 128 : KD + ((size_t)u.aux * KDW + (size_t)(16 * u.pn - 4 * (t - 2) + 60) * 256) * 2; }
    __device__ __forceinline__ unsigned voffA(int R, int C) const { return (unsigned)(R * UPW * 2 + C * 2); }
    __device__ __forceinline__ unsigned voffB(int Rb, int C) const { return (unsigned)(Rb * 256 + C * 2); }
    __device__ __forceinline__ unsigned voffB1(int Rb, int C) const { return (unsigned)((((Rb >> 4) + 3 - (C >> 4)) * 256 + (Rb & 15) * 16 + (C & 15)) * 2); }
};
__device__ __forceinline__ float gelu_fast(float x) { const float u = 1.5957691216057308f * (x + 0.044715f * x * x * x); return x - x / (1.f + __expf(u)); }
struct EpiSsmC {
    static constexpr bool PERM = true, MIDK = false, UBEGIN = false;
    bf16_t* GEL;
    __device__ __forceinline__ void unit_begin(const ge::Unit&, int, LAS unsigned char*) const {}
    __device__ __forceinline__ void midk(ge::f32x4 (&)[2][2][4][2], const ge::Unit&, int, int, LAS unsigned char*) const {}
    __device__ __forceinline__ void operator()(const ge::f32x4 (&acc)[2][2][4][2], const ge::Unit& u, int wr, int wc, int fr, int fq, LAS unsigned char*) const {
        const int g = u.aux;
#pragma unroll
        for (int ai = 0; ai < 2; ++ai)
#pragma unroll
            for (int m = 0; m < 4; ++m) {
                const int chunk = u.pm * 256 + ai * 128 + wr * 64 + m * 16 + fr;
#pragma unroll
                for (int bj = 0; bj < 2; ++bj) {
                    const int col = u.pn * 256 + bj * 128 + wc * 32 + 8 * fq, ti = col >> 4, h0 = col & 15;
                    const ge::f32x4 v0 = acc[ai][bj][m][0], v1 = acc[ai][bj][m][1];
                    u32x4 w; w.x = ge::cvt_pk_bf16(gelu_fast(v0[0]), gelu_fast(v0[1])); w.y = ge::cvt_pk_bf16(gelu_fast(v0[2]), gelu_fast(v0[3]));
                    w.z = ge::cvt_pk_bf16(gelu_fast(v1[0]), gelu_fast(v1[1])); w.w = ge::cvt_pk_bf16(gelu_fast(v1[2]), gelu_fast(v1[3]));
                    *(u32x4*)(GEL + ((size_t)g * T + chunk * 64 + ti) * HC + h0) = w;
                }
            }
    }
};
}
namespace nv {
#define SEL_CE(x, y) do { const int _h = max((x), (y)), _l = min((x), (y)); (x) = _h; (y) = _l; } while (0)
__device__ __forceinline__ void sel_sort16(int (&v)[16]) {
    SEL_CE(v[0], v[1]);
    SEL_CE(v[2], v[3]);
    SEL_CE(v[0], v[2]);
    SEL_CE(v[1], v[3]);
    SEL_CE(v[1], v[2]);
    SEL_CE(v[4], v[5]);
    SEL_CE(v[6], v[7]);
    SEL_CE(v[4], v[6]);
    SEL_CE(v[5], v[7]);
    SEL_CE(v[5], v[6]);
    SEL_CE(v[0], v[4]);
    SEL_CE(v[2], v[6]);
    SEL_CE(v[2], v[4]);
    SEL_CE(v[1], v[5]);
    SEL_CE(v[3], v[7]);
    SEL_CE(v[3], v[5]);
    SEL_CE(v[1], v[2]);
    SEL_CE(v[3], v[4]);
    SEL_CE(v[5], v[6]);
    SEL_CE(v[8], v[9]);
    SEL_CE(v[10], v[11]);
    SEL_CE(v[8], v[10]);
    SEL_CE(v[9], v[11]);
    SEL_CE(v[9], v[10]);
    SEL_CE(v[12], v[13]);
    SEL_CE(v[14], v[15]);
    SEL_CE(v[12], v[14]);
    SEL_CE(v[13], v[15]);
    SEL_CE(v[13], v[14]);
    SEL_CE(v[8], v[12]);
    SEL_CE(v[10], v[14]);
    SEL_CE(v[10], v[12]);
    SEL_CE(v[9], v[13]);
    SEL_CE(v[11], v[15]);
    SEL_CE(v[11], v[13]);
    SEL_CE(v[9], v[10]);
    SEL_CE(v[11], v[12]);
    SEL_CE(v[13], v[14]);
    SEL_CE(v[0], v[8]);
    SEL_CE(v[4], v[12]);
    SEL_CE(v[4], v[8]);
    SEL_CE(v[2], v[10]);
    SEL_CE(v[6], v[14]);
    SEL_CE(v[6], v[10]);
    SEL_CE(v[2], v[4]);
    SEL_CE(v[6], v[8]);
    SEL_CE(v[10], v[12]);
    SEL_CE(v[1], v[9]);
    SEL_CE(v[5], v[13]);
    SEL_CE(v[5], v[9]);
    SEL_CE(v[3], v[11]);
    SEL_CE(v[7], v[15]);
    SEL_CE(v[7], v[11]);
    SEL_CE(v[3], v[5]);
    SEL_CE(v[7], v[9]);
    SEL_CE(v[11], v[13]);
    SEL_CE(v[1], v[2]);
    SEL_CE(v[3], v[4]);
    SEL_CE(v[5], v[6]);
    SEL_CE(v[7], v[8]);
    SEL_CE(v[9], v[10]);
    SEL_CE(v[11], v[12]);
    SEL_CE(v[13], v[14]);
}
__device__ __forceinline__ void sel_merge16(int (&a)[16], const int (&b)[16]) {
    a[0] = max(a[0], b[15]);
    a[1] = max(a[1], b[14]);
    a[2] = max(a[2], b[13]);
    a[3] = max(a[3], b[12]);
    a[4] = max(a[4], b[11]);
    a[5] = max(a[5], b[10]);
    a[6] = max(a[6], b[9]);
    a[7] = max(a[7], b[8]);
    a[8] = max(a[8], b[7]);
    a[9] = max(a[9], b[6]);
    a[10] = max(a[10], b[5]);
    a[11] = max(a[11], b[4]);
    a[12] = max(a[12], b[3]);
    a[13] = max(a[13], b[2]);
    a[14] = max(a[14], b[1]);
    a[15] = max(a[15], b[0]);
    SEL_CE(a[0], a[8]);
    SEL_CE(a[1], a[9]);
    SEL_CE(a[2], a[10]);
    SEL_CE(a[3], a[11]);
    SEL_CE(a[4], a[12]);
    SEL_CE(a[5], a[13]);
    SEL_CE(a[6], a[14]);
    SEL_CE(a[7], a[15]);
    SEL_CE(a[0], a[4]);
    SEL_CE(a[1], a[5]);
    SEL_CE(a[2], a[6]);
    SEL_CE(a[3], a[7]);
    SEL_CE(a[8], a[12]);
    SEL_CE(a[9], a[13]);
    SEL_CE(a[10], a[14]);
    SEL_CE(a[11], a[15]);
    SEL_CE(a[0], a[2]);
    SEL_CE(a[1], a[3]);
    SEL_CE(a[4], a[6]);
    SEL_CE(a[5], a[7]);
    SEL_CE(a[8], a[10]);
    SEL_CE(a[9], a[11]);
    SEL_CE(a[12], a[14]);
    SEL_CE(a[13], a[15]);
    SEL_CE(a[0], a[1]);
    SEL_CE(a[2], a[3]);
    SEL_CE(a[4], a[5]);
    SEL_CE(a[6], a[7]);
    SEL_CE(a[8], a[9]);
    SEL_CE(a[10], a[11]);
    SEL_CE(a[12], a[13]);
    SEL_CE(a[14], a[15]);
}
constexpr int SEL_NCAND = 50;
#define SEL_CANDS(F) \
    F(0, 0, 0) \
    F(1, 0, 1) \
    F(2, 0, 2) \
    F(3, 0, 3) \
    F(4, 0, 4) \
    F(5, 0, 5) \
    F(6, 0, 6) \
    F(7, 0, 7) \
    F(8, 0, 8) \
    F(9, 0, 9) \
    F(10, 0, 10) \
    F(11, 0, 11) \
    F(12, 0, 12) \
    F(13, 0, 13) \
    F(14, 0, 14) \
    F(15, 0, 15) \
    F(16, 1, 0) \
    F(17, 1, 1) \
    F(18, 1, 2) \
    F(19, 1, 3) \
    F(20, 1, 4) \
    F(21, 1, 5) \
    F(22, 1, 6) \
    F(23, 1, 7) \
    F(24, 2, 0) \
    F(25, 2, 1) \
    F(26, 2, 2) \
    F(27, 2, 3) \
    F(28, 2, 4) \
    F(29, 3, 0) \
    F(30, 3, 1) \
    F(31, 3, 2) \
    F(32, 3, 3) \
    F(33, 4, 0) \
    F(34, 4, 1) \
    F(35, 4, 2) \
    F(36, 5, 0) \
    F(37, 5, 1) \
    F(38, 6, 0) \
    F(39, 6, 1) \
    F(40, 7, 0) \
    F(41, 7, 1) \
    F(42, 8, 0) \
    F(43, 9, 0) \
    F(44, 10, 0) \
    F(45, 11, 0) \
    F(46, 12, 0) \
    F(47, 13, 0) \
    F(48, 14, 0) \
    F(49, 15, 0)
constexpr float SEL_BIAS = 16.f;
__device__ __forceinline__ int f2key(float f) { return __float_as_int(f); }
__device__ __forceinline__ float key2f(int k) { return __int_as_float(k); }
__device__ __forceinline__ void sel_top16(const f32x16 (&acc)[4], int hi, int (&t)[16]) {
    int g1[16], g2[16], g3[16];
#pragma unroll
    for (int r = 0; r < 16; ++r) { const int n = (r & 3) + 8 * (r >> 2) + 4 * hi;
        t[r] = (f2key(acc[0][r]) & ~0x7F) | n; g1[r] = (f2key(acc[1][r]) & ~0x7F) | (32 + n); g2[r] = (f2key(acc[2][r]) & ~0x7F) | (64 + n); g3[r] = (f2key(acc[3][r]) & ~0x7F) | (96 + n); }
    sel_sort16(t); sel_sort16(g1); sel_sort16(g2); sel_sort16(g3);
    sel_merge16(t, g1); sel_merge16(g2, g3); sel_merge16(t, g2);
#pragma unroll
    for (int i = 0; i < 16; ++i) { auto rr = __builtin_amdgcn_permlane32_swap((unsigned)t[i], (unsigned)t[i], false, false); g1[i] = (int)(hi ? rr[0] : rr[1]); }
    sel_merge16(t, g1);
}
__device__ __forceinline__ void ph_select(const bf16_t* __restrict__ QP, const bf16_t* __restrict__ KEYS, unsigned short* __restrict__ idx, float* __restrict__ gate, LAS unsigned char* lds) {
    PH_IDS
    const int lane = TIDX & 63, hd = __builtin_amdgcn_readfirstlane(TIDX >> 6), r = lane & 31, hi = lane >> 5;
    LAS unsigned* my = (LAS unsigned*)(lds + hd * 2048) + lane;
    for (int tg = BIDX; tg < T / 32; tg += GDIM) {
        const int tok0 = tg * 32;
        int rk = r; asm volatile("" : "+v"(rk));
        int t1[16], t2[16];
#pragma unroll
        for (int half = 0; half < 2; ++half) {
            f32x16 acc[4];
#pragma unroll
            for (int mt = 0; mt < 4; ++mt)
#pragma unroll
                for (int i = 0; i < 16; ++i) acc[mt][i] = SEL_BIAS;
            const bf16_t* qb = QP + (size_t)(tok0 + r) * D + hd * QD + half * HALF + 8 * hi;
            const bf16_t* kb = KEYS + ((size_t)(hd * 2 + half) * NK + rk) * HALF + 8 * hi;
#pragma unroll
            for (int ks = 0; ks < 4; ++ks) {
                const bf16x8 b = *(const bf16x8*)(qb + 16 * ks);
#pragma unroll
                for (int mt = 0; mt < 4; ++mt) { const bf16x8 a = *(const bf16x8*)(kb + (size_t)mt * 32 * HALF + 16 * ks); acc[mt] = __builtin_amdgcn_mfma_f32_32x32x16_bf16(a, b, acc[mt], 0, 0, 0); }
            }
            if (half == 0) sel_top16(acc, hi, t1); else sel_top16(acc, hi, t2);
        }
        float f1[16], f2[16];
#pragma unroll
        for (int i = 0; i < 16; ++i) { f1[i] = key2f(t1[i]); f2[i] = key2f(t2[i]); }
        int c0[16], c1[16], c2[16], c3[16];
#pragma unroll
        for (int i = 0; i < 16; ++i) c3[i] = (int)0x80000000;
#define SEL_F(k, i, j) { const int v_ = (f2key(f1[i] + f2[j]) & ~0xFF) | ((i) << 4 | (j)); if ((k) < 16) c0[(k) & 15] = v_; else if ((k) < 32) c1[(k) & 15] = v_; else if ((k) < 48) c2[(k) & 15] = v_; else c3[(k) & 15] = v_; }
        SEL_CANDS(SEL_F)
#undef SEL_F
          sel_sort16(c1); sel_sort16(c2); SEL_CE(c3[0], c3[1]);
        sel_merge16(c0, c1); sel_merge16(c2, c3); sel_merge16(c0, c2);
#pragma unroll
        for (int j = 0; j < 4; ++j) {
            my[64 * j] = (unsigned)(t1[4 * j] & 0x7F) | ((unsigned)(t1[4 * j + 1] & 0x7F) << 8) | ((unsigned)(t1[4 * j + 2] & 0x7F) << 16) | ((unsigned)(t1[4 * j + 3] & 0x7F) << 24);
            my[64 * (4 + j)] = (unsigned)(t2[4 * j] & 0x7F) | ((unsigned)(t2[4 * j + 1] & 0x7F) << 8) | ((unsigned)(t2[4 * j + 2] & 0x7F) << 16) | ((unsigned)(t2[4 * j + 3] & 0x7F) << 24);
        }
        const float mx = key2f(c0[0]); float e[16], se = 0.f;
#pragma unroll
        for (int k = 0; k < 16; ++k) { e[k] = __expf(key2f(c0[k]) - mx); se += e[k]; }
        const float inv = 1.f / se;
        asm volatile("s_waitcnt lgkmcnt(0)" ::: "memory");
        const size_t o = (size_t)(tok0 + r) * 128 + hd * TOPK;
        if (hi == 0) {
            int id[16];
#pragma unroll
            for (int k = 0; k < 16; ++k) { const int code = c0[k] & 0xFF, i = code >> 4, j = code & 15;
                const unsigned w1 = my[64 * (i >> 2)], w2 = my[64 * (4 + (j >> 2))];
                id[k] = (int)((w1 >> (8 * (i & 3))) & 0x7F) * NK + (int)((w2 >> (8 * (j & 3))) & 0x7F); }
            u32x4 w0, w1;
#pragma unroll
            for (int k = 0; k < 4; ++k) { w0[k] = (unsigned)id[2 * k] | ((unsigned)id[2 * k + 1] << 16); w1[k] = (unsigned)id[8 + 2 * k] | ((unsigned)id[9 + 2 * k] << 16); }
            *(u32x4*)(idx + o) = w0; *(u32x4*)(idx + o + 8) = w1;
        } else {
#pragma unroll
            for (int k = 0; k < 4; ++k) *(float4*)(gate + o + 4 * k) = make_float4(e[4 * k] * inv, e[4 * k + 1] * inv, e[4 * k + 2] * inv, e[4 * k + 3] * inv);
        }
        asm volatile("s_waitcnt lgkmcnt(0)" ::: "memory");
    }
}
}
#ifndef PROBE_MASK
#define PROBE_MASK 0
#endif
#define REPS(bit) (((PROBE_MASK >> (bit)) & 1) ? 2 : 1)
namespace nv {
constexpr int LDS_BYTES = 147456, MISC_OFF = 131072 + 320;
struct Params { const float* in[23]; float* out; unsigned char* ws; };

__global__ void __launch_bounds__(512, 2) k_mega(Params prm) {
    extern __shared__ __attribute__((aligned(16))) unsigned char lds_raw[];
    namespace cg = cooperative_groups;
    cg::grid_group grid = cg::this_grid();
    LAS unsigned char* lds = (LAS unsigned char*)lds_raw;
    unsigned char* smem = lds_raw;
    for (int u = threadIdx.x; u < (LDS_BYTES - 131072) / 4; u += 512) ((LAS unsigned*)(lds + 131072))[u] = 0u;
    __syncthreads();
    if (threadIdx.x == 0) {
        LAS unsigned long long* tab = (LAS unsigned long long*)(lds + TAB_OFF);
#pragma unroll
        for (int i = 0; i < 23; ++i) tab[i] = (unsigned long long)prm.in[i];
        tab[23] = (unsigned long long)prm.out; tab[24] = (unsigned long long)prm.ws;
    }
    __syncthreads();
#define ARG(i) ((const float*)ldarg(lds, (i)))
#define WSP() ((unsigned char*)ldarg(lds, 24))
    XcdBarrier bar = xcd_barrier_post((unsigned*)(WSP() + WS_CTL) + CW_BAR, (volatile LAS unsigned*)(lds + MISC_OFF) + 8);
#define GRID_BAR() do { xcd_barrier(bar); asm volatile("" ::: "memory"); } while (0)
    if (threadIdx.x == 0) { volatile LAS unsigned* M = (volatile LAS unsigned*)(lds + MISC_OFF); M[16] = bar.x; M[17] = xb_add((unsigned*)(WSP() + WS_CTL) + CW_RANK + 64 * bar.x, 1u); }
    for (int rep = 0; rep < REPS(0); ++rep) {
    p0_prologue(lds);
    { unsigned char* ws = WSP(); p0_peer_tables(ARG(20), ARG(21), ARG(17), ws + WS_PU, ws + WS_PV8); }
    { unsigned char* ws = WSP(); const float* pk = ARG(19); bf16_t* kb = (bf16_t*)(ws + WS_KEYS); for (int i = obid() * 512 + otid(); i < DEPTH * PH * 2 * NK * HALF; i += ogrid() * 512) kb[i] = f2bf(pk[i]); }
    { unsigned char* ws = WSP(); p0_ssm_a(ARG(3), ARG(4), ARG(5), ARG(6), ARG(7), (f32x2v*)(ws + WS_APOW), (f32x2v*)(ws + WS_BBAR)); }
    }
    GRID_BAR();
    if (threadIdx.x == 0) {
        volatile LAS unsigned* M = (volatile LAS unsigned*)(lds + MISC_OFF); unsigned* bw = (unsigned*)(WSP() + WS_CTL) + CW_BAR; unsigned tot = 0u, ok = 1u;
        for (unsigned j = 0; j < 16; ++j) { const unsigned cnt = xb_ld(&bw[XB_XCNT(j)]); tot += cnt; if ((j < 8) != (cnt > 0u)) ok = 0u; }
        M[18] = xb_ld(&bw[XB_XCNT(bar.x)]); M[19] = (ok && tot == gridDim.x) ? 1u : 0u;
    }
    __syncthreads();
    { unsigned char* ws = WSP(); p0_ssm_b((const f32x2v*)(ws + WS_APOW), (const f32x2v*)(ws + WS_BBAR), ARG(8), ARG(9), ARG(10), (bf16_t*)(ws + WS_KD), (bf16_t*)(ws + WS_WST), (bf16_t*)(ws + WS_WOUT)); }
    grid.sync();
#pragma nounroll
    for (int l_ = 0; l_ < DEPTH; ++l_) {
        int l = l_; asm volatile("" : "+s"(l));
        {
            unsigned char* ws = WSP(); bf16_t* hb = (bf16_t*)(ws + WS_HB); float* ss1 = (float*)(ws + WS_SSP) + (size_t)T * 32;
            for (int rep = 0; rep < REPS(1); ++rep) {
            SchedGen S; S.init_plain(hb, D * 2, (const bf16_t*)(ws + WS_BT1) + (size_t)l * 2048 * D, D * 2, T, 2048, D, ogrid(), obid());
            EpiInProj E{ss1, (bf16_t*)(ws + WS_UP), (bf16_t*)(ws + WS_Q)};
            ge::gemm_phase<EpiInProj, SchedGen>(lds, S, E, otid());
            }
            for (int rep = 0; rep < REPS(2); ++rep)
            ph_flogit(hb, (const bf16_t*)(ws + WS_WF) + (size_t)l * 16 * D, ss1, ARG(13) + l * NH, (float*)(ws + WS_LOGF));
        }
        GRID_BAR();
        {
            unsigned char* ws = WSP();
            for (int rep = 0; rep < REPS(3); ++rep) {
            SchedSsmS S; S.init(ws + WS_UP, (const bf16_t*)(ws + WS_WST) + (size_t)l * G * 128 * 256, ogrid(), obid());
            EpiSsmS E{(float*)(ws + WS_SLOC)};
            ge::gemm_phase<EpiSsmS, SchedSsmS>(lds, S, E, otid());
            }
            for (int rep = 0; rep < REPS(4); ++rep)
            ph_cum2((const float*)(ws + WS_LOGF), (float*)(ws + WS_CUM));
        }
        GRID_BAR();
        for (int rep = 0; rep < REPS(5); ++rep)
        { unsigned char* ws = WSP(); ph_ssm_prefix(lds, (const float*)(ws + WS_SLOC), (const f32x2v*)(ws + WS_APOW) + (size_t)l * G * 65 * P, (bf16_t*)(ws + WS_UP)); }
        GRID_BAR();
        {
            unsigned char* ws = WSP(); float* ssp_s = (float*)(ws + WS_SSP); float* ssp_a = ssp_s + (size_t)T * 8;
            for (int rep = 0; rep < REPS(6); ++rep)
            {
                SchedSsmC S; S.init(ws + WS_UP, (const bf16_t*)(ws + WS_WOUT) + (size_t)l * G * 1024 * 128, (const bf16_t*)(ws + WS_KD) + (size_t)l * G * KDW, ogrid(), obid());
                EpiSsmC E{(bf16_t*)(ws + WS_GEL)};
                ge::gemm_phase<EpiSsmC, SchedSsmC>(lds, S, E, otid());
            }
            for (int rep = 0; rep < REPS(7); ++rep)
            attn_body::attn_phase<8>((char*)lds_raw, (const attn_body::bf16*)(ws + WS_Q), (const attn_body::bf16*)(ws + WS_K), (const attn_body::bf16*)(ws + WS_V), (const float*)(ws + WS_CUM), (attn_body::bf16*)(ws + WS_MIX), ssp_a, (unsigned*)(ws + WS_CTL) + CW_QUEUE + 64 * (l * 2 + rep), (volatile LAS unsigned*)(lds + MISC_OFF) + 24, otid());
            GRID_BAR();
            for (int rep = 0; rep < REPS(8); ++rep) {
            SchedGen S; S.init_plain(ws + WS_GEL, 32, (const bf16_t*)(ws + WS_BT2) + (size_t)l * SSMW * SSMW, SSMW * 2, T, SSMW, SSMW, ogrid(), obid());
            S.a_c16_b = T * 32; S.a_kt_b = 4l * T * 32;
            EpiGlu2 E{(const bf16_t*)(ws + WS_GEL), ARG(12) + l * SSMW, (bf16_t*)(ws + WS_MIX), ssp_s};
            ge::gemm_phase<EpiGlu2, SchedGen>(lds, S, E, otid());
            }
        }
        GRID_BAR();
        {
            unsigned char* ws = WSP(); float* ssp_s = (float*)(ws + WS_SSP); float* ssp_a = ssp_s + (size_t)T * 8; float* ssp_2 = ssp_a + (size_t)T * 8;
            for (int rep = 0; rep < REPS(9); ++rep) {
            const bool dummy = rep + 1 < REPS(9);
            SchedGen S; S.init_plain(ws + WS_MIX, D * 2, (const bf16_t*)(ws + WS_BT3) + (size_t)l * D * D, D * 2, T, D, D, ogrid(), obid());
            EpiWo E{ssp_s, ssp_a, (const bf16_t*)(ws + WS_HB), dummy ? (bf16_t*)(ws + WS_QP) : (bf16_t*)(ws + WS_HB), dummy ? (float*)(ws + WS_SLOC) : ssp_2};
            ge::gemm_phase<EpiWo, SchedGen>(lds, S, E, otid());
            }
        }
        GRID_BAR();
        {
            unsigned char* ws = WSP(); float* ssp_2 = (float*)(ws + WS_SSP) + (size_t)T * 16;
            for (int rep = 0; rep < REPS(10); ++rep) {
            SchedGen S; S.init_plain(ws + WS_HB, D * 2, (const bf16_t*)(ws + WS_BT4) + (size_t)l * D * D, D * 2, T, D, D, ogrid(), obid());
            EpiWq E{ssp_2, (bf16_t*)(ws + WS_QP)};
            ge::gemm_phase<EpiWq, SchedGen>(lds, S, E, otid());
            }
        }
        GRID_BAR();
        for (int rep = 0; rep < REPS(11); ++rep)
        { unsigned char* ws = WSP(); ph_select((const bf16_t*)(ws + WS_QP), (const bf16_t*)(ws + WS_KEYS) + (size_t)l * PH * 2 * NK * HALF, (unsigned short*)(ws + WS_IDX), (float*)(ws + WS_GATE), lds); }
        GRID_BAR();
        if (PROBE_MASK & (1 << 16)) { unsigned char* ws = WSP(); ph_peer_u<0>(lds, ws + WS_PU + (size_t)l * NEXP * D, (const bf16_t*)(ws + WS_HB), (const unsigned short*)(ws + WS_IDX), (bf16_t*)(ws + WS_UP), 1023); }
        for (int rep = 0; rep < REPS(12); ++rep)
        { unsigned char* ws = WSP(); ph_peer_u<0>(lds, ws + WS_PU + (size_t)l * NEXP * D, (const bf16_t*)(ws + WS_HB), (const unsigned short*)(ws + WS_IDX), (bf16_t*)(ws + WS_PART)); }
        GRID_BAR();
        for (int rep = 0; rep < REPS(13); ++rep)
        { unsigned char* ws = WSP(); ph_peer_coef((const bf16_t*)(ws + WS_PART), (const float*)(ws + WS_SSP) + (size_t)T * 16, (const float*)(ws + WS_GATE), (unsigned short*)(ws + WS_COEF)); }
        GRID_BAR();
        if (PROBE_MASK & (1 << 17)) { unsigned char* ws = WSP();
          ph_peer_v<0>(lds, ws + WS_PV8 + (size_t)l * NEXP * D, (const unsigned short*)(ws + WS_IDX), (const unsigned short*)(ws + WS_COEF), (const bf16_t*)(ws + WS_HB), (bf16_t*)(ws + WS_UP), (float*)(ws + WS_SLOC), 1023); }
        for (int rep = 0; rep < REPS(14); ++rep)
        { unsigned char* ws = WSP(); const bool dummy = rep + 1 < REPS(14);
          ph_peer_v<0>(lds, ws + WS_PV8 + (size_t)l * NEXP * D, (const unsigned short*)(ws + WS_IDX), (const unsigned short*)(ws + WS_COEF), (const bf16_t*)(ws + WS_HB),
                    dummy ? (bf16_t*)(ws + WS_UP) : (bf16_t*)(ws + WS_HB), dummy ? (float*)(ws + WS_SLOC) : (float*)(ws + WS_SSP) + (size_t)T * 32); }
        if (PROBE_MASK & (1 << 15)) { for (int rep = 0; rep < 8; ++rep) GRID_BAR(); }
        GRID_BAR();
    }
    { unsigned char* ws = WSP(); ph_final((const bf16_t*)(ws + WS_HB), (const float*)(ws + WS_SSP) + (size_t)T * 32, ARG(22), (float*)ldarg(lds, 23)); }
}
}

extern "C" void kernel_launch(void* const* d_in, const int* in_sizes, int n_in, void* d_out, int out_size, void* d_ws, size_t ws_size, hipStream_t stream) {
    using namespace nv;
    static int grid_blocks = 0;
    if (!grid_blocks) {
        int dev = 0, cus = 0, per_cu = 0;
        (void)hipGetDevice(&dev);
        (void)hipDeviceGetAttribute(&cus, hipDeviceAttributeMultiprocessorCount, dev);
        if (hipFuncSetAttribute((const void*)k_mega, hipFuncAttributeMaxDynamicSharedMemorySize, LDS_BYTES) != hipSuccess) { fprintf(stderr, "hipFuncSetAttribute failed\n"); grid_blocks = -1; return; }
        (void)hipOccupancyMaxActiveBlocksPerMultiprocessor(&per_cu, (const void*)k_mega, 512, LDS_BYTES);
        if (per_cu < 1) { fprintf(stderr, "occupancy query returned %d\n", per_cu); (void)hipGetLastError(); }
        grid_blocks = cus;
    }
    if (grid_blocks < 0) return;
    if (ws_size < WS_END || n_in != 23) { fprintf(stderr, "bad workspace / inputs\n"); return; }
    (void)hipMemsetAsync((char*)d_ws + WS_CTL, 0, CTL_BYTES, stream);
    Params p{};
    for (int i = 0; i < 23; ++i) p.in[i] = (const float*)d_in[i];
    p.out = (float*)d_out; p.ws = (unsigned char*)d_ws;
    void* args[] = {&p};
    hipError_t e = hipLaunchCooperativeKernel((const void*)k_mega, dim3(grid_blocks), dim3(512), args, LDS_BYTES, stream);
    if (e != hipSuccess) fprintf(stderr, "cooperative launch failed: %s (grid %d)\n", hipGetErrorString(e), grid_blocks);
}
```

```cpp
#include <hip/hip_runtime.h>
#include <hip/hip_cooperative_groups.h>
#include <hip/hip_bf16.h>
#include <cstdint>
#include <cstdio>

#define LAS __attribute__((address_space(3)))
#define GAS __attribute__((address_space(1)))

namespace nv {
constexpr int D = 1024, BATCH = 8, SEQ = 4096, DEPTH = 4, T = BATCH * SEQ;
constexpr int SSMW = 512, G = 32, HC = 16, P = 64, ATTW = 512, HD = 64, NH = 8, INW = 2056;
constexpr int PH = 8, NK = 128, TOPK = 16, QD = 128, HALF = 64, NEXP = 16384;
constexpr int CHUNK = 64, NCH = T / CHUNK  , UPW = 128 + CHUNK * HC  ;
constexpr float EPS = 1e-6f;

typedef short bf16x8 __attribute__((ext_vector_type(8)));
typedef float f32x16 __attribute__((ext_vector_type(16)));
typedef float f32x4 __attribute__((ext_vector_type(4)));
typedef unsigned u32x4 __attribute__((ext_vector_type(4)));
typedef unsigned short bf16_t;

constexpr size_t MiB = 1u << 20;
constexpr size_t WS_CTL = 0, CTL_BYTES = 4 * MiB;
constexpr size_t WS_BT1 = 4 * MiB;
constexpr size_t WS_BT2 = 20 * MiB;
constexpr size_t WS_BT3 = 22 * MiB;
constexpr size_t WS_BT4 = 30 * MiB;
constexpr size_t WS_WF = 38 * MiB;
constexpr size_t WS_KEYS = 39 * MiB;
constexpr size_t WS_KD = 40 * MiB, WS_WOUT = 49 * MiB, WS_WST = 81 * MiB;
constexpr size_t WS_PU = 90 * MiB, WS_PV8 = 154 * MiB;
constexpr size_t WS_PART = 218 * MiB;
constexpr size_t WS_H = 346 * MiB;
constexpr size_t WS_HB = 474 * MiB;
constexpr size_t WS_UP = 538 * MiB;
constexpr size_t WS_Q = 576 * MiB, WS_K = 608 * MiB, WS_V = 640 * MiB;
constexpr size_t WS_LOGF = 672 * MiB, WS_CUM = 673 * MiB;
constexpr size_t WS_SLOC = 674 * MiB, WS_GEL = 708 * MiB, WS_MIX = 740 * MiB;
constexpr size_t WS_SSP = 916 * MiB;
constexpr size_t WS_QP = 852 * MiB;
constexpr size_t WS_IDX = 804 * MiB, WS_GATE = 820 * MiB, WS_COEF = 836 * MiB;
constexpr size_t WS_XN_F = 90 * MiB, WS_MIXED_F = 218 * MiB, WS_QP_F = 852 * MiB, WS_GEL_F = 90 * MiB  , WS_YSSM_F = 740 * MiB, WS_YATT_F = 674 * MiB;
constexpr size_t WS_END = 980 * MiB;
constexpr int CW_QUEUE = 1024;
constexpr int CW_RANK = 2048;
constexpr int CW_BAR = 4096;
constexpr int CW_SS = 65536;
constexpr int SS_H1 = 0  , SS_H2 = 5  , SS_SSM = 9, SS_ATT = 13;
static_assert((size_t)(CW_SS + 17 * T) * 4 <= CTL_BYTES, "ctl region");

__device__ __forceinline__ unsigned short f2bf(float f) { unsigned u = __float_as_uint(f); return (unsigned short)((u + 0x7fffu + ((u >> 16) & 1u)) >> 16); }
__device__ __forceinline__ float bf2f(unsigned short b) { return __uint_as_float(((unsigned)b) << 16); }
__device__ __forceinline__ unsigned pk2(float lo, float hi) { return (unsigned)f2bf(lo) | ((unsigned)f2bf(hi) << 16); }
__device__ __forceinline__ float gelu_tanh(float x) { const float u = 0.7978845608028654f * (x + 0.044715f * x * x * x); return 0.5f * x * (1.f + tanhf(u)); }
__device__ __forceinline__ float wave_sum(float v) {
#pragma unroll
    for (int o = 1; o < 64; o <<= 1) v += __shfl_xor(v, o);
    return v;
}
__device__ __forceinline__ int otid() { int t = threadIdx.x; asm volatile("" : "+v"(t)); return t; }
__device__ __forceinline__ int obid() { int t = blockIdx.x; asm volatile("" : "+s"(t)); return t; }
__device__ __forceinline__ int ogrid() { int t = gridDim.x; asm volatile("" : "+s"(t)); return t; }
#define PH_IDS const int TIDX = otid(), BIDX = obid(), GDIM = ogrid(); (void)TIDX; (void)BIDX; (void)GDIM;
__device__ __forceinline__ size_t up_index(int row, int c) { const int n = row >> 6, j = row & 63, g = c >> 4, hh = c & 15; return ((size_t)g * NCH + n) * UPW + 128 + j * HC + hh; }
}
namespace ge {
#define GE_LAS __attribute__((address_space(3)))
typedef unsigned short bf16_t;
typedef short bf16x8 __attribute__((ext_vector_type(8)));
typedef float f32x4 __attribute__((ext_vector_type(4)));
typedef unsigned u32x4 __attribute__((ext_vector_type(4)));
typedef unsigned u32x2 __attribute__((ext_vector_type(2)));
constexpr int ROWF_OFF = 131072 + 4096;
constexpr int BM = 256, BK = 64, HALF = 128, HTB = HALF * BK * 2  , STAGE_BYTES = 8 * HTB, NXCD = 8, WGM = 8;

__host__ __device__ __forceinline__ int lds_byte(int r, int c) { const int st = (r >> 4) * 2 + (c >> 5), rr = r & 15, cc = c & 31, ob = rr * 64 + cc * 2; return st * 1024 + (ob ^ (((ob >> 9) & 1) << 5)); }
__host__ __device__ __forceinline__ void stage_rc(int b, int& R, int& C) { const int st = b / 1024, sb = b % 1024, swz = sb ^ (((sb >> 9) & 1) << 5); R = (st >> 1) * 16 + swz / 64; C = (st & 1) * 32 + (swz % 64) / 2; }
__host__ __device__ __forceinline__ int perm32(int rho) { const int n = rho >> 4, i = rho & 15; return 8 * (i >> 2) + 4 * n + (i & 3); }

struct Unit { const char* A0; const char* B0; int nt; int pm, pn, aux; };
__device__ __forceinline__ unsigned cvt_pk_bf16(float lo, float hi) { unsigned r; asm volatile("v_cvt_pk_bf16_f32 %0, %1, %2" : "=v"(r) : "v"(lo), "v"(hi)); return r; }

__device__ __forceinline__ bool static_tile(int i, int G, int c, int nM, int nN, int& pm, int& pn) {
    const int nwg = nM * nN; const long L = (long)i * G + c; if (L >= nwg) return false;
    int wgid = (int)L; { const int q = nwg / NXCD, r = nwg % NXCD, xcd = wgid % NXCD, off = wgid / NXCD; wgid = (xcd < r ? xcd * (q + 1) : r * (q + 1) + (xcd - r) * q) + off; }
    const int nig = WGM * nN, gid = wgid / nig, fm = gid * WGM, gsz = (nM - fm) < WGM ? (nM - fm) : WGM;
    pm = fm + ((wgid % nig) % gsz); pn = (wgid % nig) / gsz; return true;
}

template <class Epi, class Sched>
__device__ __forceinline__ void gemm_phase(GE_LAS unsigned char* lds, const Sched& S, const Epi& E, int tid) {
    const int wid = __builtin_amdgcn_readfirstlane(tid >> 6), lane = tid & 63, wr = wid >> 2, wc = wid & 3, fr = lane & 15, fq = lane >> 4;
    unsigned voffA[2], voffB[2], voffB1[2];
#pragma unroll
    for (int i = 0; i < 2; ++i) { int R, C; stage_rc(tid * 16 + i * 8192, R, C); const int Rb = Epi::PERM ? ((R & ~31) + perm32(R & 31)) : R;
        voffA[i] = S.voffA(R, C); voffB[i] = S.voffB(Rb, C); if constexpr (Sched::DUALB) voffB1[i] = S.voffB1(Rb, C); else voffB1[i] = 0u; }
    const long hA = S.hA, hB = S.hB;
    const unsigned ldsw = (unsigned)wid * 1024u;
    const int aoff = lds_byte(wr * 64 + fr, fq * 8), boff = lds_byte(wc * 32 + fr, fq * 8);
#define GE_SA(b, h) (((b) * 2 + (h)) * HTB)
#define GE_SB(b, h) ((4 + (b) * 2 + (h)) * HTB)
#define GE_STAGE(bufoff, gbase, voff) do { _Pragma("unroll") for (int _i = 0; _i < 2; ++_i) \
        __builtin_amdgcn_global_load_lds((const unsigned*)((const char*)(gbase) + (voff)[_i]), (GE_LAS unsigned*)(lds + (bufoff) + ldsw + _i * 8192), 16, 0, 0); } while (0)
#define GE_STAGE_B(bufoff, gbase, sel, half) do { if constexpr (Sched::DUALB) { const char* _g = (const char*)(gbase) + ((half) ? ((sel) ? S.hB1 : hB) : 0l); _Pragma("unroll") for (int _i = 0; _i < 2; ++_i) { const unsigned _v = (sel) ? voffB1[_i] : voffB[_i]; \
        __builtin_amdgcn_global_load_lds((const unsigned*)(_g + _v), (GE_LAS unsigned*)(lds + (bufoff) + ldsw + _i * 8192), 16, 0, 0); } } else { GE_STAGE(bufoff, (const char*)(gbase) + ((half) ? hB : 0l), voffB); } } while (0)
#define GE_LDA(dst, b, h) do { _Pragma("unroll") for (int m = 0; m < 4; ++m) _Pragma("unroll") for (int k = 0; k < 2; ++k) dst[m][k] = *(const GE_LAS bf16x8*)(lds + GE_SA(b, h) + aoff + m * 2048 + k * 1024); } while (0)
#define GE_LDB(dst, b, h) do { _Pragma("unroll") for (int n = 0; n < 2; ++n) _Pragma("unroll") for (int k = 0; k < 2; ++k) dst[n][k] = *(const GE_LAS bf16x8*)(lds + GE_SB(b, h) + boff + n * 2048 + k * 1024); } while (0)
#define GE_MMA(ai, bj, At, Bt) do { __builtin_amdgcn_s_setprio(1); _Pragma("unroll") for (int m = 0; m < 4; ++m) _Pragma("unroll") for (int n = 0; n < 2; ++n) _Pragma("unroll") for (int k = 0; k < 2; ++k) \
        acc[ai][bj][m][n] = __builtin_amdgcn_mfma_f32_16x16x32_bf16(Bt[n][k], At[m][k], acc[ai][bj][m][n], 0, 0, 0); __builtin_amdgcn_s_setprio(0); } while (0)
#define GE_WAIT_V(n) asm volatile("s_waitcnt vmcnt(" #n ")" ::: "memory")
#define GE_WAIT_L(n) asm volatile("s_waitcnt lgkmcnt(" #n ")" ::: "memory")
#define GE_BAR __builtin_amdgcn_s_barrier()
#define GE_SCHED __builtin_amdgcn_sched_barrier(0)
    Unit cur, nxt; int ui = 0;
    if (!S.next(0, cur)) return;
    f32x4 acc[2][2][4][2];
#pragma unroll
    for (int a = 0; a < 2; ++a)
#pragma unroll
        for (int b = 0; b < 2; ++b)
#pragma unroll
            for (int m = 0; m < 4; ++m)
#pragma unroll
                for (int n = 0; n < 2; ++n) acc[a][b][m][n] = (f32x4){0.f, 0.f, 0.f, 0.f};
    bf16x8 At[4][2], B0[2][2], B1[2][2];
    if constexpr (Epi::UBEGIN) E.unit_begin(cur, tid, lds + ROWF_OFF);
    {
        const char* a0 = S.ta(cur, 0); const char* b0 = S.tb(cur, 0); const char* a1 = S.ta(cur, 1); const char* b1 = S.tb(cur, 1);
        const bool s0 = S.sb(cur, 0), s1 = S.sb(cur, 1);
        GE_STAGE_B(GE_SB(0, 0), b0, s0, 0); GE_STAGE_B(GE_SB(0, 1), b0, s0, 1); GE_STAGE(GE_SA(0, 0), a0, voffA); GE_STAGE(GE_SA(0, 1), a0 + hA, voffA);
        if (wr == 1) GE_BAR;
        GE_WAIT_V(2); GE_BAR;
        GE_STAGE_B(GE_SB(1, 0), b1, s1, 0); GE_STAGE(GE_SA(1, 0), a1, voffA); GE_STAGE_B(GE_SB(1, 1), b1, s1, 1);
        GE_WAIT_V(6); GE_BAR;
    }
    for (;;) {
        const bool has_next = S.next(ui + 1, nxt);
        const int nt = cur.nt;
        for (int t = 0; t < nt; t += 2) {
            const bool last = (t == nt - 2);
            const char* a1 = S.ta(cur, t + 1);
            const char* a2 = last ? (has_next ? S.ta(nxt, 0) : S.ta(cur, 0)) : S.ta(cur, t + 2);
            const char* b2 = last ? (has_next ? S.tb(nxt, 0) : S.tb(cur, 0)) : S.tb(cur, t + 2);
            const char* a3 = last ? (has_next ? S.ta(nxt, 1) : S.ta(cur, 1)) : S.ta(cur, t + 3);
            const char* b3 = last ? (has_next ? S.tb(nxt, 1) : S.tb(cur, 1)) : S.tb(cur, t + 3);
            const bool s2 = last ? (has_next ? S.sb(nxt, 0) : S.sb(cur, 0)) : S.sb(cur, t + 2), s3 = last ? (has_next ? S.sb(nxt, 1) : S.sb(cur, 1)) : S.sb(cur, t + 3);
            GE_LDB(B0, 0, 0); GE_LDB(B1, 0, 1); GE_SCHED; GE_LDA(At, 0, 0); GE_STAGE(GE_SA(1, 1), a1 + hA, voffA);
            GE_WAIT_V(8); GE_WAIT_L(0); GE_BAR; GE_MMA(0, 0, At, B0); GE_MMA(0, 1, At, B1); GE_BAR; GE_SCHED;
            GE_LDA(At, 0, 1); GE_STAGE_B(GE_SB(0, 0), b2, s2, 0); GE_STAGE_B(GE_SB(0, 1), b2, s2, 1); GE_STAGE(GE_SA(0, 0), a2, voffA);
            GE_WAIT_V(8); GE_WAIT_L(0); GE_BAR; GE_MMA(1, 0, At, B0); GE_MMA(1, 1, At, B1); GE_BAR; GE_SCHED;
            GE_LDB(B0, 1, 0); GE_LDB(B1, 1, 1); GE_SCHED; GE_LDA(At, 1, 0); GE_STAGE(GE_SA(0, 1), a2 + hA, voffA);
            GE_WAIT_V(8); GE_WAIT_L(0); GE_BAR; GE_MMA(0, 0, At, B0); GE_MMA(0, 1, At, B1); GE_BAR; GE_SCHED;
            GE_LDA(At, 1, 1); GE_STAGE_B(GE_SB(1, 0), b3, s3, 0); GE_STAGE_B(GE_SB(1, 1), b3, s3, 1); GE_STAGE(GE_SA(1, 0), a3, voffA);
            GE_WAIT_V(8); GE_WAIT_L(0); GE_BAR; GE_MMA(1, 0, At, B0); GE_MMA(1, 1, At, B1); GE_BAR; GE_SCHED;
            if constexpr (Epi::MIDK) { if (t + 2 == (nt >> 1)) E.midk(acc, cur, wr, fr, lds + ROWF_OFF + (ui & 1) * 2048); }
        }
        if (wr == 0) GE_BAR;
        E(acc, cur, wr, wc, fr, fq, lds + ROWF_OFF + (ui & 1) * 2048);
        if (!has_next) break;
        if constexpr (Epi::UBEGIN) E.unit_begin(nxt, tid, lds + ROWF_OFF + ((ui + 1) & 1) * 2048);
#pragma unroll
        for (int a = 0; a < 2; ++a)
#pragma unroll
            for (int b = 0; b < 2; ++b)
#pragma unroll
                for (int m = 0; m < 4; ++m)
#pragma unroll
                    for (int n = 0; n < 2; ++n) acc[a][b][m][n] = (f32x4){0.f, 0.f, 0.f, 0.f};
        cur = nxt; ++ui;
        if (wr == 1) GE_BAR;
    }
    GE_WAIT_V(0);
    GE_BAR;
#undef GE_SA
#undef GE_SB
#undef GE_STAGE
#undef GE_STAGE_B
#undef GE_LDA
#undef GE_LDB
#undef GE_MMA
#undef GE_WAIT_V
#undef GE_WAIT_L
#undef GE_BAR
#undef GE_SCHED
}
}
namespace nv {
__device__ __forceinline__ float sum8(const float* p);
__device__ __forceinline__ float sum16(const float* p);
#define XB_TMO      128
#define XB_XCNT(j)  (256  + 64 * (j))
#define XB_XSUB(j)  (1280 + 64 * (j))
#define XB_XGEN(j)  (2304 + 64 * (j))
#define XB_TOP      3328
#define XB_TOPGEN   3392
#define XCD_BAR_WORDS 3456
#define XB_SPIN_CAP (1u << 24)
__device__ __forceinline__ unsigned xb_ld(unsigned* p)              { return __hip_atomic_load(p, __ATOMIC_RELAXED, __HIP_MEMORY_SCOPE_AGENT); }
__device__ __forceinline__ unsigned xb_add(unsigned* p, unsigned v) { return __hip_atomic_fetch_add(p, v, __ATOMIC_RELAXED, __HIP_MEMORY_SCOPE_AGENT); }
__device__ __forceinline__ unsigned xb_xcc_id() { return (unsigned)__builtin_amdgcn_s_getreg((3 << 11) | 20) & 0xFu; }
#define XB_SPIN(cond, bar) do { unsigned _sp = 0; while (cond) { __builtin_amdgcn_s_sleep(1); \
    if ((++_sp & 255u) == 0u) { if (xb_ld(&(bar)[XB_TMO])) break; if (_sp > XB_SPIN_CAP) { atomicAdd(&(bar)[XB_TMO], 1u); break; } } } } while (0)
struct XcdBarrier { unsigned* bar; unsigned x; volatile LAS unsigned* st; };
__device__ __forceinline__ XcdBarrier xcd_barrier_post(unsigned* bar, volatile LAS unsigned* st) {
    XcdBarrier b; b.bar = bar; b.x = xb_xcc_id(); b.st = st;
    if (threadIdx.x == 0) (void)xb_add(&bar[XB_XCNT(b.x)], 1u);
    return b;
}
__device__ __forceinline__ void xcd_barrier_complete(unsigned* bar, unsigned x, unsigned& nloc, unsigned& nx) {
    const unsigned Gsz = gridDim.x * gridDim.y * gridDim.z;
    unsigned sum, cnt, mine, sp = 0u;
    for (;;) {
        sum = 0u; cnt = 0u; mine = 0u;
#pragma unroll
        for (unsigned j = 0; j < 16; ++j) { const unsigned c = xb_ld(&bar[XB_XCNT(j)]); sum += c; cnt += (c > 0u) ? 1u : 0u; mine = (j == x) ? c : mine; }
        if (sum == Gsz) break;
        __builtin_amdgcn_s_sleep(1);
        if ((++sp & 255u) == 0u) { if (xb_ld(&bar[XB_TMO])) break; if (sp > XB_SPIN_CAP) { atomicAdd(&bar[XB_TMO], 1u); break; } }
    }
    nloc = mine > 0u ? mine : 1u; nx = cnt > 0u ? cnt : 1u;
}
__device__ __forceinline__ void xcd_barrier(const XcdBarrier& b) {
    asm volatile("s_waitcnt vmcnt(0)" ::: "memory");
    __syncthreads();
    if (threadIdx.x == 0) {
        unsigned* bar = b.bar;
        __builtin_amdgcn_s_waitcnt(0);
        unsigned nloc = b.st[0], nx = b.st[1];
        if (nloc == 0u) { xcd_barrier_complete(bar, b.x, nloc, nx); b.st[0] = nloc; b.st[1] = nx; }
        const unsigned old = xb_add(&bar[XB_XSUB(b.x)], 1u);
        const unsigned gen = old / nloc;
        if (old + 1u == (gen + 1u) * nloc) {
            __builtin_amdgcn_fence(__ATOMIC_RELEASE, "agent");
            asm volatile("s_waitcnt vmcnt(0)" ::: "memory");
            const unsigned og = xb_add(&bar[XB_TOP], 1u);
            const unsigned tg = og / nx;
            if (og + 1u == (tg + 1u) * nx) xb_add(&bar[XB_TOPGEN], 1u);
            else XB_SPIN(xb_ld(&bar[XB_TOPGEN]) == tg, bar);
            __builtin_amdgcn_fence(__ATOMIC_ACQUIRE, "agent");
            xb_add(&bar[XB_XGEN(b.x)], 1u);
            asm volatile("s_waitcnt vmcnt(0)" ::: "memory");
        } else {
            XB_SPIN(xb_ld(&bar[XB_XGEN(b.x)]) == gen, bar);
            __builtin_amdgcn_fence(__ATOMIC_ACQUIRE, "agent");
            asm volatile("s_waitcnt vmcnt(0)" ::: "memory");
        }
    }
    __syncthreads();
}

#define LDS_WAIT() asm volatile("s_waitcnt lgkmcnt(0)" ::: "memory")
template <class Sc>
__device__ __forceinline__ void p0_transpose_item(const float* __restrict__ W, int ldw, int K, int Ncols, Sc sc, bf16_t* __restrict__ WT, LAS float* scr, int item, int lane) {
    const int nblk = Ncols / 32, kb = item / nblk, nb = item % nblk, k0 = 64 * kb, n0 = 32 * nb;
#pragma unroll 8
    for (int i = 0; i < 32; ++i) { const int kk = 2 * i + (lane >> 5); scr[kk * 33 + (lane & 31)] = W[(size_t)(k0 + kk) * ldw + n0 + (lane & 31)] * sc(k0 + kk); }
    LDS_WAIT(); asm volatile("" ::: "memory");
    const int c = lane & 7;
#pragma unroll
    for (int j = 0; j < 4; ++j) { const int n = (lane >> 3) + 8 * j; const LAS float* s = scr + (8 * c) * 33 + n;
        u32x4 o; o.x = pk2(s[0 * 33], s[1 * 33]); o.y = pk2(s[2 * 33], s[3 * 33]); o.z = pk2(s[4 * 33], s[5 * 33]); o.w = pk2(s[6 * 33], s[7 * 33]);
        *(u32x4*)(WT + (size_t)(n0 + n) * K + k0 + 8 * c) = o; }
    LDS_WAIT(); asm volatile("" ::: "memory");
}
struct ScVec { const float* g; __device__ __forceinline__ float operator()(int k) const { return g[k]; } };
struct ScOne { __device__ __forceinline__ float operator()(int) const { return 1.f; } };
struct ScTwo { const float* g0; const float* g1; __device__ __forceinline__ float operator()(int k) const { return k < 512 ? g0[k] : g1[k - 512]; } };

constexpr int TAB_OFF = 131072 + 1024;
__device__ __forceinline__ void* ldarg(LAS unsigned char* lds, int i) {
    unsigned off = TAB_OFF + 8 * i; asm volatile("" : "+s"(off));
    const unsigned long long v = *(volatile LAS unsigned long long*)(lds + off);
    const unsigned lo = __builtin_amdgcn_readfirstlane((unsigned)v), hi = __builtin_amdgcn_readfirstlane((unsigned)(v >> 32));
    return (void*)(GAS void*)(((unsigned long long)hi << 32) | lo);
}

__device__ __forceinline__ void p0_prologue(LAS unsigned char* lds) {
    PH_IDS
    const int lane = TIDX & 63, wave = __builtin_amdgcn_readfirstlane(TIDX >> 6), gw = BIDX * 8 + wave, ngw = GDIM * 8;
    LAS float* scr = (LAS float*)(lds + wave * 16384);
    unsigned char* ws = (unsigned char*)ldarg(lds, 24);
    const float* a0 = (const float*)ldarg(lds, 0); const float* a1 = (const float*)ldarg(lds, 1); const float* a2 = (const float*)ldarg(lds, 2); const float* a11 = (const float*)ldarg(lds, 11);
    const float* a14 = (const float*)ldarg(lds, 14); const float* a15 = (const float*)ldarg(lds, 15); const float* a16 = (const float*)ldarg(lds, 16); const float* a17 = (const float*)ldarg(lds, 17); const float* a18 = (const float*)ldarg(lds, 18);
    constexpr int I1 = (D / 64) * (2048 / 32), I2 = (SSMW / 64) * (SSMW / 32), I3 = (D / 64) * (D / 32), I4 = I3, IL = I1 + I2 + I3 + I4;
    for (int it = gw; it < DEPTH * IL; it += ngw) {
        const int l = it / IL; int r = it % IL;
        if (r < I1) { p0_transpose_item(a2 + (size_t)l * D * INW, INW, D, 2048, ScVec{a1 + l * D}, (bf16_t*)(ws + WS_BT1) + (size_t)l * 2048 * D, scr, r, lane); continue; } r -= I1;
        if (r < I2) { p0_transpose_item(a11 + (size_t)l * SSMW * SSMW, SSMW, SSMW, SSMW, ScOne{}, (bf16_t*)(ws + WS_BT2) + (size_t)l * SSMW * SSMW, scr, r, lane); continue; } r -= I2;
        if (r < I3) { p0_transpose_item(a16 + (size_t)l * D * D, D, D, D, ScTwo{a14 + l * SSMW, a15 + l * ATTW}, (bf16_t*)(ws + WS_BT3) + (size_t)l * D * D, scr, r, lane); continue; } r -= I3;
        p0_transpose_item(a18 + (size_t)l * D * D, D, D, D, ScVec{a17 + l * D}, (bf16_t*)(ws + WS_BT4) + (size_t)l * D * D, scr, r, lane);
    }
    for (int i = BIDX * 512 + TIDX; i < DEPTH * 16 * D; i += GDIM * 512) {
        const int l = i / (16 * D), j = (i / D) % 16, k = i % D;
        const float v = j < 8 ? a2[((size_t)l * D + k) * INW + 2048 + j] * a1[l * D + k] : 0.f;
        ((bf16_t*)(ws + WS_WF))[i] = f2bf(v);
    }
    {
        const float* x = a0; bf16_t* hb = (bf16_t*)(ws + WS_HB); float* ssp1 = (float*)(ws + WS_SSP) + (size_t)T * 32;
        for (int w = gw; w < T; w += ngw) {
            const f32x4* r = (const f32x4*)(x + (size_t)w * D) + lane; unsigned long long* o = (unsigned long long*)(hb + (size_t)w * D) + lane;
            float s = 0.f;
#pragma unroll
            for (int j = 0; j < 4; ++j) { const f32x4 v = r[64 * j]; const unsigned w0 = pk2(v.x, v.y), w1 = pk2(v.z, v.w); o[64 * j] = (unsigned long long)w0 | ((unsigned long long)w1 << 32);
                const float a = __uint_as_float(w0 << 16), b = __uint_as_float(w0 & 0xffff0000u), c = __uint_as_float(w1 << 16), d = __uint_as_float(w1 & 0xffff0000u); s += (a * a + b * b) + (c * c + d * d); }
            s = wave_sum(s);
            if (lane < 8) ssp1[(size_t)w * 8 + lane] = lane == 0 ? s : 0.f;
        }
    }
}

struct SchedGen {
    static constexpr bool DUALB = false; long hB1;
    __device__ __forceinline__ bool sb(const ge::Unit&, int) const { return false; }
    __device__ __forceinline__ unsigned voffB1(int, int) const { return 0u; }
    const char* A; const char* B; int a_row_b, a_c16_b, b_row_b, b_c16_b; long a_pm_b, a_kt_b, b_pn_b, b_kt_b; int nM, nN, nt, G, c; long hA, hB;
    __device__ __forceinline__ void init_plain(const void* A_, int lda_bytes, const void* B_, int ldb_bytes, int M, int N, int K, int G_, int c_) {
        A = (const char*)A_; B = (const char*)B_; a_row_b = lda_bytes; a_c16_b = 32; b_row_b = ldb_bytes; b_c16_b = 32; a_pm_b = 256l * lda_bytes; a_kt_b = 128; b_pn_b = 256l * ldb_bytes; b_kt_b = 128;
        nM = M / 256; nN = N / 256; nt = K / 64; G = G_; c = c_; hA = 128l * lda_bytes; hB = 128l * ldb_bytes; }
    __device__ __forceinline__ bool next(int i, ge::Unit& u) const {
        int pm, pn; if (!ge::static_tile(i, G, c, nM, nN, pm, pn)) return false;
        u.A0 = A + (size_t)pm * a_pm_b; u.B0 = B + (size_t)pn * b_pn_b; u.nt = nt; u.pm = pm; u.pn = pn; u.aux = 0; return true; }
    __device__ __forceinline__ const char* ta(const ge::Unit& u, int t) const { return u.A0 + t * a_kt_b; }
    __device__ __forceinline__ const char* tb(const ge::Unit& u, int t) const { return u.B0 + t * b_kt_b; }
    __device__ __forceinline__ unsigned voffA(int R, int C) const { return (unsigned)(R * a_row_b + (C >> 4) * a_c16_b + (C & 15) * 2); }
    __device__ __forceinline__ unsigned voffB(int Rb, int C) const { return (unsigned)(Rb * b_row_b + (C >> 4) * b_c16_b + (C & 15) * 2); }
};
typedef SchedGen SchedPlain;

constexpr float QSCALE = 0.125f * 1.4426950408889634f;
struct EpiInProj {
    static constexpr bool PERM = true, MIDK = false, UBEGIN = true;
    const float* ssp1; bf16_t* UP; bf16_t* QKV;
    __device__ __forceinline__ void unit_begin(const ge::Unit& u, int tid, LAS unsigned char* rowf) const {
        if (tid < 256) { const int row = u.pm * 256 + tid; ((LAS float*)rowf)[tid] = rsqrtf(sum8(ssp1 + (size_t)row * 8) * (1.f / D) + EPS); }
    }
    __device__ __forceinline__ void midk(ge::f32x4 (&)[2][2][4][2], const ge::Unit&, int, int, LAS unsigned char*) const {}
    __device__ __forceinline__ void operator()(const ge::f32x4 (&acc)[2][2][4][2], const ge::Unit& u, int wr, int wc, int fr, int fq, LAS unsigned char* rowf) const {
        const int row0 = u.pm * 256 + wr * 64 + fr, colt = u.pn * 256, region = colt >> 9;
        bf16_t* dstb = QKV + (size_t)(region - 1) * ((WS_K - WS_Q) / 2);
#pragma unroll
        for (int ai = 0; ai < 2; ++ai)
#pragma unroll
            for (int m = 0; m < 4; ++m) {
                const int row = row0 + ai * 128 + m * 16; const float rs = ((const LAS float*)rowf)[ai * 128 + wr * 64 + m * 16 + fr];
#pragma unroll
                for (int bj = 0; bj < 2; ++bj) {
                    const int c = (colt & 511) + bj * 128 + wc * 32 + 8 * fq;
                    const float rq = region == 1 ? rs * QSCALE : rs;
                    const ge::f32x4 v0 = acc[ai][bj][m][0] * rq, v1 = acc[ai][bj][m][1] * rq;
                    u32x4 w; w.x = ge::cvt_pk_bf16(v0[0], v0[1]); w.y = ge::cvt_pk_bf16(v0[2], v0[3]); w.z = ge::cvt_pk_bf16(v1[0], v1[1]); w.w = ge::cvt_pk_bf16(v1[2], v1[3]);
                    bf16_t* dst = region == 0 ? UP + up_index(row, c) : dstb + (size_t)row * 512 + c;
                    *(u32x4*)dst = w;
                }
            }
    }
};

__device__ __forceinline__ float sum8(const float* p) { const ge::f32x4 a = *(const ge::f32x4*)p, b = *(const ge::f32x4*)(p + 4); return ((a[0] + a[1]) + (a[2] + a[3])) + ((b[0] + b[1]) + (b[2] + b[3])); }
__device__ __forceinline__ float sum16(const float* p) { return sum8(p) + sum8(p + 8); }
__device__ __forceinline__ size_t gel_index(int row, int c) { return ((size_t)(c >> 4) * T + row) * HC + (c & 15); }
__device__ __forceinline__ float sigmoidf_(float x) { return 1.f / (1.f + __expf(-x)); }
struct EpiGlu2 {
    static constexpr bool PERM = true, MIDK = false, UBEGIN = false;
    const bf16_t* GEL; const float* bias; bf16_t* MIX; float* ssp;
    __device__ __forceinline__ void unit_begin(const ge::Unit&, int, LAS unsigned char*) const {}
    __device__ __forceinline__ void midk(ge::f32x4 (&)[2][2][4][2], const ge::Unit&, int, int, LAS unsigned char*) const {}
    __device__ __forceinline__ void operator()(const ge::f32x4 (&acc)[2][2][4][2], const ge::Unit& u, int wr, int wc, int fr, int fq, LAS unsigned char*) const {
        const int row0 = u.pm * 256 + wr * 64 + fr, colt = u.pn * 256;
#pragma unroll
        for (int ai = 0; ai < 2; ++ai)
#pragma unroll
            for (int m = 0; m < 4; ++m) {
                const int row = row0 + ai * 128 + m * 16; float sq = 0.f;
#pragma unroll
                for (int bj = 0; bj < 2; ++bj) {
                    const int c = colt + bj * 128 + wc * 32 + 8 * fq;
                    const ge::f32x4 b0 = *(const ge::f32x4*)(bias + c), b1 = *(const ge::f32x4*)(bias + c + 4);
                    const u32x4 gw = *(const u32x4*)(GEL + gel_index(row, c));
                    const ge::f32x4 v0 = acc[ai][bj][m][0] + b0, v1 = acc[ai][bj][m][1] + b1;
                    float o[8];
                    o[0] = __uint_as_float(gw.x << 16) * sigmoidf_(v0[0]); o[1] = __uint_as_float(gw.x & 0xffff0000u) * sigmoidf_(v0[1]);
                    o[2] = __uint_as_float(gw.y << 16) * sigmoidf_(v0[2]); o[3] = __uint_as_float(gw.y & 0xffff0000u) * sigmoidf_(v0[3]);
                    o[4] = __uint_as_float(gw.z << 16) * sigmoidf_(v1[0]); o[5] = __uint_as_float(gw.z & 0xffff0000u) * sigmoidf_(v1[1]);
                    o[6] = __uint_as_float(gw.w << 16) * sigmoidf_(v1[2]); o[7] = __uint_as_float(gw.w & 0xffff0000u) * sigmoidf_(v1[3]);
#pragma unroll
                    for (int e = 0; e < 8; ++e) sq += o[e] * o[e];
                    u32x4 w; w.x = ge::cvt_pk_bf16(o[0], o[1]); w.y = ge::cvt_pk_bf16(o[2], o[3]); w.z = ge::cvt_pk_bf16(o[4], o[5]); w.w = ge::cvt_pk_bf16(o[6], o[7]);
                    *(u32x4*)(MIX + (size_t)row * D + c) = w;
                }
                sq += __shfl_xor(sq, 16); sq += __shfl_xor(sq, 32);
                if (fq == 0) ssp[(size_t)row * 8 + u.pn * 4 + wc] = sq;
            }
    }
};
struct EpiWo {
    static constexpr bool PERM = true, MIDK = true, UBEGIN = true;
    const float* ssp_s; const float* ssp_a; const bf16_t* hin; bf16_t* hb; float* ssp2;
    typedef float f32x2_ __attribute__((ext_vector_type(2)));
    __device__ __forceinline__ void unit_begin(const ge::Unit& u, int tid, LAS unsigned char* rowf) const {
        if (tid < 256) { const int row = u.pm * 256 + tid;
            const float rs_s = rsqrtf(sum8(ssp_s + (size_t)row * 8) * (1.f / SSMW) + EPS), rs_a = rsqrtf(sum8(ssp_a + (size_t)row * 8) * (1.f / ATTW) + EPS);
            ((LAS f32x2_*)rowf)[tid] = (f32x2_){rs_s / rs_a, rs_a}; }
    }
    __device__ __forceinline__ void midk(ge::f32x4 (&acc)[2][2][4][2], const ge::Unit& u, int wr, int fr, LAS unsigned char* rowf) const {
#pragma unroll
        for (int ai = 0; ai < 2; ++ai)
#pragma unroll
            for (int m = 0; m < 4; ++m) {
                const float f = ((const LAS f32x2_*)rowf)[ai * 128 + wr * 64 + m * 16 + fr].x;
#pragma unroll
                for (int bj = 0; bj < 2; ++bj)
#pragma unroll
                    for (int n = 0; n < 2; ++n) acc[ai][bj][m][n] = acc[ai][bj][m][n] * f;
            }
    }
    __device__ __forceinline__ void operator()(const ge::f32x4 (&acc)[2][2][4][2], const ge::Unit& u, int wr, int wc, int fr, int fq, LAS unsigned char* rowf) const {
        const int row0 = u.pm * 256 + wr * 64 + fr, colt = u.pn * 256;
#pragma unroll
        for (int ai = 0; ai < 2; ++ai)
#pragma unroll
            for (int m = 0; m < 4; ++m) {
                const int row = row0 + ai * 128 + m * 16; const float ra = ((const LAS f32x2_*)rowf)[ai * 128 + wr * 64 + m * 16 + fr].y; float sq = 0.f;
#pragma unroll
                for (int bj = 0; bj < 2; ++bj) {
                    const int c = colt + bj * 128 + wc * 32 + 8 * fq;
                    const size_t o = (size_t)row * D + c;
                    const u32x4 hw = *(const u32x4*)(hin + o);
                    const ge::f32x4 a0 = acc[ai][bj][m][0] * ra, a1 = acc[ai][bj][m][1] * ra;
                    u32x4 w; w.x = ge::cvt_pk_bf16(__uint_as_float(hw.x << 16) + a0[0], __uint_as_float(hw.x & 0xffff0000u) + a0[1]); w.y = ge::cvt_pk_bf16(__uint_as_float(hw.y << 16) + a0[2], __uint_as_float(hw.y & 0xffff0000u) + a0[3]);
                    w.z = ge::cvt_pk_bf16(__uint_as_float(hw.z << 16) + a1[0], __uint_as_float(hw.z & 0xffff0000u) + a1[1]); w.w = ge::cvt_pk_bf16(__uint_as_float(hw.w << 16) + a1[2], __uint_as_float(hw.w & 0xffff0000u) + a1[3]);
                    *(u32x4*)(hb + o) = w;
#pragma unroll
                    for (int e = 0; e < 4; ++e) { const float lo = __uint_as_float(w[e] << 16), hi = __uint_as_float(w[e] & 0xffff0000u); sq += lo * lo + hi * hi; }
                }
                sq += __shfl_xor(sq, 16); sq += __shfl_xor(sq, 32);
                if (fq == 0) ssp2[(size_t)row * 16 + u.pn * 4 + wc] = sq;
            }
    }
};
struct EpiWq {
    static constexpr bool PERM = true, MIDK = false, UBEGIN = true;
    const float* ssp2; bf16_t* QP;
    __device__ __forceinline__ void unit_begin(const ge::Unit& u, int tid, LAS unsigned char* rowf) const {
        if (tid < 256) { const int row = u.pm * 256 + tid; ((LAS float*)rowf)[tid] = rsqrtf(sum16(ssp2 + (size_t)row * 16) * (1.f / D) + EPS); }
    }
    __device__ __forceinline__ void midk(ge::f32x4 (&)[2][2][4][2], const ge::Unit&, int, int, LAS unsigned char*) const {}
    __device__ __forceinline__ void operator()(const ge::f32x4 (&acc)[2][2][4][2], const ge::Unit& u, int wr, int wc, int fr, int fq, LAS unsigned char* rowf) const {
        const int row0 = u.pm * 256 + wr * 64 + fr, colt = u.pn * 256;
#pragma unroll
        for (int ai = 0; ai < 2; ++ai)
#pragma unroll
            for (int m = 0; m < 4; ++m) {
                const int row = row0 + ai * 128 + m * 16; const float rs = ((const LAS float*)rowf)[ai * 128 + wr * 64 + m * 16 + fr];
#pragma unroll
                for (int bj = 0; bj < 2; ++bj) {
                    const int c = colt + bj * 128 + wc * 32 + 8 * fq;
                    const ge::f32x4 v0 = acc[ai][bj][m][0] * rs, v1 = acc[ai][bj][m][1] * rs;
                    u32x4 w; w.x = ge::cvt_pk_bf16(v0[0], v0[1]); w.y = ge::cvt_pk_bf16(v0[2], v0[3]); w.z = ge::cvt_pk_bf16(v1[0], v1[1]); w.w = ge::cvt_pk_bf16(v1[2], v1[3]);
                    *(u32x4*)(QP + (size_t)row * D + c) = w;
                }
            }
    }
};

__device__ __forceinline__ void ph_flogit(const bf16_t* __restrict__ hb, const bf16_t* __restrict__ wf, const float* __restrict__ ss, const float* __restrict__ bfv, float* __restrict__ logf) {
    PH_IDS
    const int lane = TIDX & 63, gw = BIDX * 8 + __builtin_amdgcn_readfirstlane(TIDX >> 6), ngw = GDIM * 8, r16 = lane & 15, q4 = lane >> 4;
    for (int item = gw; item < T / 16; item += ngw) {
        const int tok0 = item * 16;
        ge::f32x4 acc = {0.f, 0.f, 0.f, 0.f};
        const bf16_t* ar = hb + (size_t)(tok0 + r16) * D + q4 * 8; const bf16_t* br = wf + (size_t)r16 * D + q4 * 8;
#pragma unroll 8
        for (int ks = 0; ks < D / 32; ++ks) {
            const bf16x8 a = *(const bf16x8*)(ar + ks * 32), b = *(const bf16x8*)(br + ks * 32);
            acc = __builtin_amdgcn_mfma_f32_16x16x32_bf16(a, b, acc, 0, 0, 0);
        }
        if (r16 < NH) {
            const float bj = bfv[r16];
#pragma unroll
            for (int r = 0; r < 4; ++r) {
                const int tok = tok0 + 4 * q4 + r; const float x = acc[r] * rsqrtf(sum8(ss + (size_t)tok * 8) * (1.f / D) + EPS) + bj;
                logf[(size_t)tok * NH + r16] = fminf(x, 0.f) - log1pf(expf(-fabsf(x)));
            }
        }
    }
}
}
namespace nv {
__device__ __forceinline__ float gelu_fast(float x);
constexpr float USCALE = 256.f, VSCALE = 16.f;
typedef float f32x2 __attribute__((ext_vector_type(2)));
typedef int i32x2 __attribute__((ext_vector_type(2)));
__device__ __forceinline__ float clamp448(float x) { return fminf(fmaxf(x, -448.f), 448.f); }
__device__ __forceinline__ unsigned pack4_fp8(float a, float b, float c, float d) {
    int w = 0; w = __builtin_amdgcn_cvt_pk_fp8_f32(clamp448(a), clamp448(b), w, false); w = __builtin_amdgcn_cvt_pk_fp8_f32(clamp448(c), clamp448(d), w, true); return (unsigned)w; }

__device__ __forceinline__ void peer_split(LAS unsigned char* lds, int bid, int grid, int wave, int& slice, int& gw, int& ngw) {
    volatile LAS unsigned* M = (volatile LAS unsigned*)(lds + 131072 + 320);
    const unsigned x = __builtin_amdgcn_readfirstlane(M[16]), rk = __builtin_amdgcn_readfirstlane(M[17]), nl = __builtin_amdgcn_readfirstlane(M[18]), ok = __builtin_amdgcn_readfirstlane(M[19]);
    if (ok) { slice = (int)x; gw = (int)rk * 8 + wave; ngw = (int)nl * 8; }
    else { slice = bid & 7; gw = (bid >> 3) * 8 + wave; ngw = (grid >> 3) * 8; }
}
__device__ __forceinline__ void p0_peer_tables(const float* __restrict__ pu, const float* __restrict__ pv, const float* __restrict__ g2, unsigned char* __restrict__ PU8, unsigned char* __restrict__ PV8) {
    PH_IDS
    const size_t n16 = (size_t)DEPTH * NEXP * D / 16;
    for (size_t i = (size_t)BIDX * 512 + TIDX; i < 2 * n16; i += (size_t)GDIM * 512) {
        const bool isv = i >= n16; const size_t j = isv ? i - n16 : i; const size_t e0 = j * 16;
        const float* src = (isv ? pv : pu) + e0;
        const int l = (int)(e0 / ((size_t)NEXP * D)), c = (int)(e0 % D);
        f32x4 x[4];
#pragma unroll
        for (int k = 0; k < 4; ++k) x[k] = *(const f32x4*)(src + 4 * k);
        u32x4 o;
        if (isv) {
#pragma unroll
            for (int k = 0; k < 4; ++k) o[k] = pack4_fp8(x[k].x * VSCALE, x[k].y * VSCALE, x[k].z * VSCALE, x[k].w * VSCALE);
        } else {
#pragma unroll
            for (int k = 0; k < 4; ++k) { const f32x4 g = *(const f32x4*)(g2 + l * D + c + 4 * k) * USCALE; o[k] = pack4_fp8(x[k].x * g.x, x[k].y * g.y, x[k].z * g.z, x[k].w * g.w); }
        }
        const size_t er = (e0 / D) % NEXP;
        *(u32x4*)((isv ? PV8 : PU8) + (((size_t)l * 8 + (c >> 7)) * NEXP + er) * 128 + (c & 127)) = o;
    }
}

constexpr int PB = 16;
#define DPPF(x, CTRL) __int_as_float(__builtin_amdgcn_update_dpp(0, __float_as_int(x), (CTRL), 0xF, 0xF, true))
template <int MODE = 0>
__device__ __forceinline__ void ph_peer_u(LAS unsigned char* lds, const unsigned char* __restrict__ PU8, const bf16_t* __restrict__ hb, const unsigned short* __restrict__ idx, bf16_t* __restrict__ partial, int imask = 0x7fffffff) {
    PH_IDS
    const int lane = TIDX & 63, wave = __builtin_amdgcn_readfirstlane(TIDX >> 6), c8 = lane & 7, rg = lane >> 3;
    int slice, gw, ngw; peer_split(lds, BIDX, GDIM, wave, slice, gw, ngw);
    const unsigned char* tab = PU8 + (size_t)slice * NEXP * 128; const unsigned lo16 = 16u * c8;
    LAS int* li = (LAS int*)(lds + wave * 12288);
    LAS u32x4* lh = (LAS u32x4*)(lds + wave * 12288 + 8192);
    LAS float* tr = (LAS float*)(lds + 8 * 12288 + wave * 512);
    const int ntok = gw < T ? (T - gw + ngw - 1) / ngw : 0;
    const int p0 = 2 * lane, sd0 = (p0 >> 6) * 64 + (p0 & 7) * 8 + ((p0 & 63) >> 3), sd1 = sd0 + 8;
    const bool b2 = (c8 & 4) != 0, b1 = (c8 & 2) != 0, b0 = (c8 & 1) != 0;
    const int i0 = 8 * (int)b2 + 4 * (int)b0 + 2 * (int)b1;
    for (int tb = 0; tb < ntok; tb += PB) {
        const int nb = min(PB, ntok - tb);
        for (int k = 0; k < nb; ++k) {
            const size_t t = (size_t)gw + (size_t)(tb + k) * ngw;
            const unsigned iw = *(const unsigned*)(idx + t * 128 + 2 * lane); i32x2 v = {(int)(iw & 0xffffu) & imask, (int)(iw >> 16) & imask}; li[k * 128 + sd0] = v.x; li[k * 128 + sd1] = v.y;
            if (lane < 16) lh[k * 16 + lane] = *(const u32x4*)(hb + t * D + 128 * slice + 8 * lane);
        }
        asm volatile("s_waitcnt vmcnt(0) lgkmcnt(0)" ::: "memory");
        const int nstep = 4 * nb;
#define PU_ISSUE(s, B) do { const ge::u32x4 ia_ = *(const LAS ge::u32x4*)(li + ((s) >> 1) * 64 + rg * 8 + 4 * ((s) & 1)); \
            if (MODE == 3) { const ge::u32x4 ib_ = *(const LAS ge::u32x4*)(li + ((s) >> 1) * 64 + c8 * 8 + 4 * ((s) & 1)); \
                _Pragma("unroll") for (int i_ = 0; i_ < 4; ++i_) rb[B][i_] = *(const u32x4*)(tab + ((ib_[i_] ^ (unsigned)(rg & 1)) * 128u + 16u * (unsigned)(lane >> 4) + 64u * (i_ & 1))); } else \
            if (MODE == 5) { _Pragma("unroll") for (int i_ = 0; i_ < 4; ++i_) rb[B][i_] = __builtin_nontemporal_load((const u32x4*)(tab + (ia_[i_] * 128u + lo16))); } else \
            _Pragma("unroll") for (int i_ = 0; i_ < 4; ++i_) rb[B][i_] = *(const u32x4*)(tab + (ia_[i_] * 128u + lo16)); } while (0)
#define PU_STEP(s, B, QT, ISS) do { if ((ISS) != 2 || (s) < nstep) { if ((ISS) == 1 || ((ISS) == 2 && (s) + 7 < nstep)) PU_ISSUE((s) + 7, ((B) + 7) & 7); \
            const int k_ = (s) >> 2; const size_t t_ = (size_t)gw + (size_t)(tb + k_) * ngw; \
            if (QT == 0) { const u32x4 w0 = lh[k_ * 16 + 2 * c8], w1 = lh[k_ * 16 + 2 * c8 + 1];          \
                _Pragma("unroll") for (int j = 0; j < 4; ++j) { hx[j] = (f32x2){__uint_as_float(w0[j] << 16), __uint_as_float(w0[j] & 0xffff0000u)}; hx[4 + j] = (f32x2){__uint_as_float(w1[j] << 16), __uint_as_float(w1[j] & 0xffff0000u)}; } } \
            if (MODE == 6) { _Pragma("unroll") for (int i = 0; i < 4; ++i) { f32x2 dd = {0.f, 0.f}; _Pragma("unroll") for (int k = 0; k < 4; ++k) {        \
                const f32x2 q0 = __builtin_amdgcn_cvt_pk_f32_fp8((int)rb[B][i][k], false), q1 = __builtin_amdgcn_cvt_pk_f32_fp8((int)rb[B][i][k], true); \
                dd.x = __uint_as_float(__float_as_uint(dd.x) ^ __float_as_uint(q0.x) ^ __float_as_uint(q1.x)); dd.y = __uint_as_float(__float_as_uint(dd.y) ^ __float_as_uint(q0.y) ^ __float_as_uint(q1.y)); } pv[4 * QT + i] = __uint_as_float((__float_as_uint(dd.x) ^ __float_as_uint(dd.y)) & 0x3fffffffu); } } else \
            if (MODE == 7) { _Pragma("unroll") for (int i = 0; i < 4; ++i) { f32x2 dd = {0.f, 0.f}; _Pragma("unroll") for (int k = 0; k < 4; ++k) {        \
                const unsigned w_ = rb[B][i][k]; const f32x2 q0 = {__uint_as_float((w_ & 0x007fffffu) | 0x3f800000u), __uint_as_float(((w_ >> 3) & 0x007fffffu) | 0x3f800000u)}; \
                dd = __builtin_elementwise_fma(q0, hx[2 * k], dd); dd = __builtin_elementwise_fma(q0, hx[2 * k + 1], dd); } pv[4 * QT + i] = dd.x + dd.y; } } else \
            if (MODE >= 2) { _Pragma("unroll") for (int i = 0; i < 4; ++i) { const u32x4 a_ = rb[B][i]; pv[4 * QT + i] = __uint_as_float((a_.x ^ a_.y ^ a_.z ^ a_.w) & 0x3fffffffu); } } else \
            _Pragma("unroll") for (int i = 0; i < 4; ++i) { f32x2 dd = {0.f, 0.f}; _Pragma("unroll") for (int k = 0; k < 4; ++k) {        \
                const f32x2 q0 = __builtin_amdgcn_cvt_pk_f32_fp8((int)rb[B][i][k], false), q1 = __builtin_amdgcn_cvt_pk_f32_fp8((int)rb[B][i][k], true); \
                dd = __builtin_elementwise_fma(q0, hx[2 * k], dd); dd = __builtin_elementwise_fma(q1, hx[2 * k + 1], dd); } pv[4 * QT + i] = dd.x + dd.y; } \
            if (QT == 3) { float y[8], z[4]; \
                _Pragma("unroll") for (int j = 0; j < 8; ++j) { const float keep = b2 ? pv[8 + j] : pv[j], send = b2 ? pv[j] : pv[8 + j]; y[j] = keep + DPPF(send, 0x141); }       \
                _Pragma("unroll") for (int j = 0; j < 4; ++j) { const float keep = b0 ? y[4 + j] : y[j], send = b0 ? y[j] : y[4 + j]; z[j] = keep + DPPF(send, 0xB1); }          \
                const float o0 = (b1 ? z[2] : z[0]) + DPPF(b1 ? z[0] : z[2], 0x4E), o1 = (b1 ? z[3] : z[1]) + DPPF(b1 ? z[1] : z[3], 0x4E);                                    \
                  \
                tr[8 * i0 + rg] = o0; tr[8 * i0 + 8 + rg] = o1; const f32x2 ov_ = *(const LAS f32x2*)(tr + 2 * lane); \
                *(unsigned*)(partial + ((size_t)slice * T + t_) * 128 + 2 * lane) = pk2(ov_.x, ov_.y); } } asm volatile("" ::: "memory"); } while (0)
        if (nb == PB) {
            u32x4 rb[8][4]; float pv[16]; f32x2 hx[8];
            PU_ISSUE(0, 0); PU_ISSUE(1, 1); PU_ISSUE(2, 2); PU_ISSUE(3, 3); PU_ISSUE(4, 4); PU_ISSUE(5, 5); PU_ISSUE(6, 6);
#pragma nounroll
            for (int s0 = 0; s0 < 4 * PB - 8; s0 += 8) { PU_STEP(s0, 0, 0, 1); PU_STEP(s0 + 1, 1, 1, 1); PU_STEP(s0 + 2, 2, 2, 1); PU_STEP(s0 + 3, 3, 3, 1); PU_STEP(s0 + 4, 4, 0, 1); PU_STEP(s0 + 5, 5, 1, 1); PU_STEP(s0 + 6, 6, 2, 1); PU_STEP(s0 + 7, 7, 3, 1); }
            { constexpr int s0 = 4 * PB - 8; PU_STEP(s0, 0, 0, 1); PU_STEP(s0 + 1, 1, 1, 0); PU_STEP(s0 + 2, 2, 2, 0); PU_STEP(s0 + 3, 3, 3, 0); PU_STEP(s0 + 4, 4, 0, 0); PU_STEP(s0 + 5, 5, 1, 0); PU_STEP(s0 + 6, 6, 2, 0); PU_STEP(s0 + 7, 7, 3, 0); }
        } else {
            u32x4 rb[8][4]; float pv[16]; f32x2 hx[8];
#pragma nounroll
            for (int s0 = 0; s0 < nstep; s0 += 4) {
                PU_ISSUE(s0, 0); PU_ISSUE(s0 + 1, 1); PU_ISSUE(s0 + 2, 2); PU_ISSUE(s0 + 3, 3);
                PU_STEP(s0, 0, 0, 0); PU_STEP(s0 + 1, 1, 1, 0); PU_STEP(s0 + 2, 2, 2, 0); PU_STEP(s0 + 3, 3, 3, 0); }
        }
#undef PU_ISSUE
#undef PU_STEP
        asm volatile("s_waitcnt lgkmcnt(0)" ::: "memory");
    }
}

constexpr float CSCALE = 32.f;
__device__ __forceinline__ void ph_peer_coef(const bf16_t* __restrict__ partial, const float* __restrict__ ssp2, const float* __restrict__ gate, unsigned short* __restrict__ coef8) {
    PH_IDS
    const size_t n4 = (size_t)T * 128 / 4, stride = (size_t)GDIM * 512;
    for (size_t i0 = (size_t)BIDX * 512 + TIDX; i0 < n4; i0 += 2 * stride) {
        ge::u32x2 pv[2][8]; f32x4 gv[2]; float rs[2];
#pragma unroll
        for (int u = 0; u < 2; ++u) { const size_t i = i0 + u * stride;
            if (i < n4) {
#pragma unroll
                for (int k = 0; k < 8; ++k) pv[u][k] = *(const ge::u32x2*)(partial + (size_t)k * T * 128 + 4 * i);
                gv[u] = *(const f32x4*)(gate + 4 * i); rs[u] = sum16(ssp2 + (i >> 5) * 16);
            } }
#pragma unroll
        for (int u = 0; u < 2; ++u) { const size_t i = i0 + u * stride;
            if (i < n4) {
                f32x4 s = {0.f, 0.f, 0.f, 0.f};
#pragma unroll
                for (int k = 0; k < 8; ++k) { s.x += __uint_as_float(pv[u][k].x << 16); s.y += __uint_as_float(pv[u][k].x & 0xffff0000u); s.z += __uint_as_float(pv[u][k].y << 16); s.w += __uint_as_float(pv[u][k].y & 0xffff0000u); }
                const float sc = rsqrtf(rs[u] * (1.f / D) + EPS) * (1.f / USCALE);
                f32x4 o; o.x = gelu_fast(s.x * sc) * gv[u].x * CSCALE; o.y = gelu_fast(s.y * sc) * gv[u].y * CSCALE; o.z = gelu_fast(s.z * sc) * gv[u].z * CSCALE; o.w = gelu_fast(s.w * sc) * gv[u].w * CSCALE;
                const unsigned hi = pack4_fp8(o.x, o.y, o.z, o.w);
                const f32x2 h01 = __builtin_amdgcn_cvt_pk_f32_fp8((int)hi, false), h23 = __builtin_amdgcn_cvt_pk_f32_fp8((int)hi, true);
                const unsigned lo = pack4_fp8(o.x - h01.x, o.y - h01.y, o.z - h23.x, o.w - h23.y);
                const unsigned w0 = (hi & 0xffu) | ((lo & 0xffu) << 8) | ((hi & 0xff00u) << 8) | ((lo & 0xff00u) << 16);
                const unsigned w1 = ((hi >> 16) & 0xffu) | (((lo >> 16) & 0xffu) << 8) | ((hi >> 8) & 0xff0000u) | (lo & 0xff000000u);
                *(ge::u32x2*)(coef8 + 4 * i) = (ge::u32x2){w0, w1};
            } }
    }
}

template <int MODE = 0>
__device__ __forceinline__ void ph_peer_v(LAS unsigned char* lds, const unsigned char* __restrict__ PV8, const unsigned short* __restrict__ idx, const unsigned short* __restrict__ coef8, const bf16_t* hin, bf16_t* hb, float* __restrict__ ssp1, int imask = 0x7fffffff) {
    PH_IDS
    const int lane = TIDX & 63, wave = __builtin_amdgcn_readfirstlane(TIDX >> 6), c8 = lane & 7, rg = lane >> 3;
    int slice, gw, ngw; peer_split(lds, BIDX, GDIM, wave, slice, gw, ngw);
    const unsigned char* tab = PV8 + (size_t)slice * NEXP * 128; const unsigned lo16 = 16u * c8;
    LAS int* li = (LAS int*)(lds + wave * 16384);
    LAS unsigned short* lc = (LAS unsigned short*)(lds + wave * 16384 + 8192);
    LAS float* tr = (LAS float*)(lds + wave * 16384 + 12288);
    const int ntok = gw < T ? (T - gw + ngw - 1) / ngw : 0;
    const int p0 = 2 * lane, sd0 = (p0 >> 6) * 64 + (p0 & 7) * 8 + ((p0 & 63) >> 3), sd1 = sd0 + 8;
    const unsigned bsh = 8u * (c8 & 3), mlo = c8 < 4 ? 0xffffffffu : 0u, mhi = ~mlo;
    const int nn = lane & 15, qq = lane >> 4; const bool dvalid = (nn >> 3) == (qq >> 1);
    const int dcol = 64 * (qq & 1) + (nn & 7);
    for (int tb = 0; tb < ntok; tb += PB) {
        const int nb = min(PB, ntok - tb);
        for (int k = 0; k < nb; ++k) {
            const size_t t = (size_t)gw + (size_t)(tb + k) * ngw;
            const unsigned iw = *(const unsigned*)(idx + t * 128 + 2 * lane); i32x2 v = {(int)(iw & 0xffffu) & imask, (int)(iw >> 16) & imask}; const unsigned c = *(const unsigned*)(coef8 + t * 128 + 2 * lane);
            li[k * 128 + sd0] = v.x; li[k * 128 + sd1] = v.y; lc[k * 128 + sd0] = (unsigned short)(c & 0xffffu); lc[k * 128 + sd1] = (unsigned short)(c >> 16);
        }
        asm volatile("s_waitcnt vmcnt(0) lgkmcnt(0)" ::: "memory");
        const int nstep = 4 * nb;
#define PV_ISSUE(s, B) do { const ge::u32x4 ia_ = *(const LAS ge::u32x4*)(li + ((s) >> 1) * 64 + rg * 8 + 4 * ((s) & 1)); \
            _Pragma("unroll") for (int i_ = 0; i_ < 4; ++i_) rb[B][i_] = *(const u32x4*)(tab + (ia_[i_] * 128u + lo16)); } while (0)
#define PV_STEP(s, B, QT, ISS) do { if ((ISS) != 2 || (s) < nstep) { if ((ISS) == 1 || ((ISS) == 2 && (s) + 7 < nstep)) PV_ISSUE((s) + 7, ((B) + 7) & 7); \
            const int k_ = (s) >> 2; const size_t t_ = (size_t)gw + (size_t)(tb + k_) * ngw; \
            if (QT == 0) { acc0 = (ge::f32x4){0.f, 0.f, 0.f, 0.f}; acc1 = acc0; hv = *(const unsigned*)(hin + t_ * D + 128 * slice + 2 * lane); }     \
            const ge::u32x2 cw_ = *(const LAS ge::u32x2*)(lc + ((s) >> 1) * 64 + rg * 8 + 4 * ((s) & 1));                       \
            _Pragma("unroll") for (int i = 0; i < 4; ++i) { const unsigned w_ = (i < 2 ? cw_.x : cw_.y) >> (16 * (i & 1)); \
                const unsigned th_ = (w_ & 0xffu) << bsh, tl_ = ((w_ >> 8) & 0xffu) << bsh; \
                const long bh_ = (long)(((unsigned long long)(th_ & mhi) << 32) | (th_ & mlo)), bl_ = (long)(((unsigned long long)(tl_ & mhi) << 32) | (tl_ & mlo)); \
                const u32x4 av = rb[B][i]; const long a0_ = (long)(((unsigned long long)av.y << 32) | av.x), a1_ = (long)(((unsigned long long)av.w << 32) | av.z); \
                acc0 = __builtin_amdgcn_mfma_f32_16x16x32_fp8_fp8(a0_, bh_, acc0, 0, 0, 0); acc1 = __builtin_amdgcn_mfma_f32_16x16x32_fp8_fp8(a1_, bh_, acc1, 0, 0, 0); \
                acc0 = __builtin_amdgcn_mfma_f32_16x16x32_fp8_fp8(a0_, bl_, acc0, 0, 0, 0); acc1 = __builtin_amdgcn_mfma_f32_16x16x32_fp8_fp8(a1_, bl_, acc1, 0, 0, 0); } \
            if (QT == 3) { \
                if (dvalid) { LAS float* tp_ = tr + 128 * (qq >> 1) + dcol; _Pragma("unroll") for (int i = 0; i < 4; ++i) { tp_[16 * i] = acc0[i]; tp_[16 * i + 8] = acc1[i]; } } \
                const f32x2 e0_ = *(const LAS f32x2*)(tr + 2 * lane), e1_ = *(const LAS f32x2*)(tr + 128 + 2 * lane);                 \
                const unsigned w2_ = pk2(__uint_as_float(hv << 16) + (e0_.x + e1_.x) * (1.f / (VSCALE * CSCALE)), __uint_as_float(hv & 0xffff0000u) + (e0_.y + e1_.y) * (1.f / (VSCALE * CSCALE))); \
                *(unsigned*)(hb + t_ * D + 128 * slice + 2 * lane) = w2_; const float x0 = __uint_as_float(w2_ << 16), x1 = __uint_as_float(w2_ & 0xffff0000u); \
                float sq = x0 * x0 + x1 * x1; sq = wave_sum(sq); if (lane == 0) ssp1[t_ * 8 + slice] = sq; } } asm volatile("" ::: "memory"); } while (0)
        if (nb == PB) {
            u32x4 rb[8][4]; ge::f32x4 acc0, acc1; unsigned hv;
            PV_ISSUE(0, 0); PV_ISSUE(1, 1); PV_ISSUE(2, 2); PV_ISSUE(3, 3); PV_ISSUE(4, 4); PV_ISSUE(5, 5); PV_ISSUE(6, 6);
#pragma nounroll
            for (int s0 = 0; s0 < 4 * PB - 8; s0 += 8) { PV_STEP(s0, 0, 0, 1); PV_STEP(s0 + 1, 1, 1, 1); PV_STEP(s0 + 2, 2, 2, 1); PV_STEP(s0 + 3, 3, 3, 1); PV_STEP(s0 + 4, 4, 0, 1); PV_STEP(s0 + 5, 5, 1, 1); PV_STEP(s0 + 6, 6, 2, 1); PV_STEP(s0 + 7, 7, 3, 1); }
            { constexpr int s0 = 4 * PB - 8; PV_STEP(s0, 0, 0, 1); PV_STEP(s0 + 1, 1, 1, 0); PV_STEP(s0 + 2, 2, 2, 0); PV_STEP(s0 + 3, 3, 3, 0); PV_STEP(s0 + 4, 4, 0, 0); PV_STEP(s0 + 5, 5, 1, 0); PV_STEP(s0 + 6, 6, 2, 0); PV_STEP(s0 + 7, 7, 3, 0); }
        } else {
            u32x4 rb[8][4]; ge::f32x4 acc0, acc1; unsigned hv;
#pragma nounroll
            for (int s0 = 0; s0 < nstep; s0 += 4) {
                PV_ISSUE(s0, 0); PV_ISSUE(s0 + 1, 1); PV_ISSUE(s0 + 2, 2); PV_ISSUE(s0 + 3, 3);
                PV_STEP(s0, 0, 0, 0); PV_STEP(s0 + 1, 1, 1, 0); PV_STEP(s0 + 2, 2, 2, 0); PV_STEP(s0 + 3, 3, 3, 0); }
        }
#undef PV_ISSUE
#undef PV_STEP
        asm volatile("s_waitcnt lgkmcnt(0)" ::: "memory");
    }
}

__device__ __forceinline__ void ph_final(const bf16_t* __restrict__ hb, const float* __restrict__ ssp1, const float* __restrict__ g, float* __restrict__ out) {
    PH_IDS
    const int lane = TIDX & 63, gw = BIDX * 8 + __builtin_amdgcn_readfirstlane(TIDX >> 6), ngw = GDIM * 8;
    for (int w = gw; w < T; w += ngw) {
        const float rs = rsqrtf(sum8(ssp1 + (size_t)w * 8) * (1.f / D) + EPS);
        const u32x4* r = (const u32x4*)(hb + (size_t)w * D) + lane; const f32x4* gg = (const f32x4*)g; f32x4* o = (f32x4*)(out + (size_t)w * D);
#pragma unroll
        for (int j = 0; j < 2; ++j) { const u32x4 v = r[64 * j]; const int c4 = (64 * j + lane) * 2; const f32x4 g0 = gg[c4], g1 = gg[c4 + 1];
            o[c4] = (f32x4){__uint_as_float(v.x << 16) * rs * g0.x, __uint_as_float(v.x & 0xffff0000u) * rs * g0.y, __uint_as_float(v.y << 16) * rs * g0.z, __uint_as_float(v.y & 0xffff0000u) * rs * g0.w};
            o[c4 + 1] = (f32x4){__uint_as_float(v.z << 16) * rs * g1.x, __uint_as_float(v.z & 0xffff0000u) * rs * g1.y, __uint_as_float(v.w << 16) * rs * g1.z, __uint_as_float(v.w & 0xffff0000u) * rs * g1.w}; }
    }
}
}
namespace attn_body {
using bf16=__hip_bfloat16;
using bf16x8=__attribute__((ext_vector_type(8)))short;
using s16x4=__attribute__((ext_vector_type(4)))short;
using f32x16=__attribute__((ext_vector_type(16)))float;
using u32x4=__attribute__((ext_vector_type(4)))unsigned;
constexpr int BATCH=8,NHEAD=8,SEQ=4096,D=64,DM=NHEAD*D;
constexpr int OPITCH=1024,OCOL=512;
constexpr int NW=8,QBLK=32,QB=QBLK*NW,KVBLK=64,NQB=SEQ/QB;
constexpr int ATTN_PITCH=DM, ATTN_UNIT_ROWS=QB;
__device__ __forceinline__ int crow(int r,int hi){return (r&3)+8*(r>>2)+4*hi;}
#define SBAR() __builtin_amdgcn_sched_barrier(0)
__device__ __forceinline__ void cmask(f32x16&p0,f32x16&p1,int jb,int qrel,int hi){
  const float NEG=-INFINITY; int kb=64*jb+4*hi;
  #pragma unroll
  for(int r=0;r<16;++r){int kv=kb+(r&3)+8*(r>>2); if(kv>qrel)p0[r]=NEG; if(kv+32>qrel)p1[r]=NEG;}
}

constexpr int NSLOT=3, SLOTB=8192;
constexpr int LDS_K=0, LDS_V=NSLOT*SLOTB, LDS_WS=2*NSLOT*SLOTB, LDS_OST=LDS_WS+NW*64*4, LDS_CUM=LDS_OST+NW*4096, LDS_BYTES=LDS_CUM+SEQ*4;
constexpr float PRUNE_T=64.f;
constexpr float C2=0.125f*1.4426950408889634f;
__device__ __forceinline__ void glds16(const void*gsrc,unsigned lds_dst){unsigned keep;
  asm volatile("s_mov_b32 %0, m0\n\ts_mov_b32 m0, %2\n\ts_nop 0\n\tglobal_load_lds_dwordx4 %1, off\n\ts_mov_b32 m0, %0":"=&s"(keep):"v"(gsrc),"s"(lds_dst):"memory");}
__device__ __forceinline__ float max3f(float a,float b,float c){float r;asm("v_max3_f32 %0, %1, %2, %3":"=v"(r):"v"(a),"v"(b),"v"(c));return r;}
__device__ __forceinline__ float max2f(float a,float b){float r;asm("v_max_f32_e32 %0, %1, %2":"=v"(r):"v"(a),"v"(b));return r;}
__device__ __forceinline__ float fadd_s(float a,float b){float r;asm("v_add_f32_e32 %0, %1, %2":"=v"(r):"v"(a),"v"(b));return r;}
__device__ __forceinline__ float fsub_s(float a,float b){float r;asm("v_sub_f32_e32 %0, %1, %2":"=v"(r):"v"(a),"v"(b));return r;}
typedef float f32x4_t __attribute__((ext_vector_type(4)));
typedef float f32x2_t __attribute__((ext_vector_type(2))); typedef __bf16 bf16x2_t __attribute__((ext_vector_type(2)));
__device__ __forceinline__ unsigned cvtpk_s(float lo,float hi){f32x2_t v={lo,hi};bf16x2_t b=__builtin_convertvector(v,bf16x2_t);return __builtin_bit_cast(unsigned,b);}
#define WAIT_BAR(N) asm volatile("s_waitcnt vmcnt(" #N ") lgkmcnt(0)\n\ts_barrier":::"memory")

__device__ __forceinline__ void qkt(f32x16&p0,f32x16&p1,const char*Kslot,const bf16x8*qr,const f32x16&negm,int r32,int hi){
  const char*kb=Kslot+hi*1024+r32*16;
  #pragma unroll
  for(int d0=0;d0<4;++d0){
    const bf16x8 b0=*reinterpret_cast<const bf16x8*>(kb+d0*2048);
    const bf16x8 b1=*reinterpret_cast<const bf16x8*>(kb+d0*2048+512);
    if(d0==0){p0=__builtin_amdgcn_mfma_f32_32x32x16_bf16(b0,qr[0],negm,0,0,0);p1=__builtin_amdgcn_mfma_f32_32x32x16_bf16(b1,qr[0],negm,0,0,0);}
    else{p0=__builtin_amdgcn_mfma_f32_32x32x16_bf16(b0,qr[d0],p0,0,0,0);p1=__builtin_amdgcn_mfma_f32_32x32x16_bf16(b1,qr[d0],p1,0,0,0);}}
}
typedef __attribute__((address_space(3))) const char* lds_cptr;
typedef short v4i16_t __attribute__((ext_vector_type(4)));
__device__ __forceinline__ void kload8(bf16x8*kf,lds_cptr kp){
  kf[0]=*(const __attribute__((address_space(3))) bf16x8*)(kp);      kf[1]=*(const __attribute__((address_space(3))) bf16x8*)(kp+512);
  kf[2]=*(const __attribute__((address_space(3))) bf16x8*)(kp+2048); kf[3]=*(const __attribute__((address_space(3))) bf16x8*)(kp+2560);
  kf[4]=*(const __attribute__((address_space(3))) bf16x8*)(kp+4096); kf[5]=*(const __attribute__((address_space(3))) bf16x8*)(kp+4608);
  kf[6]=*(const __attribute__((address_space(3))) bf16x8*)(kp+6144); kf[7]=*(const __attribute__((address_space(3))) bf16x8*)(kp+6656);
}
__device__ __forceinline__ void kload2(bf16x8*kf,lds_cptr kp,int j){ kf[2*j]=*(const __attribute__((address_space(3))) bf16x8*)(kp+j*2048); kf[2*j+1]=*(const __attribute__((address_space(3))) bf16x8*)(kp+j*2048+512); }
__device__ __forceinline__ s16x4 vtr(lds_cptr p){ return __builtin_bit_cast(s16x4,__builtin_amdgcn_ds_read_tr16_b64_v4i16((__attribute__((address_space(3))) v4i16_t*)p)); }
__device__ __forceinline__ float rowmax(const f32x16&p0,const f32x16&p1){
  float a=max3f(p0[0],p0[1],p1[0]),b=max3f(p0[2],p0[3],p1[1]);a=max3f(a,p1[2],p1[3]);
  #pragma unroll
  for(int r=4;r<16;r+=4){a=max3f(a,p0[r],p0[r+1]);b=max3f(b,p0[r+2],p0[r+3]);a=max3f(a,p1[r],p1[r+1]);b=max3f(b,p1[r+2],p1[r+3]);}
  const float m=max2f(a,b);
  auto rr=__builtin_amdgcn_permlane32_swap(__float_as_uint(m),__float_as_uint(m),false,false);
  return max2f(__uint_as_float(rr[0]),__uint_as_float(rr[1]));
}
__device__ __forceinline__ void pv(f32x16*o,int vb,bf16x8 pa0,bf16x8 pa1,bf16x8 pa2,bf16x8 pa3){
  #pragma unroll
  for(int d0=0;d0<2;++d0){s16x4 lo[4],hi[4];
    #pragma unroll
    for(int ks=0;ks<4;++ks){
      asm volatile("ds_read_b64_tr_b16 %0,%1 offset:%c2":"=&v"(lo[ks]):"v"(vb),"i"(d0*4096+ks*1024):"memory");
      asm volatile("ds_read_b64_tr_b16 %0,%1 offset:%c2":"=&v"(hi[ks]):"v"(vb),"i"(d0*4096+ks*1024+512):"memory");}
    asm volatile("s_waitcnt lgkmcnt(0)":::"memory");SBAR();
    #define PK(k) (bf16x8){lo[k][0],lo[k][1],lo[k][2],lo[k][3],hi[k][0],hi[k][1],hi[k][2],hi[k][3]}
    o[d0]=__builtin_amdgcn_mfma_f32_32x32x16_bf16(pa0,PK(0),o[d0],0,0,0);
    o[d0]=__builtin_amdgcn_mfma_f32_32x32x16_bf16(pa1,PK(1),o[d0],0,0,0);
    o[d0]=__builtin_amdgcn_mfma_f32_32x32x16_bf16(pa2,PK(2),o[d0],0,0,0);
    o[d0]=__builtin_amdgcn_mfma_f32_32x32x16_bf16(pa3,PK(3),o[d0],0,0,0);
    #undef PK
  }
}

#ifndef ATTN_STORE16
#define ATTN_STORE16(p,v) (*(u32x4*)(p)=(v))
#endif
template<int THRL> __device__ __forceinline__ void attn_unit(int b,int h,int qb,const bf16*Q,const bf16*__restrict__ K,const bf16*__restrict__ V,const float*__restrict__ cum2,bf16*O,float*__restrict__ ssp,char*shm,int tid_){
  int tid=tid_; asm volatile("":"+v"(tid)); const int lane=tid&63,r32=lane&31,hi=lane>>5; const int wid=__builtin_amdgcn_readfirstlane(tid>>6);
  const long rowbase=(long)b*SEQ; const int q0=qb*QB;
  const bf16*Qw=Q+(rowbase+q0+wid*QBLK)*DM+h*D;
  const bf16*Kh=K+rowbase*DM+h*D,*Vh=V+rowbase*DM+h*D;
  const unsigned lds0=(unsigned)(uintptr_t)shm;
  float*wsf=(float*)(shm+LDS_WS)+wid*64;
  const int NTf=(q0+QB)/KVBLK; const float*cg=cum2+(long)(b*NHEAD+h)*SEQ;
  int ts; { const float thr=cg[q0]+PRUNE_T; const float ce=lane<NTf?cg[64*lane+63]:0.f; const unsigned long long m_=__ballot((lane<NTf)&&(ce<=thr));
    ts=m_?(int)__builtin_ctzll(m_):0; ts&=~1; if(ts>NTf-4)ts=NTf-4; ts=__builtin_amdgcn_readfirstlane(ts); }
  const bf16*ksrc=Kh+(long)(ts*KVBLK+lane)*DM+wid*8;
  const bf16*vsrc=Vh+(long)(ts*KVBLK+16*(wid&3)+(lane>>2))*DM+(wid>>2)*32+(lane&3)*8;
  const unsigned kdst=lds0+LDS_K+wid*1024, vdst=lds0+LDS_V+wid*1024;
  #define DMA_K(t,slot) glds16(ksrc+(long)(t)*KVBLK*DM,(unsigned)__builtin_amdgcn_readfirstlane(kdst+(slot)))
  #define DMA_V(t,slot) glds16(vsrc+(long)(t)*KVBLK*DM,(unsigned)__builtin_amdgcn_readfirstlane(vdst+(slot)))
  const int vb0=(int)(lds0+LDS_V)+((lane>>4)&1)*32+(lane&3)*8+(4*hi+((lane&15)>>2))*64;
  const char*Kbase=shm+LDS_K; bf16x8 kf[8];
  const lds_cptr shm3=(lds_cptr)shm; const lds_cptr kp0=shm3+LDS_K+hi*1024+r32*16; const lds_cptr vp0=shm3+LDS_V+((lane>>4)&1)*32+(lane&3)*8+(4*hi+((lane&15)>>2))*64;
  { float*cl=(float*)(shm+LDS_CUM); for(int i=tid+ts*KVBLK;i<q0+QB;i+=NW*64)cl[i-ts*KVBLK]=cg[i]; }
  const float cq2=cg[q0+wid*QBLK+r32];
  const __attribute__((address_space(3))) float* ckl=(const __attribute__((address_space(3))) float*)(shm3+LDS_CUM)+4*hi;
  #define BIAS(P0,P1,t) do{ const __attribute__((address_space(3))) float*ck_=ckl+64*(t); const float mm_=mhat-cq2; _Pragma("unroll") for(int g_=0;g_<4;++g_){ \
      const f32x4_t c0_=*(const __attribute__((address_space(3))) f32x4_t*)(ck_+8*g_)+mm_, c1_=*(const __attribute__((address_space(3))) f32x4_t*)(ck_+32+8*g_)+mm_; \
      _Pragma("unroll") for(int i_=0;i_<4;++i_){P0[4*g_+i_]-=c0_[i_];P1[4*g_+i_]-=c1_[i_];} SBAR(); } }while(0)
  const int NT=NTf-ts;
  DMA_K(0,0);DMA_V(0,0);DMA_K(1,SLOTB);
  bf16x8 qr[4];
  #pragma unroll
  for(int d0=0;d0<4;++d0)qr[d0]=*reinterpret_cast<const bf16x8*>(&Qw[(long)r32*DM+d0*16+hi*8]);
  float mhat=0.f,l_reg=0.f;f32x16 o[2];o[0]=f32x16{};o[1]=f32x16{};const f32x16 negm=f32x16{};
  const int qrel=wid*QBLK+r32;
  #define CMASK(P0,P1,t) do{int jb_=(t)-(NT-4); if(jb_>=0)cmask(P0,P1,jb_,qrel,hi);}while(0)
  bool resc=false;
  #define START(P0,P1) do{ const float rm=rowmax(P0,P1); resc=false; \
    { const float dl=rm; mhat=fadd_s(mhat,dl); \
      _Pragma("unroll") for(int r=0;r<16;++r){P0[r]=fsub_s(P0[r],dl);P1[r]=fsub_s(P1[r],dl);} \
      } \
    _Pragma("unroll") for(int r=0;r<16;++r)P0[r]=__builtin_amdgcn_exp2f(P0[r]); }while(0)
  #define RESC() do{ if(resc){ asm volatile("s_waitcnt lgkmcnt(0)":::"memory"); \
      _Pragma("unroll") for(int d_=0;d_<2;++d_) _Pragma("unroll") for(int r=0;r<16;++r)o[d_][r]*=wsf[crow(r,hi)]; } }while(0)
  f32x16 pA0,pA1,pB0,pB1;
  int sl_prev=0,sl_cur=0,sl_next=SLOTB;
  #define ROT() do{sl_prev=sl_cur;sl_cur=sl_next;sl_next=(sl_next==(NSLOT-1)*SLOTB)?0:sl_next+SLOTB;}while(0)
  DMA_K(2,2*SLOTB);
  WAIT_BAR(3);
  qkt(pA0,pA1,Kbase,qr,negm,r32,hi);asm volatile("s_nop 15\n\ts_nop 7":"+v"(pA0),"+v"(pA1));BIAS(pA0,pA1,0);CMASK(pA0,pA1,0);
  START(pA0,pA1);
  _Pragma("unroll") for(int r=0;r<16;++r)pA1[r]=__builtin_amdgcn_exp2f(pA1[r]);
  WAIT_BAR(0);
  DMA_K(3,0);DMA_V(1,SLOTB);
  ROT();
  kload8(kf,kp0+sl_cur);
  WAIT_BAR(2);
  s16x4 vlo[8],vhi[8]; u32x4 pw0,pw1,pw2,pw3;
  #define PKW(P,B) cvtpk_s(P[B],P[B+1])
  #define PAF(k) __builtin_bit_cast(bf16x8,pw##k)
  #define VFR(i) (bf16x8){vlo[i][0],vlo[i][1],vlo[i][2],vlo[i][3],vhi[i][0],vhi[i][1],vhi[i][2],vhi[i][3]}
  #define PIN(x) asm volatile("":"+v"(x))
  #define MX3(a,b,c) __builtin_fmaxf(__builtin_fmaxf((a),(b)),(c))
  #define GAPA(MF,A0,A1,A2,A3,W0,W1,PW) do{ MF; sacc+=A0; sacc+=A1; sacc+=A2; sacc+=A3; PIN(sacc); W0; W1; PIN(PW); SBAR(); }while(0)
  #define EX(v) __builtin_amdgcn_exp2f(v)
  #define GAPB(MF,X,B) do{ MF; X[B]=EX(X[B]); X[B+1]=EX(X[B+1]); X[B+2]=EX(X[B+2]); X[B+3]=EX(X[B+3]); PIN(X); SBAR(); }while(0)
  #define VRD(i) do{ vlo[i]=vtr(vp_+(((i)>>2)*4096+((i)&3)*1024)); vhi[i]=vtr(vp_+(((i)>>2)*4096+((i)&3)*1024+512)); }while(0)
  #define KRD(G,j) do{ if(G){ kload2(kf,kp0+sl_next,j); SBAR(); } }while(0)
  #define STEP(C0,C1,P0,P1,t,GK,GV,GL) do{ SBAR(); \
    const lds_cptr vp_=vp0+sl_prev; \
    VRD(0); SBAR(); float sacc=(P0[0]+P0[1]); \
    GAPA(C0=__builtin_amdgcn_mfma_f32_32x32x16_bf16(kf[0],qr[0],negm,0,0,0), P0[2],P0[3],P0[4],P0[5],     pw0[0]=PKW(P0,0), pw0[1]=PKW(P0,2), pw0); \
    VRD(4); SBAR(); GAPA(C1=__builtin_amdgcn_mfma_f32_32x32x16_bf16(kf[1],qr[0],negm,0,0,0), P0[6],P0[7],P0[8],P0[9],     pw0[2]=PKW(P0,4), pw0[3]=PKW(P0,6), pw0); \
    VRD(1); SBAR(); GAPA(C0=__builtin_amdgcn_mfma_f32_32x32x16_bf16(kf[2],qr[1],C0,0,0,0),   P0[10],P0[11],P0[12],P0[13], pw1[0]=PKW(P0,8), pw1[1]=PKW(P0,10), pw1); \
    VRD(5); SBAR(); GAPA(C1=__builtin_amdgcn_mfma_f32_32x32x16_bf16(kf[3],qr[1],C1,0,0,0),   P0[14],P0[15],P1[0],P1[1],   pw1[2]=PKW(P0,12),pw1[3]=PKW(P0,14), pw1); \
    VRD(2); SBAR(); GAPA(C0=__builtin_amdgcn_mfma_f32_32x32x16_bf16(kf[4],qr[2],C0,0,0,0),   P1[2],P1[3],P1[4],P1[5],     pw2[0]=PKW(P1,0), pw2[1]=PKW(P1,2), pw2); \
    VRD(6); SBAR(); GAPA(C1=__builtin_amdgcn_mfma_f32_32x32x16_bf16(kf[5],qr[2],C1,0,0,0),   P1[6],P1[7],P1[8],P1[9],     pw2[2]=PKW(P1,4), pw2[3]=PKW(P1,6), pw2); \
    VRD(3); SBAR(); GAPA(C0=__builtin_amdgcn_mfma_f32_32x32x16_bf16(kf[6],qr[3],C0,0,0,0),   P1[10],P1[11],P1[12],P1[13], pw3[0]=PKW(P1,8), pw3[1]=PKW(P1,10), pw3); \
    VRD(7); SBAR(); GAPA(C1=__builtin_amdgcn_mfma_f32_32x32x16_bf16(kf[7],qr[3],C1,0,0,0),   P1[14],P1[15],0.f,0.f,       pw3[2]=PKW(P1,12),pw3[3]=PKW(P1,14), pw3); \
    l_reg+=sacc; \
    if(GK){DMA_K((t)+3,sl_cur);} if(GV){DMA_V((t)+1,sl_next);} \
    BIAS(C0,C1,t); CMASK(C0,C1,t); \
    { float a=MX3(C0[0],C0[1],C1[0]),b=MX3(C0[2],C0[3],C1[1]); a=MX3(a,C1[2],C1[3]); \
      _Pragma("unroll") for(int r=4;r<16;r+=4){a=MX3(a,C0[r],C0[r+1]);b=MX3(b,C0[r+2],C0[r+3]);a=MX3(a,C1[r],C1[r+1]);b=MX3(b,C1[r+2],C1[r+3]);} \
      float rm=__builtin_fmaxf(a,b); { auto rr=__builtin_amdgcn_permlane32_swap(__float_as_uint(rm),__float_as_uint(rm),false,false); rm=__builtin_fmaxf(__uint_as_float(rr[0]),__uint_as_float(rr[1])); } \
      resc=false; \
      if(__builtin_expect(__any(rm>(float)THRL),0)){ const float dl=__builtin_fmaxf(rm,0.f); mhat+=dl; \
        _Pragma("unroll") for(int r=0;r<16;++r){C0[r]-=dl;C1[r]-=dl;} \
        const float f=__builtin_amdgcn_exp2f(-dl); l_reg*=f; if(hi==0)wsf[r32]=f; resc=true; } } \
    SBAR(); \
    GAPB(o[0]=__builtin_amdgcn_mfma_f32_32x32x16_bf16(PAF(0),VFR(0),o[0],0,0,0), C0,0); \
    GAPB(o[1]=__builtin_amdgcn_mfma_f32_32x32x16_bf16(PAF(0),VFR(4),o[1],0,0,0), C0,4); \
    KRD(GL,0); GAPB(o[0]=__builtin_amdgcn_mfma_f32_32x32x16_bf16(PAF(1),VFR(1),o[0],0,0,0), C0,8); \
    KRD(GL,1); GAPB(o[1]=__builtin_amdgcn_mfma_f32_32x32x16_bf16(PAF(1),VFR(5),o[1],0,0,0), C0,12); \
    KRD(GL,2); GAPB(o[0]=__builtin_amdgcn_mfma_f32_32x32x16_bf16(PAF(2),VFR(2),o[0],0,0,0), C1,0); \
    KRD(GL,3); GAPB(o[1]=__builtin_amdgcn_mfma_f32_32x32x16_bf16(PAF(2),VFR(6),o[1],0,0,0), C1,4); \
    GAPB(o[0]=__builtin_amdgcn_mfma_f32_32x32x16_bf16(PAF(3),VFR(3),o[0],0,0,0), C1,8); \
    GAPB(o[1]=__builtin_amdgcn_mfma_f32_32x32x16_bf16(PAF(3),VFR(7),o[1],0,0,0), C1,12); \
    }while(0)
  int t=1;
  #undef CMASK
  #define CMASK(P0,P1,t) do{}while(0)
  for(;t+5<NT;t+=2){
    STEP(pB0,pB1,pA0,pA1,t,true,true,true);     WAIT_BAR(2); RESC(); ROT();
    STEP(pA0,pA1,pB0,pB1,t+1,true,true,true);   WAIT_BAR(2); RESC(); ROT();
  }
  #undef CMASK
  #define CMASK(P0,P1,t) do{int jb_=(t)-(NT-4); if(jb_>=0)cmask(P0,P1,jb_,qrel,hi);}while(0)
  #define ENDW(tt) do{ if((tt)+3<NT){WAIT_BAR(2);} else if((tt)+2<NT){WAIT_BAR(1);} else {WAIT_BAR(0);} }while(0)
  for(;t+1<NT;t+=2){
    STEP(pB0,pB1,pA0,pA1,t,(t+3<NT),(t+1<NT),(t+1<NT));       ENDW(t);   RESC(); ROT();
    STEP(pA0,pA1,pB0,pB1,t+1,(t+4<NT),(t+2<NT),(t+2<NT));     ENDW(t+1); RESC(); ROT();
  }
  STEP(pB0,pB1,pA0,pA1,NT-1,false,false,false); RESC();
  { float sacc=pB0[0]+pB0[1]; _Pragma("unroll") for(int r=2;r<16;++r)sacc+=pB0[r]; _Pragma("unroll") for(int r=0;r<16;++r)sacc+=pB1[r]; l_reg+=sacc;
    pw0=(u32x4){PKW(pB0,0),PKW(pB0,2),PKW(pB0,4),PKW(pB0,6)};pw1=(u32x4){PKW(pB0,8),PKW(pB0,10),PKW(pB0,12),PKW(pB0,14)};pw2=(u32x4){PKW(pB1,0),PKW(pB1,2),PKW(pB1,4),PKW(pB1,6)};pw3=(u32x4){PKW(pB1,8),PKW(pB1,10),PKW(pB1,12),PKW(pB1,14)};
    SBAR(); pv(o,vb0+sl_cur,PAF(0),PAF(1),PAF(2),PAF(3)); }
  #undef PKW
  #undef PAF
  #undef VFR
  #undef PIN
  #undef MX3
  #undef GAPA
  #undef GAPB
  #undef EX
  #undef VRD
  #undef KRD
  #undef STEP
  #undef ENDW
  {auto rr=__builtin_amdgcn_permlane32_swap(__float_as_uint(l_reg),__float_as_uint(l_reg),false,false);l_reg=__uint_as_float(rr[0])+__uint_as_float(rr[1]);}
  if(hi==0)wsf[32+r32]=l_reg;asm volatile("s_waitcnt lgkmcnt(0)":::"memory");
  float rli[16];
  #pragma unroll
  for(int r=0;r<16;++r)rli[r]=__builtin_amdgcn_rcpf(wsf[32+crow(r,hi)]);
  int lane_e=lane; asm volatile("":"+v"(lane_e));
  bf16*Ow=O+(rowbase+q0+wid*QBLK)*OPITCH+OCOL+h*D; float*sw=ssp+(rowbase+q0+wid*QBLK)*8+h;
  { bf16*stg=(bf16*)(shm+LDS_OST)+wid*2048;
    #pragma unroll
    for(int r=0;r<16;++r){const int orow=crow(r,hi);
      #pragma unroll
      for(int d0=0;d0<2;++d0)stg[orow*64+d0*32+r32]=__float2bfloat16(o[d0][r]*rli[r]);}
    asm volatile("s_waitcnt lgkmcnt(0)":::"memory");
    #pragma unroll
    for(int i=0;i<4;++i){const int row=i*8+(lane_e>>3),ch=lane_e&7; const u32x4 v=*(const u32x4*)(stg+row*64+ch*8); ATTN_STORE16(Ow+(long)row*OPITCH+ch*8,v);
      float sq=0.f;
      #pragma unroll
      for(int k=0;k<4;++k){const float a=__uint_as_float(v[k]<<16),c=__uint_as_float(v[k]&0xffff0000u);sq+=a*a+c*c;}
      sq+=__shfl_xor(sq,1);sq+=__shfl_xor(sq,2);sq+=__shfl_xor(sq,4);
      if(ch==0)sw[(long)row*8]=sq; } }
  asm volatile("s_waitcnt lgkmcnt(0)\n\ts_barrier":::"memory");
  #undef DMA_K
  #undef DMA_V
  #undef CMASK
  #undef START
  #undef RESC
  #undef BIAS
  #undef ROT
}
constexpr int ATTN_LDS_BYTES=LDS_BYTES;
template<int THRL=8> __device__ __forceinline__ void attn_phase(char*lds,const bf16*Q,const bf16*K,const bf16*V,const float*cum2,bf16*O,float*ssp,unsigned*ctr,volatile __attribute__((address_space(3))) unsigned*slot,int tid){
  for(;;){
    if(tid==0)*slot=__hip_atomic_fetch_add(ctr,1u,__ATOMIC_RELAXED,__HIP_MEMORY_SCOPE_AGENT);
    __syncthreads();
    const int u=(int)*slot;
    __syncthreads();
    if(u>=BATCH*NHEAD*NQB)break;
    const int qb=NQB-1-(u>>6),h=NHEAD-1-((u>>3)&7),b=u&7;
    attn_unit<THRL>(b,h,qb,Q,K,V,cum2,O,ssp,lds,tid);
  }
}
#undef SBAR
#undef WAIT_BAR
}
namespace nv {
typedef float f32x2v __attribute__((ext_vector_type(2)));
constexpr size_t WS_APOW = 921 * MiB;
constexpr size_t WS_BBAR = 89 * MiB;
constexpr int KDW = 128 * 256;
__device__ __forceinline__ void p0_ssm_a(const float* __restrict__ lam_re, const float* __restrict__ lam_im, const float* __restrict__ log_dt, const float* __restrict__ b_re, const float* __restrict__ b_im,
                                         f32x2v* __restrict__ apow, f32x2v* __restrict__ bbar) {
    PH_IDS
    for (int i = BIDX * 512 + TIDX; i < DEPTH * G * P; i += GDIM * 512) {
        const int lg = i / P, p = i % P;
        const float dtf = expf(log_dt[lg]); const float lr = lam_re[i], li = lam_im[i];
        const double ang = (double)li * (double)dtf, k2 = rint(ang * 0.15915494309189535), red = ang - k2 * 6.283185307179586;
        const float mag = expf(lr * dtf), rr = (float)red; const double are = (double)(mag * cosf(rr)), aim = (double)(mag * sinf(rr));
        double pr = 1.0, pi = 0.0;
        for (int d = 0; d <= 64; ++d) { apow[((size_t)lg * 65 + d) * P + p] = (f32x2v){(float)pr, (float)pi}; const double nr_ = pr * are - pi * aim, ni_ = pr * aim + pi * are; pr = nr_; pi = ni_; }
        const double lrd = lr, lid = li, den = lrd * lrd + lid * lid, nr = are - 1.0, zre = (nr * lrd + aim * lid) / den, zim = (aim * lrd - nr * lid) / den;
        for (int h = 0; h < HC; ++h) { const double br = b_re[(size_t)i * HC + h], bi = b_im[(size_t)i * HC + h]; bbar[(size_t)i * HC + h] = (f32x2v){(float)(zre * br - zim * bi), (float)(zre * bi + zim * br)}; }
    }
}
__device__ __forceinline__ void p0_ssm_b(const f32x2v* __restrict__ apow, const f32x2v* __restrict__ bbar, const float* __restrict__ c_re, const float* __restrict__ c_im, const float* __restrict__ dsk,
                                         bf16_t* __restrict__ KD, bf16_t* __restrict__ WST, bf16_t* __restrict__ WOUT) {
    PH_IDS
    const int gt = BIDX * 512 + TIDX, nth = GDIM * 512;
    for (int i = gt; i < DEPTH * G * KDW; i += nth) {
        const int lg = i / KDW, r = i % KDW, dd = r >> 8, h = (r >> 4) & 15, h2 = r & 15, d = dd - 63;
        float v = 0.f;
        if (d >= 0 && dd < 127) {
            const f32x2v* ap = apow + ((size_t)lg * 65 + d) * P; const f32x2v* bb = bbar + (size_t)lg * P * HC + h2; const float* cr = c_re + ((size_t)lg * HC + h) * P; const float* ci = c_im + ((size_t)lg * HC + h) * P;
            for (int p = 0; p < P; ++p) { const f32x2v a = ap[p], b = bb[(size_t)p * HC]; const float wr = a.x * b.x - a.y * b.y, wi = a.x * b.y + a.y * b.x; v += cr[p] * wr - ci[p] * wi; }
            if (d == 0 && h == h2) v += dsk[lg * HC + h];
        }
        KD[i] = f2bf(v);
    }
    for (int i = gt; i < DEPTH * G * 128 * 256; i += nth) {
        const int lg = i >> 15, r = i & 32767, row = r >> 8, k = r & 255, j = k >> 4, h2 = k & 15, p = row & 63;
        const f32x2v a = apow[((size_t)lg * 65 + (15 - j)) * P + p], b = bbar[((size_t)lg * P + p) * HC + h2];
        WST[i] = f2bf(row < 64 ? a.x * b.x - a.y * b.y : a.x * b.y + a.y * b.x);
    }
    for (int i = gt; i < DEPTH * G * 1024 * 128; i += nth) {
        const int lg = i >> 17, r = i & 131071, row = r >> 7, k = r & 127, ti = row >> 4, h = row & 15, p = k & 63;
        const f32x2v e = apow[((size_t)lg * 65 + ti + 1) * P + p]; const float cr = c_re[((size_t)lg * HC + h) * P + p], ci = c_im[((size_t)lg * HC + h) * P + p];
        WOUT[i] = f2bf(k < 64 ? cr * e.x - ci * e.y : -(cr * e.y + ci * e.x));
    }
}

struct SchedSsmS {
    static constexpr bool DUALB = false; long hA, hB, hB1;
    const char* UP; const char* WST; int G_, c;
    __device__ __forceinline__ void init(const void* up, const void* wst_l, int grid, int bid) { UP = (const char*)up; WST = (const char*)wst_l; G_ = grid; c = bid; hA = 128l * UPW * 2; hB = 0; hB1 = 0; }
    __device__ __forceinline__ bool next(int i, ge::Unit& u) const {
        const int L = i * G_ + c; if (L >= G * 2 * 4) return false;
        const int g = L >> 3, pm = (L >> 2) & 1, ks = L & 3;
        u.A0 = UP + (((size_t)g * NCH + pm * 256) * UPW + 128 + ks * 256) * 2; u.B0 = WST + (size_t)g * 128 * 256 * 2; u.nt = 4; u.pm = pm; u.pn = ks; u.aux = g; return true; }
    __device__ __forceinline__ const char* ta(const ge::Unit& u, int t) const { return u.A0 + t * 128; }
    __device__ __forceinline__ const char* tb(const ge::Unit& u, int t) const { return u.B0 + t * 128; }
    __device__ __forceinline__ bool sb(const ge::Unit&, int) const { return false; }
    __device__ __forceinline__ unsigned voffA(int R, int C) const { return (unsigned)(R * UPW * 2 + C * 2); }
    __device__ __forceinline__ unsigned voffB(int Rb, int C) const { return (unsigned)(Rb * 512 + C * 2); }
    __device__ __forceinline__ unsigned voffB1(int, int) const { return 0u; }
};
struct EpiSsmS {
    static constexpr bool PERM = false, MIDK = false, UBEGIN = false;
    float* SLOC;
    __device__ __forceinline__ void unit_begin(const ge::Unit&, int, LAS unsigned char*) const {}
    __device__ __forceinline__ void midk(ge::f32x4 (&)[2][2][4][2], const ge::Unit&, int, int, LAS unsigned char*) const {}
    __device__ __forceinline__ void operator()(const ge::f32x4 (&acc)[2][2][4][2], const ge::Unit& u, int wr, int wc, int fr, int fq, LAS unsigned char*) const {
        const int g = u.aux, ks = u.pn;
#pragma unroll
        for (int ai = 0; ai < 2; ++ai)
#pragma unroll
            for (int m = 0; m < 4; ++m) {
                const int chunk = u.pm * 256 + ai * 128 + wr * 64 + m * 16 + fr; float* dst = SLOC + ((size_t)g * (NCH * 4) + chunk * 4 + ks) * 128;
#pragma unroll
                for (int n = 0; n < 2; ++n) *(ge::f32x4*)(dst + wc * 32 + 16 * n + 4 * fq) = acc[ai][0][m][n];
            }
    }
};

__device__ __forceinline__ void ph_ssm_prefix(LAS unsigned char* lds, const float* __restrict__ SLOC, const f32x2v* __restrict__ apow_l, bf16_t* __restrict__ UP) {
    PH_IDS
    const int p = TIDX & 63, w = __builtin_amdgcn_readfirstlane(TIDX >> 6);
    LAS f32x2v* ex = (LAS f32x2v*)lds;
    for (int item = BIDX; item < BATCH * G; item += GDIM) {
        const int b = item / G, g = item % G;
        const f32x2v a16 = apow_l[((size_t)g * 65 + 16) * P + p];
        const float* src = SLOC + ((size_t)g * (NCH * 4) + (size_t)b * 256 + 32 * w) * 128 + p; bf16_t* dst = UP + ((size_t)g * NCH + b * 64 + 8 * w) * UPW + p;
        float xr[32], xi[32];
#pragma unroll
        for (int k = 0; k < 32; ++k) { xr[k] = src[(size_t)k * 128]; xi[k] = src[(size_t)k * 128 + 64]; }
        float sr = 0.f, si = 0.f;
#pragma unroll
        for (int k = 0; k < 32; ++k) { const float nr = a16.x * sr - a16.y * si + xr[k], ni = a16.x * si + a16.y * sr + xi[k]; sr = nr; si = ni; }
        ex[w * 64 + p] = (f32x2v){sr, si};
        float qr = a16.x, qi = a16.y;
#pragma unroll
        for (int k = 0; k < 5; ++k) { const float nr = qr * qr - qi * qi, ni = 2.f * qr * qi; qr = nr; qi = ni; }
        __syncthreads();
        sr = 0.f; si = 0.f;
        for (int j = 0; j < w; ++j) { const f32x2v e = ex[j * 64 + p]; const float nr = qr * sr - qi * si + e.x, ni = qr * si + qi * sr + e.y; sr = nr; si = ni; }
#pragma unroll
        for (int k = 0; k < 32; ++k) {
            if ((k & 3) == 0) { bf16_t* d = dst + (size_t)(k >> 2) * UPW; d[0] = f2bf(sr); d[64] = f2bf(si); }
            const float nr = a16.x * sr - a16.y * si + xr[k], ni = a16.x * si + a16.y * sr + xi[k]; sr = nr; si = ni;
        }
        __syncthreads();
    }
}
__device__ __forceinline__ void ph_cum2(const float* __restrict__ logf, float* __restrict__ cum) {
    PH_IDS
    const int lane = TIDX & 63, gw = BIDX * 8 + __builtin_amdgcn_readfirstlane(TIDX >> 6), ngw = GDIM * 8;
    for (int item = gw; item < BATCH * NH; item += ngw) {
        const int b = item / NH, h = item % NH;
        const float* src = logf + ((size_t)b * SEQ + lane * 64) * NH + h; float* dst = cum + (size_t)item * SEQ + lane * 64;
        float tot = 0.f;
        for (int i = 0; i < 64; ++i) tot += src[(size_t)i * NH];
        float ex = tot;
#pragma unroll
        for (int o = 1; o < 64; o <<= 1) { const float y = __shfl_up(ex, o); if (lane >= o) ex += y; }
        float run = ex - tot;
        for (int i = 0; i < 64; ++i) { run += src[(size_t)i * NH]; dst[i] = run * 1.4426950408889634f; }
    }
}

struct SchedSsmC {
    static constexpr bool DUALB = true; long hA, hB, hB1;
    const char* UP; const char* WOUT; const char* KD; int G_, c;
    __device__ __forceinline__ void init(const void* up, const void* wout_l, const void* kd_l, int grid, int bid) { UP = (const char*)up; WOUT = (const char*)wout_l; KD = (const char*)kd_l; G_ = grid; c = bid; hA = 128l * UPW * 2; hB = 128l * 256; hB1 = 8l * 512; }
    __device__ __forceinline__ bool next(int i, ge::Unit& u) const {
        const int L = i * G_ + c; if (L >= G * 2 * 4) return false;
        const int pn = 3 - (L >> 6), g = (L & 63) >> 1, pm = L & 1;
        u.A0 = UP + ((size_t)g * NCH + pm * 256) * UPW * 2; u.B0 = nullptr; u.nt = 2 + 4 * (pn + 1); u.pm = pm; u.pn = pn; u.aux = g; return true; }
    __device__ __forceinline__ const char* ta(const ge::Unit& u, int t) const { return u.A0 + t * 128; }
    __device__ __forceinline__ bool sb(const ge::Unit&, int t) const { return t >= 2; }
    __device__ __forceinline__ const char* tb(const ge::Unit& u, int t) const {
        return t < 2 ? WOUT + ((size_t)u.aux * 1024 + u.pn * 256) * 256 + t * 128 : KD + ((size_t)u.aux * KDW + (size_t)(16 * u.pn - 4 * (t - 2) + 60) * 256) * 2; }
    __device__ __forceinline__ unsigned voffA(int R, int C) const { return (unsigned)(R * UPW * 2 + C * 2); }
    __device__ __forceinline__ unsigned voffB(int Rb, int C) const { return (unsigned)(Rb * 256 + C * 2); }
    __device__ __forceinline__ unsigned voffB1(int Rb, int C) const { return (unsigned)((((Rb >> 4) + 3 - (C >> 4)) * 256 + (Rb & 15) * 16 + (C & 15)) * 2); }
};
__device__ __forceinline__ float gelu_fast(float x) { const float u = 1.5957691216057308f * (x + 0.044715f * x * x * x); return x - x / (1.f + __expf(u)); }
struct EpiSsmC {
    static constexpr bool PERM = true, MIDK = false, UBEGIN = false;
    bf16_t* GEL;
    __device__ __forceinline__ void unit_begin(const ge::Unit&, int, LAS unsigned char*) const {}
    __device__ __forceinline__ void midk(ge::f32x4 (&)[2][2][4][2], const ge::Unit&, int, int, LAS unsigned char*) const {}
    __device__ __forceinline__ void operator()(const ge::f32x4 (&acc)[2][2][4][2], const ge::Unit& u, int wr, int wc, int fr, int fq, LAS unsigned char*) const {
        const int g = u.aux;
#pragma unroll
        for (int ai = 0; ai < 2; ++ai)
#pragma unroll
            for (int m = 0; m < 4; ++m) {
                const int chunk = u.pm * 256 + ai * 128 + wr * 64 + m * 16 + fr;
#pragma unroll
                for (int bj = 0; bj < 2; ++bj) {
                    const int col = u.pn * 256 + bj * 128 + wc * 32 + 8 * fq, ti = col >> 4, h0 = col & 15;
                    const ge::f32x4 v0 = acc[ai][bj][m][0], v1 = acc[ai][bj][m][1];
                    u32x4 w; w.x = ge::cvt_pk_bf16(gelu_fast(v0[0]), gelu_fast(v0[1])); w.y = ge::cvt_pk_bf16(gelu_fast(v0[2]), gelu_fast(v0[3]));
                    w.z = ge::cvt_pk_bf16(gelu_fast(v1[0]), gelu_fast(v1[1])); w.w = ge::cvt_pk_bf16(gelu_fast(v1[2]), gelu_fast(v1[3]));
                    *(u32x4*)(GEL + ((size_t)g * T + chunk * 64 + ti) * HC + h0) = w;
                }
            }
    }
};
}
namespace nv {
#define SEL_CE(x, y) do { const int _h = max((x), (y)), _l = min((x), (y)); (x) = _h; (y) = _l; } while (0)
__device__ __forceinline__ void sel_sort16(int (&v)[16]) {
    SEL_CE(v[0], v[1]);
    SEL_CE(v[2], v[3]);
    SEL_CE(v[0], v[2]);
    SEL_CE(v[1], v[3]);
    SEL_CE(v[1], v[2]);
    SEL_CE(v[4], v[5]);
    SEL_CE(v[6], v[7]);
    SEL_CE(v[4], v[6]);
    SEL_CE(v[5], v[7]);
    SEL_CE(v[5], v[6]);
    SEL_CE(v[0], v[4]);
    SEL_CE(v[2], v[6]);
    SEL_CE(v[2], v[4]);
    SEL_CE(v[1], v[5]);
    SEL_CE(v[3], v[7]);
    SEL_CE(v[3], v[5]);
    SEL_CE(v[1], v[2]);
    SEL_CE(v[3], v[4]);
    SEL_CE(v[5], v[6]);
    SEL_CE(v[8], v[9]);
    SEL_CE(v[10], v[11]);
    SEL_CE(v[8], v[10]);
    SEL_CE(v[9], v[11]);
    SEL_CE(v[9], v[10]);
    SEL_CE(v[12], v[13]);
    SEL_CE(v[14], v[15]);
    SEL_CE(v[12], v[14]);
    SEL_CE(v[13], v[15]);
    SEL_CE(v[13], v[14]);
    SEL_CE(v[8], v[12]);
    SEL_CE(v[10], v[14]);
    SEL_CE(v[10], v[12]);
    SEL_CE(v[9], v[13]);
    SEL_CE(v[11], v[15]);
    SEL_CE(v[11], v[13]);
    SEL_CE(v[9], v[10]);
    SEL_CE(v[11], v[12]);
    SEL_CE(v[13], v[14]);
    SEL_CE(v[0], v[8]);
    SEL_CE(v[4], v[12]);
    SEL_CE(v[4], v[8]);
    SEL_CE(v[2], v[10]);
    SEL_CE(v[6], v[14]);
    SEL_CE(v[6], v[10]);
    SEL_CE(v[2], v[4]);
    SEL_CE(v[6], v[8]);
    SEL_CE(v[10], v[12]);
    SEL_CE(v[1], v[9]);
    SEL_CE(v[5], v[13]);
    SEL_CE(v[5], v[9]);
    SEL_CE(v[3], v[11]);
    SEL_CE(v[7], v[15]);
    SEL_CE(v[7], v[11]);
    SEL_CE(v[3], v[5]);
    SEL_CE(v[7], v[9]);
    SEL_CE(v[11], v[13]);
    SEL_CE(v[1], v[2]);
    SEL_CE(v[3], v[4]);
    SEL_CE(v[5], v[6]);
    SEL_CE(v[7], v[8]);
    SEL_CE(v[9], v[10]);
    SEL_CE(v[11], v[12]);
    SEL_CE(v[13], v[14]);
}
__device__ __forceinline__ void sel_merge16(int (&a)[16], const int (&b)[16]) {
    a[0] = max(a[0], b[15]);
    a[1] = max(a[1], b[14]);
    a[2] = max(a[2], b[13]);
    a[3] = max(a[3], b[12]);
    a[4] = max(a[4], b[11]);
    a[5] = max(a[5], b[10]);
    a[6] = max(a[6], b[9]);
    a[7] = max(a[7], b[8]);
    a[8] = max(a[8], b[7]);
    a[9] = max(a[9], b[6]);
    a[10] = max(a[10], b[5]);
    a[11] = max(a[11], b[4]);
    a[12] = max(a[12], b[3]);
    a[13] = max(a[13], b[2]);
    a[14] = max(a[14], b[1]);
    a[15] = max(a[15], b[0]);
    SEL_CE(a[0], a[8]);
    SEL_CE(a[1], a[9]);
    SEL_CE(a[2], a[10]);
    SEL_CE(a[3], a[11]);
    SEL_CE(a[4], a[12]);
    SEL_CE(a[5], a[13]);
    SEL_CE(a[6], a[14]);
    SEL_CE(a[7], a[15]);
    SEL_CE(a[0], a[4]);
    SEL_CE(a[1], a[5]);
    SEL_CE(a[2], a[6]);
    SEL_CE(a[3], a[7]);
    SEL_CE(a[8], a[12]);
    SEL_CE(a[9], a[13]);
    SEL_CE(a[10], a[14]);
    SEL_CE(a[11], a[15]);
    SEL_CE(a[0], a[2]);
    SEL_CE(a[1], a[3]);
    SEL_CE(a[4], a[6]);
    SEL_CE(a[5], a[7]);
    SEL_CE(a[8], a[10]);
    SEL_CE(a[9], a[11]);
    SEL_CE(a[12], a[14]);
    SEL_CE(a[13], a[15]);
    SEL_CE(a[0], a[1]);
    SEL_CE(a[2], a[3]);
    SEL_CE(a[4], a[5]);
    SEL_CE(a[6], a[7]);
    SEL_CE(a[8], a[9]);
    SEL_CE(a[10], a[11]);
    SEL_CE(a[12], a[13]);
    SEL_CE(a[14], a[15]);
}
constexpr int SEL_NCAND = 50;
#define SEL_CANDS(F) \
    F(0, 0, 0) \
    F(1, 0, 1) \
    F(2, 0, 2) \
    F(3, 0, 3) \
    F(4, 0, 4) \
    F(5, 0, 5) \
    F(6, 0, 6) \
    F(7, 0, 7) \
    F(8, 0, 8) \
    F(9, 0, 9) \
    F(10, 0, 10) \
    F(11, 0, 11) \
    F(12, 0, 12) \
    F(13, 0, 13) \
    F(14, 0, 14) \
    F(15, 0, 15) \
    F(16, 1, 0) \
    F(17, 1, 1) \
    F(18, 1, 2) \
    F(19, 1, 3) \
    F(20, 1, 4) \
    F(21, 1, 5) \
    F(22, 1, 6) \
    F(23, 1, 7) \
    F(24, 2, 0) \
    F(25, 2, 1) \
    F(26, 2, 2) \
    F(27, 2, 3) \
    F(28, 2, 4) \
    F(29, 3, 0) \
    F(30, 3, 1) \
    F(31, 3, 2) \
    F(32, 3, 3) \
    F(33, 4, 0) \
    F(34, 4, 1) \
    F(35, 4, 2) \
    F(36, 5, 0) \
    F(37, 5, 1) \
    F(38, 6, 0) \
    F(39, 6, 1) \
    F(40, 7, 0) \
    F(41, 7, 1) \
    F(42, 8, 0) \
    F(43, 9, 0) \
    F(44, 10, 0) \
    F(45, 11, 0) \
    F(46, 12, 0) \
    F(47, 13, 0) \
    F(48, 14, 0) \
    F(49, 15, 0)
constexpr float SEL_BIAS = 16.f;
__device__ __forceinline__ int f2key(float f) { return __float_as_int(f); }
__device__ __forceinline__ float key2f(int k) { return __int_as_float(k); }
__device__ __forceinline__ void sel_top16(const f32x16 (&acc)[4], int hi, int (&t)[16]) {
    int g1[16], g2[16], g3[16];
#pragma unroll
    for (int r = 0; r < 16; ++r) { const int n = (r & 3) + 8 * (r >> 2) + 4 * hi;
        t[r] = (f2key(acc[0][r]) & ~0x7F) | n; g1[r] = (f2key(acc[1][r]) & ~0x7F) | (32 + n); g2[r] = (f2key(acc[2][r]) & ~0x7F) | (64 + n); g3[r] = (f2key(acc[3][r]) & ~0x7F) | (96 + n); }
    sel_sort16(t); sel_sort16(g1); sel_sort16(g2); sel_sort16(g3);
    sel_merge16(t, g1); sel_merge16(g2, g3); sel_merge16(t, g2);
#pragma unroll
    for (int i = 0; i < 16; ++i) { auto rr = __builtin_amdgcn_permlane32_swap((unsigned)t[i], (unsigned)t[i], false, false); g1[i] = (int)(hi ? rr[0] : rr[1]); }
    sel_merge16(t, g1);
}
__device__ __forceinline__ void ph_select(const bf16_t* __restrict__ QP, const bf16_t* __restrict__ KEYS, unsigned short* __restrict__ idx, float* __restrict__ gate, LAS unsigned char* lds) {
    PH_IDS
    const int lane = TIDX & 63, hd = __builtin_amdgcn_readfirstlane(TIDX >> 6), r = lane & 31, hi = lane >> 5;
    LAS unsigned* my = (LAS unsigned*)(lds + hd * 2048) + lane;
    for (int tg = BIDX; tg < T / 32; tg += GDIM) {
        const int tok0 = tg * 32;
        int rk = r; asm volatile("" : "+v"(rk));
        int t1[16], t2[16];
#pragma unroll
        for (int half = 0; half < 2; ++half) {
            f32x16 acc[4];
#pragma unroll
            for (int mt = 0; mt < 4; ++mt)
#pragma unroll
                for (int i = 0; i < 16; ++i) acc[mt][i] = SEL_BIAS;
            const bf16_t* qb = QP + (size_t)(tok0 + r) * D + hd * QD + half * HALF + 8 * hi;
            const bf16_t* kb = KEYS + ((size_t)(hd * 2 + half) * NK + rk) * HALF + 8 * hi;
#pragma unroll
            for (int ks = 0; ks < 4; ++ks) {
                const bf16x8 b = *(const bf16x8*)(qb + 16 * ks);
#pragma unroll
                for (int mt = 0; mt < 4; ++mt) { const bf16x8 a = *(const bf16x8*)(kb + (size_t)mt * 32 * HALF + 16 * ks); acc[mt] = __builtin_amdgcn_mfma_f32_32x32x16_bf16(a, b, acc[mt], 0, 0, 0); }
            }
            if (half == 0) sel_top16(acc, hi, t1); else sel_top16(acc, hi, t2);
        }
        float f1[16], f2[16];
#pragma unroll
        for (int i = 0; i < 16; ++i) { f1[i] = key2f(t1[i]); f2[i] = key2f(t2[i]); }
        int c0[16], c1[16], c2[16], c3[16];
#pragma unroll
        for (int i = 0; i < 16; ++i) c3[i] = (int)0x80000000;
#define SEL_F(k, i, j) { const int v_ = (f2key(f1[i] + f2[j]) & ~0xFF) | ((i) << 4 | (j)); if ((k) < 16) c0[(k) & 15] = v_; else if ((k) < 32) c1[(k) & 15] = v_; else if ((k) < 48) c2[(k) & 15] = v_; else c3[(k) & 15] = v_; }
        SEL_CANDS(SEL_F)
#undef SEL_F
          sel_sort16(c1); sel_sort16(c2); SEL_CE(c3[0], c3[1]);
        sel_merge16(c0, c1); sel_merge16(c2, c3); sel_merge16(c0, c2);
#pragma unroll
        for (int j = 0; j < 4; ++j) {
            my[64 * j] = (unsigned)(t1[4 * j] & 0x7F) | ((unsigned)(t1[4 * j + 1] & 0x7F) << 8) | ((unsigned)(t1[4 * j + 2] & 0x7F) << 16) | ((unsigned)(t1[4 * j + 3] & 0x7F) << 24);
            my[64 * (4 + j)] = (unsigned)(t2[4 * j] & 0x7F) | ((unsigned)(t2[4 * j + 1] & 0x7F) << 8) | ((unsigned)(t2[4 * j + 2] & 0x7F) << 16) | ((unsigned)(t2[4 * j + 3] & 0x7F) << 24);
        }
        const float mx = key2f(c0[0]); float e[16], se = 0.f;
#pragma unroll
        for (int k = 0; k < 16; ++k) { e[k] = __expf(key2f(c0[k]) - mx); se += e[k]; }
        const float inv = 1.f / se;
        asm volatile("s_waitcnt lgkmcnt(0)" ::: "memory");
        const size_t o = (size_t)(tok0 + r) * 128 + hd * TOPK;
        if (hi == 0) {
            int id[16];
#pragma unroll
            for (int k = 0; k < 16; ++k) { const int code = c0[k] & 0xFF, i = code >> 4, j = code & 15;
                const unsigned w1 = my[64 * (i >> 2)], w2 = my[64 * (4 + (j >> 2))];
                id[k] = (int)((w1 >> (8 * (i & 3))) & 0x7F) * NK + (int)((w2 >> (8 * (j & 3))) & 0x7F); }
            u32x4 w0, w1;
#pragma unroll
            for (int k = 0; k < 4; ++k) { w0[k] = (unsigned)id[2 * k] | ((unsigned)id[2 * k + 1] << 16); w1[k] = (unsigned)id[8 + 2 * k] | ((unsigned)id[9 + 2 * k] << 16); }
            *(u32x4*)(idx + o) = w0; *(u32x4*)(idx + o + 8) = w1;
        } else {
#pragma unroll
            for (int k = 0; k < 4; ++k) *(float4*)(gate + o + 4 * k) = make_float4(e[4 * k] * inv, e[4 * k + 1] * inv, e[4 * k + 2] * inv, e[4 * k + 3] * inv);
        }
        asm volatile("s_waitcnt lgkmcnt(0)" ::: "memory");
    }
}
}
#ifndef PROBE_MASK
#define PROBE_MASK 0
#endif
#define REPS(bit) (((PROBE_MASK >> (bit)) & 1) ? 2 : 1)
namespace nv {
constexpr int LDS_BYTES = 147456, MISC_OFF = 131072 + 320;
struct Params { const float* in[23]; float* out; unsigned char* ws; };

__global__ void __launch_bounds__(512, 2) k_mega(Params prm) {
    extern __shared__ __attribute__((aligned(16))) unsigned char lds_raw[];
    namespace cg = cooperative_groups;
    cg::grid_group grid = cg::this_grid();
    LAS unsigned char* lds = (LAS unsigned char*)lds_raw;
    unsigned char* smem = lds_raw;
    for (int u = threadIdx.x; u < (LDS_BYTES - 131072) / 4; u += 512) ((LAS unsigned*)(lds + 131072))[u] = 0u;
    __syncthreads();
    if (threadIdx.x == 0) {
        LAS unsigned long long* tab = (LAS unsigned long long*)(lds + TAB_OFF);
#pragma unroll
        for (int i = 0; i < 23; ++i) tab[i] = (unsigned long long)prm.in[i];
        tab[23] = (unsigned long long)prm.out; tab[24] = (unsigned long long)prm.ws;
    }
    __syncthreads();
#define ARG(i) ((const float*)ldarg(lds, (i)))
#define WSP() ((unsigned char*)ldarg(lds, 24))
    XcdBarrier bar = xcd_barrier_post((unsigned*)(WSP() + WS_CTL) + CW_BAR, (volatile LAS unsigned*)(lds + MISC_OFF) + 8);
#define GRID_BAR() do { xcd_barrier(bar); asm volatile("" ::: "memory"); } while (0)
    if (threadIdx.x == 0) { volatile LAS unsigned* M = (volatile LAS unsigned*)(lds + MISC_OFF); M[16] = bar.x; M[17] = xb_add((unsigned*)(WSP() + WS_CTL) + CW_RANK + 64 * bar.x, 1u); }
    for (int rep = 0; rep < REPS(0); ++rep) {
    p0_prologue(lds);
    { unsigned char* ws = WSP(); p0_peer_tables(ARG(20), ARG(21), ARG(17), ws + WS_PU, ws + WS_PV8); }
    { unsigned char* ws = WSP(); const float* pk = ARG(19); bf16_t* kb = (bf16_t*)(ws + WS_KEYS); for (int i = obid() * 512 + otid(); i < DEPTH * PH * 2 * NK * HALF; i += ogrid() * 512) kb[i] = f2bf(pk[i]); }
    { unsigned char* ws = WSP(); p0_ssm_a(ARG(3), ARG(4), ARG(5), ARG(6), ARG(7), (f32x2v*)(ws + WS_APOW), (f32x2v*)(ws + WS_BBAR)); }
    }
    GRID_BAR();
    if (threadIdx.x == 0) {
        volatile LAS unsigned* M = (volatile LAS unsigned*)(lds + MISC_OFF); unsigned* bw = (unsigned*)(WSP() + WS_CTL) + CW_BAR; unsigned tot = 0u, ok = 1u;
        for (unsigned j = 0; j < 16; ++j) { const unsigned cnt = xb_ld(&bw[XB_XCNT(j)]); tot += cnt; if ((j < 8) != (cnt > 0u)) ok = 0u; }
        M[18] = xb_ld(&bw[XB_XCNT(bar.x)]); M[19] = (ok && tot == gridDim.x) ? 1u : 0u;
    }
    __syncthreads();
    { unsigned char* ws = WSP(); p0_ssm_b((const f32x2v*)(ws + WS_APOW), (const f32x2v*)(ws + WS_BBAR), ARG(8), ARG(9), ARG(10), (bf16_t*)(ws + WS_KD), (bf16_t*)(ws + WS_WST), (bf16_t*)(ws + WS_WOUT)); }
    grid.sync();
#pragma nounroll
    for (int l_ = 0; l_ < DEPTH; ++l_) {
        int l = l_; asm volatile("" : "+s"(l));
        {
            unsigned char* ws = WSP(); bf16_t* hb = (bf16_t*)(ws + WS_HB); float* ss1 = (float*)(ws + WS_SSP) + (size_t)T * 32;
            for (int rep = 0; rep < REPS(1); ++rep) {
            SchedGen S; S.init_plain(hb, D * 2, (const bf16_t*)(ws + WS_BT1) + (size_t)l * 2048 * D, D * 2, T, 2048, D, ogrid(), obid());
            EpiInProj E{ss1, (bf16_t*)(ws + WS_UP), (bf16_t*)(ws + WS_Q)};
            ge::gemm_phase<EpiInProj, SchedGen>(lds, S, E, otid());
            }
            for (int rep = 0; rep < REPS(2); ++rep)
            ph_flogit(hb, (const bf16_t*)(ws + WS_WF) + (size_t)l * 16 * D, ss1, ARG(13) + l * NH, (float*)(ws + WS_LOGF));
        }
        GRID_BAR();
        {
            unsigned char* ws = WSP();
            for (int rep = 0; rep < REPS(3); ++rep) {
            SchedSsmS S; S.init(ws + WS_UP, (const bf16_t*)(ws + WS_WST) + (size_t)l * G * 128 * 256, ogrid(), obid());
            EpiSsmS E{(float*)(ws + WS_SLOC)};
            ge::gemm_phase<EpiSsmS, SchedSsmS>(lds, S, E, otid());
            }
            for (int rep = 0; rep < REPS(4); ++rep)
            ph_cum2((const float*)(ws + WS_LOGF), (float*)(ws + WS_CUM));
        }
        GRID_BAR();
        for (int rep = 0; rep < REPS(5); ++rep)
        { unsigned char* ws = WSP(); ph_ssm_prefix(lds, (const float*)(ws + WS_SLOC), (const f32x2v*)(ws + WS_APOW) + (size_t)l * G * 65 * P, (bf16_t*)(ws + WS_UP)); }
        GRID_BAR();
        {
            unsigned char* ws = WSP(); float* ssp_s = (float*)(ws + WS_SSP); float* ssp_a = ssp_s + (size_t)T * 8;
            for (int rep = 0; rep < REPS(6); ++rep)
            {
                SchedSsmC S; S.init(ws + WS_UP, (const bf16_t*)(ws + WS_WOUT) + (size_t)l * G * 1024 * 128, (const bf16_t*)(ws + WS_KD) + (size_t)l * G * KDW, ogrid(), obid());
                EpiSsmC E{(bf16_t*)(ws + WS_GEL)};
                ge::gemm_phase<EpiSsmC, SchedSsmC>(lds, S, E, otid());
            }
            for (int rep = 0; rep < REPS(7); ++rep)
            attn_body::attn_phase<8>((char*)lds_raw, (const attn_body::bf16*)(ws + WS_Q), (const attn_body::bf16*)(ws + WS_K), (const attn_body::bf16*)(ws + WS_V), (const float*)(ws + WS_CUM), (attn_body::bf16*)(ws + WS_MIX), ssp_a, (unsigned*)(ws + WS_CTL) + CW_QUEUE + 64 * (l * 2 + rep), (volatile LAS unsigned*)(lds + MISC_OFF) + 24, otid());
            GRID_BAR();
            for (int rep = 0; rep < REPS(8); ++rep) {
            SchedGen S; S.init_plain(ws + WS_GEL, 32, (const bf16_t*)(ws + WS_BT2) + (size_t)l * SSMW * SSMW, SSMW * 2, T, SSMW, SSMW, ogrid(), obid());
            S.a_c16_b = T * 32; S.a_kt_b = 4l * T * 32;
            EpiGlu2 E{(const bf16_t*)(ws + WS_GEL), ARG(12) + l * SSMW, (bf16_t*)(ws + WS_MIX), ssp_s};
            ge::gemm_phase<EpiGlu2, SchedGen>(lds, S, E, otid());
            }
        }
        GRID_BAR();
        {
            unsigned char* ws = WSP(); float* ssp_s = (float*)(ws + WS_SSP); float* ssp_a = ssp_s + (size_t)T * 8; float* ssp_2 = ssp_a + (size_t)T * 8;
            for (int rep = 0; rep < REPS(9); ++rep) {
            const bool dummy = rep + 1 < REPS(9);
            SchedGen S; S.init_plain(ws + WS_MIX, D * 2, (const bf16_t*)(ws + WS_BT3) + (size_t)l * D * D, D * 2, T, D, D, ogrid(), obid());
            EpiWo E{ssp_s, ssp_a, (const bf16_t*)(ws + WS_HB), dummy ? (bf16_t*)(ws + WS_QP) : (bf16_t*)(ws + WS_HB), dummy ? (float*)(ws + WS_SLOC) : ssp_2};
            ge::gemm_phase<EpiWo, SchedGen>(lds, S, E, otid());
            }
        }
        GRID_BAR();
        {
            unsigned char* ws = WSP(); float* ssp_2 = (float*)(ws + WS_SSP) + (size_t)T * 16;
            for (int rep = 0; rep < REPS(10); ++rep) {
            SchedGen S; S.init_plain(ws + WS_HB, D * 2, (const bf16_t*)(ws + WS_BT4) + (size_t)l * D * D, D * 2, T, D, D, ogrid(), obid());
            EpiWq E{ssp_2, (bf16_t*)(ws + WS_QP)};
            ge::gemm_phase<EpiWq, SchedGen>(lds, S, E, otid());
            }
        }
        GRID_BAR();
        for (int rep = 0; rep < REPS(11); ++rep)
        { unsigned char* ws = WSP(); ph_select((const bf16_t*)(ws + WS_QP), (const bf16_t*)(ws + WS_KEYS) + (size_t)l * PH * 2 * NK * HALF, (unsigned short*)(ws + WS_IDX), (float*)(ws + WS_GATE), lds); }
        GRID_BAR();
        if (PROBE_MASK & (1 << 18)) { unsigned char* ws = WSP(); ph_peer_u<2>(lds, ws + WS_PU + (size_t)l * NEXP * D, (const bf16_t*)(ws + WS_HB), (const unsigned short*)(ws + WS_IDX), (bf16_t*)(ws + WS_UP)); }
        if (PROBE_MASK & (1 << 19)) { unsigned char* ws = WSP(); ph_peer_u<3>(lds, ws + WS_PU + (size_t)l * NEXP * D, (const bf16_t*)(ws + WS_HB), (const unsigned short*)(ws + WS_IDX), (bf16_t*)(ws + WS_UP)); }
        if (PROBE_MASK & (1 << 20)) { unsigned char* ws = WSP(); ph_peer_u<2>(lds, ws + WS_PU + (size_t)l * NEXP * D, (const bf16_t*)(ws + WS_HB), (const unsigned short*)(ws + WS_IDX), (bf16_t*)(ws + WS_UP), 127); }
        if (PROBE_MASK & (1 << 21)) { unsigned char* ws = WSP(); ph_peer_u<5>(lds, ws + WS_PU + (size_t)l * NEXP * D, (const bf16_t*)(ws + WS_HB), (const unsigned short*)(ws + WS_IDX), (bf16_t*)(ws + WS_UP)); }
        if (PROBE_MASK & (1 << 22)) { unsigned char* ws = WSP(); ph_peer_u<6>(lds, ws + WS_PU + (size_t)l * NEXP * D, (const bf16_t*)(ws + WS_HB), (const unsigned short*)(ws + WS_IDX), (bf16_t*)(ws + WS_UP)); }
        if (PROBE_MASK & (1 << 23)) { unsigned char* ws = WSP(); ph_peer_u<7>(lds, ws + WS_PU + (size_t)l * NEXP * D, (const bf16_t*)(ws + WS_HB), (const unsigned short*)(ws + WS_IDX), (bf16_t*)(ws + WS_UP)); }
        if (PROBE_MASK & (1 << 16)) { unsigned char* ws = WSP(); ph_peer_u<0>(lds, ws + WS_PU + (size_t)l * NEXP * D, (const bf16_t*)(ws + WS_HB), (const unsigned short*)(ws + WS_IDX), (bf16_t*)(ws + WS_UP), 1023); }
        for (int rep = 0; rep < REPS(12); ++rep)
        { unsigned char* ws = WSP(); ph_peer_u<0>(lds, ws + WS_PU + (size_t)l * NEXP * D, (const bf16_t*)(ws + WS_HB), (const unsigned short*)(ws + WS_IDX), (bf16_t*)(ws + WS_PART)); }
        GRID_BAR();
        for (int rep = 0; rep < REPS(13); ++rep)
        { unsigned char* ws = WSP(); ph_peer_coef((const bf16_t*)(ws + WS_PART), (const float*)(ws + WS_SSP) + (size_t)T * 16, (const float*)(ws + WS_GATE), (unsigned short*)(ws + WS_COEF)); }
        GRID_BAR();
        if (PROBE_MASK & (1 << 17)) { unsigned char* ws = WSP();
          ph_peer_v<0>(lds, ws + WS_PV8 + (size_t)l * NEXP * D, (const unsigned short*)(ws + WS_IDX), (const unsigned short*)(ws + WS_COEF), (const bf16_t*)(ws + WS_HB), (bf16_t*)(ws + WS_UP), (float*)(ws + WS_SLOC), 1023); }
        for (int rep = 0; rep < REPS(14); ++rep)
        { unsigned char* ws = WSP(); const bool dummy = rep + 1 < REPS(14);
          ph_peer_v<0>(lds, ws + WS_PV8 + (size_t)l * NEXP * D, (const unsigned short*)(ws + WS_IDX), (const unsigned short*)(ws + WS_COEF), (const bf16_t*)(ws + WS_HB),
                    dummy ? (bf16_t*)(ws + WS_UP) : (bf16_t*)(ws + WS_HB), dummy ? (float*)(ws + WS_SLOC) : (float*)(ws + WS_SSP) + (size_t)T * 32); }
        if (PROBE_MASK & (1 << 15)) { for (int rep = 0; rep < 8; ++rep) GRID_BAR(); }
        GRID_BAR();
    }
    { unsigned char* ws = WSP(); ph_final((const bf16_t*)(ws + WS_HB), (const float*)(ws + WS_SSP) + (size_t)T * 32, ARG(22), (float*)ldarg(lds, 23)); }
}
}

extern "C" void kernel_launch(void* const* d_in, const int* in_sizes, int n_in, void* d_out, int out_size, void* d_ws, size_t ws_size, hipStream_t stream) {
    using namespace nv;
    static int grid_blocks = 0;
    if (!grid_blocks) {
        int dev = 0, cus = 0, per_cu = 0;
        (void)hipGetDevice(&dev);
        (void)hipDeviceGetAttribute(&cus, hipDeviceAttributeMultiprocessorCount, dev);
        if (hipFuncSetAttribute((const void*)k_mega, hipFuncAttributeMaxDynamicSharedMemorySize, LDS_BYTES) != hipSuccess) { fprintf(stderr, "hipFuncSetAttribute failed\n"); grid_blocks = -1; return; }
        (void)hipOccupancyMaxActiveBlocksPerMultiprocessor(&per_cu, (const void*)k_mega, 512, LDS_BYTES);
        if (per_cu < 1) { fprintf(stderr, "occupancy query returned %d\n", per_cu); (void)hipGetLastError(); }
        grid_blocks = cus;
    }
    if (grid_blocks < 0) return;
    if (ws_size < WS_END || n_in != 23) { fprintf(stderr, "bad workspace / inputs\n"); return; }
    (void)hipMemsetAsync((char*)d_ws + WS_CTL, 0, CTL_BYTES, stream);
    Params p{};
    for (int i = 0; i < 23; ++i) p.in[i] = (const float*)d_in[i];
    p.out = (float*)d_out; p.ws = (unsigned char*)d_ws;
    void* args[] = {&p};
    hipError_t e = hipLaunchCooperativeKernel((const void*)k_mega, dim3(grid_blocks), dim3(512), args, LDS_BYTES, stream);
    if (e != hipSuccess) fprintf(stderr, "cooperative launch failed: %s (grid %d)\n", hipGetErrorString(e), grid_blocks);
}
```

```cpp
#include <hip/hip_runtime.h>
#include <hip/hip_cooperative_groups.h>
#include <hip/hip_bf16.h>
#include <cstdint>
#include <cstdio>

#define LAS __attribute__((address_space(3)))
#define GAS __attribute__((address_space(1)))

namespace nv {
constexpr int D = 1024, BATCH = 8, SEQ = 4096, DEPTH = 4, T = BATCH * SEQ;
constexpr int SSMW = 512, G = 32, HC = 16, P = 64, ATTW = 512, HD = 64, NH = 8, INW = 2056;
constexpr int PH = 8, NK = 128, TOPK = 16, QD = 128, HALF = 64, NEXP = 16384;
constexpr int CHUNK = 64, NCH = T / CHUNK  , UPW = 128 + CHUNK * HC  ;
constexpr float EPS = 1e-6f;

typedef short bf16x8 __attribute__((ext_vector_type(8)));
typedef float f32x16 __attribute__((ext_vector_type(16)));
typedef float f32x4 __attribute__((ext_vector_type(4)));
typedef unsigned u32x4 __attribute__((ext_vector_type(4)));
typedef unsigned short bf16_t;

constexpr size_t MiB = 1u << 20;
constexpr size_t WS_CTL = 0, CTL_BYTES = 4 * MiB;
constexpr size_t WS_BT1 = 4 * MiB;
constexpr size_t WS_BT2 = 20 * MiB;
constexpr size_t WS_BT3 = 22 * MiB;
constexpr size_t WS_BT4 = 30 * MiB;
constexpr size_t WS_WF = 38 * MiB;
constexpr size_t WS_KEYS = 39 * MiB;
constexpr size_t WS_KD = 40 * MiB, WS_WOUT = 49 * MiB, WS_WST = 81 * MiB;
constexpr size_t WS_PU = 90 * MiB, WS_PV8 = 154 * MiB;
constexpr size_t WS_PART = 218 * MiB;
constexpr size_t WS_H = 346 * MiB;
constexpr size_t WS_HB = 474 * MiB;
constexpr size_t WS_UP = 538 * MiB;
constexpr size_t WS_Q = 576 * MiB, WS_K = 608 * MiB, WS_V = 640 * MiB;
constexpr size_t WS_LOGF = 672 * MiB, WS_CUM = 673 * MiB;
constexpr size_t WS_SLOC = 674 * MiB, WS_GEL = 708 * MiB, WS_MIX = 740 * MiB;
constexpr size_t WS_SSP = 916 * MiB;
constexpr size_t WS_QP = 852 * MiB;
constexpr size_t WS_IDX = 804 * MiB, WS_GATE = 820 * MiB, WS_COEF = 836 * MiB;
constexpr size_t WS_XN_F = 90 * MiB, WS_MIXED_F = 218 * MiB, WS_QP_F = 852 * MiB, WS_GEL_F = 90 * MiB  , WS_YSSM_F = 740 * MiB, WS_YATT_F = 674 * MiB;
constexpr size_t WS_END = 980 * MiB;
constexpr int CW_QUEUE = 1024;
constexpr int CW_RANK = 2048;
constexpr int CW_BAR = 4096;
constexpr int CW_SS = 65536;
constexpr int SS_H1 = 0  , SS_H2 = 5  , SS_SSM = 9, SS_ATT = 13;
static_assert((size_t)(CW_SS + 17 * T) * 4 <= CTL_BYTES, "ctl region");

__device__ __forceinline__ unsigned short f2bf(float f) { unsigned u = __float_as_uint(f); return (unsigned short)((u + 0x7fffu + ((u >> 16) & 1u)) >> 16); }
__device__ __forceinline__ float bf2f(unsigned short b) { return __uint_as_float(((unsigned)b) << 16); }
__device__ __forceinline__ unsigned pk2(float lo, float hi) { return (unsigned)f2bf(lo) | ((unsigned)f2bf(hi) << 16); }
__device__ __forceinline__ float gelu_tanh(float x) { const float u = 0.7978845608028654f * (x + 0.044715f * x * x * x); return 0.5f * x * (1.f + tanhf(u)); }
__device__ __forceinline__ float wave_sum(float v) {
#pragma unroll
    for (int o = 1; o < 64; o <<= 1) v += __shfl_xor(v, o);
    return v;
}
__device__ __forceinline__ int otid() { int t = threadIdx.x; asm volatile("" : "+v"(t)); return t; }
__device__ __forceinline__ int obid() { int t = blockIdx.x; asm volatile("" : "+s"(t)); return t; }
__device__ __forceinline__ int ogrid() { int t = gridDim.x; asm volatile("" : "+s"(t)); return t; }
#define PH_IDS const int TIDX = otid(), BIDX = obid(), GDIM = ogrid(); (void)TIDX; (void)BIDX; (void)GDIM;
__device__ __forceinline__ size_t up_index(int row, int c) { const int n = row >> 6, j = row & 63, g = c >> 4, hh = c & 15; return ((size_t)g * NCH + n) * UPW + 128 + j * HC + hh; }
}
namespace ge {
#define GE_LAS __attribute__((address_space(3)))
typedef unsigned short bf16_t;
typedef short bf16x8 __attribute__((ext_vector_type(8)));
typedef float f32x4 __attribute__((ext_vector_type(4)));
typedef unsigned u32x4 __attribute__((ext_vector_type(4)));
typedef unsigned u32x2 __attribute__((ext_vector_type(2)));
constexpr int ROWF_OFF = 131072 + 4096;
constexpr int BM = 256, BK = 64, HALF = 128, HTB = HALF * BK * 2  , STAGE_BYTES = 8 * HTB, NXCD = 8, WGM = 8;

__host__ __device__ __forceinline__ int lds_byte(int r, int c) { const int st = (r >> 4) * 2 + (c >> 5), rr = r & 15, cc = c & 31, ob = rr * 64 + cc * 2; return st * 1024 + (ob ^ (((ob >> 9) & 1) << 5)); }
__host__ __device__ __forceinline__ void stage_rc(int b, int& R, int& C) { const int st = b / 1024, sb = b % 1024, swz = sb ^ (((sb >> 9) & 1) << 5); R = (st >> 1) * 16 + swz / 64; C = (st & 1) * 32 + (swz % 64) / 2; }
__host__ __device__ __forceinline__ int perm32(int rho) { const int n = rho >> 4, i = rho & 15; return 8 * (i >> 2) + 4 * n + (i & 3); }

struct Unit { const char* A0; const char* B0; int nt; int pm, pn, aux; };
__device__ __forceinline__ unsigned cvt_pk_bf16(float lo, float hi) { unsigned r; asm volatile("v_cvt_pk_bf16_f32 %0, %1, %2" : "=v"(r) : "v"(lo), "v"(hi)); return r; }

__device__ __forceinline__ bool static_tile(int i, int G, int c, int nM, int nN, int& pm, int& pn) {
    const int nwg = nM * nN; const long L = (long)i * G + c; if (L >= nwg) return false;
    int wgid = (int)L; { const int q = nwg / NXCD, r = nwg % NXCD, xcd = wgid % NXCD, off = wgid / NXCD; wgid = (xcd < r ? xcd * (q + 1) : r * (q + 1) + (xcd - r) * q) + off; }
    const int nig = WGM * nN, gid = wgid / nig, fm = gid * WGM, gsz = (nM - fm) < WGM ? (nM - fm) : WGM;
    pm = fm + ((wgid % nig) % gsz); pn = (wgid % nig) / gsz; return true;
}

template <class Epi, class Sched>
__device__ __forceinline__ void gemm_phase(GE_LAS unsigned char* lds, const Sched& S, const Epi& E, int tid) {
    const int wid = __builtin_amdgcn_readfirstlane(tid >> 6), lane = tid & 63, wr = wid >> 2, wc = wid & 3, fr = lane & 15, fq = lane >> 4;
    unsigned voffA[2], voffB[2], voffB1[2];
#pragma unroll
    for (int i = 0; i < 2; ++i) { int R, C; stage_rc(tid * 16 + i * 8192, R, C); const int Rb = Epi::PERM ? ((R & ~31) + perm32(R & 31)) : R;
        voffA[i] = S.voffA(R, C); voffB[i] = S.voffB(Rb, C); if constexpr (Sched::DUALB) voffB1[i] = S.voffB1(Rb, C); else voffB1[i] = 0u; }
    const long hA = S.hA, hB = S.hB;
    const unsigned ldsw = (unsigned)wid * 1024u;
    const int aoff = lds_byte(wr * 64 + fr, fq * 8), boff = lds_byte(wc * 32 + fr, fq * 8);
#define GE_SA(b, h) (((b) * 2 + (h)) * HTB)
#define GE_SB(b, h) ((4 + (b) * 2 + (h)) * HTB)
#define GE_STAGE(bufoff, gbase, voff) do { _Pragma("unroll") for (int _i = 0; _i < 2; ++_i) \
        __builtin_amdgcn_global_load_lds((const unsigned*)((const char*)(gbase) + (voff)[_i]), (GE_LAS unsigned*)(lds + (bufoff) + ldsw + _i * 8192), 16, 0, 0); } while (0)
#define GE_STAGE_B(bufoff, gbase, sel, half) do { if constexpr (Sched::DUALB) { const char* _g = (const char*)(gbase) + ((half) ? ((sel) ? S.hB1 : hB) : 0l); _Pragma("unroll") for (int _i = 0; _i < 2; ++_i) { const unsigned _v = (sel) ? voffB1[_i] : voffB[_i]; \
        __builtin_amdgcn_global_load_lds((const unsigned*)(_g + _v), (GE_LAS unsigned*)(lds + (bufoff) + ldsw + _i * 8192), 16, 0, 0); } } else { GE_STAGE(bufoff, (const char*)(gbase) + ((half) ? hB : 0l), voffB); } } while (0)
#define GE_LDA(dst, b, h) do { _Pragma("unroll") for (int m = 0; m < 4; ++m) _Pragma("unroll") for (int k = 0; k < 2; ++k) dst[m][k] = *(const GE_LAS bf16x8*)(lds + GE_SA(b, h) + aoff + m * 2048 + k * 1024); } while (0)
#define GE_LDB(dst, b, h) do { _Pragma("unroll") for (int n = 0; n < 2; ++n) _Pragma("unroll") for (int k = 0; k < 2; ++k) dst[n][k] = *(const GE_LAS bf16x8*)(lds + GE_SB(b, h) + boff + n * 2048 + k * 1024); } while (0)
#define GE_MMA(ai, bj, At, Bt) do { __builtin_amdgcn_s_setprio(1); _Pragma("unroll") for (int m = 0; m < 4; ++m) _Pragma("unroll") for (int n = 0; n < 2; ++n) _Pragma("unroll") for (int k = 0; k < 2; ++k) \
        acc[ai][bj][m][n] = __builtin_amdgcn_mfma_f32_16x16x32_bf16(Bt[n][k], At[m][k], acc[ai][bj][m][n], 0, 0, 0); __builtin_amdgcn_s_setprio(0); } while (0)
#define GE_WAIT_V(n) asm volatile("s_waitcnt vmcnt(" #n ")" ::: "memory")
#define GE_WAIT_L(n) asm volatile("s_waitcnt lgkmcnt(" #n ")" ::: "memory")
#define GE_BAR __builtin_amdgcn_s_barrier()
#define GE_SCHED __builtin_amdgcn_sched_barrier(0)
    Unit cur, nxt; int ui = 0;
    if (!S.next(0, cur)) return;
    f32x4 acc[2][2][4][2];
#pragma unroll
    for (int a = 0; a < 2; ++a)
#pragma unroll
        for (int b = 0; b < 2; ++b)
#pragma unroll
            for (int m = 0; m < 4; ++m)
#pragma unroll
                for (int n = 0; n < 2; ++n) acc[a][b][m][n] = (f32x4){0.f, 0.f, 0.f, 0.f};
    bf16x8 At[4][2], B0[2][2], B1[2][2];
    if constexpr (Epi::UBEGIN) E.unit_begin(cur, tid, lds + ROWF_OFF);
    {
        const char* a0 = S.ta(cur, 0); const char* b0 = S.tb(cur, 0); const char* a1 = S.ta(cur, 1); const char* b1 = S.tb(cur, 1);
        const bool s0 = S.sb(cur, 0), s1 = S.sb(cur, 1);
        GE_STAGE_B(GE_SB(0, 0), b0, s0, 0); GE_STAGE_B(GE_SB(0, 1), b0, s0, 1); GE_STAGE(GE_SA(0, 0), a0, voffA); GE_STAGE(GE_SA(0, 1), a0 + hA, voffA);
        if (wr == 1) GE_BAR;
        GE_WAIT_V(2); GE_BAR;
        GE_STAGE_B(GE_SB(1, 0), b1, s1, 0); GE_STAGE(GE_SA(1, 0), a1, voffA); GE_STAGE_B(GE_SB(1, 1), b1, s1, 1);
        GE_WAIT_V(6); GE_BAR;
    }
    for (;;) {
        const bool has_next = S.next(ui + 1, nxt);
        const int nt = cur.nt;
        for (int t = 0; t < nt; t += 2) {
            const bool last = (t == nt - 2);
            const char* a1 = S.ta(cur, t + 1);
            const char* a2 = last ? (has_next ? S.ta(nxt, 0) : S.ta(cur, 0)) : S.ta(cur, t + 2);
            const char* b2 = last ? (has_next ? S.tb(nxt, 0) : S.tb(cur, 0)) : S.tb(cur, t + 2);
            const char* a3 = last ? (has_next ? S.ta(nxt, 1) : S.ta(cur, 1)) : S.ta(cur, t + 3);
            const char* b3 = last ? (has_next ? S.tb(nxt, 1) : S.tb(cur, 1)) : S.tb(cur, t + 3);
            const bool s2 = last ? (has_next ? S.sb(nxt, 0) : S.sb(cur, 0)) : S.sb(cur, t + 2), s3 = last ? (has_next ? S.sb(nxt, 1) : S.sb(cur, 1)) : S.sb(cur, t + 3);
            GE_LDB(B0, 0, 0); GE_LDB(B1, 0, 1); GE_SCHED; GE_LDA(At, 0, 0); GE_STAGE(GE_SA(1, 1), a1 + hA, voffA);
            GE_WAIT_V(8); GE_WAIT_L(0); GE_BAR; GE_MMA(0, 0, At, B0); GE_MMA(0, 1, At, B1); GE_BAR; GE_SCHED;
            GE_LDA(At, 0, 1); GE_STAGE_B(GE_SB(0, 0), b2, s2, 0); GE_STAGE_B(GE_SB(0, 1), b2, s2, 1); GE_STAGE(GE_SA(0, 0), a2, voffA);
            GE_WAIT_V(8); GE_WAIT_L(0); GE_BAR; GE_MMA(1, 0, At, B0); GE_MMA(1, 1, At, B1); GE_BAR; GE_SCHED;
            GE_LDB(B0, 1, 0); GE_LDB(B1, 1, 1); GE_SCHED; GE_LDA(At, 1, 0); GE_STAGE(GE_SA(0, 1), a2 + hA, voffA);
            GE_WAIT_V(8); GE_WAIT_L(0); GE_BAR; GE_MMA(0, 0, At, B0); GE_MMA(0, 1, At, B1); GE_BAR; GE_SCHED;
            GE_LDA(At, 1, 1); GE_STAGE_B(GE_SB(1, 0), b3, s3, 0); GE_STAGE_B(GE_SB(1, 1), b3, s3, 1); GE_STAGE(GE_SA(1, 0), a3, voffA);
            GE_WAIT_V(8); GE_WAIT_L(0); GE_BAR; GE_MMA(1, 0, At, B0); GE_MMA(1, 1, At, B1); GE_BAR; GE_SCHED;
            if constexpr (Epi::MIDK) { if (t + 2 == (nt >> 1)) E.midk(acc, cur, wr, fr, lds + ROWF_OFF + (ui & 1) * 2048); }
        }
        if (wr == 0) GE_BAR;
        E(acc, cur, wr, wc, fr, fq, lds + ROWF_OFF + (ui & 1) * 2048);
        if (!has_next) break;
        if constexpr (Epi::UBEGIN) E.unit_begin(nxt, tid, lds + ROWF_OFF + ((ui + 1) & 1) * 2048);
#pragma unroll
        for (int a = 0; a < 2; ++a)
#pragma unroll
            for (int b = 0; b < 2; ++b)
#pragma unroll
                for (int m = 0; m < 4; ++m)
#pragma unroll
                    for (int n = 0; n < 2; ++n) acc[a][b][m][n] = (f32x4){0.f, 0.f, 0.f, 0.f};
        cur = nxt; ++ui;
        if (wr == 1) GE_BAR;
    }
    GE_WAIT_V(0);
    GE_BAR;
#undef GE_SA
#undef GE_SB
#undef GE_STAGE
#undef GE_STAGE_B
#undef GE_LDA
#undef GE_LDB
#undef GE_MMA
#undef GE_WAIT_V
#undef GE_WAIT_L
#undef GE_BAR
#undef GE_SCHED
}
}
namespace nv {
__device__ __forceinline__ float sum8(const float* p);
__device__ __forceinline__ float sum16(const float* p);
#define XB_TMO      128
#define XB_XCNT(j)  (256  + 64 * (j))
#define XB_XSUB(j)  (1280 + 64 * (j))
#define XB_XGEN(j)  (2304 + 64 * (j))
#define XB_TOP      3328
#define XB_TOPGEN   3392
#define XCD_BAR_WORDS 3456
#define XB_SPIN_CAP (1u << 24)
__device__ __forceinline__ unsigned xb_ld(unsigned* p)              { return __hip_atomic_load(p, __ATOMIC_RELAXED, __HIP_MEMORY_SCOPE_AGENT); }
__device__ __forceinline__ unsigned xb_add(unsigned* p, unsigned v) { return __hip_atomic_fetch_add(p, v, __ATOMIC_RELAXED, __HIP_MEMORY_SCOPE_AGENT); }
__device__ __forceinline__ unsigned xb_xcc_id() { return (unsigned)__builtin_amdgcn_s_getreg((3 << 11) | 20) & 0xFu; }
#define XB_SPIN(cond, bar) do { unsigned _sp = 0; while (cond) { __builtin_amdgcn_s_sleep(1); \
    if ((++_sp & 255u) == 0u) { if (xb_ld(&(bar)[XB_TMO])) break; if (_sp > XB_SPIN_CAP) { atomicAdd(&(bar)[XB_TMO], 1u); break; } } } } while (0)
struct XcdBarrier { unsigned* bar; unsigned x; volatile LAS unsigned* st; };
__device__ __forceinline__ XcdBarrier xcd_barrier_post(unsigned* bar, volatile LAS unsigned* st) {
    XcdBarrier b; b.bar = bar; b.x = xb_xcc_id(); b.st = st;
    if (threadIdx.x == 0) (void)xb_add(&bar[XB_XCNT(b.x)], 1u);
    return b;
}
__device__ __forceinline__ void xcd_barrier_complete(unsigned* bar, unsigned x, unsigned& nloc, unsigned& nx) {
    const unsigned Gsz = gridDim.x * gridDim.y * gridDim.z;
    unsigned sum, cnt, mine, sp = 0u;
    for (;;) {
        sum = 0u; cnt = 0u; mine = 0u;
#pragma unroll
        for (unsigned j = 0; j < 16; ++j) { const unsigned c = xb_ld(&bar[XB_XCNT(j)]); sum += c; cnt += (c > 0u) ? 1u : 0u; mine = (j == x) ? c : mine; }
        if (sum == Gsz) break;
        __builtin_amdgcn_s_sleep(1);
        if ((++sp & 255u) == 0u) { if (xb_ld(&bar[XB_TMO])) break; if (sp > XB_SPIN_CAP) { atomicAdd(&bar[XB_TMO], 1u); break; } }
    }
    nloc = mine > 0u ? mine : 1u; nx = cnt > 0u ? cnt : 1u;
}
__device__ __forceinline__ void xcd_barrier(const XcdBarrier& b) {
    asm volatile("s_waitcnt vmcnt(0)" ::: "memory");
    __syncthreads();
    if (threadIdx.x == 0) {
        unsigned* bar = b.bar;
        __builtin_amdgcn_s_waitcnt(0);
        unsigned nloc = b.st[0], nx = b.st[1];
        if (nloc == 0u) { xcd_barrier_complete(bar, b.x, nloc, nx); b.st[0] = nloc; b.st[1] = nx; }
        const unsigned old = xb_add(&bar[XB_XSUB(b.x)], 1u);
        const unsigned gen = old / nloc;
        if (old + 1u == (gen + 1u) * nloc) {
            __builtin_amdgcn_fence(__ATOMIC_RELEASE, "agent");
            asm volatile("s_waitcnt vmcnt(0)" ::: "memory");
            const unsigned og = xb_add(&bar[XB_TOP], 1u);
            const unsigned tg = og / nx;
            if (og + 1u == (tg + 1u) * nx) xb_add(&bar[XB_TOPGEN], 1u);
            else XB_SPIN(xb_ld(&bar[XB_TOPGEN]) == tg, bar);
            __builtin_amdgcn_fence(__ATOMIC_ACQUIRE, "agent");
            xb_add(&bar[XB_XGEN(b.x)], 1u);
            asm volatile("s_waitcnt vmcnt(0)" ::: "memory");
        } else {
            XB_SPIN(xb_ld(&bar[XB_XGEN(b.x)]) == gen, bar);
            __builtin_amdgcn_fence(__ATOMIC_ACQUIRE, "agent");
            asm volatile("s_waitcnt vmcnt(0)" ::: "memory");
        }
    }
    __syncthreads();
}

#define LDS_WAIT() asm volatile("s_waitcnt lgkmcnt(0)" ::: "memory")
template <class Sc>
__device__ __forceinline__ void p0_transpose_item(const float* __restrict__ W, int ldw, int K, int Ncols, Sc sc, bf16_t* __restrict__ WT, LAS float* scr, int item, int lane) {
    const int nblk = Ncols / 32, kb = item / nblk, nb = item % nblk, k0 = 64 * kb, n0 = 32 * nb;
#pragma unroll 8
    for (int i = 0; i < 32; ++i) { const int kk = 2 * i + (lane >> 5); scr[kk * 33 + (lane & 31)] = W[(size_t)(k0 + kk) * ldw + n0 + (lane & 31)] * sc(k0 + kk); }
    LDS_WAIT(); asm volatile("" ::: "memory");
    const int c = lane & 7;
#pragma unroll
    for (int j = 0; j < 4; ++j) { const int n = (lane >> 3) + 8 * j; const LAS float* s = scr + (8 * c) * 33 + n;
        u32x4 o; o.x = pk2(s[0 * 33], s[1 * 33]); o.y = pk2(s[2 * 33], s[3 * 33]); o.z = pk2(s[4 * 33], s[5 * 33]); o.w = pk2(s[6 * 33], s[7 * 33]);
        *(u32x4*)(WT + (size_t)(n0 + n) * K + k0 + 8 * c) = o; }
    LDS_WAIT(); asm volatile("" ::: "memory");
}
struct ScVec { const float* g; __device__ __forceinline__ float operator()(int k) const { return g[k]; } };
struct ScOne { __device__ __forceinline__ float operator()(int) const { return 1.f; } };
struct ScTwo { const float* g0; const float* g1; __device__ __forceinline__ float operator()(int k) const { return k < 512 ? g0[k] : g1[k - 512]; } };

constexpr int TAB_OFF = 131072 + 1024;
__device__ __forceinline__ void* ldarg(LAS unsigned char* lds, int i) {
    unsigned off = TAB_OFF + 8 * i; asm volatile("" : "+s"(off));
    const unsigned long long v = *(volatile LAS unsigned long long*)(lds + off);
    const unsigned lo = __builtin_amdgcn_readfirstlane((unsigned)v), hi = __builtin_amdgcn_readfirstlane((unsigned)(v >> 32));
    return (void*)(GAS void*)(((unsigned long long)hi << 32) | lo);
}

__device__ __forceinline__ void p0_prologue(LAS unsigned char* lds) {
    PH_IDS
    const int lane = TIDX & 63, wave = __builtin_amdgcn_readfirstlane(TIDX >> 6), gw = BIDX * 8 + wave, ngw = GDIM * 8;
    LAS float* scr = (LAS float*)(lds + wave * 16384);
    unsigned char* ws = (unsigned char*)ldarg(lds, 24);
    const float* a0 = (const float*)ldarg(lds, 0); const float* a1 = (const float*)ldarg(lds, 1); const float* a2 = (const float*)ldarg(lds, 2); const float* a11 = (const float*)ldarg(lds, 11);
    const float* a14 = (const float*)ldarg(lds, 14); const float* a15 = (const float*)ldarg(lds, 15); const float* a16 = (const float*)ldarg(lds, 16); const float* a17 = (const float*)ldarg(lds, 17); const float* a18 = (const float*)ldarg(lds, 18);
    constexpr int I1 = (D / 64) * (2048 / 32), I2 = (SSMW / 64) * (SSMW / 32), I3 = (D / 64) * (D / 32), I4 = I3, IL = I1 + I2 + I3 + I4;
    for (int it = gw; it < DEPTH * IL; it += ngw) {
        const int l = it / IL; int r = it % IL;
        if (r < I1) { p0_transpose_item(a2 + (size_t)l * D * INW, INW, D, 2048, ScVec{a1 + l * D}, (bf16_t*)(ws + WS_BT1) + (size_t)l * 2048 * D, scr, r, lane); continue; } r -= I1;
        if (r < I2) { p0_transpose_item(a11 + (size_t)l * SSMW * SSMW, SSMW, SSMW, SSMW, ScOne{}, (bf16_t*)(ws + WS_BT2) + (size_t)l * SSMW * SSMW, scr, r, lane); continue; } r -= I2;
        if (r < I3) { p0_transpose_item(a16 + (size_t)l * D * D, D, D, D, ScTwo{a14 + l * SSMW, a15 + l * ATTW}, (bf16_t*)(ws + WS_BT3) + (size_t)l * D * D, scr, r, lane); continue; } r -= I3;
        p0_transpose_item(a18 + (size_t)l * D * D, D, D, D, ScVec{a17 + l * D}, (bf16_t*)(ws + WS_BT4) + (size_t)l * D * D, scr, r, lane);
    }
    for (int i = BIDX * 512 + TIDX; i < DEPTH * 16 * D; i += GDIM * 512) {
        const int l = i / (16 * D), j = (i / D) % 16, k = i % D;
        const float v = j < 8 ? a2[((size_t)l * D + k) * INW + 2048 + j] * a1[l * D + k] : 0.f;
        ((bf16_t*)(ws + WS_WF))[i] = f2bf(v);
    }
    {
        const float* x = a0; bf16_t* hb = (bf16_t*)(ws + WS_HB); float* ssp1 = (float*)(ws + WS_SSP) + (size_t)T * 32;
        for (int w = gw; w < T; w += ngw) {
            const f32x4* r = (const f32x4*)(x + (size_t)w * D) + lane; unsigned long long* o = (unsigned long long*)(hb + (size_t)w * D) + lane;
            float s = 0.f;
#pragma unroll
            for (int j = 0; j < 4; ++j) { const f32x4 v = r[64 * j]; const unsigned w0 = pk2(v.x, v.y), w1 = pk2(v.z, v.w); o[64 * j] = (unsigned long long)w0 | ((unsigned long long)w1 << 32);
                const float a = __uint_as_float(w0 << 16), b = __uint_as_float(w0 & 0xffff0000u), c = __uint_as_float(w1 << 16), d = __uint_as_float(w1 & 0xffff0000u); s += (a * a + b * b) + (c * c + d * d); }
            s = wave_sum(s);
            if (lane < 8) ssp1[(size_t)w * 8 + lane] = lane == 0 ? s : 0.f;
        }
    }
}

struct SchedGen {
    static constexpr bool DUALB = false; long hB1;
    __device__ __forceinline__ bool sb(const ge::Unit&, int) const { return false; }
    __device__ __forceinline__ unsigned voffB1(int, int) const { return 0u; }
    const char* A; const char* B; int a_row_b, a_c16_b, b_row_b, b_c16_b; long a_pm_b, a_kt_b, b_pn_b, b_kt_b; int nM, nN, nt, G, c; long hA, hB;
    __device__ __forceinline__ void init_plain(const void* A_, int lda_bytes, const void* B_, int ldb_bytes, int M, int N, int K, int G_, int c_) {
        A = (const char*)A_; B = (const char*)B_; a_row_b = lda_bytes; a_c16_b = 32; b_row_b = ldb_bytes; b_c16_b = 32; a_pm_b = 256l * lda_bytes; a_kt_b = 128; b_pn_b = 256l * ldb_bytes; b_kt_b = 128;
        nM = M / 256; nN = N / 256; nt = K / 64; G = G_; c = c_; hA = 128l * lda_bytes; hB = 128l * ldb_bytes; }
    __device__ __forceinline__ bool next(int i, ge::Unit& u) const {
        int pm, pn; if (!ge::static_tile(i, G, c, nM, nN, pm, pn)) return false;
        u.A0 = A + (size_t)pm * a_pm_b; u.B0 = B + (size_t)pn * b_pn_b; u.nt = nt; u.pm = pm; u.pn = pn; u.aux = 0; return true; }
    __device__ __forceinline__ const char* ta(const ge::Unit& u, int t) const { return u.A0 + t * a_kt_b; }
    __device__ __forceinline__ const char* tb(const ge::Unit& u, int t) const { return u.B0 + t * b_kt_b; }
    __device__ __forceinline__ unsigned voffA(int R, int C) const { return (unsigned)(R * a_row_b + (C >> 4) * a_c16_b + (C & 15) * 2); }
    __device__ __forceinline__ unsigned voffB(int Rb, int C) const { return (unsigned)(Rb * b_row_b + (C >> 4) * b_c16_b + (C & 15) * 2); }
};
typedef SchedGen SchedPlain;

constexpr float QSCALE = 0.125f * 1.4426950408889634f;
struct EpiInProj {
    static constexpr bool PERM = true, MIDK = false, UBEGIN = true;
    const float* ssp1; bf16_t* UP; bf16_t* QKV;
    __device__ __forceinline__ void unit_begin(const ge::Unit& u, int tid, LAS unsigned char* rowf) const {
        if (tid < 256) { const int row = u.pm * 256 + tid; ((LAS float*)rowf)[tid] = rsqrtf(sum8(ssp1 + (size_t)row * 8) * (1.f / D) + EPS); }
    }
    __device__ __forceinline__ void midk(ge::f32x4 (&)[2][2][4][2], const ge::Unit&, int, int, LAS unsigned char*) const {}
    __device__ __forceinline__ void operator()(const ge::f32x4 (&acc)[2][2][4][2], const ge::Unit& u, int wr, int wc, int fr, int fq, LAS unsigned char* rowf) const {
        const int row0 = u.pm * 256 + wr * 64 + fr, colt = u.pn * 256, region = colt >> 9;
        bf16_t* dstb = QKV + (size_t)(region - 1) * ((WS_K - WS_Q) / 2);
#pragma unroll
        for (int ai = 0; ai < 2; ++ai)
#pragma unroll
            for (int m = 0; m < 4; ++m) {
                const int row = row0 + ai * 128 + m * 16; const float rs = ((const LAS float*)rowf)[ai * 128 + wr * 64 + m * 16 + fr];
#pragma unroll
                for (int bj = 0; bj < 2; ++bj) {
                    const int c = (colt & 511) + bj * 128 + wc * 32 + 8 * fq;
                    const float rq = region == 1 ? rs * QSCALE : rs;
                    const ge::f32x4 v0 = acc[ai][bj][m][0] * rq, v1 = acc[ai][bj][m][1] * rq;
                    u32x4 w; w.x = ge::cvt_pk_bf16(v0[0], v0[1]); w.y = ge::cvt_pk_bf16(v0[2], v0[3]); w.z = ge::cvt_pk_bf16(v1[0], v1[1]); w.w = ge::cvt_pk_bf16(v1[2], v1[3]);
                    bf16_t* dst = region == 0 ? UP + up_index(row, c) : dstb + (size_t)row * 512 + c;
                    *(u32x4*)dst = w;
                }
            }
    }
};

__device__ __forceinline__ float sum8(const float* p) { const ge::f32x4 a = *(const ge::f32x4*)p, b = *(const ge::f32x4*)(p + 4); return ((a[0] + a[1]) + (a[2] + a[3])) + ((b[0] + b[1]) + (b[2] + b[3])); }
__device__ __forceinline__ float sum16(const float* p) { return sum8(p) + sum8(p + 8); }
__device__ __forceinline__ size_t gel_index(int row, int c) { return ((size_t)(c >> 4) * T + row) * HC + (c & 15); }
__device__ __forceinline__ float sigmoidf_(float x) { return 1.f / (1.f + __expf(-x)); }
struct EpiGlu2 {
    static constexpr bool PERM = true, MIDK = false, UBEGIN = false;
    const bf16_t* GEL; const float* bias; bf16_t* MIX; float* ssp;
    __device__ __forceinline__ void unit_begin(const ge::Unit&, int, LAS unsigned char*) const {}
    __device__ __forceinline__ void midk(ge::f32x4 (&)[2][2][4][2], const ge::Unit&, int, int, LAS unsigned char*) const {}
    __device__ __forceinline__ void operator()(const ge::f32x4 (&acc)[2][2][4][2], const ge::Unit& u, int wr, int wc, int fr, int fq, LAS unsigned char*) const {
        const int row0 = u.pm * 256 + wr * 64 + fr, colt = u.pn * 256;
#pragma unroll
        for (int ai = 0; ai < 2; ++ai)
#pragma unroll
            for (int m = 0; m < 4; ++m) {
                const int row = row0 + ai * 128 + m * 16; float sq = 0.f;
#pragma unroll
                for (int bj = 0; bj < 2; ++bj) {
                    const int c = colt + bj * 128 + wc * 32 + 8 * fq;
                    const ge::f32x4 b0 = *(const ge::f32x4*)(bias + c), b1 = *(const ge::f32x4*)(bias + c + 4);
                    const u32x4 gw = *(const u32x4*)(GEL + gel_index(row, c));
                    const ge::f32x4 v0 = acc[ai][bj][m][0] + b0, v1 = acc[ai][bj][m][1] + b1;
                    float o[8];
                    o[0] = __uint_as_float(gw.x << 16) * sigmoidf_(v0[0]); o[1] = __uint_as_float(gw.x & 0xffff0000u) * sigmoidf_(v0[1]);
                    o[2] = __uint_as_float(gw.y << 16) * sigmoidf_(v0[2]); o[3] = __uint_as_float(gw.y & 0xffff0000u) * sigmoidf_(v0[3]);
                    o[4] = __uint_as_float(gw.z << 16) * sigmoidf_(v1[0]); o[5] = __uint_as_float(gw.z & 0xffff0000u) * sigmoidf_(v1[1]);
                    o[6] = __uint_as_float(gw.w << 16) * sigmoidf_(v1[2]); o[7] = __uint_as_float(gw.w & 0xffff0000u) * sigmoidf_(v1[3]);
#pragma unroll
                    for (int e = 0; e < 8; ++e) sq += o[e] * o[e];
                    u32x4 w; w.x = ge::cvt_pk_bf16(o[0], o[1]); w.y = ge::cvt_pk_bf16(o[2], o[3]); w.z = ge::cvt_pk_bf16(o[4], o[5]); w.w = ge::cvt_pk_bf16(o[6], o[7]);
                    *(u32x4*)(MIX + (size_t)row * D + c) = w;
                }
                sq += __shfl_xor(sq, 16); sq += __shfl_xor(sq, 32);
                if (fq == 0) ssp[(size_t)row * 8 + u.pn * 4 + wc] = sq;
            }
    }
};
struct EpiWo {
    static constexpr bool PERM = true, MIDK = true, UBEGIN = true;
    const float* ssp_s; const float* ssp_a; const bf16_t* hin; bf16_t* hb; float* ssp2;
    typedef float f32x2_ __attribute__((ext_vector_type(2)));
    __device__ __forceinline__ void unit_begin(const ge::Unit& u, int tid, LAS unsigned char* rowf) const {
        if (tid < 256) { const int row = u.pm * 256 + tid;
            const float rs_s = rsqrtf(sum8(ssp_s + (size_t)row * 8) * (1.f / SSMW) + EPS), rs_a = rsqrtf(sum8(ssp_a + (size_t)row * 8) * (1.f / ATTW) + EPS);
            ((LAS f32x2_*)rowf)[tid] = (f32x2_){rs_s / rs_a, rs_a}; }
    }
    __device__ __forceinline__ void midk(ge::f32x4 (&acc)[2][2][4][2], const ge::Unit& u, int wr, int fr, LAS unsigned char* rowf) const {
#pragma unroll
        for (int ai = 0; ai < 2; ++ai)
#pragma unroll
            for (int m = 0; m < 4; ++m) {
                const float f = ((const LAS f32x2_*)rowf)[ai * 128 + wr * 64 + m * 16 + fr].x;
#pragma unroll
                for (int bj = 0; bj < 2; ++bj)
#pragma unroll
                    for (int n = 0; n < 2; ++n) acc[ai][bj][m][n] = acc[ai][bj][m][n] * f;
            }
    }
    __device__ __forceinline__ void operator()(const ge::f32x4 (&acc)[2][2][4][2], const ge::Unit& u, int wr, int wc, int fr, int fq, LAS unsigned char* rowf) const {
        const int row0 = u.pm * 256 + wr * 64 + fr, colt = u.pn * 256;
#pragma unroll
        for (int ai = 0; ai < 2; ++ai)
#pragma unroll
            for (int m = 0; m < 4; ++m) {
                const int row = row0 + ai * 128 + m * 16; const float ra = ((const LAS f32x2_*)rowf)[ai * 128 + wr * 64 + m * 16 + fr].y; float sq = 0.f;
#pragma unroll
                for (int bj = 0; bj < 2; ++bj) {
                    const int c = colt + bj * 128 + wc * 32 + 8 * fq;
                    const size_t o = (size_t)row * D + c;
                    const u32x4 hw = *(const u32x4*)(hin + o);
                    const ge::f32x4 a0 = acc[ai][bj][m][0] * ra, a1 = acc[ai][bj][m][1] * ra;
                    u32x4 w; w.x = ge::cvt_pk_bf16(__uint_as_float(hw.x << 16) + a0[0], __uint_as_float(hw.x & 0xffff0000u) + a0[1]); w.y = ge::cvt_pk_bf16(__uint_as_float(hw.y << 16) + a0[2], __uint_as_float(hw.y & 0xffff0000u) + a0[3]);
                    w.z = ge::cvt_pk_bf16(__uint_as_float(hw.z << 16) + a1[0], __uint_as_float(hw.z & 0xffff0000u) + a1[1]); w.w = ge::cvt_pk_bf16(__uint_as_float(hw.w << 16) + a1[2], __uint_as_float(hw.w & 0xffff0000u) + a1[3]);
                    *(u32x4*)(hb + o) = w;
#pragma unroll
                    for (int e = 0; e < 4; ++e) { const float lo = __uint_as_float(w[e] << 16), hi = __uint_as_float(w[e] & 0xffff0000u); sq += lo * lo + hi * hi; }
                }
                sq += __shfl_xor(sq, 16); sq += __shfl_xor(sq, 32);
                if (fq == 0) ssp2[(size_t)row * 16 + u.pn * 4 + wc] = sq;
            }
    }
};
struct EpiWq {
    static constexpr bool PERM = true, MIDK = false, UBEGIN = true;
    const float* ssp2; bf16_t* QP;
    __device__ __forceinline__ void unit_begin(const ge::Unit& u, int tid, LAS unsigned char* rowf) const {
        if (tid < 256) { const int row = u.pm * 256 + tid; ((LAS float*)rowf)[tid] = rsqrtf(sum16(ssp2 + (size_t)row * 16) * (1.f / D) + EPS); }
    }
    __device__ __forceinline__ void midk(ge::f32x4 (&)[2][2][4][2], const ge::Unit&, int, int, LAS unsigned char*) const {}
    __device__ __forceinline__ void operator()(const ge::f32x4 (&acc)[2][2][4][2], const ge::Unit& u, int wr, int wc, int fr, int fq, LAS unsigned char* rowf) const {
        const int row0 = u.pm * 256 + wr * 64 + fr, colt = u.pn * 256;
#pragma unroll
        for (int ai = 0; ai < 2; ++ai)
#pragma unroll
            for (int m = 0; m < 4; ++m) {
                const int row = row0 + ai * 128 + m * 16; const float rs = ((const LAS float*)rowf)[ai * 128 + wr * 64 + m * 16 + fr];
#pragma unroll
                for (int bj = 0; bj < 2; ++bj) {
                    const int c = colt + bj * 128 + wc * 32 + 8 * fq;
                    const ge::f32x4 v0 = acc[ai][bj][m][0] * rs, v1 = acc[ai][bj][m][1] * rs;
                    u32x4 w; w.x = ge::cvt_pk_bf16(v0[0], v0[1]); w.y = ge::cvt_pk_bf16(v0[2], v0[3]); w.z = ge::cvt_pk_bf16(v1[0], v1[1]); w.w = ge::cvt_pk_bf16(v1[2], v1[3]);
                    *(u32x4*)(QP + (size_t)row * D + c) = w;
                }
            }
    }
};

__device__ __forceinline__ void ph_flogit(const bf16_t* __restrict__ hb, const bf16_t* __restrict__ wf, const float* __restrict__ ss, const float* __restrict__ bfv, float* __restrict__ logf) {
    PH_IDS
    const int lane = TIDX & 63, gw = BIDX * 8 + __builtin_amdgcn_readfirstlane(TIDX >> 6), ngw = GDIM * 8, r16 = lane & 15, q4 = lane >> 4;
    for (int item = gw; item < T / 16; item += ngw) {
        const int tok0 = item * 16;
        ge::f32x4 acc = {0.f, 0.f, 0.f, 0.f};
        const bf16_t* ar = hb + (size_t)(tok0 + r16) * D + q4 * 8; const bf16_t* br = wf + (size_t)r16 * D + q4 * 8;
#pragma unroll 8
        for (int ks = 0; ks < D / 32; ++ks) {
            const bf16x8 a = *(const bf16x8*)(ar + ks * 32), b = *(const bf16x8*)(br + ks * 32);
            acc = __builtin_amdgcn_mfma_f32_16x16x32_bf16(a, b, acc, 0, 0, 0);
        }
        if (r16 < NH) {
            const float bj = bfv[r16];
#pragma unroll
            for (int r = 0; r < 4; ++r) {
                const int tok = tok0 + 4 * q4 + r; const float x = acc[r] * rsqrtf(sum8(ss + (size_t)tok * 8) * (1.f / D) + EPS) + bj;
                logf[(size_t)tok * NH + r16] = fminf(x, 0.f) - log1pf(expf(-fabsf(x)));
            }
        }
    }
}
}
namespace nv {
__device__ __forceinline__ float gelu_fast(float x);
constexpr float USCALE = 256.f, VSCALE = 16.f;
typedef float f32x2 __attribute__((ext_vector_type(2)));
typedef int i32x2 __attribute__((ext_vector_type(2)));
__device__ __forceinline__ float clamp448(float x) { return fminf(fmaxf(x, -448.f), 448.f); }
__device__ __forceinline__ unsigned pack4_fp8(float a, float b, float c, float d) {
    int w = 0; w = __builtin_amdgcn_cvt_pk_fp8_f32(clamp448(a), clamp448(b), w, false); w = __builtin_amdgcn_cvt_pk_fp8_f32(clamp448(c), clamp448(d), w, true); return (unsigned)w; }

__device__ __forceinline__ void peer_split(LAS unsigned char* lds, int bid, int grid, int wave, int& slice, int& gw, int& ngw) {
    volatile LAS unsigned* M = (volatile LAS unsigned*)(lds + 131072 + 320);
    const unsigned x = __builtin_amdgcn_readfirstlane(M[16]), rk = __builtin_amdgcn_readfirstlane(M[17]), nl = __builtin_amdgcn_readfirstlane(M[18]), ok = __builtin_amdgcn_readfirstlane(M[19]);
    if (ok) { slice = (int)x; gw = (int)rk * 8 + wave; ngw = (int)nl * 8; }
    else { slice = bid & 7; gw = (bid >> 3) * 8 + wave; ngw = (grid >> 3) * 8; }
}
__device__ __forceinline__ void p0_peer_tables(const float* __restrict__ pu, const float* __restrict__ pv, const float* __restrict__ g2, unsigned char* __restrict__ PU8, unsigned char* __restrict__ PV8) {
    PH_IDS
    const size_t n16 = (size_t)DEPTH * NEXP * D / 16;
    for (size_t i = (size_t)BIDX * 512 + TIDX; i < 2 * n16; i += (size_t)GDIM * 512) {
        const bool isv = i >= n16; const size_t j = isv ? i - n16 : i; const size_t e0 = j * 16;
        const float* src = (isv ? pv : pu) + e0;
        const int l = (int)(e0 / ((size_t)NEXP * D)), c = (int)(e0 % D);
        f32x4 x[4];
#pragma unroll
        for (int k = 0; k < 4; ++k) x[k] = *(const f32x4*)(src + 4 * k);
        u32x4 o;
        if (isv) {
#pragma unroll
            for (int k = 0; k < 4; ++k) o[k] = pack4_fp8(x[k].x * VSCALE, x[k].y * VSCALE, x[k].z * VSCALE, x[k].w * VSCALE);
        } else {
#pragma unroll
            for (int k = 0; k < 4; ++k) { const f32x4 g = *(const f32x4*)(g2 + l * D + c + 4 * k) * USCALE; o[k] = pack4_fp8(x[k].x * g.x, x[k].y * g.y, x[k].z * g.z, x[k].w * g.w); }
        }
        const size_t er = (e0 / D) % NEXP;
        *(u32x4*)((isv ? PV8 : PU8) + (((size_t)l * 8 + (c >> 7)) * NEXP + er) * 128 + (c & 127)) = o;
    }
}

constexpr int PB = 16;
#define DPPF(x, CTRL) __int_as_float(__builtin_amdgcn_update_dpp(0, __float_as_int(x), (CTRL), 0xF, 0xF, true))
template <int MODE = 0>
__device__ __forceinline__ void ph_peer_u(LAS unsigned char* lds, const unsigned char* __restrict__ PU8, const bf16_t* __restrict__ hb, const unsigned short* __restrict__ idx, bf16_t* __restrict__ partial, int imask = 0x7fffffff) {
    PH_IDS
    const int lane = TIDX & 63, wave = __builtin_amdgcn_readfirstlane(TIDX >> 6), c8 = lane & 7, rg = lane >> 3;
    int slice, gw, ngw; peer_split(lds, BIDX, GDIM, wave, slice, gw, ngw);
    const unsigned char* tab = PU8 + (size_t)slice * NEXP * 128; const unsigned lo16 = 16u * c8;
    LAS int* li = (LAS int*)(lds + wave * 12288);
    LAS unsigned* lh = (LAS unsigned*)(lds + wave * 12288 + 8192);
    LAS float* tr = (LAS float*)(lds + 8 * 12288 + wave * 512);
    const int ntok = gw < T ? (T - gw + ngw - 1) / ngw : 0;
    const int p0 = 2 * lane, sd0 = (p0 >> 6) * 64 + (p0 & 7) * 8 + ((p0 & 63) >> 3), sd1 = sd0 + 8;
    const bool b2 = (c8 & 4) != 0, b1 = (c8 & 2) != 0, b0 = (c8 & 1) != 0;
    const int i0 = 8 * (int)b2 + 4 * (int)b0 + 2 * (int)b1;
#define PU_SLOAD(k, IW, HW) do { const size_t ts_ = (size_t)gw + (size_t)min((k), ntok - 1) * ngw; IW = *(const unsigned*)(idx + ts_ * 128 + 2 * lane); HW = *(const unsigned*)(hb + ts_ * D + 128 * slice + 2 * lane); } while (0)
#define PU_SWRITE(k, IW, HW) do { LAS int* d_ = li + ((k) & (PB - 1)) * 128; d_[sd0] = (int)((IW) & 0xffffu) & imask; d_[sd1] = (int)((IW) >> 16) & imask; lh[((k) & (PB - 1)) * 64 + lane] = (HW); } while (0)
#define PU_ISSUE(s, B) do { const ge::u32x4 ia_ = *(const LAS ge::u32x4*)(li + (((s) >> 1) & (2 * PB - 1)) * 64 + rg * 8 + 4 * ((s) & 1)); \
            _Pragma("unroll") for (int i_ = 0; i_ < 4; ++i_) rb[B][i_] = *(const u32x4*)(tab + (ia_[i_] * 128u + lo16)); } while (0)
#define PU_STEP(s, B, QT, ISS) do { if (ISS) PU_ISSUE((s) + 7, ((B) + 7) & 7); \
            const int k_ = (s) >> 2; const size_t t_ = (size_t)gw + (size_t)k_ * ngw; \
            if (QT == 0) { const LAS u32x4* hp_ = (const LAS u32x4*)(lh + (k_ & (PB - 1)) * 64) + 2 * c8; const u32x4 w0 = hp_[0], w1 = hp_[1];          \
                _Pragma("unroll") for (int j = 0; j < 4; ++j) { hx[j] = (f32x2){__uint_as_float(w0[j] << 16), __uint_as_float(w0[j] & 0xffff0000u)}; hx[4 + j] = (f32x2){__uint_as_float(w1[j] << 16), __uint_as_float(w1[j] & 0xffff0000u)}; } } \
            if (MODE >= 2) { _Pragma("unroll") for (int i = 0; i < 4; ++i) { const u32x4 a_ = rb[B][i]; pv[4 * QT + i] = __uint_as_float((a_.x ^ a_.y ^ a_.z ^ a_.w) & 0x3fffffffu); } } else \
            _Pragma("unroll") for (int i = 0; i < 4; ++i) { f32x2 dd = {0.f, 0.f}; _Pragma("unroll") for (int k = 0; k < 4; ++k) {        \
                const f32x2 q0 = __builtin_amdgcn_cvt_pk_f32_fp8((int)rb[B][i][k], false), q1 = __builtin_amdgcn_cvt_pk_f32_fp8((int)rb[B][i][k], true); \
                dd = __builtin_elementwise_fma(q0, hx[2 * k], dd); dd = __builtin_elementwise_fma(q1, hx[2 * k + 1], dd); } pv[4 * QT + i] = dd.x + dd.y; } \
            if (QT == 3) { float y[8], z[4]; \
                _Pragma("unroll") for (int j = 0; j < 8; ++j) { const float keep = b2 ? pv[8 + j] : pv[j], send = b2 ? pv[j] : pv[8 + j]; y[j] = keep + DPPF(send, 0x141); }       \
                _Pragma("unroll") for (int j = 0; j < 4; ++j) { const float keep = b0 ? y[4 + j] : y[j], send = b0 ? y[j] : y[4 + j]; z[j] = keep + DPPF(send, 0xB1); }          \
                const float o0 = (b1 ? z[2] : z[0]) + DPPF(b1 ? z[0] : z[2], 0x4E), o1 = (b1 ? z[3] : z[1]) + DPPF(b1 ? z[1] : z[3], 0x4E);                                    \
                  \
                tr[8 * i0 + rg] = o0; tr[8 * i0 + 8 + rg] = o1; const f32x2 ov_ = *(const LAS f32x2*)(tr + 2 * lane); \
                *(unsigned*)(partial + ((size_t)slice * T + t_) * 128 + 2 * lane) = pk2(ov_.x, ov_.y); } asm volatile("" ::: "memory"); __builtin_amdgcn_sched_barrier(0); } while (0)
    if (ntok >= 8 && !(ntok & 1)) {
        u32x4 rb[8][4]; float pv[16]; f32x2 hx[8]; unsigned xi, xh, yi, yh;
        for (int k = 0; k < 6; ++k) { unsigned a_, b_; PU_SLOAD(k, a_, b_); PU_SWRITE(k, a_, b_); }
        PU_SLOAD(6, xi, xh); PU_SLOAD(7, yi, yh);
        asm volatile("s_waitcnt vmcnt(0) lgkmcnt(0)" ::: "memory");
        PU_ISSUE(0, 0); PU_ISSUE(1, 1); PU_ISSUE(2, 2); PU_ISSUE(3, 3); PU_ISSUE(4, 4); PU_ISSUE(5, 5); PU_ISSUE(6, 6);
        const int send = 4 * ntok - 8;
#pragma nounroll
        for (int s0 = 0; s0 < send; s0 += 8) {
            PU_SWRITE((s0 >> 2) + 6, xi, xh); PU_SLOAD((s0 >> 2) + 8, xi, xh);
            PU_STEP(s0, 0, 0, 1); PU_STEP(s0 + 1, 1, 1, 1); PU_STEP(s0 + 2, 2, 2, 1); PU_STEP(s0 + 3, 3, 3, 1);
            PU_SWRITE((s0 >> 2) + 7, yi, yh); PU_SLOAD((s0 >> 2) + 9, yi, yh);
            PU_STEP(s0 + 4, 4, 0, 1); PU_STEP(s0 + 5, 5, 1, 1); PU_STEP(s0 + 6, 6, 2, 1); PU_STEP(s0 + 7, 7, 3, 1); }
        { const int s0 = send; PU_STEP(s0, 0, 0, 1); PU_STEP(s0 + 1, 1, 1, 0); PU_STEP(s0 + 2, 2, 2, 0); PU_STEP(s0 + 3, 3, 3, 0); PU_STEP(s0 + 4, 4, 0, 0); PU_STEP(s0 + 5, 5, 1, 0); PU_STEP(s0 + 6, 6, 2, 0); PU_STEP(s0 + 7, 7, 3, 0); }
    } else {
        u32x4 rb[8][4]; float pv[16]; f32x2 hx[8];
#pragma nounroll
        for (int k = 0; k < ntok; ++k) {
            { unsigned a_, b_; PU_SLOAD(k, a_, b_); PU_SWRITE(k, a_, b_); } asm volatile("s_waitcnt vmcnt(0) lgkmcnt(0)" ::: "memory");
            const int s0 = 4 * k; PU_ISSUE(s0, 0); PU_ISSUE(s0 + 1, 1); PU_ISSUE(s0 + 2, 2); PU_ISSUE(s0 + 3, 3);
            PU_STEP(s0, 0, 0, 0); PU_STEP(s0 + 1, 1, 1, 0); PU_STEP(s0 + 2, 2, 2, 0); PU_STEP(s0 + 3, 3, 3, 0); }
    }
#undef PU_SLOAD
#undef PU_SWRITE
#undef PU_ISSUE
#undef PU_STEP
    asm volatile("s_waitcnt lgkmcnt(0)" ::: "memory");
}

constexpr float CSCALE = 32.f;
__device__ __forceinline__ void ph_peer_coef(const bf16_t* __restrict__ partial, const float* __restrict__ ssp2, const float* __restrict__ gate, unsigned short* __restrict__ coef8) {
    PH_IDS
    const size_t n4 = (size_t)T * 128 / 4, stride = (size_t)GDIM * 512;
    for (size_t i0 = (size_t)BIDX * 512 + TIDX; i0 < n4; i0 += 2 * stride) {
        ge::u32x2 pv[2][8]; f32x4 gv[2]; float rs[2];
#pragma unroll
        for (int u = 0; u < 2; ++u) { const size_t i = i0 + u * stride;
            if (i < n4) {
#pragma unroll
                for (int k = 0; k < 8; ++k) pv[u][k] = *(const ge::u32x2*)(partial + (size_t)k * T * 128 + 4 * i);
                gv[u] = *(const f32x4*)(gate + 4 * i); rs[u] = sum16(ssp2 + (i >> 5) * 16);
            } }
#pragma unroll
        for (int u = 0; u < 2; ++u) { const size_t i = i0 + u * stride;
            if (i < n4) {
                f32x4 s = {0.f, 0.f, 0.f, 0.f};
#pragma unroll
                for (int k = 0; k < 8; ++k) { s.x += __uint_as_float(pv[u][k].x << 16); s.y += __uint_as_float(pv[u][k].x & 0xffff0000u); s.z += __uint_as_float(pv[u][k].y << 16); s.w += __uint_as_float(pv[u][k].y & 0xffff0000u); }
                const float sc = rsqrtf(rs[u] * (1.f / D) + EPS) * (1.f / USCALE);
                f32x4 o; o.x = gelu_fast(s.x * sc) * gv[u].x * CSCALE; o.y = gelu_fast(s.y * sc) * gv[u].y * CSCALE; o.z = gelu_fast(s.z * sc) * gv[u].z * CSCALE; o.w = gelu_fast(s.w * sc) * gv[u].w * CSCALE;
                const unsigned hi = pack4_fp8(o.x, o.y, o.z, o.w);
                const f32x2 h01 = __builtin_amdgcn_cvt_pk_f32_fp8((int)hi, false), h23 = __builtin_amdgcn_cvt_pk_f32_fp8((int)hi, true);
                const unsigned lo = pack4_fp8(o.x - h01.x, o.y - h01.y, o.z - h23.x, o.w - h23.y);
                const unsigned w0 = (hi & 0xffu) | ((lo & 0xffu) << 8) | ((hi & 0xff00u) << 8) | ((lo & 0xff00u) << 16);
                const unsigned w1 = ((hi >> 16) & 0xffu) | (((lo >> 16) & 0xffu) << 8) | ((hi >> 8) & 0xff0000u) | (lo & 0xff000000u);
                *(ge::u32x2*)(coef8 + 4 * i) = (ge::u32x2){w0, w1};
            } }
    }
}

template <int MODE = 0>
__device__ __forceinline__ void ph_peer_v(LAS unsigned char* lds, const unsigned char* __restrict__ PV8, const unsigned short* __restrict__ idx, const unsigned short* __restrict__ coef8, const bf16_t* hin, bf16_t* hb, float* __restrict__ ssp1, int imask = 0x7fffffff) {
    PH_IDS
    const int lane = TIDX & 63, wave = __builtin_amdgcn_readfirstlane(TIDX >> 6), c8 = lane & 7, rg = lane >> 3;
    int slice, gw, ngw; peer_split(lds, BIDX, GDIM, wave, slice, gw, ngw);
    const unsigned char* tab = PV8 + (size_t)slice * NEXP * 128; const unsigned lo16 = 16u * c8;
    LAS int* li = (LAS int*)(lds + wave * 16384);
    LAS unsigned short* lc = (LAS unsigned short*)(lds + wave * 16384 + 8192);
    LAS unsigned* lr = (LAS unsigned*)(lds + wave * 16384 + 12288);
    LAS float* tr = (LAS float*)(lds + ge::ROWF_OFF + wave * 1024);
    const int ntok = gw < T ? (T - gw + ngw - 1) / ngw : 0;
    const int p0 = 2 * lane, sd0 = (p0 >> 6) * 64 + (p0 & 7) * 8 + ((p0 & 63) >> 3), sd1 = sd0 + 8;
    const unsigned bsh = 8u * (c8 & 3), mlo = c8 < 4 ? 0xffffffffu : 0u, mhi = ~mlo;
    const int nn = lane & 15, qq = lane >> 4; const bool dvalid = (nn >> 3) == (qq >> 1);
    const int dcol = 64 * (qq & 1) + (nn & 7);
#define PV_SLOAD(k, IW, CW, RW) do { const size_t ts_ = (size_t)gw + (size_t)min((k), ntok - 1) * ngw; IW = *(const unsigned*)(idx + ts_ * 128 + 2 * lane); CW = *(const unsigned*)(coef8 + ts_ * 128 + 2 * lane); \
            RW = *(const unsigned*)(hin + ts_ * D + 128 * slice + 2 * lane); } while (0)
#define PV_SWRITE(k, IW, CW, RW) do { const int o_ = ((k) & (PB - 1)) * 128; li[o_ + sd0] = (int)((IW) & 0xffffu) & imask; li[o_ + sd1] = (int)((IW) >> 16) & imask; \
            lc[o_ + sd0] = (unsigned short)((CW) & 0xffffu); lc[o_ + sd1] = (unsigned short)((CW) >> 16); lr[((k) & (PB - 1)) * 64 + lane] = (RW); } while (0)
#define PV_ISSUE(s, B) do { const ge::u32x4 ia_ = *(const LAS ge::u32x4*)(li + (((s) >> 1) & (2 * PB - 1)) * 64 + rg * 8 + 4 * ((s) & 1)); \
            _Pragma("unroll") for (int i_ = 0; i_ < 4; ++i_) rb[B][i_] = *(const u32x4*)(tab + (ia_[i_] * 128u + lo16)); } while (0)
#define PV_STEP(s, B, QT, ISS) do { if (ISS) PV_ISSUE((s) + 7, ((B) + 7) & 7); \
            const int k_ = (s) >> 2; const size_t t_ = (size_t)gw + (size_t)k_ * ngw; \
            if (QT == 0) { acc0 = (ge::f32x4){0.f, 0.f, 0.f, 0.f}; acc1 = acc0; } \
            const ge::u32x2 cw_ = *(const LAS ge::u32x2*)(lc + (((s) >> 1) & (2 * PB - 1)) * 64 + rg * 8 + 4 * ((s) & 1));                       \
            _Pragma("unroll") for (int i = 0; i < 4; ++i) { const unsigned w_ = (i < 2 ? cw_.x : cw_.y) >> (16 * (i & 1)); \
                const unsigned th_ = (w_ & 0xffu) << bsh, tl_ = ((w_ >> 8) & 0xffu) << bsh; \
                const long bh_ = (long)(((unsigned long long)(th_ & mhi) << 32) | (th_ & mlo)), bl_ = (long)(((unsigned long long)(tl_ & mhi) << 32) | (tl_ & mlo)); \
                const u32x4 av = rb[B][i]; const long a0_ = (long)(((unsigned long long)av.y << 32) | av.x), a1_ = (long)(((unsigned long long)av.w << 32) | av.z); \
                acc0 = __builtin_amdgcn_mfma_f32_16x16x32_fp8_fp8(a0_, bh_, acc0, 0, 0, 0); acc1 = __builtin_amdgcn_mfma_f32_16x16x32_fp8_fp8(a1_, bh_, acc1, 0, 0, 0); \
                acc0 = __builtin_amdgcn_mfma_f32_16x16x32_fp8_fp8(a0_, bl_, acc0, 0, 0, 0); acc1 = __builtin_amdgcn_mfma_f32_16x16x32_fp8_fp8(a1_, bl_, acc1, 0, 0, 0); } \
            if (QT == 3) { \
                if (dvalid) { LAS float* tp_ = tr + 128 * (qq >> 1) + dcol; _Pragma("unroll") for (int i = 0; i < 4; ++i) { tp_[16 * i] = acc0[i]; tp_[16 * i + 8] = acc1[i]; } } \
                const f32x2 e0_ = *(const LAS f32x2*)(tr + 2 * lane), e1_ = *(const LAS f32x2*)(tr + 128 + 2 * lane);                 \
                const unsigned hv = lr[(k_ & (PB - 1)) * 64 + lane];                                                                     \
                const unsigned w2_ = pk2(__uint_as_float(hv << 16) + (e0_.x + e1_.x) * (1.f / (VSCALE * CSCALE)), __uint_as_float(hv & 0xffff0000u) + (e0_.y + e1_.y) * (1.f / (VSCALE * CSCALE))); \
                *(unsigned*)(hb + t_ * D + 128 * slice + 2 * lane) = w2_; const float x0 = __uint_as_float(w2_ << 16), x1 = __uint_as_float(w2_ & 0xffff0000u); \
                float sq = x0 * x0 + x1 * x1; sq = wave_sum(sq); if (lane == 0) ssp1[t_ * 8 + slice] = sq; } asm volatile("" ::: "memory"); __builtin_amdgcn_sched_barrier(0); } while (0)
    if (ntok >= 8 && !(ntok & 1)) {
        u32x4 rb[8][4]; ge::f32x4 acc0, acc1; unsigned xi, xc, xr, yi, yc, yr;
        for (int k = 0; k < 6; ++k) { unsigned a_, b_, c_; PV_SLOAD(k, a_, b_, c_); PV_SWRITE(k, a_, b_, c_); }
        PV_SLOAD(6, xi, xc, xr); PV_SLOAD(7, yi, yc, yr);
        asm volatile("s_waitcnt vmcnt(0) lgkmcnt(0)" ::: "memory");
        PV_ISSUE(0, 0); PV_ISSUE(1, 1); PV_ISSUE(2, 2); PV_ISSUE(3, 3); PV_ISSUE(4, 4); PV_ISSUE(5, 5); PV_ISSUE(6, 6);
        const int send = 4 * ntok - 8;
#pragma nounroll
        for (int s0 = 0; s0 < send; s0 += 8) {
            PV_SWRITE((s0 >> 2) + 6, xi, xc, xr); PV_SLOAD((s0 >> 2) + 8, xi, xc, xr);
            PV_STEP(s0, 0, 0, 1); PV_STEP(s0 + 1, 1, 1, 1); PV_STEP(s0 + 2, 2, 2, 1); PV_STEP(s0 + 3, 3, 3, 1);
            PV_SWRITE((s0 >> 2) + 7, yi, yc, yr); PV_SLOAD((s0 >> 2) + 9, yi, yc, yr);
            PV_STEP(s0 + 4, 4, 0, 1); PV_STEP(s0 + 5, 5, 1, 1); PV_STEP(s0 + 6, 6, 2, 1); PV_STEP(s0 + 7, 7, 3, 1); }
        { const int s0 = send; PV_STEP(s0, 0, 0, 1); PV_STEP(s0 + 1, 1, 1, 0); PV_STEP(s0 + 2, 2, 2, 0); PV_STEP(s0 + 3, 3, 3, 0); PV_STEP(s0 + 4, 4, 0, 0); PV_STEP(s0 + 5, 5, 1, 0); PV_STEP(s0 + 6, 6, 2, 0); PV_STEP(s0 + 7, 7, 3, 0); }
    } else {
        u32x4 rb[8][4]; ge::f32x4 acc0, acc1;
#pragma nounroll
        for (int k = 0; k < ntok; ++k) {
            { unsigned a_, b_, c_; PV_SLOAD(k, a_, b_, c_); PV_SWRITE(k, a_, b_, c_); } asm volatile("s_waitcnt vmcnt(0) lgkmcnt(0)" ::: "memory");
            const int s0 = 4 * k; PV_ISSUE(s0, 0); PV_ISSUE(s0 + 1, 1); PV_ISSUE(s0 + 2, 2); PV_ISSUE(s0 + 3, 3);
            PV_STEP(s0, 0, 0, 0); PV_STEP(s0 + 1, 1, 1, 0); PV_STEP(s0 + 2, 2, 2, 0); PV_STEP(s0 + 3, 3, 3, 0); }
    }
#undef PV_SLOAD
#undef PV_SWRITE
#undef PV_ISSUE
#undef PV_STEP
    asm volatile("s_waitcnt lgkmcnt(0)" ::: "memory");
}

__device__ __forceinline__ void ph_final(const bf16_t* __restrict__ hb, const float* __restrict__ ssp1, const float* __restrict__ g, float* __restrict__ out) {
    PH_IDS
    const int lane = TIDX & 63, gw = BIDX * 8 + __builtin_amdgcn_readfirstlane(TIDX >> 6), ngw = GDIM * 8;
    for (int w = gw; w < T; w += ngw) {
        const float rs = rsqrtf(sum8(ssp1 + (size_t)w * 8) * (1.f / D) + EPS);
        const u32x4* r = (const u32x4*)(hb + (size_t)w * D) + lane; const f32x4* gg = (const f32x4*)g; f32x4* o = (f32x4*)(out + (size_t)w * D);
#pragma unroll
        for (int j = 0; j < 2; ++j) { const u32x4 v = r[64 * j]; const int c4 = (64 * j + lane) * 2; const f32x4 g0 = gg[c4], g1 = gg[c4 + 1];
            o[c4] = (f32x4){__uint_as_float(v.x << 16) * rs * g0.x, __uint_as_float(v.x & 0xffff0000u) * rs * g0.y, __uint_as_float(v.y << 16) * rs * g0.z, __uint_as_float(v.y & 0xffff0000u) * rs * g0.w};
            o[c4 + 1] = (f32x4){__uint_as_float(v.z << 16) * rs * g1.x, __uint_as_float(v.z & 0xffff0000u) * rs * g1.y, __uint_as_float(v.w << 16) * rs * g1.z, __uint_as_float(v.w & 0xffff0000u) * rs * g1.w}; }
    }
}
}
namespace attn_body {
using bf16=__hip_bfloat16;
using bf16x8=__attribute__((ext_vector_type(8)))short;
using s16x4=__attribute__((ext_vector_type(4)))short;
using f32x16=__attribute__((ext_vector_type(16)))float;
using u32x4=__attribute__((ext_vector_type(4)))unsigned;
constexpr int BATCH=8,NHEAD=8,SEQ=4096,D=64,DM=NHEAD*D;
constexpr int OPITCH=1024,OCOL=512;
constexpr int NW=8,QBLK=32,QB=QBLK*NW,KVBLK=64,NQB=SEQ/QB;
constexpr int ATTN_PITCH=DM, ATTN_UNIT_ROWS=QB;
__device__ __forceinline__ int crow(int r,int hi){return (r&3)+8*(r>>2)+4*hi;}
#define SBAR() __builtin_amdgcn_sched_barrier(0)
__device__ __forceinline__ void cmask(f32x16&p0,f32x16&p1,int jb,int qrel,int hi){
  const float NEG=-INFINITY; int kb=64*jb+4*hi;
  #pragma unroll
  for(int r=0;r<16;++r){int kv=kb+(r&3)+8*(r>>2); if(kv>qrel)p0[r]=NEG; if(kv+32>qrel)p1[r]=NEG;}
}

constexpr int NSLOT=3, SLOTB=8192;
constexpr int LDS_K=0, LDS_V=NSLOT*SLOTB, LDS_WS=2*NSLOT*SLOTB, LDS_OST=LDS_WS+NW*64*4, LDS_CUM=LDS_OST+NW*4096, LDS_BYTES=LDS_CUM+SEQ*4;
constexpr float PRUNE_T=64.f;
constexpr float C2=0.125f*1.4426950408889634f;
__device__ __forceinline__ void glds16(const void*gsrc,unsigned lds_dst){unsigned keep;
  asm volatile("s_mov_b32 %0, m0\n\ts_mov_b32 m0, %2\n\ts_nop 0\n\tglobal_load_lds_dwordx4 %1, off\n\ts_mov_b32 m0, %0":"=&s"(keep):"v"(gsrc),"s"(lds_dst):"memory");}
__device__ __forceinline__ float max3f(float a,float b,float c){float r;asm("v_max3_f32 %0, %1, %2, %3":"=v"(r):"v"(a),"v"(b),"v"(c));return r;}
__device__ __forceinline__ float max2f(float a,float b){float r;asm("v_max_f32_e32 %0, %1, %2":"=v"(r):"v"(a),"v"(b));return r;}
__device__ __forceinline__ float fadd_s(float a,float b){float r;asm("v_add_f32_e32 %0, %1, %2":"=v"(r):"v"(a),"v"(b));return r;}
__device__ __forceinline__ float fsub_s(float a,float b){float r;asm("v_sub_f32_e32 %0, %1, %2":"=v"(r):"v"(a),"v"(b));return r;}
typedef float f32x4_t __attribute__((ext_vector_type(4)));
typedef float f32x2_t __attribute__((ext_vector_type(2))); typedef __bf16 bf16x2_t __attribute__((ext_vector_type(2)));
__device__ __forceinline__ unsigned cvtpk_s(float lo,float hi){f32x2_t v={lo,hi};bf16x2_t b=__builtin_convertvector(v,bf16x2_t);return __builtin_bit_cast(unsigned,b);}
#define WAIT_BAR(N) asm volatile("s_waitcnt vmcnt(" #N ") lgkmcnt(0)\n\ts_barrier":::"memory")

__device__ __forceinline__ void qkt(f32x16&p0,f32x16&p1,const char*Kslot,const bf16x8*qr,const f32x16&negm,int r32,int hi){
  const char*kb=Kslot+hi*1024+r32*16;
  #pragma unroll
  for(int d0=0;d0<4;++d0){
    const bf16x8 b0=*reinterpret_cast<const bf16x8*>(kb+d0*2048);
    const bf16x8 b1=*reinterpret_cast<const bf16x8*>(kb+d0*2048+512);
    if(d0==0){p0=__builtin_amdgcn_mfma_f32_32x32x16_bf16(b0,qr[0],negm,0,0,0);p1=__builtin_amdgcn_mfma_f32_32x32x16_bf16(b1,qr[0],negm,0,0,0);}
    else{p0=__builtin_amdgcn_mfma_f32_32x32x16_bf16(b0,qr[d0],p0,0,0,0);p1=__builtin_amdgcn_mfma_f32_32x32x16_bf16(b1,qr[d0],p1,0,0,0);}}
}
typedef __attribute__((address_space(3))) const char* lds_cptr;
typedef short v4i16_t __attribute__((ext_vector_type(4)));
__device__ __forceinline__ void kload8(bf16x8*kf,lds_cptr kp){
  kf[0]=*(const __attribute__((address_space(3))) bf16x8*)(kp);      kf[1]=*(const __attribute__((address_space(3))) bf16x8*)(kp+512);
  kf[2]=*(const __attribute__((address_space(3))) bf16x8*)(kp+2048); kf[3]=*(const __attribute__((address_space(3))) bf16x8*)(kp+2560);
  kf[4]=*(const __attribute__((address_space(3))) bf16x8*)(kp+4096); kf[5]=*(const __attribute__((address_space(3))) bf16x8*)(kp+4608);
  kf[6]=*(const __attribute__((address_space(3))) bf16x8*)(kp+6144); kf[7]=*(const __attribute__((address_space(3))) bf16x8*)(kp+6656);
}
__device__ __forceinline__ void kload2(bf16x8*kf,lds_cptr kp,int j){ kf[2*j]=*(const __attribute__((address_space(3))) bf16x8*)(kp+j*2048); kf[2*j+1]=*(const __attribute__((address_space(3))) bf16x8*)(kp+j*2048+512); }
__device__ __forceinline__ s16x4 vtr(lds_cptr p){ return __builtin_bit_cast(s16x4,__builtin_amdgcn_ds_read_tr16_b64_v4i16((__attribute__((address_space(3))) v4i16_t*)p)); }
__device__ __forceinline__ float rowmax(const f32x16&p0,const f32x16&p1){
  float a=max3f(p0[0],p0[1],p1[0]),b=max3f(p0[2],p0[3],p1[1]);a=max3f(a,p1[2],p1[3]);
  #pragma unroll
  for(int r=4;r<16;r+=4){a=max3f(a,p0[r],p0[r+1]);b=max3f(b,p0[r+2],p0[r+3]);a=max3f(a,p1[r],p1[r+1]);b=max3f(b,p1[r+2],p1[r+3]);}
  const float m=max2f(a,b);
  auto rr=__builtin_amdgcn_permlane32_swap(__float_as_uint(m),__float_as_uint(m),false,false);
  return max2f(__uint_as_float(rr[0]),__uint_as_float(rr[1]));
}
__device__ __forceinline__ void pv(f32x16*o,int vb,bf16x8 pa0,bf16x8 pa1,bf16x8 pa2,bf16x8 pa3){
  #pragma unroll
  for(int d0=0;d0<2;++d0){s16x4 lo[4],hi[4];
    #pragma unroll
    for(int ks=0;ks<4;++ks){
      asm volatile("ds_read_b64_tr_b16 %0,%1 offset:%c2":"=&v"(lo[ks]):"v"(vb),"i"(d0*4096+ks*1024):"memory");
      asm volatile("ds_read_b64_tr_b16 %0,%1 offset:%c2":"=&v"(hi[ks]):"v"(vb),"i"(d0*4096+ks*1024+512):"memory");}
    asm volatile("s_waitcnt lgkmcnt(0)":::"memory");SBAR();
    #define PK(k) (bf16x8){lo[k][0],lo[k][1],lo[k][2],lo[k][3],hi[k][0],hi[k][1],hi[k][2],hi[k][3]}
    o[d0]=__builtin_amdgcn_mfma_f32_32x32x16_bf16(pa0,PK(0),o[d0],0,0,0);
    o[d0]=__builtin_amdgcn_mfma_f32_32x32x16_bf16(pa1,PK(1),o[d0],0,0,0);
    o[d0]=__builtin_amdgcn_mfma_f32_32x32x16_bf16(pa2,PK(2),o[d0],0,0,0);
    o[d0]=__builtin_amdgcn_mfma_f32_32x32x16_bf16(pa3,PK(3),o[d0],0,0,0);
    #undef PK
  }
}

#ifndef ATTN_STORE16
#define ATTN_STORE16(p,v) (*(u32x4*)(p)=(v))
#endif
template<int THRL> __device__ __forceinline__ void attn_unit(int b,int h,int qb,const bf16*Q,const bf16*__restrict__ K,const bf16*__restrict__ V,const float*__restrict__ cum2,bf16*O,float*__restrict__ ssp,char*shm,int tid_){
  int tid=tid_; asm volatile("":"+v"(tid)); const int lane=tid&63,r32=lane&31,hi=lane>>5; const int wid=__builtin_amdgcn_readfirstlane(tid>>6);
  const long rowbase=(long)b*SEQ; const int q0=qb*QB;
  const bf16*Qw=Q+(rowbase+q0+wid*QBLK)*DM+h*D;
  const bf16*Kh=K+rowbase*DM+h*D,*Vh=V+rowbase*DM+h*D;
  const unsigned lds0=(unsigned)(uintptr_t)shm;
  float*wsf=(float*)(shm+LDS_WS)+wid*64;
  const int NTf=(q0+QB)/KVBLK; const float*cg=cum2+(long)(b*NHEAD+h)*SEQ;
  int ts; { const float thr=cg[q0]+PRUNE_T; const float ce=lane<NTf?cg[64*lane+63]:0.f; const unsigned long long m_=__ballot((lane<NTf)&&(ce<=thr));
    ts=m_?(int)__builtin_ctzll(m_):0; ts&=~1; if(ts>NTf-4)ts=NTf-4; ts=__builtin_amdgcn_readfirstlane(ts); }
  const bf16*ksrc=Kh+(long)(ts*KVBLK+lane)*DM+wid*8;
  const bf16*vsrc=Vh+(long)(ts*KVBLK+16*(wid&3)+(lane>>2))*DM+(wid>>2)*32+(lane&3)*8;
  const unsigned kdst=lds0+LDS_K+wid*1024, vdst=lds0+LDS_V+wid*1024;
  #define DMA_K(t,slot) glds16(ksrc+(long)(t)*KVBLK*DM,(unsigned)__builtin_amdgcn_readfirstlane(kdst+(slot)))
  #define DMA_V(t,slot) glds16(vsrc+(long)(t)*KVBLK*DM,(unsigned)__builtin_amdgcn_readfirstlane(vdst+(slot)))
  const int vb0=(int)(lds0+LDS_V)+((lane>>4)&1)*32+(lane&3)*8+(4*hi+((lane&15)>>2))*64;
  const char*Kbase=shm+LDS_K; bf16x8 kf[8];
  const lds_cptr shm3=(lds_cptr)shm; const lds_cptr kp0=shm3+LDS_K+hi*1024+r32*16; const lds_cptr vp0=shm3+LDS_V+((lane>>4)&1)*32+(lane&3)*8+(4*hi+((lane&15)>>2))*64;
  { float*cl=(float*)(shm+LDS_CUM); for(int i=tid+ts*KVBLK;i<q0+QB;i+=NW*64)cl[i-ts*KVBLK]=cg[i]; }
  const float cq2=cg[q0+wid*QBLK+r32];
  const __attribute__((address_space(3))) float* ckl=(const __attribute__((address_space(3))) float*)(shm3+LDS_CUM)+4*hi;
  #define BIAS(P0,P1,t) do{ const __attribute__((address_space(3))) float*ck_=ckl+64*(t); const float mm_=mhat-cq2; _Pragma("unroll") for(int g_=0;g_<4;++g_){ \
      const f32x4_t c0_=*(const __attribute__((address_space(3))) f32x4_t*)(ck_+8*g_)+mm_, c1_=*(const __attribute__((address_space(3))) f32x4_t*)(ck_+32+8*g_)+mm_; \
      _Pragma("unroll") for(int i_=0;i_<4;++i_){P0[4*g_+i_]-=c0_[i_];P1[4*g_+i_]-=c1_[i_];} SBAR(); } }while(0)
  const int NT=NTf-ts;
  DMA_K(0,0);DMA_V(0,0);DMA_K(1,SLOTB);
  bf16x8 qr[4];
  #pragma unroll
  for(int d0=0;d0<4;++d0)qr[d0]=*reinterpret_cast<const bf16x8*>(&Qw[(long)r32*DM+d0*16+hi*8]);
  float mhat=0.f,l_reg=0.f;f32x16 o[2];o[0]=f32x16{};o[1]=f32x16{};const f32x16 negm=f32x16{};
  const int qrel=wid*QBLK+r32;
  #define CMASK(P0,P1,t) do{int jb_=(t)-(NT-4); if(jb_>=0)cmask(P0,P1,jb_,qrel,hi);}while(0)
  bool resc=false;
  #define START(P0,P1) do{ const float rm=rowmax(P0,P1); resc=false; \
    { const float dl=rm; mhat=fadd_s(mhat,dl); \
      _Pragma("unroll") for(int r=0;r<16;++r){P0[r]=fsub_s(P0[r],dl);P1[r]=fsub_s(P1[r],dl);} \
      } \
    _Pragma("unroll") for(int r=0;r<16;++r)P0[r]=__builtin_amdgcn_exp2f(P0[r]); }while(0)
  #define RESC() do{ if(resc){ asm volatile("s_waitcnt lgkmcnt(0)":::"memory"); \
      _Pragma("unroll") for(int d_=0;d_<2;++d_) _Pragma("unroll") for(int r=0;r<16;++r)o[d_][r]*=wsf[crow(r,hi)]; } }while(0)
  f32x16 pA0,pA1,pB0,pB1;
  int sl_prev=0,sl_cur=0,sl_next=SLOTB;
  #define ROT() do{sl_prev=sl_cur;sl_cur=sl_next;sl_next=(sl_next==(NSLOT-1)*SLOTB)?0:sl_next+SLOTB;}while(0)
  DMA_K(2,2*SLOTB);
  WAIT_BAR(3);
  qkt(pA0,pA1,Kbase,qr,negm,r32,hi);asm volatile("s_nop 15\n\ts_nop 7":"+v"(pA0),"+v"(pA1));BIAS(pA0,pA1,0);CMASK(pA0,pA1,0);
  START(pA0,pA1);
  _Pragma("unroll") for(int r=0;r<16;++r)pA1[r]=__builtin_amdgcn_exp2f(pA1[r]);
  WAIT_BAR(0);
  DMA_K(3,0);DMA_V(1,SLOTB);
  ROT();
  kload8(kf,kp0+sl_cur);
  WAIT_BAR(2);
  s16x4 vlo[8],vhi[8]; u32x4 pw0,pw1,pw2,pw3;
  #define PKW(P,B) cvtpk_s(P[B],P[B+1])
  #define PAF(k) __builtin_bit_cast(bf16x8,pw##k)
  #define VFR(i) (bf16x8){vlo[i][0],vlo[i][1],vlo[i][2],vlo[i][3],vhi[i][0],vhi[i][1],vhi[i][2],vhi[i][3]}
  #define PIN(x) asm volatile("":"+v"(x))
  #define MX3(a,b,c) __builtin_fmaxf(__builtin_fmaxf((a),(b)),(c))
  #define GAPA(MF,A0,A1,A2,A3,W0,W1,PW) do{ MF; sacc+=A0; sacc+=A1; sacc+=A2; sacc+=A3; PIN(sacc); W0; W1; PIN(PW); SBAR(); }while(0)
  #define EX(v) __builtin_amdgcn_exp2f(v)
  #define GAPB(MF,X,B) do{ MF; X[B]=EX(X[B]); X[B+1]=EX(X[B+1]); X[B+2]=EX(X[B+2]); X[B+3]=EX(X[B+3]); PIN(X); SBAR(); }while(0)
  #define VRD(i) do{ vlo[i]=vtr(vp_+(((i)>>2)*4096+((i)&3)*1024)); vhi[i]=vtr(vp_+(((i)>>2)*4096+((i)&3)*1024+512)); }while(0)
  #define KRD(G,j) do{ if(G){ kload2(kf,kp0+sl_next,j); SBAR(); } }while(0)
  #define STEP(C0,C1,P0,P1,t,GK,GV,GL) do{ SBAR(); \
    const lds_cptr vp_=vp0+sl_prev; \
    VRD(0); SBAR(); float sacc=(P0[0]+P0[1]); \
    GAPA(C0=__builtin_amdgcn_mfma_f32_32x32x16_bf16(kf[0],qr[0],negm,0,0,0), P0[2],P0[3],P0[4],P0[5],     pw0[0]=PKW(P0,0), pw0[1]=PKW(P0,2), pw0); \
    VRD(4); SBAR(); GAPA(C1=__builtin_amdgcn_mfma_f32_32x32x16_bf16(kf[1],qr[0],negm,0,0,0), P0[6],P0[7],P0[8],P0[9],     pw0[2]=PKW(P0,4), pw0[3]=PKW(P0,6), pw0); \
    VRD(1); SBAR(); GAPA(C0=__builtin_amdgcn_mfma_f32_32x32x16_bf16(kf[2],qr[1],C0,0,0,0),   P0[10],P0[11],P0[12],P0[13], pw1[0]=PKW(P0,8), pw1[1]=PKW(P0,10), pw1); \
    VRD(5); SBAR(); GAPA(C1=__builtin_amdgcn_mfma_f32_32x32x16_bf16(kf[3],qr[1],C1,0,0,0),   P0[14],P0[15],P1[0],P1[1],   pw1[2]=PKW(P0,12),pw1[3]=PKW(P0,14), pw1); \
    VRD(2); SBAR(); GAPA(C0=__builtin_amdgcn_mfma_f32_32x32x16_bf16(kf[4],qr[2],C0,0,0,0),   P1[2],P1[3],P1[4],P1[5],     pw2[0]=PKW(P1,0), pw2[1]=PKW(P1,2), pw2); \
    VRD(6); SBAR(); GAPA(C1=__builtin_amdgcn_mfma_f32_32x32x16_bf16(kf[5],qr[2],C1,0,0,0),   P1[6],P1[7],P1[8],P1[9],     pw2[2]=PKW(P1,4), pw2[3]=PKW(P1,6), pw2); \
    VRD(3); SBAR(); GAPA(C0=__builtin_amdgcn_mfma_f32_32x32x16_bf16(kf[6],qr[3],C0,0,0,0),   P1[10],P1[11],P1[12],P1[13], pw3[0]=PKW(P1,8), pw3[1]=PKW(P1,10), pw3); \
    VRD(7); SBAR(); GAPA(C1=__builtin_amdgcn_mfma_f32_32x32x16_bf16(kf[7],qr[3],C1,0,0,0),   P1[14],P1[15],0.f,0.f,       pw3[2]=PKW(P1,12),pw3[3]=PKW(P1,14), pw3); \
    l_reg+=sacc; \
    if(GK){DMA_K((t)+3,sl_cur);} if(GV){DMA_V((t)+1,sl_next);} \
    BIAS(C0,C1,t); CMASK(C0,C1,t); \
    { float a=MX3(C0[0],C0[1],C1[0]),b=MX3(C0[2],C0[3],C1[1]); a=MX3(a,C1[2],C1[3]); \
      _Pragma("unroll") for(int r=4;r<16;r+=4){a=MX3(a,C0[r],C0[r+1]);b=MX3(b,C0[r+2],C0[r+3]);a=MX3(a,C1[r],C1[r+1]);b=MX3(b,C1[r+2],C1[r+3]);} \
      float rm=__builtin_fmaxf(a,b); { auto rr=__builtin_amdgcn_permlane32_swap(__float_as_uint(rm),__float_as_uint(rm),false,false); rm=__builtin_fmaxf(__uint_as_float(rr[0]),__uint_as_float(rr[1])); } \
      resc=false; \
      if(__builtin_expect(__any(rm>(float)THRL),0)){ const float dl=__builtin_fmaxf(rm,0.f); mhat+=dl; \
        _Pragma("unroll") for(int r=0;r<16;++r){C0[r]-=dl;C1[r]-=dl;} \
        const float f=__builtin_amdgcn_exp2f(-dl); l_reg*=f; if(hi==0)wsf[r32]=f; resc=true; } } \
    SBAR(); \
    GAPB(o[0]=__builtin_amdgcn_mfma_f32_32x32x16_bf16(PAF(0),VFR(0),o[0],0,0,0), C0,0); \
    GAPB(o[1]=__builtin_amdgcn_mfma_f32_32x32x16_bf16(PAF(0),VFR(4),o[1],0,0,0), C0,4); \
    KRD(GL,0); GAPB(o[0]=__builtin_amdgcn_mfma_f32_32x32x16_bf16(PAF(1),VFR(1),o[0],0,0,0), C0,8); \
    KRD(GL,1); GAPB(o[1]=__builtin_amdgcn_mfma_f32_32x32x16_bf16(PAF(1),VFR(5),o[1],0,0,0), C0,12); \
    KRD(GL,2); GAPB(o[0]=__builtin_amdgcn_mfma_f32_32x32x16_bf16(PAF(2),VFR(2),o[0],0,0,0), C1,0); \
    KRD(GL,3); GAPB(o[1]=__builtin_amdgcn_mfma_f32_32x32x16_bf16(PAF(2),VFR(6),o[1],0,0,0), C1,4); \
    GAPB(o[0]=__builtin_amdgcn_mfma_f32_32x32x16_bf16(PAF(3),VFR(3),o[0],0,0,0), C1,8); \
    GAPB(o[1]=__builtin_amdgcn_mfma_f32_32x32x16_bf16(PAF(3),VFR(7),o[1],0,0,0), C1,12); \
    }while(0)
  int t=1;
  #undef CMASK
  #define CMASK(P0,P1,t) do{}while(0)
  for(;t+5<NT;t+=2){
    STEP(pB0,pB1,pA0,pA1,t,true,true,true);     WAIT_BAR(2); RESC(); ROT();
    STEP(pA0,pA1,pB0,pB1,t+1,true,true,true);   WAIT_BAR(2); RESC(); ROT();
  }
  #undef CMASK
  #define CMASK(P0,P1,t) do{int jb_=(t)-(NT-4); if(jb_>=0)cmask(P0,P1,jb_,qrel,hi);}while(0)
  #define ENDW(tt) do{ if((tt)+3<NT){WAIT_BAR(2);} else if((tt)+2<NT){WAIT_BAR(1);} else {WAIT_BAR(0);} }while(0)
  for(;t+1<NT;t+=2){
    STEP(pB0,pB1,pA0,pA1,t,(t+3<NT),(t+1<NT),(t+1<NT));       ENDW(t);   RESC(); ROT();
    STEP(pA0,pA1,pB0,pB1,t+1,(t+4<NT),(t+2<NT),(t+2<NT));     ENDW(t+1); RESC(); ROT();
  }
  STEP(pB0,pB1,pA0,pA1,NT-1,false,false,false); RESC();
  { float sacc=pB0[0]+pB0[1]; _Pragma("unroll") for(int r=2;r<16;++r)sacc+=pB0[r]; _Pragma("unroll") for(int r=0;r<16;++r)sacc+=pB1[r]; l_reg+=sacc;
    pw0=(u32x4){PKW(pB0,0),PKW(pB0,2),PKW(pB0,4),PKW(pB0,6)};pw1=(u32x4){PKW(pB0,8),PKW(pB0,10),PKW(pB0,12),PKW(pB0,14)};pw2=(u32x4){PKW(pB1,0),PKW(pB1,2),PKW(pB1,4),PKW(pB1,6)};pw3=(u32x4){PKW(pB1,8),PKW(pB1,10),PKW(pB1,12),PKW(pB1,14)};
    SBAR(); pv(o,vb0+sl_cur,PAF(0),PAF(1),PAF(2),PAF(3)); }
  #undef PKW
  #undef PAF
  #undef VFR
  #undef PIN
  #undef MX3
  #undef GAPA
  #undef GAPB
  #undef EX
  #undef VRD
  #undef KRD
  #undef STEP
  #undef ENDW
  {auto rr=__builtin_amdgcn_permlane32_swap(__float_as_uint(l_reg),__float_as_uint(l_reg),false,false);l_reg=__uint_as_float(rr[0])+__uint_as_float(rr[1]);}
  if(hi==0)wsf[32+r32]=l_reg;asm volatile("s_waitcnt lgkmcnt(0)":::"memory");
  float rli[16];
  #pragma unroll
  for(int r=0;r<16;++r)rli[r]=__builtin_amdgcn_rcpf(wsf[32+crow(r,hi)]);
  int lane_e=lane; asm volatile("":"+v"(lane_e));
  bf16*Ow=O+(rowbase+q0+wid*QBLK)*OPITCH+OCOL+h*D; float*sw=ssp+(rowbase+q0+wid*QBLK)*8+h;
  { bf16*stg=(bf16*)(shm+LDS_OST)+wid*2048;
    #pragma unroll
    for(int r=0;r<16;++r){const int orow=crow(r,hi);
      #pragma unroll
      for(int d0=0;d0<2;++d0)stg[orow*64+d0*32+r32]=__float2bfloat16(o[d0][r]*rli[r]);}
    asm volatile("s_waitcnt lgkmcnt(0)":::"memory");
    #pragma unroll
    for(int i=0;i<4;++i){const int row=i*8+(lane_e>>3),ch=lane_e&7; const u32x4 v=*(const u32x4*)(stg+row*64+ch*8); ATTN_STORE16(Ow+(long)row*OPITCH+ch*8,v);
      float sq=0.f;
      #pragma unroll
      for(int k=0;k<4;++k){const float a=__uint_as_float(v[k]<<16),c=__uint_as_float(v[k]&0xffff0000u);sq+=a*a+c*c;}
      sq+=__shfl_xor(sq,1);sq+=__shfl_xor(sq,2);sq+=__shfl_xor(sq,4);
      if(ch==0)sw[(long)row*8]=sq; } }
  asm volatile("s_waitcnt lgkmcnt(0)\n\ts_barrier":::"memory");
  #undef DMA_K
  #undef DMA_V
  #undef CMASK
  #undef START
  #undef RESC
  #undef BIAS
  #undef ROT
}
constexpr int ATTN_LDS_BYTES=LDS_BYTES;
template<int THRL=8> __device__ __forceinline__ void attn_phase(char*lds,const bf16*Q,const bf16*K,const bf16*V,const float*cum2,bf16*O,float*ssp,unsigned*ctr,volatile __attribute__((address_space(3))) unsigned*slot,int tid){
  for(;;){
    if(tid==0)*slot=__hip_atomic_fetch_add(ctr,1u,__ATOMIC_RELAXED,__HIP_MEMORY_SCOPE_AGENT);
    __syncthreads();
    const int u=(int)*slot;
    __syncthreads();
    if(u>=BATCH*NHEAD*NQB)break;
    const int qb=NQB-1-(u>>6),h=NHEAD-1-((u>>3)&7),b=u&7;
    attn_unit<THRL>(b,h,qb,Q,K,V,cum2,O,ssp,lds,tid);
  }
}
#undef SBAR
#undef WAIT_BAR
}
namespace nv {
typedef float f32x2v __attribute__((ext_vector_type(2)));
constexpr size_t WS_APOW = 921 * MiB;
constexpr size_t WS_BBAR = 89 * MiB;
constexpr int KDW = 128 * 256;
__device__ __forceinline__ void p0_ssm_a(const float* __restrict__ lam_re, const float* __restrict__ lam_im, const float* __restrict__ log_dt, const float* __restrict__ b_re, const float* __restrict__ b_im,
                                         f32x2v* __restrict__ apow, f32x2v* __restrict__ bbar) {
    PH_IDS
    for (int i = BIDX * 512 + TIDX; i < DEPTH * G * P; i += GDIM * 512) {
        const int lg = i / P, p = i % P;
        const float dtf = expf(log_dt[lg]); const float lr = lam_re[i], li = lam_im[i];
        const double ang = (double)li * (double)dtf, k2 = rint(ang * 0.15915494309189535), red = ang - k2 * 6.283185307179586;
        const float mag = expf(lr * dtf), rr = (float)red; const double are = (double)(mag * cosf(rr)), aim = (double)(mag * sinf(rr));
        double pr = 1.0, pi = 0.0;
        for (int d = 0; d <= 64; ++d) { apow[((size_t)lg * 65 + d) * P + p] = (f32x2v){(float)pr, (float)pi}; const double nr_ = pr * are - pi * aim, ni_ = pr * aim + pi * are; pr = nr_; pi = ni_; }
        const double lrd = lr, lid = li, den = lrd * lrd + lid * lid, nr = are - 1.0, zre = (nr * lrd + aim * lid) / den, zim = (aim * lrd - nr * lid) / den;
        for (int h = 0; h < HC; ++h) { const double br = b_re[(size_t)i * HC + h], bi = b_im[(size_t)i * HC + h]; bbar[(size_t)i * HC + h] = (f32x2v){(float)(zre * br - zim * bi), (float)(zre * bi + zim * br)}; }
    }
}
__device__ __forceinline__ void p0_ssm_b(const f32x2v* __restrict__ apow, const f32x2v* __restrict__ bbar, const float* __restrict__ c_re, const float* __restrict__ c_im, const float* __restrict__ dsk,
                                         bf16_t* __restrict__ KD, bf16_t* __restrict__ WST, bf16_t* __restrict__ WOUT) {
    PH_IDS
    const int gt = BIDX * 512 + TIDX, nth = GDIM * 512;
    for (int i = gt; i < DEPTH * G * KDW; i += nth) {
        const int lg = i / KDW, r = i % KDW, dd = r >> 8, h = (r >> 4) & 15, h2 = r & 15, d = dd - 63;
        float v = 0.f;
        if (d >= 0 && dd < 127) {
            const f32x2v* ap = apow + ((size_t)lg * 65 + d) * P; const f32x2v* bb = bbar + (size_t)lg * P * HC + h2; const float* cr = c_re + ((size_t)lg * HC + h) * P; const float* ci = c_im + ((size_t)lg * HC + h) * P;
            for (int p = 0; p < P; ++p) { const f32x2v a = ap[p], b = bb[(size_t)p * HC]; const float wr = a.x * b.x - a.y * b.y, wi = a.x * b.y + a.y * b.x; v += cr[p] * wr - ci[p] * wi; }
            if (d == 0 && h == h2) v += dsk[lg * HC + h];
        }
        KD[i] = f2bf(v);
    }
    for (int i = gt; i < DEPTH * G * 128 * 256; i += nth) {
        const int lg = i >> 15, r = i & 32767, row = r >> 8, k = r & 255, j = k >> 4, h2 = k & 15, p = row & 63;
        const f32x2v a = apow[((size_t)lg * 65 + (15 - j)) * P + p], b = bbar[((size_t)lg * P + p) * HC + h2];
        WST[i] = f2bf(row < 64 ? a.x * b.x - a.y * b.y : a.x * b.y + a.y * b.x);
    }
    for (int i = gt; i < DEPTH * G * 1024 * 128; i += nth) {
        const int lg = i >> 17, r = i & 131071, row = r >> 7, k = r & 127, ti = row >> 4, h = row & 15, p = k & 63;
        const f32x2v e = apow[((size_t)lg * 65 + ti + 1) * P + p]; const float cr = c_re[((size_t)lg * HC + h) * P + p], ci = c_im[((size_t)lg * HC + h) * P + p];
        WOUT[i] = f2bf(k < 64 ? cr * e.x - ci * e.y : -(cr * e.y + ci * e.x));
    }
}

struct SchedSsmS {
    static constexpr bool DUALB = false; long hA, hB, hB1;
    const char* UP; const char* WST; int G_, c;
    __device__ __forceinline__ void init(const void* up, const void* wst_l, int grid, int bid) { UP = (const char*)up; WST = (const char*)wst_l; G_ = grid; c = bid; hA = 128l * UPW * 2; hB = 0; hB1 = 0; }
    __device__ __forceinline__ bool next(int i, ge::Unit& u) const {
        const int L = i * G_ + c; if (L >= G * 2 * 4) return false;
        const int g = L >> 3, pm = (L >> 2) & 1, ks = L & 3;
        u.A0 = UP + (((size_t)g * NCH + pm * 256) * UPW + 128 + ks * 256) * 2; u.B0 = WST + (size_t)g * 128 * 256 * 2; u.nt = 4; u.pm = pm; u.pn = ks; u.aux = g; return true; }
    __device__ __forceinline__ const char* ta(const ge::Unit& u, int t) const { return u.A0 + t * 128; }
    __device__ __forceinline__ const char* tb(const ge::Unit& u, int t) const { return u.B0 + t * 128; }
    __device__ __forceinline__ bool sb(const ge::Unit&, int) const { return false; }
    __device__ __forceinline__ unsigned voffA(int R, int C) const { return (unsigned)(R * UPW * 2 + C * 2); }
    __device__ __forceinline__ unsigned voffB(int Rb, int C) const { return (unsigned)(Rb * 512 + C * 2); }
    __device__ __forceinline__ unsigned voffB1(int, int) const { return 0u; }
};
struct EpiSsmS {
    static constexpr bool PERM = false, MIDK = false, UBEGIN = false;
    float* SLOC;
    __device__ __forceinline__ void unit_begin(const ge::Unit&, int, LAS unsigned char*) const {}
    __device__ __forceinline__ void midk(ge::f32x4 (&)[2][2][4][2], const ge::Unit&, int, int, LAS unsigned char*) const {}
    __device__ __forceinline__ void operator()(const ge::f32x4 (&acc)[2][2][4][2], const ge::Unit& u, int wr, int wc, int fr, int fq, LAS unsigned char*) const {
        const int g = u.aux, ks = u.pn;
#pragma unroll
        for (int ai = 0; ai < 2; ++ai)
#pragma unroll
            for (int m = 0; m < 4; ++m) {
                const int chunk = u.pm * 256 + ai * 128 + wr * 64 + m * 16 + fr; float* dst = SLOC + ((size_t)g * (NCH * 4) + chunk * 4 + ks) * 128;
#pragma unroll
                for (int n = 0; n < 2; ++n) *(ge::f32x4*)(dst + wc * 32 + 16 * n + 4 * fq) = acc[ai][0][m][n];
            }
    }
};

__device__ __forceinline__ void ph_ssm_prefix(LAS unsigned char* lds, const float* __restrict__ SLOC, const f32x2v* __restrict__ apow_l, bf16_t* __restrict__ UP) {
    PH_IDS
    const int p = TIDX & 63, w = __builtin_amdgcn_readfirstlane(TIDX >> 6);
    LAS f32x2v* ex = (LAS f32x2v*)lds;
    for (int item = BIDX; item < BATCH * G; item += GDIM) {
        const int b = item / G, g = item % G;
        const f32x2v a16 = apow_l[((size_t)g * 65 + 16) * P + p];
        const float* src = SLOC + ((size_t)g * (NCH * 4) + (size_t)b * 256 + 32 * w) * 128 + p; bf16_t* dst = UP + ((size_t)g * NCH + b * 64 + 8 * w) * UPW + p;
        float xr[32], xi[32];
#pragma unroll
        for (int k = 0; k < 32; ++k) { xr[k] = src[(size_t)k * 128]; xi[k] = src[(size_t)k * 128 + 64]; }
        float sr = 0.f, si = 0.f;
#pragma unroll
        for (int k = 0; k < 32; ++k) { const float nr = a16.x * sr - a16.y * si + xr[k], ni = a16.x * si + a16.y * sr + xi[k]; sr = nr; si = ni; }
        ex[w * 64 + p] = (f32x2v){sr, si};
        float qr = a16.x, qi = a16.y;
#pragma unroll
        for (int k = 0; k < 5; ++k) { const float nr = qr * qr - qi * qi, ni = 2.f * qr * qi; qr = nr; qi = ni; }
        __syncthreads();
        sr = 0.f; si = 0.f;
        for (int j = 0; j < w; ++j) { const f32x2v e = ex[j * 64 + p]; const float nr = qr * sr - qi * si + e.x, ni = qr * si + qi * sr + e.y; sr = nr; si = ni; }
#pragma unroll
        for (int k = 0; k < 32; ++k) {
            if ((k & 3) == 0) { bf16_t* d = dst + (size_t)(k >> 2) * UPW; d[0] = f2bf(sr); d[64] = f2bf(si); }
            const float nr = a16.x * sr - a16.y * si + xr[k], ni = a16.x * si + a16.y * sr + xi[k]; sr = nr; si = ni;
        }
        __syncthreads();
    }
}
__device__ __forceinline__ void ph_cum2(const float* __restrict__ logf, float* __restrict__ cum) {
    PH_IDS
    const int lane = TIDX & 63, gw = BIDX * 8 + __builtin_amdgcn_readfirstlane(TIDX >> 6), ngw = GDIM * 8;
    for (int item = gw; item < BATCH * NH; item += ngw) {
        const int b = item / NH, h = item % NH;
        const float* src = logf + ((size_t)b * SEQ + lane * 64) * NH + h; float* dst = cum + (size_t)item * SEQ + lane * 64;
        float tot = 0.f;
        for (int i = 0; i < 64; ++i) tot += src[(size_t)i * NH];
        float ex = tot;
#pragma unroll
        for (int o = 1; o < 64; o <<= 1) { const float y = __shfl_up(ex, o); if (lane >= o) ex += y; }
        float run = ex - tot;
        for (int i = 0; i < 64; ++i) { run += src[(size_t)i * NH]; dst[i] = run * 1.4426950408889634f; }
    }
}

struct SchedSsmC {
    static constexpr bool DUALB = true; long hA, hB, hB1;
    const char* UP; const char* WOUT; const char* KD; int G_, c;
    __device__ __forceinline__ void init(const void* up, const void* wout_l, const void* kd_l, int grid, int bid) { UP = (const char*)up; WOUT = (const char*)wout_l; KD = (const char*)kd_l; G_ = grid; c = bid; hA = 128l * UPW * 2; hB = 128l * 256; hB1 = 8l * 512; }
    __device__ __forceinline__ bool next(int i, ge::Unit& u) const {
        const int L = i * G_ + c; if (L >= G * 2 * 4) return false;
        const int pn = 3 - (L >> 6), g = (L & 63) >> 1, pm = L & 1;
        u.A0 = UP + ((size_t)g * NCH + pm * 256) * UPW * 2; u.B0 = nullptr; u.nt = 2 + 4 * (pn + 1); u.pm = pm; u.pn = pn; u.aux = g; return true; }
    __device__ __forceinline__ const char* ta(const ge::Unit& u, int t) const { return u.A0 + t * 128; }
    __device__ __forceinline__ bool sb(const ge::Unit&, int t) const { return t >= 2; }
    __device__ __forceinline__ const char* tb(const ge::Unit& u, int t) const {
        return t < 2 ? WOUT + ((size_t)u.aux * 1024 + u.pn * 256) * 256 + t * 128 : KD + ((size_t)u.aux * KDW + (size_t)(16 * u.pn - 4 * (t - 2) + 60) * 256) * 2; }
    __device__ __forceinline__ unsigned voffA(int R, int C) const { return (unsigned)(R * UPW * 2 + C * 2); }
    __device__ __forceinline__ unsigned voffB(int Rb, int C) const { return (unsigned)(Rb * 256 + C * 2); }
    __device__ __forceinline__ unsigned voffB1(int Rb, int C) const { return (unsigned)((((Rb >> 4) + 3 - (C >> 4)) * 256 + (Rb & 15) * 16 + (C & 15)) * 2); }
};
__device__ __forceinline__ float gelu_fast(float x) { const float u = 1.5957691216057308f * (x + 0.044715f * x * x * x); return x - x / (1.f + __expf(u)); }
struct EpiSsmC {
    static constexpr bool PERM = true, MIDK = false, UBEGIN = false;
    bf16_t* GEL;
    __device__ __forceinline__ void unit_begin(const ge::Unit&, int, LAS unsigned char*) const {}
    __device__ __forceinline__ void midk(ge::f32x4 (&)[2][2][4][2], const ge::Unit&, int, int, LAS unsigned char*) const {}
    __device__ __forceinline__ void operator()(const ge::f32x4 (&acc)[2][2][4][2], const ge::Unit& u, int wr, int wc, int fr, int fq, LAS unsigned char*) const {
        const int g = u.aux;
#pragma unroll
        for (int ai = 0; ai < 2; ++ai)
#pragma unroll
            for (int m = 0; m < 4; ++m) {
                const int chunk = u.pm * 256 + ai * 128 + wr * 64 + m * 16 + fr;
#pragma unroll
                for (int bj = 0; bj < 2; ++bj) {
                    const int col = u.pn * 256 + bj * 128 + wc * 32 + 8 * fq, ti = col >> 4, h0 = col & 15;
                    const ge::f32x4 v0 = acc[ai][bj][m][0], v1 = acc[ai][bj][m][1];
                    u32x4 w; w.x = ge::cvt_pk_bf16(gelu_fast(v0[0]), gelu_fast(v0[1])); w.y = ge::cvt_pk_bf16(gelu_fast(v0[2]), gelu_fast(v0[3]));
                    w.z = ge::cvt_pk_bf16(gelu_fast(v1[0]), gelu_fast(v1[1])); w.w = ge::cvt_pk_bf16(gelu_fast(v1[2]), gelu_fast(v1[3]));
                    *(u32x4*)(GEL + ((size_t)g * T + chunk * 64 + ti) * HC + h0) = w;
                }
            }
    }
};
}
namespace nv {
#define SEL_CE(x, y) do { const int _h = max((x), (y)), _l = min((x), (y)); (x) = _h; (y) = _l; } while (0)
__device__ __forceinline__ void sel_sort16(int (&v)[16]) {
    SEL_CE(v[0], v[1]);
    SEL_CE(v[2], v[3]);
    SEL_CE(v[0], v[2]);
    SEL_CE(v[1], v[3]);
    SEL_CE(v[1], v[2]);
    SEL_CE(v[4], v[5]);
    SEL_CE(v[6], v[7]);
    SEL_CE(v[4], v[6]);
    SEL_CE(v[5], v[7]);
    SEL_CE(v[5], v[6]);
    SEL_CE(v[0], v[4]);
    SEL_CE(v[2], v[6]);
    SEL_CE(v[2], v[4]);
    SEL_CE(v[1], v[5]);
    SEL_CE(v[3], v[7]);
    SEL_CE(v[3], v[5]);
    SEL_CE(v[1], v[2]);
    SEL_CE(v[3], v[4]);
    SEL_CE(v[5], v[6]);
    SEL_CE(v[8], v[9]);
    SEL_CE(v[10], v[11]);
    SEL_CE(v[8], v[10]);
    SEL_CE(v[9], v[11]);
    SEL_CE(v[9], v[10]);
    SEL_CE(v[12], v[13]);
    SEL_CE(v[14], v[15]);
    SEL_CE(v[12], v[14]);
    SEL_CE(v[13], v[15]);
    SEL_CE(v[13], v[14]);
    SEL_CE(v[8], v[12]);
    SEL_CE(v[10], v[14]);
    SEL_CE(v[10], v[12]);
    SEL_CE(v[9], v[13]);
    SEL_CE(v[11], v[15]);
    SEL_CE(v[11], v[13]);
    SEL_CE(v[9], v[10]);
    SEL_CE(v[11], v[12]);
    SEL_CE(v[13], v[14]);
    SEL_CE(v[0], v[8]);
    SEL_CE(v[4], v[12]);
    SEL_CE(v[4], v[8]);
    SEL_CE(v[2], v[10]);
    SEL_CE(v[6], v[14]);
    SEL_CE(v[6], v[10]);
    SEL_CE(v[2], v[4]);
    SEL_CE(v[6], v[8]);
    SEL_CE(v[10], v[12]);
    SEL_CE(v[1], v[9]);
    SEL_CE(v[5], v[13]);
    SEL_CE(v[5], v[9]);
    SEL_CE(v[3], v[11]);
    SEL_CE(v[7], v[15]);
    SEL_CE(v[7], v[11]);
    SEL_CE(v[3], v[5]);
    SEL_CE(v[7], v[9]);
    SEL_CE(v[11], v[13]);
    SEL_CE(v[1], v[2]);
    SEL_CE(v[3], v[4]);
    SEL_CE(v[5], v[6]);
    SEL_CE(v[7], v[8]);
    SEL_CE(v[9], v[10]);
    SEL_CE(v[11], v[12]);
    SEL_CE(v[13], v[14]);
}
__device__ __forceinline__ void sel_merge16(int (&a)[16], const int (&b)[16]) {
    a[0] = max(a[0], b[15]);
    a[1] = max(a[1], b[14]);
    a[2] = max(a[2], b[13]);
    a[3] = max(a[3], b[12]);
    a[4] = max(a[4], b[11]);
    a[5] = max(a[5], b[10]);
    a[6] = max(a[6], b[9]);
    a[7] = max(a[7], b[8]);
    a[8] = max(a[8], b[7]);
    a[9] = max(a[9], b[6]);
    a[10] = max(a[10], b[5]);
    a[11] = max(a[11], b[4]);
    a[12] = max(a[12], b[3]);
    a[13] = max(a[13], b[2]);
    a[14] = max(a[14], b[1]);
    a[15] = max(a[15], b[0]);
    SEL_CE(a[0], a[8]);
    SEL_CE(a[1], a[9]);
    SEL_CE(a[2], a[10]);
    SEL_CE(a[3], a[11]);
    SEL_CE(a[4], a[12]);
    SEL_CE(a[5], a[13]);
    SEL_CE(a[6], a[14]);
    SEL_CE(a[7], a[15]);
    SEL_CE(a[0], a[4]);
    SEL_CE(a[1], a[5]);
    SEL_CE(a[2], a[6]);
    SEL_CE(a[3], a[7]);
    SEL_CE(a[8], a[12]);
    SEL_CE(a[9], a[13]);
    SEL_CE(a[10], a[14]);
    SEL_CE(a[11], a[15]);
    SEL_CE(a[0], a[2]);
    SEL_CE(a[1], a[3]);
    SEL_CE(a[4], a[6]);
    SEL_CE(a[5], a[7]);
    SEL_CE(a[8], a[10]);
    SEL_CE(a[9], a[11]);
    SEL_CE(a[12], a[14]);
    SEL_CE(a[13], a[15]);
    SEL_CE(a[0], a[1]);
    SEL_CE(a[2], a[3]);
    SEL_CE(a[4], a[5]);
    SEL_CE(a[6], a[7]);
    SEL_CE(a[8], a[9]);
    SEL_CE(a[10], a[11]);
    SEL_CE(a[12], a[13]);
    SEL_CE(a[14], a[15]);
}
constexpr int SEL_NCAND = 50;
#define SEL_CANDS(F) \
    F(0, 0, 0) \
    F(1, 0, 1) \
    F(2, 0, 2) \
    F(3, 0, 3) \
    F(4, 0, 4) \
    F(5, 0, 5) \
    F(6, 0, 6) \
    F(7, 0, 7) \
    F(8, 0, 8) \
    F(9, 0, 9) \
    F(10, 0, 10) \
    F(11, 0, 11) \
    F(12, 0, 12) \
    F(13, 0, 13) \
    F(14, 0, 14) \
    F(15, 0, 15) \
    F(16, 1, 0) \
    F(17, 1, 1) \
    F(18, 1, 2) \
    F(19, 1, 3) \
    F(20, 1, 4) \
    F(21, 1, 5) \
    F(22, 1, 6) \
    F(23, 1, 7) \
    F(24, 2, 0) \
    F(25, 2, 1) \
    F(26, 2, 2) \
    F(27, 2, 3) \
    F(28, 2, 4) \
    F(29, 3, 0) \
    F(30, 3, 1) \
    F(31, 3, 2) \
    F(32, 3, 3) \
    F(33, 4, 0) \
    F(34, 4, 1) \
    F(35, 4, 2) \
    F(36, 5, 0) \
    F(37, 5, 1) \
    F(38, 6, 0) \
    F(39, 6, 1) \
    F(40, 7, 0) \
    F(41, 7, 1) \
    F(42, 8, 0) \
    F(43, 9, 0) \
    F(44, 10, 0) \
    F(45, 11, 0) \
    F(46, 12, 0) \
    F(47, 13, 0) \
    F(48, 14, 0) \
    F(49, 15, 0)
constexpr float SEL_BIAS = 16.f;
__device__ __forceinline__ int f2key(float f) { return __float_as_int(f); }
__device__ __forceinline__ float key2f(int k) { return __int_as_float(k); }
__device__ __forceinline__ void sel_top16(const f32x16 (&acc)[4], int hi, int (&t)[16]) {
    int g1[16], g2[16], g3[16];
#pragma unroll
    for (int r = 0; r < 16; ++r) { const int n = (r & 3) + 8 * (r >> 2) + 4 * hi;
        t[r] = (f2key(acc[0][r]) & ~0x7F) | n; g1[r] = (f2key(acc[1][r]) & ~0x7F) | (32 + n); g2[r] = (f2key(acc[2][r]) & ~0x7F) | (64 + n); g3[r] = (f2key(acc[3][r]) & ~0x7F) | (96 + n); }
    sel_sort16(t); sel_sort16(g1); sel_sort16(g2); sel_sort16(g3);
    sel_merge16(t, g1); sel_merge16(g2, g3); sel_merge16(t, g2);
#pragma unroll
    for (int i = 0; i < 16; ++i) { auto rr = __builtin_amdgcn_permlane32_swap((unsigned)t[i], (unsigned)t[i], false, false); g1[i] = (int)(hi ? rr[0] : rr[1]); }
    sel_merge16(t, g1);
}
__device__ __forceinline__ void ph_select(const bf16_t* __restrict__ QP, const bf16_t* __restrict__ KEYS, unsigned short* __restrict__ idx, float* __restrict__ gate, LAS unsigned char* lds) {
    PH_IDS
    const int lane = TIDX & 63, hd = __builtin_amdgcn_readfirstlane(TIDX >> 6), r = lane & 31, hi = lane >> 5;
    LAS unsigned* my = (LAS unsigned*)(lds + hd * 2048) + lane;
    for (int tg = BIDX; tg < T / 32; tg += GDIM) {
        const int tok0 = tg * 32;
        int rk = r; asm volatile("" : "+v"(rk));
        int t1[16], t2[16];
#pragma unroll
        for (int half = 0; half < 2; ++half) {
            f32x16 acc[4];
#pragma unroll
            for (int mt = 0; mt < 4; ++mt)
#pragma unroll
                for (int i = 0; i < 16; ++i) acc[mt][i] = SEL_BIAS;
            const bf16_t* qb = QP + (size_t)(tok0 + r) * D + hd * QD + half * HALF + 8 * hi;
            const bf16_t* kb = KEYS + ((size_t)(hd * 2 + half) * NK + rk) * HALF + 8 * hi;
#pragma unroll
            for (int ks = 0; ks < 4; ++ks) {
                const bf16x8 b = *(const bf16x8*)(qb + 16 * ks);
#pragma unroll
                for (int mt = 0; mt < 4; ++mt) { const bf16x8 a = *(const bf16x8*)(kb + (size_t)mt * 32 * HALF + 16 * ks); acc[mt] = __builtin_amdgcn_mfma_f32_32x32x16_bf16(a, b, acc[mt], 0, 0, 0); }
            }
            if (half == 0) sel_top16(acc, hi, t1); else sel_top16(acc, hi, t2);
        }
        float f1[16], f2[16];
#pragma unroll
        for (int i = 0; i < 16; ++i) { f1[i] = key2f(t1[i]); f2[i] = key2f(t2[i]); }
        int c0[16], c1[16], c2[16], c3[16];
#pragma unroll
        for (int i = 0; i < 16; ++i) c3[i] = (int)0x80000000;
#define SEL_F(k, i, j) { const int v_ = (f2key(f1[i] + f2[j]) & ~0xFF) | ((i) << 4 | (j)); if ((k) < 16) c0[(k) & 15] = v_; else if ((k) < 32) c1[(k) & 15] = v_; else if ((k) < 48) c2[(k) & 15] = v_; else c3[(k) & 15] = v_; }
        SEL_CANDS(SEL_F)
#undef SEL_F
          sel_sort16(c1); sel_sort16(c2); SEL_CE(c3[0], c3[1]);
        sel_merge16(c0, c1); sel_merge16(c2, c3); sel_merge16(c0, c2);
#pragma unroll
        for (int j = 0; j < 4; ++j) {
            my[64 * j] = (unsigned)(t1[4 * j] & 0x7F) | ((unsigned)(t1[4 * j + 1] & 0x7F) << 8) | ((unsigned)(t1[4 * j + 2] & 0x7F) << 16) | ((unsigned)(t1[4 * j + 3] & 0x7F) << 24);
            my[64 * (4 + j)] = (unsigned)(t2[4 * j] & 0x7F) | ((unsigned)(t2[4 * j + 1] & 0x7F) << 8) | ((unsigned)(t2[4 * j + 2] & 0x7F) << 16) | ((unsigned)(t2[4 * j + 3] & 0x7F) << 24);
        }
        const float mx = key2f(c0[0]); float e[16], se = 0.f;
#pragma unroll
        for (int k = 0; k < 16; ++k) { e[k] = __expf(key2f(c0[k]) - mx); se += e[k]; }
        const float inv = 1.f / se;
        asm volatile("s_waitcnt lgkmcnt(0)" ::: "memory");
        const size_t o = (size_t)(tok0 + r) * 128 + hd * TOPK;
        if (hi == 0) {
            int id[16];
#pragma unroll
            for (int k = 0; k < 16; ++k) { const int code = c0[k] & 0xFF, i = code >> 4, j = code & 15;
                const unsigned w1 = my[64 * (i >> 2)], w2 = my[64 * (4 + (j >> 2))];
                id[k] = (int)((w1 >> (8 * (i & 3))) & 0x7F) * NK + (int)((w2 >> (8 * (j & 3))) & 0x7F); }
            u32x4 w0, w1;
#pragma unroll
            for (int k = 0; k < 4; ++k) { w0[k] = (unsigned)id[2 * k] | ((unsigned)id[2 * k + 1] << 16); w1[k] = (unsigned)id[8 + 2 * k] | ((unsigned)id[9 + 2 * k] << 16); }
            *(u32x4*)(idx + o) = w0; *(u32x4*)(idx + o + 8) = w1;
        } else {
#pragma unroll
            for (int k = 0; k < 4; ++k) *(float4*)(gate + o + 4 * k) = make_float4(e[4 * k] * inv, e[4 * k + 1] * inv, e[4 * k + 2] * inv, e[4 * k + 3] * inv);
        }
        asm volatile("s_waitcnt lgkmcnt(0)" ::: "memory");
    }
}
}
#ifndef PROBE_MASK
#define PROBE_MASK 0
#endif
#define REPS(bit) (((PROBE_MASK >> (bit)) & 1) ? 2 : 1)
namespace nv {
constexpr int LDS_BYTES = 147456, MISC_OFF = 131072 + 320;
struct Params { const float* in[23]; float* out; unsigned char* ws; };

__global__ void __launch_bounds__(512, 2) k_mega(Params prm) {
    extern __shared__ __attribute__((aligned(16))) unsigned char lds_raw[];
    namespace cg = cooperative_groups;
    cg::grid_group grid = cg::this_grid();
    LAS unsigned char* lds = (LAS unsigned char*)lds_raw;
    unsigned char* smem = lds_raw;
    for (int u = threadIdx.x; u < (LDS_BYTES - 131072) / 4; u += 512) ((LAS unsigned*)(lds + 131072))[u] = 0u;
    __syncthreads();
    if (threadIdx.x == 0) {
        LAS unsigned long long* tab = (LAS unsigned long long*)(lds + TAB_OFF);
#pragma unroll
        for (int i = 0; i < 23; ++i) tab[i] = (unsigned long long)prm.in[i];
        tab[23] = (unsigned long long)prm.out; tab[24] = (unsigned long long)prm.ws;
    }
    __syncthreads();
#define ARG(i) ((const float*)ldarg(lds, (i)))
#define WSP() ((unsigned char*)ldarg(lds, 24))
    XcdBarrier bar = xcd_barrier_post((unsigned*)(WSP() + WS_CTL) + CW_BAR, (volatile LAS unsigned*)(lds + MISC_OFF) + 8);
#define GRID_BAR() do { xcd_barrier(bar); asm volatile("" ::: "memory"); } while (0)
    if (threadIdx.x == 0) { volatile LAS unsigned* M = (volatile LAS unsigned*)(lds + MISC_OFF); M[16] = bar.x; M[17] = xb_add((unsigned*)(WSP() + WS_CTL) + CW_RANK + 64 * bar.x, 1u); }
    for (int rep = 0; rep < REPS(0); ++rep) {
    p0_prologue(lds);
    { unsigned char* ws = WSP(); p0_peer_tables(ARG(20), ARG(21), ARG(17), ws + WS_PU, ws + WS_PV8); }
    { unsigned char* ws = WSP(); const float* pk = ARG(19); bf16_t* kb = (bf16_t*)(ws + WS_KEYS); for (int i = obid() * 512 + otid(); i < DEPTH * PH * 2 * NK * HALF; i += ogrid() * 512) kb[i] = f2bf(pk[i]); }
    { unsigned char* ws = WSP(); p0_ssm_a(ARG(3), ARG(4), ARG(5), ARG(6), ARG(7), (f32x2v*)(ws + WS_APOW), (f32x2v*)(ws + WS_BBAR)); }
    }
    GRID_BAR();
    if (threadIdx.x == 0) {
        volatile LAS unsigned* M = (volatile LAS unsigned*)(lds + MISC_OFF); unsigned* bw = (unsigned*)(WSP() + WS_CTL) + CW_BAR; unsigned tot = 0u, ok = 1u;
        for (unsigned j = 0; j < 16; ++j) { const unsigned cnt = xb_ld(&bw[XB_XCNT(j)]); tot += cnt; if ((j < 8) != (cnt > 0u)) ok = 0u; }
        M[18] = xb_ld(&bw[XB_XCNT(bar.x)]); M[19] = (ok && tot == gridDim.x) ? 1u : 0u;
    }
    __syncthreads();
    { unsigned char* ws = WSP(); p0_ssm_b((const f32x2v*)(ws + WS_APOW), (const f32x2v*)(ws + WS_BBAR), ARG(8), ARG(9), ARG(10), (bf16_t*)(ws + WS_KD), (bf16_t*)(ws + WS_WST), (bf16_t*)(ws + WS_WOUT)); }
    grid.sync();
#pragma nounroll
    for (int l_ = 0; l_ < DEPTH; ++l_) {
        int l = l_; asm volatile("" : "+s"(l));
        {
            unsigned char* ws = WSP(); bf16_t* hb = (bf16_t*)(ws + WS_HB); float* ss1 = (float*)(ws + WS_SSP) + (size_t)T * 32;
            for (int rep = 0; rep < REPS(1); ++rep) {
            SchedGen S; S.init_plain(hb, D * 2, (const bf16_t*)(ws + WS_BT1) + (size_t)l * 2048 * D, D * 2, T, 2048, D, ogrid(), obid());
            EpiInProj E{ss1, (bf16_t*)(ws + WS_UP), (bf16_t*)(ws + WS_Q)};
            ge::gemm_phase<EpiInProj, SchedGen>(lds, S, E, otid());
            }
            for (int rep = 0; rep < REPS(2); ++rep)
            ph_flogit(hb, (const bf16_t*)(ws + WS_WF) + (size_t)l * 16 * D, ss1, ARG(13) + l * NH, (float*)(ws + WS_LOGF));
        }
        GRID_BAR();
        {
            unsigned char* ws = WSP();
            for (int rep = 0; rep < REPS(3); ++rep) {
            SchedSsmS S; S.init(ws + WS_UP, (const bf16_t*)(ws + WS_WST) + (size_t)l * G * 128 * 256, ogrid(), obid());
            EpiSsmS E{(float*)(ws + WS_SLOC)};
            ge::gemm_phase<EpiSsmS, SchedSsmS>(lds, S, E, otid());
            }
            for (int rep = 0; rep < REPS(4); ++rep)
            ph_cum2((const float*)(ws + WS_LOGF), (float*)(ws + WS_CUM));
        }
        GRID_BAR();
        for (int rep = 0; rep < REPS(5); ++rep)
        { unsigned char* ws = WSP(); ph_ssm_prefix(lds, (const float*)(ws + WS_SLOC), (const f32x2v*)(ws + WS_APOW) + (size_t)l * G * 65 * P, (bf16_t*)(ws + WS_UP)); }
        GRID_BAR();
        {
            unsigned char* ws = WSP(); float* ssp_s = (float*)(ws + WS_SSP); float* ssp_a = ssp_s + (size_t)T * 8;
            for (int rep = 0; rep < REPS(6); ++rep)
            {
                SchedSsmC S; S.init(ws + WS_UP, (const bf16_t*)(ws + WS_WOUT) + (size_t)l * G * 1024 * 128, (const bf16_t*)(ws + WS_KD) + (size_t)l * G * KDW, ogrid(), obid());
                EpiSsmC E{(bf16_t*)(ws + WS_GEL)};
                ge::gemm_phase<EpiSsmC, SchedSsmC>(lds, S, E, otid());
            }
            for (int rep = 0; rep < REPS(7); ++rep)
            attn_body::attn_phase<8>((char*)lds_raw, (const attn_body::bf16*)(ws + WS_Q), (const attn_body::bf16*)(ws + WS_K), (const attn_body::bf16*)(ws + WS_V), (const float*)(ws + WS_CUM), (attn_body::bf16*)(ws + WS_MIX), ssp_a, (unsigned*)(ws + WS_CTL) + CW_QUEUE + 64 * (l * 2 + rep), (volatile LAS unsigned*)(lds + MISC_OFF) + 24, otid());
            GRID_BAR();
            for (int rep = 0; rep < REPS(8); ++rep) {
            SchedGen S; S.init_plain(ws + WS_GEL, 32, (const bf16_t*)(ws + WS_BT2) + (size_t)l * SSMW * SSMW, SSMW * 2, T, SSMW, SSMW, ogrid(), obid());
            S.a_c16_b = T * 32; S.a_kt_b = 4l * T * 32;
            EpiGlu2 E{(const bf16_t*)(ws + WS_GEL), ARG(12) + l * SSMW, (bf16_t*)(ws + WS_MIX), ssp_s};
            ge::gemm_phase<EpiGlu2, SchedGen>(lds, S, E, otid());
            }
        }
        GRID_BAR();
        {
            unsigned char* ws = WSP(); float* ssp_s = (float*)(ws + WS_SSP); float* ssp_a = ssp_s + (size_t)T * 8; float* ssp_2 = ssp_a + (size_t)T * 8;
            for (int rep = 0; rep < REPS(9); ++rep) {
            const bool dummy = rep + 1 < REPS(9);
            SchedGen S; S.init_plain(ws + WS_MIX, D * 2, (const bf16_t*)(ws + WS_BT3) + (size_t)l * D * D, D * 2, T, D, D, ogrid(), obid());
            EpiWo E{ssp_s, ssp_a, (const bf16_t*)(ws + WS_HB), dummy ? (bf16_t*)(ws + WS_QP) : (bf16_t*)(ws + WS_HB), dummy ? (float*)(ws + WS_SLOC) : ssp_2};
            ge::gemm_phase<EpiWo, SchedGen>(lds, S, E, otid());
            }
        }
        GRID_BAR();
        {
            unsigned char* ws = WSP(); float* ssp_2 = (float*)(ws + WS_SSP) + (size_t)T * 16;
            for (int rep = 0; rep < REPS(10); ++rep) {
            SchedGen S; S.init_plain(ws + WS_HB, D * 2, (const bf16_t*)(ws + WS_BT4) + (size_t)l * D * D, D * 2, T, D, D, ogrid(), obid());
            EpiWq E{ssp_2, (bf16_t*)(ws + WS_QP)};
            ge::gemm_phase<EpiWq, SchedGen>(lds, S, E, otid());
            }
        }
        GRID_BAR();
        for (int rep = 0; rep < REPS(11); ++rep)
        { unsigned char* ws = WSP(); ph_select((const bf16_t*)(ws + WS_QP), (const bf16_t*)(ws + WS_KEYS) + (size_t)l * PH * 2 * NK * HALF, (unsigned short*)(ws + WS_IDX), (float*)(ws + WS_GATE), lds); }
        GRID_BAR();
        if (PROBE_MASK & (1 << 18)) { unsigned char* ws = WSP(); ph_peer_u<2>(lds, ws + WS_PU + (size_t)l * NEXP * D, (const bf16_t*)(ws + WS_HB), (const unsigned short*)(ws + WS_IDX), (bf16_t*)(ws + WS_UP)); }
        if (PROBE_MASK & (1 << 20)) { unsigned char* ws = WSP(); ph_peer_u<2>(lds, ws + WS_PU + (size_t)l * NEXP * D, (const bf16_t*)(ws + WS_HB), (const unsigned short*)(ws + WS_IDX), (bf16_t*)(ws + WS_UP), 127); }
        if (PROBE_MASK & (1 << 16)) { unsigned char* ws = WSP(); ph_peer_u<0>(lds, ws + WS_PU + (size_t)l * NEXP * D, (const bf16_t*)(ws + WS_HB), (const unsigned short*)(ws + WS_IDX), (bf16_t*)(ws + WS_UP), 1023); }
        for (int rep = 0; rep < REPS(12); ++rep)
        { unsigned char* ws = WSP(); ph_peer_u<0>(lds, ws + WS_PU + (size_t)l * NEXP * D, (const bf16_t*)(ws + WS_HB), (const unsigned short*)(ws + WS_IDX), (bf16_t*)(ws + WS_PART)); }
        GRID_BAR();
        for (int rep = 0; rep < REPS(13); ++rep)
        { unsigned char* ws = WSP(); ph_peer_coef((const bf16_t*)(ws + WS_PART), (const float*)(ws + WS_SSP) + (size_t)T * 16, (const float*)(ws + WS_GATE), (unsigned short*)(ws + WS_COEF)); }
        GRID_BAR();
        if (PROBE_MASK & (1 << 17)) { unsigned char* ws = WSP();
          ph_peer_v<0>(lds, ws + WS_PV8 + (size_t)l * NEXP * D, (const unsigned short*)(ws + WS_IDX), (const unsigned short*)(ws + WS_COEF), (const bf16_t*)(ws + WS_HB), (bf16_t*)(ws + WS_UP), (float*)(ws + WS_SLOC), 1023); }
        for (int rep = 0; rep < REPS(14); ++rep)
        { unsigned char* ws = WSP(); const bool dummy = rep + 1 < REPS(14);
          ph_peer_v<0>(lds, ws + WS_PV8 + (size_t)l * NEXP * D, (const unsigned short*)(ws + WS_IDX), (const unsigned short*)(ws + WS_COEF), (const bf16_t*)(ws + WS_HB),
                    dummy ? (bf16_t*)(ws + WS_UP) : (bf16_t*)(ws + WS_HB), dummy ? (float*)(ws + WS_SLOC) : (float*)(ws + WS_SSP) + (size_t)T * 32); }
        if (PROBE_MASK & (1 << 15)) { for (int rep = 0; rep < 8; ++rep) GRID_BAR(); }
        GRID_BAR();
    }
    { unsigned char* ws = WSP(); ph_final((const bf16_t*)(ws + WS_HB), (const float*)(ws + WS_SSP) + (size_t)T * 32, ARG(22), (float*)ldarg(lds, 23)); }
}
}

extern "C" void kernel_launch(void* const* d_in, const int* in_sizes, int n_in, void* d_out, int out_size, void* d_ws, size_t ws_size, hipStream_t stream) {
    using namespace nv;
    static int grid_blocks = 0;
    if (!grid_blocks) {
        int dev = 0, cus = 0, per_cu = 0;
        (void)hipGetDevice(&dev);
        (void)hipDeviceGetAttribute(&cus, hipDeviceAttributeMultiprocessorCount, dev);
        if (hipFuncSetAttribute((const void*)k_mega, hipFuncAttributeMaxDynamicSharedMemorySize, LDS_BYTES) != hipSuccess) { fprintf(stderr, "hipFuncSetAttribute failed\n"); grid_blocks = -1; return; }
        (void)hipOccupancyMaxActiveBlocksPerMultiprocessor(&per_cu, (const void*)k_mega, 512, LDS_BYTES);
        if (per_cu < 1) { fprintf(stderr, "occupancy query returned %d\n", per_cu); (void)hipGetLastError(); }
        grid_blocks = cus;
    }
    if (grid_blocks < 0) return;
    if (ws_size < WS_END || n_in != 23) { fprintf(stderr, "bad workspace / inputs\n"); return; }
    (void)hipMemsetAsync((char*)d_ws + WS_CTL, 0, CTL_BYTES, stream);
    Params p{};
    for (int i = 0; i < 23; ++i) p.in[i] = (const float*)d_in[i];
    p.out = (float*)d_out; p.ws = (unsigned char*)d_ws;
    void* args[] = {&p};
    hipError_t e = hipLaunchCooperativeKernel((const void*)k_mega, dim3(grid_blocks), dim3(512), args, LDS_BYTES, stream);
    if (e != hipSuccess) fprintf(stderr, "cooperative launch failed: %s (grid %d)\n", hipGetErrorString(e), grid_blocks);
}
```

```cpp
#include <hip/hip_runtime.h>
#include <hip/hip_cooperative_groups.h>
#include <hip/hip_bf16.h>
#include <cstdint>
#include <cstdio>

#define LAS __attribute__((address_space(3)))
#define GAS __attribute__((address_space(1)))

namespace nv {
constexpr int D = 1024, BATCH = 8, SEQ = 4096, DEPTH = 4, T = BATCH * SEQ;
constexpr int SSMW = 512, G = 32, HC = 16, P = 64, ATTW = 512, HD = 64, NH = 8, INW = 2056;
constexpr int PH = 8, NK = 128, TOPK = 16, QD = 128, HALF = 64, NEXP = 16384;
constexpr int CHUNK = 64, NCH = T / CHUNK  , UPW = 128 + CHUNK * HC  ;
constexpr float EPS = 1e-6f;

typedef short bf16x8 __attribute__((ext_vector_type(8)));
typedef float f32x16 __attribute__((ext_vector_type(16)));
typedef float f32x4 __attribute__((ext_vector_type(4)));
typedef unsigned u32x4 __attribute__((ext_vector_type(4)));
typedef unsigned short bf16_t;

constexpr size_t MiB = 1u << 20;
constexpr size_t WS_CTL = 0, CTL_BYTES = 4 * MiB;
constexpr size_t WS_BT1 = 4 * MiB;
constexpr size_t WS_BT2 = 20 * MiB;
constexpr size_t WS_BT3 = 22 * MiB;
constexpr size_t WS_BT4 = 30 * MiB;
constexpr size_t WS_WF = 38 * MiB;
constexpr size_t WS_KEYS = 39 * MiB;
constexpr size_t WS_KD = 40 * MiB, WS_WOUT = 49 * MiB, WS_WST = 81 * MiB;
constexpr size_t WS_PU = 90 * MiB, WS_PV8 = 154 * MiB;
constexpr size_t WS_PART = 218 * MiB;
constexpr size_t WS_H = 346 * MiB;
constexpr size_t WS_HB = 474 * MiB;
constexpr size_t WS_UP = 538 * MiB;
constexpr size_t WS_Q = 576 * MiB, WS_K = 608 * MiB, WS_V = 640 * MiB;
constexpr size_t WS_LOGF = 672 * MiB, WS_CUM = 673 * MiB;
constexpr size_t WS_SLOC = 674 * MiB, WS_GEL = 708 * MiB, WS_MIX = 740 * MiB;
constexpr size_t WS_SSP = 916 * MiB;
constexpr size_t WS_QP = 852 * MiB;
constexpr size_t WS_IDX = 804 * MiB, WS_GATE = 820 * MiB, WS_COEF = 836 * MiB;
constexpr size_t WS_XN_F = 90 * MiB, WS_MIXED_F = 218 * MiB, WS_QP_F = 852 * MiB, WS_GEL_F = 90 * MiB  , WS_YSSM_F = 740 * MiB, WS_YATT_F = 674 * MiB;
constexpr size_t WS_END = 980 * MiB;
constexpr int CW_QUEUE = 1024;
constexpr int CW_RANK = 2048;
constexpr int CW_BAR = 4096;
constexpr int CW_SS = 65536;
constexpr int SS_H1 = 0  , SS_H2 = 5  , SS_SSM = 9, SS_ATT = 13;
static_assert((size_t)(CW_SS + 17 * T) * 4 <= CTL_BYTES, "ctl region");

__device__ __forceinline__ unsigned short f2bf(float f) { unsigned u = __float_as_uint(f); return (unsigned short)((u + 0x7fffu + ((u >> 16) & 1u)) >> 16); }
__device__ __forceinline__ float bf2f(unsigned short b) { return __uint_as_float(((unsigned)b) << 16); }
__device__ __forceinline__ unsigned pk2(float lo, float hi) { return (unsigned)f2bf(lo) | ((unsigned)f2bf(hi) << 16); }
__device__ __forceinline__ float gelu_tanh(float x) { const float u = 0.7978845608028654f * (x + 0.044715f * x * x * x); return 0.5f * x * (1.f + tanhf(u)); }
__device__ __forceinline__ float wave_sum(float v) {
#pragma unroll
    for (int o = 1; o < 64; o <<= 1) v += __shfl_xor(v, o);
    return v;
}
__device__ __forceinline__ int otid() { int t = threadIdx.x; asm volatile("" : "+v"(t)); return t; }
__device__ __forceinline__ int obid() { int t = blockIdx.x; asm volatile("" : "+s"(t)); return t; }
__device__ __forceinline__ int ogrid() { int t = gridDim.x; asm volatile("" : "+s"(t)); return t; }
#define PH_IDS const int TIDX = otid(), BIDX = obid(), GDIM = ogrid(); (void)TIDX; (void)BIDX; (void)GDIM;
__device__ __forceinline__ size_t up_index(int row, int c) { const int n = row >> 6, j = row & 63, g = c >> 4, hh = c & 15; return ((size_t)g * NCH + n) * UPW + 128 + j * HC + hh; }
}
namespace ge {
#define GE_LAS __attribute__((address_space(3)))
typedef unsigned short bf16_t;
typedef short bf16x8 __attribute__((ext_vector_type(8)));
typedef float f32x4 __attribute__((ext_vector_type(4)));
typedef unsigned u32x4 __attribute__((ext_vector_type(4)));
typedef unsigned u32x2 __attribute__((ext_vector_type(2)));
constexpr int ROWF_OFF = 131072 + 4096;
constexpr int BM = 256, BK = 64, HALF = 128, HTB = HALF * BK * 2  , STAGE_BYTES = 8 * HTB, NXCD = 8, WGM = 8;

__host__ __device__ __forceinline__ int lds_byte(int r, int c) { const int st = (r >> 4) * 2 + (c >> 5), rr = r & 15, cc = c & 31, ob = rr * 64 + cc * 2; return st * 1024 + (ob ^ (((ob >> 9) & 1) << 5)); }
__host__ __device__ __forceinline__ void stage_rc(int b, int& R, int& C) { const int st = b / 1024, sb = b % 1024, swz = sb ^ (((sb >> 9) & 1) << 5); R = (st >> 1) * 16 + swz / 64; C = (st & 1) * 32 + (swz % 64) / 2; }
__host__ __device__ __forceinline__ int perm32(int rho) { const int n = rho >> 4, i = rho & 15; return 8 * (i >> 2) + 4 * n + (i & 3); }

struct Unit { const char* A0; const char* B0; int nt; int pm, pn, aux; };
__device__ __forceinline__ unsigned cvt_pk_bf16(float lo, float hi) { unsigned r; asm volatile("v_cvt_pk_bf16_f32 %0, %1, %2" : "=v"(r) : "v"(lo), "v"(hi)); return r; }

__device__ __forceinline__ bool static_tile(int i, int G, int c, int nM, int nN, int& pm, int& pn) {
    const int nwg = nM * nN; const long L = (long)i * G + c; if (L >= nwg) return false;
    int wgid = (int)L; { const int q = nwg / NXCD, r = nwg % NXCD, xcd = wgid % NXCD, off = wgid / NXCD; wgid = (xcd < r ? xcd * (q + 1) : r * (q + 1) + (xcd - r) * q) + off; }
    const int nig = WGM * nN, gid = wgid / nig, fm = gid * WGM, gsz = (nM - fm) < WGM ? (nM - fm) : WGM;
    pm = fm + ((wgid % nig) % gsz); pn = (wgid % nig) / gsz; return true;
}

template <class Epi, class Sched>
__device__ __forceinline__ void gemm_phase(GE_LAS unsigned char* lds, const Sched& S, const Epi& E, int tid) {
    const int wid = __builtin_amdgcn_readfirstlane(tid >> 6), lane = tid & 63, wr = wid >> 2, wc = wid & 3, fr = lane & 15, fq = lane >> 4;
    unsigned voffA[2], voffB[2], voffB1[2];
#pragma unroll
    for (int i = 0; i < 2; ++i) { int R, C; stage_rc(tid * 16 + i * 8192, R, C); const int Rb = Epi::PERM ? ((R & ~31) + perm32(R & 31)) : R;
        voffA[i] = S.voffA(R, C); voffB[i] = S.voffB(Rb, C); if constexpr (Sched::DUALB) voffB1[i] = S.voffB1(Rb, C); else voffB1[i] = 0u; }
    const long hA = S.hA, hB = S.hB;
    const unsigned ldsw = (unsigned)wid * 1024u;
    const int aoff = lds_byte(wr * 64 + fr, fq * 8), boff = lds_byte(wc * 32 + fr, fq * 8);
#define GE_SA(b, h) (((b) * 2 + (h)) * HTB)
#define GE_SB(b, h) ((4 + (b) * 2 + (h)) * HTB)
#define GE_STAGE(bufoff, gbase, voff) do { _Pragma("unroll") for (int _i = 0; _i < 2; ++_i) \
        __builtin_amdgcn_global_load_lds((const unsigned*)((const char*)(gbase) + (voff)[_i]), (GE_LAS unsigned*)(lds + (bufoff) + ldsw + _i * 8192), 16, 0, 0); } while (0)
#define GE_STAGE_B(bufoff, gbase, sel, half) do { if constexpr (Sched::DUALB) { const char* _g = (const char*)(gbase) + ((half) ? ((sel) ? S.hB1 : hB) : 0l); _Pragma("unroll") for (int _i = 0; _i < 2; ++_i) { const unsigned _v = (sel) ? voffB1[_i] : voffB[_i]; \
        __builtin_amdgcn_global_load_lds((const unsigned*)(_g + _v), (GE_LAS unsigned*)(lds + (bufoff) + ldsw + _i * 8192), 16, 0, 0); } } else { GE_STAGE(bufoff, (const char*)(gbase) + ((half) ? hB : 0l), voffB); } } while (0)
#define GE_LDA(dst, b, h) do { _Pragma("unroll") for (int m = 0; m < 4; ++m) _Pragma("unroll") for (int k = 0; k < 2; ++k) dst[m][k] = *(const GE_LAS bf16x8*)(lds + GE_SA(b, h) + aoff + m * 2048 + k * 1024); } while (0)
#define GE_LDB(dst, b, h) do { _Pragma("unroll") for (int n = 0; n < 2; ++n) _Pragma("unroll") for (int k = 0; k < 2; ++k) dst[n][k] = *(const GE_LAS bf16x8*)(lds + GE_SB(b, h) + boff + n * 2048 + k * 1024); } while (0)
#define GE_MMA(ai, bj, At, Bt) do { __builtin_amdgcn_s_setprio(1); _Pragma("unroll") for (int m = 0; m < 4; ++m) _Pragma("unroll") for (int n = 0; n < 2; ++n) _Pragma("unroll") for (int k = 0; k < 2; ++k) \
        acc[ai][bj][m][n] = __builtin_amdgcn_mfma_f32_16x16x32_bf16(Bt[n][k], At[m][k], acc[ai][bj][m][n], 0, 0, 0); __builtin_amdgcn_s_setprio(0); } while (0)
#define GE_WAIT_V(n) asm volatile("s_waitcnt vmcnt(" #n ")" ::: "memory")
#define GE_WAIT_L(n) asm volatile("s_waitcnt lgkmcnt(" #n ")" ::: "memory")
#define GE_BAR __builtin_amdgcn_s_barrier()
#define GE_SCHED __builtin_amdgcn_sched_barrier(0)
    Unit cur, nxt; int ui = 0;
    if (!S.next(0, cur)) return;
    f32x4 acc[2][2][4][2];
#pragma unroll
    for (int a = 0; a < 2; ++a)
#pragma unroll
        for (int b = 0; b < 2; ++b)
#pragma unroll
            for (int m = 0; m < 4; ++m)
#pragma unroll
                for (int n = 0; n < 2; ++n) acc[a][b][m][n] = (f32x4){0.f, 0.f, 0.f, 0.f};
    bf16x8 At[4][2], B0[2][2], B1[2][2];
    if constexpr (Epi::UBEGIN) E.unit_begin(cur, tid, lds + ROWF_OFF);
    {
        const char* a0 = S.ta(cur, 0); const char* b0 = S.tb(cur, 0); const char* a1 = S.ta(cur, 1); const char* b1 = S.tb(cur, 1);
        const bool s0 = S.sb(cur, 0), s1 = S.sb(cur, 1);
        GE_STAGE_B(GE_SB(0, 0), b0, s0, 0); GE_STAGE_B(GE_SB(0, 1), b0, s0, 1); GE_STAGE(GE_SA(0, 0), a0, voffA); GE_STAGE(GE_SA(0, 1), a0 + hA, voffA);
        if (wr == 1) GE_BAR;
        GE_WAIT_V(2); GE_BAR;
        GE_STAGE_B(GE_SB(1, 0), b1, s1, 0); GE_STAGE(GE_SA(1, 0), a1, voffA); GE_STAGE_B(GE_SB(1, 1), b1, s1, 1);
        GE_WAIT_V(6); GE_BAR;
    }
    for (;;) {
        const bool has_next = S.next(ui + 1, nxt);
        const int nt = cur.nt;
        for (int t = 0; t < nt; t += 2) {
            const bool last = (t == nt - 2);
            const char* a1 = S.ta(cur, t + 1);
            const char* a2 = last ? (has_next ? S.ta(nxt, 0) : S.ta(cur, 0)) : S.ta(cur, t + 2);
            const char* b2 = last ? (has_next ? S.tb(nxt, 0) : S.tb(cur, 0)) : S.tb(cur, t + 2);
            const char* a3 = last ? (has_next ? S.ta(nxt, 1) : S.ta(cur, 1)) : S.ta(cur, t + 3);
            const char* b3 = last ? (has_next ? S.tb(nxt, 1) : S.tb(cur, 1)) : S.tb(cur, t + 3);
            const bool s2 = last ? (has_next ? S.sb(nxt, 0) : S.sb(cur, 0)) : S.sb(cur, t + 2), s3 = last ? (has_next ? S.sb(nxt, 1) : S.sb(cur, 1)) : S.sb(cur, t + 3);
            GE_LDB(B0, 0, 0); GE_LDB(B1, 0, 1); GE_SCHED; GE_LDA(At, 0, 0); GE_STAGE(GE_SA(1, 1), a1 + hA, voffA);
            GE_WAIT_V(8); GE_WAIT_L(0); GE_BAR; GE_MMA(0, 0, At, B0); GE_MMA(0, 1, At, B1); GE_BAR; GE_SCHED;
            GE_LDA(At, 0, 1); GE_STAGE_B(GE_SB(0, 0), b2, s2, 0); GE_STAGE_B(GE_SB(0, 1), b2, s2, 1); GE_STAGE(GE_SA(0, 0), a2, voffA);
            GE_WAIT_V(8); GE_WAIT_L(0); GE_BAR; GE_MMA(1, 0, At, B0); GE_MMA(1, 1, At, B1); GE_BAR; GE_SCHED;
            GE_LDB(B0, 1, 0); GE_LDB(B1, 1, 1); GE_SCHED; GE_LDA(At, 1, 0); GE_STAGE(GE_SA(0, 1), a2 + hA, voffA);
            GE_WAIT_V(8); GE_WAIT_L(0); GE_BAR; GE_MMA(0, 0, At, B0); GE_MMA(0, 1, At, B1); GE_BAR; GE_SCHED;
            GE_LDA(At, 1, 1); GE_STAGE_B(GE_SB(1, 0), b3, s3, 0); GE_STAGE_B(GE_SB(1, 1), b3, s3, 1); GE_STAGE(GE_SA(1, 0), a3, voffA);
            GE_WAIT_V(8); GE_WAIT_L(0); GE_BAR; GE_MMA(1, 0, At, B0); GE_MMA(1, 1, At, B1); GE_BAR; GE_SCHED;
            if constexpr (Epi::MIDK) { if (t + 2 == (nt >> 1)) E.midk(acc, cur, wr, fr, lds + ROWF_OFF + (ui & 1) * 2048); }
        }
        if (wr == 0) GE_BAR;
        E(acc, cur, wr, wc, fr, fq, lds + ROWF_OFF + (ui & 1) * 2048);
        if (!has_next) break;
        if constexpr (Epi::UBEGIN) E.unit_begin(nxt, tid, lds + ROWF_OFF + ((ui + 1) & 1) * 2048);
#pragma unroll
        for (int a = 0; a < 2; ++a)
#pragma unroll
            for (int b = 0; b < 2; ++b)
#pragma unroll
                for (int m = 0; m < 4; ++m)
#pragma unroll
                    for (int n = 0; n < 2; ++n) acc[a][b][m][n] = (f32x4){0.f, 0.f, 0.f, 0.f};
        cur = nxt; ++ui;
        if (wr == 1) GE_BAR;
    }
    GE_WAIT_V(0);
    GE_BAR;
#undef GE_SA
#undef GE_SB
#undef GE_STAGE
#undef GE_STAGE_B
#undef GE_LDA
#undef GE_LDB
#undef GE_MMA
#undef GE_WAIT_V
#undef GE_WAIT_L
#undef GE_BAR
#undef GE_SCHED
}
}
namespace nv {
__device__ __forceinline__ float sum8(const float* p);
__device__ __forceinline__ float sum16(const float* p);
#define XB_TMO      128
#define XB_XCNT(j)  (256  + 64 * (j))
#define XB_XSUB(j)  (1280 + 64 * (j))
#define XB_XGEN(j)  (2304 + 64 * (j))
#define XB_TOP      3328
#define XB_TOPGEN   3392
#define XCD_BAR_WORDS 3456
#define XB_SPIN_CAP (1u << 24)
__device__ __forceinline__ unsigned xb_ld(unsigned* p)              { return __hip_atomic_load(p, __ATOMIC_RELAXED, __HIP_MEMORY_SCOPE_AGENT); }
__device__ __forceinline__ unsigned xb_add(unsigned* p, unsigned v) { return __hip_atomic_fetch_add(p, v, __ATOMIC_RELAXED, __HIP_MEMORY_SCOPE_AGENT); }
__device__ __forceinline__ unsigned xb_xcc_id() { return (unsigned)__builtin_amdgcn_s_getreg((3 << 11) | 20) & 0xFu; }
#define XB_SPIN(cond, bar) do { unsigned _sp = 0; while (cond) { __builtin_amdgcn_s_sleep(1); \
    if ((++_sp & 255u) == 0u) { if (xb_ld(&(bar)[XB_TMO])) break; if (_sp > XB_SPIN_CAP) { atomicAdd(&(bar)[XB_TMO], 1u); break; } } } } while (0)
struct XcdBarrier { unsigned* bar; unsigned x; volatile LAS unsigned* st; };
__device__ __forceinline__ XcdBarrier xcd_barrier_post(unsigned* bar, volatile LAS unsigned* st) {
    XcdBarrier b; b.bar = bar; b.x = xb_xcc_id(); b.st = st;
    if (threadIdx.x == 0) (void)xb_add(&bar[XB_XCNT(b.x)], 1u);
    return b;
}
__device__ __forceinline__ void xcd_barrier_complete(unsigned* bar, unsigned x, unsigned& nloc, unsigned& nx) {
    const unsigned Gsz = gridDim.x * gridDim.y * gridDim.z;
    unsigned sum, cnt, mine, sp = 0u;
    for (;;) {
        sum = 0u; cnt = 0u; mine = 0u;
#pragma unroll
        for (unsigned j = 0; j < 16; ++j) { const unsigned c = xb_ld(&bar[XB_XCNT(j)]); sum += c; cnt += (c > 0u) ? 1u : 0u; mine = (j == x) ? c : mine; }
        if (sum == Gsz) break;
        __builtin_amdgcn_s_sleep(1);
        if ((++sp & 255u) == 0u) { if (xb_ld(&bar[XB_TMO])) break; if (sp > XB_SPIN_CAP) { atomicAdd(&bar[XB_TMO], 1u); break; } }
    }
    nloc = mine > 0u ? mine : 1u; nx = cnt > 0u ? cnt : 1u;
}
__device__ __forceinline__ void xcd_barrier(const XcdBarrier& b) {
    asm volatile("s_waitcnt vmcnt(0)" ::: "memory");
    __syncthreads();
    if (threadIdx.x == 0) {
        unsigned* bar = b.bar;
        __builtin_amdgcn_s_waitcnt(0);
        unsigned nloc = b.st[0], nx = b.st[1];
        if (nloc == 0u) { xcd_barrier_complete(bar, b.x, nloc, nx); b.st[0] = nloc; b.st[1] = nx; }
        const unsigned old = xb_add(&bar[XB_XSUB(b.x)], 1u);
        const unsigned gen = old / nloc;
        if (old + 1u == (gen + 1u) * nloc) {
            __builtin_amdgcn_fence(__ATOMIC_RELEASE, "agent");
            asm volatile("s_waitcnt vmcnt(0)" ::: "memory");
            const unsigned og = xb_add(&bar[XB_TOP], 1u);
            const unsigned tg = og / nx;
            if (og + 1u == (tg + 1u) * nx) xb_add(&bar[XB_TOPGEN], 1u);
            else XB_SPIN(xb_ld(&bar[XB_TOPGEN]) == tg, bar);
            __builtin_amdgcn_fence(__ATOMIC_ACQUIRE, "agent");
            xb_add(&bar[XB_XGEN(b.x)], 1u);
            asm volatile("s_waitcnt vmcnt(0)" ::: "memory");
        } else {
            XB_SPIN(xb_ld(&bar[XB_XGEN(b.x)]) == gen, bar);
            __builtin_amdgcn_fence(__ATOMIC_ACQUIRE, "agent");
            asm volatile("s_waitcnt vmcnt(0)" ::: "memory");
        }
    }
    __syncthreads();
}

#define LDS_WAIT() asm volatile("s_waitcnt lgkmcnt(0)" ::: "memory")
template <class Sc>
__device__ __forceinline__ void p0_transpose_item(const float* __restrict__ W, int ldw, int K, int Ncols, Sc sc, bf16_t* __restrict__ WT, LAS float* scr, int item, int lane) {
    const int nblk = Ncols / 32, kb = item / nblk, nb = item % nblk, k0 = 64 * kb, n0 = 32 * nb;
    float wv[32];
#pragma unroll
    for (int i = 0; i < 32; ++i) { const int kk = 2 * i + (lane >> 5); wv[i] = W[(size_t)(k0 + kk) * ldw + n0 + (lane & 31)]; }
#pragma unroll
    for (int i = 0; i < 32; ++i) { const int kk = 2 * i + (lane >> 5); scr[kk * 33 + (lane & 31)] = wv[i] * sc(k0 + kk); }
    LDS_WAIT(); asm volatile("" ::: "memory");
    const int c = lane & 7;
#pragma unroll
    for (int j = 0; j < 4; ++j) { const int n = (lane >> 3) + 8 * j; const LAS float* s = scr + (8 * c) * 33 + n;
        u32x4 o; o.x = pk2(s[0 * 33], s[1 * 33]); o.y = pk2(s[2 * 33], s[3 * 33]); o.z = pk2(s[4 * 33], s[5 * 33]); o.w = pk2(s[6 * 33], s[7 * 33]);
        *(u32x4*)(WT + (size_t)(n0 + n) * K + k0 + 8 * c) = o; }
    LDS_WAIT(); asm volatile("" ::: "memory");
}
struct ScVec { const float* g; __device__ __forceinline__ float operator()(int k) const { return g[k]; } };
struct ScOne { __device__ __forceinline__ float operator()(int) const { return 1.f; } };
struct ScTwo { const float* g0; const float* g1; __device__ __forceinline__ float operator()(int k) const { return k < 512 ? g0[k] : g1[k - 512]; } };

constexpr int TAB_OFF = 131072 + 1024;
__device__ __forceinline__ void* ldarg(LAS unsigned char* lds, int i) {
    unsigned off = TAB_OFF + 8 * i; asm volatile("" : "+s"(off));
    const unsigned long long v = *(volatile LAS unsigned long long*)(lds + off);
    const unsigned lo = __builtin_amdgcn_readfirstlane((unsigned)v), hi = __builtin_amdgcn_readfirstlane((unsigned)(v >> 32));
    return (void*)(GAS void*)(((unsigned long long)hi << 32) | lo);
}

__device__ __forceinline__ void p0_prologue(LAS unsigned char* lds) {
    PH_IDS
    const int lane = TIDX & 63, wave = __builtin_amdgcn_readfirstlane(TIDX >> 6), gw = BIDX * 8 + wave, ngw = GDIM * 8;
    LAS float* scr = (LAS float*)(lds + wave * 16384);
    unsigned char* ws = (unsigned char*)ldarg(lds, 24);
    const float* a0 = (const float*)ldarg(lds, 0); const float* a1 = (const float*)ldarg(lds, 1); const float* a2 = (const float*)ldarg(lds, 2); const float* a11 = (const float*)ldarg(lds, 11);
    const float* a14 = (const float*)ldarg(lds, 14); const float* a15 = (const float*)ldarg(lds, 15); const float* a16 = (const float*)ldarg(lds, 16); const float* a17 = (const float*)ldarg(lds, 17); const float* a18 = (const float*)ldarg(lds, 18);
    constexpr int I1 = (D / 64) * (2048 / 32), I2 = (SSMW / 64) * (SSMW / 32), I3 = (D / 64) * (D / 32), I4 = I3, IL = I1 + I2 + I3 + I4;
    for (int it = gw; it < DEPTH * IL; it += ngw) {
        const int l = it / IL; int r = it % IL;
        if (r < I1) { p0_transpose_item(a2 + (size_t)l * D * INW, INW, D, 2048, ScVec{a1 + l * D}, (bf16_t*)(ws + WS_BT1) + (size_t)l * 2048 * D, scr, r, lane); continue; } r -= I1;
        if (r < I2) { p0_transpose_item(a11 + (size_t)l * SSMW * SSMW, SSMW, SSMW, SSMW, ScOne{}, (bf16_t*)(ws + WS_BT2) + (size_t)l * SSMW * SSMW, scr, r, lane); continue; } r -= I2;
        if (r < I3) { p0_transpose_item(a16 + (size_t)l * D * D, D, D, D, ScTwo{a14 + l * SSMW, a15 + l * ATTW}, (bf16_t*)(ws + WS_BT3) + (size_t)l * D * D, scr, r, lane); continue; } r -= I3;
        p0_transpose_item(a18 + (size_t)l * D * D, D, D, D, ScVec{a17 + l * D}, (bf16_t*)(ws + WS_BT4) + (size_t)l * D * D, scr, r, lane);
    }
    for (int i = BIDX * 512 + TIDX; i < DEPTH * 16 * D; i += GDIM * 512) {
        const int l = i / (16 * D), j = (i / D) % 16, k = i % D;
        const float v = j < 8 ? a2[((size_t)l * D + k) * INW + 2048 + j] * a1[l * D + k] : 0.f;
        ((bf16_t*)(ws + WS_WF))[i] = f2bf(v);
    }
    {
        const float* x = a0; bf16_t* hb = (bf16_t*)(ws + WS_HB); float* ssp1 = (float*)(ws + WS_SSP) + (size_t)T * 32;
        constexpr int NR = 4;
        for (int w0 = gw; w0 < T; w0 += NR * ngw) {
            f32x4 v[NR][4];
#pragma unroll
            for (int u = 0; u < NR; ++u) { const int w = w0 + u * ngw; if (w < T) { const f32x4* r = (const f32x4*)(x + (size_t)w * D) + lane;
#pragma unroll
                for (int j = 0; j < 4; ++j) v[u][j] = r[64 * j]; } }
#pragma unroll
            for (int u = 0; u < NR; ++u) { const int w = w0 + u * ngw; if (w < T) { unsigned long long* o = (unsigned long long*)(hb + (size_t)w * D) + lane;
                float s = 0.f;
#pragma unroll
                for (int j = 0; j < 4; ++j) { const unsigned q0 = pk2(v[u][j].x, v[u][j].y), q1 = pk2(v[u][j].z, v[u][j].w); o[64 * j] = (unsigned long long)q0 | ((unsigned long long)q1 << 32);
                    const float a = __uint_as_float(q0 << 16), b = __uint_as_float(q0 & 0xffff0000u), c = __uint_as_float(q1 << 16), d = __uint_as_float(q1 & 0xffff0000u); s += (a * a + b * b) + (c * c + d * d); }
                s = wave_sum(s);
                if (lane < 8) ssp1[(size_t)w * 8 + lane] = lane == 0 ? s : 0.f; } }
        }
    }
}

struct SchedGen {
    static constexpr bool DUALB = false; long hB1;
    __device__ __forceinline__ bool sb(const ge::Unit&, int) const { return false; }
    __device__ __forceinline__ unsigned voffB1(int, int) const { return 0u; }
    const char* A; const char* B; int a_row_b, a_c16_b, b_row_b, b_c16_b; long a_pm_b, a_kt_b, b_pn_b, b_kt_b; int nM, nN, nt, G, c; long hA, hB;
    __device__ __forceinline__ void init_plain(const void* A_, int lda_bytes, const void* B_, int ldb_bytes, int M, int N, int K, int G_, int c_) {
        A = (const char*)A_; B = (const char*)B_; a_row_b = lda_bytes; a_c16_b = 32; b_row_b = ldb_bytes; b_c16_b = 32; a_pm_b = 256l * lda_bytes; a_kt_b = 128; b_pn_b = 256l * ldb_bytes; b_kt_b = 128;
        nM = M / 256; nN = N / 256; nt = K / 64; G = G_; c = c_; hA = 128l * lda_bytes; hB = 128l * ldb_bytes; }
    __device__ __forceinline__ bool next(int i, ge::Unit& u) const {
        int pm, pn; if (!ge::static_tile(i, G, c, nM, nN, pm, pn)) return false;
        u.A0 = A + (size_t)pm * a_pm_b; u.B0 = B + (size_t)pn * b_pn_b; u.nt = nt; u.pm = pm; u.pn = pn; u.aux = 0; return true; }
    __device__ __forceinline__ const char* ta(const ge::Unit& u, int t) const { return u.A0 + t * a_kt_b; }
    __device__ __forceinline__ const char* tb(const ge::Unit& u, int t) const { return u.B0 + t * b_kt_b; }
    __device__ __forceinline__ unsigned voffA(int R, int C) const { return (unsigned)(R * a_row_b + (C >> 4) * a_c16_b + (C & 15) * 2); }
    __device__ __forceinline__ unsigned voffB(int Rb, int C) const { return (unsigned)(Rb * b_row_b + (C >> 4) * b_c16_b + (C & 15) * 2); }
};
typedef SchedGen SchedPlain;

constexpr float QSCALE = 0.125f * 1.4426950408889634f;
struct EpiInProj {
    static constexpr bool PERM = true, MIDK = false, UBEGIN = true;
    const float* ssp1; bf16_t* UP; bf16_t* QKV;
    __device__ __forceinline__ void unit_begin(const ge::Unit& u, int tid, LAS unsigned char* rowf) const {
        if (tid < 256) { const int row = u.pm * 256 + tid; ((LAS float*)rowf)[tid] = rsqrtf(sum8(ssp1 + (size_t)row * 8) * (1.f / D) + EPS); }
    }
    __device__ __forceinline__ void midk(ge::f32x4 (&)[2][2][4][2], const ge::Unit&, int, int, LAS unsigned char*) const {}
    __device__ __forceinline__ void operator()(const ge::f32x4 (&acc)[2][2][4][2], const ge::Unit& u, int wr, int wc, int fr, int fq, LAS unsigned char* rowf) const {
        const int row0 = u.pm * 256 + wr * 64 + fr, colt = u.pn * 256, region = colt >> 9;
        bf16_t* dstb = QKV + (size_t)(region - 1) * ((WS_K - WS_Q) / 2);
#pragma unroll
        for (int ai = 0; ai < 2; ++ai)
#pragma unroll
            for (int m = 0; m < 4; ++m) {
                const int row = row0 + ai * 128 + m * 16; const float rs = ((const LAS float*)rowf)[ai * 128 + wr * 64 + m * 16 + fr];
#pragma unroll
                for (int bj = 0; bj < 2; ++bj) {
                    const int c = (colt & 511) + bj * 128 + wc * 32 + 8 * fq;
                    const float rq = region == 1 ? rs * QSCALE : rs;
                    const ge::f32x4 v0 = acc[ai][bj][m][0] * rq, v1 = acc[ai][bj][m][1] * rq;
                    u32x4 w; w.x = ge::cvt_pk_bf16(v0[0], v0[1]); w.y = ge::cvt_pk_bf16(v0[2], v0[3]); w.z = ge::cvt_pk_bf16(v1[0], v1[1]); w.w = ge::cvt_pk_bf16(v1[2], v1[3]);
                    bf16_t* dst = region == 0 ? UP + up_index(row, c) : dstb + (size_t)row * 512 + c;
                    *(u32x4*)dst = w;
                }
            }
    }
};

__device__ __forceinline__ float sum8(const float* p) { const ge::f32x4 a = *(const ge::f32x4*)p, b = *(const ge::f32x4*)(p + 4); return ((a[0] + a[1]) + (a[2] + a[3])) + ((b[0] + b[1]) + (b[2] + b[3])); }
__device__ __forceinline__ float sum16(const float* p) { return sum8(p) + sum8(p + 8); }
__device__ __forceinline__ size_t gel_index(int row, int c) { return ((size_t)(c >> 4) * T + row) * HC + (c & 15); }
__device__ __forceinline__ float sigmoidf_(float x) { return 1.f / (1.f + __expf(-x)); }
struct EpiGlu2 {
    static constexpr bool PERM = true, MIDK = false, UBEGIN = false;
    const bf16_t* GEL; const float* bias; bf16_t* MIX; float* ssp;
    __device__ __forceinline__ void unit_begin(const ge::Unit&, int, LAS unsigned char*) const {}
    __device__ __forceinline__ void midk(ge::f32x4 (&)[2][2][4][2], const ge::Unit&, int, int, LAS unsigned char*) const {}
    __device__ __forceinline__ void operator()(const ge::f32x4 (&acc)[2][2][4][2], const ge::Unit& u, int wr, int wc, int fr, int fq, LAS unsigned char*) const {
        const int row0 = u.pm * 256 + wr * 64 + fr, colt = u.pn * 256;
#pragma unroll
        for (int ai = 0; ai < 2; ++ai)
#pragma unroll
            for (int m = 0; m < 4; ++m) {
                const int row = row0 + ai * 128 + m * 16; float sq = 0.f;
#pragma unroll
                for (int bj = 0; bj < 2; ++bj) {
                    const int c = colt + bj * 128 + wc * 32 + 8 * fq;
                    const ge::f32x4 b0 = *(const ge::f32x4*)(bias + c), b1 = *(const ge::f32x4*)(bias + c + 4);
                    const u32x4 gw = *(const u32x4*)(GEL + gel_index(row, c));
                    const ge::f32x4 v0 = acc[ai][bj][m][0] + b0, v1 = acc[ai][bj][m][1] + b1;
                    float o[8];
                    o[0] = __uint_as_float(gw.x << 16) * sigmoidf_(v0[0]); o[1] = __uint_as_float(gw.x & 0xffff0000u) * sigmoidf_(v0[1]);
                    o[2] = __uint_as_float(gw.y << 16) * sigmoidf_(v0[2]); o[3] = __uint_as_float(gw.y & 0xffff0000u) * sigmoidf_(v0[3]);
                    o[4] = __uint_as_float(gw.z << 16) * sigmoidf_(v1[0]); o[5] = __uint_as_float(gw.z & 0xffff0000u) * sigmoidf_(v1[1]);
                    o[6] = __uint_as_float(gw.w << 16) * sigmoidf_(v1[2]); o[7] = __uint_as_float(gw.w & 0xffff0000u) * sigmoidf_(v1[3]);
#pragma unroll
                    for (int e = 0; e < 8; ++e) sq += o[e] * o[e];
                    u32x4 w; w.x = ge::cvt_pk_bf16(o[0], o[1]); w.y = ge::cvt_pk_bf16(o[2], o[3]); w.z = ge::cvt_pk_bf16(o[4], o[5]); w.w = ge::cvt_pk_bf16(o[6], o[7]);
                    *(u32x4*)(MIX + (size_t)row * D + c) = w;
                }
                sq += __shfl_xor(sq, 16); sq += __shfl_xor(sq, 32);
                if (fq == 0) ssp[(size_t)row * 8 + u.pn * 4 + wc] = sq;
            }
    }
};
struct EpiWo {
    static constexpr bool PERM = true, MIDK = true, UBEGIN = true;
    const float* ssp_s; const float* ssp_a; const bf16_t* hin; bf16_t* hb; float* ssp2;
    typedef float f32x2_ __attribute__((ext_vector_type(2)));
    __device__ __forceinline__ void unit_begin(const ge::Unit& u, int tid, LAS unsigned char* rowf) const {
        if (tid < 256) { const int row = u.pm * 256 + tid;
            const float rs_s = rsqrtf(sum8(ssp_s + (size_t)row * 8) * (1.f / SSMW) + EPS), rs_a = rsqrtf(sum8(ssp_a + (size_t)row * 8) * (1.f / ATTW) + EPS);
            ((LAS f32x2_*)rowf)[tid] = (f32x2_){rs_s / rs_a, rs_a}; }
    }
    __device__ __forceinline__ void midk(ge::f32x4 (&acc)[2][2][4][2], const ge::Unit& u, int wr, int fr, LAS unsigned char* rowf) const {
#pragma unroll
        for (int ai = 0; ai < 2; ++ai)
#pragma unroll
            for (int m = 0; m < 4; ++m) {
                const float f = ((const LAS f32x2_*)rowf)[ai * 128 + wr * 64 + m * 16 + fr].x;
#pragma unroll
                for (int bj = 0; bj < 2; ++bj)
#pragma unroll
                    for (int n = 0; n < 2; ++n) acc[ai][bj][m][n] = acc[ai][bj][m][n] * f;
            }
    }
    __device__ __forceinline__ void operator()(const ge::f32x4 (&acc)[2][2][4][2], const ge::Unit& u, int wr, int wc, int fr, int fq, LAS unsigned char* rowf) const {
        const int row0 = u.pm * 256 + wr * 64 + fr, colt = u.pn * 256;
#pragma unroll
        for (int ai = 0; ai < 2; ++ai)
#pragma unroll
            for (int m = 0; m < 4; ++m) {
                const int row = row0 + ai * 128 + m * 16; const float ra = ((const LAS f32x2_*)rowf)[ai * 128 + wr * 64 + m * 16 + fr].y; float sq = 0.f;
#pragma unroll
                for (int bj = 0; bj < 2; ++bj) {
                    const int c = colt + bj * 128 + wc * 32 + 8 * fq;
                    const size_t o = (size_t)row * D + c;
                    const u32x4 hw = *(const u32x4*)(hin + o);
                    const ge::f32x4 a0 = acc[ai][bj][m][0] * ra, a1 = acc[ai][bj][m][1] * ra;
                    u32x4 w; w.x = ge::cvt_pk_bf16(__uint_as_float(hw.x << 16) + a0[0], __uint_as_float(hw.x & 0xffff0000u) + a0[1]); w.y = ge::cvt_pk_bf16(__uint_as_float(hw.y << 16) + a0[2], __uint_as_float(hw.y & 0xffff0000u) + a0[3]);
                    w.z = ge::cvt_pk_bf16(__uint_as_float(hw.z << 16) + a1[0], __uint_as_float(hw.z & 0xffff0000u) + a1[1]); w.w = ge::cvt_pk_bf16(__uint_as_float(hw.w << 16) + a1[2], __uint_as_float(hw.w & 0xffff0000u) + a1[3]);
                    *(u32x4*)(hb + o) = w;
#pragma unroll
                    for (int e = 0; e < 4; ++e) { const float lo = __uint_as_float(w[e] << 16), hi = __uint_as_float(w[e] & 0xffff0000u); sq += lo * lo + hi * hi; }
                }
                sq += __shfl_xor(sq, 16); sq += __shfl_xor(sq, 32);
                if (fq == 0) ssp2[(size_t)row * 16 + u.pn * 4 + wc] = sq;
            }
    }
};
struct EpiWq {
    static constexpr bool PERM = true, MIDK = false, UBEGIN = true;
    const float* ssp2; bf16_t* QP;
    __device__ __forceinline__ void unit_begin(const ge::Unit& u, int tid, LAS unsigned char* rowf) const {
        if (tid < 256) { const int row = u.pm * 256 + tid; ((LAS float*)rowf)[tid] = rsqrtf(sum16(ssp2 + (size_t)row * 16) * (1.f / D) + EPS); }
    }
    __device__ __forceinline__ void midk(ge::f32x4 (&)[2][2][4][2], const ge::Unit&, int, int, LAS unsigned char*) const {}
    __device__ __forceinline__ void operator()(const ge::f32x4 (&acc)[2][2][4][2], const ge::Unit& u, int wr, int wc, int fr, int fq, LAS unsigned char* rowf) const {
        const int row0 = u.pm * 256 + wr * 64 + fr, colt = u.pn * 256;
#pragma unroll
        for (int ai = 0; ai < 2; ++ai)
#pragma unroll
            for (int m = 0; m < 4; ++m) {
                const int row = row0 + ai * 128 + m * 16; const float rs = ((const LAS float*)rowf)[ai * 128 + wr * 64 + m * 16 + fr];
#pragma unroll
                for (int bj = 0; bj < 2; ++bj) {
                    const int c = colt + bj * 128 + wc * 32 + 8 * fq;
                    const ge::f32x4 v0 = acc[ai][bj][m][0] * rs, v1 = acc[ai][bj][m][1] * rs;
                    u32x4 w; w.x = ge::cvt_pk_bf16(v0[0], v0[1]); w.y = ge::cvt_pk_bf16(v0[2], v0[3]); w.z = ge::cvt_pk_bf16(v1[0], v1[1]); w.w = ge::cvt_pk_bf16(v1[2], v1[3]);
                    *(u32x4*)(QP + (size_t)row * D + c) = w;
                }
            }
    }
};

__device__ __forceinline__ void ph_flogit(const bf16_t* __restrict__ hb, const bf16_t* __restrict__ wf, const float* __restrict__ ss, const float* __restrict__ bfv, float* __restrict__ logf) {
    PH_IDS
    const int lane = TIDX & 63, gw = BIDX * 8 + __builtin_amdgcn_readfirstlane(TIDX >> 6), ngw = GDIM * 8, r16 = lane & 15, q4 = lane >> 4;
    for (int item = gw; item < T / 16; item += ngw) {
        const int tok0 = item * 16;
        ge::f32x4 acc = {0.f, 0.f, 0.f, 0.f};
        const bf16_t* ar = hb + (size_t)(tok0 + r16) * D + q4 * 8; const bf16_t* br = wf + (size_t)r16 * D + q4 * 8;
#pragma unroll 8
        for (int ks = 0; ks < D / 32; ++ks) {
            const bf16x8 a = *(const bf16x8*)(ar + ks * 32), b = *(const bf16x8*)(br + ks * 32);
            acc = __builtin_amdgcn_mfma_f32_16x16x32_bf16(a, b, acc, 0, 0, 0);
        }
        if (r16 < NH) {
            const float bj = bfv[r16];
#pragma unroll
            for (int r = 0; r < 4; ++r) {
                const int tok = tok0 + 4 * q4 + r; const float x = acc[r] * rsqrtf(sum8(ss + (size_t)tok * 8) * (1.f / D) + EPS) + bj;
                logf[(size_t)tok * NH + r16] = fminf(x, 0.f) - log1pf(expf(-fabsf(x)));
            }
        }
    }
}
}
namespace nv {
__device__ __forceinline__ float gelu_fast(float x);
constexpr float USCALE = 256.f, VSCALE = 16.f;
typedef float f32x2 __attribute__((ext_vector_type(2)));
typedef int i32x2 __attribute__((ext_vector_type(2)));
__device__ __forceinline__ float clamp448(float x) { return fminf(fmaxf(x, -448.f), 448.f); }
__device__ __forceinline__ unsigned pack4_fp8(float a, float b, float c, float d) {
    int w = 0; w = __builtin_amdgcn_cvt_pk_fp8_f32(clamp448(a), clamp448(b), w, false); w = __builtin_amdgcn_cvt_pk_fp8_f32(clamp448(c), clamp448(d), w, true); return (unsigned)w; }

__device__ __forceinline__ void peer_split(LAS unsigned char* lds, int bid, int grid, int wave, int& slice, int& gw, int& ngw) {
    volatile LAS unsigned* M = (volatile LAS unsigned*)(lds + 131072 + 320);
    const unsigned x = __builtin_amdgcn_readfirstlane(M[16]), rk = __builtin_amdgcn_readfirstlane(M[17]), nl = __builtin_amdgcn_readfirstlane(M[18]), ok = __builtin_amdgcn_readfirstlane(M[19]);
    if (ok) { slice = (int)x; gw = (int)rk * 8 + wave; ngw = (int)nl * 8; }
    else { slice = bid & 7; gw = (bid >> 3) * 8 + wave; ngw = (grid >> 3) * 8; }
}
__device__ __forceinline__ void p0_peer_tables(const float* __restrict__ pu, const float* __restrict__ pv, const float* __restrict__ g2, unsigned char* __restrict__ PU8, unsigned char* __restrict__ PV8) {
    PH_IDS
    const size_t n16 = (size_t)DEPTH * NEXP * D / 16;
    const size_t stride = (size_t)GDIM * 512;
    constexpr int NU = 4;
    for (size_t i0 = (size_t)BIDX * 512 + TIDX; i0 < 2 * n16; i0 += NU * stride) {
        f32x4 x[NU][4];
#pragma unroll
        for (int u = 0; u < NU; ++u) { const size_t i = i0 + u * stride;
            if (i < 2 * n16) { const bool isv = i >= n16; const float* src = (isv ? pv : pu) + (isv ? i - n16 : i) * 16;
#pragma unroll
                for (int k = 0; k < 4; ++k) x[u][k] = *(const f32x4*)(src + 4 * k); } }
#pragma unroll
        for (int u = 0; u < NU; ++u) { const size_t i = i0 + u * stride;
            if (i < 2 * n16) {
                const bool isv = i >= n16; const size_t e0 = (isv ? i - n16 : i) * 16;
                const int l = (int)(e0 / ((size_t)NEXP * D)), c = (int)(e0 % D);
                u32x4 o;
                if (isv) {
#pragma unroll
                    for (int k = 0; k < 4; ++k) o[k] = pack4_fp8(x[u][k].x * VSCALE, x[u][k].y * VSCALE, x[u][k].z * VSCALE, x[u][k].w * VSCALE);
                } else {
#pragma unroll
                    for (int k = 0; k < 4; ++k) { const f32x4 g = *(const f32x4*)(g2 + l * D + c + 4 * k) * USCALE; o[k] = pack4_fp8(x[u][k].x * g.x, x[u][k].y * g.y, x[u][k].z * g.z, x[u][k].w * g.w); }
                }
                const size_t er = (e0 / D) % NEXP;
                *(u32x4*)((isv ? PV8 : PU8) + (((size_t)l * 8 + (c >> 7)) * NEXP + er) * 128 + (c & 127)) = o;
            } }
    }
}

#ifndef PU_LOOK
#define PU_LOOK 7
#endif
#ifndef PV_LO
#define PV_LO 0
#endif
#ifndef PV_LOOK
#define PV_LOOK 7
#endif
constexpr int PB = 16;
#define DPPF(x, CTRL) __int_as_float(__builtin_amdgcn_update_dpp(0, __float_as_int(x), (CTRL), 0xF, 0xF, true))
template <int MODE = 0, int LOOKU = PU_LOOK>
__device__ __forceinline__ void ph_peer_u(LAS unsigned char* lds, const unsigned char* __restrict__ PU8, const bf16_t* __restrict__ hb, const unsigned short* __restrict__ idx, bf16_t* __restrict__ partial, int imask = 0x7fffffff) {
    PH_IDS
    const int lane = TIDX & 63, wave = __builtin_amdgcn_readfirstlane(TIDX >> 6), c8 = lane & 7, rg = lane >> 3;
    int slice, gw, ngw; peer_split(lds, BIDX, GDIM, wave, slice, gw, ngw);
    const unsigned char* tab = PU8 + (size_t)slice * NEXP * 128; const unsigned lo16 = 16u * c8;
    LAS int* li = (LAS int*)(lds + wave * 12288);
    LAS unsigned* lh = (LAS unsigned*)(lds + wave * 12288 + 8192);
    LAS float* tr = (LAS float*)(lds + 8 * 12288 + wave * 512);
    const int ntok = gw < T ? (T - gw + ngw - 1) / ngw : 0;
    const int p0 = 2 * lane, sd0 = (p0 >> 6) * 64 + (p0 & 7) * 8 + ((p0 & 63) >> 3), sd1 = sd0 + 8;
    const bool b2 = (c8 & 4) != 0, b1 = (c8 & 2) != 0, b0 = (c8 & 1) != 0;
    const int i0 = 8 * (int)b2 + 4 * (int)b0 + 2 * (int)b1;
#define PU_SLOAD(k, IW, HW) do { const size_t ts_ = (size_t)gw + (size_t)min((k), ntok - 1) * ngw; IW = *(const unsigned*)(idx + ts_ * 128 + 2 * lane); HW = *(const unsigned*)(hb + ts_ * D + 128 * slice + 2 * lane); } while (0)
#define PU_SWRITE(k, IW, HW) do { LAS int* d_ = li + ((k) & (PB - 1)) * 128; d_[sd0] = (int)((IW) & 0xffffu) & imask; d_[sd1] = (int)((IW) >> 16) & imask; lh[((k) & (PB - 1)) * 64 + lane] = (HW); } while (0)
#define PU_ISSUE(s, B) do { const ge::u32x4 ia_ = *(const LAS ge::u32x4*)(li + (((s) >> 1) & (2 * PB - 1)) * 64 + rg * 8 + 4 * ((s) & 1)); \
            _Pragma("unroll") for (int i_ = 0; i_ < 4; ++i_) rb[B][i_] = *(const u32x4*)(tab + (ia_[i_] * 128u + lo16)); } while (0)
#define PU_STEP(s, B, QT, ISS) do { if (ISS) { PU_ISSUE((s) + LOOKU, ((B) + LOOKU) & 7); asm volatile("" ::: "memory"); __builtin_amdgcn_sched_barrier(0); } \
            const int k_ = (s) >> 2; const size_t t_ = (size_t)gw + (size_t)k_ * ngw; \
            if (QT == 0) { const LAS u32x4* hp_ = (const LAS u32x4*)(lh + (k_ & (PB - 1)) * 64) + 2 * c8; const u32x4 w0 = hp_[0], w1 = hp_[1];          \
                _Pragma("unroll") for (int j = 0; j < 4; ++j) { hx[j] = (f32x2){__uint_as_float(w0[j] << 16), __uint_as_float(w0[j] & 0xffff0000u)}; hx[4 + j] = (f32x2){__uint_as_float(w1[j] << 16), __uint_as_float(w1[j] & 0xffff0000u)}; } } \
            if (MODE >= 2) { _Pragma("unroll") for (int i = 0; i < 4; ++i) { const u32x4 a_ = rb[B][i]; pv[4 * QT + i] = __uint_as_float((a_.x ^ a_.y ^ a_.z ^ a_.w) & 0x3fffffffu); } } \
            _Pragma("unroll") for (int i = 0; i < (MODE == 0 ? 4 : MODE == 3 ? 2 : 0); ++i) { f32x2 dd = {0.f, 0.f}; _Pragma("unroll") for (int k = 0; k < 4; ++k) {        \
                const f32x2 q0 = __builtin_amdgcn_cvt_pk_f32_fp8((int)rb[B][i][k], false), q1 = __builtin_amdgcn_cvt_pk_f32_fp8((int)rb[B][i][k], true); \
                dd = __builtin_elementwise_fma(q0, hx[2 * k], dd); dd = __builtin_elementwise_fma(q1, hx[2 * k + 1], dd); } pv[4 * QT + i] = dd.x + dd.y; } \
            if (QT == 3) { float y[8], z[4]; \
                _Pragma("unroll") for (int j = 0; j < 8; ++j) { const float keep = b2 ? pv[8 + j] : pv[j], send = b2 ? pv[j] : pv[8 + j]; y[j] = keep + DPPF(send, 0x141); }       \
                _Pragma("unroll") for (int j = 0; j < 4; ++j) { const float keep = b0 ? y[4 + j] : y[j], send = b0 ? y[j] : y[4 + j]; z[j] = keep + DPPF(send, 0xB1); }          \
                const float o0 = (b1 ? z[2] : z[0]) + DPPF(b1 ? z[0] : z[2], 0x4E), o1 = (b1 ? z[3] : z[1]) + DPPF(b1 ? z[1] : z[3], 0x4E);                                    \
                  \
                tr[8 * i0 + rg] = o0; tr[8 * i0 + 8 + rg] = o1; const f32x2 ov_ = *(const LAS f32x2*)(tr + 2 * lane); \
                *(unsigned*)(partial + ((size_t)slice * T + t_) * 128 + 2 * lane) = pk2(ov_.x, ov_.y); } asm volatile("" ::: "memory"); __builtin_amdgcn_sched_barrier(0); } while (0)
    if (ntok >= 8 && !(ntok & 1)) {
        u32x4 rb[8][4]; float pv[16]; f32x2 hx[8]; unsigned xi, xh, yi, yh;
        { unsigned a_[6], b_[6];
#pragma unroll
            for (int k = 0; k < 6; ++k) PU_SLOAD(k, a_[k], b_[k]);
            PU_SLOAD(6, xi, xh); PU_SLOAD(7, yi, yh);
#pragma unroll
            for (int k = 0; k < 6; ++k) PU_SWRITE(k, a_[k], b_[k]); }
        asm volatile("s_waitcnt vmcnt(0) lgkmcnt(0)" ::: "memory");
#define ORD_ asm volatile("" ::: "memory"); __builtin_amdgcn_sched_barrier(0);
        PU_ISSUE(0, 0); ORD_ PU_ISSUE(1, 1); ORD_ PU_ISSUE(2, 2); ORD_ PU_ISSUE(3, 3); ORD_ if (LOOKU > 4) { PU_ISSUE(4, 4); ORD_ } if (LOOKU > 5) { PU_ISSUE(5, 5); ORD_ } if (LOOKU > 6) { PU_ISSUE(6, 6); ORD_ }
#undef ORD_
        const int send = 4 * ntok - 8;
#pragma nounroll
        for (int s0 = 0; s0 < send; s0 += 8) {
            PU_SWRITE((s0 >> 2) + 6, xi, xh); PU_SLOAD((s0 >> 2) + 8, xi, xh);
            PU_STEP(s0, 0, 0, 1); PU_STEP(s0 + 1, 1, 1, 1); PU_STEP(s0 + 2, 2, 2, 1); PU_STEP(s0 + 3, 3, 3, 1);
            PU_SWRITE((s0 >> 2) + 7, yi, yh); PU_SLOAD((s0 >> 2) + 9, yi, yh);
            PU_STEP(s0 + 4, 4, 0, 1); PU_STEP(s0 + 5, 5, 1, 1); PU_STEP(s0 + 6, 6, 2, 1); PU_STEP(s0 + 7, 7, 3, 1); }
        { const int s0 = send; PU_STEP(s0, 0, 0, (0 + LOOKU <= 7)); PU_STEP(s0 + 1, 1, 1, (1 + LOOKU <= 7)); PU_STEP(s0 + 2, 2, 2, (2 + LOOKU <= 7)); PU_STEP(s0 + 3, 3, 3, 0); PU_STEP(s0 + 4, 4, 0, 0); PU_STEP(s0 + 5, 5, 1, 0); PU_STEP(s0 + 6, 6, 2, 0); PU_STEP(s0 + 7, 7, 3, 0); }
    } else {
        u32x4 rb[8][4]; float pv[16]; f32x2 hx[8];
#pragma nounroll
        for (int k = 0; k < ntok; ++k) {
            { unsigned a_, b_; PU_SLOAD(k, a_, b_); PU_SWRITE(k, a_, b_); } asm volatile("s_waitcnt vmcnt(0) lgkmcnt(0)" ::: "memory");
            const int s0 = 4 * k; PU_ISSUE(s0, 0); PU_ISSUE(s0 + 1, 1); PU_ISSUE(s0 + 2, 2); PU_ISSUE(s0 + 3, 3);
            PU_STEP(s0, 0, 0, 0); PU_STEP(s0 + 1, 1, 1, 0); PU_STEP(s0 + 2, 2, 2, 0); PU_STEP(s0 + 3, 3, 3, 0); }
    }
#undef PU_SLOAD
#undef PU_SWRITE
#undef PU_ISSUE
#undef PU_STEP
    asm volatile("s_waitcnt lgkmcnt(0)" ::: "memory");
}

constexpr float CSCALE = 32.f;
__device__ __forceinline__ void ph_peer_coef(const bf16_t* __restrict__ partial, const float* __restrict__ ssp2, const float* __restrict__ gate, unsigned short* __restrict__ coef8) {
    PH_IDS
    const size_t n4 = (size_t)T * 128 / 4, stride = (size_t)GDIM * 512;
    for (size_t i0 = (size_t)BIDX * 512 + TIDX; i0 < n4; i0 += 2 * stride) {
        ge::u32x2 pv[2][8]; f32x4 gv[2]; float rs[2];
#pragma unroll
        for (int u = 0; u < 2; ++u) { const size_t i = i0 + u * stride;
            if (i < n4) {
#pragma unroll
                for (int k = 0; k < 8; ++k) pv[u][k] = *(const ge::u32x2*)(partial + (size_t)k * T * 128 + 4 * i);
                gv[u] = *(const f32x4*)(gate + 4 * i); rs[u] = sum16(ssp2 + (i >> 5) * 16);
            } }
#pragma unroll
        for (int u = 0; u < 2; ++u) { const size_t i = i0 + u * stride;
            if (i < n4) {
                f32x4 s = {0.f, 0.f, 0.f, 0.f};
#pragma unroll
                for (int k = 0; k < 8; ++k) { s.x += __uint_as_float(pv[u][k].x << 16); s.y += __uint_as_float(pv[u][k].x & 0xffff0000u); s.z += __uint_as_float(pv[u][k].y << 16); s.w += __uint_as_float(pv[u][k].y & 0xffff0000u); }
                const float sc = rsqrtf(rs[u] * (1.f / D) + EPS) * (1.f / USCALE);
                f32x4 o; o.x = gelu_fast(s.x * sc) * gv[u].x * CSCALE; o.y = gelu_fast(s.y * sc) * gv[u].y * CSCALE; o.z = gelu_fast(s.z * sc) * gv[u].z * CSCALE; o.w = gelu_fast(s.w * sc) * gv[u].w * CSCALE;
                const unsigned hi = pack4_fp8(o.x, o.y, o.z, o.w);
                const f32x2 h01 = __builtin_amdgcn_cvt_pk_f32_fp8((int)hi, false), h23 = __builtin_amdgcn_cvt_pk_f32_fp8((int)hi, true);
                const unsigned lo = pack4_fp8(o.x - h01.x, o.y - h01.y, o.z - h23.x, o.w - h23.y);
                const unsigned w0 = (hi & 0xffu) | ((lo & 0xffu) << 8) | ((hi & 0xff00u) << 8) | ((lo & 0xff00u) << 16);
                const unsigned w1 = ((hi >> 16) & 0xffu) | (((lo >> 16) & 0xffu) << 8) | ((hi >> 8) & 0xff0000u) | (lo & 0xff000000u);
                *(ge::u32x2*)(coef8 + 4 * i) = (ge::u32x2){w0, w1};
            } }
    }
}

template <int MODE = 0>
__device__ __forceinline__ void ph_peer_v(LAS unsigned char* lds, const unsigned char* __restrict__ PV8, const unsigned short* __restrict__ idx, const unsigned short* __restrict__ coef8, const bf16_t* hin, bf16_t* hb, float* __restrict__ ssp1, int imask = 0x7fffffff) {
    PH_IDS
    const int lane = TIDX & 63, wave = __builtin_amdgcn_readfirstlane(TIDX >> 6), c8 = lane & 7, rg = lane >> 3;
    int slice, gw, ngw; peer_split(lds, BIDX, GDIM, wave, slice, gw, ngw);
    const unsigned char* tab = PV8 + (size_t)slice * NEXP * 128; const unsigned lo16 = 16u * c8;
    LAS int* li = (LAS int*)(lds + wave * 16384);
    LAS unsigned short* lc = (LAS unsigned short*)(lds + wave * 16384 + 8192);
    LAS unsigned* lr = (LAS unsigned*)(lds + wave * 16384 + 12288);
    LAS float* tr = (LAS float*)(lds + ge::ROWF_OFF + wave * 1024);
    const int ntok = gw < T ? (T - gw + ngw - 1) / ngw : 0;
    const int p0 = 2 * lane, sd0 = (p0 >> 6) * 64 + (p0 & 7) * 8 + ((p0 & 63) >> 3), sd1 = sd0 + 8;
    const unsigned bsh = 8u * (c8 & 3), mlo = c8 < 4 ? 0xffffffffu : 0u, mhi = ~mlo;
    const int nn = lane & 15, qq = lane >> 4; const bool dvalid = (nn >> 3) == (qq >> 1);
    const int dcol = 64 * (qq & 1) + (nn & 7);
#define PV_SLOAD(k, IW, CW, RW) do { const size_t ts_ = (size_t)gw + (size_t)min((k), ntok - 1) * ngw; IW = *(const unsigned*)(idx + ts_ * 128 + 2 * lane); CW = *(const unsigned*)(coef8 + ts_ * 128 + 2 * lane); \
            RW = *(const unsigned*)(hin + ts_ * D + 128 * slice + 2 * lane); } while (0)
#define PV_SWRITE(k, IW, CW, RW) do { const int o_ = ((k) & (PB - 1)) * 128; li[o_ + sd0] = (int)((IW) & 0xffffu) & imask; li[o_ + sd1] = (int)((IW) >> 16) & imask; \
            lc[o_ + sd0] = (unsigned short)((CW) & 0xffffu); lc[o_ + sd1] = (unsigned short)((CW) >> 16); lr[((k) & (PB - 1)) * 64 + lane] = (RW); } while (0)
#define PV_ISSUE(s, B) do { const ge::u32x4 ia_ = *(const LAS ge::u32x4*)(li + (((s) >> 1) & (2 * PB - 1)) * 64 + rg * 8 + 4 * ((s) & 1)); \
            _Pragma("unroll") for (int i_ = 0; i_ < 4; ++i_) rb[B][i_] = *(const u32x4*)(tab + (ia_[i_] * 128u + lo16)); } while (0)
#define PV_STEP(s, B, QT, ISS) do { if (ISS) { PV_ISSUE((s) + PV_LOOK, ((B) + PV_LOOK) & 7); asm volatile("" ::: "memory"); __builtin_amdgcn_sched_barrier(0); } \
            const int k_ = (s) >> 2; const size_t t_ = (size_t)gw + (size_t)k_ * ngw; \
            if (QT == 0) { acc0 = (ge::f32x4){0.f, 0.f, 0.f, 0.f}; acc1 = acc0; } \
            const ge::u32x2 cw_ = *(const LAS ge::u32x2*)(lc + (((s) >> 1) & (2 * PB - 1)) * 64 + rg * 8 + 4 * ((s) & 1));                       \
            _Pragma("unroll") for (int i = 0; i < 4; ++i) { const unsigned w_ = (i < 2 ? cw_.x : cw_.y) >> (16 * (i & 1)); \
                const unsigned th_ = (w_ & 0xffu) << bsh, tl_ = ((w_ >> 8) & 0xffu) << bsh; \
                const long bh_ = (long)(((unsigned long long)(th_ & mhi) << 32) | (th_ & mlo)), bl_ = (long)(((unsigned long long)(tl_ & mhi) << 32) | (tl_ & mlo)); \
                const u32x4 av = rb[B][i]; const long a0_ = (long)(((unsigned long long)av.y << 32) | av.x), a1_ = (long)(((unsigned long long)av.w << 32) | av.z); \
                acc0 = __builtin_amdgcn_mfma_f32_16x16x32_fp8_fp8(a0_, bh_, acc0, 0, 0, 0); acc1 = __builtin_amdgcn_mfma_f32_16x16x32_fp8_fp8(a1_, bh_, acc1, 0, 0, 0); \
                if (PV_LO) { acc0 = __builtin_amdgcn_mfma_f32_16x16x32_fp8_fp8(a0_, bl_, acc0, 0, 0, 0); acc1 = __builtin_amdgcn_mfma_f32_16x16x32_fp8_fp8(a1_, bl_, acc1, 0, 0, 0); } } \
            if (QT == 3) { \
                if (dvalid) { LAS float* tp_ = tr + 128 * (qq >> 1) + dcol; _Pragma("unroll") for (int i = 0; i < 4; ++i) { tp_[16 * i] = acc0[i]; tp_[16 * i + 8] = acc1[i]; } } \
                const f32x2 e0_ = *(const LAS f32x2*)(tr + 2 * lane), e1_ = *(const LAS f32x2*)(tr + 128 + 2 * lane);                 \
                const unsigned hv = lr[(k_ & (PB - 1)) * 64 + lane];                                                                     \
                const unsigned w2_ = pk2(__uint_as_float(hv << 16) + (e0_.x + e1_.x) * (1.f / (VSCALE * CSCALE)), __uint_as_float(hv & 0xffff0000u) + (e0_.y + e1_.y) * (1.f / (VSCALE * CSCALE))); \
                *(unsigned*)(hb + t_ * D + 128 * slice + 2 * lane) = w2_; const float x0 = __uint_as_float(w2_ << 16), x1 = __uint_as_float(w2_ & 0xffff0000u); \
                float sq = x0 * x0 + x1 * x1; sq = wave_sum(sq); if (lane == 0) ssp1[t_ * 8 + slice] = sq; } \
            asm volatile("" : "+v"(acc0), "+v"(acc1) :: "memory");             \
            __builtin_amdgcn_sched_barrier(0); } while (0)
    if (ntok >= 8 && !(ntok & 1)) {
        u32x4 rb[8][4]; ge::f32x4 acc0, acc1; unsigned xi, xc, xr, yi, yc, yr;
        { unsigned a_[6], b_[6], c_[6];
#pragma unroll
            for (int k = 0; k < 6; ++k) PV_SLOAD(k, a_[k], b_[k], c_[k]);
            PV_SLOAD(6, xi, xc, xr); PV_SLOAD(7, yi, yc, yr);
#pragma unroll
            for (int k = 0; k < 6; ++k) PV_SWRITE(k, a_[k], b_[k], c_[k]); }
        asm volatile("s_waitcnt vmcnt(0) lgkmcnt(0)" ::: "memory");
#define ORD_ asm volatile("" ::: "memory"); __builtin_amdgcn_sched_barrier(0);
        PV_ISSUE(0, 0); ORD_ PV_ISSUE(1, 1); ORD_ PV_ISSUE(2, 2); ORD_ PV_ISSUE(3, 3); ORD_ if (PV_LOOK > 4) { PV_ISSUE(4, 4); ORD_ } if (PV_LOOK > 5) { PV_ISSUE(5, 5); ORD_ } if (PV_LOOK > 6) { PV_ISSUE(6, 6); ORD_ }
#undef ORD_
        const int send = 4 * ntok - 8;
#pragma nounroll
        for (int s0 = 0; s0 < send; s0 += 8) {
            PV_SWRITE((s0 >> 2) + 6, xi, xc, xr); PV_SLOAD((s0 >> 2) + 8, xi, xc, xr);
            PV_STEP(s0, 0, 0, 1); PV_STEP(s0 + 1, 1, 1, 1); PV_STEP(s0 + 2, 2, 2, 1); PV_STEP(s0 + 3, 3, 3, 1);
            PV_SWRITE((s0 >> 2) + 7, yi, yc, yr); PV_SLOAD((s0 >> 2) + 9, yi, yc, yr);
            PV_STEP(s0 + 4, 4, 0, 1); PV_STEP(s0 + 5, 5, 1, 1); PV_STEP(s0 + 6, 6, 2, 1); PV_STEP(s0 + 7, 7, 3, 1); }
        { const int s0 = send; PV_STEP(s0, 0, 0, (0 + PV_LOOK <= 7)); PV_STEP(s0 + 1, 1, 1, (1 + PV_LOOK <= 7)); PV_STEP(s0 + 2, 2, 2, (2 + PV_LOOK <= 7)); PV_STEP(s0 + 3, 3, 3, 0); PV_STEP(s0 + 4, 4, 0, 0); PV_STEP(s0 + 5, 5, 1, 0); PV_STEP(s0 + 6, 6, 2, 0); PV_STEP(s0 + 7, 7, 3, 0); }
    } else {
        u32x4 rb[8][4]; ge::f32x4 acc0, acc1;
#pragma nounroll
        for (int k = 0; k < ntok; ++k) {
            { unsigned a_, b_, c_; PV_SLOAD(k, a_, b_, c_); PV_SWRITE(k, a_, b_, c_); } asm volatile("s_waitcnt vmcnt(0) lgkmcnt(0)" ::: "memory");
            const int s0 = 4 * k; PV_ISSUE(s0, 0); PV_ISSUE(s0 + 1, 1); PV_ISSUE(s0 + 2, 2); PV_ISSUE(s0 + 3, 3);
            PV_STEP(s0, 0, 0, 0); PV_STEP(s0 + 1, 1, 1, 0); PV_STEP(s0 + 2, 2, 2, 0); PV_STEP(s0 + 3, 3, 3, 0); }
    }
#undef PV_SLOAD
#undef PV_SWRITE
#undef PV_ISSUE
#undef PV_STEP
    asm volatile("s_waitcnt lgkmcnt(0)" ::: "memory");
}

__device__ __forceinline__ void ph_final(const bf16_t* __restrict__ hb, const float* __restrict__ ssp1, const float* __restrict__ g, float* __restrict__ out) {
    PH_IDS
    const int lane = TIDX & 63, gw = BIDX * 8 + __builtin_amdgcn_readfirstlane(TIDX >> 6), ngw = GDIM * 8;
    for (int w = gw; w < T; w += ngw) {
        const float rs = rsqrtf(sum8(ssp1 + (size_t)w * 8) * (1.f / D) + EPS);
        const u32x4* r = (const u32x4*)(hb + (size_t)w * D) + lane; const f32x4* gg = (const f32x4*)g; f32x4* o = (f32x4*)(out + (size_t)w * D);
#pragma unroll
        for (int j = 0; j < 2; ++j) { const u32x4 v = r[64 * j]; const int c4 = (64 * j + lane) * 2; const f32x4 g0 = gg[c4], g1 = gg[c4 + 1];
            o[c4] = (f32x4){__uint_as_float(v.x << 16) * rs * g0.x, __uint_as_float(v.x & 0xffff0000u) * rs * g0.y, __uint_as_float(v.y << 16) * rs * g0.z, __uint_as_float(v.y & 0xffff0000u) * rs * g0.w};
            o[c4 + 1] = (f32x4){__uint_as_float(v.z << 16) * rs * g1.x, __uint_as_float(v.z & 0xffff0000u) * rs * g1.y, __uint_as_float(v.w << 16) * rs * g1.z, __uint_as_float(v.w & 0xffff0000u) * rs * g1.w}; }
    }
}
}
namespace attn_body {
using bf16=__hip_bfloat16;
using bf16x8=__attribute__((ext_vector_type(8)))short;
using s16x4=__attribute__((ext_vector_type(4)))short;
using f32x16=__attribute__((ext_vector_type(16)))float;
using u32x4=__attribute__((ext_vector_type(4)))unsigned;
constexpr int BATCH=8,NHEAD=8,SEQ=4096,D=64,DM=NHEAD*D;
constexpr int OPITCH=1024,OCOL=512;
constexpr int NW=8,QBLK=32,QB=QBLK*NW,KVBLK=64,NQB=SEQ/QB;
constexpr int ATTN_PITCH=DM, ATTN_UNIT_ROWS=QB;
__device__ __forceinline__ int crow(int r,int hi){return (r&3)+8*(r>>2)+4*hi;}
#define SBAR() __builtin_amdgcn_sched_barrier(0)
__device__ __forceinline__ void cmask(f32x16&p0,f32x16&p1,int jb,int qrel,int hi){
  const float NEG=-INFINITY; int kb=64*jb+4*hi;
  #pragma unroll
  for(int r=0;r<16;++r){int kv=kb+(r&3)+8*(r>>2); if(kv>qrel)p0[r]=NEG; if(kv+32>qrel)p1[r]=NEG;}
}

constexpr int NSLOT=3, SLOTB=8192;
constexpr int LDS_K=0, LDS_V=NSLOT*SLOTB, LDS_WS=2*NSLOT*SLOTB, LDS_OST=LDS_WS+NW*64*4, LDS_CUM=LDS_OST+NW*4096, LDS_BYTES=LDS_CUM+SEQ*4;
constexpr float PRUNE_T=64.f;
constexpr float C2=0.125f*1.4426950408889634f;
__device__ __forceinline__ void glds16(const void*gsrc,unsigned lds_dst){unsigned keep;
  asm volatile("s_mov_b32 %0, m0\n\ts_mov_b32 m0, %2\n\ts_nop 0\n\tglobal_load_lds_dwordx4 %1, off\n\ts_mov_b32 m0, %0":"=&s"(keep):"v"(gsrc),"s"(lds_dst):"memory");}
__device__ __forceinline__ float max3f(float a,float b,float c){float r;asm("v_max3_f32 %0, %1, %2, %3":"=v"(r):"v"(a),"v"(b),"v"(c));return r;}
__device__ __forceinline__ float max2f(float a,float b){float r;asm("v_max_f32_e32 %0, %1, %2":"=v"(r):"v"(a),"v"(b));return r;}
__device__ __forceinline__ float fadd_s(float a,float b){float r;asm("v_add_f32_e32 %0, %1, %2":"=v"(r):"v"(a),"v"(b));return r;}
__device__ __forceinline__ float fsub_s(float a,float b){float r;asm("v_sub_f32_e32 %0, %1, %2":"=v"(r):"v"(a),"v"(b));return r;}
typedef float f32x4_t __attribute__((ext_vector_type(4)));
typedef float f32x2_t __attribute__((ext_vector_type(2))); typedef __bf16 bf16x2_t __attribute__((ext_vector_type(2)));
__device__ __forceinline__ unsigned cvtpk_s(float lo,float hi){f32x2_t v={lo,hi};bf16x2_t b=__builtin_convertvector(v,bf16x2_t);return __builtin_bit_cast(unsigned,b);}
#define WAIT_BAR(N) asm volatile("s_waitcnt vmcnt(" #N ") lgkmcnt(0)\n\ts_barrier":::"memory")

__device__ __forceinline__ void qkt(f32x16&p0,f32x16&p1,const char*Kslot,const bf16x8*qr,const f32x16&negm,int r32,int hi){
  const char*kb=Kslot+hi*1024+r32*16;
  #pragma unroll
  for(int d0=0;d0<4;++d0){
    const bf16x8 b0=*reinterpret_cast<const bf16x8*>(kb+d0*2048);
    const bf16x8 b1=*reinterpret_cast<const bf16x8*>(kb+d0*2048+512);
    if(d0==0){p0=__builtin_amdgcn_mfma_f32_32x32x16_bf16(b0,qr[0],negm,0,0,0);p1=__builtin_amdgcn_mfma_f32_32x32x16_bf16(b1,qr[0],negm,0,0,0);}
    else{p0=__builtin_amdgcn_mfma_f32_32x32x16_bf16(b0,qr[d0],p0,0,0,0);p1=__builtin_amdgcn_mfma_f32_32x32x16_bf16(b1,qr[d0],p1,0,0,0);}}
}
typedef __attribute__((address_space(3))) const char* lds_cptr;
typedef short v4i16_t __attribute__((ext_vector_type(4)));
__device__ __forceinline__ void kload8(bf16x8*kf,lds_cptr kp){
  kf[0]=*(const __attribute__((address_space(3))) bf16x8*)(kp);      kf[1]=*(const __attribute__((address_space(3))) bf16x8*)(kp+512);
  kf[2]=*(const __attribute__((address_space(3))) bf16x8*)(kp+2048); kf[3]=*(const __attribute__((address_space(3))) bf16x8*)(kp+2560);
  kf[4]=*(const __attribute__((address_space(3))) bf16x8*)(kp+4096); kf[5]=*(const __attribute__((address_space(3))) bf16x8*)(kp+4608);
  kf[6]=*(const __attribute__((address_space(3))) bf16x8*)(kp+6144); kf[7]=*(const __attribute__((address_space(3))) bf16x8*)(kp+6656);
}
__device__ __forceinline__ void kload2(bf16x8*kf,lds_cptr kp,int j){ kf[2*j]=*(const __attribute__((address_space(3))) bf16x8*)(kp+j*2048); kf[2*j+1]=*(const __attribute__((address_space(3))) bf16x8*)(kp+j*2048+512); }
__device__ __forceinline__ s16x4 vtr(lds_cptr p){ return __builtin_bit_cast(s16x4,__builtin_amdgcn_ds_read_tr16_b64_v4i16((__attribute__((address_space(3))) v4i16_t*)p)); }
__device__ __forceinline__ float rowmax(const f32x16&p0,const f32x16&p1){
  float a=max3f(p0[0],p0[1],p1[0]),b=max3f(p0[2],p0[3],p1[1]);a=max3f(a,p1[2],p1[3]);
  #pragma unroll
  for(int r=4;r<16;r+=4){a=max3f(a,p0[r],p0[r+1]);b=max3f(b,p0[r+2],p0[r+3]);a=max3f(a,p1[r],p1[r+1]);b=max3f(b,p1[r+2],p1[r+3]);}
  const float m=max2f(a,b);
  auto rr=__builtin_amdgcn_permlane32_swap(__float_as_uint(m),__float_as_uint(m),false,false);
  return max2f(__uint_as_float(rr[0]),__uint_as_float(rr[1]));
}
__device__ __forceinline__ void pv(f32x16*o,int vb,bf16x8 pa0,bf16x8 pa1,bf16x8 pa2,bf16x8 pa3){
  #pragma unroll
  for(int d0=0;d0<2;++d0){s16x4 lo[4],hi[4];
    #pragma unroll
    for(int ks=0;ks<4;++ks){
      asm volatile("ds_read_b64_tr_b16 %0,%1 offset:%c2":"=&v"(lo[ks]):"v"(vb),"i"(d0*4096+ks*1024):"memory");
      asm volatile("ds_read_b64_tr_b16 %0,%1 offset:%c2":"=&v"(hi[ks]):"v"(vb),"i"(d0*4096+ks*1024+512):"memory");}
    asm volatile("s_waitcnt lgkmcnt(0)":::"memory");SBAR();
    #define PK(k) (bf16x8){lo[k][0],lo[k][1],lo[k][2],lo[k][3],hi[k][0],hi[k][1],hi[k][2],hi[k][3]}
    o[d0]=__builtin_amdgcn_mfma_f32_32x32x16_bf16(pa0,PK(0),o[d0],0,0,0);
    o[d0]=__builtin_amdgcn_mfma_f32_32x32x16_bf16(pa1,PK(1),o[d0],0,0,0);
    o[d0]=__builtin_amdgcn_mfma_f32_32x32x16_bf16(pa2,PK(2),o[d0],0,0,0);
    o[d0]=__builtin_amdgcn_mfma_f32_32x32x16_bf16(pa3,PK(3),o[d0],0,0,0);
    #undef PK
  }
}

#ifndef ATTN_STORE16
#define ATTN_STORE16(p,v) (*(u32x4*)(p)=(v))
#endif
template<int THRL> __device__ __forceinline__ void attn_unit(int b,int h,int qb,const bf16*Q,const bf16*__restrict__ K,const bf16*__restrict__ V,const float*__restrict__ cum2,bf16*O,float*__restrict__ ssp,char*shm,int tid_){
  int tid=tid_; asm volatile("":"+v"(tid)); const int lane=tid&63,r32=lane&31,hi=lane>>5; const int wid=__builtin_amdgcn_readfirstlane(tid>>6);
  const long rowbase=(long)b*SEQ; const int q0=qb*QB;
  const bf16*Qw=Q+(rowbase+q0+wid*QBLK)*DM+h*D;
  const bf16*Kh=K+rowbase*DM+h*D,*Vh=V+rowbase*DM+h*D;
  const unsigned lds0=(unsigned)(uintptr_t)shm;
  float*wsf=(float*)(shm+LDS_WS)+wid*64;
  const int NTf=(q0+QB)/KVBLK; const float*cg=cum2+(long)(b*NHEAD+h)*SEQ;
  int ts; { const float thr=cg[q0]+PRUNE_T; const float ce=lane<NTf?cg[64*lane+63]:0.f; const unsigned long long m_=__ballot((lane<NTf)&&(ce<=thr));
    ts=m_?(int)__builtin_ctzll(m_):0; ts&=~1; if(ts>NTf-4)ts=NTf-4; ts=__builtin_amdgcn_readfirstlane(ts); }
  const bf16*ksrc=Kh+(long)(ts*KVBLK+lane)*DM+wid*8;
  const bf16*vsrc=Vh+(long)(ts*KVBLK+16*(wid&3)+(lane>>2))*DM+(wid>>2)*32+(lane&3)*8;
  const unsigned kdst=lds0+LDS_K+wid*1024, vdst=lds0+LDS_V+wid*1024;
  #define DMA_K(t,slot) glds16(ksrc+(long)(t)*KVBLK*DM,(unsigned)__builtin_amdgcn_readfirstlane(kdst+(slot)))
  #define DMA_V(t,slot) glds16(vsrc+(long)(t)*KVBLK*DM,(unsigned)__builtin_amdgcn_readfirstlane(vdst+(slot)))
  const int vb0=(int)(lds0+LDS_V)+((lane>>4)&1)*32+(lane&3)*8+(4*hi+((lane&15)>>2))*64;
  const char*Kbase=shm+LDS_K; bf16x8 kf[8];
  const lds_cptr shm3=(lds_cptr)shm; const lds_cptr kp0=shm3+LDS_K+hi*1024+r32*16; const lds_cptr vp0=shm3+LDS_V+((lane>>4)&1)*32+(lane&3)*8+(4*hi+((lane&15)>>2))*64;
  { float*cl=(float*)(shm+LDS_CUM); for(int i=tid+ts*KVBLK;i<q0+QB;i+=NW*64)cl[i-ts*KVBLK]=cg[i]; }
  const float cq2=cg[q0+wid*QBLK+r32];
  const __attribute__((address_space(3))) float* ckl=(const __attribute__((address_space(3))) float*)(shm3+LDS_CUM)+4*hi;
  #define BIAS(P0,P1,t) do{ const __attribute__((address_space(3))) float*ck_=ckl+64*(t); const float mm_=mhat-cq2; _Pragma("unroll") for(int g_=0;g_<4;++g_){ \
      const f32x4_t c0_=*(const __attribute__((address_space(3))) f32x4_t*)(ck_+8*g_)+mm_, c1_=*(const __attribute__((address_space(3))) f32x4_t*)(ck_+32+8*g_)+mm_; \
      _Pragma("unroll") for(int i_=0;i_<4;++i_){P0[4*g_+i_]-=c0_[i_];P1[4*g_+i_]-=c1_[i_];} SBAR(); } }while(0)
  const int NT=NTf-ts;
  DMA_K(0,0);DMA_V(0,0);DMA_K(1,SLOTB);
  bf16x8 qr[4];
  #pragma unroll
  for(int d0=0;d0<4;++d0)qr[d0]=*reinterpret_cast<const bf16x8*>(&Qw[(long)r32*DM+d0*16+hi*8]);
  float mhat=0.f,l_reg=0.f;f32x16 o[2];o[0]=f32x16{};o[1]=f32x16{};const f32x16 negm=f32x16{};
  const int qrel=wid*QBLK+r32;
  #define CMASK(P0,P1,t) do{int jb_=(t)-(NT-4); if(jb_>=0)cmask(P0,P1,jb_,qrel,hi);}while(0)
  bool resc=false;
  #define START(P0,P1) do{ const float rm=rowmax(P0,P1); resc=false; \
    { const float dl=rm; mhat=fadd_s(mhat,dl); \
      _Pragma("unroll") for(int r=0;r<16;++r){P0[r]=fsub_s(P0[r],dl);P1[r]=fsub_s(P1[r],dl);} \
      } \
    _Pragma("unroll") for(int r=0;r<16;++r)P0[r]=__builtin_amdgcn_exp2f(P0[r]); }while(0)
  #define RESC() do{ if(resc){ asm volatile("s_waitcnt lgkmcnt(0)":::"memory"); \
      _Pragma("unroll") for(int d_=0;d_<2;++d_) _Pragma("unroll") for(int r=0;r<16;++r)o[d_][r]*=wsf[crow(r,hi)]; } }while(0)
  f32x16 pA0,pA1,pB0,pB1;
  int sl_prev=0,sl_cur=0,sl_next=SLOTB;
  #define ROT() do{sl_prev=sl_cur;sl_cur=sl_next;sl_next=(sl_next==(NSLOT-1)*SLOTB)?0:sl_next+SLOTB;}while(0)
  DMA_K(2,2*SLOTB);
  WAIT_BAR(3);
  qkt(pA0,pA1,Kbase,qr,negm,r32,hi);asm volatile("s_nop 15\n\ts_nop 7":"+v"(pA0),"+v"(pA1));BIAS(pA0,pA1,0);CMASK(pA0,pA1,0);
  START(pA0,pA1);
  _Pragma("unroll") for(int r=0;r<16;++r)pA1[r]=__builtin_amdgcn_exp2f(pA1[r]);
  WAIT_BAR(0);
  DMA_K(3,0);DMA_V(1,SLOTB);
  ROT();
  kload8(kf,kp0+sl_cur);
  WAIT_BAR(2);
  s16x4 vlo[8],vhi[8]; u32x4 pw0,pw1,pw2,pw3;
  #define PKW(P,B) cvtpk_s(P[B],P[B+1])
  #define PAF(k) __builtin_bit_cast(bf16x8,pw##k)
  #define VFR(i) (bf16x8){vlo[i][0],vlo[i][1],vlo[i][2],vlo[i][3],vhi[i][0],vhi[i][1],vhi[i][2],vhi[i][3]}
  #define PIN(x) asm volatile("":"+v"(x))
  #define MX3(a,b,c) __builtin_fmaxf(__builtin_fmaxf((a),(b)),(c))
  #define GAPA(MF,A0,A1,A2,A3,W0,W1,PW) do{ MF; sacc+=A0; sacc+=A1; sacc+=A2; sacc+=A3; PIN(sacc); W0; W1; PIN(PW); SBAR(); }while(0)
  #define EX(v) __builtin_amdgcn_exp2f(v)
  #define GAPB(MF,X,B) do{ MF; X[B]=EX(X[B]); X[B+1]=EX(X[B+1]); X[B+2]=EX(X[B+2]); X[B+3]=EX(X[B+3]); PIN(X); SBAR(); }while(0)
  #define VRD(i) do{ vlo[i]=vtr(vp_+(((i)>>2)*4096+((i)&3)*1024)); vhi[i]=vtr(vp_+(((i)>>2)*4096+((i)&3)*1024+512)); }while(0)
  #define KRD(G,j) do{ if(G){ kload2(kf,kp0+sl_next,j); SBAR(); } }while(0)
  #define STEP(C0,C1,P0,P1,t,GK,GV,GL) do{ SBAR(); \
    const lds_cptr vp_=vp0+sl_prev; \
    VRD(0); SBAR(); float sacc=(P0[0]+P0[1]); \
    GAPA(C0=__builtin_amdgcn_mfma_f32_32x32x16_bf16(kf[0],qr[0],negm,0,0,0), P0[2],P0[3],P0[4],P0[5],     pw0[0]=PKW(P0,0), pw0[1]=PKW(P0,2), pw0); \
    VRD(4); SBAR(); GAPA(C1=__builtin_amdgcn_mfma_f32_32x32x16_bf16(kf[1],qr[0],negm,0,0,0), P0[6],P0[7],P0[8],P0[9],     pw0[2]=PKW(P0,4), pw0[3]=PKW(P0,6), pw0); \
    VRD(1); SBAR(); GAPA(C0=__builtin_amdgcn_mfma_f32_32x32x16_bf16(kf[2],qr[1],C0,0,0,0),   P0[10],P0[11],P0[12],P0[13], pw1[0]=PKW(P0,8), pw1[1]=PKW(P0,10), pw1); \
    VRD(5); SBAR(); GAPA(C1=__builtin_amdgcn_mfma_f32_32x32x16_bf16(kf[3],qr[1],C1,0,0,0),   P0[14],P0[15],P1[0],P1[1],   pw1[2]=PKW(P0,12),pw1[3]=PKW(P0,14), pw1); \
    VRD(2); SBAR(); GAPA(C0=__builtin_amdgcn_mfma_f32_32x32x16_bf16(kf[4],qr[2],C0,0,0,0),   P1[2],P1[3],P1[4],P1[5],     pw2[0]=PKW(P1,0), pw2[1]=PKW(P1,2), pw2); \
    VRD(6); SBAR(); GAPA(C1=__builtin_amdgcn_mfma_f32_32x32x16_bf16(kf[5],qr[2],C1,0,0,0),   P1[6],P1[7],P1[8],P1[9],     pw2[2]=PKW(P1,4), pw2[3]=PKW(P1,6), pw2); \
    VRD(3); SBAR(); GAPA(C0=__builtin_amdgcn_mfma_f32_32x32x16_bf16(kf[6],qr[3],C0,0,0,0),   P1[10],P1[11],P1[12],P1[13], pw3[0]=PKW(P1,8), pw3[1]=PKW(P1,10), pw3); \
    VRD(7); SBAR(); GAPA(C1=__builtin_amdgcn_mfma_f32_32x32x16_bf16(kf[7],qr[3],C1,0,0,0),   P1[14],P1[15],0.f,0.f,       pw3[2]=PKW(P1,12),pw3[3]=PKW(P1,14), pw3); \
    l_reg+=sacc; \
    if(GK){DMA_K((t)+3,sl_cur);} if(GV){DMA_V((t)+1,sl_next);} \
    BIAS(C0,C1,t); CMASK(C0,C1,t); \
    { float a=MX3(C0[0],C0[1],C1[0]),b=MX3(C0[2],C0[3],C1[1]); a=MX3(a,C1[2],C1[3]); \
      _Pragma("unroll") for(int r=4;r<16;r+=4){a=MX3(a,C0[r],C0[r+1]);b=MX3(b,C0[r+2],C0[r+3]);a=MX3(a,C1[r],C1[r+1]);b=MX3(b,C1[r+2],C1[r+3]);} \
      float rm=__builtin_fmaxf(a,b); { auto rr=__builtin_amdgcn_permlane32_swap(__float_as_uint(rm),__float_as_uint(rm),false,false); rm=__builtin_fmaxf(__uint_as_float(rr[0]),__uint_as_float(rr[1])); } \
      resc=false; \
      if(__builtin_expect(__any(rm>(float)THRL),0)){ const float dl=__builtin_fmaxf(rm,0.f); mhat+=dl; \
        _Pragma("unroll") for(int r=0;r<16;++r){C0[r]-=dl;C1[r]-=dl;} \
        const float f=__builtin_amdgcn_exp2f(-dl); l_reg*=f; if(hi==0)wsf[r32]=f; resc=true; } } \
    SBAR(); \
    GAPB(o[0]=__builtin_amdgcn_mfma_f32_32x32x16_bf16(PAF(0),VFR(0),o[0],0,0,0), C0,0); \
    GAPB(o[1]=__builtin_amdgcn_mfma_f32_32x32x16_bf16(PAF(0),VFR(4),o[1],0,0,0), C0,4); \
    KRD(GL,0); GAPB(o[0]=__builtin_amdgcn_mfma_f32_32x32x16_bf16(PAF(1),VFR(1),o[0],0,0,0), C0,8); \
    KRD(GL,1); GAPB(o[1]=__builtin_amdgcn_mfma_f32_32x32x16_bf16(PAF(1),VFR(5),o[1],0,0,0), C0,12); \
    KRD(GL,2); GAPB(o[0]=__builtin_amdgcn_mfma_f32_32x32x16_bf16(PAF(2),VFR(2),o[0],0,0,0), C1,0); \
    KRD(GL,3); GAPB(o[1]=__builtin_amdgcn_mfma_f32_32x32x16_bf16(PAF(2),VFR(6),o[1],0,0,0), C1,4); \
    GAPB(o[0]=__builtin_amdgcn_mfma_f32_32x32x16_bf16(PAF(3),VFR(3),o[0],0,0,0), C1,8); \
    GAPB(o[1]=__builtin_amdgcn_mfma_f32_32x32x16_bf16(PAF(3),VFR(7),o[1],0,0,0), C1,12); \
    }while(0)
  int t=1;
  #undef CMASK
  #define CMASK(P0,P1,t) do{}while(0)
  for(;t+5<NT;t+=2){
    STEP(pB0,pB1,pA0,pA1,t,true,true,true);     WAIT_BAR(2); RESC(); ROT();
    STEP(pA0,pA1,pB0,pB1,t+1,true,true,true);   WAIT_BAR(2); RESC(); ROT();
  }
  #undef CMASK
  #define CMASK(P0,P1,t) do{int jb_=(t)-(NT-4); if(jb_>=0)cmask(P0,P1,jb_,qrel,hi);}while(0)
  #define ENDW(tt) do{ if((tt)+3<NT){WAIT_BAR(2);} else if((tt)+2<NT){WAIT_BAR(1);} else {WAIT_BAR(0);} }while(0)
  for(;t+1<NT;t+=2){
    STEP(pB0,pB1,pA0,pA1,t,(t+3<NT),(t+1<NT),(t+1<NT));       ENDW(t);   RESC(); ROT();
    STEP(pA0,pA1,pB0,pB1,t+1,(t+4<NT),(t+2<NT),(t+2<NT));     ENDW(t+1); RESC(); ROT();
  }
  STEP(pB0,pB1,pA0,pA1,NT-1,false,false,false); RESC();
  { float sacc=pB0[0]+pB0[1]; _Pragma("unroll") for(int r=2;r<16;++r)sacc+=pB0[r]; _Pragma("unroll") for(int r=0;r<16;++r)sacc+=pB1[r]; l_reg+=sacc;
    pw0=(u32x4){PKW(pB0,0),PKW(pB0,2),PKW(pB0,4),PKW(pB0,6)};pw1=(u32x4){PKW(pB0,8),PKW(pB0,10),PKW(pB0,12),PKW(pB0,14)};pw2=(u32x4){PKW(pB1,0),PKW(pB1,2),PKW(pB1,4),PKW(pB1,6)};pw3=(u32x4){PKW(pB1,8),PKW(pB1,10),PKW(pB1,12),PKW(pB1,14)};
    SBAR(); pv(o,vb0+sl_cur,PAF(0),PAF(1),PAF(2),PAF(3)); }
  #undef PKW
  #undef PAF
  #undef VFR
  #undef PIN
  #undef MX3
  #undef GAPA
  #undef GAPB
  #undef EX
  #undef VRD
  #undef KRD
  #undef STEP
  #undef ENDW
  {auto rr=__builtin_amdgcn_permlane32_swap(__float_as_uint(l_reg),__float_as_uint(l_reg),false,false);l_reg=__uint_as_float(rr[0])+__uint_as_float(rr[1]);}
  if(hi==0)wsf[32+r32]=l_reg;asm volatile("s_waitcnt lgkmcnt(0)":::"memory");
  float rli[16];
  #pragma unroll
  for(int r=0;r<16;++r)rli[r]=__builtin_amdgcn_rcpf(wsf[32+crow(r,hi)]);
  int lane_e=lane; asm volatile("":"+v"(lane_e));
  bf16*Ow=O+(rowbase+q0+wid*QBLK)*OPITCH+OCOL+h*D; float*sw=ssp+(rowbase+q0+wid*QBLK)*8+h;
  { bf16*stg=(bf16*)(shm+LDS_OST)+wid*2048;
    #pragma unroll
    for(int r=0;r<16;++r){const int orow=crow(r,hi);
      #pragma unroll
      for(int d0=0;d0<2;++d0)stg[orow*64+d0*32+r32]=__float2bfloat16(o[d0][r]*rli[r]);}
    asm volatile("s_waitcnt lgkmcnt(0)":::"memory");
    #pragma unroll
    for(int i=0;i<4;++i){const int row=i*8+(lane_e>>3),ch=lane_e&7; const u32x4 v=*(const u32x4*)(stg+row*64+ch*8); ATTN_STORE16(Ow+(long)row*OPITCH+ch*8,v);
      float sq=0.f;
      #pragma unroll
      for(int k=0;k<4;++k){const float a=__uint_as_float(v[k]<<16),c=__uint_as_float(v[k]&0xffff0000u);sq+=a*a+c*c;}
      sq+=__shfl_xor(sq,1);sq+=__shfl_xor(sq,2);sq+=__shfl_xor(sq,4);
      if(ch==0)sw[(long)row*8]=sq; } }
  asm volatile("s_waitcnt lgkmcnt(0)\n\ts_barrier":::"memory");
  #undef DMA_K
  #undef DMA_V
  #undef CMASK
  #undef START
  #undef RESC
  #undef BIAS
  #undef ROT
}
constexpr int ATTN_LDS_BYTES=LDS_BYTES;
template<int THRL=8> __device__ __forceinline__ void attn_phase(char*lds,const bf16*Q,const bf16*K,const bf16*V,const float*cum2,bf16*O,float*ssp,unsigned*ctr,volatile __attribute__((address_space(3))) unsigned*slot,int tid){
  for(;;){
    if(tid==0)*slot=__hip_atomic_fetch_add(ctr,1u,__ATOMIC_RELAXED,__HIP_MEMORY_SCOPE_AGENT);
    __syncthreads();
    const int u=(int)*slot;
    __syncthreads();
    if(u>=BATCH*NHEAD*NQB)break;
    const int qb=NQB-1-(u>>6),h=NHEAD-1-((u>>3)&7),b=u&7;
    attn_unit<THRL>(b,h,qb,Q,K,V,cum2,O,ssp,lds,tid);
  }
}
#undef SBAR
#undef WAIT_BAR
}
namespace nv {
typedef float f32x2v __attribute__((ext_vector_type(2)));
constexpr size_t WS_APOW = 921 * MiB;
constexpr size_t WS_BBAR = 89 * MiB;
constexpr int KDW = 128 * 256;
__device__ __forceinline__ void p0_ssm_a(const float* __restrict__ lam_re, const float* __restrict__ lam_im, const float* __restrict__ log_dt, const float* __restrict__ b_re, const float* __restrict__ b_im,
                                         f32x2v* __restrict__ apow, f32x2v* __restrict__ bbar) {
    PH_IDS
    for (int i = BIDX * 512 + TIDX; i < DEPTH * G * P; i += GDIM * 512) {
        const int lg = i / P, p = i % P;
        const float dtf = expf(log_dt[lg]); const float lr = lam_re[i], li = lam_im[i];
        const double ang = (double)li * (double)dtf, k2 = rint(ang * 0.15915494309189535), red = ang - k2 * 6.283185307179586;
        const float mag = expf(lr * dtf), rr = (float)red; const double are = (double)(mag * cosf(rr)), aim = (double)(mag * sinf(rr));
        double pr = 1.0, pi = 0.0;
        for (int d = 0; d <= 64; ++d) { apow[((size_t)lg * 65 + d) * P + p] = (f32x2v){(float)pr, (float)pi}; const double nr_ = pr * are - pi * aim, ni_ = pr * aim + pi * are; pr = nr_; pi = ni_; }
        const double lrd = lr, lid = li, den = lrd * lrd + lid * lid, nr = are - 1.0, zre = (nr * lrd + aim * lid) / den, zim = (aim * lrd - nr * lid) / den;
        for (int h = 0; h < HC; ++h) { const double br = b_re[(size_t)i * HC + h], bi = b_im[(size_t)i * HC + h]; bbar[(size_t)i * HC + h] = (f32x2v){(float)(zre * br - zim * bi), (float)(zre * bi + zim * br)}; }
    }
}
__device__ __forceinline__ void p0_ssm_b(const f32x2v* __restrict__ apow, const f32x2v* __restrict__ bbar, const float* __restrict__ c_re, const float* __restrict__ c_im, const float* __restrict__ dsk,
                                         bf16_t* __restrict__ KD, bf16_t* __restrict__ WST, bf16_t* __restrict__ WOUT) {
    PH_IDS
    const int gt = BIDX * 512 + TIDX, nth = GDIM * 512;
    for (int i = gt; i < DEPTH * G * KDW; i += nth) {
        const int lg = i / KDW, r = i % KDW, dd = r >> 8, h = (r >> 4) & 15, h2 = r & 15, d = dd - 63;
        float v = 0.f;
        if (d >= 0 && dd < 127) {
            const f32x2v* ap = apow + ((size_t)lg * 65 + d) * P; const f32x2v* bb = bbar + (size_t)lg * P * HC + h2; const float* cr = c_re + ((size_t)lg * HC + h) * P; const float* ci = c_im + ((size_t)lg * HC + h) * P;
            for (int p = 0; p < P; ++p) { const f32x2v a = ap[p], b = bb[(size_t)p * HC]; const float wr = a.x * b.x - a.y * b.y, wi = a.x * b.y + a.y * b.x; v += cr[p] * wr - ci[p] * wi; }
            if (d == 0 && h == h2) v += dsk[lg * HC + h];
        }
        KD[i] = f2bf(v);
    }
    for (int i = gt; i < DEPTH * G * 128 * 256; i += nth) {
        const int lg = i >> 15, r = i & 32767, row = r >> 8, k = r & 255, j = k >> 4, h2 = k & 15, p = row & 63;
        const f32x2v a = apow[((size_t)lg * 65 + (15 - j)) * P + p], b = bbar[((size_t)lg * P + p) * HC + h2];
        WST[i] = f2bf(row < 64 ? a.x * b.x - a.y * b.y : a.x * b.y + a.y * b.x);
    }
    for (int i = gt; i < DEPTH * G * 1024 * 128; i += nth) {
        const int lg = i >> 17, r = i & 131071, row = r >> 7, k = r & 127, ti = row >> 4, h = row & 15, p = k & 63;
        const f32x2v e = apow[((size_t)lg * 65 + ti + 1) * P + p]; const float cr = c_re[((size_t)lg * HC + h) * P + p], ci = c_im[((size_t)lg * HC + h) * P + p];
        WOUT[i] = f2bf(k < 64 ? cr * e.x - ci * e.y : -(cr * e.y + ci * e.x));
    }
}

struct SchedSsmS {
    static constexpr bool DUALB = false; long hA, hB, hB1;
    const char* UP; const char* WST; int G_, c;
    __device__ __forceinline__ void init(const void* up, const void* wst_l, int grid, int bid) { UP = (const char*)up; WST = (const char*)wst_l; G_ = grid; c = bid; hA = 128l * UPW * 2; hB = 0; hB1 = 0; }
    __device__ __forceinline__ bool next(int i, ge::Unit& u) const {
        const int L = i * G_ + c; if (L >= G * 2 * 4) return false;
        const int g = L >> 3, pm = (L >> 2) & 1, ks = L & 3;
        u.A0 = UP + (((size_t)g * NCH + pm * 256) * UPW + 128 + ks * 256) * 2; u.B0 = WST + (size_t)g * 128 * 256 * 2; u.nt = 4; u.pm = pm; u.pn = ks; u.aux = g; return true; }
    __device__ __forceinline__ const char* ta(const ge::Unit& u, int t) const { return u.A0 + t * 128; }
    __device__ __forceinline__ const char* tb(const ge::Unit& u, int t) const { return u.B0 + t * 128; }
    __device__ __forceinline__ bool sb(const ge::Unit&, int) const { return false; }
    __device__ __forceinline__ unsigned voffA(int R, int C) const { return (unsigned)(R * UPW * 2 + C * 2); }
    __device__ __forceinline__ unsigned voffB(int Rb, int C) const { return (unsigned)(Rb * 512 + C * 2); }
    __device__ __forceinline__ unsigned voffB1(int, int) const { return 0u; }
};
struct EpiSsmS {
    static constexpr bool PERM = false, MIDK = false, UBEGIN = false;
    float* SLOC;
    __device__ __forceinline__ void unit_begin(const ge::Unit&, int, LAS unsigned char*) const {}
    __device__ __forceinline__ void midk(ge::f32x4 (&)[2][2][4][2], const ge::Unit&, int, int, LAS unsigned char*) const {}
    __device__ __forceinline__ void operator()(const ge::f32x4 (&acc)[2][2][4][2], const ge::Unit& u, int wr, int wc, int fr, int fq, LAS unsigned char*) const {
        const int g = u.aux, ks = u.pn;
#pragma unroll
        for (int ai = 0; ai < 2; ++ai)
#pragma unroll
            for (int m = 0; m < 4; ++m) {
                const int chunk = u.pm * 256 + ai * 128 + wr * 64 + m * 16 + fr; float* dst = SLOC + ((size_t)g * (NCH * 4) + chunk * 4 + ks) * 128;
#pragma unroll
                for (int n = 0; n < 2; ++n) *(ge::f32x4*)(dst + wc * 32 + 16 * n + 4 * fq) = acc[ai][0][m][n];
            }
    }
};

__device__ __forceinline__ void ph_ssm_prefix(LAS unsigned char* lds, const float* __restrict__ SLOC, const f32x2v* __restrict__ apow_l, bf16_t* __restrict__ UP) {
    PH_IDS
    const int p = TIDX & 63, w = __builtin_amdgcn_readfirstlane(TIDX >> 6);
    LAS f32x2v* ex = (LAS f32x2v*)lds;
    for (int item = BIDX; item < BATCH * G; item += GDIM) {
        const int b = item / G, g = item % G;
        const f32x2v a16 = apow_l[((size_t)g * 65 + 16) * P + p];
        const float* src = SLOC + ((size_t)g * (NCH * 4) + (size_t)b * 256 + 32 * w) * 128 + p; bf16_t* dst = UP + ((size_t)g * NCH + b * 64 + 8 * w) * UPW + p;
        float xr[32], xi[32];
#pragma unroll
        for (int k = 0; k < 32; ++k) { xr[k] = src[(size_t)k * 128]; xi[k] = src[(size_t)k * 128 + 64]; }
        float sr = 0.f, si = 0.f;
#pragma unroll
        for (int k = 0; k < 32; ++k) { const float nr = a16.x * sr - a16.y * si + xr[k], ni = a16.x * si + a16.y * sr + xi[k]; sr = nr; si = ni; }
        ex[w * 64 + p] = (f32x2v){sr, si};
        float qr = a16.x, qi = a16.y;
#pragma unroll
        for (int k = 0; k < 5; ++k) { const float nr = qr * qr - qi * qi, ni = 2.f * qr * qi; qr = nr; qi = ni; }
        __syncthreads();
        sr = 0.f; si = 0.f;
        for (int j = 0; j < w; ++j) { const f32x2v e = ex[j * 64 + p]; const float nr = qr * sr - qi * si + e.x, ni = qr * si + qi * sr + e.y; sr = nr; si = ni; }
#pragma unroll
        for (int k = 0; k < 32; ++k) {
            if ((k & 3) == 0) { bf16_t* d = dst + (size_t)(k >> 2) * UPW; d[0] = f2bf(sr); d[64] = f2bf(si); }
            const float nr = a16.x * sr - a16.y * si + xr[k], ni = a16.x * si + a16.y * sr + xi[k]; sr = nr; si = ni;
        }
        __syncthreads();
    }
}
__device__ __forceinline__ void ph_cum2(const float* __restrict__ logf, float* __restrict__ cum) {
    PH_IDS
    const int lane = TIDX & 63, gw = BIDX * 8 + __builtin_amdgcn_readfirstlane(TIDX >> 6), ngw = GDIM * 8;
    for (int item = gw; item < BATCH * NH; item += ngw) {
        const int b = item / NH, h = item % NH;
        const float* src = logf + ((size_t)b * SEQ + lane * 64) * NH + h; float* dst = cum + (size_t)item * SEQ + lane * 64;
        float tot = 0.f;
        for (int i = 0; i < 64; ++i) tot += src[(size_t)i * NH];
        float ex = tot;
#pragma unroll
        for (int o = 1; o < 64; o <<= 1) { const float y = __shfl_up(ex, o); if (lane >= o) ex += y; }
        float run = ex - tot;
        for (int i = 0; i < 64; ++i) { run += src[(size_t)i * NH]; dst[i] = run * 1.4426950408889634f; }
    }
}

struct SchedSsmC {
    static constexpr bool DUALB = true; long hA, hB, hB1;
    const char* UP; const char* WOUT; const char* KD; int G_, c;
    __device__ __forceinline__ void init(const void* up, const void* wout_l, const void* kd_l, int grid, int bid) { UP = (const char*)up; WOUT = (const char*)wout_l; KD = (const char*)kd_l; G_ = grid; c = bid; hA = 128l * UPW * 2; hB = 128l * 256; hB1 = 8l * 512; }
    __device__ __forceinline__ bool next(int i, ge::Unit& u) const {
        const int L = i * G_ + c; if (L >= G * 2 * 4) return false;
        const int pn = 3 - (L >> 6), g = (L & 63) >> 1, pm = L & 1;
        u.A0 = UP + ((size_t)g * NCH + pm * 256) * UPW * 2; u.B0 = nullptr; u.nt = 2 + 4 * (pn + 1); u.pm = pm; u.pn = pn; u.aux = g; return true; }
    __device__ __forceinline__ const char* ta(const ge::Unit& u, int t) const { return u.A0 + t * 128; }
    __device__ __forceinline__ bool sb(const ge::Unit&, int t) const { return t >= 2; }
    __device__ __forceinline__ const char* tb(const ge::Unit& u, int t) const {
        return t < 2 ? WOUT + ((size_t)u.aux * 1024 + u.pn * 256) * 256 + t * 128 : KD + ((size_t)u.aux * KDW + (size_t)(16 * u.pn - 4 * (t - 2) + 60) * 256) * 2; }
    __device__ __forceinline__ unsigned voffA(int R, int C) const { return (unsigned)(R * UPW * 2 + C * 2); }
    __device__ __forceinline__ unsigned voffB(int Rb, int C) const { return (unsigned)(Rb * 256 + C * 2); }
    __device__ __forceinline__ unsigned voffB1(int Rb, int C) const { return (unsigned)((((Rb >> 4) + 3 - (C >> 4)) * 256 + (Rb & 15) * 16 + (C & 15)) * 2); }
};
__device__ __forceinline__ float gelu_fast(float x) { const float u = 1.5957691216057308f * (x + 0.044715f * x * x * x); return x - x / (1.f + __expf(u)); }
struct EpiSsmC {
    static constexpr bool PERM = true, MIDK = false, UBEGIN = false;
    bf16_t* GEL;
    __device__ __forceinline__ void unit_begin(const ge::Unit&, int, LAS unsigned char*) const {}
    __device__ __forceinline__ void midk(ge::f32x4 (&)[2][2][4][2], const ge::Unit&, int, int, LAS unsigned char*) const {}
    __device__ __forceinline__ void operator()(const ge::f32x4 (&acc)[2][2][4][2], const ge::Unit& u, int wr, int wc, int fr, int fq, LAS unsigned char*) const {
        const int g = u.aux;
#pragma unroll
        for (int ai = 0; ai < 2; ++ai)
#pragma unroll
            for (int m = 0; m < 4; ++m) {
                const int chunk = u.pm * 256 + ai * 128 + wr * 64 + m * 16 + fr;
#pragma unroll
                for (int bj = 0; bj < 2; ++bj) {
                    const int col = u.pn * 256 + bj * 128 + wc * 32 + 8 * fq, ti = col >> 4, h0 = col & 15;
                    const ge::f32x4 v0 = acc[ai][bj][m][0], v1 = acc[ai][bj][m][1];
                    u32x4 w; w.x = ge::cvt_pk_bf16(gelu_fast(v0[0]), gelu_fast(v0[1])); w.y = ge::cvt_pk_bf16(gelu_fast(v0[2]), gelu_fast(v0[3]));
                    w.z = ge::cvt_pk_bf16(gelu_fast(v1[0]), gelu_fast(v1[1])); w.w = ge::cvt_pk_bf16(gelu_fast(v1[2]), gelu_fast(v1[3]));
                    *(u32x4*)(GEL + ((size_t)g * T + chunk * 64 + ti) * HC + h0) = w;
                }
            }
    }
};
}
namespace nv {
#define SEL_CE(x, y) do { const int _h = max((x), (y)), _l = min((x), (y)); (x) = _h; (y) = _l; } while (0)
__device__ __forceinline__ void sel_sort16(int (&v)[16]) {
    SEL_CE(v[0], v[1]);
    SEL_CE(v[2], v[3]);
    SEL_CE(v[0], v[2]);
    SEL_CE(v[1], v[3]);
    SEL_CE(v[1], v[2]);
    SEL_CE(v[4], v[5]);
    SEL_CE(v[6], v[7]);
    SEL_CE(v[4], v[6]);
    SEL_CE(v[5], v[7]);
    SEL_CE(v[5], v[6]);
    SEL_CE(v[0], v[4]);
    SEL_CE(v[2], v[6]);
    SEL_CE(v[2], v[4]);
    SEL_CE(v[1], v[5]);
    SEL_CE(v[3], v[7]);
    SEL_CE(v[3], v[5]);
    SEL_CE(v[1], v[2]);
    SEL_CE(v[3], v[4]);
    SEL_CE(v[5], v[6]);
    SEL_CE(v[8], v[9]);
    SEL_CE(v[10], v[11]);
    SEL_CE(v[8], v[10]);
    SEL_CE(v[9], v[11]);
    SEL_CE(v[9], v[10]);
    SEL_CE(v[12], v[13]);
    SEL_CE(v[14], v[15]);
    SEL_CE(v[12], v[14]);
    SEL_CE(v[13], v[15]);
    SEL_CE(v[13], v[14]);
    SEL_CE(v[8], v[12]);
    SEL_CE(v[10], v[14]);
    SEL_CE(v[10], v[12]);
    SEL_CE(v[9], v[13]);
    SEL_CE(v[11], v[15]);
    SEL_CE(v[11], v[13]);
    SEL_CE(v[9], v[10]);
    SEL_CE(v[11], v[12]);
    SEL_CE(v[13], v[14]);
    SEL_CE(v[0], v[8]);
    SEL_CE(v[4], v[12]);
    SEL_CE(v[4], v[8]);
    SEL_CE(v[2], v[10]);
    SEL_CE(v[6], v[14]);
    SEL_CE(v[6], v[10]);
    SEL_CE(v[2], v[4]);
    SEL_CE(v[6], v[8]);
    SEL_CE(v[10], v[12]);
    SEL_CE(v[1], v[9]);
    SEL_CE(v[5], v[13]);
    SEL_CE(v[5], v[9]);
    SEL_CE(v[3], v[11]);
    SEL_CE(v[7], v[15]);
    SEL_CE(v[7], v[11]);
    SEL_CE(v[3], v[5]);
    SEL_CE(v[7], v[9]);
    SEL_CE(v[11], v[13]);
    SEL_CE(v[1], v[2]);
    SEL_CE(v[3], v[4]);
    SEL_CE(v[5], v[6]);
    SEL_CE(v[7], v[8]);
    SEL_CE(v[9], v[10]);
    SEL_CE(v[11], v[12]);
    SEL_CE(v[13], v[14]);
}
__device__ __forceinline__ void sel_merge16(int (&a)[16], const int (&b)[16]) {
    a[0] = max(a[0], b[15]);
    a[1] = max(a[1], b[14]);
    a[2] = max(a[2], b[13]);
    a[3] = max(a[3], b[12]);
    a[4] = max(a[4], b[11]);
    a[5] = max(a[5], b[10]);
    a[6] = max(a[6], b[9]);
    a[7] = max(a[7], b[8]);
    a[8] = max(a[8], b[7]);
    a[9] = max(a[9], b[6]);
    a[10] = max(a[10], b[5]);
    a[11] = max(a[11], b[4]);
    a[12] = max(a[12], b[3]);
    a[13] = max(a[13], b[2]);
    a[14] = max(a[14], b[1]);
    a[15] = max(a[15], b[0]);
    SEL_CE(a[0], a[8]);
    SEL_CE(a[1], a[9]);
    SEL_CE(a[2], a[10]);
    SEL_CE(a[3], a[11]);
    SEL_CE(a[4], a[12]);
    SEL_CE(a[5], a[13]);
    SEL_CE(a[6], a[14]);
    SEL_CE(a[7], a[15]);
    SEL_CE(a[0], a[4]);
    SEL_CE(a[1], a[5]);
    SEL_CE(a[2], a[6]);
    SEL_CE(a[3], a[7]);
    SEL_CE(a[8], a[12]);
    SEL_CE(a[9], a[13]);
    SEL_CE(a[10], a[14]);
    SEL_CE(a[11], a[15]);
    SEL_CE(a[0], a[2]);
    SEL_CE(a[1], a[3]);
    SEL_CE(a[4], a[6]);
    SEL_CE(a[5], a[7]);
    SEL_CE(a[8], a[10]);
    SEL_CE(a[9], a[11]);
    SEL_CE(a[12], a[14]);
    SEL_CE(a[13], a[15]);
    SEL_CE(a[0], a[1]);
    SEL_CE(a[2], a[3]);
    SEL_CE(a[4], a[5]);
    SEL_CE(a[6], a[7]);
    SEL_CE(a[8], a[9]);
    SEL_CE(a[10], a[11]);
    SEL_CE(a[12], a[13]);
    SEL_CE(a[14], a[15]);
}
constexpr int SEL_NCAND = 50;
#define SEL_CANDS(F) \
    F(0, 0, 0) \
    F(1, 0, 1) \
    F(2, 0, 2) \
    F(3, 0, 3) \
    F(4, 0, 4) \
    F(5, 0, 5) \
    F(6, 0, 6) \
    F(7, 0, 7) \
    F(8, 0, 8) \
    F(9, 0, 9) \
    F(10, 0, 10) \
    F(11, 0, 11) \
    F(12, 0, 12) \
    F(13, 0, 13) \
    F(14, 0, 14) \
    F(15, 0, 15) \
    F(16, 1, 0) \
    F(17, 1, 1) \
    F(18, 1, 2) \
    F(19, 1, 3) \
    F(20, 1, 4) \
    F(21, 1, 5) \
    F(22, 1, 6) \
    F(23, 1, 7) \
    F(24, 2, 0) \
    F(25, 2, 1) \
    F(26, 2, 2) \
    F(27, 2, 3) \
    F(28, 2, 4) \
    F(29, 3, 0) \
    F(30, 3, 1) \
    F(31, 3, 2) \
    F(32, 3, 3) \
    F(33, 4, 0) \
    F(34, 4, 1) \
    F(35, 4, 2) \
    F(36, 5, 0) \
    F(37, 5, 1) \
    F(38, 6, 0) \
    F(39, 6, 1) \
    F(40, 7, 0) \
    F(41, 7, 1) \
    F(42, 8, 0) \
    F(43, 9, 0) \
    F(44, 10, 0) \
    F(45, 11, 0) \
    F(46, 12, 0) \
    F(47, 13, 0) \
    F(48, 14, 0) \
    F(49, 15, 0)
constexpr float SEL_BIAS = 16.f;
__device__ __forceinline__ int f2key(float f) { return __float_as_int(f); }
__device__ __forceinline__ float key2f(int k) { return __int_as_float(k); }
__device__ __forceinline__ void sel_top16(const f32x16 (&acc)[4], int hi, int (&t)[16]) {
    int g1[16], g2[16], g3[16];
#pragma unroll
    for (int r = 0; r < 16; ++r) { const int n = (r & 3) + 8 * (r >> 2) + 4 * hi;
        t[r] = (f2key(acc[0][r]) & ~0x7F) | n; g1[r] = (f2key(acc[1][r]) & ~0x7F) | (32 + n); g2[r] = (f2key(acc[2][r]) & ~0x7F) | (64 + n); g3[r] = (f2key(acc[3][r]) & ~0x7F) | (96 + n); }
    sel_sort16(t); sel_sort16(g1); sel_sort16(g2); sel_sort16(g3);
    sel_merge16(t, g1); sel_merge16(g2, g3); sel_merge16(t, g2);
#pragma unroll
    for (int i = 0; i < 16; ++i) { auto rr = __builtin_amdgcn_permlane32_swap((unsigned)t[i], (unsigned)t[i], false, false); g1[i] = (int)(hi ? rr[0] : rr[1]); }
    sel_merge16(t, g1);
}
__device__ __forceinline__ void ph_select(const bf16_t* __restrict__ QP, const bf16_t* __restrict__ KEYS, unsigned short* __restrict__ idx, float* __restrict__ gate, LAS unsigned char* lds) {
    PH_IDS
    const int lane = TIDX & 63, hd = __builtin_amdgcn_readfirstlane(TIDX >> 6), r = lane & 31, hi = lane >> 5;
    LAS unsigned* my = (LAS unsigned*)(lds + hd * 2048) + lane;
    for (int tg = BIDX; tg < T / 32; tg += GDIM) {
        const int tok0 = tg * 32;
        int rk = r; asm volatile("" : "+v"(rk));
        int t1[16], t2[16];
#pragma unroll
        for (int half = 0; half < 2; ++half) {
            f32x16 acc[4];
#pragma unroll
            for (int mt = 0; mt < 4; ++mt)
#pragma unroll
                for (int i = 0; i < 16; ++i) acc[mt][i] = SEL_BIAS;
            const bf16_t* qb = QP + (size_t)(tok0 + r) * D + hd * QD + half * HALF + 8 * hi;
            const bf16_t* kb = KEYS + ((size_t)(hd * 2 + half) * NK + rk) * HALF + 8 * hi;
#pragma unroll
            for (int ks = 0; ks < 4; ++ks) {
                const bf16x8 b = *(const bf16x8*)(qb + 16 * ks);
#pragma unroll
                for (int mt = 0; mt < 4; ++mt) { const bf16x8 a = *(const bf16x8*)(kb + (size_t)mt * 32 * HALF + 16 * ks); acc[mt] = __builtin_amdgcn_mfma_f32_32x32x16_bf16(a, b, acc[mt], 0, 0, 0); }
            }
            if (half == 0) sel_top16(acc, hi, t1); else sel_top16(acc, hi, t2);
        }
        float f1[16], f2[16];
#pragma unroll
        for (int i = 0; i < 16; ++i) { f1[i] = key2f(t1[i]); f2[i] = key2f(t2[i]); }
        int c0[16], c1[16], c2[16], c3[16];
#pragma unroll
        for (int i = 0; i < 16; ++i) c3[i] = (int)0x80000000;
#define SEL_F(k, i, j) { const int v_ = (f2key(f1[i] + f2[j]) & ~0xFF) | ((i) << 4 | (j)); if ((k) < 16) c0[(k) & 15] = v_; else if ((k) < 32) c1[(k) & 15] = v_; else if ((k) < 48) c2[(k) & 15] = v_; else c3[(k) & 15] = v_; }
        SEL_CANDS(SEL_F)
#undef SEL_F
          sel_sort16(c1); sel_sort16(c2); SEL_CE(c3[0], c3[1]);
        sel_merge16(c0, c1); sel_merge16(c2, c3); sel_merge16(c0, c2);
#pragma unroll
        for (int j = 0; j < 4; ++j) {
            my[64 * j] = (unsigned)(t1[4 * j] & 0x7F) | ((unsigned)(t1[4 * j + 1] & 0x7F) << 8) | ((unsigned)(t1[4 * j + 2] & 0x7F) << 16) | ((unsigned)(t1[4 * j + 3] & 0x7F) << 24);
            my[64 * (4 + j)] = (unsigned)(t2[4 * j] & 0x7F) | ((unsigned)(t2[4 * j + 1] & 0x7F) << 8) | ((unsigned)(t2[4 * j + 2] & 0x7F) << 16) | ((unsigned)(t2[4 * j + 3] & 0x7F) << 24);
        }
        const float mx = key2f(c0[0]); float e[16], se = 0.f;
#pragma unroll
        for (int k = 0; k < 16; ++k) { e[k] = __expf(key2f(c0[k]) - mx); se += e[k]; }
        const float inv = 1.f / se;
        asm volatile("s_waitcnt lgkmcnt(0)" ::: "memory");
        const size_t o = (size_t)(tok0 + r) * 128 + hd * TOPK;
        if (hi == 0) {
            int id[16];
#pragma unroll
            for (int k = 0; k < 16; ++k) { const int code = c0[k] & 0xFF, i = code >> 4, j = code & 15;
                const unsigned w1 = my[64 * (i >> 2)], w2 = my[64 * (4 + (j >> 2))];
                id[k] = (int)((w1 >> (8 * (i & 3))) & 0x7F) * NK + (int)((w2 >> (8 * (j & 3))) & 0x7F); }
            u32x4 w0, w1;
#pragma unroll
            for (int k = 0; k < 4; ++k) { w0[k] = (unsigned)id[2 * k] | ((unsigned)id[2 * k + 1] << 16); w1[k] = (unsigned)id[8 + 2 * k] | ((unsigned)id[9 + 2 * k] << 16); }
            *(u32x4*)(idx + o) = w0; *(u32x4*)(idx + o + 8) = w1;
        } else {
#pragma unroll
            for (int k = 0; k < 4; ++k) *(float4*)(gate + o + 4 * k) = make_float4(e[4 * k] * inv, e[4 * k + 1] * inv, e[4 * k + 2] * inv, e[4 * k + 3] * inv);
        }
        asm volatile("s_waitcnt lgkmcnt(0)" ::: "memory");
    }
}
}
#ifndef PROBE_MASK
#define PROBE_MASK 0
#endif
#define REPS(bit) (((PROBE_MASK >> (bit)) & 1) ? 2 : 1)
namespace nv {
constexpr int LDS_BYTES = 147456, MISC_OFF = 131072 + 320;
struct Params { const float* in[23]; float* out; unsigned char* ws; };

__global__ void __launch_bounds__(512, 2) k_mega(Params prm) {
    extern __shared__ __attribute__((aligned(16))) unsigned char lds_raw[];
    namespace cg = cooperative_groups;
    cg::grid_group grid = cg::this_grid();
    LAS unsigned char* lds = (LAS unsigned char*)lds_raw;
    unsigned char* smem = lds_raw;
    for (int u = threadIdx.x; u < (LDS_BYTES - 131072) / 4; u += 512) ((LAS unsigned*)(lds + 131072))[u] = 0u;
    __syncthreads();
    if (threadIdx.x == 0) {
        LAS unsigned long long* tab = (LAS unsigned long long*)(lds + TAB_OFF);
#pragma unroll
        for (int i = 0; i < 23; ++i) tab[i] = (unsigned long long)prm.in[i];
        tab[23] = (unsigned long long)prm.out; tab[24] = (unsigned long long)prm.ws;
    }
    __syncthreads();
#define ARG(i) ((const float*)ldarg(lds, (i)))
#define WSP() ((unsigned char*)ldarg(lds, 24))
    XcdBarrier bar = xcd_barrier_post((unsigned*)(WSP() + WS_CTL) + CW_BAR, (volatile LAS unsigned*)(lds + MISC_OFF) + 8);
#define GRID_BAR() do { xcd_barrier(bar); asm volatile("" ::: "memory"); } while (0)
    if (threadIdx.x == 0) { volatile LAS unsigned* M = (volatile LAS unsigned*)(lds + MISC_OFF); M[16] = bar.x; M[17] = xb_add((unsigned*)(WSP() + WS_CTL) + CW_RANK + 64 * bar.x, 1u); }
    for (int rep = 0; rep < REPS(0); ++rep) {
    for (int rep2 = 0; rep2 < REPS(25); ++rep2)
    p0_prologue(lds);
    for (int rep2 = 0; rep2 < REPS(24); ++rep2)
    { unsigned char* ws = WSP(); p0_peer_tables(ARG(20), ARG(21), ARG(17), ws + WS_PU, ws + WS_PV8); }
    { unsigned char* ws = WSP(); const float* pk = ARG(19); bf16_t* kb = (bf16_t*)(ws + WS_KEYS); for (int i = obid() * 512 + otid(); i < DEPTH * PH * 2 * NK * HALF; i += ogrid() * 512) kb[i] = f2bf(pk[i]); }
    { unsigned char* ws = WSP(); p0_ssm_a(ARG(3), ARG(4), ARG(5), ARG(6), ARG(7), (f32x2v*)(ws + WS_APOW), (f32x2v*)(ws + WS_BBAR)); }
    }
    GRID_BAR();
    if (threadIdx.x == 0) {
        volatile LAS unsigned* M = (volatile LAS unsigned*)(lds + MISC_OFF); unsigned* bw = (unsigned*)(WSP() + WS_CTL) + CW_BAR; unsigned tot = 0u, ok = 1u;
        for (unsigned j = 0; j < 16; ++j) { const unsigned cnt = xb_ld(&bw[XB_XCNT(j)]); tot += cnt; if ((j < 8) != (cnt > 0u)) ok = 0u; }
        M[18] = xb_ld(&bw[XB_XCNT(bar.x)]); M[19] = (ok && tot == gridDim.x) ? 1u : 0u;
    }
    __syncthreads();
    { unsigned char* ws = WSP(); p0_ssm_b((const f32x2v*)(ws + WS_APOW), (const f32x2v*)(ws + WS_BBAR), ARG(8), ARG(9), ARG(10), (bf16_t*)(ws + WS_KD), (bf16_t*)(ws + WS_WST), (bf16_t*)(ws + WS_WOUT)); }
    grid.sync();
#pragma nounroll
    for (int l_ = 0; l_ < DEPTH; ++l_) {
        int l = l_; asm volatile("" : "+s"(l));
        {
            unsigned char* ws = WSP(); bf16_t* hb = (bf16_t*)(ws + WS_HB); float* ss1 = (float*)(ws + WS_SSP) + (size_t)T * 32;
            for (int rep = 0; rep < REPS(1); ++rep) {
            SchedGen S; S.init_plain(hb, D * 2, (const bf16_t*)(ws + WS_BT1) + (size_t)l * 2048 * D, D * 2, T, 2048, D, ogrid(), obid());
            EpiInProj E{ss1, (bf16_t*)(ws + WS_UP), (bf16_t*)(ws + WS_Q)};
            ge::gemm_phase<EpiInProj, SchedGen>(lds, S, E, otid());
            }
            for (int rep = 0; rep < REPS(2); ++rep)
            ph_flogit(hb, (const bf16_t*)(ws + WS_WF) + (size_t)l * 16 * D, ss1, ARG(13) + l * NH, (float*)(ws + WS_LOGF));
        }
        GRID_BAR();
        {
            unsigned char* ws = WSP();
            for (int rep = 0; rep < REPS(3); ++rep) {
            SchedSsmS S; S.init(ws + WS_UP, (const bf16_t*)(ws + WS_WST) + (size_t)l * G * 128 * 256, ogrid(), obid());
            EpiSsmS E{(float*)(ws + WS_SLOC)};
            ge::gemm_phase<EpiSsmS, SchedSsmS>(lds, S, E, otid());
            }
            for (int rep = 0; rep < REPS(4); ++rep)
            ph_cum2((const float*)(ws + WS_LOGF), (float*)(ws + WS_CUM));
        }
        GRID_BAR();
        for (int rep = 0; rep < REPS(5); ++rep)
        { unsigned char* ws = WSP(); ph_ssm_prefix(lds, (const float*)(ws + WS_SLOC), (const f32x2v*)(ws + WS_APOW) + (size_t)l * G * 65 * P, (bf16_t*)(ws + WS_UP)); }
        GRID_BAR();
        {
            unsigned char* ws = WSP(); float* ssp_s = (float*)(ws + WS_SSP); float* ssp_a = ssp_s + (size_t)T * 8;
            for (int rep = 0; rep < REPS(6); ++rep)
            {
                SchedSsmC S; S.init(ws + WS_UP, (const bf16_t*)(ws + WS_WOUT) + (size_t)l * G * 1024 * 128, (const bf16_t*)(ws + WS_KD) + (size_t)l * G * KDW, ogrid(), obid());
                EpiSsmC E{(bf16_t*)(ws + WS_GEL)};
                ge::gemm_phase<EpiSsmC, SchedSsmC>(lds, S, E, otid());
            }
            for (int rep = 0; rep < REPS(7); ++rep)
            attn_body::attn_phase<8>((char*)lds_raw, (const attn_body::bf16*)(ws + WS_Q), (const attn_body::bf16*)(ws + WS_K), (const attn_body::bf16*)(ws + WS_V), (const float*)(ws + WS_CUM), (attn_body::bf16*)(ws + WS_MIX), ssp_a, (unsigned*)(ws + WS_CTL) + CW_QUEUE + 64 * (l * 2 + rep), (volatile LAS unsigned*)(lds + MISC_OFF) + 24, otid());
            GRID_BAR();
            for (int rep = 0; rep < REPS(8); ++rep) {
            SchedGen S; S.init_plain(ws + WS_GEL, 32, (const bf16_t*)(ws + WS_BT2) + (size_t)l * SSMW * SSMW, SSMW * 2, T, SSMW, SSMW, ogrid(), obid());
            S.a_c16_b = T * 32; S.a_kt_b = 4l * T * 32;
            EpiGlu2 E{(const bf16_t*)(ws + WS_GEL), ARG(12) + l * SSMW, (bf16_t*)(ws + WS_MIX), ssp_s};
            ge::gemm_phase<EpiGlu2, SchedGen>(lds, S, E, otid());
            }
        }
        GRID_BAR();
        {
            unsigned char* ws = WSP(); float* ssp_s = (float*)(ws + WS_SSP); float* ssp_a = ssp_s + (size_t)T * 8; float* ssp_2 = ssp_a + (size_t)T * 8;
            for (int rep = 0; rep < REPS(9); ++rep) {
            const bool dummy = rep + 1 < REPS(9);
            SchedGen S; S.init_plain(ws + WS_MIX, D * 2, (const bf16_t*)(ws + WS_BT3) + (size_t)l * D * D, D * 2, T, D, D, ogrid(), obid());
            EpiWo E{ssp_s, ssp_a, (const bf16_t*)(ws + WS_HB), dummy ? (bf16_t*)(ws + WS_QP) : (bf16_t*)(ws + WS_HB), dummy ? (float*)(ws + WS_SLOC) : ssp_2};
            ge::gemm_phase<EpiWo, SchedGen>(lds, S, E, otid());
            }
        }
        GRID_BAR();
        {
            unsigned char* ws = WSP(); float* ssp_2 = (float*)(ws + WS_SSP) + (size_t)T * 16;
            for (int rep = 0; rep < REPS(10); ++rep) {
            SchedGen S; S.init_plain(ws + WS_HB, D * 2, (const bf16_t*)(ws + WS_BT4) + (size_t)l * D * D, D * 2, T, D, D, ogrid(), obid());
            EpiWq E{ssp_2, (bf16_t*)(ws + WS_QP)};
            ge::gemm_phase<EpiWq, SchedGen>(lds, S, E, otid());
            }
        }
        GRID_BAR();
        for (int rep = 0; rep < REPS(11); ++rep)
        { unsigned char* ws = WSP(); ph_select((const bf16_t*)(ws + WS_QP), (const bf16_t*)(ws + WS_KEYS) + (size_t)l * PH * 2 * NK * HALF, (unsigned short*)(ws + WS_IDX), (float*)(ws + WS_GATE), lds); }
        GRID_BAR();
        if (PROBE_MASK & (1 << 18)) { unsigned char* ws = WSP(); ph_peer_u<2>(lds, ws + WS_PU + (size_t)l * NEXP * D, (const bf16_t*)(ws + WS_HB), (const unsigned short*)(ws + WS_IDX), (bf16_t*)(ws + WS_UP)); }
        if (PROBE_MASK & (1 << 20)) { unsigned char* ws = WSP(); ph_peer_u<2, 5>(lds, ws + WS_PU + (size_t)l * NEXP * D, (const bf16_t*)(ws + WS_HB), (const unsigned short*)(ws + WS_IDX), (bf16_t*)(ws + WS_UP)); }
        if (PROBE_MASK & (1 << 19)) { unsigned char* ws = WSP(); ph_peer_u<3>(lds, ws + WS_PU + (size_t)l * NEXP * D, (const bf16_t*)(ws + WS_HB), (const unsigned short*)(ws + WS_IDX), (bf16_t*)(ws + WS_UP)); }
        if (PROBE_MASK & (1 << 16)) { unsigned char* ws = WSP(); ph_peer_u<0>(lds, ws + WS_PU + (size_t)l * NEXP * D, (const bf16_t*)(ws + WS_HB), (const unsigned short*)(ws + WS_IDX), (bf16_t*)(ws + WS_UP), 1023); }
        for (int rep = 0; rep < REPS(12); ++rep)
        { unsigned char* ws = WSP(); ph_peer_u<0>(lds, ws + WS_PU + (size_t)l * NEXP * D, (const bf16_t*)(ws + WS_HB), (const unsigned short*)(ws + WS_IDX), (bf16_t*)(ws + WS_PART)); }
        GRID_BAR();
        for (int rep = 0; rep < REPS(13); ++rep)
        { unsigned char* ws = WSP(); ph_peer_coef((const bf16_t*)(ws + WS_PART), (const float*)(ws + WS_SSP) + (size_t)T * 16, (const float*)(ws + WS_GATE), (unsigned short*)(ws + WS_COEF)); }
        GRID_BAR();
        if (PROBE_MASK & (1 << 17)) { unsigned char* ws = WSP();
          ph_peer_v<0>(lds, ws + WS_PV8 + (size_t)l * NEXP * D, (const unsigned short*)(ws + WS_IDX), (const unsigned short*)(ws + WS_COEF), (const bf16_t*)(ws + WS_HB), (bf16_t*)(ws + WS_UP), (float*)(ws + WS_SLOC), 1023); }
        for (int rep = 0; rep < REPS(14); ++rep)
        { unsigned char* ws = WSP(); const bool dummy = rep + 1 < REPS(14);
          ph_peer_v<0>(lds, ws + WS_PV8 + (size_t)l * NEXP * D, (const unsigned short*)(ws + WS_IDX), (const unsigned short*)(ws + WS_COEF), (const bf16_t*)(ws + WS_HB),
                    dummy ? (bf16_t*)(ws + WS_UP) : (bf16_t*)(ws + WS_HB), dummy ? (float*)(ws + WS_SLOC) : (float*)(ws + WS_SSP) + (size_t)T * 32); }
        if (PROBE_MASK & (1 << 15)) { for (int rep = 0; rep < 8; ++rep) GRID_BAR(); }
        GRID_BAR();
    }
    { unsigned char* ws = WSP(); ph_final((const bf16_t*)(ws + WS_HB), (const float*)(ws + WS_SSP) + (size_t)T * 32, ARG(22), (float*)ldarg(lds, 23)); }
}
}

extern "C" void kernel_launch(void* const* d_in, const int* in_sizes, int n_in, void* d_out, int out_size, void* d_ws, size_t ws_size, hipStream_t stream) {
    using namespace nv;
    static int grid_blocks = 0;
    if (!grid_blocks) {
        int dev = 0, cus = 0, per_cu = 0;
        (void)hipGetDevice(&dev);
        (void)hipDeviceGetAttribute(&cus, hipDeviceAttributeMultiprocessorCount, dev);
        if (hipFuncSetAttribute((const void*)k_mega, hipFuncAttributeMaxDynamicSharedMemorySize, LDS_BYTES) != hipSuccess) { fprintf(stderr, "hipFuncSetAttribute failed\n"); grid_blocks = -1; return; }
        (void)hipOccupancyMaxActiveBlocksPerMultiprocessor(&per_cu, (const void*)k_mega, 512, LDS_BYTES);
        if (per_cu < 1) { fprintf(stderr, "occupancy query returned %d\n", per_cu); (void)hipGetLastError(); }
        grid_blocks = cus;
    }
    if (grid_blocks < 0) return;
    if (ws_size < WS_END || n_in != 23) { fprintf(stderr, "bad workspace / inputs\n"); return; }
    (void)hipMemsetAsync((char*)d_ws + WS_CTL, 0, CTL_BYTES, stream);
    Params p{};
    for (int i = 0; i < 23; ++i) p.in[i] = (const float*)d_in[i];
    p.out = (float*)d_out; p.ws = (unsigned char*)d_ws;
    void* args[] = {&p};
    hipError_t e = hipLaunchCooperativeKernel((const void*)k_mega, dim3(grid_blocks), dim3(512), args, LDS_BYTES, stream);
    if (e != hipSuccess) fprintf(stderr, "cooperative launch failed: %s (grid %d)\n", hipGetErrorString(e), grid_blocks);
}
```

```cpp
#include <hip/hip_runtime.h>
#include <hip/hip_cooperative_groups.h>
#include <hip/hip_bf16.h>
#include <cstdint>
#include <cstdio>

#define LAS __attribute__((address_space(3)))
#define GAS __attribute__((address_space(1)))

namespace nv {
constexpr int D = 1024, BATCH = 8, SEQ = 4096, DEPTH = 4, T = BATCH * SEQ;
constexpr int SSMW = 512, G = 32, HC = 16, P = 64, ATTW = 512, HD = 64, NH = 8, INW = 2056;
constexpr int PH = 8, NK = 128, TOPK = 16, QD = 128, HALF = 64, NEXP = 16384;
constexpr int CHUNK = 64, NCH = T / CHUNK  , UPW = 128 + CHUNK * HC  ;
constexpr float EPS = 1e-6f;

typedef short bf16x8 __attribute__((ext_vector_type(8)));
typedef float f32x16 __attribute__((ext_vector_type(16)));
typedef float f32x4 __attribute__((ext_vector_type(4)));
typedef unsigned u32x4 __attribute__((ext_vector_type(4)));
typedef unsigned short bf16_t;

constexpr size_t MiB = 1u << 20;
constexpr size_t WS_CTL = 0, CTL_BYTES = 4 * MiB;
constexpr size_t WS_BT1 = 4 * MiB;
constexpr size_t WS_BT2 = 20 * MiB;
constexpr size_t WS_BT3 = 22 * MiB;
constexpr size_t WS_BT4 = 30 * MiB;
constexpr size_t WS_WF = 38 * MiB;
constexpr size_t WS_KEYS = 39 * MiB;
constexpr size_t WS_KD = 40 * MiB, WS_WOUT = 49 * MiB, WS_WST = 81 * MiB;
constexpr size_t WS_PU = 90 * MiB, WS_PV8 = 154 * MiB;
constexpr size_t WS_PART = 218 * MiB;
constexpr size_t WS_H = 346 * MiB;
constexpr size_t WS_HB = 474 * MiB;
constexpr size_t WS_UP = 538 * MiB;
constexpr size_t WS_Q = 576 * MiB, WS_K = 608 * MiB, WS_V = 640 * MiB;
constexpr size_t WS_LOGF = 672 * MiB, WS_CUM = 673 * MiB;
constexpr size_t WS_SLOC = 674 * MiB, WS_GEL = 708 * MiB, WS_MIX = 740 * MiB;
constexpr size_t WS_SSP = 916 * MiB;
constexpr size_t WS_QP = 852 * MiB;
constexpr size_t WS_IDX = 804 * MiB, WS_GATE = 820 * MiB, WS_COEF = 836 * MiB;
constexpr size_t WS_XN_F = 90 * MiB, WS_MIXED_F = 218 * MiB, WS_QP_F = 852 * MiB, WS_GEL_F = 90 * MiB  , WS_YSSM_F = 740 * MiB, WS_YATT_F = 674 * MiB;
constexpr size_t WS_US = 980 * MiB;
constexpr size_t WS_END = 981 * MiB;
constexpr int CW_QUEUE = 1024;
constexpr int CW_RANK = 2048;
constexpr int CW_BAR = 4096;
constexpr int CW_SS = 65536;
constexpr int SS_H1 = 0  , SS_H2 = 5  , SS_SSM = 9, SS_ATT = 13;
static_assert((size_t)(CW_SS + 17 * T) * 4 <= CTL_BYTES, "ctl region");

__device__ __forceinline__ unsigned short f2bf(float f) { unsigned u = __float_as_uint(f); return (unsigned short)((u + 0x7fffu + ((u >> 16) & 1u)) >> 16); }
__device__ __forceinline__ float bf2f(unsigned short b) { return __uint_as_float(((unsigned)b) << 16); }
__device__ __forceinline__ unsigned pk2(float lo, float hi) { return (unsigned)f2bf(lo) | ((unsigned)f2bf(hi) << 16); }
__device__ __forceinline__ float gelu_tanh(float x) { const float u = 0.7978845608028654f * (x + 0.044715f * x * x * x); return 0.5f * x * (1.f + tanhf(u)); }
__device__ __forceinline__ float wave_sum(float v) {
#pragma unroll
    for (int o = 1; o < 64; o <<= 1) v += __shfl_xor(v, o);
    return v;
}
__device__ __forceinline__ int otid() { int t = threadIdx.x; asm volatile("" : "+v"(t)); return t; }
__device__ __forceinline__ int obid() { int t = blockIdx.x; asm volatile("" : "+s"(t)); return t; }
__device__ __forceinline__ int ogrid() { int t = gridDim.x; asm volatile("" : "+s"(t)); return t; }
#define PH_IDS const int TIDX = otid(), BIDX = obid(), GDIM = ogrid(); (void)TIDX; (void)BIDX; (void)GDIM;
__device__ __forceinline__ size_t up_index(int row, int c) { const int n = row >> 6, j = row & 63, g = c >> 4, hh = c & 15; return ((size_t)g * NCH + n) * UPW + 128 + j * HC + hh; }
}
namespace ge {
#define GE_LAS __attribute__((address_space(3)))
typedef unsigned short bf16_t;
typedef short bf16x8 __attribute__((ext_vector_type(8)));
typedef float f32x4 __attribute__((ext_vector_type(4)));
typedef unsigned u32x4 __attribute__((ext_vector_type(4)));
typedef unsigned u32x2 __attribute__((ext_vector_type(2)));
constexpr int ROWF_OFF = 131072 + 4096;
constexpr int BM = 256, BK = 64, HALF = 128, HTB = HALF * BK * 2  , STAGE_BYTES = 8 * HTB, NXCD = 8, WGM = 8;

__host__ __device__ __forceinline__ int lds_byte(int r, int c) { const int st = (r >> 4) * 2 + (c >> 5), rr = r & 15, cc = c & 31, ob = rr * 64 + cc * 2; return st * 1024 + (ob ^ (((ob >> 9) & 1) << 5)); }
__host__ __device__ __forceinline__ void stage_rc(int b, int& R, int& C) { const int st = b / 1024, sb = b % 1024, swz = sb ^ (((sb >> 9) & 1) << 5); R = (st >> 1) * 16 + swz / 64; C = (st & 1) * 32 + (swz % 64) / 2; }
__host__ __device__ __forceinline__ int perm32(int rho) { const int n = rho >> 4, i = rho & 15; return 8 * (i >> 2) + 4 * n + (i & 3); }

struct Unit { const char* A0; const char* B0; int nt; int pm, pn, aux; };
__device__ __forceinline__ unsigned cvt_pk_bf16(float lo, float hi) { unsigned r; asm volatile("v_cvt_pk_bf16_f32 %0, %1, %2" : "=v"(r) : "v"(lo), "v"(hi)); return r; }

__device__ __forceinline__ bool static_tile(int i, int G, int c, int nM, int nN, int& pm, int& pn) {
    const int nwg = nM * nN; const long L = (long)i * G + c; if (L >= nwg) return false;
    int wgid = (int)L; { const int q = nwg / NXCD, r = nwg % NXCD, xcd = wgid % NXCD, off = wgid / NXCD; wgid = (xcd < r ? xcd * (q + 1) : r * (q + 1) + (xcd - r) * q) + off; }
    const int nig = WGM * nN, gid = wgid / nig, fm = gid * WGM, gsz = (nM - fm) < WGM ? (nM - fm) : WGM;
    pm = fm + ((wgid % nig) % gsz); pn = (wgid % nig) / gsz; return true;
}

template <class Epi, class Sched>
__device__ __forceinline__ void gemm_phase(GE_LAS unsigned char* lds, const Sched& S, const Epi& E, int tid) {
    const int wid = __builtin_amdgcn_readfirstlane(tid >> 6), lane = tid & 63, wr = wid >> 2, wc = wid & 3, fr = lane & 15, fq = lane >> 4;
    unsigned voffA[2], voffB[2], voffB1[2];
#pragma unroll
    for (int i = 0; i < 2; ++i) { int R, C; stage_rc(tid * 16 + i * 8192, R, C); const int Rb = Epi::PERM ? ((R & ~31) + perm32(R & 31)) : R;
        voffA[i] = S.voffA(R, C); voffB[i] = S.voffB(Rb, C); if constexpr (Sched::DUALB) voffB1[i] = S.voffB1(Rb, C); else voffB1[i] = 0u; }
    const long hA = S.hA, hB = S.hB;
    const unsigned ldsw = (unsigned)wid * 1024u;
    const int aoff = lds_byte(wr * 64 + fr, fq * 8), boff = lds_byte(wc * 32 + fr, fq * 8);
#define GE_SA(b, h) (((b) * 2 + (h)) * HTB)
#define GE_SB(b, h) ((4 + (b) * 2 + (h)) * HTB)
#define GE_STAGE(bufoff, gbase, voff) do { _Pragma("unroll") for (int _i = 0; _i < 2; ++_i) \
        __builtin_amdgcn_global_load_lds((const unsigned*)((const char*)(gbase) + (voff)[_i]), (GE_LAS unsigned*)(lds + (bufoff) + ldsw + _i * 8192), 16, 0, 0); } while (0)
#define GE_STAGE_B(bufoff, gbase, sel, half) do { if constexpr (Sched::DUALB) { const char* _g = (const char*)(gbase) + ((half) ? ((sel) ? S.hB1 : hB) : 0l); _Pragma("unroll") for (int _i = 0; _i < 2; ++_i) { const unsigned _v = (sel) ? voffB1[_i] : voffB[_i]; \
        __builtin_amdgcn_global_load_lds((const unsigned*)(_g + _v), (GE_LAS unsigned*)(lds + (bufoff) + ldsw + _i * 8192), 16, 0, 0); } } else { GE_STAGE(bufoff, (const char*)(gbase) + ((half) ? hB : 0l), voffB); } } while (0)
#define GE_LDA(dst, b, h) do { _Pragma("unroll") for (int m = 0; m < 4; ++m) _Pragma("unroll") for (int k = 0; k < 2; ++k) dst[m][k] = *(const GE_LAS bf16x8*)(lds + GE_SA(b, h) + aoff + m * 2048 + k * 1024); } while (0)
#define GE_LDB(dst, b, h) do { _Pragma("unroll") for (int n = 0; n < 2; ++n) _Pragma("unroll") for (int k = 0; k < 2; ++k) dst[n][k] = *(const GE_LAS bf16x8*)(lds + GE_SB(b, h) + boff + n * 2048 + k * 1024); } while (0)
#define GE_MMA(ai, bj, At, Bt) do { __builtin_amdgcn_s_setprio(1); _Pragma("unroll") for (int m = 0; m < 4; ++m) _Pragma("unroll") for (int n = 0; n < 2; ++n) _Pragma("unroll") for (int k = 0; k < 2; ++k) \
        acc[ai][bj][m][n] = __builtin_amdgcn_mfma_f32_16x16x32_bf16(Bt[n][k], At[m][k], acc[ai][bj][m][n], 0, 0, 0); __builtin_amdgcn_s_setprio(0); } while (0)
#define GE_WAIT_V(n) asm volatile("s_waitcnt vmcnt(" #n ")" ::: "memory")
#define GE_WAIT_L(n) asm volatile("s_waitcnt lgkmcnt(" #n ")" ::: "memory")
#define GE_BAR __builtin_amdgcn_s_barrier()
#define GE_SCHED __builtin_amdgcn_sched_barrier(0)
    Unit cur, nxt; int ui = 0;
    if (!S.next(0, cur)) return;
    f32x4 acc[2][2][4][2];
#pragma unroll
    for (int a = 0; a < 2; ++a)
#pragma unroll
        for (int b = 0; b < 2; ++b)
#pragma unroll
            for (int m = 0; m < 4; ++m)
#pragma unroll
                for (int n = 0; n < 2; ++n) acc[a][b][m][n] = (f32x4){0.f, 0.f, 0.f, 0.f};
    bf16x8 At[4][2], B0[2][2], B1[2][2];
    if constexpr (Epi::UBEGIN) E.unit_begin(cur, tid, lds + ROWF_OFF);
    {
        const char* a0 = S.ta(cur, 0); const char* b0 = S.tb(cur, 0); const char* a1 = S.ta(cur, 1); const char* b1 = S.tb(cur, 1);
        const bool s0 = S.sb(cur, 0), s1 = S.sb(cur, 1);
        GE_STAGE_B(GE_SB(0, 0), b0, s0, 0); GE_STAGE_B(GE_SB(0, 1), b0, s0, 1); GE_STAGE(GE_SA(0, 0), a0, voffA); GE_STAGE(GE_SA(0, 1), a0 + hA, voffA);
        if (wr == 1) GE_BAR;
        GE_WAIT_V(2); GE_BAR;
        GE_STAGE_B(GE_SB(1, 0), b1, s1, 0); GE_STAGE(GE_SA(1, 0), a1, voffA); GE_STAGE_B(GE_SB(1, 1), b1, s1, 1);
        GE_WAIT_V(6); GE_BAR;
    }
    for (;;) {
        const bool has_next = S.next(ui + 1, nxt);
        const int nt = cur.nt;
        for (int t = 0; t < nt; t += 2) {
            const bool last = (t == nt - 2);
            const char* a1 = S.ta(cur, t + 1);
            const char* a2 = last ? (has_next ? S.ta(nxt, 0) : S.ta(cur, 0)) : S.ta(cur, t + 2);
            const char* b2 = last ? (has_next ? S.tb(nxt, 0) : S.tb(cur, 0)) : S.tb(cur, t + 2);
            const char* a3 = last ? (has_next ? S.ta(nxt, 1) : S.ta(cur, 1)) : S.ta(cur, t + 3);
            const char* b3 = last ? (has_next ? S.tb(nxt, 1) : S.tb(cur, 1)) : S.tb(cur, t + 3);
            const bool s2 = last ? (has_next ? S.sb(nxt, 0) : S.sb(cur, 0)) : S.sb(cur, t + 2), s3 = last ? (has_next ? S.sb(nxt, 1) : S.sb(cur, 1)) : S.sb(cur, t + 3);
            GE_LDB(B0, 0, 0); GE_LDB(B1, 0, 1); GE_SCHED; GE_LDA(At, 0, 0); GE_STAGE(GE_SA(1, 1), a1 + hA, voffA);
            GE_WAIT_V(8); GE_WAIT_L(0); GE_BAR; GE_MMA(0, 0, At, B0); GE_MMA(0, 1, At, B1); GE_BAR; GE_SCHED;
            GE_LDA(At, 0, 1); GE_STAGE_B(GE_SB(0, 0), b2, s2, 0); GE_STAGE_B(GE_SB(0, 1), b2, s2, 1); GE_STAGE(GE_SA(0, 0), a2, voffA);
            GE_WAIT_V(8); GE_WAIT_L(0); GE_BAR; GE_MMA(1, 0, At, B0); GE_MMA(1, 1, At, B1); GE_BAR; GE_SCHED;
            GE_LDB(B0, 1, 0); GE_LDB(B1, 1, 1); GE_SCHED; GE_LDA(At, 1, 0); GE_STAGE(GE_SA(0, 1), a2 + hA, voffA);
            GE_WAIT_V(8); GE_WAIT_L(0); GE_BAR; GE_MMA(0, 0, At, B0); GE_MMA(0, 1, At, B1); GE_BAR; GE_SCHED;
            GE_LDA(At, 1, 1); GE_STAGE_B(GE_SB(1, 0), b3, s3, 0); GE_STAGE_B(GE_SB(1, 1), b3, s3, 1); GE_STAGE(GE_SA(1, 0), a3, voffA);
            GE_WAIT_V(8); GE_WAIT_L(0); GE_BAR; GE_MMA(1, 0, At, B0); GE_MMA(1, 1, At, B1); GE_BAR; GE_SCHED;
            if constexpr (Epi::MIDK) { if (t + 2 == (nt >> 1)) E.midk(acc, cur, wr, fr, lds + ROWF_OFF + (ui & 1) * 2048); }
        }
        if (wr == 0) GE_BAR;
        E(acc, cur, wr, wc, fr, fq, lds + ROWF_OFF + (ui & 1) * 2048);
        if (!has_next) break;
        if constexpr (Epi::UBEGIN) E.unit_begin(nxt, tid, lds + ROWF_OFF + ((ui + 1) & 1) * 2048);
#pragma unroll
        for (int a = 0; a < 2; ++a)
#pragma unroll
            for (int b = 0; b < 2; ++b)
#pragma unroll
                for (int m = 0; m < 4; ++m)
#pragma unroll
                    for (int n = 0; n < 2; ++n) acc[a][b][m][n] = (f32x4){0.f, 0.f, 0.f, 0.f};
        cur = nxt; ++ui;
        if (wr == 1) GE_BAR;
    }
    GE_WAIT_V(0);
    GE_BAR;
#undef GE_SA
#undef GE_SB
#undef GE_STAGE
#undef GE_STAGE_B
#undef GE_LDA
#undef GE_LDB
#undef GE_MMA
#undef GE_WAIT_V
#undef GE_WAIT_L
#undef GE_BAR
#undef GE_SCHED
}
}
namespace nv {
__device__ __forceinline__ float sum8(const float* p);
__device__ __forceinline__ float sum16(const float* p);
#define XB_TMO      128
#define XB_XCNT(j)  (256  + 64 * (j))
#define XB_XSUB(j)  (1280 + 64 * (j))
#define XB_XGEN(j)  (2304 + 64 * (j))
#define XB_TOP      3328
#define XB_TOPGEN   3392
#define XCD_BAR_WORDS 3456
#define XB_SPIN_CAP (1u << 24)
__device__ __forceinline__ unsigned xb_ld(unsigned* p)              { return __hip_atomic_load(p, __ATOMIC_RELAXED, __HIP_MEMORY_SCOPE_AGENT); }
__device__ __forceinline__ unsigned xb_add(unsigned* p, unsigned v) { return __hip_atomic_fetch_add(p, v, __ATOMIC_RELAXED, __HIP_MEMORY_SCOPE_AGENT); }
__device__ __forceinline__ unsigned xb_xcc_id() { return (unsigned)__builtin_amdgcn_s_getreg((3 << 11) | 20) & 0xFu; }
#define XB_SPIN(cond, bar) do { unsigned _sp = 0; while (cond) { __builtin_amdgcn_s_sleep(1); \
    if ((++_sp & 255u) == 0u) { if (xb_ld(&(bar)[XB_TMO])) break; if (_sp > XB_SPIN_CAP) { atomicAdd(&(bar)[XB_TMO], 1u); break; } } } } while (0)
struct XcdBarrier { unsigned* bar; unsigned x; volatile LAS unsigned* st; };
__device__ __forceinline__ XcdBarrier xcd_barrier_post(unsigned* bar, volatile LAS unsigned* st) {
    XcdBarrier b; b.bar = bar; b.x = xb_xcc_id(); b.st = st;
    if (threadIdx.x == 0) (void)xb_add(&bar[XB_XCNT(b.x)], 1u);
    return b;
}
__device__ __forceinline__ void xcd_barrier_complete(unsigned* bar, unsigned x, unsigned& nloc, unsigned& nx) {
    const unsigned Gsz = gridDim.x * gridDim.y * gridDim.z;
    unsigned sum, cnt, mine, sp = 0u;
    for (;;) {
        sum = 0u; cnt = 0u; mine = 0u;
#pragma unroll
        for (unsigned j = 0; j < 16; ++j) { const unsigned c = xb_ld(&bar[XB_XCNT(j)]); sum += c; cnt += (c > 0u) ? 1u : 0u; mine = (j == x) ? c : mine; }
        if (sum == Gsz) break;
        __builtin_amdgcn_s_sleep(1);
        if ((++sp & 255u) == 0u) { if (xb_ld(&bar[XB_TMO])) break; if (sp > XB_SPIN_CAP) { atomicAdd(&bar[XB_TMO], 1u); break; } }
    }
    nloc = mine > 0u ? mine : 1u; nx = cnt > 0u ? cnt : 1u;
}
__device__ __forceinline__ void xcd_barrier(const XcdBarrier& b) {
    asm volatile("s_waitcnt vmcnt(0)" ::: "memory");
    __syncthreads();
    if (threadIdx.x == 0) {
        unsigned* bar = b.bar;
        __builtin_amdgcn_s_waitcnt(0);
        unsigned nloc = b.st[0], nx = b.st[1];
        if (nloc == 0u) { xcd_barrier_complete(bar, b.x, nloc, nx); b.st[0] = nloc; b.st[1] = nx; }
        const unsigned old = xb_add(&bar[XB_XSUB(b.x)], 1u);
        const unsigned gen = old / nloc;
        if (old + 1u == (gen + 1u) * nloc) {
            __builtin_amdgcn_fence(__ATOMIC_RELEASE, "agent");
            asm volatile("s_waitcnt vmcnt(0)" ::: "memory");
            const unsigned og = xb_add(&bar[XB_TOP], 1u);
            const unsigned tg = og / nx;
            if (og + 1u == (tg + 1u) * nx) xb_add(&bar[XB_TOPGEN], 1u);
            else XB_SPIN(xb_ld(&bar[XB_TOPGEN]) == tg, bar);
            __builtin_amdgcn_fence(__ATOMIC_ACQUIRE, "agent");
            xb_add(&bar[XB_XGEN(b.x)], 1u);
            asm volatile("s_waitcnt vmcnt(0)" ::: "memory");
        } else {
            XB_SPIN(xb_ld(&bar[XB_XGEN(b.x)]) == gen, bar);
            __builtin_amdgcn_fence(__ATOMIC_ACQUIRE, "agent");
            asm volatile("s_waitcnt vmcnt(0)" ::: "memory");
        }
    }
    __syncthreads();
}

#define LDS_WAIT() asm volatile("s_waitcnt lgkmcnt(0)" ::: "memory")
template <class Sc>
__device__ __forceinline__ void p0_transpose_item(const float* __restrict__ W, int ldw, int K, int Ncols, Sc sc, bf16_t* __restrict__ WT, LAS float* scr, int item, int lane) {
    const int nblk = Ncols / 32, kb = item / nblk, nb = item % nblk, k0 = 64 * kb, n0 = 32 * nb;
    float wv[32];
#pragma unroll
    for (int i = 0; i < 32; ++i) { const int kk = 2 * i + (lane >> 5); wv[i] = W[(size_t)(k0 + kk) * ldw + n0 + (lane & 31)]; }
#pragma unroll
    for (int i = 0; i < 32; ++i) { const int kk = 2 * i + (lane >> 5); scr[kk * 33 + (lane & 31)] = wv[i] * sc(k0 + kk); }
    LDS_WAIT(); asm volatile("" ::: "memory");
    const int c = lane & 7;
#pragma unroll
    for (int j = 0; j < 4; ++j) { const int n = (lane >> 3) + 8 * j; const LAS float* s = scr + (8 * c) * 33 + n;
        u32x4 o; o.x = pk2(s[0 * 33], s[1 * 33]); o.y = pk2(s[2 * 33], s[3 * 33]); o.z = pk2(s[4 * 33], s[5 * 33]); o.w = pk2(s[6 * 33], s[7 * 33]);
        *(u32x4*)(WT + (size_t)(n0 + n) * K + k0 + 8 * c) = o; }
    LDS_WAIT(); asm volatile("" ::: "memory");
}
struct ScVec { const float* g; __device__ __forceinline__ float operator()(int k) const { return g[k]; } };
struct ScOne { __device__ __forceinline__ float operator()(int) const { return 1.f; } };
struct ScTwo { const float* g0; const float* g1; __device__ __forceinline__ float operator()(int k) const { return k < 512 ? g0[k] : g1[k - 512]; } };

constexpr int TAB_OFF = 131072 + 1024;
__device__ __forceinline__ void* ldarg(LAS unsigned char* lds, int i) {
    unsigned off = TAB_OFF + 8 * i; asm volatile("" : "+s"(off));
    const unsigned long long v = *(volatile LAS unsigned long long*)(lds + off);
    const unsigned lo = __builtin_amdgcn_readfirstlane((unsigned)v), hi = __builtin_amdgcn_readfirstlane((unsigned)(v >> 32));
    return (void*)(GAS void*)(((unsigned long long)hi << 32) | lo);
}

__device__ __forceinline__ void p0_prologue(LAS unsigned char* lds) {
    PH_IDS
    const int lane = TIDX & 63, wave = __builtin_amdgcn_readfirstlane(TIDX >> 6), gw = BIDX * 8 + wave, ngw = GDIM * 8;
    LAS float* scr = (LAS float*)(lds + wave * 16384);
    unsigned char* ws = (unsigned char*)ldarg(lds, 24);
    const float* a0 = (const float*)ldarg(lds, 0); const float* a1 = (const float*)ldarg(lds, 1); const float* a2 = (const float*)ldarg(lds, 2); const float* a11 = (const float*)ldarg(lds, 11);
    const float* a14 = (const float*)ldarg(lds, 14); const float* a15 = (const float*)ldarg(lds, 15); const float* a16 = (const float*)ldarg(lds, 16); const float* a17 = (const float*)ldarg(lds, 17); const float* a18 = (const float*)ldarg(lds, 18);
    constexpr int I1 = (D / 64) * (2048 / 32), I2 = (SSMW / 64) * (SSMW / 32), I3 = (D / 64) * (D / 32), I4 = I3, IL = I1 + I2 + I3 + I4;
    for (int it = gw; it < DEPTH * IL; it += ngw) {
        const int l = it / IL; int r = it % IL;
        if (r < I1) { p0_transpose_item(a2 + (size_t)l * D * INW, INW, D, 2048, ScVec{a1 + l * D}, (bf16_t*)(ws + WS_BT1) + (size_t)l * 2048 * D, scr, r, lane); continue; } r -= I1;
        if (r < I2) { p0_transpose_item(a11 + (size_t)l * SSMW * SSMW, SSMW, SSMW, SSMW, ScOne{}, (bf16_t*)(ws + WS_BT2) + (size_t)l * SSMW * SSMW, scr, r, lane); continue; } r -= I2;
        if (r < I3) { p0_transpose_item(a16 + (size_t)l * D * D, D, D, D, ScTwo{a14 + l * SSMW, a15 + l * ATTW}, (bf16_t*)(ws + WS_BT3) + (size_t)l * D * D, scr, r, lane); continue; } r -= I3;
        p0_transpose_item(a18 + (size_t)l * D * D, D, D, D, ScVec{a17 + l * D}, (bf16_t*)(ws + WS_BT4) + (size_t)l * D * D, scr, r, lane);
    }
    for (int i = BIDX * 512 + TIDX; i < DEPTH * 16 * D; i += GDIM * 512) {
        const int l = i / (16 * D), j = (i / D) % 16, k = i % D;
        const float v = j < 8 ? a2[((size_t)l * D + k) * INW + 2048 + j] * a1[l * D + k] : 0.f;
        ((bf16_t*)(ws + WS_WF))[i] = f2bf(v);
    }
    {
        const float* x = a0; bf16_t* hb = (bf16_t*)(ws + WS_HB); float* ssp1 = (float*)(ws + WS_SSP) + (size_t)T * 32;
        constexpr int NR = 4;
        for (int w0 = gw; w0 < T; w0 += NR * ngw) {
            f32x4 v[NR][4];
#pragma unroll
            for (int u = 0; u < NR; ++u) { const int w = w0 + u * ngw; if (w < T) { const f32x4* r = (const f32x4*)(x + (size_t)w * D) + lane;
#pragma unroll
                for (int j = 0; j < 4; ++j) v[u][j] = r[64 * j]; } }
#pragma unroll
            for (int u = 0; u < NR; ++u) { const int w = w0 + u * ngw; if (w < T) { unsigned long long* o = (unsigned long long*)(hb + (size_t)w * D) + lane;
                float s = 0.f;
#pragma unroll
                for (int j = 0; j < 4; ++j) { const unsigned q0 = pk2(v[u][j].x, v[u][j].y), q1 = pk2(v[u][j].z, v[u][j].w); o[64 * j] = (unsigned long long)q0 | ((unsigned long long)q1 << 32);
                    const float a = __uint_as_float(q0 << 16), b = __uint_as_float(q0 & 0xffff0000u), c = __uint_as_float(q1 << 16), d = __uint_as_float(q1 & 0xffff0000u); s += (a * a + b * b) + (c * c + d * d); }
                s = wave_sum(s);
                if (lane < 8) ssp1[(size_t)w * 8 + lane] = lane == 0 ? s : 0.f; } }
        }
    }
}

struct SchedGen {
    static constexpr bool DUALB = false; long hB1;
    __device__ __forceinline__ bool sb(const ge::Unit&, int) const { return false; }
    __device__ __forceinline__ unsigned voffB1(int, int) const { return 0u; }
    const char* A; const char* B; int a_row_b, a_c16_b, b_row_b, b_c16_b; long a_pm_b, a_kt_b, b_pn_b, b_kt_b; int nM, nN, nt, G, c; long hA, hB;
    __device__ __forceinline__ void init_plain(const void* A_, int lda_bytes, const void* B_, int ldb_bytes, int M, int N, int K, int G_, int c_) {
        A = (const char*)A_; B = (const char*)B_; a_row_b = lda_bytes; a_c16_b = 32; b_row_b = ldb_bytes; b_c16_b = 32; a_pm_b = 256l * lda_bytes; a_kt_b = 128; b_pn_b = 256l * ldb_bytes; b_kt_b = 128;
        nM = M / 256; nN = N / 256; nt = K / 64; G = G_; c = c_; hA = 128l * lda_bytes; hB = 128l * ldb_bytes; }
    __device__ __forceinline__ bool next(int i, ge::Unit& u) const {
        int pm, pn; if (!ge::static_tile(i, G, c, nM, nN, pm, pn)) return false;
        u.A0 = A + (size_t)pm * a_pm_b; u.B0 = B + (size_t)pn * b_pn_b; u.nt = nt; u.pm = pm; u.pn = pn; u.aux = 0; return true; }
    __device__ __forceinline__ const char* ta(const ge::Unit& u, int t) const { return u.A0 + t * a_kt_b; }
    __device__ __forceinline__ const char* tb(const ge::Unit& u, int t) const { return u.B0 + t * b_kt_b; }
    __device__ __forceinline__ unsigned voffA(int R, int C) const { return (unsigned)(R * a_row_b + (C >> 4) * a_c16_b + (C & 15) * 2); }
    __device__ __forceinline__ unsigned voffB(int Rb, int C) const { return (unsigned)(Rb * b_row_b + (C >> 4) * b_c16_b + (C & 15) * 2); }
};
typedef SchedGen SchedPlain;

constexpr float QSCALE = 0.125f * 1.4426950408889634f;
struct EpiInProj {
    static constexpr bool PERM = true, MIDK = false, UBEGIN = true;
    const float* ssp1; bf16_t* UP; bf16_t* QKV;
    __device__ __forceinline__ void unit_begin(const ge::Unit& u, int tid, LAS unsigned char* rowf) const {
        if (tid < 256) { const int row = u.pm * 256 + tid; ((LAS float*)rowf)[tid] = rsqrtf(sum8(ssp1 + (size_t)row * 8) * (1.f / D) + EPS); }
    }
    __device__ __forceinline__ void midk(ge::f32x4 (&)[2][2][4][2], const ge::Unit&, int, int, LAS unsigned char*) const {}
    __device__ __forceinline__ void operator()(const ge::f32x4 (&acc)[2][2][4][2], const ge::Unit& u, int wr, int wc, int fr, int fq, LAS unsigned char* rowf) const {
        const int row0 = u.pm * 256 + wr * 64 + fr, colt = u.pn * 256, region = colt >> 9;
        bf16_t* dstb = QKV + (size_t)(region - 1) * ((WS_K - WS_Q) / 2);
#pragma unroll
        for (int ai = 0; ai < 2; ++ai)
#pragma unroll
            for (int m = 0; m < 4; ++m) {
                const int row = row0 + ai * 128 + m * 16; const float rs = ((const LAS float*)rowf)[ai * 128 + wr * 64 + m * 16 + fr];
#pragma unroll
                for (int bj = 0; bj < 2; ++bj) {
                    const int c = (colt & 511) + bj * 128 + wc * 32 + 8 * fq;
                    const float rq = region == 1 ? rs * QSCALE : rs;
                    const ge::f32x4 v0 = acc[ai][bj][m][0] * rq, v1 = acc[ai][bj][m][1] * rq;
                    u32x4 w; w.x = ge::cvt_pk_bf16(v0[0], v0[1]); w.y = ge::cvt_pk_bf16(v0[2], v0[3]); w.z = ge::cvt_pk_bf16(v1[0], v1[1]); w.w = ge::cvt_pk_bf16(v1[2], v1[3]);
                    bf16_t* dst = region == 0 ? UP + up_index(row, c) : dstb + (size_t)row * 512 + c;
                    *(u32x4*)dst = w;
                }
            }
    }
};

__device__ __forceinline__ float sum8(const float* p) { const ge::f32x4 a = *(const ge::f32x4*)p, b = *(const ge::f32x4*)(p + 4); return ((a[0] + a[1]) + (a[2] + a[3])) + ((b[0] + b[1]) + (b[2] + b[3])); }
__device__ __forceinline__ float sum16(const float* p) { return sum8(p) + sum8(p + 8); }
__device__ __forceinline__ size_t gel_index(int row, int c) { return ((size_t)(c >> 4) * T + row) * HC + (c & 15); }
__device__ __forceinline__ float sigmoidf_(float x) { return 1.f / (1.f + __expf(-x)); }
struct EpiGlu2 {
    static constexpr bool PERM = true, MIDK = false, UBEGIN = false;
    const bf16_t* GEL; const float* bias; bf16_t* MIX; float* ssp;
    __device__ __forceinline__ void unit_begin(const ge::Unit&, int, LAS unsigned char*) const {}
    __device__ __forceinline__ void midk(ge::f32x4 (&)[2][2][4][2], const ge::Unit&, int, int, LAS unsigned char*) const {}
    __device__ __forceinline__ void operator()(const ge::f32x4 (&acc)[2][2][4][2], const ge::Unit& u, int wr, int wc, int fr, int fq, LAS unsigned char*) const {
        const int row0 = u.pm * 256 + wr * 64 + fr, colt = u.pn * 256;
#pragma unroll
        for (int ai = 0; ai < 2; ++ai)
#pragma unroll
            for (int m = 0; m < 4; ++m) {
                const int row = row0 + ai * 128 + m * 16; float sq = 0.f;
#pragma unroll
                for (int bj = 0; bj < 2; ++bj) {
                    const int c = colt + bj * 128 + wc * 32 + 8 * fq;
                    const ge::f32x4 b0 = *(const ge::f32x4*)(bias + c), b1 = *(const ge::f32x4*)(bias + c + 4);
                    const u32x4 gw = *(const u32x4*)(GEL + gel_index(row, c));
                    const ge::f32x4 v0 = acc[ai][bj][m][0] + b0, v1 = acc[ai][bj][m][1] + b1;
                    float o[8];
                    o[0] = __uint_as_float(gw.x << 16) * sigmoidf_(v0[0]); o[1] = __uint_as_float(gw.x & 0xffff0000u) * sigmoidf_(v0[1]);
                    o[2] = __uint_as_float(gw.y << 16) * sigmoidf_(v0[2]); o[3] = __uint_as_float(gw.y & 0xffff0000u) * sigmoidf_(v0[3]);
                    o[4] = __uint_as_float(gw.z << 16) * sigmoidf_(v1[0]); o[5] = __uint_as_float(gw.z & 0xffff0000u) * sigmoidf_(v1[1]);
                    o[6] = __uint_as_float(gw.w << 16) * sigmoidf_(v1[2]); o[7] = __uint_as_float(gw.w & 0xffff0000u) * sigmoidf_(v1[3]);
#pragma unroll
                    for (int e = 0; e < 8; ++e) sq += o[e] * o[e];
                    u32x4 w; w.x = ge::cvt_pk_bf16(o[0], o[1]); w.y = ge::cvt_pk_bf16(o[2], o[3]); w.z = ge::cvt_pk_bf16(o[4], o[5]); w.w = ge::cvt_pk_bf16(o[6], o[7]);
                    *(u32x4*)(MIX + (size_t)row * D + c) = w;
                }
                sq += __shfl_xor(sq, 16); sq += __shfl_xor(sq, 32);
                if (fq == 0) ssp[(size_t)row * 8 + u.pn * 4 + wc] = sq;
            }
    }
};
struct EpiWo {
    static constexpr bool PERM = true, MIDK = true, UBEGIN = true;
    const float* ssp_s; const float* ssp_a; const bf16_t* hin; bf16_t* hb; float* ssp2;
    typedef float f32x2_ __attribute__((ext_vector_type(2)));
    __device__ __forceinline__ void unit_begin(const ge::Unit& u, int tid, LAS unsigned char* rowf) const {
        if (tid < 256) { const int row = u.pm * 256 + tid;
            const float rs_s = rsqrtf(sum8(ssp_s + (size_t)row * 8) * (1.f / SSMW) + EPS), rs_a = rsqrtf(sum8(ssp_a + (size_t)row * 8) * (1.f / ATTW) + EPS);
            ((LAS f32x2_*)rowf)[tid] = (f32x2_){rs_s / rs_a, rs_a}; }
    }
    __device__ __forceinline__ void midk(ge::f32x4 (&acc)[2][2][4][2], const ge::Unit& u, int wr, int fr, LAS unsigned char* rowf) const {
#pragma unroll
        for (int ai = 0; ai < 2; ++ai)
#pragma unroll
            for (int m = 0; m < 4; ++m) {
                const float f = ((const LAS f32x2_*)rowf)[ai * 128 + wr * 64 + m * 16 + fr].x;
#pragma unroll
                for (int bj = 0; bj < 2; ++bj)
#pragma unroll
                    for (int n = 0; n < 2; ++n) acc[ai][bj][m][n] = acc[ai][bj][m][n] * f;
            }
    }
    __device__ __forceinline__ void operator()(const ge::f32x4 (&acc)[2][2][4][2], const ge::Unit& u, int wr, int wc, int fr, int fq, LAS unsigned char* rowf) const {
        const int row0 = u.pm * 256 + wr * 64 + fr, colt = u.pn * 256;
#pragma unroll
        for (int ai = 0; ai < 2; ++ai)
#pragma unroll
            for (int m = 0; m < 4; ++m) {
                const int row = row0 + ai * 128 + m * 16; const float ra = ((const LAS f32x2_*)rowf)[ai * 128 + wr * 64 + m * 16 + fr].y; float sq = 0.f;
#pragma unroll
                for (int bj = 0; bj < 2; ++bj) {
                    const int c = colt + bj * 128 + wc * 32 + 8 * fq;
                    const size_t o = (size_t)row * D + c;
                    const u32x4 hw = *(const u32x4*)(hin + o);
                    const ge::f32x4 a0 = acc[ai][bj][m][0] * ra, a1 = acc[ai][bj][m][1] * ra;
                    u32x4 w; w.x = ge::cvt_pk_bf16(__uint_as_float(hw.x << 16) + a0[0], __uint_as_float(hw.x & 0xffff0000u) + a0[1]); w.y = ge::cvt_pk_bf16(__uint_as_float(hw.y << 16) + a0[2], __uint_as_float(hw.y & 0xffff0000u) + a0[3]);
                    w.z = ge::cvt_pk_bf16(__uint_as_float(hw.z << 16) + a1[0], __uint_as_float(hw.z & 0xffff0000u) + a1[1]); w.w = ge::cvt_pk_bf16(__uint_as_float(hw.w << 16) + a1[2], __uint_as_float(hw.w & 0xffff0000u) + a1[3]);
                    *(u32x4*)(hb + o) = w;
#pragma unroll
                    for (int e = 0; e < 4; ++e) { const float lo = __uint_as_float(w[e] << 16), hi = __uint_as_float(w[e] & 0xffff0000u); sq += lo * lo + hi * hi; }
                }
                sq += __shfl_xor(sq, 16); sq += __shfl_xor(sq, 32);
                if (fq == 0) ssp2[(size_t)row * 16 + u.pn * 4 + wc] = sq;
            }
    }
};
struct EpiWq {
    static constexpr bool PERM = true, MIDK = false, UBEGIN = true;
    const float* ssp2; bf16_t* QP;
    __device__ __forceinline__ void unit_begin(const ge::Unit& u, int tid, LAS unsigned char* rowf) const {
        if (tid < 256) { const int row = u.pm * 256 + tid; ((LAS float*)rowf)[tid] = rsqrtf(sum16(ssp2 + (size_t)row * 16) * (1.f / D) + EPS); }
    }
    __device__ __forceinline__ void midk(ge::f32x4 (&)[2][2][4][2], const ge::Unit&, int, int, LAS unsigned char*) const {}
    __device__ __forceinline__ void operator()(const ge::f32x4 (&acc)[2][2][4][2], const ge::Unit& u, int wr, int wc, int fr, int fq, LAS unsigned char* rowf) const {
        const int row0 = u.pm * 256 + wr * 64 + fr, colt = u.pn * 256;
#pragma unroll
        for (int ai = 0; ai < 2; ++ai)
#pragma unroll
            for (int m = 0; m < 4; ++m) {
                const int row = row0 + ai * 128 + m * 16; const float rs = ((const LAS float*)rowf)[ai * 128 + wr * 64 + m * 16 + fr];
#pragma unroll
                for (int bj = 0; bj < 2; ++bj) {
                    const int c = colt + bj * 128 + wc * 32 + 8 * fq;
                    const ge::f32x4 v0 = acc[ai][bj][m][0] * rs, v1 = acc[ai][bj][m][1] * rs;
                    u32x4 w; w.x = ge::cvt_pk_bf16(v0[0], v0[1]); w.y = ge::cvt_pk_bf16(v0[2], v0[3]); w.z = ge::cvt_pk_bf16(v1[0], v1[1]); w.w = ge::cvt_pk_bf16(v1[2], v1[3]);
                    *(u32x4*)(QP + (size_t)row * D + c) = w;
                }
            }
    }
};

__device__ __forceinline__ void ph_flogit(const bf16_t* __restrict__ hb, const bf16_t* __restrict__ wf, const float* __restrict__ ss, const float* __restrict__ bfv, float* __restrict__ logf) {
    PH_IDS
    const int lane = TIDX & 63, gw = BIDX * 8 + __builtin_amdgcn_readfirstlane(TIDX >> 6), ngw = GDIM * 8, r16 = lane & 15, q4 = lane >> 4;
    for (int item = gw; item < T / 16; item += ngw) {
        const int tok0 = item * 16;
        ge::f32x4 acc = {0.f, 0.f, 0.f, 0.f};
        const bf16_t* ar = hb + (size_t)(tok0 + r16) * D + q4 * 8; const bf16_t* br = wf + (size_t)r16 * D + q4 * 8;
#pragma unroll 8
        for (int ks = 0; ks < D / 32; ++ks) {
            const bf16x8 a = *(const bf16x8*)(ar + ks * 32), b = *(const bf16x8*)(br + ks * 32);
            acc = __builtin_amdgcn_mfma_f32_16x16x32_bf16(a, b, acc, 0, 0, 0);
        }
        if (r16 < NH) {
            const float bj = bfv[r16];
#pragma unroll
            for (int r = 0; r < 4; ++r) {
                const int tok = tok0 + 4 * q4 + r; const float x = acc[r] * rsqrtf(sum8(ss + (size_t)tok * 8) * (1.f / D) + EPS) + bj;
                logf[(size_t)tok * NH + r16] = fminf(x, 0.f) - log1pf(expf(-fabsf(x)));
            }
        }
    }
}
}
namespace nv {
__device__ __forceinline__ float gelu_fast(float x);
constexpr float USCALE = 256.f, VSCALE = 16.f;
typedef float f32x2 __attribute__((ext_vector_type(2)));
typedef int i32x2 __attribute__((ext_vector_type(2)));
__device__ __forceinline__ float clamp448(float x) { return fminf(fmaxf(x, -448.f), 448.f); }
__device__ __forceinline__ unsigned pack4_fp8(float a, float b, float c, float d) {
    int w = 0; w = __builtin_amdgcn_cvt_pk_fp8_f32(clamp448(a), clamp448(b), w, false); w = __builtin_amdgcn_cvt_pk_fp8_f32(clamp448(c), clamp448(d), w, true); return (unsigned)w; }

__device__ __forceinline__ void peer_split(LAS unsigned char* lds, int bid, int grid, int wave, int& slice, int& gw, int& ngw) {
    volatile LAS unsigned* M = (volatile LAS unsigned*)(lds + 131072 + 320);
    const unsigned x = __builtin_amdgcn_readfirstlane(M[16]), rk = __builtin_amdgcn_readfirstlane(M[17]), nl = __builtin_amdgcn_readfirstlane(M[18]), ok = __builtin_amdgcn_readfirstlane(M[19]);
    if (ok) { slice = (int)x; gw = (int)rk * 8 + wave; ngw = (int)nl * 8; }
    else { slice = bid & 7; gw = (bid >> 3) * 8 + wave; ngw = (grid >> 3) * 8; }
}
__device__ __forceinline__ float wave_max(float v) {
#pragma unroll
    for (int o = 1; o < 64; o <<= 1) v = fmaxf(v, __shfl_xor(v, o));
    return v;
}
__device__ __forceinline__ unsigned pack4_i8(float a, float b, float c, float d) {
    const int ia = (int)rintf(a), ib = (int)rintf(b), ic = (int)rintf(c), id = (int)rintf(d);
    return (unsigned)(ia & 0xff) | ((unsigned)(ib & 0xff) << 8) | ((unsigned)(ic & 0xff) << 16) | ((unsigned)id << 24); }
__device__ __forceinline__ void p0_peer_tables(const float* __restrict__ pu, const float* __restrict__ pv, const float* __restrict__ g2, unsigned char* __restrict__ PU8, unsigned char* __restrict__ PV8, float* __restrict__ US) {
    PH_IDS
    const size_t n16 = (size_t)DEPTH * NEXP * D / 16;
    const size_t stride = (size_t)GDIM * 512;
    constexpr int NU = 4;
    for (size_t i0 = (size_t)BIDX * 512 + TIDX; i0 < 2 * n16; i0 += NU * stride) {
        f32x4 x[NU][4];
#pragma unroll
        for (int u = 0; u < NU; ++u) { const size_t i = i0 + u * stride;
            if (i < 2 * n16) { const bool isv = i >= n16; const float* src = (isv ? pv : pu) + (isv ? i - n16 : i) * 16;
#pragma unroll
                for (int k = 0; k < 4; ++k) x[u][k] = *(const f32x4*)(src + 4 * k); } }
#pragma unroll
        for (int u = 0; u < NU; ++u) { const size_t i = i0 + u * stride;
            if (i < 2 * n16) {
                const bool isv = i >= n16; const size_t e0 = (isv ? i - n16 : i) * 16;
                const int l = (int)(e0 / ((size_t)NEXP * D)), c = (int)(e0 % D);
                const size_t er = (e0 / D) % NEXP;
                u32x4 o;
                if (isv) {
#pragma unroll
                    for (int k = 0; k < 4; ++k) o[k] = pack4_fp8(x[u][k].x * VSCALE, x[u][k].y * VSCALE, x[u][k].z * VSCALE, x[u][k].w * VSCALE);
                } else {
                    f32x4 y[4]; float m = 0.f;
#pragma unroll
                    for (int k = 0; k < 4; ++k) { y[k] = x[u][k] * *(const f32x4*)(g2 + l * D + c + 4 * k); m = fmaxf(fmaxf(m, fmaxf(fabsf(y[k].x), fabsf(y[k].y))), fmaxf(fabsf(y[k].z), fabsf(y[k].w))); }
                    m = fmaxf(wave_max(m), 1e-30f);
                    const float inv = 127.f / m;
#pragma unroll
                    for (int k = 0; k < 4; ++k) o[k] = pack4_i8(y[k].x * inv, y[k].y * inv, y[k].z * inv, y[k].w * inv);
                    if ((TIDX & 63) == 0) US[(size_t)l * NEXP + er] = m * (1.f / 127.f);
                }
                *(u32x4*)((isv ? PV8 : PU8) + (((size_t)l * 8 + (c >> 7)) * NEXP + er) * 128 + (c & 127)) = o;
            } }
    }
}

#ifndef PU_LOOK
#define PU_LOOK 7
#endif
#ifndef PV_LO
#define PV_LO 0
#endif
#ifndef PV_LOOK
#define PV_LOOK 7
#endif
constexpr int PB = 16;
#define DPPI(x, CTRL) __builtin_amdgcn_update_dpp(0, (x), (CTRL), 0xF, 0xF, true)
template <int MODE = 0, int LOOKU = PU_LOOK>
__device__ __forceinline__ void ph_peer_u(LAS unsigned char* lds, const unsigned char* __restrict__ PU8, const bf16_t* __restrict__ hb, const unsigned short* __restrict__ idx, bf16_t* __restrict__ partial, int imask = 0x7fffffff) {
    PH_IDS
    const int lane = TIDX & 63, wave = __builtin_amdgcn_readfirstlane(TIDX >> 6), c8 = lane & 7, rg = lane >> 3;
    int slice, gw, ngw; peer_split(lds, BIDX, GDIM, wave, slice, gw, ngw);
    const unsigned char* tab = PU8 + (size_t)slice * NEXP * 128; const unsigned lo16 = 16u * c8;
    LAS int* li = (LAS int*)(lds + wave * 12288);
    LAS unsigned short* lh = (LAS unsigned short*)(lds + wave * 12288 + 8192);
    LAS float* lsc = (LAS float*)(lds + wave * 12288 + 8192 + 2048);
    LAS float* tr = (LAS float*)(lds + 8 * 12288 + wave * 512);
    const int ntok = gw < T ? (T - gw + ngw - 1) / ngw : 0;
    const int p0 = 2 * lane, sd0 = (p0 >> 6) * 64 + (p0 & 7) * 8 + ((p0 & 63) >> 3), sd1 = sd0 + 8;
    const bool b2 = (c8 & 4) != 0, b1 = (c8 & 2) != 0, b0 = (c8 & 1) != 0;
    const int i0 = 8 * (int)b2 + 4 * (int)b0 + 2 * (int)b1;
#define PU_SLOAD(k, IW, HW) do { const size_t ts_ = (size_t)gw + (size_t)min((k), ntok - 1) * ngw; IW = *(const unsigned*)(idx + ts_ * 128 + 2 * lane); HW = *(const unsigned*)(hb + ts_ * D + 128 * slice + 2 * lane); } while (0)
#define PU_SWRITE(k, IW, HW) do { LAS int* d_ = li + ((k) & (PB - 1)) * 128; d_[sd0] = (int)((IW) & 0xffffu) & imask; d_[sd1] = (int)((IW) >> 16) & imask; \
            const float h0_ = __uint_as_float((HW) << 16), h1_ = __uint_as_float((HW) & 0xffff0000u); const float m_ = fmaxf(wave_max(fmaxf(fabsf(h0_), fabsf(h1_))), 1e-30f), inv_ = 127.f / m_; \
            const int q0_ = (int)rintf(h0_ * inv_), q1_ = (int)rintf(h1_ * inv_); lh[((k) & (PB - 1)) * 64 + lane] = (unsigned short)((q0_ & 0xff) | ((q1_ & 0xff) << 8)); \
            if (lane == 0) lsc[(k) & (PB - 1)] = m_ * (1.f / 127.f); } while (0)
#define PU_ISSUE(s, B) do { const ge::u32x4 ia_ = *(const LAS ge::u32x4*)(li + (((s) >> 1) & (2 * PB - 1)) * 64 + rg * 8 + 4 * ((s) & 1)); \
            _Pragma("unroll") for (int i_ = 0; i_ < 4; ++i_) rb[B][i_] = *(const u32x4*)(tab + (ia_[i_] * 128u + lo16)); } while (0)
#define PU_STEP(s, B, QT, ISS) do { if (ISS) { PU_ISSUE((s) + LOOKU, ((B) + LOOKU) & 7); asm volatile("" ::: "memory"); __builtin_amdgcn_sched_barrier(0); } \
            const int k_ = (s) >> 2; const size_t t_ = (size_t)gw + (size_t)k_ * ngw; \
            if (QT == 0) hx = *((const LAS ge::u32x4*)(lh + (k_ & (PB - 1)) * 64) + c8);          \
            if (MODE >= 2) { _Pragma("unroll") for (int i = 0; i < 4; ++i) { const u32x4 a_ = rb[B][i]; pv[4 * QT + i] = (int)((a_.x ^ a_.y ^ a_.z ^ a_.w) & 0x3fffu); } } else \
            _Pragma("unroll") for (int i = 0; i < 4; ++i) { int dd = 0; _Pragma("unroll") for (int k = 0; k < 4; ++k) dd = __builtin_amdgcn_sdot4((int)rb[B][i][k], (int)hx[k], dd, false); pv[4 * QT + i] = dd; } \
            if (QT == 3) { int y[8], z[4]; \
                _Pragma("unroll") for (int j = 0; j < 8; ++j) { const int keep = b2 ? pv[8 + j] : pv[j], send = b2 ? pv[j] : pv[8 + j]; y[j] = keep + DPPI(send, 0x141); }       \
                _Pragma("unroll") for (int j = 0; j < 4; ++j) { const int keep = b0 ? y[4 + j] : y[j], send = b0 ? y[j] : y[4 + j]; z[j] = keep + DPPI(send, 0xB1); }          \
                const int o0 = (b1 ? z[2] : z[0]) + DPPI(b1 ? z[0] : z[2], 0x4E), o1 = (b1 ? z[3] : z[1]) + DPPI(b1 ? z[1] : z[3], 0x4E);                                    \
                  \
                const float st_ = lsc[k_ & (PB - 1)]; tr[8 * i0 + rg] = (float)o0 * st_; tr[8 * i0 + 8 + rg] = (float)o1 * st_; const f32x2 ov_ = *(const LAS f32x2*)(tr + 2 * lane); \
                *(unsigned*)(partial + ((size_t)slice * T + t_) * 128 + 2 * lane) = pk2(ov_.x, ov_.y); } \
            asm volatile("" : "+v"(pv[4 * QT]), "+v"(pv[4 * QT + 1]), "+v"(pv[4 * QT + 2]), "+v"(pv[4 * QT + 3]) :: "memory"); __builtin_amdgcn_sched_barrier(0); } while (0)
    if (ntok >= 8 && !(ntok & 1)) {
        u32x4 rb[8][4]; int pv[16]; ge::u32x4 hx; unsigned xi, xh, yi, yh;
        { unsigned a_[6], b_[6];
#pragma unroll
            for (int k = 0; k < 6; ++k) PU_SLOAD(k, a_[k], b_[k]);
            PU_SLOAD(6, xi, xh); PU_SLOAD(7, yi, yh);
#pragma unroll
            for (int k = 0; k < 6; ++k) PU_SWRITE(k, a_[k], b_[k]); }
        asm volatile("s_waitcnt vmcnt(0) lgkmcnt(0)" ::: "memory");
#define ORD_ asm volatile("" ::: "memory"); __builtin_amdgcn_sched_barrier(0);
        PU_ISSUE(0, 0); ORD_ PU_ISSUE(1, 1); ORD_ PU_ISSUE(2, 2); ORD_ PU_ISSUE(3, 3); ORD_ if (LOOKU > 4) { PU_ISSUE(4, 4); ORD_ } if (LOOKU > 5) { PU_ISSUE(5, 5); ORD_ } if (LOOKU > 6) { PU_ISSUE(6, 6); ORD_ }
#undef ORD_
        const int send = 4 * ntok - 8;
#pragma nounroll
        for (int s0 = 0; s0 < send; s0 += 8) {
            PU_SWRITE((s0 >> 2) + 6, xi, xh); PU_SLOAD((s0 >> 2) + 8, xi, xh);
            PU_STEP(s0, 0, 0, 1); PU_STEP(s0 + 1, 1, 1, 1); PU_STEP(s0 + 2, 2, 2, 1); PU_STEP(s0 + 3, 3, 3, 1);
            PU_SWRITE((s0 >> 2) + 7, yi, yh); PU_SLOAD((s0 >> 2) + 9, yi, yh);
            PU_STEP(s0 + 4, 4, 0, 1); PU_STEP(s0 + 5, 5, 1, 1); PU_STEP(s0 + 6, 6, 2, 1); PU_STEP(s0 + 7, 7, 3, 1); }
        { const int s0 = send; PU_STEP(s0, 0, 0, (0 + LOOKU <= 7)); PU_STEP(s0 + 1, 1, 1, (1 + LOOKU <= 7)); PU_STEP(s0 + 2, 2, 2, (2 + LOOKU <= 7)); PU_STEP(s0 + 3, 3, 3, 0); PU_STEP(s0 + 4, 4, 0, 0); PU_STEP(s0 + 5, 5, 1, 0); PU_STEP(s0 + 6, 6, 2, 0); PU_STEP(s0 + 7, 7, 3, 0); }
    } else {
        u32x4 rb[8][4]; int pv[16]; ge::u32x4 hx;
#pragma nounroll
        for (int k = 0; k < ntok; ++k) {
            { unsigned a_, b_; PU_SLOAD(k, a_, b_); PU_SWRITE(k, a_, b_); } asm volatile("s_waitcnt vmcnt(0) lgkmcnt(0)" ::: "memory");
            const int s0 = 4 * k; PU_ISSUE(s0, 0); PU_ISSUE(s0 + 1, 1); PU_ISSUE(s0 + 2, 2); PU_ISSUE(s0 + 3, 3);
            PU_STEP(s0, 0, 0, 0); PU_STEP(s0 + 1, 1, 1, 0); PU_STEP(s0 + 2, 2, 2, 0); PU_STEP(s0 + 3, 3, 3, 0); }
    }
#undef PU_SLOAD
#undef PU_SWRITE
#undef PU_ISSUE
#undef PU_STEP
    asm volatile("s_waitcnt lgkmcnt(0)" ::: "memory");
}

constexpr float CSCALE = 32.f;
__device__ __forceinline__ void ph_peer_coef(const bf16_t* __restrict__ partial, const float* __restrict__ ssp2, const float* __restrict__ gate, const unsigned short* __restrict__ idx, const float* __restrict__ us, unsigned short* __restrict__ coef8) {
    PH_IDS
    const size_t n4 = (size_t)T * 128 / 4, stride = (size_t)GDIM * 512;
    for (size_t i0 = (size_t)BIDX * 512 + TIDX; i0 < n4; i0 += 2 * stride) {
        ge::u32x2 pv[2][8]; f32x4 gv[2], se[2]; float rs[2];
#pragma unroll
        for (int u = 0; u < 2; ++u) { const size_t i = i0 + u * stride;
            if (i < n4) {
                const ge::u32x2 iw = *(const ge::u32x2*)(idx + 4 * i);
                se[u] = (f32x4){us[iw.x & 0xffffu], us[iw.x >> 16], us[iw.y & 0xffffu], us[iw.y >> 16]};
#pragma unroll
                for (int k = 0; k < 8; ++k) pv[u][k] = *(const ge::u32x2*)(partial + (size_t)k * T * 128 + 4 * i);
                gv[u] = *(const f32x4*)(gate + 4 * i); rs[u] = sum16(ssp2 + (i >> 5) * 16);
            } }
#pragma unroll
        for (int u = 0; u < 2; ++u) { const size_t i = i0 + u * stride;
            if (i < n4) {
                f32x4 s = {0.f, 0.f, 0.f, 0.f};
#pragma unroll
                for (int k = 0; k < 8; ++k) { s.x += __uint_as_float(pv[u][k].x << 16); s.y += __uint_as_float(pv[u][k].x & 0xffff0000u); s.z += __uint_as_float(pv[u][k].y << 16); s.w += __uint_as_float(pv[u][k].y & 0xffff0000u); }
                const float sc = rsqrtf(rs[u] * (1.f / D) + EPS);
                f32x4 o; o.x = gelu_fast(s.x * sc * se[u].x) * gv[u].x * CSCALE; o.y = gelu_fast(s.y * sc * se[u].y) * gv[u].y * CSCALE; o.z = gelu_fast(s.z * sc * se[u].z) * gv[u].z * CSCALE; o.w = gelu_fast(s.w * sc * se[u].w) * gv[u].w * CSCALE;
                const unsigned hi = pack4_fp8(o.x, o.y, o.z, o.w);
                *(ge::u32x2*)(coef8 + 4 * i) = (ge::u32x2){(hi & 0xffu) | ((hi & 0xff00u) << 8), ((hi >> 16) & 0xffu) | ((hi >> 8) & 0xff0000u)};
            } }
    }
}

template <int MODE = 0>
__device__ __forceinline__ void ph_peer_v(LAS unsigned char* lds, const unsigned char* __restrict__ PV8, const unsigned short* __restrict__ idx, const unsigned short* __restrict__ coef8, const bf16_t* hin, bf16_t* hb, float* __restrict__ ssp1, int imask = 0x7fffffff) {
    PH_IDS
    const int lane = TIDX & 63, wave = __builtin_amdgcn_readfirstlane(TIDX >> 6), c8 = lane & 7, rg = lane >> 3;
    int slice, gw, ngw; peer_split(lds, BIDX, GDIM, wave, slice, gw, ngw);
    const unsigned char* tab = PV8 + (size_t)slice * NEXP * 128; const unsigned lo16 = 16u * c8;
    LAS int* li = (LAS int*)(lds + wave * 16384);
    LAS unsigned short* lc = (LAS unsigned short*)(lds + wave * 16384 + 8192);
    LAS unsigned* lr = (LAS unsigned*)(lds + wave * 16384 + 12288);
    LAS float* tr = (LAS float*)(lds + ge::ROWF_OFF + wave * 1024);
    const int ntok = gw < T ? (T - gw + ngw - 1) / ngw : 0;
    const int p0 = 2 * lane, sd0 = (p0 >> 6) * 64 + (p0 & 7) * 8 + ((p0 & 63) >> 3), sd1 = sd0 + 8;
    const unsigned bsh = 8u * (c8 & 3), mlo = c8 < 4 ? 0xffffffffu : 0u, mhi = ~mlo;
    const int nn = lane & 15, qq = lane >> 4; const bool dvalid = (nn >> 3) == (qq >> 1);
    const int dcol = 64 * (qq & 1) + (nn & 7);
#define PV_SLOAD(k, IW, CW, RW) do { const size_t ts_ = (size_t)gw + (size_t)min((k), ntok - 1) * ngw; IW = *(const unsigned*)(idx + ts_ * 128 + 2 * lane); CW = *(const unsigned*)(coef8 + ts_ * 128 + 2 * lane); \
            RW = *(const unsigned*)(hin + ts_ * D + 128 * slice + 2 * lane); } while (0)
#define PV_SWRITE(k, IW, CW, RW) do { const int o_ = ((k) & (PB - 1)) * 128; li[o_ + sd0] = (int)((IW) & 0xffffu) & imask; li[o_ + sd1] = (int)((IW) >> 16) & imask; \
            lc[o_ + sd0] = (unsigned short)((CW) & 0xffffu); lc[o_ + sd1] = (unsigned short)((CW) >> 16); lr[((k) & (PB - 1)) * 64 + lane] = (RW); } while (0)
#define PV_ISSUE(s, B) do { const ge::u32x4 ia_ = *(const LAS ge::u32x4*)(li + (((s) >> 1) & (2 * PB - 1)) * 64 + rg * 8 + 4 * ((s) & 1)); \
            _Pragma("unroll") for (int i_ = 0; i_ < 4; ++i_) rb[B][i_] = *(const u32x4*)(tab + (ia_[i_] * 128u + lo16)); } while (0)
#define PV_STEP(s, B, QT, ISS) do { if (ISS) { PV_ISSUE((s) + PV_LOOK, ((B) + PV_LOOK) & 7); asm volatile("" ::: "memory"); __builtin_amdgcn_sched_barrier(0); } \
            const int k_ = (s) >> 2; const size_t t_ = (size_t)gw + (size_t)k_ * ngw; \
            if (QT == 0) { acc0 = (ge::f32x4){0.f, 0.f, 0.f, 0.f}; acc1 = acc0; } \
            const ge::u32x2 cw_ = *(const LAS ge::u32x2*)(lc + (((s) >> 1) & (2 * PB - 1)) * 64 + rg * 8 + 4 * ((s) & 1));                       \
            _Pragma("unroll") for (int i = 0; i < 4; ++i) { const unsigned w_ = (i < 2 ? cw_.x : cw_.y) >> (16 * (i & 1)); \
                const unsigned th_ = (w_ & 0xffu) << bsh, tl_ = ((w_ >> 8) & 0xffu) << bsh; \
                const long bh_ = (long)(((unsigned long long)(th_ & mhi) << 32) | (th_ & mlo)), bl_ = (long)(((unsigned long long)(tl_ & mhi) << 32) | (tl_ & mlo)); \
                const u32x4 av = rb[B][i]; const long a0_ = (long)(((unsigned long long)av.y << 32) | av.x), a1_ = (long)(((unsigned long long)av.w << 32) | av.z); \
                acc0 = __builtin_amdgcn_mfma_f32_16x16x32_fp8_fp8(a0_, bh_, acc0, 0, 0, 0); acc1 = __builtin_amdgcn_mfma_f32_16x16x32_fp8_fp8(a1_, bh_, acc1, 0, 0, 0); \
                if (PV_LO) { acc0 = __builtin_amdgcn_mfma_f32_16x16x32_fp8_fp8(a0_, bl_, acc0, 0, 0, 0); acc1 = __builtin_amdgcn_mfma_f32_16x16x32_fp8_fp8(a1_, bl_, acc1, 0, 0, 0); } } \
            if (QT == 3) { \
                if (dvalid) { LAS float* tp_ = tr + 128 * (qq >> 1) + dcol; _Pragma("unroll") for (int i = 0; i < 4; ++i) { tp_[16 * i] = acc0[i]; tp_[16 * i + 8] = acc1[i]; } } \
                const f32x2 e0_ = *(const LAS f32x2*)(tr + 2 * lane), e1_ = *(const LAS f32x2*)(tr + 128 + 2 * lane);                 \
                const unsigned hv = lr[(k_ & (PB - 1)) * 64 + lane];                                                                     \
                const unsigned w2_ = pk2(__uint_as_float(hv << 16) + (e0_.x + e1_.x) * (1.f / (VSCALE * CSCALE)), __uint_as_float(hv & 0xffff0000u) + (e0_.y + e1_.y) * (1.f / (VSCALE * CSCALE))); \
                *(unsigned*)(hb + t_ * D + 128 * slice + 2 * lane) = w2_; const float x0 = __uint_as_float(w2_ << 16), x1 = __uint_as_float(w2_ & 0xffff0000u); \
                float sq = x0 * x0 + x1 * x1; sq = wave_sum(sq); if (lane == 0) ssp1[t_ * 8 + slice] = sq; } \
            asm volatile("" : "+v"(acc0), "+v"(acc1) :: "memory");             \
            __builtin_amdgcn_sched_barrier(0); } while (0)
    if (ntok >= 8 && !(ntok & 1)) {
        u32x4 rb[8][4]; ge::f32x4 acc0, acc1; unsigned xi, xc, xr, yi, yc, yr;
        { unsigned a_[6], b_[6], c_[6];
#pragma unroll
            for (int k = 0; k < 6; ++k) PV_SLOAD(k, a_[k], b_[k], c_[k]);
            PV_SLOAD(6, xi, xc, xr); PV_SLOAD(7, yi, yc, yr);
#pragma unroll
            for (int k = 0; k < 6; ++k) PV_SWRITE(k, a_[k], b_[k], c_[k]); }
        asm volatile("s_waitcnt vmcnt(0) lgkmcnt(0)" ::: "memory");
#define ORD_ asm volatile("" ::: "memory"); __builtin_amdgcn_sched_barrier(0);
        PV_ISSUE(0, 0); ORD_ PV_ISSUE(1, 1); ORD_ PV_ISSUE(2, 2); ORD_ PV_ISSUE(3, 3); ORD_ if (PV_LOOK > 4) { PV_ISSUE(4, 4); ORD_ } if (PV_LOOK > 5) { PV_ISSUE(5, 5); ORD_ } if (PV_LOOK > 6) { PV_ISSUE(6, 6); ORD_ }
#undef ORD_
        const int send = 4 * ntok - 8;
#pragma nounroll
        for (int s0 = 0; s0 < send; s0 += 8) {
            PV_SWRITE((s0 >> 2) + 6, xi, xc, xr); PV_SLOAD((s0 >> 2) + 8, xi, xc, xr);
            PV_STEP(s0, 0, 0, 1); PV_STEP(s0 + 1, 1, 1, 1); PV_STEP(s0 + 2, 2, 2, 1); PV_STEP(s0 + 3, 3, 3, 1);
            PV_SWRITE((s0 >> 2) + 7, yi, yc, yr); PV_SLOAD((s0 >> 2) + 9, yi, yc, yr);
            PV_STEP(s0 + 4, 4, 0, 1); PV_STEP(s0 + 5, 5, 1, 1); PV_STEP(s0 + 6, 6, 2, 1); PV_STEP(s0 + 7, 7, 3, 1); }
        { const int s0 = send; PV_STEP(s0, 0, 0, (0 + PV_LOOK <= 7)); PV_STEP(s0 + 1, 1, 1, (1 + PV_LOOK <= 7)); PV_STEP(s0 + 2, 2, 2, (2 + PV_LOOK <= 7)); PV_STEP(s0 + 3, 3, 3, 0); PV_STEP(s0 + 4, 4, 0, 0); PV_STEP(s0 + 5, 5, 1, 0); PV_STEP(s0 + 6, 6, 2, 0); PV_STEP(s0 + 7, 7, 3, 0); }
    } else {
        u32x4 rb[8][4]; ge::f32x4 acc0, acc1;
#pragma nounroll
        for (int k = 0; k < ntok; ++k) {
            { unsigned a_, b_, c_; PV_SLOAD(k, a_, b_, c_); PV_SWRITE(k, a_, b_, c_); } asm volatile("s_waitcnt vmcnt(0) lgkmcnt(0)" ::: "memory");
            const int s0 = 4 * k; PV_ISSUE(s0, 0); PV_ISSUE(s0 + 1, 1); PV_ISSUE(s0 + 2, 2); PV_ISSUE(s0 + 3, 3);
            PV_STEP(s0, 0, 0, 0); PV_STEP(s0 + 1, 1, 1, 0); PV_STEP(s0 + 2, 2, 2, 0); PV_STEP(s0 + 3, 3, 3, 0); }
    }
#undef PV_SLOAD
#undef PV_SWRITE
#undef PV_ISSUE
#undef PV_STEP
    asm volatile("s_waitcnt lgkmcnt(0)" ::: "memory");
}

__device__ __forceinline__ void ph_final(const bf16_t* __restrict__ hb, const float* __restrict__ ssp1, const float* __restrict__ g, float* __restrict__ out) {
    PH_IDS
    const int lane = TIDX & 63, gw = BIDX * 8 + __builtin_amdgcn_readfirstlane(TIDX >> 6), ngw = GDIM * 8;
    for (int w = gw; w < T; w += ngw) {
        const float rs = rsqrtf(sum8(ssp1 + (size_t)w * 8) * (1.f / D) + EPS);
        const u32x4* r = (const u32x4*)(hb + (size_t)w * D) + lane; const f32x4* gg = (const f32x4*)g; f32x4* o = (f32x4*)(out + (size_t)w * D);
#pragma unroll
        for (int j = 0; j < 2; ++j) { const u32x4 v = r[64 * j]; const int c4 = (64 * j + lane) * 2; const f32x4 g0 = gg[c4], g1 = gg[c4 + 1];
            o[c4] = (f32x4){__uint_as_float(v.x << 16) * rs * g0.x, __uint_as_float(v.x & 0xffff0000u) * rs * g0.y, __uint_as_float(v.y << 16) * rs * g0.z, __uint_as_float(v.y & 0xffff0000u) * rs * g0.w};
            o[c4 + 1] = (f32x4){__uint_as_float(v.z << 16) * rs * g1.x, __uint_as_float(v.z & 0xffff0000u) * rs * g1.y, __uint_as_float(v.w << 16) * rs * g1.z, __uint_as_float(v.w & 0xffff0000u) * rs * g1.w}; }
    }
}
}
namespace attn_body {
using bf16=__hip_bfloat16;
using bf16x8=__attribute__((ext_vector_type(8)))short;
using s16x4=__attribute__((ext_vector_type(4)))short;
using f32x16=__attribute__((ext_vector_type(16)))float;
using u32x4=__attribute__((ext_vector_type(4)))unsigned;
constexpr int BATCH=8,NHEAD=8,SEQ=4096,D=64,DM=NHEAD*D;
constexpr int OPITCH=1024,OCOL=512;
constexpr int NW=8,QBLK=32,QB=QBLK*NW,KVBLK=64,NQB=SEQ/QB;
constexpr int ATTN_PITCH=DM, ATTN_UNIT_ROWS=QB;
__device__ __forceinline__ int crow(int r,int hi){return (r&3)+8*(r>>2)+4*hi;}
#define SBAR() __builtin_amdgcn_sched_barrier(0)
__device__ __forceinline__ void cmask(f32x16&p0,f32x16&p1,int jb,int qrel,int hi){
  const float NEG=-INFINITY; int kb=64*jb+4*hi;
  #pragma unroll
  for(int r=0;r<16;++r){int kv=kb+(r&3)+8*(r>>2); if(kv>qrel)p0[r]=NEG; if(kv+32>qrel)p1[r]=NEG;}
}

constexpr int NSLOT=3, SLOTB=8192;
constexpr int LDS_K=0, LDS_V=NSLOT*SLOTB, LDS_WS=2*NSLOT*SLOTB, LDS_OST=LDS_WS+NW*64*4, LDS_CUM=LDS_OST+NW*4096, LDS_BYTES=LDS_CUM+SEQ*4;
constexpr float PRUNE_T=64.f;
constexpr float C2=0.125f*1.4426950408889634f;
__device__ __forceinline__ void glds16(const void*gsrc,unsigned lds_dst){unsigned keep;
  asm volatile("s_mov_b32 %0, m0\n\ts_mov_b32 m0, %2\n\ts_nop 0\n\tglobal_load_lds_dwordx4 %1, off\n\ts_mov_b32 m0, %0":"=&s"(keep):"v"(gsrc),"s"(lds_dst):"memory");}
__device__ __forceinline__ float max3f(float a,float b,float c){float r;asm("v_max3_f32 %0, %1, %2, %3":"=v"(r):"v"(a),"v"(b),"v"(c));return r;}
__device__ __forceinline__ float max2f(float a,float b){float r;asm("v_max_f32_e32 %0, %1, %2":"=v"(r):"v"(a),"v"(b));return r;}
__device__ __forceinline__ float fadd_s(float a,float b){float r;asm("v_add_f32_e32 %0, %1, %2":"=v"(r):"v"(a),"v"(b));return r;}
__device__ __forceinline__ float fsub_s(float a,float b){float r;asm("v_sub_f32_e32 %0, %1, %2":"=v"(r):"v"(a),"v"(b));return r;}
typedef float f32x4_t __attribute__((ext_vector_type(4)));
typedef float f32x2_t __attribute__((ext_vector_type(2))); typedef __bf16 bf16x2_t __attribute__((ext_vector_type(2)));
__device__ __forceinline__ unsigned cvtpk_s(float lo,float hi){f32x2_t v={lo,hi};bf16x2_t b=__builtin_convertvector(v,bf16x2_t);return __builtin_bit_cast(unsigned,b);}
#define WAIT_BAR(N) asm volatile("s_waitcnt vmcnt(" #N ") lgkmcnt(0)\n\ts_barrier":::"memory")

__device__ __forceinline__ void qkt(f32x16&p0,f32x16&p1,const char*Kslot,const bf16x8*qr,const f32x16&negm,int r32,int hi){
  const char*kb=Kslot+hi*1024+r32*16;
  #pragma unroll
  for(int d0=0;d0<4;++d0){
    const bf16x8 b0=*reinterpret_cast<const bf16x8*>(kb+d0*2048);
    const bf16x8 b1=*reinterpret_cast<const bf16x8*>(kb+d0*2048+512);
    if(d0==0){p0=__builtin_amdgcn_mfma_f32_32x32x16_bf16(b0,qr[0],negm,0,0,0);p1=__builtin_amdgcn_mfma_f32_32x32x16_bf16(b1,qr[0],negm,0,0,0);}
    else{p0=__builtin_amdgcn_mfma_f32_32x32x16_bf16(b0,qr[d0],p0,0,0,0);p1=__builtin_amdgcn_mfma_f32_32x32x16_bf16(b1,qr[d0],p1,0,0,0);}}
}
typedef __attribute__((address_space(3))) const char* lds_cptr;
typedef short v4i16_t __attribute__((ext_vector_type(4)));
__device__ __forceinline__ void kload8(bf16x8*kf,lds_cptr kp){
  kf[0]=*(const __attribute__((address_space(3))) bf16x8*)(kp);      kf[1]=*(const __attribute__((address_space(3))) bf16x8*)(kp+512);
  kf[2]=*(const __attribute__((address_space(3))) bf16x8*)(kp+2048); kf[3]=*(const __attribute__((address_space(3))) bf16x8*)(kp+2560);
  kf[4]=*(const __attribute__((address_space(3))) bf16x8*)(kp+4096); kf[5]=*(const __attribute__((address_space(3))) bf16x8*)(kp+4608);
  kf[6]=*(const __attribute__((address_space(3))) bf16x8*)(kp+6144); kf[7]=*(const __attribute__((address_space(3))) bf16x8*)(kp+6656);
}
__device__ __forceinline__ void kload2(bf16x8*kf,lds_cptr kp,int j){ kf[2*j]=*(const __attribute__((address_space(3))) bf16x8*)(kp+j*2048); kf[2*j+1]=*(const __attribute__((address_space(3))) bf16x8*)(kp+j*2048+512); }
__device__ __forceinline__ s16x4 vtr(lds_cptr p){ return __builtin_bit_cast(s16x4,__builtin_amdgcn_ds_read_tr16_b64_v4i16((__attribute__((address_space(3))) v4i16_t*)p)); }
__device__ __forceinline__ float rowmax(const f32x16&p0,const f32x16&p1){
  float a=max3f(p0[0],p0[1],p1[0]),b=max3f(p0[2],p0[3],p1[1]);a=max3f(a,p1[2],p1[3]);
  #pragma unroll
  for(int r=4;r<16;r+=4){a=max3f(a,p0[r],p0[r+1]);b=max3f(b,p0[r+2],p0[r+3]);a=max3f(a,p1[r],p1[r+1]);b=max3f(b,p1[r+2],p1[r+3]);}
  const float m=max2f(a,b);
  auto rr=__builtin_amdgcn_permlane32_swap(__float_as_uint(m),__float_as_uint(m),false,false);
  return max2f(__uint_as_float(rr[0]),__uint_as_float(rr[1]));
}
__device__ __forceinline__ void pv(f32x16*o,int vb,bf16x8 pa0,bf16x8 pa1,bf16x8 pa2,bf16x8 pa3){
  #pragma unroll
  for(int d0=0;d0<2;++d0){s16x4 lo[4],hi[4];
    #pragma unroll
    for(int ks=0;ks<4;++ks){
      asm volatile("ds_read_b64_tr_b16 %0,%1 offset:%c2":"=&v"(lo[ks]):"v"(vb),"i"(d0*4096+ks*1024):"memory");
      asm volatile("ds_read_b64_tr_b16 %0,%1 offset:%c2":"=&v"(hi[ks]):"v"(vb),"i"(d0*4096+ks*1024+512):"memory");}
    asm volatile("s_waitcnt lgkmcnt(0)":::"memory");SBAR();
    #define PK(k) (bf16x8){lo[k][0],lo[k][1],lo[k][2],lo[k][3],hi[k][0],hi[k][1],hi[k][2],hi[k][3]}
    o[d0]=__builtin_amdgcn_mfma_f32_32x32x16_bf16(pa0,PK(0),o[d0],0,0,0);
    o[d0]=__builtin_amdgcn_mfma_f32_32x32x16_bf16(pa1,PK(1),o[d0],0,0,0);
    o[d0]=__builtin_amdgcn_mfma_f32_32x32x16_bf16(pa2,PK(2),o[d0],0,0,0);
    o[d0]=__builtin_amdgcn_mfma_f32_32x32x16_bf16(pa3,PK(3),o[d0],0,0,0);
    #undef PK
  }
}

#ifndef ATTN_STORE16
#define ATTN_STORE16(p,v) (*(u32x4*)(p)=(v))
#endif
template<int THRL> __device__ __forceinline__ void attn_unit(int b,int h,int qb,const bf16*Q,const bf16*__restrict__ K,const bf16*__restrict__ V,const float*__restrict__ cum2,bf16*O,float*__restrict__ ssp,char*shm,int tid_){
  int tid=tid_; asm volatile("":"+v"(tid)); const int lane=tid&63,r32=lane&31,hi=lane>>5; const int wid=__builtin_amdgcn_readfirstlane(tid>>6);
  const long rowbase=(long)b*SEQ; const int q0=qb*QB;
  const bf16*Qw=Q+(rowbase+q0+wid*QBLK)*DM+h*D;
  const bf16*Kh=K+rowbase*DM+h*D,*Vh=V+rowbase*DM+h*D;
  const unsigned lds0=(unsigned)(uintptr_t)shm;
  float*wsf=(float*)(shm+LDS_WS)+wid*64;
  const int NTf=(q0+QB)/KVBLK; const float*cg=cum2+(long)(b*NHEAD+h)*SEQ;
  int ts; { const float thr=cg[q0]+PRUNE_T; const float ce=lane<NTf?cg[64*lane+63]:0.f; const unsigned long long m_=__ballot((lane<NTf)&&(ce<=thr));
    ts=m_?(int)__builtin_ctzll(m_):0; ts&=~1; if(ts>NTf-4)ts=NTf-4; ts=__builtin_amdgcn_readfirstlane(ts); }
  const bf16*ksrc=Kh+(long)(ts*KVBLK+lane)*DM+wid*8;
  const bf16*vsrc=Vh+(long)(ts*KVBLK+16*(wid&3)+(lane>>2))*DM+(wid>>2)*32+(lane&3)*8;
  const unsigned kdst=lds0+LDS_K+wid*1024, vdst=lds0+LDS_V+wid*1024;
  #define DMA_K(t,slot) glds16(ksrc+(long)(t)*KVBLK*DM,(unsigned)__builtin_amdgcn_readfirstlane(kdst+(slot)))
  #define DMA_V(t,slot) glds16(vsrc+(long)(t)*KVBLK*DM,(unsigned)__builtin_amdgcn_readfirstlane(vdst+(slot)))
  const int vb0=(int)(lds0+LDS_V)+((lane>>4)&1)*32+(lane&3)*8+(4*hi+((lane&15)>>2))*64;
  const char*Kbase=shm+LDS_K; bf16x8 kf[8];
  const lds_cptr shm3=(lds_cptr)shm; const lds_cptr kp0=shm3+LDS_K+hi*1024+r32*16; const lds_cptr vp0=shm3+LDS_V+((lane>>4)&1)*32+(lane&3)*8+(4*hi+((lane&15)>>2))*64;
  { float*cl=(float*)(shm+LDS_CUM); for(int i=tid+ts*KVBLK;i<q0+QB;i+=NW*64)cl[i-ts*KVBLK]=cg[i]; }
  const float cq2=cg[q0+wid*QBLK+r32];
  const __attribute__((address_space(3))) float* ckl=(const __attribute__((address_space(3))) float*)(shm3+LDS_CUM)+4*hi;
  #define BIAS(P0,P1,t) do{ const __attribute__((address_space(3))) float*ck_=ckl+64*(t); const float mm_=mhat-cq2; _Pragma("unroll") for(int g_=0;g_<4;++g_){ \
      const f32x4_t c0_=*(const __attribute__((address_space(3))) f32x4_t*)(ck_+8*g_)+mm_, c1_=*(const __attribute__((address_space(3))) f32x4_t*)(ck_+32+8*g_)+mm_; \
      _Pragma("unroll") for(int i_=0;i_<4;++i_){P0[4*g_+i_]-=c0_[i_];P1[4*g_+i_]-=c1_[i_];} SBAR(); } }while(0)
  const int NT=NTf-ts;
  DMA_K(0,0);DMA_V(0,0);DMA_K(1,SLOTB);
  bf16x8 qr[4];
  #pragma unroll
  for(int d0=0;d0<4;++d0)qr[d0]=*reinterpret_cast<const bf16x8*>(&Qw[(long)r32*DM+d0*16+hi*8]);
  float mhat=0.f,l_reg=0.f;f32x16 o[2];o[0]=f32x16{};o[1]=f32x16{};const f32x16 negm=f32x16{};
  const int qrel=wid*QBLK+r32;
  #define CMASK(P0,P1,t) do{int jb_=(t)-(NT-4); if(jb_>=0)cmask(P0,P1,jb_,qrel,hi);}while(0)
  bool resc=false;
  #define START(P0,P1) do{ const float rm=rowmax(P0,P1); resc=false; \
    { const float dl=rm; mhat=fadd_s(mhat,dl); \
      _Pragma("unroll") for(int r=0;r<16;++r){P0[r]=fsub_s(P0[r],dl);P1[r]=fsub_s(P1[r],dl);} \
      } \
    _Pragma("unroll") for(int r=0;r<16;++r)P0[r]=__builtin_amdgcn_exp2f(P0[r]); }while(0)
  #define RESC() do{ if(resc){ asm volatile("s_waitcnt lgkmcnt(0)":::"memory"); \
      _Pragma("unroll") for(int d_=0;d_<2;++d_) _Pragma("unroll") for(int r=0;r<16;++r)o[d_][r]*=wsf[crow(r,hi)]; } }while(0)
  f32x16 pA0,pA1,pB0,pB1;
  int sl_prev=0,sl_cur=0,sl_next=SLOTB;
  #define ROT() do{sl_prev=sl_cur;sl_cur=sl_next;sl_next=(sl_next==(NSLOT-1)*SLOTB)?0:sl_next+SLOTB;}while(0)
  DMA_K(2,2*SLOTB);
  WAIT_BAR(3);
  qkt(pA0,pA1,Kbase,qr,negm,r32,hi);asm volatile("s_nop 15\n\ts_nop 7":"+v"(pA0),"+v"(pA1));BIAS(pA0,pA1,0);CMASK(pA0,pA1,0);
  START(pA0,pA1);
  _Pragma("unroll") for(int r=0;r<16;++r)pA1[r]=__builtin_amdgcn_exp2f(pA1[r]);
  WAIT_BAR(0);
  DMA_K(3,0);DMA_V(1,SLOTB);
  ROT();
  kload8(kf,kp0+sl_cur);
  WAIT_BAR(2);
  s16x4 vlo[8],vhi[8]; u32x4 pw0,pw1,pw2,pw3;
  #define PKW(P,B) cvtpk_s(P[B],P[B+1])
  #define PAF(k) __builtin_bit_cast(bf16x8,pw##k)
  #define VFR(i) (bf16x8){vlo[i][0],vlo[i][1],vlo[i][2],vlo[i][3],vhi[i][0],vhi[i][1],vhi[i][2],vhi[i][3]}
  #define PIN(x) asm volatile("":"+v"(x))
  #define MX3(a,b,c) __builtin_fmaxf(__builtin_fmaxf((a),(b)),(c))
  #define GAPA(MF,A0,A1,A2,A3,W0,W1,PW) do{ MF; sacc+=A0; sacc+=A1; sacc+=A2; sacc+=A3; PIN(sacc); W0; W1; PIN(PW); SBAR(); }while(0)
  #define EX(v) __builtin_amdgcn_exp2f(v)
  #define GAPB(MF,X,B) do{ MF; X[B]=EX(X[B]); X[B+1]=EX(X[B+1]); X[B+2]=EX(X[B+2]); X[B+3]=EX(X[B+3]); PIN(X); SBAR(); }while(0)
  #define VRD(i) do{ vlo[i]=vtr(vp_+(((i)>>2)*4096+((i)&3)*1024)); vhi[i]=vtr(vp_+(((i)>>2)*4096+((i)&3)*1024+512)); }while(0)
  #define KRD(G,j) do{ if(G){ kload2(kf,kp0+sl_next,j); SBAR(); } }while(0)
  #define STEP(C0,C1,P0,P1,t,GK,GV,GL) do{ SBAR(); \
    const lds_cptr vp_=vp0+sl_prev; \
    VRD(0); SBAR(); float sacc=(P0[0]+P0[1]); \
    GAPA(C0=__builtin_amdgcn_mfma_f32_32x32x16_bf16(kf[0],qr[0],negm,0,0,0), P0[2],P0[3],P0[4],P0[5],     pw0[0]=PKW(P0,0), pw0[1]=PKW(P0,2), pw0); \
    VRD(4); SBAR(); GAPA(C1=__builtin_amdgcn_mfma_f32_32x32x16_bf16(kf[1],qr[0],negm,0,0,0), P0[6],P0[7],P0[8],P0[9],     pw0[2]=PKW(P0,4), pw0[3]=PKW(P0,6), pw0); \
    VRD(1); SBAR(); GAPA(C0=__builtin_amdgcn_mfma_f32_32x32x16_bf16(kf[2],qr[1],C0,0,0,0),   P0[10],P0[11],P0[12],P0[13], pw1[0]=PKW(P0,8), pw1[1]=PKW(P0,10), pw1); \
    VRD(5); SBAR(); GAPA(C1=__builtin_amdgcn_mfma_f32_32x32x16_bf16(kf[3],qr[1],C1,0,0,0),   P0[14],P0[15],P1[0],P1[1],   pw1[2]=PKW(P0,12),pw1[3]=PKW(P0,14), pw1); \
    VRD(2); SBAR(); GAPA(C0=__builtin_amdgcn_mfma_f32_32x32x16_bf16(kf[4],qr[2],C0,0,0,0),   P1[2],P1[3],P1[4],P1[5],     pw2[0]=PKW(P1,0), pw2[1]=PKW(P1,2), pw2); \
    VRD(6); SBAR(); GAPA(C1=__builtin_amdgcn_mfma_f32_32x32x16_bf16(kf[5],qr[2],C1,0,0,0),   P1[6],P1[7],P1[8],P1[9],     pw2[2]=PKW(P1,4), pw2[3]=PKW(P1,6), pw2); \
    VRD(3); SBAR(); GAPA(C0=__builtin_amdgcn_mfma_f32_32x32x16_bf16(kf[6],qr[3],C0,0,0,0),   P1[10],P1[11],P1[12],P1[13], pw3[0]=PKW(P1,8), pw3[1]=PKW(P1,10), pw3); \
    VRD(7); SBAR(); GAPA(C1=__builtin_amdgcn_mfma_f32_32x32x16_bf16(kf[7],qr[3],C1,0,0,0),   P1[14],P1[15],0.f,0.f,       pw3[2]=PKW(P1,12),pw3[3]=PKW(P1,14), pw3); \
    l_reg+=sacc; \
    if(GK){DMA_K((t)+3,sl_cur);} if(GV){DMA_V((t)+1,sl_next);} \
    BIAS(C0,C1,t); CMASK(C0,C1,t); \
    { float a=MX3(C0[0],C0[1],C1[0]),b=MX3(C0[2],C0[3],C1[1]); a=MX3(a,C1[2],C1[3]); \
      _Pragma("unroll") for(int r=4;r<16;r+=4){a=MX3(a,C0[r],C0[r+1]);b=MX3(b,C0[r+2],C0[r+3]);a=MX3(a,C1[r],C1[r+1]);b=MX3(b,C1[r+2],C1[r+3]);} \
      float rm=__builtin_fmaxf(a,b); { auto rr=__builtin_amdgcn_permlane32_swap(__float_as_uint(rm),__float_as_uint(rm),false,false); rm=__builtin_fmaxf(__uint_as_float(rr[0]),__uint_as_float(rr[1])); } \
      resc=false; \
      if(__builtin_expect(__any(rm>(float)THRL),0)){ const float dl=__builtin_fmaxf(rm,0.f); mhat+=dl; \
        _Pragma("unroll") for(int r=0;r<16;++r){C0[r]-=dl;C1[r]-=dl;} \
        const float f=__builtin_amdgcn_exp2f(-dl); l_reg*=f; if(hi==0)wsf[r32]=f; resc=true; } } \
    SBAR(); \
    GAPB(o[0]=__builtin_amdgcn_mfma_f32_32x32x16_bf16(PAF(0),VFR(0),o[0],0,0,0), C0,0); \
    GAPB(o[1]=__builtin_amdgcn_mfma_f32_32x32x16_bf16(PAF(0),VFR(4),o[1],0,0,0), C0,4); \
    KRD(GL,0); GAPB(o[0]=__builtin_amdgcn_mfma_f32_32x32x16_bf16(PAF(1),VFR(1),o[0],0,0,0), C0,8); \
    KRD(GL,1); GAPB(o[1]=__builtin_amdgcn_mfma_f32_32x32x16_bf16(PAF(1),VFR(5),o[1],0,0,0), C0,12); \
    KRD(GL,2); GAPB(o[0]=__builtin_amdgcn_mfma_f32_32x32x16_bf16(PAF(2),VFR(2),o[0],0,0,0), C1,0); \
    KRD(GL,3); GAPB(o[1]=__builtin_amdgcn_mfma_f32_32x32x16_bf16(PAF(2),VFR(6),o[1],0,0,0), C1,4); \
    GAPB(o[0]=__builtin_amdgcn_mfma_f32_32x32x16_bf16(PAF(3),VFR(3),o[0],0,0,0), C1,8); \
    GAPB(o[1]=__builtin_amdgcn_mfma_f32_32x32x16_bf16(PAF(3),VFR(7),o[1],0,0,0), C1,12); \
    }while(0)
  int t=1;
  #undef CMASK
  #define CMASK(P0,P1,t) do{}while(0)
  for(;t+5<NT;t+=2){
    STEP(pB0,pB1,pA0,pA1,t,true,true,true);     WAIT_BAR(2); RESC(); ROT();
    STEP(pA0,pA1,pB0,pB1,t+1,true,true,true);   WAIT_BAR(2); RESC(); ROT();
  }
  #undef CMASK
  #define CMASK(P0,P1,t) do{int jb_=(t)-(NT-4); if(jb_>=0)cmask(P0,P1,jb_,qrel,hi);}while(0)
  #define ENDW(tt) do{ if((tt)+3<NT){WAIT_BAR(2);} else if((tt)+2<NT){WAIT_BAR(1);} else {WAIT_BAR(0);} }while(0)
  for(;t+1<NT;t+=2){
    STEP(pB0,pB1,pA0,pA1,t,(t+3<NT),(t+1<NT),(t+1<NT));       ENDW(t);   RESC(); ROT();
    STEP(pA0,pA1,pB0,pB1,t+1,(t+4<NT),(t+2<NT),(t+2<NT));     ENDW(t+1); RESC(); ROT();
  }
  STEP(pB0,pB1,pA0,pA1,NT-1,false,false,false); RESC();
  { float sacc=pB0[0]+pB0[1]; _Pragma("unroll") for(int r=2;r<16;++r)sacc+=pB0[r]; _Pragma("unroll") for(int r=0;r<16;++r)sacc+=pB1[r]; l_reg+=sacc;
    pw0=(u32x4){PKW(pB0,0),PKW(pB0,2),PKW(pB0,4),PKW(pB0,6)};pw1=(u32x4){PKW(pB0,8),PKW(pB0,10),PKW(pB0,12),PKW(pB0,14)};pw2=(u32x4){PKW(pB1,0),PKW(pB1,2),PKW(pB1,4),PKW(pB1,6)};pw3=(u32x4){PKW(pB1,8),PKW(pB1,10),PKW(pB1,12),PKW(pB1,14)};
    SBAR(); pv(o,vb0+sl_cur,PAF(0),PAF(1),PAF(2),PAF(3)); }
  #undef PKW
  #undef PAF
  #undef VFR
  #undef PIN
  #undef MX3
  #undef GAPA
  #undef GAPB
  #undef EX
  #undef VRD
  #undef KRD
  #undef STEP
  #undef ENDW
  {auto rr=__builtin_amdgcn_permlane32_swap(__float_as_uint(l_reg),__float_as_uint(l_reg),false,false);l_reg=__uint_as_float(rr[0])+__uint_as_float(rr[1]);}
  if(hi==0)wsf[32+r32]=l_reg;asm volatile("s_waitcnt lgkmcnt(0)":::"memory");
  float rli[16];
  #pragma unroll
  for(int r=0;r<16;++r)rli[r]=__builtin_amdgcn_rcpf(wsf[32+crow(r,hi)]);
  int lane_e=lane; asm volatile("":"+v"(lane_e));
  bf16*Ow=O+(rowbase+q0+wid*QBLK)*OPITCH+OCOL+h*D; float*sw=ssp+(rowbase+q0+wid*QBLK)*8+h;
  { bf16*stg=(bf16*)(shm+LDS_OST)+wid*2048;
    #pragma unroll
    for(int r=0;r<16;++r){const int orow=crow(r,hi);
      #pragma unroll
      for(int d0=0;d0<2;++d0)stg[orow*64+d0*32+r32]=__float2bfloat16(o[d0][r]*rli[r]);}
    asm volatile("s_waitcnt lgkmcnt(0)":::"memory");
    #pragma unroll
    for(int i=0;i<4;++i){const int row=i*8+(lane_e>>3),ch=lane_e&7; const u32x4 v=*(const u32x4*)(stg+row*64+ch*8); ATTN_STORE16(Ow+(long)row*OPITCH+ch*8,v);
      float sq=0.f;
      #pragma unroll
      for(int k=0;k<4;++k){const float a=__uint_as_float(v[k]<<16),c=__uint_as_float(v[k]&0xffff0000u);sq+=a*a+c*c;}
      sq+=__shfl_xor(sq,1);sq+=__shfl_xor(sq,2);sq+=__shfl_xor(sq,4);
      if(ch==0)sw[(long)row*8]=sq; } }
  asm volatile("s_waitcnt lgkmcnt(0)\n\ts_barrier":::"memory");
  #undef DMA_K
  #undef DMA_V
  #undef CMASK
  #undef START
  #undef RESC
  #undef BIAS
  #undef ROT
}
constexpr int ATTN_LDS_BYTES=LDS_BYTES;
template<int THRL=8> __device__ __forceinline__ void attn_phase(char*lds,const bf16*Q,const bf16*K,const bf16*V,const float*cum2,bf16*O,float*ssp,unsigned*ctr,volatile __attribute__((address_space(3))) unsigned*slot,int tid){
  for(;;){
    if(tid==0)*slot=__hip_atomic_fetch_add(ctr,1u,__ATOMIC_RELAXED,__HIP_MEMORY_SCOPE_AGENT);
    __syncthreads();
    const int u=(int)*slot;
    __syncthreads();
    if(u>=BATCH*NHEAD*NQB)break;
    const int qb=NQB-1-(u>>6),h=NHEAD-1-((u>>3)&7),b=u&7;
    attn_unit<THRL>(b,h,qb,Q,K,V,cum2,O,ssp,lds,tid);
  }
}
#undef SBAR
#undef WAIT_BAR
}
namespace nv {
typedef float f32x2v __attribute__((ext_vector_type(2)));
constexpr size_t WS_APOW = 921 * MiB;
constexpr size_t WS_BBAR = 89 * MiB;
constexpr int KDW = 128 * 256;
__device__ __forceinline__ void p0_ssm_a(const float* __restrict__ lam_re, const float* __restrict__ lam_im, const float* __restrict__ log_dt, const float* __restrict__ b_re, const float* __restrict__ b_im,
                                         f32x2v* __restrict__ apow, f32x2v* __restrict__ bbar) {
    PH_IDS
    for (int i = BIDX * 512 + TIDX; i < DEPTH * G * P; i += GDIM * 512) {
        const int lg = i / P, p = i % P;
        const float dtf = expf(log_dt[lg]); const float lr = lam_re[i], li = lam_im[i];
        const double ang = (double)li * (double)dtf, k2 = rint(ang * 0.15915494309189535), red = ang - k2 * 6.283185307179586;
        const float mag = expf(lr * dtf), rr = (float)red; const double are = (double)(mag * cosf(rr)), aim = (double)(mag * sinf(rr));
        double pr = 1.0, pi = 0.0;
        for (int d = 0; d <= 64; ++d) { apow[((size_t)lg * 65 + d) * P + p] = (f32x2v){(float)pr, (float)pi}; const double nr_ = pr * are - pi * aim, ni_ = pr * aim + pi * are; pr = nr_; pi = ni_; }
        const double lrd = lr, lid = li, den = lrd * lrd + lid * lid, nr = are - 1.0, zre = (nr * lrd + aim * lid) / den, zim = (aim * lrd - nr * lid) / den;
        for (int h = 0; h < HC; ++h) { const double br = b_re[(size_t)i * HC + h], bi = b_im[(size_t)i * HC + h]; bbar[(size_t)i * HC + h] = (f32x2v){(float)(zre * br - zim * bi), (float)(zre * bi + zim * br)}; }
    }
}
__device__ __forceinline__ void p0_ssm_b(const f32x2v* __restrict__ apow, const f32x2v* __restrict__ bbar, const float* __restrict__ c_re, const float* __restrict__ c_im, const float* __restrict__ dsk,
                                         bf16_t* __restrict__ KD, bf16_t* __restrict__ WST, bf16_t* __restrict__ WOUT) {
    PH_IDS
    const int gt = BIDX * 512 + TIDX, nth = GDIM * 512;
    for (int i = gt; i < DEPTH * G * KDW; i += nth) {
        const int lg = i / KDW, r = i % KDW, dd = r >> 8, h = (r >> 4) & 15, h2 = r & 15, d = dd - 63;
        float v = 0.f;
        if (d >= 0 && dd < 127) {
            const f32x2v* ap = apow + ((size_t)lg * 65 + d) * P; const f32x2v* bb = bbar + (size_t)lg * P * HC + h2; const float* cr = c_re + ((size_t)lg * HC + h) * P; const float* ci = c_im + ((size_t)lg * HC + h) * P;
            for (int p = 0; p < P; ++p) { const f32x2v a = ap[p], b = bb[(size_t)p * HC]; const float wr = a.x * b.x - a.y * b.y, wi = a.x * b.y + a.y * b.x; v += cr[p] * wr - ci[p] * wi; }
            if (d == 0 && h == h2) v += dsk[lg * HC + h];
        }
        KD[i] = f2bf(v);
    }
    for (int i = gt; i < DEPTH * G * 128 * 256; i += nth) {
        const int lg = i >> 15, r = i & 32767, row = r >> 8, k = r & 255, j = k >> 4, h2 = k & 15, p = row & 63;
        const f32x2v a = apow[((size_t)lg * 65 + (15 - j)) * P + p], b = bbar[((size_t)lg * P + p) * HC + h2];
        WST[i] = f2bf(row < 64 ? a.x * b.x - a.y * b.y : a.x * b.y + a.y * b.x);
    }
    for (int i = gt; i < DEPTH * G * 1024 * 128; i += nth) {
        const int lg = i >> 17, r = i & 131071, row = r >> 7, k = r & 127, ti = row >> 4, h = row & 15, p = k & 63;
        const f32x2v e = apow[((size_t)lg * 65 + ti + 1) * P + p]; const float cr = c_re[((size_t)lg * HC + h) * P + p], ci = c_im[((size_t)lg * HC + h) * P + p];
        WOUT[i] = f2bf(k < 64 ? cr * e.x - ci * e.y : -(cr * e.y + ci * e.x));
    }
}

struct SchedSsmS {
    static constexpr bool DUALB = false; long hA, hB, hB1;
    const char* UP; const char* WST; int G_, c;
    __device__ __forceinline__ void init(const void* up, const void* wst_l, int grid, int bid) { UP = (const char*)up; WST = (const char*)wst_l; G_ = grid; c = bid; hA = 128l * UPW * 2; hB = 0; hB1 = 0; }
    __device__ __forceinline__ bool next(int i, ge::Unit& u) const {
        const int L = i * G_ + c; if (L >= G * 2 * 4) return false;
        const int g = L >> 3, pm = (L >> 2) & 1, ks = L & 3;
        u.A0 = UP + (((size_t)g * NCH + pm * 256) * UPW + 128 + ks * 256) * 2; u.B0 = WST + (size_t)g * 128 * 256 * 2; u.nt = 4; u.pm = pm; u.pn = ks; u.aux = g; return true; }
    __device__ __forceinline__ const char* ta(const ge::Unit& u, int t) const { return u.A0 + t * 128; }
    __device__ __forceinline__ const char* tb(const ge::Unit& u, int t) const { return u.B0 + t * 128; }
    __device__ __forceinline__ bool sb(const ge::Unit&, int) const { return false; }
    __device__ __forceinline__ unsigned voffA(int R, int C) const { return (unsigned)(R * UPW * 2 + C * 2); }
    __device__ __forceinline__ unsigned voffB(int Rb, int C) const { return (unsigned)(Rb * 512 + C * 2); }
    __device__ __forceinline__ unsigned voffB1(int, int) const { return 0u; }
};
struct EpiSsmS {
    static constexpr bool PERM = false, MIDK = false, UBEGIN = false;
    float* SLOC;
    __device__ __forceinline__ void unit_begin(const ge::Unit&, int, LAS unsigned char*) const {}
    __device__ __forceinline__ void midk(ge::f32x4 (&)[2][2][4][2], const ge::Unit&, int, int, LAS unsigned char*) const {}
    __device__ __forceinline__ void operator()(const ge::f32x4 (&acc)[2][2][4][2], const ge::Unit& u, int wr, int wc, int fr, int fq, LAS unsigned char*) const {
        const int g = u.aux, ks = u.pn;
#pragma unroll
        for (int ai = 0; ai < 2; ++ai)
#pragma unroll
            for (int m = 0; m < 4; ++m) {
                const int chunk = u.pm * 256 + ai * 128 + wr * 64 + m * 16 + fr; float* dst = SLOC + ((size_t)g * (NCH * 4) + chunk * 4 + ks) * 128;
#pragma unroll
                for (int n = 0; n < 2; ++n) *(ge::f32x4*)(dst + wc * 32 + 16 * n + 4 * fq) = acc[ai][0][m][n];
            }
    }
};

__device__ __forceinline__ void ph_ssm_prefix(LAS unsigned char* lds, const float* __restrict__ SLOC, const f32x2v* __restrict__ apow_l, bf16_t* __restrict__ UP) {
    PH_IDS
    const int p = TIDX & 63, w = __builtin_amdgcn_readfirstlane(TIDX >> 6);
    LAS f32x2v* ex = (LAS f32x2v*)lds;
    for (int item = BIDX; item < BATCH * G; item += GDIM) {
        const int b = item / G, g = item % G;
        const f32x2v a16 = apow_l[((size_t)g * 65 + 16) * P + p];
        const float* src = SLOC + ((size_t)g * (NCH * 4) + (size_t)b * 256 + 32 * w) * 128 + p; bf16_t* dst = UP + ((size_t)g * NCH + b * 64 + 8 * w) * UPW + p;
        float xr[32], xi[32];
#pragma unroll
        for (int k = 0; k < 32; ++k) { xr[k] = src[(size_t)k * 128]; xi[k] = src[(size_t)k * 128 + 64]; }
        float sr = 0.f, si = 0.f;
#pragma unroll
        for (int k = 0; k < 32; ++k) { const float nr = a16.x * sr - a16.y * si + xr[k], ni = a16.x * si + a16.y * sr + xi[k]; sr = nr; si = ni; }
        ex[w * 64 + p] = (f32x2v){sr, si};
        float qr = a16.x, qi = a16.y;
#pragma unroll
        for (int k = 0; k < 5; ++k) { const float nr = qr * qr - qi * qi, ni = 2.f * qr * qi; qr = nr; qi = ni; }
        __syncthreads();
        sr = 0.f; si = 0.f;
        for (int j = 0; j < w; ++j) { const f32x2v e = ex[j * 64 + p]; const float nr = qr * sr - qi * si + e.x, ni = qr * si + qi * sr + e.y; sr = nr; si = ni; }
#pragma unroll
        for (int k = 0; k < 32; ++k) {
            if ((k & 3) == 0) { bf16_t* d = dst + (size_t)(k >> 2) * UPW; d[0] = f2bf(sr); d[64] = f2bf(si); }
            const float nr = a16.x * sr - a16.y * si + xr[k], ni = a16.x * si + a16.y * sr + xi[k]; sr = nr; si = ni;
        }
        __syncthreads();
    }
}
__device__ __forceinline__ void ph_cum2(const float* __restrict__ logf, float* __restrict__ cum) {
    PH_IDS
    const int lane = TIDX & 63, gw = BIDX * 8 + __builtin_amdgcn_readfirstlane(TIDX >> 6), ngw = GDIM * 8;
    for (int item = gw; item < BATCH * NH; item += ngw) {
        const int b = item / NH, h = item % NH;
        const float* src = logf + ((size_t)b * SEQ + lane * 64) * NH + h; float* dst = cum + (size_t)item * SEQ + lane * 64;
        float tot = 0.f;
        for (int i = 0; i < 64; ++i) tot += src[(size_t)i * NH];
        float ex = tot;
#pragma unroll
        for (int o = 1; o < 64; o <<= 1) { const float y = __shfl_up(ex, o); if (lane >= o) ex += y; }
        float run = ex - tot;
        for (int i = 0; i < 64; ++i) { run += src[(size_t)i * NH]; dst[i] = run * 1.4426950408889634f; }
    }
}

struct SchedSsmC {
    static constexpr bool DUALB = true; long hA, hB, hB1;
    const char* UP; const char* WOUT; const char* KD; int G_, c;
    __device__ __forceinline__ void init(const void* up, const void* wout_l, const void* kd_l, int grid, int bid) { UP = (const char*)up; WOUT = (const char*)wout_l; KD = (const char*)kd_l; G_ = grid; c = bid; hA = 128l * UPW * 2; hB = 128l * 256; hB1 = 8l * 512; }
    __device__ __forceinline__ bool next(int i, ge::Unit& u) const {
        const int L = i * G_ + c; if (L >= G * 2 * 4) return false;
        const int pn = 3 - (L >> 6), g = (L & 63) >> 1, pm = L & 1;
        u.A0 = UP + ((size_t)g * NCH + pm * 256) * UPW * 2; u.B0 = nullptr; u.nt = 2 + 4 * (pn + 1); u.pm = pm; u.pn = pn; u.aux = g; return true; }
    __device__ __forceinline__ const char* ta(const ge::Unit& u, int t) const { return u.A0 + t * 128; }
    __device__ __forceinline__ bool sb(const ge::Unit&, int t) const { return t >= 2; }
    __device__ __forceinline__ const char* tb(const ge::Unit& u, int t) const {
        return t < 2 ? WOUT + ((size_t)u.aux * 1024 + u.pn * 256) * 256 + t * 128 : KD + ((size_t)u.aux * KDW + (size_t)(16 * u.pn - 4 * (t - 2) + 60) * 256) * 2; }
    __device__ __forceinline__ unsigned voffA(int R, int C) const { return (unsigned)(R * UPW * 2 + C * 2); }
    __device__ __forceinline__ unsigned voffB(int Rb, int C) const { return (unsigned)(Rb * 256 + C * 2); }
    __device__ __forceinline__ unsigned voffB1(int Rb, int C) const { return (unsigned)((((Rb >> 4) + 3 - (C >> 4)) * 256 + (Rb & 15) * 16 + (C & 15)) * 2); }
};
__device__ __forceinline__ float gelu_fast(float x) { const float u = 1.5957691216057308f * (x + 0.044715f * x * x * x); return x - x / (1.f + __expf(u)); }
struct EpiSsmC {
    static constexpr bool PERM = true, MIDK = false, UBEGIN = false;
    bf16_t* GEL;
    __device__ __forceinline__ void unit_begin(const ge::Unit&, int, LAS unsigned char*) const {}
    __device__ __forceinline__ void midk(ge::f32x4 (&)[2][2][4][2], const ge::Unit&, int, int, LAS unsigned char*) const {}
    __device__ __forceinline__ void operator()(const ge::f32x4 (&acc)[2][2][4][2], const ge::Unit& u, int wr, int wc, int fr, int fq, LAS unsigned char*) const {
        const int g = u.aux;
#pragma unroll
        for (int ai = 0; ai < 2; ++ai)
#pragma unroll
            for (int m = 0; m < 4; ++m) {
                const int chunk = u.pm * 256 + ai * 128 + wr * 64 + m * 16 + fr;
#pragma unroll
                for (int bj = 0; bj < 2; ++bj) {
                    const int col = u.pn * 256 + bj * 128 + wc * 32 + 8 * fq, ti = col >> 4, h0 = col & 15;
                    const ge::f32x4 v0 = acc[ai][bj][m][0], v1 = acc[ai][bj][m][1];
                    u32x4 w; w.x = ge::cvt_pk_bf16(gelu_fast(v0[0]), gelu_fast(v0[1])); w.y = ge::cvt_pk_bf16(gelu_fast(v0[2]), gelu_fast(v0[3]));
                    w.z = ge::cvt_pk_bf16(gelu_fast(v1[0]), gelu_fast(v1[1])); w.w = ge::cvt_pk_bf16(gelu_fast(v1[2]), gelu_fast(v1[3]));
                    *(u32x4*)(GEL + ((size_t)g * T + chunk * 64 + ti) * HC + h0) = w;
                }
            }
    }
};
}
namespace nv {
#define SEL_CE(x, y) do { const int _h = max((x), (y)), _l = min((x), (y)); (x) = _h; (y) = _l; } while (0)
__device__ __forceinline__ void sel_sort16(int (&v)[16]) {
    SEL_CE(v[0], v[1]);
    SEL_CE(v[2], v[3]);
    SEL_CE(v[0], v[2]);
    SEL_CE(v[1], v[3]);
    SEL_CE(v[1], v[2]);
    SEL_CE(v[4], v[5]);
    SEL_CE(v[6], v[7]);
    SEL_CE(v[4], v[6]);
    SEL_CE(v[5], v[7]);
    SEL_CE(v[5], v[6]);
    SEL_CE(v[0], v[4]);
    SEL_CE(v[2], v[6]);
    SEL_CE(v[2], v[4]);
    SEL_CE(v[1], v[5]);
    SEL_CE(v[3], v[7]);
    SEL_CE(v[3], v[5]);
    SEL_CE(v[1], v[2]);
    SEL_CE(v[3], v[4]);
    SEL_CE(v[5], v[6]);
    SEL_CE(v[8], v[9]);
    SEL_CE(v[10], v[11]);
    SEL_CE(v[8], v[10]);
    SEL_CE(v[9], v[11]);
    SEL_CE(v[9], v[10]);
    SEL_CE(v[12], v[13]);
    SEL_CE(v[14], v[15]);
    SEL_CE(v[12], v[14]);
    SEL_CE(v[13], v[15]);
    SEL_CE(v[13], v[14]);
    SEL_CE(v[8], v[12]);
    SEL_CE(v[10], v[14]);
    SEL_CE(v[10], v[12]);
    SEL_CE(v[9], v[13]);
    SEL_CE(v[11], v[15]);
    SEL_CE(v[11], v[13]);
    SEL_CE(v[9], v[10]);
    SEL_CE(v[11], v[12]);
    SEL_CE(v[13], v[14]);
    SEL_CE(v[0], v[8]);
    SEL_CE(v[4], v[12]);
    SEL_CE(v[4], v[8]);
    SEL_CE(v[2], v[10]);
    SEL_CE(v[6], v[14]);
    SEL_CE(v[6], v[10]);
    SEL_CE(v[2], v[4]);
    SEL_CE(v[6], v[8]);
    SEL_CE(v[10], v[12]);
    SEL_CE(v[1], v[9]);
    SEL_CE(v[5], v[13]);
    SEL_CE(v[5], v[9]);
    SEL_CE(v[3], v[11]);
    SEL_CE(v[7], v[15]);
    SEL_CE(v[7], v[11]);
    SEL_CE(v[3], v[5]);
    SEL_CE(v[7], v[9]);
    SEL_CE(v[11], v[13]);
    SEL_CE(v[1], v[2]);
    SEL_CE(v[3], v[4]);
    SEL_CE(v[5], v[6]);
    SEL_CE(v[7], v[8]);
    SEL_CE(v[9], v[10]);
    SEL_CE(v[11], v[12]);
    SEL_CE(v[13], v[14]);
}
__device__ __forceinline__ void sel_merge16(int (&a)[16], const int (&b)[16]) {
    a[0] = max(a[0], b[15]);
    a[1] = max(a[1], b[14]);
    a[2] = max(a[2], b[13]);
    a[3] = max(a[3], b[12]);
    a[4] = max(a[4], b[11]);
    a[5] = max(a[5], b[10]);
    a[6] = max(a[6], b[9]);
    a[7] = max(a[7], b[8]);
    a[8] = max(a[8], b[7]);
    a[9] = max(a[9], b[6]);
    a[10] = max(a[10], b[5]);
    a[11] = max(a[11], b[4]);
    a[12] = max(a[12], b[3]);
    a[13] = max(a[13], b[2]);
    a[14] = max(a[14], b[1]);
    a[15] = max(a[15], b[0]);
    SEL_CE(a[0], a[8]);
    SEL_CE(a[1], a[9]);
    SEL_CE(a[2], a[10]);
    SEL_CE(a[3], a[11]);
    SEL_CE(a[4], a[12]);
    SEL_CE(a[5], a[13]);
    SEL_CE(a[6], a[14]);
    SEL_CE(a[7], a[15]);
    SEL_CE(a[0], a[4]);
    SEL_CE(a[1], a[5]);
    SEL_CE(a[2], a[6]);
    SEL_CE(a[3], a[7]);
    SEL_CE(a[8], a[12]);
    SEL_CE(a[9], a[13]);
    SEL_CE(a[10], a[14]);
    SEL_CE(a[11], a[15]);
    SEL_CE(a[0], a[2]);
    SEL_CE(a[1], a[3]);
    SEL_CE(a[4], a[6]);
    SEL_CE(a[5], a[7]);
    SEL_CE(a[8], a[10]);
    SEL_CE(a[9], a[11]);
    SEL_CE(a[12], a[14]);
    SEL_CE(a[13], a[15]);
    SEL_CE(a[0], a[1]);
    SEL_CE(a[2], a[3]);
    SEL_CE(a[4], a[5]);
    SEL_CE(a[6], a[7]);
    SEL_CE(a[8], a[9]);
    SEL_CE(a[10], a[11]);
    SEL_CE(a[12], a[13]);
    SEL_CE(a[14], a[15]);
}
constexpr int SEL_NCAND = 50;
#define SEL_CANDS(F) \
    F(0, 0, 0) \
    F(1, 0, 1) \
    F(2, 0, 2) \
    F(3, 0, 3) \
    F(4, 0, 4) \
    F(5, 0, 5) \
    F(6, 0, 6) \
    F(7, 0, 7) \
    F(8, 0, 8) \
    F(9, 0, 9) \
    F(10, 0, 10) \
    F(11, 0, 11) \
    F(12, 0, 12) \
    F(13, 0, 13) \
    F(14, 0, 14) \
    F(15, 0, 15) \
    F(16, 1, 0) \
    F(17, 1, 1) \
    F(18, 1, 2) \
    F(19, 1, 3) \
    F(20, 1, 4) \
    F(21, 1, 5) \
    F(22, 1, 6) \
    F(23, 1, 7) \
    F(24, 2, 0) \
    F(25, 2, 1) \
    F(26, 2, 2) \
    F(27, 2, 3) \
    F(28, 2, 4) \
    F(29, 3, 0) \
    F(30, 3, 1) \
    F(31, 3, 2) \
    F(32, 3, 3) \
    F(33, 4, 0) \
    F(34, 4, 1) \
    F(35, 4, 2) \
    F(36, 5, 0) \
    F(37, 5, 1) \
    F(38, 6, 0) \
    F(39, 6, 1) \
    F(40, 7, 0) \
    F(41, 7, 1) \
    F(42, 8, 0) \
    F(43, 9, 0) \
    F(44, 10, 0) \
    F(45, 11, 0) \
    F(46, 12, 0) \
    F(47, 13, 0) \
    F(48, 14, 0) \
    F(49, 15, 0)
constexpr float SEL_BIAS = 16.f;
__device__ __forceinline__ int f2key(float f) { return __float_as_int(f); }
__device__ __forceinline__ float key2f(int k) { return __int_as_float(k); }
__device__ __forceinline__ void sel_top16(const f32x16 (&acc)[4], int hi, int (&t)[16]) {
    int g1[16], g2[16], g3[16];
#pragma unroll
    for (int r = 0; r < 16; ++r) { const int n = (r & 3) + 8 * (r >> 2) + 4 * hi;
        t[r] = (f2key(acc[0][r]) & ~0x7F) | n; g1[r] = (f2key(acc[1][r]) & ~0x7F) | (32 + n); g2[r] = (f2key(acc[2][r]) & ~0x7F) | (64 + n); g3[r] = (f2key(acc[3][r]) & ~0x7F) | (96 + n); }
    sel_sort16(t); sel_sort16(g1); sel_sort16(g2); sel_sort16(g3);
    sel_merge16(t, g1); sel_merge16(g2, g3); sel_merge16(t, g2);
#pragma unroll
    for (int i = 0; i < 16; ++i) { auto rr = __builtin_amdgcn_permlane32_swap((unsigned)t[i], (unsigned)t[i], false, false); g1[i] = (int)(hi ? rr[0] : rr[1]); }
    sel_merge16(t, g1);
}
__device__ __forceinline__ void ph_select(const bf16_t* __restrict__ QP, const bf16_t* __restrict__ KEYS, unsigned short* __restrict__ idx, float* __restrict__ gate, LAS unsigned char* lds) {
    PH_IDS
    const int lane = TIDX & 63, hd = __builtin_amdgcn_readfirstlane(TIDX >> 6), r = lane & 31, hi = lane >> 5;
    LAS unsigned* my = (LAS unsigned*)(lds + hd * 2048) + lane;
    for (int tg = BIDX; tg < T / 32; tg += GDIM) {
        const int tok0 = tg * 32;
        int rk = r; asm volatile("" : "+v"(rk));
        int t1[16], t2[16];
#pragma unroll
        for (int half = 0; half < 2; ++half) {
            f32x16 acc[4];
#pragma unroll
            for (int mt = 0; mt < 4; ++mt)
#pragma unroll
                for (int i = 0; i < 16; ++i) acc[mt][i] = SEL_BIAS;
            const bf16_t* qb = QP + (size_t)(tok0 + r) * D + hd * QD + half * HALF + 8 * hi;
            const bf16_t* kb = KEYS + ((size_t)(hd * 2 + half) * NK + rk) * HALF + 8 * hi;
#pragma unroll
            for (int ks = 0; ks < 4; ++ks) {
                const bf16x8 b = *(const bf16x8*)(qb + 16 * ks);
#pragma unroll
                for (int mt = 0; mt < 4; ++mt) { const bf16x8 a = *(const bf16x8*)(kb + (size_t)mt * 32 * HALF + 16 * ks); acc[mt] = __builtin_amdgcn_mfma_f32_32x32x16_bf16(a, b, acc[mt], 0, 0, 0); }
            }
            if (half == 0) sel_top16(acc, hi, t1); else sel_top16(acc, hi, t2);
        }
        float f1[16], f2[16];
#pragma unroll
        for (int i = 0; i < 16; ++i) { f1[i] = key2f(t1[i]); f2[i] = key2f(t2[i]); }
        int c0[16], c1[16], c2[16], c3[16];
#pragma unroll
        for (int i = 0; i < 16; ++i) c3[i] = (int)0x80000000;
#define SEL_F(k, i, j) { const int v_ = (f2key(f1[i] + f2[j]) & ~0xFF) | ((i) << 4 | (j)); if ((k) < 16) c0[(k) & 15] = v_; else if ((k) < 32) c1[(k) & 15] = v_; else if ((k) < 48) c2[(k) & 15] = v_; else c3[(k) & 15] = v_; }
        SEL_CANDS(SEL_F)
#undef SEL_F
          sel_sort16(c1); sel_sort16(c2); SEL_CE(c3[0], c3[1]);
        sel_merge16(c0, c1); sel_merge16(c2, c3); sel_merge16(c0, c2);
#pragma unroll
        for (int j = 0; j < 4; ++j) {
            my[64 * j] = (unsigned)(t1[4 * j] & 0x7F) | ((unsigned)(t1[4 * j + 1] & 0x7F) << 8) | ((unsigned)(t1[4 * j + 2] & 0x7F) << 16) | ((unsigned)(t1[4 * j + 3] & 0x7F) << 24);
            my[64 * (4 + j)] = (unsigned)(t2[4 * j] & 0x7F) | ((unsigned)(t2[4 * j + 1] & 0x7F) << 8) | ((unsigned)(t2[4 * j + 2] & 0x7F) << 16) | ((unsigned)(t2[4 * j + 3] & 0x7F) << 24);
        }
        const float mx = key2f(c0[0]); float e[16], se = 0.f;
#pragma unroll
        for (int k = 0; k < 16; ++k) { e[k] = __expf(key2f(c0[k]) - mx); se += e[k]; }
        const float inv = 1.f / se;
        asm volatile("s_waitcnt lgkmcnt(0)" ::: "memory");
        const size_t o = (size_t)(tok0 + r) * 128 + hd * TOPK;
        if (hi == 0) {
            int id[16];
#pragma unroll
            for (int k = 0; k < 16; ++k) { const int code = c0[k] & 0xFF, i = code >> 4, j = code & 15;
                const unsigned w1 = my[64 * (i >> 2)], w2 = my[64 * (4 + (j >> 2))];
                id[k] = (int)((w1 >> (8 * (i & 3))) & 0x7F) * NK + (int)((w2 >> (8 * (j & 3))) & 0x7F); }
            u32x4 w0, w1;
#pragma unroll
            for (int k = 0; k < 4; ++k) { w0[k] = (unsigned)id[2 * k] | ((unsigned)id[2 * k + 1] << 16); w1[k] = (unsigned)id[8 + 2 * k] | ((unsigned)id[9 + 2 * k] << 16); }
            *(u32x4*)(idx + o) = w0; *(u32x4*)(idx + o + 8) = w1;
        } else {
#pragma unroll
            for (int k = 0; k < 4; ++k) *(float4*)(gate + o + 4 * k) = make_float4(e[4 * k] * inv, e[4 * k + 1] * inv, e[4 * k + 2] * inv, e[4 * k + 3] * inv);
        }
        asm volatile("s_waitcnt lgkmcnt(0)" ::: "memory");
    }
}
}
#ifndef PROBE_MASK
#define PROBE_MASK 0
#endif
#define REPS(bit) (((PROBE_MASK >> (bit)) & 1) ? 2 : 1)
namespace nv {
constexpr int LDS_BYTES = 147456, MISC_OFF = 131072 + 320;
struct Params { const float* in[23]; float* out; unsigned char* ws; };

__global__ void __launch_bounds__(512, 2) k_mega(Params prm) {
    extern __shared__ __attribute__((aligned(16))) unsigned char lds_raw[];
    namespace cg = cooperative_groups;
    cg::grid_group grid = cg::this_grid();
    LAS unsigned char* lds = (LAS unsigned char*)lds_raw;
    unsigned char* smem = lds_raw;
    for (int u = threadIdx.x; u < (LDS_BYTES - 131072) / 4; u += 512) ((LAS unsigned*)(lds + 131072))[u] = 0u;
    __syncthreads();
    if (threadIdx.x == 0) {
        LAS unsigned long long* tab = (LAS unsigned long long*)(lds + TAB_OFF);
#pragma unroll
        for (int i = 0; i < 23; ++i) tab[i] = (unsigned long long)prm.in[i];
        tab[23] = (unsigned long long)prm.out; tab[24] = (unsigned long long)prm.ws;
    }
    __syncthreads();
#define ARG(i) ((const float*)ldarg(lds, (i)))
#define WSP() ((unsigned char*)ldarg(lds, 24))
    XcdBarrier bar = xcd_barrier_post((unsigned*)(WSP() + WS_CTL) + CW_BAR, (volatile LAS unsigned*)(lds + MISC_OFF) + 8);
#define GRID_BAR() do { xcd_barrier(bar); asm volatile("" ::: "memory"); } while (0)
    if (threadIdx.x == 0) { volatile LAS unsigned* M = (volatile LAS unsigned*)(lds + MISC_OFF); M[16] = bar.x; M[17] = xb_add((unsigned*)(WSP() + WS_CTL) + CW_RANK + 64 * bar.x, 1u); }
    for (int rep = 0; rep < REPS(0); ++rep) {
    for (int rep2 = 0; rep2 < REPS(25); ++rep2)
    p0_prologue(lds);
    for (int rep2 = 0; rep2 < REPS(24); ++rep2)
    { unsigned char* ws = WSP(); p0_peer_tables(ARG(20), ARG(21), ARG(17), ws + WS_PU, ws + WS_PV8, (float*)(ws + WS_US)); }
    { unsigned char* ws = WSP(); const float* pk = ARG(19); bf16_t* kb = (bf16_t*)(ws + WS_KEYS); for (int i = obid() * 512 + otid(); i < DEPTH * PH * 2 * NK * HALF; i += ogrid() * 512) kb[i] = f2bf(pk[i]); }
    { unsigned char* ws = WSP(); p0_ssm_a(ARG(3), ARG(4), ARG(5), ARG(6), ARG(7), (f32x2v*)(ws + WS_APOW), (f32x2v*)(ws + WS_BBAR)); }
    }
    GRID_BAR();
    if (threadIdx.x == 0) {
        volatile LAS unsigned* M = (volatile LAS unsigned*)(lds + MISC_OFF); unsigned* bw = (unsigned*)(WSP() + WS_CTL) + CW_BAR; unsigned tot = 0u, ok = 1u;
        for (unsigned j = 0; j < 16; ++j) { const unsigned cnt = xb_ld(&bw[XB_XCNT(j)]); tot += cnt; if ((j < 8) != (cnt > 0u)) ok = 0u; }
        M[18] = xb_ld(&bw[XB_XCNT(bar.x)]); M[19] = (ok && tot == gridDim.x) ? 1u : 0u;
    }
    __syncthreads();
    { unsigned char* ws = WSP(); p0_ssm_b((const f32x2v*)(ws + WS_APOW), (const f32x2v*)(ws + WS_BBAR), ARG(8), ARG(9), ARG(10), (bf16_t*)(ws + WS_KD), (bf16_t*)(ws + WS_WST), (bf16_t*)(ws + WS_WOUT)); }
    grid.sync();
#pragma nounroll
    for (int l_ = 0; l_ < DEPTH; ++l_) {
        int l = l_; asm volatile("" : "+s"(l));
        {
            unsigned char* ws = WSP(); bf16_t* hb = (bf16_t*)(ws + WS_HB); float* ss1 = (float*)(ws + WS_SSP) + (size_t)T * 32;
            for (int rep = 0; rep < REPS(1); ++rep) {
            SchedGen S; S.init_plain(hb, D * 2, (const bf16_t*)(ws + WS_BT1) + (size_t)l * 2048 * D, D * 2, T, 2048, D, ogrid(), obid());
            EpiInProj E{ss1, (bf16_t*)(ws + WS_UP), (bf16_t*)(ws + WS_Q)};
            ge::gemm_phase<EpiInProj, SchedGen>(lds, S, E, otid());
            }
            for (int rep = 0; rep < REPS(2); ++rep)
            ph_flogit(hb, (const bf16_t*)(ws + WS_WF) + (size_t)l * 16 * D, ss1, ARG(13) + l * NH, (float*)(ws + WS_LOGF));
        }
        GRID_BAR();
        {
            unsigned char* ws = WSP();
            for (int rep = 0; rep < REPS(3); ++rep) {
            SchedSsmS S; S.init(ws + WS_UP, (const bf16_t*)(ws + WS_WST) + (size_t)l * G * 128 * 256, ogrid(), obid());
            EpiSsmS E{(float*)(ws + WS_SLOC)};
            ge::gemm_phase<EpiSsmS, SchedSsmS>(lds, S, E, otid());
            }
            for (int rep = 0; rep < REPS(4); ++rep)
            ph_cum2((const float*)(ws + WS_LOGF), (float*)(ws + WS_CUM));
        }
        GRID_BAR();
        for (int rep = 0; rep < REPS(5); ++rep)
        { unsigned char* ws = WSP(); ph_ssm_prefix(lds, (const float*)(ws + WS_SLOC), (const f32x2v*)(ws + WS_APOW) + (size_t)l * G * 65 * P, (bf16_t*)(ws + WS_UP)); }
        GRID_BAR();
        {
            unsigned char* ws = WSP(); float* ssp_s = (float*)(ws + WS_SSP); float* ssp_a = ssp_s + (size_t)T * 8;
            for (int rep = 0; rep < REPS(6); ++rep)
            {
                SchedSsmC S; S.init(ws + WS_UP, (const bf16_t*)(ws + WS_WOUT) + (size_t)l * G * 1024 * 128, (const bf16_t*)(ws + WS_KD) + (size_t)l * G * KDW, ogrid(), obid());
                EpiSsmC E{(bf16_t*)(ws + WS_GEL)};
                ge::gemm_phase<EpiSsmC, SchedSsmC>(lds, S, E, otid());
            }
            for (int rep = 0; rep < REPS(7); ++rep)
            attn_body::attn_phase<8>((char*)lds_raw, (const attn_body::bf16*)(ws + WS_Q), (const attn_body::bf16*)(ws + WS_K), (const attn_body::bf16*)(ws + WS_V), (const float*)(ws + WS_CUM), (attn_body::bf16*)(ws + WS_MIX), ssp_a, (unsigned*)(ws + WS_CTL) + CW_QUEUE + 64 * (l * 2 + rep), (volatile LAS unsigned*)(lds + MISC_OFF) + 24, otid());
            GRID_BAR();
            for (int rep = 0; rep < REPS(8); ++rep) {
            SchedGen S; S.init_plain(ws + WS_GEL, 32, (const bf16_t*)(ws + WS_BT2) + (size_t)l * SSMW * SSMW, SSMW * 2, T, SSMW, SSMW, ogrid(), obid());
            S.a_c16_b = T * 32; S.a_kt_b = 4l * T * 32;
            EpiGlu2 E{(const bf16_t*)(ws + WS_GEL), ARG(12) + l * SSMW, (bf16_t*)(ws + WS_MIX), ssp_s};
            ge::gemm_phase<EpiGlu2, SchedGen>(lds, S, E, otid());
            }
        }
        GRID_BAR();
        {
            unsigned char* ws = WSP(); float* ssp_s = (float*)(ws + WS_SSP); float* ssp_a = ssp_s + (size_t)T * 8; float* ssp_2 = ssp_a + (size_t)T * 8;
            for (int rep = 0; rep < REPS(9); ++rep) {
            const bool dummy = rep + 1 < REPS(9);
            SchedGen S; S.init_plain(ws + WS_MIX, D * 2, (const bf16_t*)(ws + WS_BT3) + (size_t)l * D * D, D * 2, T, D, D, ogrid(), obid());
            EpiWo E{ssp_s, ssp_a, (const bf16_t*)(ws + WS_HB), dummy ? (bf16_t*)(ws + WS_QP) : (bf16_t*)(ws + WS_HB), dummy ? (float*)(ws + WS_SLOC) : ssp_2};
            ge::gemm_phase<EpiWo, SchedGen>(lds, S, E, otid());
            }
        }
        GRID_BAR();
        {
            unsigned char* ws = WSP(); float* ssp_2 = (float*)(ws + WS_SSP) + (size_t)T * 16;
            for (int rep = 0; rep < REPS(10); ++rep) {
            SchedGen S; S.init_plain(ws + WS_HB, D * 2, (const bf16_t*)(ws + WS_BT4) + (size_t)l * D * D, D * 2, T, D, D, ogrid(), obid());
            EpiWq E{ssp_2, (bf16_t*)(ws + WS_QP)};
            ge::gemm_phase<EpiWq, SchedGen>(lds, S, E, otid());
            }
        }
        GRID_BAR();
        for (int rep = 0; rep < REPS(11); ++rep)
        { unsigned char* ws = WSP(); ph_select((const bf16_t*)(ws + WS_QP), (const bf16_t*)(ws + WS_KEYS) + (size_t)l * PH * 2 * NK * HALF, (unsigned short*)(ws + WS_IDX), (float*)(ws + WS_GATE), lds); }
        GRID_BAR();
        if (PROBE_MASK & (1 << 18)) { unsigned char* ws = WSP(); ph_peer_u<2>(lds, ws + WS_PU + (size_t)l * NEXP * D, (const bf16_t*)(ws + WS_HB), (const unsigned short*)(ws + WS_IDX), (bf16_t*)(ws + WS_UP)); }
        if (PROBE_MASK & (1 << 20)) { unsigned char* ws = WSP(); ph_peer_u<2, 5>(lds, ws + WS_PU + (size_t)l * NEXP * D, (const bf16_t*)(ws + WS_HB), (const unsigned short*)(ws + WS_IDX), (bf16_t*)(ws + WS_UP)); }
        if (PROBE_MASK & (1 << 19)) { unsigned char* ws = WSP(); ph_peer_u<3>(lds, ws + WS_PU + (size_t)l * NEXP * D, (const bf16_t*)(ws + WS_HB), (const unsigned short*)(ws + WS_IDX), (bf16_t*)(ws + WS_UP)); }
        if (PROBE_MASK & (1 << 16)) { unsigned char* ws = WSP(); ph_peer_u<0>(lds, ws + WS_PU + (size_t)l * NEXP * D, (const bf16_t*)(ws + WS_HB), (const unsigned short*)(ws + WS_IDX), (bf16_t*)(ws + WS_UP), 1023); }
        for (int rep = 0; rep < REPS(12); ++rep)
        { unsigned char* ws = WSP(); ph_peer_u<0>(lds, ws + WS_PU + (size_t)l * NEXP * D, (const bf16_t*)(ws + WS_HB), (const unsigned short*)(ws + WS_IDX), (bf16_t*)(ws + WS_PART)); }
        GRID_BAR();
        for (int rep = 0; rep < REPS(13); ++rep)
        { unsigned char* ws = WSP(); ph_peer_coef((const bf16_t*)(ws + WS_PART), (const float*)(ws + WS_SSP) + (size_t)T * 16, (const float*)(ws + WS_GATE), (const unsigned short*)(ws + WS_IDX), (const float*)(ws + WS_US) + (size_t)l * NEXP, (unsigned short*)(ws + WS_COEF)); }
        GRID_BAR();
        if (PROBE_MASK & (1 << 17)) { unsigned char* ws = WSP();
          ph_peer_v<0>(lds, ws + WS_PV8 + (size_t)l * NEXP * D, (const unsigned short*)(ws + WS_IDX), (const unsigned short*)(ws + WS_COEF), (const bf16_t*)(ws + WS_HB), (bf16_t*)(ws + WS_UP), (float*)(ws + WS_SLOC), 1023); }
        for (int rep = 0; rep < REPS(14); ++rep)
        { unsigned char* ws = WSP(); const bool dummy = rep + 1 < REPS(14);
          ph_peer_v<0>(lds, ws + WS_PV8 + (size_t)l * NEXP * D, (const unsigned short*)(ws + WS_IDX), (const unsigned short*)(ws + WS_COEF), (const bf16_t*)(ws + WS_HB),
                    dummy ? (bf16_t*)(ws + WS_UP) : (bf16_t*)(ws + WS_HB), dummy ? (float*)(ws + WS_SLOC) : (float*)(ws + WS_SSP) + (size_t)T * 32); }
        if (PROBE_MASK & (1 << 15)) { for (int rep = 0; rep < 8; ++rep) GRID_BAR(); }
        GRID_BAR();
    }
    { unsigned char* ws = WSP(); ph_final((const bf16_t*)(ws + WS_HB), (const float*)(ws + WS_SSP) + (size_t)T * 32, ARG(22), (float*)ldarg(lds, 23)); }
}
}

extern "C" void kernel_launch(void* const* d_in, const int* in_sizes, int n_in, void* d_out, int out_size, void* d_ws, size_t ws_size, hipStream_t stream) {
    using namespace nv;
    static int grid_blocks = 0;
    if (!grid_blocks) {
        int dev = 0, cus = 0, per_cu = 0;
        (void)hipGetDevice(&dev);
        (void)hipDeviceGetAttribute(&cus, hipDeviceAttributeMultiprocessorCount, dev);
        if (hipFuncSetAttribute((const void*)k_mega, hipFuncAttributeMaxDynamicSharedMemorySize, LDS_BYTES) != hipSuccess) { fprintf(stderr, "hipFuncSetAttribute failed\n"); grid_blocks = -1; return; }
        (void)hipOccupancyMaxActiveBlocksPerMultiprocessor(&per_cu, (const void*)k_mega, 512, LDS_BYTES);
        if (per_cu < 1) { fprintf(stderr, "occupancy query returned %d\n", per_cu); (void)hipGetLastError(); }
        grid_blocks = cus;
    }
    if (grid_blocks < 0) return;
    if (ws_size < WS_END || n_in != 23) { fprintf(stderr, "bad workspace / inputs\n"); return; }
    (void)hipMemsetAsync((char*)d_ws + WS_CTL, 0, CTL_BYTES, stream);
    Params p{};
    for (int i = 0; i < 23; ++i) p.in[i] = (const float*)d_in[i];
    p.out = (float*)d_out; p.ws = (unsigned char*)d_ws;
    void* args[] = {&p};
    hipError_t e = hipLaunchCooperativeKernel((const void*)k_mega, dim3(grid_blocks), dim3(512), args, LDS_BYTES, stream);
    if (e != hipSuccess) fprintf(stderr, "cooperative launch failed: %s (grid %d)\n", hipGetErrorString(e), grid_blocks);
}
```

```cpp
#include <hip/hip_runtime.h>
#include <hip/hip_cooperative_groups.h>
#include <hip/hip_bf16.h>
#include <cstdint>
#include <cstdio>

#define LAS __attribute__((address_space(3)))
#define GAS __attribute__((address_space(1)))

namespace nv {
constexpr int D = 1024, BATCH = 8, SEQ = 4096, DEPTH = 4, T = BATCH * SEQ;
constexpr int SSMW = 512, G = 32, HC = 16, P = 64, ATTW = 512, HD = 64, NH = 8, INW = 2056;
constexpr int PH = 8, NK = 128, TOPK = 16, QD = 128, HALF = 64, NEXP = 16384;
constexpr int CHUNK = 64, NCH = T / CHUNK  , UPW = 128 + CHUNK * HC  ;
constexpr float EPS = 1e-6f;

typedef short bf16x8 __attribute__((ext_vector_type(8)));
typedef float f32x16 __attribute__((ext_vector_type(16)));
typedef float f32x4 __attribute__((ext_vector_type(4)));
typedef unsigned u32x4 __attribute__((ext_vector_type(4)));
typedef unsigned short bf16_t;

constexpr size_t MiB = 1u << 20;
constexpr size_t WS_CTL = 0, CTL_BYTES = 4 * MiB;
constexpr size_t WS_BT1 = 4 * MiB;
constexpr size_t WS_BT2 = 20 * MiB;
constexpr size_t WS_BT3 = 22 * MiB;
constexpr size_t WS_BT4 = 30 * MiB;
constexpr size_t WS_WF = 38 * MiB;
constexpr size_t WS_KEYS = 39 * MiB;
constexpr size_t WS_KD = 40 * MiB, WS_WOUT = 49 * MiB, WS_WST = 81 * MiB;
constexpr size_t WS_PU = 90 * MiB, WS_PV8 = 154 * MiB;
constexpr size_t WS_PART = 218 * MiB;
constexpr size_t WS_H = 346 * MiB;
constexpr size_t WS_HB = 474 * MiB;
constexpr size_t WS_UP = 538 * MiB;
constexpr size_t WS_Q = 576 * MiB, WS_K = 608 * MiB, WS_V = 640 * MiB;
constexpr size_t WS_LOGF = 672 * MiB, WS_CUM = 673 * MiB;
constexpr size_t WS_SLOC = 674 * MiB, WS_GEL = 708 * MiB, WS_MIX = 740 * MiB;
constexpr size_t WS_SSP = 916 * MiB;
constexpr size_t WS_QP = 852 * MiB;
constexpr size_t WS_IDX = 804 * MiB, WS_GATE = 820 * MiB, WS_COEF = 836 * MiB;
constexpr size_t WS_XN_F = 90 * MiB, WS_MIXED_F = 218 * MiB, WS_QP_F = 852 * MiB, WS_GEL_F = 90 * MiB  , WS_YSSM_F = 740 * MiB, WS_YATT_F = 674 * MiB;
constexpr size_t WS_US = 980 * MiB;
constexpr size_t WS_END = 981 * MiB;
constexpr int CW_QUEUE = 1024;
constexpr int CW_GDONE = 3072;
constexpr int CW_RANK = 2048;
constexpr int CW_BAR = 4096;
constexpr int CW_SS = 65536;
constexpr int SS_H1 = 0  , SS_H2 = 5  , SS_SSM = 9, SS_ATT = 13;
static_assert((size_t)(CW_SS + 17 * T) * 4 <= CTL_BYTES, "ctl region");

__device__ __forceinline__ unsigned short f2bf(float f) { unsigned u = __float_as_uint(f); return (unsigned short)((u + 0x7fffu + ((u >> 16) & 1u)) >> 16); }
__device__ __forceinline__ float bf2f(unsigned short b) { return __uint_as_float(((unsigned)b) << 16); }
__device__ __forceinline__ unsigned pk2(float lo, float hi) { return (unsigned)f2bf(lo) | ((unsigned)f2bf(hi) << 16); }
__device__ __forceinline__ float gelu_tanh(float x) { const float u = 0.7978845608028654f * (x + 0.044715f * x * x * x); return 0.5f * x * (1.f + tanhf(u)); }
#define DPPF_(x, CTRL) __int_as_float(__builtin_amdgcn_update_dpp(0, __float_as_int(x), (CTRL), 0xF, 0xF, true))
__device__ __forceinline__ float wave_sum(float v) {
    v += DPPF_(v, 0xB1); v += DPPF_(v, 0x4E); v += DPPF_(v, 0x141); v += DPPF_(v, 0x140);
    { const auto r = __builtin_amdgcn_permlane16_swap(__float_as_uint(v), __float_as_uint(v), false, false); v = __uint_as_float(r[0]) + __uint_as_float(r[1]); }
    { const auto r = __builtin_amdgcn_permlane32_swap(__float_as_uint(v), __float_as_uint(v), false, false); v = __uint_as_float(r[0]) + __uint_as_float(r[1]); }
    return v;
}
__device__ __forceinline__ float wave_max(float v) {
    v = fmaxf(v, DPPF_(v, 0xB1)); v = fmaxf(v, DPPF_(v, 0x4E)); v = fmaxf(v, DPPF_(v, 0x141)); v = fmaxf(v, DPPF_(v, 0x140));
    { const auto r = __builtin_amdgcn_permlane16_swap(__float_as_uint(v), __float_as_uint(v), false, false); v = fmaxf(__uint_as_float(r[0]), __uint_as_float(r[1])); }
    { const auto r = __builtin_amdgcn_permlane32_swap(__float_as_uint(v), __float_as_uint(v), false, false); v = fmaxf(__uint_as_float(r[0]), __uint_as_float(r[1])); }
    return v;
}
__device__ __forceinline__ int otid() { int t = threadIdx.x; asm volatile("" : "+v"(t)); return t; }
__device__ __forceinline__ int obid() { int t = blockIdx.x; asm volatile("" : "+s"(t)); return t; }
__device__ __forceinline__ int ogrid() { int t = gridDim.x; asm volatile("" : "+s"(t)); return t; }
#define PH_IDS const int TIDX = otid(), BIDX = obid(), GDIM = ogrid(); (void)TIDX; (void)BIDX; (void)GDIM;
__device__ __forceinline__ size_t up_index(int row, int c) { const int n = row >> 6, j = row & 63, g = c >> 4, hh = c & 15; return ((size_t)g * NCH + n) * UPW + 128 + j * HC + hh; }
}
namespace ge {
#define GE_LAS __attribute__((address_space(3)))
typedef unsigned short bf16_t;
typedef short bf16x8 __attribute__((ext_vector_type(8)));
typedef float f32x4 __attribute__((ext_vector_type(4)));
typedef unsigned u32x4 __attribute__((ext_vector_type(4)));
typedef unsigned u32x2 __attribute__((ext_vector_type(2)));
constexpr int ROWF_OFF = 131072 + 4096;
constexpr int BM = 256, BK = 64, HALF = 128, HTB = HALF * BK * 2  , STAGE_BYTES = 8 * HTB, NXCD = 8, WGM = 8;

__host__ __device__ __forceinline__ int lds_byte(int r, int c) { const int st = (r >> 4) * 2 + (c >> 5), rr = r & 15, cc = c & 31, ob = rr * 64 + cc * 2; return st * 1024 + (ob ^ (((ob >> 9) & 1) << 5)); }
__host__ __device__ __forceinline__ void stage_rc(int b, int& R, int& C) { const int st = b / 1024, sb = b % 1024, swz = sb ^ (((sb >> 9) & 1) << 5); R = (st >> 1) * 16 + swz / 64; C = (st & 1) * 32 + (swz % 64) / 2; }
__host__ __device__ __forceinline__ int perm32(int rho) { const int n = rho >> 4, i = rho & 15; return 8 * (i >> 2) + 4 * n + (i & 3); }

struct Unit { const char* A0; const char* B0; int nt; int pm, pn, aux; };
__device__ __forceinline__ unsigned cvt_pk_bf16(float lo, float hi) { unsigned r; asm volatile("v_cvt_pk_bf16_f32 %0, %1, %2" : "=v"(r) : "v"(lo), "v"(hi)); return r; }

__device__ __forceinline__ bool static_tile(int i, int G, int c, int nM, int nN, int& pm, int& pn) {
    const int nwg = nM * nN; const long L = (long)i * G + c; if (L >= nwg) return false;
    int wgid = (int)L; { const int q = nwg / NXCD, r = nwg % NXCD, xcd = wgid % NXCD, off = wgid / NXCD; wgid = (xcd < r ? xcd * (q + 1) : r * (q + 1) + (xcd - r) * q) + off; }
    const int nig = WGM * nN, gid = wgid / nig, fm = gid * WGM, gsz = (nM - fm) < WGM ? (nM - fm) : WGM;
    pm = fm + ((wgid % nig) % gsz); pn = (wgid % nig) / gsz; return true;
}

template <class Epi, class Sched>
__device__ __forceinline__ void gemm_phase(GE_LAS unsigned char* lds, const Sched& S, const Epi& E, int tid) {
    const int wid = __builtin_amdgcn_readfirstlane(tid >> 6), lane = tid & 63, wr = wid >> 2, wc = wid & 3, fr = lane & 15, fq = lane >> 4;
    unsigned voffA[2], voffB[2], voffB1[2];
#pragma unroll
    for (int i = 0; i < 2; ++i) { int R, C; stage_rc(tid * 16 + i * 8192, R, C); const int Rb = Epi::PERM ? ((R & ~31) + perm32(R & 31)) : R;
        voffA[i] = S.voffA(R, C); voffB[i] = S.voffB(Rb, C); if constexpr (Sched::DUALB) voffB1[i] = S.voffB1(Rb, C); else voffB1[i] = 0u; }
    const long hA = S.hA, hB = S.hB;
    const unsigned ldsw = (unsigned)wid * 1024u;
    const int aoff = lds_byte(wr * 64 + fr, fq * 8), boff = lds_byte(wc * 32 + fr, fq * 8);
#define GE_SA(b, h) (((b) * 2 + (h)) * HTB)
#define GE_SB(b, h) ((4 + (b) * 2 + (h)) * HTB)
#define GE_STAGE(bufoff, gbase, voff) do { _Pragma("unroll") for (int _i = 0; _i < 2; ++_i) \
        __builtin_amdgcn_global_load_lds((const unsigned*)((const char*)(gbase) + (voff)[_i]), (GE_LAS unsigned*)(lds + (bufoff) + ldsw + _i * 8192), 16, 0, 0); } while (0)
#define GE_STAGE_B(bufoff, gbase, sel, half) do { if constexpr (Sched::DUALB) { const char* _g = (const char*)(gbase) + ((half) ? ((sel) ? S.hB1 : hB) : 0l); _Pragma("unroll") for (int _i = 0; _i < 2; ++_i) { const unsigned _v = (sel) ? voffB1[_i] : voffB[_i]; \
        __builtin_amdgcn_global_load_lds((const unsigned*)(_g + _v), (GE_LAS unsigned*)(lds + (bufoff) + ldsw + _i * 8192), 16, 0, 0); } } else { GE_STAGE(bufoff, (const char*)(gbase) + ((half) ? hB : 0l), voffB); } } while (0)
#define GE_LDA(dst, b, h) do { _Pragma("unroll") for (int m = 0; m < 4; ++m) _Pragma("unroll") for (int k = 0; k < 2; ++k) dst[m][k] = *(const GE_LAS bf16x8*)(lds + GE_SA(b, h) + aoff + m * 2048 + k * 1024); } while (0)
#define GE_LDB(dst, b, h) do { _Pragma("unroll") for (int n = 0; n < 2; ++n) _Pragma("unroll") for (int k = 0; k < 2; ++k) dst[n][k] = *(const GE_LAS bf16x8*)(lds + GE_SB(b, h) + boff + n * 2048 + k * 1024); } while (0)
#define GE_MMA(ai, bj, At, Bt) do { __builtin_amdgcn_s_setprio(1); _Pragma("unroll") for (int m = 0; m < 4; ++m) _Pragma("unroll") for (int n = 0; n < 2; ++n) _Pragma("unroll") for (int k = 0; k < 2; ++k) \
        acc[ai][bj][m][n] = __builtin_amdgcn_mfma_f32_16x16x32_bf16(Bt[n][k], At[m][k], acc[ai][bj][m][n], 0, 0, 0); __builtin_amdgcn_s_setprio(0); } while (0)
#define GE_WAIT_V(n) asm volatile("s_waitcnt vmcnt(" #n ")" ::: "memory")
#define GE_WAIT_L(n) asm volatile("s_waitcnt lgkmcnt(" #n ")" ::: "memory")
#define GE_BAR __builtin_amdgcn_s_barrier()
#define GE_SCHED __builtin_amdgcn_sched_barrier(0)
    Unit cur, nxt; int ui = 0;
    if (!S.next(0, cur)) return;
    f32x4 acc[2][2][4][2];
#pragma unroll
    for (int a = 0; a < 2; ++a)
#pragma unroll
        for (int b = 0; b < 2; ++b)
#pragma unroll
            for (int m = 0; m < 4; ++m)
#pragma unroll
                for (int n = 0; n < 2; ++n) acc[a][b][m][n] = (f32x4){0.f, 0.f, 0.f, 0.f};
    bf16x8 At[4][2], B0[2][2], B1[2][2];
    if constexpr (Epi::UBEGIN) E.unit_begin(cur, tid, lds + ROWF_OFF);
    {
        const char* a0 = S.ta(cur, 0); const char* b0 = S.tb(cur, 0); const char* a1 = S.ta(cur, 1); const char* b1 = S.tb(cur, 1);
        const bool s0 = S.sb(cur, 0), s1 = S.sb(cur, 1);
        GE_STAGE_B(GE_SB(0, 0), b0, s0, 0); GE_STAGE_B(GE_SB(0, 1), b0, s0, 1); GE_STAGE(GE_SA(0, 0), a0, voffA); GE_STAGE(GE_SA(0, 1), a0 + hA, voffA);
        if (wr == 1) GE_BAR;
        GE_WAIT_V(2); GE_BAR;
        GE_STAGE_B(GE_SB(1, 0), b1, s1, 0); GE_STAGE(GE_SA(1, 0), a1, voffA); GE_STAGE_B(GE_SB(1, 1), b1, s1, 1);
        GE_WAIT_V(6); GE_BAR;
    }
    for (;;) {
        const bool has_next = S.next(ui + 1, nxt);
        const int nt = cur.nt;
        for (int t = 0; t < nt; t += 2) {
            const bool last = (t == nt - 2);
            const char* a1 = S.ta(cur, t + 1);
            const char* a2 = last ? (has_next ? S.ta(nxt, 0) : S.ta(cur, 0)) : S.ta(cur, t + 2);
            const char* b2 = last ? (has_next ? S.tb(nxt, 0) : S.tb(cur, 0)) : S.tb(cur, t + 2);
            const char* a3 = last ? (has_next ? S.ta(nxt, 1) : S.ta(cur, 1)) : S.ta(cur, t + 3);
            const char* b3 = last ? (has_next ? S.tb(nxt, 1) : S.tb(cur, 1)) : S.tb(cur, t + 3);
            const bool s2 = last ? (has_next ? S.sb(nxt, 0) : S.sb(cur, 0)) : S.sb(cur, t + 2), s3 = last ? (has_next ? S.sb(nxt, 1) : S.sb(cur, 1)) : S.sb(cur, t + 3);
            GE_LDB(B0, 0, 0); GE_LDB(B1, 0, 1); GE_SCHED; GE_LDA(At, 0, 0); GE_STAGE(GE_SA(1, 1), a1 + hA, voffA);
            GE_WAIT_V(8); GE_WAIT_L(0); GE_BAR; GE_MMA(0, 0, At, B0); GE_MMA(0, 1, At, B1); GE_BAR; GE_SCHED;
            GE_LDA(At, 0, 1); GE_STAGE_B(GE_SB(0, 0), b2, s2, 0); GE_STAGE_B(GE_SB(0, 1), b2, s2, 1); GE_STAGE(GE_SA(0, 0), a2, voffA);
            GE_WAIT_V(8); GE_WAIT_L(0); GE_BAR; GE_MMA(1, 0, At, B0); GE_MMA(1, 1, At, B1); GE_BAR; GE_SCHED;
            GE_LDB(B0, 1, 0); GE_LDB(B1, 1, 1); GE_SCHED; GE_LDA(At, 1, 0); GE_STAGE(GE_SA(0, 1), a2 + hA, voffA);
            GE_WAIT_V(8); GE_WAIT_L(0); GE_BAR; GE_MMA(0, 0, At, B0); GE_MMA(0, 1, At, B1); GE_BAR; GE_SCHED;
            GE_LDA(At, 1, 1); GE_STAGE_B(GE_SB(1, 0), b3, s3, 0); GE_STAGE_B(GE_SB(1, 1), b3, s3, 1); GE_STAGE(GE_SA(1, 0), a3, voffA);
            GE_WAIT_V(8); GE_WAIT_L(0); GE_BAR; GE_MMA(1, 0, At, B0); GE_MMA(1, 1, At, B1); GE_BAR; GE_SCHED;
            if constexpr (Epi::MIDK) { if (t + 2 == (nt >> 1)) E.midk(acc, cur, wr, fr, lds + ROWF_OFF + (ui & 1) * 2048); }
        }
        if (wr == 0) GE_BAR;
        E(acc, cur, wr, wc, fr, fq, lds + ROWF_OFF + (ui & 1) * 2048);
        if (!has_next) break;
        if constexpr (Epi::UBEGIN) E.unit_begin(nxt, tid, lds + ROWF_OFF + ((ui + 1) & 1) * 2048);
#pragma unroll
        for (int a = 0; a < 2; ++a)
#pragma unroll
            for (int b = 0; b < 2; ++b)
#pragma unroll
                for (int m = 0; m < 4; ++m)
#pragma unroll
                    for (int n = 0; n < 2; ++n) acc[a][b][m][n] = (f32x4){0.f, 0.f, 0.f, 0.f};
        cur = nxt; ++ui;
        if (wr == 1) GE_BAR;
    }
    GE_WAIT_V(0);
    GE_BAR;
#undef GE_SA
#undef GE_SB
#undef GE_STAGE
#undef GE_STAGE_B
#undef GE_LDA
#undef GE_LDB
#undef GE_MMA
#undef GE_WAIT_V
#undef GE_WAIT_L
#undef GE_BAR
#undef GE_SCHED
}
}
namespace nv {
__device__ __forceinline__ float sum8(const float* p);
__device__ __forceinline__ float sum16(const float* p);
#define XB_TMO      128
#define XB_XCNT(j)  (256  + 64 * (j))
#define XB_XSUB(j)  (1280 + 64 * (j))
#define XB_XGEN(j)  (2304 + 64 * (j))
#define XB_TOP      3328
#define XB_TOPGEN   3392
#define XCD_BAR_WORDS 3456
#define XB_SPIN_CAP (1u << 24)
__device__ __forceinline__ unsigned xb_ld(unsigned* p)              { return __hip_atomic_load(p, __ATOMIC_RELAXED, __HIP_MEMORY_SCOPE_AGENT); }
__device__ __forceinline__ unsigned xb_add(unsigned* p, unsigned v) { return __hip_atomic_fetch_add(p, v, __ATOMIC_RELAXED, __HIP_MEMORY_SCOPE_AGENT); }
__device__ __forceinline__ unsigned xb_xcc_id() { return (unsigned)__builtin_amdgcn_s_getreg((3 << 11) | 20) & 0xFu; }
#define XB_SPIN(cond, bar) do { unsigned _sp = 0; while (cond) { __builtin_amdgcn_s_sleep(1); \
    if ((++_sp & 255u) == 0u) { if (xb_ld(&(bar)[XB_TMO])) break; if (_sp > XB_SPIN_CAP) { atomicAdd(&(bar)[XB_TMO], 1u); break; } } } } while (0)
struct XcdBarrier { unsigned* bar; unsigned x; volatile LAS unsigned* st; };
__device__ __forceinline__ XcdBarrier xcd_barrier_post(unsigned* bar, volatile LAS unsigned* st) {
    XcdBarrier b; b.bar = bar; b.x = xb_xcc_id(); b.st = st;
    if (threadIdx.x == 0) (void)xb_add(&bar[XB_XCNT(b.x)], 1u);
    return b;
}
__device__ __forceinline__ void xcd_barrier_complete(unsigned* bar, unsigned x, unsigned& nloc, unsigned& nx) {
    const unsigned Gsz = gridDim.x * gridDim.y * gridDim.z;
    unsigned sum, cnt, mine, sp = 0u;
    for (;;) {
        sum = 0u; cnt = 0u; mine = 0u;
#pragma unroll
        for (unsigned j = 0; j < 16; ++j) { const unsigned c = xb_ld(&bar[XB_XCNT(j)]); sum += c; cnt += (c > 0u) ? 1u : 0u; mine = (j == x) ? c : mine; }
        if (sum == Gsz) break;
        __builtin_amdgcn_s_sleep(1);
        if ((++sp & 255u) == 0u) { if (xb_ld(&bar[XB_TMO])) break; if (sp > XB_SPIN_CAP) { atomicAdd(&bar[XB_TMO], 1u); break; } }
    }
    nloc = mine > 0u ? mine : 1u; nx = cnt > 0u ? cnt : 1u;
}
__device__ __forceinline__ void xcd_barrier(const XcdBarrier& b) {
    asm volatile("s_waitcnt vmcnt(0)" ::: "memory");
    __syncthreads();
    if (threadIdx.x == 0) {
        unsigned* bar = b.bar;
        __builtin_amdgcn_s_waitcnt(0);
        unsigned nloc = b.st[0], nx = b.st[1];
        if (nloc == 0u) { xcd_barrier_complete(bar, b.x, nloc, nx); b.st[0] = nloc; b.st[1] = nx; }
        const unsigned old = xb_add(&bar[XB_XSUB(b.x)], 1u);
        const unsigned gen = old / nloc;
        if (old + 1u == (gen + 1u) * nloc) {
            __builtin_amdgcn_fence(__ATOMIC_RELEASE, "agent");
            asm volatile("s_waitcnt vmcnt(0)" ::: "memory");
            const unsigned og = xb_add(&bar[XB_TOP], 1u);
            const unsigned target = (og / nx + 1u) * nx;
            if (og + 1u != target) XB_SPIN(xb_ld(&bar[XB_TOP]) < target, bar);
            __builtin_amdgcn_fence(__ATOMIC_ACQUIRE, "agent");
            xb_add(&bar[XB_XGEN(b.x)], 1u);
            asm volatile("s_waitcnt vmcnt(0)" ::: "memory");
        } else {
            XB_SPIN(xb_ld(&bar[XB_XGEN(b.x)]) == gen, bar);
            __builtin_amdgcn_fence(__ATOMIC_ACQUIRE, "agent");
            asm volatile("s_waitcnt vmcnt(0)" ::: "memory");
        }
    }
    __syncthreads();
}

#define LDS_WAIT() asm volatile("s_waitcnt lgkmcnt(0)" ::: "memory")
template <class Sc>
__device__ __forceinline__ void p0_transpose_item(const float* __restrict__ W, int ldw, int K, int Ncols, Sc sc, bf16_t* __restrict__ WT, LAS float* scr, int item, int lane) {
    const int nblk = Ncols / 32, kb = item / nblk, nb = item % nblk, k0 = 64 * kb, n0 = 32 * nb;
    float wv[32];
#pragma unroll
    for (int i = 0; i < 32; ++i) { const int kk = 2 * i + (lane >> 5); wv[i] = W[(size_t)(k0 + kk) * ldw + n0 + (lane & 31)]; }
#pragma unroll
    for (int i = 0; i < 32; ++i) { const int kk = 2 * i + (lane >> 5); scr[kk * 33 + (lane & 31)] = wv[i] * sc(k0 + kk); }
    LDS_WAIT(); asm volatile("" ::: "memory");
    const int c = lane & 7;
#pragma unroll
    for (int j = 0; j < 4; ++j) { const int n = (lane >> 3) + 8 * j; const LAS float* s = scr + (8 * c) * 33 + n;
        u32x4 o; o.x = pk2(s[0 * 33], s[1 * 33]); o.y = pk2(s[2 * 33], s[3 * 33]); o.z = pk2(s[4 * 33], s[5 * 33]); o.w = pk2(s[6 * 33], s[7 * 33]);
        *(u32x4*)(WT + (size_t)(n0 + n) * K + k0 + 8 * c) = o; }
    LDS_WAIT(); asm volatile("" ::: "memory");
}
struct ScVec { const float* g; __device__ __forceinline__ float operator()(int k) const { return g[k]; } };
struct ScOne { __device__ __forceinline__ float operator()(int) const { return 1.f; } };
struct ScTwo { const float* g0; const float* g1; __device__ __forceinline__ float operator()(int k) const { return k < 512 ? g0[k] : g1[k - 512]; } };

constexpr int TAB_OFF = 131072 + 1024;
__device__ __forceinline__ void* ldarg(LAS unsigned char* lds, int i) {
    unsigned off = TAB_OFF + 8 * i; asm volatile("" : "+s"(off));
    const unsigned long long v = *(volatile LAS unsigned long long*)(lds + off);
    const unsigned lo = __builtin_amdgcn_readfirstlane((unsigned)v), hi = __builtin_amdgcn_readfirstlane((unsigned)(v >> 32));
    return (void*)(GAS void*)(((unsigned long long)hi << 32) | lo);
}

__device__ __forceinline__ void p0_prologue(LAS unsigned char* lds) {
    PH_IDS
    const int lane = TIDX & 63, wave = __builtin_amdgcn_readfirstlane(TIDX >> 6), gw = BIDX * 8 + wave, ngw = GDIM * 8;
    LAS float* scr = (LAS float*)(lds + wave * 16384);
    unsigned char* ws = (unsigned char*)ldarg(lds, 24);
    const float* a0 = (const float*)ldarg(lds, 0); const float* a1 = (const float*)ldarg(lds, 1); const float* a2 = (const float*)ldarg(lds, 2); const float* a11 = (const float*)ldarg(lds, 11);
    const float* a14 = (const float*)ldarg(lds, 14); const float* a15 = (const float*)ldarg(lds, 15); const float* a16 = (const float*)ldarg(lds, 16); const float* a17 = (const float*)ldarg(lds, 17); const float* a18 = (const float*)ldarg(lds, 18);
    constexpr int I1 = (D / 64) * (2048 / 32), I2 = (SSMW / 64) * (SSMW / 32), I3 = (D / 64) * (D / 32), I4 = I3, IL = I1 + I2 + I3 + I4;
    for (int it = gw; it < DEPTH * IL; it += ngw) {
        const int l = it / IL; int r = it % IL;
        if (r < I1) { p0_transpose_item(a2 + (size_t)l * D * INW, INW, D, 2048, ScVec{a1 + l * D}, (bf16_t*)(ws + WS_BT1) + (size_t)l * 2048 * D, scr, r, lane); continue; } r -= I1;
        if (r < I2) { p0_transpose_item(a11 + (size_t)l * SSMW * SSMW, SSMW, SSMW, SSMW, ScOne{}, (bf16_t*)(ws + WS_BT2) + (size_t)l * SSMW * SSMW, scr, r, lane); continue; } r -= I2;
        if (r < I3) { p0_transpose_item(a16 + (size_t)l * D * D, D, D, D, ScTwo{a14 + l * SSMW, a15 + l * ATTW}, (bf16_t*)(ws + WS_BT3) + (size_t)l * D * D, scr, r, lane); continue; } r -= I3;
        p0_transpose_item(a18 + (size_t)l * D * D, D, D, D, ScVec{a17 + l * D}, (bf16_t*)(ws + WS_BT4) + (size_t)l * D * D, scr, r, lane);
    }
    for (int i = BIDX * 512 + TIDX; i < DEPTH * 16 * D; i += GDIM * 512) {
        const int l = i / (16 * D), j = (i / D) % 16, k = i % D;
        const float v = j < 8 ? a2[((size_t)l * D + k) * INW + 2048 + j] * a1[l * D + k] : 0.f;
        ((bf16_t*)(ws + WS_WF))[i] = f2bf(v);
    }
    {
        const float* x = a0; bf16_t* hb = (bf16_t*)(ws + WS_HB); float* ssp1 = (float*)(ws + WS_SSP) + (size_t)T * 32;
        constexpr int NR = 4;
        for (int w0 = gw; w0 < T; w0 += NR * ngw) {
            f32x4 v[NR][4];
#pragma unroll
            for (int u = 0; u < NR; ++u) { const int w = w0 + u * ngw; if (w < T) { const f32x4* r = (const f32x4*)(x + (size_t)w * D) + lane;
#pragma unroll
                for (int j = 0; j < 4; ++j) v[u][j] = r[64 * j]; } }
#pragma unroll
            for (int u = 0; u < NR; ++u) { const int w = w0 + u * ngw; if (w < T) { unsigned long long* o = (unsigned long long*)(hb + (size_t)w * D) + lane;
                float s = 0.f;
#pragma unroll
                for (int j = 0; j < 4; ++j) { const unsigned q0 = pk2(v[u][j].x, v[u][j].y), q1 = pk2(v[u][j].z, v[u][j].w); o[64 * j] = (unsigned long long)q0 | ((unsigned long long)q1 << 32);
                    const float a = __uint_as_float(q0 << 16), b = __uint_as_float(q0 & 0xffff0000u), c = __uint_as_float(q1 << 16), d = __uint_as_float(q1 & 0xffff0000u); s += (a * a + b * b) + (c * c + d * d); }
                s = wave_sum(s);
                if (lane < 8) ssp1[(size_t)w * 8 + lane] = lane == 0 ? s : 0.f; } }
        }
    }
}

struct SchedGen {
    static constexpr bool DUALB = false; long hB1;
    __device__ __forceinline__ bool sb(const ge::Unit&, int) const { return false; }
    __device__ __forceinline__ unsigned voffB1(int, int) const { return 0u; }
    const char* A; const char* B; int a_row_b, a_c16_b, b_row_b, b_c16_b; long a_pm_b, a_kt_b, b_pn_b, b_kt_b; int nM, nN, nt, G, c; long hA, hB;
    __device__ __forceinline__ void init_plain(const void* A_, int lda_bytes, const void* B_, int ldb_bytes, int M, int N, int K, int G_, int c_) {
        A = (const char*)A_; B = (const char*)B_; a_row_b = lda_bytes; a_c16_b = 32; b_row_b = ldb_bytes; b_c16_b = 32; a_pm_b = 256l * lda_bytes; a_kt_b = 128; b_pn_b = 256l * ldb_bytes; b_kt_b = 128;
        nM = M / 256; nN = N / 256; nt = K / 64; G = G_; c = c_; hA = 128l * lda_bytes; hB = 128l * ldb_bytes; }
    __device__ __forceinline__ bool next(int i, ge::Unit& u) const {
        int pm, pn; if (!ge::static_tile(i, G, c, nM, nN, pm, pn)) return false;
        u.A0 = A + (size_t)pm * a_pm_b; u.B0 = B + (size_t)pn * b_pn_b; u.nt = nt; u.pm = pm; u.pn = pn; u.aux = 0; return true; }
    __device__ __forceinline__ const char* ta(const ge::Unit& u, int t) const { return u.A0 + t * a_kt_b; }
    __device__ __forceinline__ const char* tb(const ge::Unit& u, int t) const { return u.B0 + t * b_kt_b; }
    __device__ __forceinline__ unsigned voffA(int R, int C) const { return (unsigned)(R * a_row_b + (C >> 4) * a_c16_b + (C & 15) * 2); }
    __device__ __forceinline__ unsigned voffB(int Rb, int C) const { return (unsigned)(Rb * b_row_b + (C >> 4) * b_c16_b + (C & 15) * 2); }
};
typedef SchedGen SchedPlain;

constexpr float QSCALE = 0.125f * 1.4426950408889634f;
struct EpiInProj {
    static constexpr bool PERM = true, MIDK = false, UBEGIN = true;
    const float* ssp1; bf16_t* UP; bf16_t* QKV;
    __device__ __forceinline__ void unit_begin(const ge::Unit& u, int tid, LAS unsigned char* rowf) const {
        if (tid < 256) { const int row = u.pm * 256 + tid; ((LAS float*)rowf)[tid] = rsqrtf(sum8(ssp1 + (size_t)row * 8) * (1.f / D) + EPS); }
    }
    __device__ __forceinline__ void midk(ge::f32x4 (&)[2][2][4][2], const ge::Unit&, int, int, LAS unsigned char*) const {}
    __device__ __forceinline__ void operator()(const ge::f32x4 (&acc)[2][2][4][2], const ge::Unit& u, int wr, int wc, int fr, int fq, LAS unsigned char* rowf) const {
        const int row0 = u.pm * 256 + wr * 64 + fr, colt = u.pn * 256, region = colt >> 9;
        bf16_t* dstb = QKV + (size_t)(region - 1) * ((WS_K - WS_Q) / 2);
#pragma unroll
        for (int ai = 0; ai < 2; ++ai)
#pragma unroll
            for (int m = 0; m < 4; ++m) {
                const int row = row0 + ai * 128 + m * 16; const float rs = ((const LAS float*)rowf)[ai * 128 + wr * 64 + m * 16 + fr];
#pragma unroll
                for (int bj = 0; bj < 2; ++bj) {
                    const int c = (colt & 511) + bj * 128 + wc * 32 + 8 * fq;
                    const float rq = region == 1 ? rs * QSCALE : rs;
                    const ge::f32x4 v0 = acc[ai][bj][m][0] * rq, v1 = acc[ai][bj][m][1] * rq;
                    u32x4 w; w.x = ge::cvt_pk_bf16(v0[0], v0[1]); w.y = ge::cvt_pk_bf16(v0[2], v0[3]); w.z = ge::cvt_pk_bf16(v1[0], v1[1]); w.w = ge::cvt_pk_bf16(v1[2], v1[3]);
                    bf16_t* dst = region == 0 ? UP + up_index(row, c) : dstb + (size_t)row * 512 + c;
                    *(u32x4*)dst = w;
                }
            }
    }
};

__device__ __forceinline__ float sum8(const float* p) { const ge::f32x4 a = *(const ge::f32x4*)p, b = *(const ge::f32x4*)(p + 4); return ((a[0] + a[1]) + (a[2] + a[3])) + ((b[0] + b[1]) + (b[2] + b[3])); }
__device__ __forceinline__ float sum16(const float* p) { return sum8(p) + sum8(p + 8); }
__device__ __forceinline__ size_t gel_index(int row, int c) { return ((size_t)(c >> 4) * T + row) * HC + (c & 15); }
__device__ __forceinline__ float sigmoidf_(float x) { return __builtin_amdgcn_rcpf(1.f + __expf(-x)); }
struct EpiGlu2 {
    static constexpr bool PERM = true, MIDK = false, UBEGIN = false;
    const bf16_t* GEL; const float* bias; bf16_t* MIX; float* ssp;
    __device__ __forceinline__ void unit_begin(const ge::Unit&, int, LAS unsigned char*) const {}
    __device__ __forceinline__ void midk(ge::f32x4 (&)[2][2][4][2], const ge::Unit&, int, int, LAS unsigned char*) const {}
    __device__ __forceinline__ void operator()(const ge::f32x4 (&acc)[2][2][4][2], const ge::Unit& u, int wr, int wc, int fr, int fq, LAS unsigned char*) const {
        const int row0 = u.pm * 256 + wr * 64 + fr, colt = u.pn * 256;
#pragma unroll
        for (int ai = 0; ai < 2; ++ai)
#pragma unroll
            for (int m = 0; m < 4; ++m) {
                const int row = row0 + ai * 128 + m * 16; float sq = 0.f;
                u32x4 gws[2]; ge::f32x4 bs[2][2];
#pragma unroll
                for (int bj = 0; bj < 2; ++bj) { const int c = colt + bj * 128 + wc * 32 + 8 * fq; bs[bj][0] = *(const ge::f32x4*)(bias + c); bs[bj][1] = *(const ge::f32x4*)(bias + c + 4); gws[bj] = *(const u32x4*)(GEL + gel_index(row, c)); }
#pragma unroll
                for (int bj = 0; bj < 2; ++bj) {
                    const int c = colt + bj * 128 + wc * 32 + 8 * fq;
                    const ge::f32x4 b0 = bs[bj][0], b1 = bs[bj][1];
                    const u32x4 gw = gws[bj];
                    const ge::f32x4 v0 = acc[ai][bj][m][0] + b0, v1 = acc[ai][bj][m][1] + b1;
                    float o[8];
                    o[0] = __uint_as_float(gw.x << 16) * sigmoidf_(v0[0]); o[1] = __uint_as_float(gw.x & 0xffff0000u) * sigmoidf_(v0[1]);
                    o[2] = __uint_as_float(gw.y << 16) * sigmoidf_(v0[2]); o[3] = __uint_as_float(gw.y & 0xffff0000u) * sigmoidf_(v0[3]);
                    o[4] = __uint_as_float(gw.z << 16) * sigmoidf_(v1[0]); o[5] = __uint_as_float(gw.z & 0xffff0000u) * sigmoidf_(v1[1]);
                    o[6] = __uint_as_float(gw.w << 16) * sigmoidf_(v1[2]); o[7] = __uint_as_float(gw.w & 0xffff0000u) * sigmoidf_(v1[3]);
#pragma unroll
                    for (int e = 0; e < 8; ++e) sq += o[e] * o[e];
                    u32x4 w; w.x = ge::cvt_pk_bf16(o[0], o[1]); w.y = ge::cvt_pk_bf16(o[2], o[3]); w.z = ge::cvt_pk_bf16(o[4], o[5]); w.w = ge::cvt_pk_bf16(o[6], o[7]);
                    *(u32x4*)(MIX + (size_t)row * D + c) = w;
                }
                sq += __shfl_xor(sq, 16); sq += __shfl_xor(sq, 32);
                if (fq == 0) ssp[(size_t)row * 8 + u.pn * 4 + wc] = sq;
            }
    }
};
struct EpiWo {
    static constexpr bool PERM = true, MIDK = true, UBEGIN = true;
    const float* ssp_s; const float* ssp_a; const bf16_t* hin; bf16_t* hb; float* ssp2;
    typedef float f32x2_ __attribute__((ext_vector_type(2)));
    __device__ __forceinline__ void unit_begin(const ge::Unit& u, int tid, LAS unsigned char* rowf) const {
        if (tid < 256) { const int row = u.pm * 256 + tid;
            const float rs_s = rsqrtf(sum8(ssp_s + (size_t)row * 8) * (1.f / SSMW) + EPS), rs_a = rsqrtf(sum8(ssp_a + (size_t)row * 8) * (1.f / ATTW) + EPS);
            ((LAS f32x2_*)rowf)[tid] = (f32x2_){rs_s / rs_a, rs_a}; }
    }
    __device__ __forceinline__ void midk(ge::f32x4 (&acc)[2][2][4][2], const ge::Unit& u, int wr, int fr, LAS unsigned char* rowf) const {
#pragma unroll
        for (int ai = 0; ai < 2; ++ai)
#pragma unroll
            for (int m = 0; m < 4; ++m) {
                const float f = ((const LAS f32x2_*)rowf)[ai * 128 + wr * 64 + m * 16 + fr].x;
#pragma unroll
                for (int bj = 0; bj < 2; ++bj)
#pragma unroll
                    for (int n = 0; n < 2; ++n) acc[ai][bj][m][n] = acc[ai][bj][m][n] * f;
            }
    }
    __device__ __forceinline__ void operator()(const ge::f32x4 (&acc)[2][2][4][2], const ge::Unit& u, int wr, int wc, int fr, int fq, LAS unsigned char* rowf) const {
        const int row0 = u.pm * 256 + wr * 64 + fr, colt = u.pn * 256;
#pragma unroll
        for (int ai = 0; ai < 4; ++ai) {
            u32x4 hws[4][2];
#pragma unroll
            for (int m = 2 * (ai & 1); m < 2 * (ai & 1) + 2; ++m)
#pragma unroll
                for (int bj = 0; bj < 2; ++bj) hws[m][bj] = *(const u32x4*)(hin + (size_t)(row0 + (ai >> 1) * 128 + m * 16) * D + colt + bj * 128 + wc * 32 + 8 * fq);
            asm volatile("" ::: "memory"); __builtin_amdgcn_sched_barrier(0);
#pragma unroll
            for (int m = 2 * (ai & 1); m < 2 * (ai & 1) + 2; ++m) {
                const int row = row0 + (ai >> 1) * 128 + m * 16; const float ra = ((const LAS f32x2_*)rowf)[(ai >> 1) * 128 + wr * 64 + m * 16 + fr].y; float sq = 0.f;
#pragma unroll
                for (int bj = 0; bj < 2; ++bj) {
                    const int c = colt + bj * 128 + wc * 32 + 8 * fq;
                    const size_t o = (size_t)row * D + c;
                    const u32x4 hw = hws[m][bj];
                    const ge::f32x4 a0 = acc[ai >> 1][bj][m][0] * ra, a1 = acc[ai >> 1][bj][m][1] * ra;
                    u32x4 w; w.x = ge::cvt_pk_bf16(__uint_as_float(hw.x << 16) + a0[0], __uint_as_float(hw.x & 0xffff0000u) + a0[1]); w.y = ge::cvt_pk_bf16(__uint_as_float(hw.y << 16) + a0[2], __uint_as_float(hw.y & 0xffff0000u) + a0[3]);
                    w.z = ge::cvt_pk_bf16(__uint_as_float(hw.z << 16) + a1[0], __uint_as_float(hw.z & 0xffff0000u) + a1[1]); w.w = ge::cvt_pk_bf16(__uint_as_float(hw.w << 16) + a1[2], __uint_as_float(hw.w & 0xffff0000u) + a1[3]);
                    *(u32x4*)(hb + o) = w;
#pragma unroll
                    for (int e = 0; e < 4; ++e) { const float lo = __uint_as_float(w[e] << 16), hi = __uint_as_float(w[e] & 0xffff0000u); sq += lo * lo + hi * hi; }
                }
                sq += __shfl_xor(sq, 16); sq += __shfl_xor(sq, 32);
                if (fq == 0) ssp2[(size_t)row * 16 + u.pn * 4 + wc] = sq;
            }
            asm volatile("" ::: "memory"); __builtin_amdgcn_sched_barrier(0);
        }
    }
};
struct EpiWq {
    static constexpr bool PERM = true, MIDK = false, UBEGIN = true;
    const float* ssp2; bf16_t* QP;
    __device__ __forceinline__ void unit_begin(const ge::Unit& u, int tid, LAS unsigned char* rowf) const {
        if (tid < 256) { const int row = u.pm * 256 + tid; ((LAS float*)rowf)[tid] = rsqrtf(sum16(ssp2 + (size_t)row * 16) * (1.f / D) + EPS); }
    }
    __device__ __forceinline__ void midk(ge::f32x4 (&)[2][2][4][2], const ge::Unit&, int, int, LAS unsigned char*) const {}
    __device__ __forceinline__ void operator()(const ge::f32x4 (&acc)[2][2][4][2], const ge::Unit& u, int wr, int wc, int fr, int fq, LAS unsigned char* rowf) const {
        const int row0 = u.pm * 256 + wr * 64 + fr, colt = u.pn * 256;
#pragma unroll
        for (int ai = 0; ai < 2; ++ai)
#pragma unroll
            for (int m = 0; m < 4; ++m) {
                const int row = row0 + ai * 128 + m * 16; const float rs = ((const LAS float*)rowf)[ai * 128 + wr * 64 + m * 16 + fr];
#pragma unroll
                for (int bj = 0; bj < 2; ++bj) {
                    const int c = colt + bj * 128 + wc * 32 + 8 * fq;
                    const ge::f32x4 v0 = acc[ai][bj][m][0] * rs, v1 = acc[ai][bj][m][1] * rs;
                    u32x4 w; w.x = ge::cvt_pk_bf16(v0[0], v0[1]); w.y = ge::cvt_pk_bf16(v0[2], v0[3]); w.z = ge::cvt_pk_bf16(v1[0], v1[1]); w.w = ge::cvt_pk_bf16(v1[2], v1[3]);
                    *(u32x4*)(QP + (size_t)row * D + c) = w;
                }
            }
    }
};

__device__ __forceinline__ void ph_flogit(LAS unsigned char* lds, const bf16_t* __restrict__ hb, const bf16_t* __restrict__ wf, const float* __restrict__ ss, const float* __restrict__ bfv, float* __restrict__ logf) {
    PH_IDS
    const int lane = TIDX & 63, gw = BIDX * 8 + __builtin_amdgcn_readfirstlane(TIDX >> 6), ngw = GDIM * 8, r16 = lane & 15, q4 = lane >> 4;
    LAS unsigned char* wfl = lds;
    __syncthreads();
#pragma unroll
    for (int j = 0; j < 4; ++j) { const int ch = TIDX + 512 * j, row = ch >> 7, c = ch & 127; *(LAS bf16x8*)(wfl + row * 2048 + ((c ^ row) * 16)) = *(const bf16x8*)(wf + (size_t)row * D + c * 8); }
    __syncthreads();
    for (int item = gw; item < T / 16; item += ngw) {
        const int tok0 = item * 16;
        ge::f32x4 acc = {0.f, 0.f, 0.f, 0.f};
        const bf16_t* ar = hb + (size_t)(tok0 + r16) * D + q4 * 8; const bf16_t* br = wf + (size_t)r16 * D + q4 * 8;
#pragma unroll
        for (int kh = 0; kh < 2; ++kh) {
            bf16x8 a[16], b[16];
#pragma unroll
            for (int ks = 0; ks < 16; ++ks) { a[ks] = *(const bf16x8*)(ar + (kh * 16 + ks) * 32); b[ks] = *(const LAS bf16x8*)(wfl + r16 * 2048 + (((4 * (kh * 16 + ks) + q4) ^ r16) * 16)); }
            asm volatile("" ::: "memory"); __builtin_amdgcn_sched_barrier(0);
#pragma unroll
            for (int ks = 0; ks < 16; ++ks) acc = __builtin_amdgcn_mfma_f32_16x16x32_bf16(a[ks], b[ks], acc, 0, 0, 0);
            asm volatile("" : "+v"(acc) :: "memory"); __builtin_amdgcn_sched_barrier(0);
        }
        if (r16 < NH) {
            const float bj = bfv[r16];
#pragma unroll
            for (int r = 0; r < 4; ++r) {
                const int tok = tok0 + 4 * q4 + r; const float x = acc[r] * rsqrtf(sum8(ss + (size_t)tok * 8) * (1.f / D) + EPS) + bj;
                logf[(size_t)tok * NH + r16] = fminf(x, 0.f) - log1pf(expf(-fabsf(x)));
            }
        }
    }
}
}
namespace nv {
__device__ __forceinline__ float gelu_fast(float x);
constexpr float USCALE = 256.f, VSCALE = 16.f;
typedef float f32x2 __attribute__((ext_vector_type(2)));
typedef int i32x2 __attribute__((ext_vector_type(2)));
__device__ __forceinline__ float clamp448(float x) { return fminf(fmaxf(x, -448.f), 448.f); }
__device__ __forceinline__ unsigned pack4_fp8(float a, float b, float c, float d) {
    int w = 0; w = __builtin_amdgcn_cvt_pk_fp8_f32(clamp448(a), clamp448(b), w, false); w = __builtin_amdgcn_cvt_pk_fp8_f32(clamp448(c), clamp448(d), w, true); return (unsigned)w; }

__device__ __forceinline__ void peer_split(LAS unsigned char* lds, int bid, int grid, int wave, int& slice, int& gw, int& ngw) {
    volatile LAS unsigned* M = (volatile LAS unsigned*)(lds + 131072 + 320);
    const unsigned x = __builtin_amdgcn_readfirstlane(M[16]), rk = __builtin_amdgcn_readfirstlane(M[17]), nl = __builtin_amdgcn_readfirstlane(M[18]), ok = __builtin_amdgcn_readfirstlane(M[19]);
    if (ok) { slice = (int)x; gw = (int)rk * 8 + wave; ngw = (int)nl * 8; }
    else { slice = bid & 7; gw = (bid >> 3) * 8 + wave; ngw = (grid >> 3) * 8; }
}
__device__ __forceinline__ unsigned pack4_i8(float a, float b, float c, float d) {
    const int ia = (int)rintf(a), ib = (int)rintf(b), ic = (int)rintf(c), id = (int)rintf(d);
    return (unsigned)(ia & 0xff) | ((unsigned)(ib & 0xff) << 8) | ((unsigned)(ic & 0xff) << 16) | ((unsigned)id << 24); }
__device__ __forceinline__ void p0_peer_tables(const float* __restrict__ pu, const float* __restrict__ pv, const float* __restrict__ g2, unsigned char* __restrict__ PU8, unsigned char* __restrict__ PV8, float* __restrict__ US) {
    PH_IDS
    const size_t n16 = (size_t)DEPTH * NEXP * D / 16;
    const size_t stride = (size_t)GDIM * 512;
    constexpr int NU = 4;
    for (size_t i0 = (size_t)BIDX * 512 + TIDX; i0 < 2 * n16; i0 += NU * stride) {
        f32x4 x[NU][4];
#pragma unroll
        for (int u = 0; u < NU; ++u) { const size_t i = i0 + u * stride;
            if (i < 2 * n16) { const bool isv = i >= n16; const float* src = (isv ? pv : pu) + (isv ? i - n16 : i) * 16;
#pragma unroll
                for (int k = 0; k < 4; ++k) x[u][k] = *(const f32x4*)(src + 4 * k); } }
#pragma unroll
        for (int u = 0; u < NU; ++u) { const size_t i = i0 + u * stride;
            if (i < 2 * n16) {
                const bool isv = i >= n16; const size_t e0 = (isv ? i - n16 : i) * 16;
                const int l = (int)(e0 / ((size_t)NEXP * D)), c = (int)(e0 % D);
                const size_t er = (e0 / D) % NEXP;
                u32x4 o;
                if (isv) {
#pragma unroll
                    for (int k = 0; k < 4; ++k) o[k] = pack4_fp8(x[u][k].x * VSCALE, x[u][k].y * VSCALE, x[u][k].z * VSCALE, x[u][k].w * VSCALE);
                } else {
                    f32x4 y[4]; float m = 0.f;
#pragma unroll
                    for (int k = 0; k < 4; ++k) { y[k] = x[u][k] * *(const f32x4*)(g2 + l * D + c + 4 * k); m = fmaxf(fmaxf(m, fmaxf(fabsf(y[k].x), fabsf(y[k].y))), fmaxf(fabsf(y[k].z), fabsf(y[k].w))); }
                    m = fmaxf(wave_max(m), 1e-30f);
                    const float inv = 7.f / m;
                    unsigned w2[2] = {0u, 0u};
#pragma unroll
                    for (int k = 0; k < 4; ++k) { const int q0 = (int)rintf(y[k].x * inv), q1 = (int)rintf(y[k].y * inv), q2 = (int)rintf(y[k].z * inv), q3 = (int)rintf(y[k].w * inv);
                        w2[k >> 1] |= ((unsigned)(q0 & 15) | ((unsigned)(q1 & 15) << 4) | ((unsigned)(q2 & 15) << 8) | ((unsigned)(q3 & 15) << 12)) << (16 * (k & 1)); }
                    if ((TIDX & 63) == 0) US[(size_t)l * NEXP + er] = m * (1.f / 7.f);
                    *(ge::u32x2*)(PU8 + (size_t)l * NEXP * D + ((size_t)(c >> 8) * NEXP + er) * 128 + ((c & 255) >> 1)) = (ge::u32x2){w2[0], w2[1]};
                }
                if (isv) *(u32x4*)(PV8 + (((size_t)l * 8 + (c >> 7)) * NEXP + er) * 128 + (c & 127)) = o;
            } }
    }
}

#if defined(PROBE_MASK)
#define PEER_FORCE_SIMPLE ((PROBE_MASK >> 26) & 1)
#else
#define PEER_FORCE_SIMPLE 0
#endif
#ifndef PU_LOOK
#define PU_LOOK 7
#endif
#ifndef PV_LO
#define PV_LO 0
#endif
#ifndef PV_LOOK
#define PV_LOOK 7
#endif
constexpr int PB = 16;
#define DPPI(x, CTRL) __builtin_amdgcn_update_dpp(0, (x), (CTRL), 0xF, 0xF, true)
template <int MODE = 0, int LOOKU = PU_LOOK>
__device__ __forceinline__ void ph_peer_u(LAS unsigned char* lds, const unsigned char* __restrict__ PU8, const bf16_t* __restrict__ hb, const unsigned short* __restrict__ idx, bf16_t* __restrict__ partial, int imask = 0x7fffffff) {
    PH_IDS
    const int lane = TIDX & 63, wave = __builtin_amdgcn_readfirstlane(TIDX >> 6), c8 = lane & 7, rg = lane >> 3;
    int slice, gw, ngw; peer_split(lds, BIDX, GDIM, wave, slice, gw, ngw);
    { const int half_ = slice & 1; slice >>= 1; gw = 2 * gw + half_; ngw *= 2; }
    const unsigned char* tab = PU8 + (size_t)slice * NEXP * 128; const unsigned lo16 = 16u * c8;
    LAS int* li = (LAS int*)(lds + wave * 12288);
    LAS unsigned short* lha = (LAS unsigned short*)(lds + wave * 12288 + 8192);
    LAS unsigned short* lhb = lha + PB * 64;
    LAS float* lsc = (LAS float*)(lds + 8 * 12288 + 8 * 512 + wave * 64);
    LAS float* tr = (LAS float*)(lds + 8 * 12288 + wave * 512);
    const int ntok = gw < T ? (T - gw + ngw - 1) / ngw : 0;
    const int sd0 = (lane >> 5) * 64 + (lane & 7) * 8 + ((2 * (lane >> 3)) & 7), sd1 = sd0 + 1;
    const bool b2 = (c8 & 4) != 0, b1 = (c8 & 2) != 0, b0 = (c8 & 1) != 0;
    const int i0 = 8 * (int)b2 + 4 * (int)b0 + 2 * (int)b1, pown = (i0 >> 1) * 16 + 2 * rg;
#define PU_SLOAD(k, IW, HW) do { const size_t ts_ = (size_t)gw + (size_t)min((k), ntok - 1) * ngw; IW = *(const unsigned*)(idx + ts_ * 128 + 2 * lane); HW = *(const ge::u32x2*)(hb + ts_ * D + 256 * slice + 4 * lane); } while (0)
#define PU_SWRITE(k, IW, HW) do { LAS int* d_ = li + ((k) & (PB - 1)) * 128; d_[sd0] = (int)((IW) & 0xffffu) & imask; d_[sd1] = (int)((IW) >> 16) & imask; \
            const float h0_ = __uint_as_float((HW).x << 16), h1_ = __uint_as_float((HW).x & 0xffff0000u), h2_ = __uint_as_float((HW).y << 16), h3_ = __uint_as_float((HW).y & 0xffff0000u); \
            const float m_ = fmaxf(wave_max(fmaxf(fmaxf(fabsf(h0_), fabsf(h1_)), fmaxf(fabsf(h2_), fabsf(h3_)))), 1e-30f), inv_ = 119.f / m_; \
            const int q0_ = (int)rintf(h0_ * inv_), q1_ = (int)rintf(h1_ * inv_), q2_ = (int)rintf(h2_ * inv_), q3_ = (int)rintf(h3_ * inv_);        \
            const int a0_ = (q0_ + 8) >> 4, a1_ = (q1_ + 8) >> 4, a2_ = (q2_ + 8) >> 4, a3_ = (q3_ + 8) >> 4; \
            lha[((k) & (PB - 1)) * 64 + lane] = (unsigned short)((a0_ & 15) | ((a1_ & 15) << 4) | ((a2_ & 15) << 8) | ((a3_ & 15) << 12)); \
            lhb[((k) & (PB - 1)) * 64 + lane] = (unsigned short)(((q0_ - 16 * a0_) & 15) | (((q1_ - 16 * a1_) & 15) << 4) | (((q2_ - 16 * a2_) & 15) << 8) | (((q3_ - 16 * a3_) & 15) << 12)); \
            if (lane == 0) lsc[(k) & (PB - 1)] = m_ * (1.f / 119.f); } while (0)
#define PU_ISSUE(s, B) do { const ge::u32x4 ia_ = *(const LAS ge::u32x4*)(li + (((s) >> 1) & (2 * PB - 1)) * 64 + rg * 8 + 4 * ((s) & 1)); \
            _Pragma("unroll") for (int i_ = 0; i_ < 4; ++i_) rb[B][i_] = *(const u32x4*)(tab + (ia_[i_] * 128u + lo16)); } while (0)
#define PU_STEP(s, B, QT, ISS) do { if (ISS) { PU_ISSUE((s) + LOOKU, ((B) + LOOKU) & 7); asm volatile("" ::: "memory"); __builtin_amdgcn_sched_barrier(0); } \
            const int k_ = (s) >> 2; const size_t t_ = (size_t)gw + (size_t)k_ * ngw; \
            if (QT == 0) { hxa = *((const LAS ge::u32x4*)(lha + (k_ & (PB - 1)) * 64) + c8); hxb = *((const LAS ge::u32x4*)(lhb + (k_ & (PB - 1)) * 64) + c8); }          \
            _Pragma("unroll") for (int i = 0; i < 4; ++i) { int dh = 0, dl = 0; _Pragma("unroll") for (int k = 0; k < 4; ++k) { \
                dh = __builtin_amdgcn_sdot8((int)rb[B][i][k], (int)hxa[k], dh, false); dl = __builtin_amdgcn_sdot8((int)rb[B][i][k], (int)hxb[k], dl, false); } pv[4 * QT + i] = 16 * dh + dl; } \
            if (QT == 3) { int y[8], z[4]; \
                _Pragma("unroll") for (int j = 0; j < 8; ++j) { const int keep = b2 ? pv[8 + j] : pv[j], send = b2 ? pv[j] : pv[8 + j]; y[j] = keep + DPPI(send, 0x141); }       \
                _Pragma("unroll") for (int j = 0; j < 4; ++j) { const int keep = b0 ? y[4 + j] : y[j], send = b0 ? y[j] : y[4 + j]; z[j] = keep + DPPI(send, 0xB1); }          \
                const int o0 = (b1 ? z[2] : z[0]) + DPPI(b1 ? z[0] : z[2], 0x4E), o1 = (b1 ? z[3] : z[1]) + DPPI(b1 ? z[1] : z[3], 0x4E);                                    \
                const float st_ = lsc[k_ & (PB - 1)]; \
                *(unsigned*)(partial + ((size_t)slice * T + t_) * 128 + pown) = pk2((float)o0 * st_, (float)o1 * st_); }        \
            asm volatile("" : "+v"(pv[4 * QT]), "+v"(pv[4 * QT + 1]), "+v"(pv[4 * QT + 2]), "+v"(pv[4 * QT + 3]) :: "memory"); __builtin_amdgcn_sched_barrier(0); } while (0)
    int simple_ = PEER_FORCE_SIMPLE; asm volatile("" : "+s"(simple_));
    if (ntok >= 8 && !(ntok & 1) && !simple_) {
        u32x4 rb[8][4]; int pv[16]; ge::u32x4 hxa, hxb; unsigned xi, yi; ge::u32x2 xh, yh;
        { unsigned a_[6]; ge::u32x2 b_[6];
#pragma unroll
            for (int k = 0; k < 6; ++k) PU_SLOAD(k, a_[k], b_[k]);
            PU_SLOAD(6, xi, xh); PU_SLOAD(7, yi, yh);
#pragma unroll
            for (int k = 0; k < 6; ++k) PU_SWRITE(k, a_[k], b_[k]); }
        asm volatile("s_waitcnt vmcnt(0) lgkmcnt(0)" ::: "memory");
#define ORD_ asm volatile("" ::: "memory"); __builtin_amdgcn_sched_barrier(0);
        PU_ISSUE(0, 0); ORD_ PU_ISSUE(1, 1); ORD_ PU_ISSUE(2, 2); ORD_ PU_ISSUE(3, 3); ORD_ if (LOOKU > 4) { PU_ISSUE(4, 4); ORD_ } if (LOOKU > 5) { PU_ISSUE(5, 5); ORD_ } if (LOOKU > 6) { PU_ISSUE(6, 6); ORD_ }
#undef ORD_
        const int send = 4 * ntok - 8;
#pragma nounroll
        for (int s0 = 0; s0 < send; s0 += 8) {
            PU_SWRITE((s0 >> 2) + 6, xi, xh); PU_SLOAD((s0 >> 2) + 8, xi, xh);
            PU_STEP(s0, 0, 0, 1); PU_STEP(s0 + 1, 1, 1, 1); PU_STEP(s0 + 2, 2, 2, 1); PU_STEP(s0 + 3, 3, 3, 1);
            PU_SWRITE((s0 >> 2) + 7, yi, yh); PU_SLOAD((s0 >> 2) + 9, yi, yh);
            PU_STEP(s0 + 4, 4, 0, 1); PU_STEP(s0 + 5, 5, 1, 1); PU_STEP(s0 + 6, 6, 2, 1); PU_STEP(s0 + 7, 7, 3, 1); }
        { const int s0 = send; PU_STEP(s0, 0, 0, (0 + LOOKU <= 7)); PU_STEP(s0 + 1, 1, 1, (1 + LOOKU <= 7)); PU_STEP(s0 + 2, 2, 2, (2 + LOOKU <= 7)); PU_STEP(s0 + 3, 3, 3, 0); PU_STEP(s0 + 4, 4, 0, 0); PU_STEP(s0 + 5, 5, 1, 0); PU_STEP(s0 + 6, 6, 2, 0); PU_STEP(s0 + 7, 7, 3, 0); }
    } else {
        u32x4 rb[8][4]; int pv[16]; ge::u32x4 hxa, hxb;
#pragma nounroll
        for (int k = 0; k < ntok; ++k) {
            { unsigned a_; ge::u32x2 b_; PU_SLOAD(k, a_, b_); PU_SWRITE(k, a_, b_); } asm volatile("s_waitcnt vmcnt(0) lgkmcnt(0)" ::: "memory");
            const int s0 = 4 * k; PU_ISSUE(s0, 0); PU_ISSUE(s0 + 1, 1); PU_ISSUE(s0 + 2, 2); PU_ISSUE(s0 + 3, 3);
            PU_STEP(s0, 0, 0, 0); PU_STEP(s0 + 1, 1, 1, 0); PU_STEP(s0 + 2, 2, 2, 0); PU_STEP(s0 + 3, 3, 3, 0); }
    }
#undef PU_SLOAD
#undef PU_SWRITE
#undef PU_ISSUE
#undef PU_STEP
    asm volatile("s_waitcnt lgkmcnt(0)" ::: "memory");
}

constexpr float CSCALE = 32.f;
__device__ __forceinline__ void ph_peer_coef(LAS unsigned char* lds, const bf16_t* __restrict__ partial, const float* __restrict__ ssp2, const float* __restrict__ gate, const unsigned short* __restrict__ idx, const float* __restrict__ us_g, unsigned short* __restrict__ coef8) {
    PH_IDS
    LAS float* us = (LAS float*)lds;
    __syncthreads();
#pragma unroll
    for (int j = 0; j < NEXP / (4 * 512); ++j) *(LAS f32x4*)(us + 4 * (TIDX + 512 * j)) = *(const f32x4*)(us_g + 4 * (TIDX + 512 * j));
    __syncthreads();
    const size_t n4 = (size_t)T * 128 / 4, stride = (size_t)GDIM * 512;
    constexpr int NG = 4;
    for (size_t i0 = (size_t)BIDX * 512 + TIDX; i0 < n4; i0 += NG * stride) {
        ge::u32x2 pv[NG][4]; f32x4 gv[NG], se[NG]; float rs[NG];
#pragma unroll
        for (int u = 0; u < NG; ++u) { const size_t i = i0 + u * stride;
            if (i < n4) {
                const ge::u32x2 iw = *(const ge::u32x2*)(idx + 4 * i);
                se[u] = (f32x4){us[iw.x & 0xffffu], us[iw.x >> 16], us[iw.y & 0xffffu], us[iw.y >> 16]};
#pragma unroll
                for (int k = 0; k < 4; ++k) pv[u][k] = *(const ge::u32x2*)(partial + (size_t)k * T * 128 + 4 * i);
                gv[u] = *(const f32x4*)(gate + 4 * i); rs[u] = sum16(ssp2 + (i >> 5) * 16);
            } }
#pragma unroll
        for (int u = 0; u < NG; ++u) { const size_t i = i0 + u * stride;
            if (i < n4) {
                f32x4 s = {0.f, 0.f, 0.f, 0.f};
#pragma unroll
                for (int k = 0; k < 4; ++k) { s.x += __uint_as_float(pv[u][k].x << 16); s.y += __uint_as_float(pv[u][k].x & 0xffff0000u); s.z += __uint_as_float(pv[u][k].y << 16); s.w += __uint_as_float(pv[u][k].y & 0xffff0000u); }
                const float sc = rsqrtf(rs[u] * (1.f / D) + EPS);
                f32x4 o; o.x = gelu_fast(s.x * sc * se[u].x) * gv[u].x * CSCALE; o.y = gelu_fast(s.y * sc * se[u].y) * gv[u].y * CSCALE; o.z = gelu_fast(s.z * sc * se[u].z) * gv[u].z * CSCALE; o.w = gelu_fast(s.w * sc * se[u].w) * gv[u].w * CSCALE;
                const unsigned hi = pack4_fp8(o.x, o.y, o.z, o.w);
                *(ge::u32x2*)(coef8 + 4 * i) = (ge::u32x2){(hi & 0xffu) | ((hi & 0xff00u) << 8), ((hi >> 16) & 0xffu) | ((hi >> 8) & 0xff0000u)};
            } }
    }
}

template <int MODE = 0>
__device__ __forceinline__ void ph_peer_v(LAS unsigned char* lds, const unsigned char* __restrict__ PV8, const unsigned short* __restrict__ idx, const unsigned short* __restrict__ coef8, const bf16_t* hin, bf16_t* hb, float* __restrict__ ssp1, int imask = 0x7fffffff) {
    PH_IDS
    const int lane = TIDX & 63, wave = __builtin_amdgcn_readfirstlane(TIDX >> 6), c8 = lane & 7, rg = lane >> 3;
    int slice, gw, ngw; peer_split(lds, BIDX, GDIM, wave, slice, gw, ngw);
    const unsigned char* tab = PV8 + (size_t)slice * NEXP * 128; const unsigned lo16 = 16u * c8;
    LAS int* li = (LAS int*)(lds + wave * 16384);
    LAS unsigned short* lc = (LAS unsigned short*)(lds + wave * 16384 + 8192);
    LAS unsigned* lr = (LAS unsigned*)(lds + wave * 16384 + 12288);
    LAS float* tr = (LAS float*)(lds + ge::ROWF_OFF + wave * 1024);
    const int ntok = gw < T ? (T - gw + ngw - 1) / ngw : 0;
    const int p0 = 2 * lane, sd0 = (p0 >> 6) * 64 + (p0 & 7) * 8 + ((p0 & 63) >> 3), sd1 = sd0 + 8;
    const unsigned bsh = 8u * (c8 & 3), mlo = c8 < 4 ? 0xffffffffu : 0u, mhi = ~mlo;
    const int nn = lane & 15, qq = lane >> 4; const bool dvalid = (nn >> 3) == (qq >> 1);
    const int dcol = 64 * (qq & 1) + (nn & 7);
#define PV_SLOAD(k, IW, CW, RW) do { const size_t ts_ = (size_t)gw + (size_t)min((k), ntok - 1) * ngw; IW = *(const unsigned*)(idx + ts_ * 128 + 2 * lane); CW = *(const unsigned*)(coef8 + ts_ * 128 + 2 * lane); \
            RW = *(const unsigned*)(hin + ts_ * D + 128 * slice + 2 * lane); } while (0)
#define PV_SWRITE(k, IW, CW, RW) do { const int o_ = ((k) & (PB - 1)) * 128; li[o_ + sd0] = (int)((IW) & 0xffffu) & imask; li[o_ + sd1] = (int)((IW) >> 16) & imask; \
            lc[o_ + sd0] = (unsigned short)((CW) & 0xffffu); lc[o_ + sd1] = (unsigned short)((CW) >> 16); lr[((k) & (PB - 1)) * 64 + lane] = (RW); } while (0)
#define PV_ISSUE(s, B) do { const ge::u32x4 ia_ = *(const LAS ge::u32x4*)(li + (((s) >> 1) & (2 * PB - 1)) * 64 + rg * 8 + 4 * ((s) & 1)); \
            _Pragma("unroll") for (int i_ = 0; i_ < 4; ++i_) rb[B][i_] = *(const u32x4*)(tab + (ia_[i_] * 128u + lo16)); } while (0)
#define PV_STEP(s, B, QT, ISS) do { if (ISS) { PV_ISSUE((s) + PV_LOOK, ((B) + PV_LOOK) & 7); asm volatile("" ::: "memory"); __builtin_amdgcn_sched_barrier(0); } \
            const int k_ = (s) >> 2; const size_t t_ = (size_t)gw + (size_t)k_ * ngw; \
            if (QT == 0) { acc0 = (ge::f32x4){0.f, 0.f, 0.f, 0.f}; acc1 = acc0; } \
            const ge::u32x2 cw_ = *(const LAS ge::u32x2*)(lc + (((s) >> 1) & (2 * PB - 1)) * 64 + rg * 8 + 4 * ((s) & 1));                       \
            _Pragma("unroll") for (int i = 0; i < 4; ++i) { const unsigned w_ = (i < 2 ? cw_.x : cw_.y) >> (16 * (i & 1)); \
                const unsigned th_ = (w_ & 0xffu) << bsh, tl_ = ((w_ >> 8) & 0xffu) << bsh; \
                const long bh_ = (long)(((unsigned long long)(th_ & mhi) << 32) | (th_ & mlo)), bl_ = (long)(((unsigned long long)(tl_ & mhi) << 32) | (tl_ & mlo)); \
                const u32x4 av = rb[B][i]; const long a0_ = (long)(((unsigned long long)av.y << 32) | av.x), a1_ = (long)(((unsigned long long)av.w << 32) | av.z); \
                acc0 = __builtin_amdgcn_mfma_f32_16x16x32_fp8_fp8(a0_, bh_, acc0, 0, 0, 0); acc1 = __builtin_amdgcn_mfma_f32_16x16x32_fp8_fp8(a1_, bh_, acc1, 0, 0, 0); \
                if (PV_LO) { acc0 = __builtin_amdgcn_mfma_f32_16x16x32_fp8_fp8(a0_, bl_, acc0, 0, 0, 0); acc1 = __builtin_amdgcn_mfma_f32_16x16x32_fp8_fp8(a1_, bl_, acc1, 0, 0, 0); } } \
            if (QT == 3) { \
                if (dvalid) { LAS float* tp_ = tr + 128 * (qq >> 1) + dcol; _Pragma("unroll") for (int i = 0; i < 4; ++i) { tp_[16 * i] = acc0[i]; tp_[16 * i + 8] = acc1[i]; } } \
                const f32x2 e0_ = *(const LAS f32x2*)(tr + 2 * lane), e1_ = *(const LAS f32x2*)(tr + 128 + 2 * lane);                 \
                const unsigned hv = lr[(k_ & (PB - 1)) * 64 + lane];                                                                     \
                const unsigned w2_ = pk2(__uint_as_float(hv << 16) + (e0_.x + e1_.x) * (1.f / (VSCALE * CSCALE)), __uint_as_float(hv & 0xffff0000u) + (e0_.y + e1_.y) * (1.f / (VSCALE * CSCALE))); \
                *(unsigned*)(hb + t_ * D + 128 * slice + 2 * lane) = w2_; const float x0 = __uint_as_float(w2_ << 16), x1 = __uint_as_float(w2_ & 0xffff0000u); \
                float sq = x0 * x0 + x1 * x1; sq = wave_sum(sq); if (lane == 0) ssp1[t_ * 8 + slice] = sq; } \
            asm volatile("" : "+v"(acc0), "+v"(acc1) :: "memory");             \
            __builtin_amdgcn_sched_barrier(0); } while (0)
    int simple_ = PEER_FORCE_SIMPLE; asm volatile("" : "+s"(simple_));
    if (ntok >= 8 && !(ntok & 1) && !simple_) {
        u32x4 rb[8][4]; ge::f32x4 acc0, acc1; unsigned xi, xc, xr, yi, yc, yr;
        { unsigned a_[6], b_[6], c_[6];
#pragma unroll
            for (int k = 0; k < 6; ++k) PV_SLOAD(k, a_[k], b_[k], c_[k]);
            PV_SLOAD(6, xi, xc, xr); PV_SLOAD(7, yi, yc, yr);
#pragma unroll
            for (int k = 0; k < 6; ++k) PV_SWRITE(k, a_[k], b_[k], c_[k]); }
        asm volatile("s_waitcnt vmcnt(0) lgkmcnt(0)" ::: "memory");
#define ORD_ asm volatile("" ::: "memory"); __builtin_amdgcn_sched_barrier(0);
        PV_ISSUE(0, 0); ORD_ PV_ISSUE(1, 1); ORD_ PV_ISSUE(2, 2); ORD_ PV_ISSUE(3, 3); ORD_ if (PV_LOOK > 4) { PV_ISSUE(4, 4); ORD_ } if (PV_LOOK > 5) { PV_ISSUE(5, 5); ORD_ } if (PV_LOOK > 6) { PV_ISSUE(6, 6); ORD_ }
#undef ORD_
        const int send = 4 * ntok - 8;
#pragma nounroll
        for (int s0 = 0; s0 < send; s0 += 8) {
            PV_SWRITE((s0 >> 2) + 6, xi, xc, xr); PV_SLOAD((s0 >> 2) + 8, xi, xc, xr);
            PV_STEP(s0, 0, 0, 1); PV_STEP(s0 + 1, 1, 1, 1); PV_STEP(s0 + 2, 2, 2, 1); PV_STEP(s0 + 3, 3, 3, 1);
            PV_SWRITE((s0 >> 2) + 7, yi, yc, yr); PV_SLOAD((s0 >> 2) + 9, yi, yc, yr);
            PV_STEP(s0 + 4, 4, 0, 1); PV_STEP(s0 + 5, 5, 1, 1); PV_STEP(s0 + 6, 6, 2, 1); PV_STEP(s0 + 7, 7, 3, 1); }
        { const int s0 = send; PV_STEP(s0, 0, 0, (0 + PV_LOOK <= 7)); PV_STEP(s0 + 1, 1, 1, (1 + PV_LOOK <= 7)); PV_STEP(s0 + 2, 2, 2, (2 + PV_LOOK <= 7)); PV_STEP(s0 + 3, 3, 3, 0); PV_STEP(s0 + 4, 4, 0, 0); PV_STEP(s0 + 5, 5, 1, 0); PV_STEP(s0 + 6, 6, 2, 0); PV_STEP(s0 + 7, 7, 3, 0); }
    } else {
        u32x4 rb[8][4]; ge::f32x4 acc0, acc1;
#pragma nounroll
        for (int k = 0; k < ntok; ++k) {
            { unsigned a_, b_, c_; PV_SLOAD(k, a_, b_, c_); PV_SWRITE(k, a_, b_, c_); } asm volatile("s_waitcnt vmcnt(0) lgkmcnt(0)" ::: "memory");
            const int s0 = 4 * k; PV_ISSUE(s0, 0); PV_ISSUE(s0 + 1, 1); PV_ISSUE(s0 + 2, 2); PV_ISSUE(s0 + 3, 3);
            PV_STEP(s0, 0, 0, 0); PV_STEP(s0 + 1, 1, 1, 0); PV_STEP(s0 + 2, 2, 2, 0); PV_STEP(s0 + 3, 3, 3, 0); }
    }
#undef PV_SLOAD
#undef PV_SWRITE
#undef PV_ISSUE
#undef PV_STEP
    asm volatile("s_waitcnt lgkmcnt(0)" ::: "memory");
}

__device__ __forceinline__ void ph_final(const bf16_t* __restrict__ hb, const float* __restrict__ ssp1, const float* __restrict__ g, float* __restrict__ out) {
    PH_IDS
    const int lane = TIDX & 63, gw = BIDX * 8 + __builtin_amdgcn_readfirstlane(TIDX >> 6), ngw = GDIM * 8;
    constexpr int NR = 4;
    const f32x4* gg = (const f32x4*)g;
    for (int w0 = gw; w0 < T; w0 += NR * ngw) {
        u32x4 v[NR][2]; f32x4 sa[NR], sb[NR];
#pragma unroll
        for (int u = 0; u < NR; ++u) { const int w = min(w0 + u * ngw, T - 1); const u32x4* r = (const u32x4*)(hb + (size_t)w * D) + lane;
            v[u][0] = r[0]; v[u][1] = r[64]; sa[u] = *(const f32x4*)(ssp1 + (size_t)w * 8); sb[u] = *(const f32x4*)(ssp1 + (size_t)w * 8 + 4); }
#pragma unroll
        for (int u = 0; u < NR; ++u) { const int w = w0 + u * ngw; if (w < T) {
            const float rs = rsqrtf((((sa[u][0] + sa[u][1]) + (sa[u][2] + sa[u][3])) + ((sb[u][0] + sb[u][1]) + (sb[u][2] + sb[u][3]))) * (1.f / D) + EPS);
            f32x4* o = (f32x4*)(out + (size_t)w * D);
#pragma unroll
            for (int j = 0; j < 2; ++j) { const u32x4 x = v[u][j]; const int c4 = (64 * j + lane) * 2; const f32x4 g0 = gg[c4], g1 = gg[c4 + 1];
                o[c4] = (f32x4){__uint_as_float(x.x << 16) * rs * g0.x, __uint_as_float(x.x & 0xffff0000u) * rs * g0.y, __uint_as_float(x.y << 16) * rs * g0.z, __uint_as_float(x.y & 0xffff0000u) * rs * g0.w};
                o[c4 + 1] = (f32x4){__uint_as_float(x.z << 16) * rs * g1.x, __uint_as_float(x.z & 0xffff0000u) * rs * g1.y, __uint_as_float(x.w << 16) * rs * g1.z, __uint_as_float(x.w & 0xffff0000u) * rs * g1.w}; }
        } }
    }
}
}
namespace attn_body {
using bf16=__hip_bfloat16;
using bf16x8=__attribute__((ext_vector_type(8)))short;
using s16x4=__attribute__((ext_vector_type(4)))short;
using f32x16=__attribute__((ext_vector_type(16)))float;
using u32x4=__attribute__((ext_vector_type(4)))unsigned;
constexpr int BATCH=8,NHEAD=8,SEQ=4096,D=64,DM=NHEAD*D;
constexpr int OPITCH=1024,OCOL=512;
constexpr int NW=8,QBLK=32,QB=QBLK*NW,KVBLK=64,NQB=SEQ/QB;
constexpr int ATTN_PITCH=DM, ATTN_UNIT_ROWS=QB;
__device__ __forceinline__ int crow(int r,int hi){return (r&3)+8*(r>>2)+4*hi;}
#define SBAR() __builtin_amdgcn_sched_barrier(0)
__device__ __forceinline__ void cmask(f32x16&p0,f32x16&p1,int jb,int qrel,int hi){
  const float NEG=-INFINITY; int kb=64*jb+4*hi;
  #pragma unroll
  for(int r=0;r<16;++r){int kv=kb+(r&3)+8*(r>>2); if(kv>qrel)p0[r]=NEG; if(kv+32>qrel)p1[r]=NEG;}
}

constexpr int NSLOT=3, SLOTB=8192;
constexpr int LDS_K=0, LDS_V=NSLOT*SLOTB, LDS_WS=2*NSLOT*SLOTB, LDS_OST=LDS_WS+NW*64*4, LDS_CUM=LDS_OST+NW*4096, LDS_BYTES=LDS_CUM+SEQ*4;
constexpr float PRUNE_T=48.f;
constexpr float C2=0.125f*1.4426950408889634f;
__device__ __forceinline__ void glds16(const void*gsrc,unsigned lds_dst){unsigned keep;
  asm volatile("s_mov_b32 %0, m0\n\ts_mov_b32 m0, %2\n\ts_nop 0\n\tglobal_load_lds_dwordx4 %1, off\n\ts_mov_b32 m0, %0":"=&s"(keep):"v"(gsrc),"s"(lds_dst):"memory");}
__device__ __forceinline__ float max3f(float a,float b,float c){float r;asm("v_max3_f32 %0, %1, %2, %3":"=v"(r):"v"(a),"v"(b),"v"(c));return r;}
__device__ __forceinline__ float max2f(float a,float b){float r;asm("v_max_f32_e32 %0, %1, %2":"=v"(r):"v"(a),"v"(b));return r;}
__device__ __forceinline__ float fadd_s(float a,float b){float r;asm("v_add_f32_e32 %0, %1, %2":"=v"(r):"v"(a),"v"(b));return r;}
__device__ __forceinline__ float fsub_s(float a,float b){float r;asm("v_sub_f32_e32 %0, %1, %2":"=v"(r):"v"(a),"v"(b));return r;}
typedef float f32x4_t __attribute__((ext_vector_type(4)));
typedef float f32x2_t __attribute__((ext_vector_type(2))); typedef __bf16 bf16x2_t __attribute__((ext_vector_type(2)));
__device__ __forceinline__ unsigned cvtpk_s(float lo,float hi){f32x2_t v={lo,hi};bf16x2_t b=__builtin_convertvector(v,bf16x2_t);return __builtin_bit_cast(unsigned,b);}
#define WAIT_BAR(N) asm volatile("s_waitcnt vmcnt(" #N ") lgkmcnt(0)\n\ts_barrier":::"memory")

__device__ __forceinline__ void qkt(f32x16&p0,f32x16&p1,const char*Kslot,const bf16x8*qr,const f32x16&negm,int r32,int hi){
  const char*kb=Kslot+r32*128+((hi^(r32&1))*16); const int kx=(r32&6)*16;
  #pragma unroll
  for(int d0=0;d0<4;++d0){
    const bf16x8 b0=*reinterpret_cast<const bf16x8*>(kb+(kx^(32*d0)));
    const bf16x8 b1=*reinterpret_cast<const bf16x8*>(kb+(kx^(32*d0))+4096);
    if(d0==0){p0=__builtin_amdgcn_mfma_f32_32x32x16_bf16(b0,qr[0],negm,0,0,0);p1=__builtin_amdgcn_mfma_f32_32x32x16_bf16(b1,qr[0],negm,0,0,0);}
    else{p0=__builtin_amdgcn_mfma_f32_32x32x16_bf16(b0,qr[d0],p0,0,0,0);p1=__builtin_amdgcn_mfma_f32_32x32x16_bf16(b1,qr[d0],p1,0,0,0);}}
}
typedef __attribute__((address_space(3))) const char* lds_cptr;
typedef short v4i16_t __attribute__((ext_vector_type(4)));
__device__ __forceinline__ void kload2(bf16x8*kf,lds_cptr kp,int kx,int j){ kf[2*j]=*(const __attribute__((address_space(3))) bf16x8*)(kp+(kx^(32*j))); kf[2*j+1]=*(const __attribute__((address_space(3))) bf16x8*)(kp+(kx^(32*j))+4096); }
__device__ __forceinline__ void kload8(bf16x8*kf,lds_cptr kp,int kx){ kload2(kf,kp,kx,0); kload2(kf,kp,kx,1); kload2(kf,kp,kx,2); kload2(kf,kp,kx,3); }
__device__ __forceinline__ s16x4 vtr(lds_cptr p){ return __builtin_bit_cast(s16x4,__builtin_amdgcn_ds_read_tr16_b64_v4i16((__attribute__((address_space(3))) v4i16_t*)p)); }
__device__ __forceinline__ float rowmax(const f32x16&p0,const f32x16&p1){
  float a=max3f(p0[0],p0[1],p1[0]),b=max3f(p0[2],p0[3],p1[1]);a=max3f(a,p1[2],p1[3]);
  #pragma unroll
  for(int r=4;r<16;r+=4){a=max3f(a,p0[r],p0[r+1]);b=max3f(b,p0[r+2],p0[r+3]);a=max3f(a,p1[r],p1[r+1]);b=max3f(b,p1[r+2],p1[r+3]);}
  const float m=max2f(a,b);
  auto rr=__builtin_amdgcn_permlane32_swap(__float_as_uint(m),__float_as_uint(m),false,false);
  return max2f(__uint_as_float(rr[0]),__uint_as_float(rr[1]));
}
__device__ __forceinline__ void pv(f32x16*o,int vb,bf16x8 pa0,bf16x8 pa1,bf16x8 pa2,bf16x8 pa3){
  #pragma unroll
  for(int d0=0;d0<2;++d0){s16x4 lo[4],hi[4];
    #pragma unroll
    for(int ks=0;ks<4;++ks){
      asm volatile("ds_read_b64_tr_b16 %0,%1 offset:%c2":"=&v"(lo[ks]):"v"(vb),"i"(d0*4096+ks*1024):"memory");
      asm volatile("ds_read_b64_tr_b16 %0,%1 offset:%c2":"=&v"(hi[ks]):"v"(vb),"i"(d0*4096+ks*1024+512):"memory");}
    asm volatile("s_waitcnt lgkmcnt(0)":::"memory");SBAR();
    #define PK(k) (bf16x8){lo[k][0],lo[k][1],lo[k][2],lo[k][3],hi[k][0],hi[k][1],hi[k][2],hi[k][3]}
    o[d0]=__builtin_amdgcn_mfma_f32_32x32x16_bf16(pa0,PK(0),o[d0],0,0,0);
    o[d0]=__builtin_amdgcn_mfma_f32_32x32x16_bf16(pa1,PK(1),o[d0],0,0,0);
    o[d0]=__builtin_amdgcn_mfma_f32_32x32x16_bf16(pa2,PK(2),o[d0],0,0,0);
    o[d0]=__builtin_amdgcn_mfma_f32_32x32x16_bf16(pa3,PK(3),o[d0],0,0,0);
    #undef PK
  }
}

#ifndef ATTN_STORE16
#define ATTN_STORE16(p,v) (*(u32x4*)(p)=(v))
#endif
template<int THRL> __device__ __forceinline__ void attn_unit(int b,int h,int qb,const bf16*Q,const bf16*__restrict__ K,const bf16*__restrict__ V,const float*__restrict__ cum2,bf16*O,float*__restrict__ ssp,char*shm,int tid_){
  int tid=tid_; asm volatile("":"+v"(tid)); const int lane=tid&63,r32=lane&31,hi=lane>>5; const int wid=__builtin_amdgcn_readfirstlane(tid>>6);
  const long rowbase=(long)b*SEQ; const int q0=qb*QB;
  const bf16*Qw=Q+(rowbase+q0+wid*QBLK)*DM+h*D;
  const bf16*Kh=K+rowbase*DM+h*D,*Vh=V+rowbase*DM+h*D;
  const unsigned lds0=(unsigned)(uintptr_t)shm;
  float*wsf=(float*)(shm+LDS_WS)+wid*64;
  const int NTf=(q0+QB)/KVBLK; const float*cg=cum2+(long)(b*NHEAD+h)*SEQ;
  int ts; { const float thr=cg[q0]+PRUNE_T; const float ce=lane<NTf?cg[64*lane+63]:0.f; const unsigned long long m_=__ballot((lane<NTf)&&(ce<=thr));
    ts=m_?(int)__builtin_ctzll(m_):0; ts&=~1; if(ts>NTf-4)ts=NTf-4; ts=__builtin_amdgcn_readfirstlane(ts); }
  const bf16*ksrc=Kh+(long)(ts*KVBLK+8*wid+(lane>>3))*DM+((lane&7)^(lane>>3))*8;
  const bf16*vsrc=Vh+(long)(ts*KVBLK+16*(wid&3)+(lane>>2))*DM+(wid>>2)*32+(lane&3)*8;
  const unsigned kdst=lds0+LDS_K+wid*1024, vdst=lds0+LDS_V+wid*1024;
  #define DMA_K(t,slot) glds16(ksrc+(long)(t)*KVBLK*DM,(unsigned)__builtin_amdgcn_readfirstlane(kdst+(slot)))
  #define DMA_V(t,slot) glds16(vsrc+(long)(t)*KVBLK*DM,(unsigned)__builtin_amdgcn_readfirstlane(vdst+(slot)))
  const int vb0=(int)(lds0+LDS_V)+((lane>>4)&1)*32+(lane&3)*8+(4*hi+((lane&15)>>2))*64;
  const char*Kbase=shm+LDS_K; bf16x8 kf[8];
  const lds_cptr shm3=(lds_cptr)shm; const lds_cptr kp0=shm3+LDS_K+r32*128+((hi^(r32&1))*16); const int kx0=(r32&6)*16; const lds_cptr vp0=shm3+LDS_V+((lane>>4)&1)*32+(lane&3)*8+(4*hi+((lane&15)>>2))*64;
  { float*cl=(float*)(shm+LDS_CUM); const int cb_=ts*KVBLK, cn_=q0+QB-cb_;
    static_assert(SEQ<=8*NW*64,"cum table copy"); float cv_[8];
    _Pragma("unroll") for(int j_=0;j_<8;++j_){ const int i_=tid+NW*64*j_; cv_[j_]=cg[cb_+(i_<cn_?i_:cn_-1)]; }
    _Pragma("unroll") for(int j_=0;j_<8;++j_){ const int i_=tid+NW*64*j_; if(i_<cn_)cl[i_]=cv_[j_]; } }
  const float cq2=cg[q0+wid*QBLK+r32];
  const __attribute__((address_space(3))) float* ckl=(const __attribute__((address_space(3))) float*)(shm3+LDS_CUM)+4*hi;
  #define BIAS(P0,P1,t) do{ const __attribute__((address_space(3))) float*ck_=ckl+64*(t); const float mm_=mhat-cq2; _Pragma("unroll") for(int g_=0;g_<4;++g_){ \
      const f32x4_t c0_=*(const __attribute__((address_space(3))) f32x4_t*)(ck_+8*g_)+mm_, c1_=*(const __attribute__((address_space(3))) f32x4_t*)(ck_+32+8*g_)+mm_; \
      _Pragma("unroll") for(int i_=0;i_<4;++i_){P0[4*g_+i_]-=c0_[i_];P1[4*g_+i_]-=c1_[i_];} SBAR(); } }while(0)
  const int NT=NTf-ts;
  DMA_K(0,0);DMA_V(0,0);DMA_K(1,SLOTB);
  bf16x8 qr[4];
  #pragma unroll
  for(int d0=0;d0<4;++d0)qr[d0]=*reinterpret_cast<const bf16x8*>(&Qw[(long)r32*DM+d0*16+hi*8]);
  float mhat=0.f,l_reg=0.f;f32x16 o[2];o[0]=f32x16{};o[1]=f32x16{};const f32x16 negm=f32x16{};
  const int qrel=wid*QBLK+r32;
  #define CMASK(P0,P1,t) do{int jb_=(t)-(NT-4); if(jb_>=0)cmask(P0,P1,jb_,qrel,hi);}while(0)
  bool resc=false;
  #define START(P0,P1) do{ const float rm=rowmax(P0,P1); resc=false; \
    { const float dl=rm; mhat=fadd_s(mhat,dl); \
      _Pragma("unroll") for(int r=0;r<16;++r){P0[r]=fsub_s(P0[r],dl);P1[r]=fsub_s(P1[r],dl);} \
      } \
    _Pragma("unroll") for(int r=0;r<16;++r)P0[r]=__builtin_amdgcn_exp2f(P0[r]); }while(0)
  #define RESC() do{ if(resc){ asm volatile("s_waitcnt lgkmcnt(0)":::"memory"); \
      _Pragma("unroll") for(int d_=0;d_<2;++d_) _Pragma("unroll") for(int r=0;r<16;++r)o[d_][r]*=wsf[crow(r,hi)]; } }while(0)
  f32x16 pA0,pA1,pB0,pB1;
  int sl_prev=0,sl_cur=0,sl_next=SLOTB;
  #define ROT() do{sl_prev=sl_cur;sl_cur=sl_next;sl_next=(sl_next==(NSLOT-1)*SLOTB)?0:sl_next+SLOTB;}while(0)
  DMA_K(2,2*SLOTB);
  WAIT_BAR(3);
  qkt(pA0,pA1,Kbase,qr,negm,r32,hi);asm volatile("s_nop 15\n\ts_nop 7":"+v"(pA0),"+v"(pA1));BIAS(pA0,pA1,0);CMASK(pA0,pA1,0);
  START(pA0,pA1);
  _Pragma("unroll") for(int r=0;r<16;++r)pA1[r]=__builtin_amdgcn_exp2f(pA1[r]);
  WAIT_BAR(0);
  DMA_K(3,0);DMA_V(1,SLOTB);
  ROT();
  kload8(kf,kp0+sl_cur,kx0);
  WAIT_BAR(2);
  s16x4 vlo[8],vhi[8]; u32x4 pw0,pw1,pw2,pw3;
  #define PKW(P,B) cvtpk_s(P[B],P[B+1])
  #define PAF(k) __builtin_bit_cast(bf16x8,pw##k)
  #define VFR(i) (bf16x8){vlo[i][0],vlo[i][1],vlo[i][2],vlo[i][3],vhi[i][0],vhi[i][1],vhi[i][2],vhi[i][3]}
  #define PIN(x) asm volatile("":"+v"(x))
  #define MX3(a,b,c) __builtin_fmaxf(__builtin_fmaxf((a),(b)),(c))
  #define GAPA(MF,A0,A1,A2,A3,W0,W1,PW) do{ MF; sacc+=A0; sacc+=A1; sacc+=A2; sacc+=A3; PIN(sacc); W0; W1; PIN(PW); SBAR(); }while(0)
  #define EX(v) __builtin_amdgcn_exp2f(v)
  #define GAPB(MF,X,B) do{ MF; X[B]=EX(X[B]); X[B+1]=EX(X[B+1]); X[B+2]=EX(X[B+2]); X[B+3]=EX(X[B+3]); PIN(X); SBAR(); }while(0)
  #define VRD(i) do{ vlo[i]=vtr(vp_+(((i)>>2)*4096+((i)&3)*1024)); vhi[i]=vtr(vp_+(((i)>>2)*4096+((i)&3)*1024+512)); }while(0)
  #define KRD(G,j) do{ if(G){ kload2(kf,kp0+sl_next,kx0,j); SBAR(); } }while(0)
  #define STEP(C0,C1,P0,P1,t,GK,GV,GL) do{ SBAR(); \
    const lds_cptr vp_=vp0+sl_prev; \
    VRD(0); SBAR(); float sacc=(P0[0]+P0[1]); \
    GAPA(C0=__builtin_amdgcn_mfma_f32_32x32x16_bf16(kf[0],qr[0],negm,0,0,0), P0[2],P0[3],P0[4],P0[5],     pw0[0]=PKW(P0,0), pw0[1]=PKW(P0,2), pw0); \
    VRD(4); SBAR(); GAPA(C1=__builtin_amdgcn_mfma_f32_32x32x16_bf16(kf[1],qr[0],negm,0,0,0), P0[6],P0[7],P0[8],P0[9],     pw0[2]=PKW(P0,4), pw0[3]=PKW(P0,6), pw0); \
    VRD(1); SBAR(); GAPA(C0=__builtin_amdgcn_mfma_f32_32x32x16_bf16(kf[2],qr[1],C0,0,0,0),   P0[10],P0[11],P0[12],P0[13], pw1[0]=PKW(P0,8), pw1[1]=PKW(P0,10), pw1); \
    VRD(5); SBAR(); GAPA(C1=__builtin_amdgcn_mfma_f32_32x32x16_bf16(kf[3],qr[1],C1,0,0,0),   P0[14],P0[15],P1[0],P1[1],   pw1[2]=PKW(P0,12),pw1[3]=PKW(P0,14), pw1); \
    VRD(2); SBAR(); GAPA(C0=__builtin_amdgcn_mfma_f32_32x32x16_bf16(kf[4],qr[2],C0,0,0,0),   P1[2],P1[3],P1[4],P1[5],     pw2[0]=PKW(P1,0), pw2[1]=PKW(P1,2), pw2); \
    VRD(6); SBAR(); GAPA(C1=__builtin_amdgcn_mfma_f32_32x32x16_bf16(kf[5],qr[2],C1,0,0,0),   P1[6],P1[7],P1[8],P1[9],     pw2[2]=PKW(P1,4), pw2[3]=PKW(P1,6), pw2); \
    VRD(3); SBAR(); GAPA(C0=__builtin_amdgcn_mfma_f32_32x32x16_bf16(kf[6],qr[3],C0,0,0,0),   P1[10],P1[11],P1[12],P1[13], pw3[0]=PKW(P1,8), pw3[1]=PKW(P1,10), pw3); \
    VRD(7); SBAR(); GAPA(C1=__builtin_amdgcn_mfma_f32_32x32x16_bf16(kf[7],qr[3],C1,0,0,0),   P1[14],P1[15],0.f,0.f,       pw3[2]=PKW(P1,12),pw3[3]=PKW(P1,14), pw3); \
    l_reg+=sacc; \
    if(GK){DMA_K((t)+3,sl_cur);} if(GV){DMA_V((t)+1,sl_next);} \
    BIAS(C0,C1,t); CMASK(C0,C1,t); \
    { float a=MX3(C0[0],C0[1],C1[0]),b=MX3(C0[2],C0[3],C1[1]); a=MX3(a,C1[2],C1[3]); \
      _Pragma("unroll") for(int r=4;r<16;r+=4){a=MX3(a,C0[r],C0[r+1]);b=MX3(b,C0[r+2],C0[r+3]);a=MX3(a,C1[r],C1[r+1]);b=MX3(b,C1[r+2],C1[r+3]);} \
      float rm=__builtin_fmaxf(a,b); { auto rr=__builtin_amdgcn_permlane32_swap(__float_as_uint(rm),__float_as_uint(rm),false,false); rm=__builtin_fmaxf(__uint_as_float(rr[0]),__uint_as_float(rr[1])); } \
      resc=false; \
      if(__builtin_expect(__any(rm>(float)THRL),0)){ const float dl=__builtin_fmaxf(rm,0.f); mhat+=dl; \
        _Pragma("unroll") for(int r=0;r<16;++r){C0[r]-=dl;C1[r]-=dl;} \
        const float f=__builtin_amdgcn_exp2f(-dl); l_reg*=f; if(hi==0)wsf[r32]=f; resc=true; } } \
    SBAR(); \
    GAPB(o[0]=__builtin_amdgcn_mfma_f32_32x32x16_bf16(PAF(0),VFR(0),o[0],0,0,0), C0,0); \
    GAPB(o[1]=__builtin_amdgcn_mfma_f32_32x32x16_bf16(PAF(0),VFR(4),o[1],0,0,0), C0,4); \
    KRD(GL,0); GAPB(o[0]=__builtin_amdgcn_mfma_f32_32x32x16_bf16(PAF(1),VFR(1),o[0],0,0,0), C0,8); \
    KRD(GL,1); GAPB(o[1]=__builtin_amdgcn_mfma_f32_32x32x16_bf16(PAF(1),VFR(5),o[1],0,0,0), C0,12); \
    KRD(GL,2); GAPB(o[0]=__builtin_amdgcn_mfma_f32_32x32x16_bf16(PAF(2),VFR(2),o[0],0,0,0), C1,0); \
    KRD(GL,3); GAPB(o[1]=__builtin_amdgcn_mfma_f32_32x32x16_bf16(PAF(2),VFR(6),o[1],0,0,0), C1,4); \
    GAPB(o[0]=__builtin_amdgcn_mfma_f32_32x32x16_bf16(PAF(3),VFR(3),o[0],0,0,0), C1,8); \
    GAPB(o[1]=__builtin_amdgcn_mfma_f32_32x32x16_bf16(PAF(3),VFR(7),o[1],0,0,0), C1,12); \
    }while(0)
  int t=1;
  #undef CMASK
  #define CMASK(P0,P1,t) do{}while(0)
  for(;t+5<NT;t+=2){
    STEP(pB0,pB1,pA0,pA1,t,true,true,true);     WAIT_BAR(2); RESC(); ROT();
    STEP(pA0,pA1,pB0,pB1,t+1,true,true,true);   WAIT_BAR(2); RESC(); ROT();
  }
  #undef CMASK
  #define CMASK(P0,P1,t) do{int jb_=(t)-(NT-4); if(jb_>=0)cmask(P0,P1,jb_,qrel,hi);}while(0)
  #define ENDW(tt) do{ if((tt)+3<NT){WAIT_BAR(2);} else if((tt)+2<NT){WAIT_BAR(1);} else {WAIT_BAR(0);} }while(0)
  for(;t+1<NT;t+=2){
    STEP(pB0,pB1,pA0,pA1,t,(t+3<NT),(t+1<NT),(t+1<NT));       ENDW(t);   RESC(); ROT();
    STEP(pA0,pA1,pB0,pB1,t+1,(t+4<NT),(t+2<NT),(t+2<NT));     ENDW(t+1); RESC(); ROT();
  }
  STEP(pB0,pB1,pA0,pA1,NT-1,false,false,false); RESC();
  { float sacc=pB0[0]+pB0[1]; _Pragma("unroll") for(int r=2;r<16;++r)sacc+=pB0[r]; _Pragma("unroll") for(int r=0;r<16;++r)sacc+=pB1[r]; l_reg+=sacc;
    pw0=(u32x4){PKW(pB0,0),PKW(pB0,2),PKW(pB0,4),PKW(pB0,6)};pw1=(u32x4){PKW(pB0,8),PKW(pB0,10),PKW(pB0,12),PKW(pB0,14)};pw2=(u32x4){PKW(pB1,0),PKW(pB1,2),PKW(pB1,4),PKW(pB1,6)};pw3=(u32x4){PKW(pB1,8),PKW(pB1,10),PKW(pB1,12),PKW(pB1,14)};
    SBAR(); pv(o,vb0+sl_cur,PAF(0),PAF(1),PAF(2),PAF(3)); }
  #undef PKW
  #undef PAF
  #undef VFR
  #undef PIN
  #undef MX3
  #undef GAPA
  #undef GAPB
  #undef EX
  #undef VRD
  #undef KRD
  #undef STEP
  #undef ENDW
  {auto rr=__builtin_amdgcn_permlane32_swap(__float_as_uint(l_reg),__float_as_uint(l_reg),false,false);l_reg=__uint_as_float(rr[0])+__uint_as_float(rr[1]);}
  if(hi==0)wsf[32+r32]=l_reg;asm volatile("s_waitcnt lgkmcnt(0)":::"memory");
  float rli[16];
  #pragma unroll
  for(int r=0;r<16;++r)rli[r]=__builtin_amdgcn_rcpf(wsf[32+crow(r,hi)]);
  int lane_e=lane; asm volatile("":"+v"(lane_e));
  bf16*Ow=O+(rowbase+q0+wid*QBLK)*OPITCH+OCOL+h*D; float*sw=ssp+(rowbase+q0+wid*QBLK)*8+h;
  { bf16*stg=(bf16*)(shm+LDS_OST)+wid*2048;
    #pragma unroll
    for(int r=0;r<16;++r){const int orow=crow(r,hi);
      #pragma unroll
      for(int d0=0;d0<2;++d0)stg[orow*64+d0*32+r32]=__float2bfloat16(o[d0][r]*rli[r]);}
    asm volatile("s_waitcnt lgkmcnt(0)":::"memory");
    #pragma unroll
    for(int i=0;i<4;++i){const int row=i*8+(lane_e>>3),ch=lane_e&7; const u32x4 v=*(const u32x4*)(stg+row*64+ch*8); ATTN_STORE16(Ow+(long)row*OPITCH+ch*8,v);
      float sq=0.f;
      #pragma unroll
      for(int k=0;k<4;++k){const float a=__uint_as_float(v[k]<<16),c=__uint_as_float(v[k]&0xffff0000u);sq+=a*a+c*c;}
      sq+=__shfl_xor(sq,1);sq+=__shfl_xor(sq,2);sq+=__shfl_xor(sq,4);
      if(ch==0)sw[(long)row*8]=sq; } }
  asm volatile("s_waitcnt lgkmcnt(0)\n\ts_barrier":::"memory");
  #undef DMA_K
  #undef DMA_V
  #undef CMASK
  #undef START
  #undef RESC
  #undef BIAS
  #undef ROT
}
constexpr int ATTN_LDS_BYTES=LDS_BYTES;
template<int THRL=8> __device__ __forceinline__ void attn_phase(char*lds,const bf16*Q,const bf16*K,const bf16*V,const float*cum2,bf16*O,float*ssp,unsigned*ctr,volatile __attribute__((address_space(3))) unsigned*slot,int tid,int ubeg=0,int uend=BATCH*NHEAD*NQB){
  for(;;){
    if(tid==0)*slot=__hip_atomic_fetch_add(ctr,1u,__ATOMIC_RELAXED,__HIP_MEMORY_SCOPE_AGENT);
    __syncthreads();
    const int u=ubeg+(int)*slot;
    __syncthreads();
    if(u>=uend)break;
    const int qb=NQB-1-(u>>6),h=NHEAD-1-((u>>3)&7),b=u&7;
    attn_unit<THRL>(b,h,qb,Q,K,V,cum2,O,ssp,lds,tid);
  }
}
#undef SBAR
#undef WAIT_BAR
}
namespace nv {
typedef float f32x2v __attribute__((ext_vector_type(2)));
constexpr size_t WS_APOW = 921 * MiB;
constexpr size_t WS_BBAR = 89 * MiB;
constexpr int KDW = 128 * 256;
__device__ __forceinline__ void p0_ssm_a(const float* __restrict__ lam_re, const float* __restrict__ lam_im, const float* __restrict__ log_dt, const float* __restrict__ b_re, const float* __restrict__ b_im,
                                         f32x2v* __restrict__ apow, f32x2v* __restrict__ bbar) {
    PH_IDS
    for (int i = BIDX * 512 + TIDX; i < DEPTH * G * P; i += GDIM * 512) {
        const int lg = i / P, p = i % P;
        const float dtf = expf(log_dt[lg]); const float lr = lam_re[i], li = lam_im[i];
        const double ang = (double)li * (double)dtf, k2 = rint(ang * 0.15915494309189535), red = ang - k2 * 6.283185307179586;
        const float mag = expf(lr * dtf), rr = (float)red; const double are = (double)(mag * cosf(rr)), aim = (double)(mag * sinf(rr));
        double pr = 1.0, pi = 0.0;
        for (int d = 0; d <= 64; ++d) { apow[((size_t)lg * 65 + d) * P + p] = (f32x2v){(float)pr, (float)pi}; const double nr_ = pr * are - pi * aim, ni_ = pr * aim + pi * are; pr = nr_; pi = ni_; }
        const double lrd = lr, lid = li, den = lrd * lrd + lid * lid, nr = are - 1.0, zre = (nr * lrd + aim * lid) / den, zim = (aim * lrd - nr * lid) / den;
        float brv[HC], biv[HC];
#pragma unroll
        for (int h4 = 0; h4 < HC / 4; ++h4) { const f32x4 x = *(const f32x4*)(b_re + (size_t)i * HC + 4 * h4), y = *(const f32x4*)(b_im + (size_t)i * HC + 4 * h4);
            brv[4 * h4] = x.x; brv[4 * h4 + 1] = x.y; brv[4 * h4 + 2] = x.z; brv[4 * h4 + 3] = x.w; biv[4 * h4] = y.x; biv[4 * h4 + 1] = y.y; biv[4 * h4 + 2] = y.z; biv[4 * h4 + 3] = y.w; }
#pragma unroll
        for (int h = 0; h < HC; ++h) { const double br = brv[h], bi = biv[h]; bbar[(size_t)i * HC + h] = (f32x2v){(float)(zre * br - zim * bi), (float)(zre * bi + zim * br)}; }
    }
}
__device__ __forceinline__ void p0_ssm_b(LAS unsigned char* lds, const f32x2v* __restrict__ apow, const f32x2v* __restrict__ bbar, const float* __restrict__ c_re, const float* __restrict__ c_im, const float* __restrict__ dsk,
                                         bf16_t* __restrict__ KD, bf16_t* __restrict__ WST, bf16_t* __restrict__ WOUT) {
    PH_IDS
    const int gt = BIDX * 512 + TIDX, nth = GDIM * 512;
    {
        LAS f32x2v* la = (LAS f32x2v*)lds; LAS f32x2v* lb = la + 64 * 64; LAS float* lcr = (LAS float*)(lb + 64 * 16); LAS float* lci = lcr + 16 * 64;
        const int h = (TIDX >> 4) & 15, h2 = TIDX & 15, dq = TIDX >> 8;
        for (int item = BIDX; item < DEPTH * G * 2; item += GDIM) {
            const int lg = item >> 1, dbase = 32 * (item & 1) + 16 * dq;
            __syncthreads();
#pragma unroll
            for (int j = 0; j < 8; ++j) la[TIDX + 512 * j] = apow[(size_t)lg * 65 * P + TIDX + 512 * j];
#pragma unroll
            for (int j = 0; j < 2; ++j) { lb[TIDX + 512 * j] = bbar[(size_t)lg * P * HC + TIDX + 512 * j]; lcr[TIDX + 512 * j] = c_re[(size_t)lg * HC * P + TIDX + 512 * j]; lci[TIDX + 512 * j] = c_im[(size_t)lg * HC * P + TIDX + 512 * j]; }
            __syncthreads();
            float acc[16];
#pragma unroll
            for (int d = 0; d < 16; ++d) acc[d] = 0.f;
            for (int p = 0; p < P; ++p) {
                const f32x2v b = lb[p * 16 + h2]; const float cr = lcr[h * 64 + p], ci = lci[h * 64 + p];
                const float mr = cr * b.x - ci * b.y, mi = cr * b.y + ci * b.x;
#pragma unroll
                for (int d = 0; d < 16; ++d) { const f32x2v av = la[(dbase + d) * 64 + p]; acc[d] += mr * av.x - mi * av.y; }
            }
            bf16_t* kd = KD + (size_t)lg * KDW;
#pragma unroll
            for (int d = 0; d < 16; ++d) { const int dg = dbase + d; const float v = acc[d] + ((dg == 0 && h == h2) ? dsk[lg * HC + h] : 0.f); kd[(dg + 63) * 256 + h * 16 + h2] = f2bf(v); }
#pragma unroll
            for (int j = 0; j < 16; ++j) { const int z = (item & 1) * 8192 + TIDX + 512 * j; kd[z < 63 * 256 ? z : 127 * 256 + (z - 63 * 256)] = (bf16_t)0; }
        }
        __syncthreads();
    }
#pragma unroll 8
    for (int q = gt; q < DEPTH * G * 64 * 256; q += nth) {
        const int lg = q >> 14, p = (q >> 8) & 63, k = q & 255, j = k >> 4, h2 = k & 15;
        const f32x2v a = apow[((size_t)lg * 65 + (15 - j)) * P + p], b = bbar[((size_t)lg * P + p) * HC + h2];
        WST[(size_t)lg * 32768 + p * 256 + k] = f2bf(a.x * b.x - a.y * b.y); WST[(size_t)lg * 32768 + (64 + p) * 256 + k] = f2bf(a.x * b.y + a.y * b.x);
    }
    for (int q = gt; q < DEPTH * G * HC * P; q += nth) {
        const int lg = q >> 10, h = (q >> 6) & 15, p = q & 63;
        const float cr = c_re[((size_t)lg * HC + h) * P + p], ci = c_im[((size_t)lg * HC + h) * P + p];
        const f32x2v* ep = apow + ((size_t)lg * 65 + 1) * P + p; bf16_t* wo = WOUT + (((size_t)lg * 1024 + h) * 128 + p);
#pragma unroll 8
        for (int ti = 0; ti < 64; ++ti) { const f32x2v e = ep[(size_t)ti * P]; wo[(size_t)ti * 16 * 128] = f2bf(cr * e.x - ci * e.y); wo[(size_t)ti * 16 * 128 + 64] = f2bf(-(cr * e.y + ci * e.x)); }
    }
}

struct SchedSsmS {
    static constexpr bool DUALB = false; long hA, hB, hB1;
    const char* UP; const char* WST; int G_, c;
    __device__ __forceinline__ void init(const void* up, const void* wst_l, int grid, int bid) { UP = (const char*)up; WST = (const char*)wst_l; G_ = grid; c = bid; hA = 128l * UPW * 2; hB = 0; hB1 = 0; }
    __device__ __forceinline__ bool next(int i, ge::Unit& u) const {
        const int L = i * G_ + c; if (L >= G * 2 * 4) return false;
        const int g = L >> 3, pm = (L >> 2) & 1, ks = L & 3;
        u.A0 = UP + (((size_t)g * NCH + pm * 256) * UPW + 128 + ks * 256) * 2; u.B0 = WST + (size_t)g * 128 * 256 * 2; u.nt = 4; u.pm = pm; u.pn = ks; u.aux = g; return true; }
    __device__ __forceinline__ const char* ta(const ge::Unit& u, int t) const { return u.A0 + t * 128; }
    __device__ __forceinline__ const char* tb(const ge::Unit& u, int t) const { return u.B0 + t * 128; }
    __device__ __forceinline__ bool sb(const ge::Unit&, int) const { return false; }
    __device__ __forceinline__ unsigned voffA(int R, int C) const { return (unsigned)(R * UPW * 2 + C * 2); }
    __device__ __forceinline__ unsigned voffB(int Rb, int C) const { return (unsigned)(Rb * 512 + C * 2); }
    __device__ __forceinline__ unsigned voffB1(int, int) const { return 0u; }
};
struct EpiSsmS {
    static constexpr bool PERM = false, MIDK = false, UBEGIN = false;
    float* SLOC;
    __device__ __forceinline__ void unit_begin(const ge::Unit&, int, LAS unsigned char*) const {}
    __device__ __forceinline__ void midk(ge::f32x4 (&)[2][2][4][2], const ge::Unit&, int, int, LAS unsigned char*) const {}
    __device__ __forceinline__ void operator()(const ge::f32x4 (&acc)[2][2][4][2], const ge::Unit& u, int wr, int wc, int fr, int fq, LAS unsigned char*) const {
        const int g = u.aux, ks = u.pn;
#pragma unroll
        for (int ai = 0; ai < 2; ++ai)
#pragma unroll
            for (int m = 0; m < 4; ++m) {
                const int chunk = u.pm * 256 + ai * 128 + wr * 64 + m * 16 + fr; float* dst = SLOC + ((size_t)g * (NCH * 4) + chunk * 4 + ks) * 128;
#pragma unroll
                for (int n = 0; n < 2; ++n) *(ge::f32x4*)(dst + wc * 32 + 16 * n + 4 * fq) = acc[ai][0][m][n];
            }
    }
};

__device__ __forceinline__ void ph_ssm_prefix(LAS unsigned char* lds, const float* __restrict__ SLOC, const f32x2v* __restrict__ apow_l, bf16_t* __restrict__ UP) {
    PH_IDS
    const int p = TIDX & 63, w = __builtin_amdgcn_readfirstlane(TIDX >> 6);
    LAS f32x2v* ex = (LAS f32x2v*)lds;
    for (int item = BIDX; item < BATCH * G; item += GDIM) {
        const int b = item / G, g = item % G;
        const f32x2v a16 = apow_l[((size_t)g * 65 + 16) * P + p];
        const float* src = SLOC + ((size_t)g * (NCH * 4) + (size_t)b * 256 + 32 * w) * 128 + p; bf16_t* dst = UP + ((size_t)g * NCH + b * 64 + 8 * w) * UPW + p;
        float xr[32], xi[32];
#pragma unroll
        for (int k = 0; k < 32; ++k) { xr[k] = src[(size_t)k * 128]; xi[k] = src[(size_t)k * 128 + 64]; }
        float sr = 0.f, si = 0.f;
#pragma unroll
        for (int k = 0; k < 32; ++k) { const float nr = a16.x * sr - a16.y * si + xr[k], ni = a16.x * si + a16.y * sr + xi[k]; sr = nr; si = ni; }
        ex[w * 64 + p] = (f32x2v){sr, si};
        float qr = a16.x, qi = a16.y;
#pragma unroll
        for (int k = 0; k < 5; ++k) { const float nr = qr * qr - qi * qi, ni = 2.f * qr * qi; qr = nr; qi = ni; }
        __syncthreads();
        sr = 0.f; si = 0.f;
        for (int j = 0; j < w; ++j) { const f32x2v e = ex[j * 64 + p]; const float nr = qr * sr - qi * si + e.x, ni = qr * si + qi * sr + e.y; sr = nr; si = ni; }
#pragma unroll
        for (int k = 0; k < 32; ++k) {
            if ((k & 3) == 0) { bf16_t* d = dst + (size_t)(k >> 2) * UPW; d[0] = f2bf(sr); d[64] = f2bf(si); }
            const float nr = a16.x * sr - a16.y * si + xr[k], ni = a16.x * si + a16.y * sr + xi[k]; sr = nr; si = ni;
        }
        __syncthreads();
    }
}
__device__ __forceinline__ void ph_cum2(LAS unsigned char* lds, const float* __restrict__ logf, float* __restrict__ cum) {
    PH_IDS
    static_assert(NH == 8 && SEQ == 512 * 8, "ph_cum2 layout");
    const int lane = TIDX & 63, wave = __builtin_amdgcn_readfirstlane(TIDX >> 6);
    LAS float* wsum = (LAS float*)lds;
    __syncthreads();
    for (int b = BIDX; b < BATCH; b += GDIM) {
        const f32x4* src = (const f32x4*)(logf + ((size_t)b * SEQ + TIDX * 8) * NH);
        f32x4 v[16];
#pragma unroll
        for (int i = 0; i < 16; ++i) v[i] = src[i];
        float run[8];
#pragma unroll
        for (int h = 0; h < 8; ++h) run[h] = 0.f;
#pragma unroll
        for (int t = 0; t < 8; ++t)
#pragma unroll
            for (int h = 0; h < 8; ++h) { run[h] += v[2 * t + (h >> 2)][h & 3]; v[2 * t + (h >> 2)][h & 3] = run[h]; }
        float ex[8];
#pragma unroll
        for (int h = 0; h < 8; ++h) { ex[h] = run[h];
#pragma unroll
            for (int o = 1; o < 64; o <<= 1) { const float y = __shfl_up(ex[h], o); if (lane >= o) ex[h] += y; }
            if (lane == 63) wsum[wave * 8 + h] = ex[h]; }
        __syncthreads();
        float base[8];
#pragma unroll
        for (int h = 0; h < 8; ++h) { float pre = 0.f;
#pragma unroll
            for (int w = 0; w < 7; ++w) pre += (w < wave) ? wsum[w * 8 + h] : 0.f;
            base[h] = pre + ex[h] - run[h]; }
        __syncthreads();
#pragma unroll
        for (int h = 0; h < 8; ++h) { f32x4* dst = (f32x4*)(cum + ((size_t)b * NH + h) * SEQ + TIDX * 8);
            f32x4 o0, o1;
#pragma unroll
            for (int t = 0; t < 4; ++t) { o0[t] = (base[h] + v[2 * t + (h >> 2)][h & 3]) * 1.4426950408889634f; o1[t] = (base[h] + v[2 * (t + 4) + (h >> 2)][h & 3]) * 1.4426950408889634f; }
            dst[0] = o0; dst[1] = o1; }
    }
}

struct SchedSsmC {
    static constexpr bool DUALB = true; long hA, hB, hB1;
    const char* UP; const char* WOUT; const char* KD; int G_, c;
    __device__ __forceinline__ void init(const void* up, const void* wout_l, const void* kd_l, int grid, int bid) { UP = (const char*)up; WOUT = (const char*)wout_l; KD = (const char*)kd_l; G_ = grid; c = bid; hA = 128l * UPW * 2; hB = 128l * 256; hB1 = 8l * 512; }
    __device__ __forceinline__ bool next(int i, ge::Unit& u) const {
        const int L = i * G_ + c; if (L >= G * 2 * 4) return false;
        const int pn = 3 - (L >> 6), g = (L & 63) >> 1, pm = L & 1;
        u.A0 = UP + ((size_t)g * NCH + pm * 256) * UPW * 2; u.B0 = nullptr; u.nt = 2 + 4 * (pn + 1); u.pm = pm; u.pn = pn; u.aux = g; return true; }
    __device__ __forceinline__ const char* ta(const ge::Unit& u, int t) const { return u.A0 + t * 128; }
    __device__ __forceinline__ bool sb(const ge::Unit&, int t) const { return t >= 2; }
    __device__ __forceinline__ const char* tb(const ge::Unit& u, int t) const {
        return t < 2 ? WOUT + ((size_t)u.aux * 1024 + u.pn * 256) * 256 + t * 128 : KD + ((size_t)u.aux * KDW + (size_t)(16 * u.pn - 4 * (t - 2) + 60) * 256) * 2; }
    __device__ __forceinline__ unsigned voffA(int R, int C) const { return (unsigned)(R * UPW * 2 + C * 2); }
    __device__ __forceinline__ unsigned voffB(int Rb, int C) const { return (unsigned)(Rb * 256 + C * 2); }
    __device__ __forceinline__ unsigned voffB1(int Rb, int C) const { return (unsigned)((((Rb >> 4) + 3 - (C >> 4)) * 256 + (Rb & 15) * 16 + (C & 15)) * 2); }
};
__device__ __forceinline__ float gelu_fast(float x) { const float u = 1.5957691216057308f * (x + 0.044715f * x * x * x); return x - x / (1.f + __expf(u)); }
struct EpiSsmC {
    static constexpr bool PERM = true, MIDK = false, UBEGIN = false;
    bf16_t* GEL;
    __device__ __forceinline__ void unit_begin(const ge::Unit&, int, LAS unsigned char*) const {}
    __device__ __forceinline__ void midk(ge::f32x4 (&)[2][2][4][2], const ge::Unit&, int, int, LAS unsigned char*) const {}
    __device__ __forceinline__ void operator()(const ge::f32x4 (&acc)[2][2][4][2], const ge::Unit& u, int wr, int wc, int fr, int fq, LAS unsigned char*) const {
        const int g = u.aux;
#pragma unroll
        for (int ai = 0; ai < 2; ++ai)
#pragma unroll
            for (int m = 0; m < 4; ++m) {
                const int chunk = u.pm * 256 + ai * 128 + wr * 64 + m * 16 + fr;
#pragma unroll
                for (int bj = 0; bj < 2; ++bj) {
                    const int col = u.pn * 256 + bj * 128 + wc * 32 + 8 * fq, ti = col >> 4, h0 = col & 15;
                    const ge::f32x4 v0 = acc[ai][bj][m][0], v1 = acc[ai][bj][m][1];
                    u32x4 w; w.x = ge::cvt_pk_bf16(gelu_fast(v0[0]), gelu_fast(v0[1])); w.y = ge::cvt_pk_bf16(gelu_fast(v0[2]), gelu_fast(v0[3]));
                    w.z = ge::cvt_pk_bf16(gelu_fast(v1[0]), gelu_fast(v1[1])); w.w = ge::cvt_pk_bf16(gelu_fast(v1[2]), gelu_fast(v1[3]));
                    *(u32x4*)(GEL + ((size_t)g * T + chunk * 64 + ti) * HC + h0) = w;
                }
            }
    }
};
}
namespace nv {
#define SEL_CE(x, y) do { const int _h = max((x), (y)), _l = min((x), (y)); (x) = _h; (y) = _l; } while (0)
__device__ __forceinline__ void sel_sort16(int (&v)[16]) {
    SEL_CE(v[0], v[1]);
    SEL_CE(v[2], v[3]);
    SEL_CE(v[0], v[2]);
    SEL_CE(v[1], v[3]);
    SEL_CE(v[1], v[2]);
    SEL_CE(v[4], v[5]);
    SEL_CE(v[6], v[7]);
    SEL_CE(v[4], v[6]);
    SEL_CE(v[5], v[7]);
    SEL_CE(v[5], v[6]);
    SEL_CE(v[0], v[4]);
    SEL_CE(v[2], v[6]);
    SEL_CE(v[2], v[4]);
    SEL_CE(v[1], v[5]);
    SEL_CE(v[3], v[7]);
    SEL_CE(v[3], v[5]);
    SEL_CE(v[1], v[2]);
    SEL_CE(v[3], v[4]);
    SEL_CE(v[5], v[6]);
    SEL_CE(v[8], v[9]);
    SEL_CE(v[10], v[11]);
    SEL_CE(v[8], v[10]);
    SEL_CE(v[9], v[11]);
    SEL_CE(v[9], v[10]);
    SEL_CE(v[12], v[13]);
    SEL_CE(v[14], v[15]);
    SEL_CE(v[12], v[14]);
    SEL_CE(v[13], v[15]);
    SEL_CE(v[13], v[14]);
    SEL_CE(v[8], v[12]);
    SEL_CE(v[10], v[14]);
    SEL_CE(v[10], v[12]);
    SEL_CE(v[9], v[13]);
    SEL_CE(v[11], v[15]);
    SEL_CE(v[11], v[13]);
    SEL_CE(v[9], v[10]);
    SEL_CE(v[11], v[12]);
    SEL_CE(v[13], v[14]);
    SEL_CE(v[0], v[8]);
    SEL_CE(v[4], v[12]);
    SEL_CE(v[4], v[8]);
    SEL_CE(v[2], v[10]);
    SEL_CE(v[6], v[14]);
    SEL_CE(v[6], v[10]);
    SEL_CE(v[2], v[4]);
    SEL_CE(v[6], v[8]);
    SEL_CE(v[10], v[12]);
    SEL_CE(v[1], v[9]);
    SEL_CE(v[5], v[13]);
    SEL_CE(v[5], v[9]);
    SEL_CE(v[3], v[11]);
    SEL_CE(v[7], v[15]);
    SEL_CE(v[7], v[11]);
    SEL_CE(v[3], v[5]);
    SEL_CE(v[7], v[9]);
    SEL_CE(v[11], v[13]);
    SEL_CE(v[1], v[2]);
    SEL_CE(v[3], v[4]);
    SEL_CE(v[5], v[6]);
    SEL_CE(v[7], v[8]);
    SEL_CE(v[9], v[10]);
    SEL_CE(v[11], v[12]);
    SEL_CE(v[13], v[14]);
}
__device__ __forceinline__ void sel_merge16(int (&a)[16], const int (&b)[16]) {
    a[0] = max(a[0], b[15]);
    a[1] = max(a[1], b[14]);
    a[2] = max(a[2], b[13]);
    a[3] = max(a[3], b[12]);
    a[4] = max(a[4], b[11]);
    a[5] = max(a[5], b[10]);
    a[6] = max(a[6], b[9]);
    a[7] = max(a[7], b[8]);
    a[8] = max(a[8], b[7]);
    a[9] = max(a[9], b[6]);
    a[10] = max(a[10], b[5]);
    a[11] = max(a[11], b[4]);
    a[12] = max(a[12], b[3]);
    a[13] = max(a[13], b[2]);
    a[14] = max(a[14], b[1]);
    a[15] = max(a[15], b[0]);
    SEL_CE(a[0], a[8]);
    SEL_CE(a[1], a[9]);
    SEL_CE(a[2], a[10]);
    SEL_CE(a[3], a[11]);
    SEL_CE(a[4], a[12]);
    SEL_CE(a[5], a[13]);
    SEL_CE(a[6], a[14]);
    SEL_CE(a[7], a[15]);
    SEL_CE(a[0], a[4]);
    SEL_CE(a[1], a[5]);
    SEL_CE(a[2], a[6]);
    SEL_CE(a[3], a[7]);
    SEL_CE(a[8], a[12]);
    SEL_CE(a[9], a[13]);
    SEL_CE(a[10], a[14]);
    SEL_CE(a[11], a[15]);
    SEL_CE(a[0], a[2]);
    SEL_CE(a[1], a[3]);
    SEL_CE(a[4], a[6]);
    SEL_CE(a[5], a[7]);
    SEL_CE(a[8], a[10]);
    SEL_CE(a[9], a[11]);
    SEL_CE(a[12], a[14]);
    SEL_CE(a[13], a[15]);
    SEL_CE(a[0], a[1]);
    SEL_CE(a[2], a[3]);
    SEL_CE(a[4], a[5]);
    SEL_CE(a[6], a[7]);
    SEL_CE(a[8], a[9]);
    SEL_CE(a[10], a[11]);
    SEL_CE(a[12], a[13]);
    SEL_CE(a[14], a[15]);
}
constexpr int SEL_NCAND = 50;
#define SEL_CANDS(F) \
    F(0, 0, 0) \
    F(1, 0, 1) \
    F(2, 0, 2) \
    F(3, 0, 3) \
    F(4, 0, 4) \
    F(5, 0, 5) \
    F(6, 0, 6) \
    F(7, 0, 7) \
    F(8, 0, 8) \
    F(9, 0, 9) \
    F(10, 0, 10) \
    F(11, 0, 11) \
    F(12, 0, 12) \
    F(13, 0, 13) \
    F(14, 0, 14) \
    F(15, 0, 15) \
    F(16, 1, 0) \
    F(17, 1, 1) \
    F(18, 1, 2) \
    F(19, 1, 3) \
    F(20, 1, 4) \
    F(21, 1, 5) \
    F(22, 1, 6) \
    F(23, 1, 7) \
    F(24, 2, 0) \
    F(25, 2, 1) \
    F(26, 2, 2) \
    F(27, 2, 3) \
    F(28, 2, 4) \
    F(29, 3, 0) \
    F(30, 3, 1) \
    F(31, 3, 2) \
    F(32, 3, 3) \
    F(33, 4, 0) \
    F(34, 4, 1) \
    F(35, 4, 2) \
    F(36, 5, 0) \
    F(37, 5, 1) \
    F(38, 6, 0) \
    F(39, 6, 1) \
    F(40, 7, 0) \
    F(41, 7, 1) \
    F(42, 8, 0) \
    F(43, 9, 0) \
    F(44, 10, 0) \
    F(45, 11, 0) \
    F(46, 12, 0) \
    F(47, 13, 0) \
    F(48, 14, 0) \
    F(49, 15, 0)
constexpr float SEL_BIAS = 16.f;
__device__ __forceinline__ int f2key(float f) { return __float_as_int(f); }
__device__ __forceinline__ float key2f(int k) { return __int_as_float(k); }
__device__ __forceinline__ void sel_top16(const f32x16 (&acc)[4], int hi, int (&t)[16]) {
    int g1[16], g2[16], g3[16];
#pragma unroll
    for (int r = 0; r < 16; ++r) { const int n = (r & 3) + 8 * (r >> 2) + 4 * hi;
        t[r] = (f2key(acc[0][r]) & ~0x7F) | n; g1[r] = (f2key(acc[1][r]) & ~0x7F) | (32 + n); g2[r] = (f2key(acc[2][r]) & ~0x7F) | (64 + n); g3[r] = (f2key(acc[3][r]) & ~0x7F) | (96 + n); }
    sel_sort16(t); sel_sort16(g1); sel_sort16(g2); sel_sort16(g3);
    sel_merge16(t, g1); sel_merge16(g2, g3); sel_merge16(t, g2);
#pragma unroll
    for (int i = 0; i < 16; ++i) { auto rr = __builtin_amdgcn_permlane32_swap((unsigned)t[i], (unsigned)t[i], false, false); g1[i] = (int)(hi ? rr[0] : rr[1]); }
    sel_merge16(t, g1);
}
__device__ __forceinline__ void ph_select(const bf16_t* __restrict__ QP, const bf16_t* __restrict__ KEYS, unsigned short* __restrict__ idx, float* __restrict__ gate, LAS unsigned char* lds) {
    PH_IDS
    const int lane = TIDX & 63, hd = __builtin_amdgcn_readfirstlane(TIDX >> 6), r = lane & 31, hi = lane >> 5;
    LAS unsigned* my = (LAS unsigned*)(lds + ge::ROWF_OFF + hd * 1024) + r;
    LAS unsigned char* kl = lds + hd * 16384;
    const int krow = lane >> 3, kch = (lane & 7) ^ krow;
    bf16x8 fb[4];
#define SEL_DMA(half) do { const char* kb_ = (const char*)(KEYS + (size_t)(hd * 2 + (half)) * NK * HALF); unsigned ko_ = (unsigned)(krow * 128 + kch * 16); asm volatile("" : "+v"(ko_));     \
        _Pragma("unroll") for (int i_ = 0; i_ < 16; ++i_) __builtin_amdgcn_global_load_lds((const unsigned*)(kb_ + (ko_ + (unsigned)(i_ * 1024))), (LAS unsigned*)(kl + i_ * 1024), 16, 0, 0); \
        asm volatile("" ::: "memory"); __builtin_amdgcn_sched_barrier(0); } while (0)
#define SEL_LOAD_Q(tk0, half) do { const bf16_t* qb_ = QP + (size_t)((tk0) + r) * D + hd * QD + (half) * HALF + 8 * hi; \
        _Pragma("unroll") for (int ks = 0; ks < 4; ++ks) fb[ks] = *(const bf16x8*)(qb_ + 16 * ks); \
        asm volatile("" ::: "memory"); __builtin_amdgcn_sched_barrier(0); } while (0)
#define SEL_MFMA() do { asm volatile("s_waitcnt vmcnt(0)" ::: "memory"); \
        _Pragma("unroll") for (int mt = 0; mt < 4; ++mt) _Pragma("unroll") for (int i = 0; i < 16; ++i) acc[mt][i] = SEL_BIAS; \
        _Pragma("unroll") for (int ks = 0; ks < 4; ++ks) { bf16x8 a_[4]; \
            _Pragma("unroll") for (int mt = 0; mt < 4; ++mt) a_[mt] = *(const LAS bf16x8*)(kl + (32 * mt + r) * 128 + (((2 * ks + hi) ^ (r & 7)) * 16)); \
            _Pragma("unroll") for (int mt = 0; mt < 4; ++mt) acc[mt] = __builtin_amdgcn_mfma_f32_32x32x16_bf16(a_[mt], fb[ks], acc[mt], 0, 0, 0); } \
        asm volatile("s_waitcnt lgkmcnt(0)" : "+v"(acc[0]), "+v"(acc[1]), "+v"(acc[2]), "+v"(acc[3]) :: "memory"); __builtin_amdgcn_sched_barrier(0); } while (0)
    if (BIDX < T / 32) { SEL_LOAD_Q(BIDX * 32, 0); SEL_DMA(0); }
    for (int tg = BIDX; tg < T / 32; tg += GDIM) {
        const int tok0 = tg * 32;
        int t1[16], t2[16];
        { f32x16 acc[4]; SEL_MFMA(); SEL_LOAD_Q(tok0, 1); SEL_DMA(1); sel_top16(acc, hi, t1); }
        { f32x16 acc[4]; SEL_MFMA(); SEL_LOAD_Q(min(tg + GDIM, T / 32 - 1) * 32, 0); SEL_DMA(0); sel_top16(acc, hi, t2); }
        float f1[16], f2[16];
#pragma unroll
        for (int i = 0; i < 16; ++i) { f1[i] = key2f(t1[i]); f2[i] = key2f(t2[i]); }
        int c0[16], c1[16], c2[16], c3[16];
#pragma unroll
        for (int i = 0; i < 16; ++i) c3[i] = (int)0x80000000;
#define SEL_F(k, i, j) { const int v_ = (f2key(f1[i] + f2[j]) & ~0xFF) | ((i) << 4 | (j)); if ((k) < 16) c0[(k) & 15] = v_; else if ((k) < 32) c1[(k) & 15] = v_; else if ((k) < 48) c2[(k) & 15] = v_; else c3[(k) & 15] = v_; }
        SEL_CANDS(SEL_F)
#undef SEL_F
          sel_sort16(c1); sel_sort16(c2); SEL_CE(c3[0], c3[1]);
        sel_merge16(c0, c1); sel_merge16(c2, c3); sel_merge16(c0, c2);
#pragma unroll
        for (int j = 0; j < 4; ++j) {
            my[32 * j] = (unsigned)(t1[4 * j] & 0x7F) | ((unsigned)(t1[4 * j + 1] & 0x7F) << 8) | ((unsigned)(t1[4 * j + 2] & 0x7F) << 16) | ((unsigned)(t1[4 * j + 3] & 0x7F) << 24);
            my[32 * (4 + j)] = (unsigned)(t2[4 * j] & 0x7F) | ((unsigned)(t2[4 * j + 1] & 0x7F) << 8) | ((unsigned)(t2[4 * j + 2] & 0x7F) << 16) | ((unsigned)(t2[4 * j + 3] & 0x7F) << 24);
        }
        const float mx = key2f(c0[0]); float e[16], se = 0.f;
#pragma unroll
        for (int k = 0; k < 16; ++k) { e[k] = __expf(key2f(c0[k]) - mx); se += e[k]; }
        const float inv = 1.f / se;
        asm volatile("s_waitcnt lgkmcnt(0)" ::: "memory");
        const size_t o = (size_t)(tok0 + r) * 128 + hd * TOPK;
        if (hi == 0) {
            int id[16];
#pragma unroll
            for (int k = 0; k < 16; ++k) { const int code = c0[k] & 0xFF, i = code >> 4, j = code & 15;
                const unsigned w1 = my[32 * (i >> 2)], w2 = my[32 * (4 + (j >> 2))];
                id[k] = (int)((w1 >> (8 * (i & 3))) & 0x7F) * NK + (int)((w2 >> (8 * (j & 3))) & 0x7F); }
            u32x4 w0, w1;
#pragma unroll
            for (int k = 0; k < 4; ++k) { w0[k] = (unsigned)id[2 * k] | ((unsigned)id[2 * k + 1] << 16); w1[k] = (unsigned)id[8 + 2 * k] | ((unsigned)id[9 + 2 * k] << 16); }
            *(u32x4*)(idx + o) = w0; *(u32x4*)(idx + o + 8) = w1;
        } else {
#pragma unroll
            for (int k = 0; k < 4; ++k) *(float4*)(gate + o + 4 * k) = make_float4(e[4 * k] * inv, e[4 * k + 1] * inv, e[4 * k + 2] * inv, e[4 * k + 3] * inv);
        }
        asm volatile("s_waitcnt lgkmcnt(0)" ::: "memory");
    }
    asm volatile("s_waitcnt vmcnt(0)" ::: "memory");
#undef SEL_DMA
#undef SEL_LOAD_Q
#undef SEL_MFMA
}
}
#ifndef PROBE_MASK
#define PROBE_MASK 0
#endif
#define REPS(bit) (((PROBE_MASK >> (bit)) & 1) ? 2 : 1)
namespace nv {
constexpr int LDS_BYTES = 147456, MISC_OFF = 131072 + 320;
struct Params { const float* in[23]; float* out; unsigned char* ws; };

__global__ void __launch_bounds__(512, 2) k_mega(Params prm) {
    extern __shared__ __attribute__((aligned(16))) unsigned char lds_raw[];
    namespace cg = cooperative_groups;
    cg::grid_group grid = cg::this_grid();
    LAS unsigned char* lds = (LAS unsigned char*)lds_raw;
    unsigned char* smem = lds_raw;
    for (int u = threadIdx.x; u < (LDS_BYTES - 131072) / 4; u += 512) ((LAS unsigned*)(lds + 131072))[u] = 0u;
    __syncthreads();
    if (threadIdx.x == 0) {
        LAS unsigned long long* tab = (LAS unsigned long long*)(lds + TAB_OFF);
#pragma unroll
        for (int i = 0; i < 23; ++i) tab[i] = (unsigned long long)prm.in[i];
        tab[23] = (unsigned long long)prm.out; tab[24] = (unsigned long long)prm.ws;
    }
    __syncthreads();
#define ARG(i) ((const float*)ldarg(lds, (i)))
#define WSP() ((unsigned char*)ldarg(lds, 24))
    XcdBarrier bar = xcd_barrier_post((unsigned*)(WSP() + WS_CTL) + CW_BAR, (volatile LAS unsigned*)(lds + MISC_OFF) + 8);
#define GRID_BAR() do { xcd_barrier(bar); asm volatile("" ::: "memory"); } while (0)
    if (threadIdx.x == 0) { volatile LAS unsigned* M = (volatile LAS unsigned*)(lds + MISC_OFF); M[16] = bar.x; M[17] = xb_add((unsigned*)(WSP() + WS_CTL) + CW_RANK + 64 * bar.x, 1u); }
    for (int rep = 0; rep < REPS(0); ++rep) {
    for (int rep2 = 0; rep2 < REPS(25); ++rep2)
    p0_prologue(lds);
    for (int rep2 = 0; rep2 < REPS(24); ++rep2)
    { unsigned char* ws = WSP(); p0_peer_tables(ARG(20), ARG(21), ARG(17), ws + WS_PU, ws + WS_PV8, (float*)(ws + WS_US)); }
    { unsigned char* ws = WSP(); const float* pk = ARG(19); bf16_t* kb = (bf16_t*)(ws + WS_KEYS); const int i0_ = obid() * 512 + otid(), st_ = ogrid() * 512;
      _Pragma("unroll 4") for (int i = i0_; i < DEPTH * PH * 2 * NK * HALF; i += st_) kb[i] = f2bf(pk[i]); }
    { unsigned char* ws = WSP(); p0_ssm_a(ARG(3), ARG(4), ARG(5), ARG(6), ARG(7), (f32x2v*)(ws + WS_APOW), (f32x2v*)(ws + WS_BBAR)); }
    }
    GRID_BAR();
    if (threadIdx.x == 0) {
        volatile LAS unsigned* M = (volatile LAS unsigned*)(lds + MISC_OFF); unsigned* bw = (unsigned*)(WSP() + WS_CTL) + CW_BAR; unsigned tot = 0u, ok = 1u;
        for (unsigned j = 0; j < 16; ++j) { const unsigned cnt = xb_ld(&bw[XB_XCNT(j)]); tot += cnt; if ((j < 8) != (cnt > 0u)) ok = 0u; }
        M[18] = xb_ld(&bw[XB_XCNT(bar.x)]); M[19] = (ok && tot == gridDim.x && !((PROBE_MASK >> 27) & 1)) ? 1u : 0u;
    }
    __syncthreads();
    for (int rep2 = 0; rep2 < REPS(28); ++rep2)
    { unsigned char* ws = WSP(); p0_ssm_b(lds, (const f32x2v*)(ws + WS_APOW), (const f32x2v*)(ws + WS_BBAR), ARG(8), ARG(9), ARG(10), (bf16_t*)(ws + WS_KD), (bf16_t*)(ws + WS_WST), (bf16_t*)(ws + WS_WOUT)); }
    grid.sync();
#pragma nounroll
    for (int l_ = 0; l_ < DEPTH; ++l_) {
        int l = l_; asm volatile("" : "+s"(l));
        {
            unsigned char* ws = WSP(); bf16_t* hb = (bf16_t*)(ws + WS_HB); float* ss1 = (float*)(ws + WS_SSP) + (size_t)T * 32;
            for (int rep = 0; rep < REPS(1); ++rep) {
            SchedGen S; S.init_plain(hb, D * 2, (const bf16_t*)(ws + WS_BT1) + (size_t)l * 2048 * D, D * 2, T, 2048, D, ogrid(), obid());
            EpiInProj E{ss1, (bf16_t*)(ws + WS_UP), (bf16_t*)(ws + WS_Q)};
            ge::gemm_phase<EpiInProj, SchedGen>(lds, S, E, otid());
            }
            for (int rep = 0; rep < REPS(2); ++rep)
            ph_flogit(lds, hb, (const bf16_t*)(ws + WS_WF) + (size_t)l * 16 * D, ss1, ARG(13) + l * NH, (float*)(ws + WS_LOGF));
        }
        GRID_BAR();
        {
            unsigned char* ws = WSP();
            for (int rep = 0; rep < REPS(3); ++rep) {
            SchedSsmS S; S.init(ws + WS_UP, (const bf16_t*)(ws + WS_WST) + (size_t)l * G * 128 * 256, ogrid(), obid());
            EpiSsmS E{(float*)(ws + WS_SLOC)};
            ge::gemm_phase<EpiSsmS, SchedSsmS>(lds, S, E, otid());
            }
            for (int rep = 0; rep < REPS(4); ++rep)
            ph_cum2(lds, (const float*)(ws + WS_LOGF), (float*)(ws + WS_CUM));
        }
        GRID_BAR();
        {
            unsigned char* ws = WSP(); float* ssp_s = (float*)(ws + WS_SSP); float* ssp_a = ssp_s + (size_t)T * 8;
            unsigned* pdone = (unsigned*)(ws + WS_CTL) + CW_GDONE + 64 * (2 * l); unsigned* gdone = pdone + 64; unsigned* bw = (unsigned*)(ws + WS_CTL) + CW_BAR;
#define SIGNAL_DONE(c) do { asm volatile("s_waitcnt vmcnt(0)" ::: "memory"); __syncthreads(); \
            if (threadIdx.x == 0) { const unsigned nloc_ = bar.st[0]; const unsigned old_ = xb_add((c) + 4 * (1 + bar.x), 1u); \
                if (old_ + 1u == nloc_) { __builtin_amdgcn_fence(__ATOMIC_RELEASE, "agent"); asm volatile("s_waitcnt vmcnt(0)" ::: "memory"); (void)xb_add((c), 1u); } } } while (0)
#define WAIT_DONE(c) do { if (threadIdx.x == 0) { const unsigned nx_ = bar.st[1]; XB_SPIN(xb_ld(c) < nx_, bw); __builtin_amdgcn_fence(__ATOMIC_ACQUIRE, "agent"); } __syncthreads(); } while (0)
#define ATTN_SEG(seg, u0, u1) attn_body::attn_phase<8>((char*)lds_raw, (const attn_body::bf16*)(ws + WS_Q), (const attn_body::bf16*)(ws + WS_K), (const attn_body::bf16*)(ws + WS_V), (const float*)(ws + WS_CUM), \
            (attn_body::bf16*)(ws + WS_MIX), ssp_a, (unsigned*)(ws + WS_CTL) + CW_QUEUE + 64 * (l * 4 + rep * 2 + (seg)), (volatile LAS unsigned*)(lds + MISC_OFF) + 24, otid(), (u0), (u1))
            for (int rep = 0; rep < REPS(5); ++rep)
            ph_ssm_prefix(lds, (const float*)(ws + WS_SLOC), (const f32x2v*)(ws + WS_APOW) + (size_t)l * G * 65 * P, (bf16_t*)(ws + WS_UP));
            SIGNAL_DONE(pdone);
            for (int rep = 0; rep < REPS(7); ++rep) ATTN_SEG(0, 0, 512);
            WAIT_DONE(pdone);
            for (int rep = 0; rep < REPS(6); ++rep)
            {
                SchedSsmC S; S.init(ws + WS_UP, (const bf16_t*)(ws + WS_WOUT) + (size_t)l * G * 1024 * 128, (const bf16_t*)(ws + WS_KD) + (size_t)l * G * KDW, ogrid(), obid());
                EpiSsmC E{(bf16_t*)(ws + WS_GEL)};
                ge::gemm_phase<EpiSsmC, SchedSsmC>(lds, S, E, otid());
            }
            SIGNAL_DONE(gdone);
            for (int rep = 0; rep < REPS(7); ++rep) ATTN_SEG(1, 512, 1024);
            WAIT_DONE(gdone);
#undef SIGNAL_DONE
#undef WAIT_DONE
#undef ATTN_SEG
            for (int rep = 0; rep < REPS(8); ++rep) {
            SchedGen S; S.init_plain(ws + WS_GEL, 32, (const bf16_t*)(ws + WS_BT2) + (size_t)l * SSMW * SSMW, SSMW * 2, T, SSMW, SSMW, ogrid(), obid());
            S.a_c16_b = T * 32; S.a_kt_b = 4l * T * 32;
            EpiGlu2 E{(const bf16_t*)(ws + WS_GEL), ARG(12) + l * SSMW, (bf16_t*)(ws + WS_MIX), ssp_s};
            ge::gemm_phase<EpiGlu2, SchedGen>(lds, S, E, otid());
            }
        }
        GRID_BAR();
        {
            unsigned char* ws = WSP(); float* ssp_s = (float*)(ws + WS_SSP); float* ssp_a = ssp_s + (size_t)T * 8; float* ssp_2 = ssp_a + (size_t)T * 8;
            for (int rep = 0; rep < REPS(9); ++rep) {
            const bool dummy = rep + 1 < REPS(9);
            SchedGen S; S.init_plain(ws + WS_MIX, D * 2, (const bf16_t*)(ws + WS_BT3) + (size_t)l * D * D, D * 2, T, D, D, ogrid(), obid());
            EpiWo E{ssp_s, ssp_a, (const bf16_t*)(ws + WS_HB), dummy ? (bf16_t*)(ws + WS_QP) : (bf16_t*)(ws + WS_HB), dummy ? (float*)(ws + WS_SLOC) : ssp_2};
            ge::gemm_phase<EpiWo, SchedGen>(lds, S, E, otid());
            }
        }
        GRID_BAR();
        {
            unsigned char* ws = WSP(); float* ssp_2 = (float*)(ws + WS_SSP) + (size_t)T * 16;
            for (int rep = 0; rep < REPS(10); ++rep) {
            SchedGen S; S.init_plain(ws + WS_HB, D * 2, (const bf16_t*)(ws + WS_BT4) + (size_t)l * D * D, D * 2, T, D, D, ogrid(), obid());
            EpiWq E{ssp_2, (bf16_t*)(ws + WS_QP)};
            ge::gemm_phase<EpiWq, SchedGen>(lds, S, E, otid());
            }
        }
        GRID_BAR();
        for (int rep = 0; rep < REPS(11); ++rep)
        { unsigned char* ws = WSP(); ph_select((const bf16_t*)(ws + WS_QP), (const bf16_t*)(ws + WS_KEYS) + (size_t)l * PH * 2 * NK * HALF, (unsigned short*)(ws + WS_IDX), (float*)(ws + WS_GATE), lds); }
        GRID_BAR();
        if (PROBE_MASK & (1 << 18)) { unsigned char* ws = WSP(); ph_peer_u<2>(lds, ws + WS_PU + (size_t)l * NEXP * D, (const bf16_t*)(ws + WS_HB), (const unsigned short*)(ws + WS_IDX), (bf16_t*)(ws + WS_UP)); }
        if (PROBE_MASK & (1 << 20)) { unsigned char* ws = WSP(); ph_peer_u<2, 5>(lds, ws + WS_PU + (size_t)l * NEXP * D, (const bf16_t*)(ws + WS_HB), (const unsigned short*)(ws + WS_IDX), (bf16_t*)(ws + WS_UP)); }
        if (PROBE_MASK & (1 << 19)) { unsigned char* ws = WSP(); ph_peer_u<3>(lds, ws + WS_PU + (size_t)l * NEXP * D, (const bf16_t*)(ws + WS_HB), (const unsigned short*)(ws + WS_IDX), (bf16_t*)(ws + WS_UP)); }
        if (PROBE_MASK & (1 << 16)) { unsigned char* ws = WSP(); ph_peer_u<0>(lds, ws + WS_PU + (size_t)l * NEXP * D, (const bf16_t*)(ws + WS_HB), (const unsigned short*)(ws + WS_IDX), (bf16_t*)(ws + WS_UP), 1023); }
        for (int rep = 0; rep < REPS(12); ++rep)
        { unsigned char* ws = WSP(); ph_peer_u<0>(lds, ws + WS_PU + (size_t)l * NEXP * D, (const bf16_t*)(ws + WS_HB), (const unsigned short*)(ws + WS_IDX), (bf16_t*)(ws + WS_PART)); }
        GRID_BAR();
        for (int rep = 0; rep < REPS(13); ++rep)
        { unsigned char* ws = WSP(); ph_peer_coef(lds, (const bf16_t*)(ws + WS_PART), (const float*)(ws + WS_SSP) + (size_t)T * 16, (const float*)(ws + WS_GATE), (const unsigned short*)(ws + WS_IDX), (const float*)(ws + WS_US) + (size_t)l * NEXP, (unsigned short*)(ws + WS_COEF)); }
        GRID_BAR();
        if (PROBE_MASK & (1 << 17)) { unsigned char* ws = WSP();
          ph_peer_v<0>(lds, ws + WS_PV8 + (size_t)l * NEXP * D, (const unsigned short*)(ws + WS_IDX), (const unsigned short*)(ws + WS_COEF), (const bf16_t*)(ws + WS_HB), (bf16_t*)(ws + WS_UP), (float*)(ws + WS_SLOC), 1023); }
        for (int rep = 0; rep < REPS(14); ++rep)
        { unsigned char* ws = WSP(); const bool dummy = rep + 1 < REPS(14);
          ph_peer_v<0>(lds, ws + WS_PV8 + (size_t)l * NEXP * D, (const unsigned short*)(ws + WS_IDX), (const unsigned short*)(ws + WS_COEF), (const bf16_t*)(ws + WS_HB),
                    dummy ? (bf16_t*)(ws + WS_UP) : (bf16_t*)(ws + WS_HB), dummy ? (float*)(ws + WS_SLOC) : (float*)(ws + WS_SSP) + (size_t)T * 32); }
        if (PROBE_MASK & (1 << 15)) { for (int rep = 0; rep < 8; ++rep) GRID_BAR(); }
        GRID_BAR();
    }
    { unsigned char* ws = WSP(); ph_final((const bf16_t*)(ws + WS_HB), (const float*)(ws + WS_SSP) + (size_t)T * 32, ARG(22), (float*)ldarg(lds, 23)); }
}
}

extern "C" void kernel_launch(void* const* d_in, const int* in_sizes, int n_in, void* d_out, int out_size, void* d_ws, size_t ws_size, hipStream_t stream) {
    using namespace nv;
    static int grid_blocks = 0;
    if (!grid_blocks) {
        int dev = 0, cus = 0, per_cu = 0;
        (void)hipGetDevice(&dev);
        (void)hipDeviceGetAttribute(&cus, hipDeviceAttributeMultiprocessorCount, dev);
        if (hipFuncSetAttribute((const void*)k_mega, hipFuncAttributeMaxDynamicSharedMemorySize, LDS_BYTES) != hipSuccess) { fprintf(stderr, "hipFuncSetAttribute failed\n"); grid_blocks = -1; return; }
        (void)hipOccupancyMaxActiveBlocksPerMultiprocessor(&per_cu, (const void*)k_mega, 512, LDS_BYTES);
        if (per_cu < 1) { fprintf(stderr, "occupancy query returned %d\n", per_cu); (void)hipGetLastError(); }
        grid_blocks = cus;
    }
    if (grid_blocks < 0) return;
    if (ws_size < WS_END || n_in != 23) { fprintf(stderr, "bad workspace / inputs\n"); return; }
    (void)hipMemsetAsync((char*)d_ws + WS_CTL, 0, 64 * 1024, stream);
    Params p{};
    for (int i = 0; i < 23; ++i) p.in[i] = (const float*)d_in[i];
    p.out = (float*)d_out; p.ws = (unsigned char*)d_ws;
    void* args[] = {&p};
    hipError_t e = hipLaunchCooperativeKernel((const void*)k_mega, dim3(grid_blocks), dim3(512), args, LDS_BYTES, stream);
    if (e != hipSuccess) fprintf(stderr, "cooperative launch failed: %s (grid %d)\n", hipGetErrorString(e), grid_blocks);
}
```
